# Optimizing an MI355X kernel written in HIP

```python
import jax, jax.numpy as jnp
from jax import lax
import numpy as np

D_MODEL = 2048
BATCH = 1
SEQ = 8192
DEPTH = 1

MEM_LEN = 256
RMS_EPS = 1e-5

SB_HEADS = 8
SB_HEAD_DIM = 128
SB_WIDTH = SB_HEADS * SB_HEAD_DIM
Q_BLOCK = 128

POOL_WINDOWS = (2, 4, 8, 16)
POOL_GROUPS = len(POOL_WINDOWS)
POOL_GROUP_DIM = 256
POOL_WIDTH = POOL_GROUPS * POOL_GROUP_DIM

N_BRANCH = 2
IN_WIDTH = 3 * SB_WIDTH + POOL_WIDTH

XA_HEADS = 4
XA_HEAD_DIM = 128
XA_WIDTH = XA_HEADS * XA_HEAD_DIM

N_EXPERTS = 32
TOP_K = 4
D_FF = D_MODEL
SWIGLU_ALPHA = 1.702
SWIGLU_LIMIT = 7.0
EXPERT_BLOCK = 256

kernel_name = "hybrid_stickbreak_pool_moe_block"


def rms_norm(x, g):
    x32 = x.astype(jnp.float32)
    y = x32 * lax.rsqrt(jnp.mean(x32 * x32, axis=-1, keepdims=True) + RMS_EPS)
    return (y * g.astype(jnp.float32)).astype(x.dtype)


def stick_breaking_attention(q, k, v):
    B, H, S, dh = q.shape
    nb = S // Q_BLOCK
    scale = dh ** -0.5
    k_pos = jnp.arange(S)
    q_blocks = q.reshape(B, H, nb, Q_BLOCK, dh).transpose(2, 0, 1, 3, 4)
    starts = jnp.arange(nb) * Q_BLOCK

    def one_block(args):
        q_blk, start = args
        z = jnp.einsum('bhqd,bhkd->bhqk', q_blk, k, preferred_element_type=jnp.float32) * scale
        q_pos = start + jnp.arange(Q_BLOCK)
        causal = k_pos[None, :] < q_pos[:, None]
        neg_log_keep = jnp.where(causal, jax.nn.softplus(z), 0.0)
        later = lax.cumsum(neg_log_keep, axis=3, reverse=True) - neg_log_keep
        log_w = jax.nn.log_sigmoid(z) - later
        w = jnp.where(causal, jnp.exp(log_w), 0.0)
        return jnp.einsum('bhqk,bhkd->bhqd', w.astype(v.dtype), v)

    out = lax.map(one_block, (q_blocks, starts))
    return out.transpose(1, 2, 0, 3, 4).reshape(B, H, S, dh)


def multiscale_pool(p, pool_lin, pool_scale):
    B, S, _ = p.shape
    pg = p.reshape(B, S, POOL_GROUPS, POOL_GROUP_DIM).astype(jnp.float32)
    csum = jnp.cumsum(pg, axis=1)
    pos = jnp.arange(S)
    outs = []
    for g, w in enumerate(POOL_WINDOWS):
        c = csum[:, :, g]
        c_prev = jnp.pad(c, ((0, 0), (w, 0), (0, 0)))[:, :S]
        count = jnp.minimum(pos + 1, w).astype(jnp.float32)[None, :, None]
        outs.append((c - c_prev) / count - pg[:, :, g])
    pooled = jnp.stack(outs, axis=2).astype(p.dtype)
    mixed = jnp.einsum('bsgc,gcd->bsgd', pooled, pool_lin)
    return mixed.reshape(B, S, POOL_WIDTH) * pool_scale


def memory_cross_attention(u, m, w_q, w_kv, w_o):
    B, S, _ = u.shape
    M = m.shape[1]
    q = (u @ w_q).reshape(B, S, XA_HEADS, XA_HEAD_DIM)
    kv = (m @ w_kv).reshape(B, M, 2, XA_HEADS, XA_HEAD_DIM)
    k, v = kv[:, :, 0], kv[:, :, 1]
    s = jnp.einsum('bshd,bmhd->bhsm', q, k, preferred_element_type=jnp.float32) * (XA_HEAD_DIM ** -0.5)
    p = jax.nn.softmax(s, axis=-1).astype(v.dtype)
    o = jnp.einsum('bhsm,bmhd->bshd', p, v).reshape(B, S, XA_WIDTH)
    return o @ w_o


def moe_ffn(t, w_router, b_router, w_up, b_up, w_down, b_down):
    B, S, D = t.shape
    N = B * S
    tok = t.reshape(N, D)
    logits = (tok @ w_router + b_router).astype(jnp.float32)
    top_logit, top_idx = lax.top_k(logits, TOP_K)
    gate = jax.nn.softmax(top_logit, axis=-1).astype(t.dtype)

    NK = N * TOP_K
    flat_e = top_idx.reshape(NK)
    flat_tok = jnp.arange(NK, dtype=jnp.int32) // TOP_K
    flat_g = gate.reshape(NK)
    order = jnp.argsort(flat_e)
    se, st, sg = flat_e[order], flat_tok[order], flat_g[order]

    counts = jnp.bincount(flat_e, length=N_EXPERTS)
    starts = jnp.cumsum(counts) - counts
    padded = (counts + EXPERT_BLOCK - 1) // EXPERT_BLOCK * EXPERT_BLOCK
    padded_ends = jnp.cumsum(padded)
    padded_starts = padded_ends - padded
    dest = padded_starts[se] + (jnp.arange(NK) - starts[se])

    nblk = -(-NK // EXPERT_BLOCK) + N_EXPERTS
    P = nblk * EXPERT_BLOCK
    row_tok = jnp.full((P,), N, jnp.int32).at[dest].set(st)
    row_gate = jnp.zeros((P,), t.dtype).at[dest].set(sg)
    blk_start = jnp.arange(nblk) * EXPERT_BLOCK
    blk_expert = jnp.minimum(jnp.sum(padded_ends[None, :] <= blk_start[:, None], axis=1), N_EXPERTS - 1)

    tok_pad = jnp.concatenate([tok, jnp.zeros((1, D), tok.dtype)], axis=0)
    rows = tok_pad[row_tok].reshape(nblk, EXPERT_BLOCK, D)

    def expert_block(args):
        xb, e = args
        hdn = xb @ w_up[e] + b_up[e]
        g_h = jnp.minimum(hdn[:, :D_FF], SWIGLU_LIMIT)
        l_h = jnp.clip(hdn[:, D_FF:], -SWIGLU_LIMIT, SWIGLU_LIMIT)
        act = g_h * jax.nn.sigmoid(SWIGLU_ALPHA * g_h) * (l_h + 1.0)
        return act @ w_down[e] + b_down[e]

    y_rows = lax.map(expert_block, (rows, blk_expert)).reshape(P, D)
    y = jax.ops.segment_sum(y_rows * row_gate[:, None], row_tok, num_segments=N + 1)[:N]
    return y.reshape(B, S, D)


def setup_inputs(seed: int = 0) -> dict:
    key = jax.random.key(seed)
    ks = jax.random.split(key, 24)
    f32 = jnp.float32
    L, D = DEPTH, D_MODEL

    def w(k, shape, fan_in):
        return jax.random.normal(k, shape, f32) * (fan_in ** -0.5)

    def gain(k, shape):
        return 1.0 + 0.02 * jax.random.normal(k, shape, f32)

    def small(k, shape):
        return 0.01 * jax.random.normal(k, shape, f32)

    return {
        "x": jax.random.normal(ks[0], (BATCH, SEQ, D), f32),
        "mem": jax.random.normal(ks[1], (BATCH, MEM_LEN, D), f32),
        "norm_mix": gain(ks[2], (L, D)),
        "w_in": w(ks[3], (L, D, IN_WIDTH), D),
        "pool_lin": w(ks[4], (L, POOL_GROUPS, POOL_GROUP_DIM, POOL_GROUP_DIM), POOL_GROUP_DIM),
        "pool_scale": gain(ks[5], (L, POOL_WIDTH)),
        "w_branch_a": w(ks[6], (L, SB_WIDTH, D), SB_WIDTH),
        "w_branch_b": w(ks[7], (L, POOL_WIDTH, D), POOL_WIDTH),
        "w_gate": w(ks[8], (L, D, N_BRANCH * D), D),
        "b_gate": small(ks[9], (L, N_BRANCH * D)),
        "w_mix_out": w(ks[10], (L, D, D), D),
        "xa_norm": gain(ks[11], (L, D)),
        "mem_norm": gain(ks[12], (L, D)),
        "xa_wq": w(ks[13], (L, D, XA_WIDTH), D),
        "xa_wkv": w(ks[14], (L, D, 2 * XA_WIDTH), D),
        "xa_wo": w(ks[15], (L, XA_WIDTH, D), XA_WIDTH),
        "moe_norm": gain(ks[16], (L, D)),
        "w_router": w(ks[17], (L, D, N_EXPERTS), D),
        "b_router": small(ks[18], (L, N_EXPERTS)),
        "w_up": w(ks[19], (L, N_EXPERTS, D, 2 * D_FF), D),
        "b_up": small(ks[20], (L, N_EXPERTS, 2 * D_FF)),
        "w_down": w(ks[21], (L, N_EXPERTS, D_FF, D), D_FF),
        "b_down": small(ks[22], (L, N_EXPERTS, D)),
        "final_norm": gain(ks[23], (D,)),
    }


def reference(x, mem, norm_mix, w_in, pool_lin, pool_scale, w_branch_a, w_branch_b, w_gate, b_gate,
              w_mix_out, xa_norm, mem_norm, xa_wq, xa_wkv, xa_wo, moe_norm, w_router, b_router,
              w_up, b_up, w_down, b_down, final_norm):
    B, S, D = x.shape
    h = x
    for l in range(DEPTH):
        u = rms_norm(h, norm_mix[l])
        proj = u @ w_in[l]
        q, k, v, p = jnp.split(proj, [SB_WIDTH, 2 * SB_WIDTH, 3 * SB_WIDTH], axis=-1)

        def heads(t):
            return t.reshape(B, S, SB_HEADS, SB_HEAD_DIM).transpose(0, 2, 1, 3)

        o_a = stick_breaking_attention(heads(q), heads(k), heads(v))
        o_a = o_a.transpose(0, 2, 1, 3).reshape(B, S, SB_WIDTH)
        o_b = multiscale_pool(p, pool_lin[l], pool_scale[l])

        y_a = o_a @ w_branch_a[l]
        y_b = o_b @ w_branch_b[l]
        g = jax.nn.sigmoid(u @ w_gate[l] + b_gate[l]).reshape(B, S, N_BRANCH, D)
        merged = g[:, :, 0] * y_a + g[:, :, 1] * y_b
        h = h + merged @ w_mix_out[l]

        h = h + memory_cross_attention(rms_norm(h, xa_norm[l]), rms_norm(mem, mem_norm[l]),
                                       xa_wq[l], xa_wkv[l], xa_wo[l])

        h = h + moe_ffn(rms_norm(h, moe_norm[l]), w_router[l], b_router[l],
                        w_up[l], b_up[l], w_down[l], b_down[l])
    return rms_norm(h, final_norm)
```

```cpp
#include <hip/hip_runtime.h>
#include <cstdio>
#include <cstdint>

#ifndef MK_ONE_LAUNCH
#define MK_ONE_LAUNCH 1
#endif
#ifndef REPEAT_MASK
#define REPEAT_MASK 0
#endif
#define GC_P1 208
#define GC_P12 232

#define LAS __attribute__((address_space(3)))
#define GAS __attribute__((address_space(1)))
typedef unsigned short bf16_t;
typedef short bf16x8 __attribute__((ext_vector_type(8)));
typedef short s16x4 __attribute__((ext_vector_type(4)));
typedef float f32x4 __attribute__((ext_vector_type(4)));
typedef float f32x2 __attribute__((ext_vector_type(2)));
typedef unsigned u32x4 __attribute__((ext_vector_type(4)));
typedef unsigned u32x2 __attribute__((ext_vector_type(2)));
typedef int v8i32 __attribute__((ext_vector_type(8)));
typedef int v6i32 __attribute__((ext_vector_type(6)));
typedef float f32x16 __attribute__((ext_vector_type(16)));

constexpr int S = 8192, D = 2048, MEM = 256;
constexpr int SBH = 8, HD = 128, SBW = 1024, POOLW = 1024, INW = 4096, NP1 = 8192;
constexpr int XAH = 4, XAW = 512;
constexpr int NE = 32, TOPK = 4, DFF = 2048, NK = S * TOPK, EBLK = 256, MAXBLK = NK / EBLK + NE, PROWS = MAXBLK * EBLK;
constexpr float RMS_EPS = 1e-5f;

constexpr size_t MiB = 1u << 20;
constexpr size_t WS_CTL = 0, CTL_ZERO_BYTES = 1 * MiB;
constexpr size_t WS_W1T = 2 * MiB;
constexpr size_t WS_WAT = WS_W1T + 32 * MiB;
constexpr size_t WS_WBT = WS_WAT + 4 * MiB;
constexpr size_t WS_WMT = WS_WBT + 4 * MiB;
constexpr size_t WS_PLT = WS_WMT + 8 * MiB;
constexpr size_t WS_WQT = WS_PLT + 1 * MiB;
constexpr size_t WS_WKVT = WS_WQT + 2 * MiB;
constexpr size_t WS_WOT = WS_WKVT + 4 * MiB;
constexpr size_t WS_WUPT = WS_WOT + 2 * MiB;
constexpr size_t WS_WDNT = WS_WUPT + 512 * MiB;
constexpr size_t WS_U = WS_WDNT + 256 * MiB;
constexpr size_t WS_MEMN = WS_U + 32 * MiB;
constexpr size_t WS_PG = WS_MEMN + 1 * MiB;
constexpr size_t WS_OA = WS_PG + 128 * MiB;
constexpr size_t WS_PO = WS_OA + 16 * MiB;
constexpr size_t WS_OB = WS_PO + 16 * MiB;
constexpr size_t WS_TMP = WS_OB + 16 * MiB;
constexpr size_t WS_MG = WS_TMP + 64 * MiB;
constexpr size_t WS_H1 = WS_MG + 32 * MiB;
constexpr size_t WS_U2 = WS_H1 + 64 * MiB;
constexpr size_t WS_QXA = WS_U2 + 32 * MiB;
constexpr size_t WS_KVM = WS_QXA + 8 * MiB;
constexpr size_t WS_OXA = WS_KVM + 1 * MiB;
constexpr size_t WS_H2 = WS_OXA + 8 * MiB;
constexpr size_t WS_TB = WS_H2 + 64 * MiB;
constexpr size_t WS_ROWS = WS_TB + 32 * MiB;
constexpr size_t WS_ACT = WS_ROWS + 160 * MiB;
constexpr size_t WS_SLOT = WS_ACT + 160 * MiB;
constexpr size_t WS_ASGE = WS_SLOT + 128 * MiB;
constexpr size_t WS_ASGP = WS_ASGE + 1 * MiB;
constexpr size_t WS_GATE = WS_ASGP + 1 * MiB;
constexpr size_t WS_RSLOT = WS_GATE + 1 * MiB;
constexpr size_t WS_WRT = WS_RSLOT + 1 * MiB;
constexpr size_t WS_END = WS_WRT + 1 * MiB;
constexpr int CW_CNT = 64;
constexpr int CW_CUR = 192;  constexpr int CW_DONE = 256;
constexpr int CW_BAR = 4096;

constexpr int RING_BYTES = 131072;
constexpr int LDS_X_OFF = RING_BYTES;
constexpr int LDS_BYTES = 163840;
constexpr int LX_BAR = 0;
constexpr int LX_TAB = 64;
constexpr int LX_CVS = 32;
constexpr int LX_SBF = 128;
constexpr int LX_LOG = 1024;
constexpr int LX_RPART = 4096;

constexpr int NWAVES = 8;

__device__ __forceinline__ unsigned cvt_pk_bf16(float lo, float hi) { unsigned r; asm volatile("v_cvt_pk_bf16_f32 %0, %1, %2" : "=v"(r) : "v"(lo), "v"(hi)); return r; }
__device__ __forceinline__ unsigned pk4_fp8(float a, float b, float c, float d) { int p = __builtin_amdgcn_cvt_pk_fp8_f32(a, b, 0, false); p = __builtin_amdgcn_cvt_pk_fp8_f32(c, d, p, true); return (unsigned)p; }
__device__ __forceinline__ v6i32 pk32_fp6(const f32x16& lo, const f32x16& hi) { return __builtin_amdgcn_cvt_scalef32_2xpk16_fp6_f32(lo, hi, 1.0f); }
__device__ __forceinline__ void st_fp6_block(unsigned char* p, const v6i32& b) { *(u32x4*)p = (u32x4){(unsigned)b[0], (unsigned)b[1], (unsigned)b[2], (unsigned)b[3]}; *(u32x4*)(p + 64) = (u32x4){(unsigned)b[4], (unsigned)b[5], 0u, 0u}; }
__device__ __forceinline__ float bf_lo(unsigned w) { return __uint_as_float(w << 16); }
__device__ __forceinline__ float bf_hi(unsigned w) { return __uint_as_float(w & 0xffff0000u); }
__device__ __forceinline__ float wave_sum(float v) {
#pragma unroll
    for (int o = 1; o < 64; o <<= 1) v += __shfl_xor(v, o);
    return v;
}
__device__ __forceinline__ float sigmoidf_fast(float x) { return __builtin_amdgcn_rcpf(1.0f + __builtin_amdgcn_exp2f(x * -1.4426950408889634f)); }

#define XB_TMO      128
#define XB_XCNT(j)  (256  + 64 * (j))
#define XB_XSUB(j)  (1280 + 64 * (j))
#define XB_XGEN(j)  (2304 + 64 * (j))
#define XB_TOP      3328
#define XB_TOPGEN   3392
#define XCD_BAR_WORDS 3456
#define XB_SPIN_CAP (1u << 18)
__device__ __forceinline__ unsigned xb_ld(unsigned* p)              { return __hip_atomic_load(p, __ATOMIC_RELAXED, __HIP_MEMORY_SCOPE_AGENT); }
__device__ __forceinline__ unsigned xb_add(unsigned* p, unsigned v) { return __hip_atomic_fetch_add(p, v, __ATOMIC_RELAXED, __HIP_MEMORY_SCOPE_AGENT); }
__device__ __forceinline__ unsigned xb_xcc_id() { return (unsigned)__builtin_amdgcn_s_getreg((3 << 11) | 20) & 0xFu; }
#define XB_SPIN(cond, bar) do { unsigned _sp = 0; while (cond) { __builtin_amdgcn_s_sleep(1); \
    if ((++_sp & 255u) == 0u) { if (xb_ld(&(bar)[XB_TMO])) break; if (_sp > XB_SPIN_CAP) { atomicAdd(&(bar)[XB_TMO], 1u); break; } } } } while (0)
struct XcdBarrier { unsigned* bar; unsigned x; volatile LAS unsigned* st; };
__device__ __forceinline__ XcdBarrier xcd_barrier_post(unsigned* bar, volatile LAS unsigned* st) {
    XcdBarrier b; b.bar = bar; b.x = xb_xcc_id(); b.st = st;
    if (threadIdx.x == 0) (void)xb_add(&bar[XB_XCNT(b.x)], 1u);
    return b;
}
__device__ __forceinline__ void xcd_barrier_complete(unsigned* bar, unsigned x, unsigned& nloc, unsigned& nx) {
    const unsigned G = gridDim.x * gridDim.y * gridDim.z;
    unsigned sum, cnt, mine, sp = 0u;
    for (;;) {
        sum = 0u; cnt = 0u; mine = 0u;
#pragma unroll
        for (unsigned j = 0; j < 16; ++j) { const unsigned c = xb_ld(&bar[XB_XCNT(j)]); sum += c; cnt += (c > 0u) ? 1u : 0u; mine = (j == x) ? c : mine; }
        if (sum == G) break;
        __builtin_amdgcn_s_sleep(1);
        if ((++sp & 255u) == 0u) { if (xb_ld(&bar[XB_TMO])) break; if (sp > XB_SPIN_CAP) { atomicAdd(&bar[XB_TMO], 1u); break; } }
    }
    nloc = mine > 0u ? mine : 1u; nx = cnt > 0u ? cnt : 1u;
}
__device__ __forceinline__ void xcd_barrier(const XcdBarrier& b) {
    asm volatile("s_waitcnt vmcnt(0)" ::: "memory");
    __syncthreads();
    if (threadIdx.x == 0) {
        unsigned* bar = b.bar;
        __builtin_amdgcn_s_waitcnt(0);
        unsigned nloc = b.st[0], nx = b.st[1];
        if (nloc == 0u) { xcd_barrier_complete(bar, b.x, nloc, nx); b.st[0] = nloc; b.st[1] = nx; }
        const unsigned old = xb_add(&bar[XB_XSUB(b.x)], 1u);
        const unsigned gen = old / nloc;
        if (old + 1u == (gen + 1u) * nloc) {
            __builtin_amdgcn_fence(__ATOMIC_RELEASE, "agent");
            asm volatile("s_waitcnt vmcnt(0)" ::: "memory");
            const unsigned og = xb_add(&bar[XB_TOP], 1u);
            const unsigned tg = og / nx;
            if (og + 1u == (tg + 1u) * nx) xb_add(&bar[XB_TOPGEN], 1u);
            else XB_SPIN(xb_ld(&bar[XB_TOPGEN]) == tg, bar);
            __builtin_amdgcn_fence(__ATOMIC_ACQUIRE, "agent");
            xb_add(&bar[XB_XGEN(b.x)], 1u);
            asm volatile("s_waitcnt vmcnt(0)" ::: "memory");
        } else {
            XB_SPIN(xb_ld(&bar[XB_XGEN(b.x)]) == gen, bar);
            __builtin_amdgcn_fence(__ATOMIC_ACQUIRE, "agent");
            asm volatile("s_waitcnt vmcnt(0)" ::: "memory");
        }
    }
    __syncthreads();
}

namespace pg8 {
constexpr int BM = 256, BK = 64, HALF = 128, HTB = HALF * BK * 2, STAGE_BYTES = 8 * HTB, NXCD = 8, WGM = 8;
__host__ __device__ __forceinline__ int lds_byte(int r, int c) { const int st = (r >> 4) * 2 + (c >> 5), rr = r & 15, cc = c & 31, ob = rr * 64 + cc * 2; return st * 1024 + (ob ^ (((ob >> 9) & 1) << 5)); }
__host__ __device__ __forceinline__ void stage_rc(int b, int& R, int& C) { const int st = b / 1024, sb = b % 1024, swz = sb ^ (((sb >> 9) & 1) << 5); R = (st >> 1) * 16 + swz / 64; C = (st & 1) * 32 + (swz % 64) / 2; }
__host__ __device__ __forceinline__ int perm32(int rho) { const int n = rho >> 4, i = rho & 15; return 8 * (i >> 2) + 4 * n + (i & 3); }

struct Unit { const char* A; const char* B0; const char* B1; int r0, c0, x; };

__device__ __forceinline__ void tile_of(int L, int nM, int nN, int& pm, int& pn) {
    const int nwg = nM * nN; int wgid = L;
    { const int q = nwg / NXCD, r = nwg % NXCD, xcd = wgid % NXCD, off = wgid / NXCD; wgid = (xcd < r ? xcd * (q + 1) : r * (q + 1) + (xcd - r) * q) + off; }
    const int nig = WGM * nN, gid = wgid / nig, fm = gid * WGM, gsz = (nM - fm) < WGM ? (nM - fm) : WGM;
    pm = fm + ((wgid % nig) % gsz); pn = (wgid % nig) / gsz;
}
struct DenseSched {
    const char* A; const char* B; int lda, ldb, nM, nN, G, c;
    __device__ __forceinline__ bool next(int i, Unit& u) const {
        const long L = (long)i * G + c; if (L >= (long)nM * nN) return false;
        int pm, pn; tile_of((int)L, nM, nN, pm, pn);
        u.A = A + (size_t)pm * BM * lda * 2; u.B0 = B + (size_t)pn * BM * ldb * 2; u.B1 = u.B0 + (size_t)HALF * ldb * 2; u.r0 = pm * BM; u.c0 = pn * BM; u.x = 0; return true;
    }
};
struct BranchSched {
    const char* A0; const char* A1; const char* B0; const char* B1; int lda, ldb, nM, nN, G, c;
    __device__ __forceinline__ bool next(int i, Unit& u) const {
        const long L = (long)(i >> 1) * G + c; if (L >= (long)nM * nN) return false;
        int pm, pn; tile_of((int)L, nM, nN, pm, pn); const int br = i & 1;
        u.A = (br ? A1 : A0) + (size_t)pm * BM * lda * 2; u.B0 = (br ? B1 : B0) + (size_t)pn * BM * ldb * 2; u.B1 = u.B0 + (size_t)HALF * ldb * 2; u.r0 = pm * BM; u.c0 = pn * BM; u.x = br; return true;
    }
};
struct PoolSched {
    const char* A; const char* B; int G, c;
    __device__ __forceinline__ bool next(int i, Unit& u) const {
        const int L = i * G + c; if (L >= (S / BM) * 4) return false;
        const int pm = L >> 2, g = L & 3;
        u.A = A + ((size_t)pm * BM * POOLW + g * 256) * 2; u.B0 = B + (size_t)g * 256 * 256 * 2; u.B1 = u.B0 + (size_t)HALF * 256 * 2; u.r0 = pm * BM; u.c0 = g * 256; u.x = g; return true;
    }
};
struct MoeSched {
    const char* A; const char* B; int NT; size_t estride; size_t tstride; size_t hoff; const LAS int* tab; int G, c; bool gather; size_t arow;
    __device__ __forceinline__ int tu(int i) const { return __builtin_amdgcn_readfirstlane(tab[i]); }
    __device__ __forceinline__ bool next(int i, Unit& u) const {
        const int L = i * G + c; if (L >= tu(32)) return false;
        int e = 0;
#pragma unroll
        for (int s = 16; s >= 1; s >>= 1) { if (tu(e + s) <= L) e += s; }
        const int r = L - tu(e), nb = tu(66 + e), nt = r / nb, blk = r - nt * nb, prow = tu(33 + e) + blk * EBLK;
        u.A = gather ? A : A + (size_t)prow * arow; u.B0 = B + (size_t)e * estride + (size_t)nt * tstride; u.B1 = u.B0 + hoff; u.r0 = prow; u.c0 = nt; u.x = e; return true;
    }
};

template <class Epi, class Sched, bool ALIGN_EPI, bool GATHER = false, int PREC = 0>
__device__ __forceinline__ void gemm_phase(LAS unsigned char* lds, const int K, const int lda, const int ldb, const Sched& S, const Epi& E, const LAS int* gtab = nullptr) {
    const int tid = threadIdx.x, wid = __builtin_amdgcn_readfirstlane(tid >> 6), lane = tid & 63, wr = wid >> 2, wc = wid & 3, fr = lane & 15, fq = lane >> 4;
    const int nt = K / BK;
    unsigned voffB[2], vc[2][2], vn[2][2]; int RA[2], CA[2];
#pragma unroll
    for (int i = 0; i < 2; ++i) { int R, C; stage_rc(tid * 16 + i * 8192, R, C); const int Rb = Epi::PERM ? ((R & ~31) + perm32(R & 31)) : R; RA[i] = R; CA[i] = C;
        voffB[i] = (unsigned)(Rb * ldb + C) * 2u; }
#define PG8_AOFF(dst, ord) do { _Pragma("unroll") for (int _h = 0; _h < 2; ++_h) _Pragma("unroll") for (int _i = 0; _i < 2; ++_i) \
        dst[_h][_i] = GATHER ? ((unsigned)gtab[(ord) * 256 + _h * HALF + RA[_i]] * (unsigned)lda + (unsigned)CA[_i]) * 2u : (unsigned)((_h * HALF + RA[_i]) * lda + CA[_i]) * 2u; } while (0)
    const size_t kstep = (size_t)(BK * 2);
    const unsigned ldsw = (unsigned)wid * 1024u;
    const int aoff = lds_byte(wr * 64 + fr, fq * 8), boff = lds_byte(wc * 32 + fr, fq * 8);
#define PG8_SA(b, h) (((b) * 2 + (h)) * HTB)
#define PG8_SB(b, h) ((4 + (b) * 2 + (h)) * HTB)
#define PG8_STAGE(bufoff, gbase, voff) do { _Pragma("unroll") for (int _i = 0; _i < 2; ++_i) \
        __builtin_amdgcn_global_load_lds((const unsigned*)((const char*)(gbase) + (voff)[_i]), (LAS unsigned*)(lds + (bufoff) + ldsw + _i * 8192), 16, 0, 0); } while (0)
#define PG8_LD6(off) __builtin_bit_cast(v6i32, __builtin_shufflevector(*(const LAS u32x4*)(lds + (off)), __builtin_shufflevector(*(const LAS u32x2*)(lds + (off) + 1024), *(const LAS u32x2*)(lds + (off) + 1024), 0, 1, -1, -1), 0, 1, 2, 3, 4, 5))
#define PG8_LD8(off) __builtin_bit_cast(v8i32, __builtin_shufflevector(*(const LAS u32x4*)(lds + (off)), *(const LAS u32x4*)(lds + (off) + 1024), 0, 1, 2, 3, 4, 5, 6, 7))
#define PG8_LDA(dst, b, h) do { if (PREC == 2) { _Pragma("unroll") for (int m = 0; m < 4; ++m) dst##6[m] = PG8_LD6(PG8_SA(b, h) + aoff + m * 2048); } \
      else if (PREC == 1) { _Pragma("unroll") for (int m = 0; m < 4; ++m) dst##8[m] = PG8_LD8(PG8_SA(b, h) + aoff + m * 2048); } \
      else { _Pragma("unroll") for (int m = 0; m < 4; ++m) _Pragma("unroll") for (int k = 0; k < 2; ++k) dst[m][k] = *(const LAS bf16x8*)(lds + PG8_SA(b, h) + aoff + m * 2048 + k * 1024); } } while (0)
#define PG8_LDB(dst, b, h) do { if (PREC == 2) { _Pragma("unroll") for (int n = 0; n < 2; ++n) dst##6[n] = PG8_LD6(PG8_SB(b, h) + boff + n * 2048); } \
      else if (PREC == 1) { _Pragma("unroll") for (int n = 0; n < 2; ++n) dst##8[n] = PG8_LD8(PG8_SB(b, h) + boff + n * 2048); } \
      else { _Pragma("unroll") for (int n = 0; n < 2; ++n) _Pragma("unroll") for (int k = 0; k < 2; ++k) dst[n][k] = *(const LAS bf16x8*)(lds + PG8_SB(b, h) + boff + n * 2048 + k * 1024); } } while (0)
#define PG8_MMA(ai, bj, At, Bt) do { __builtin_amdgcn_s_setprio(1); if (PREC == 2) { _Pragma("unroll") for (int m = 0; m < 4; ++m) _Pragma("unroll") for (int n = 0; n < 2; ++n) \
        asm volatile("v_mfma_scale_f32_16x16x128_f8f6f4 %0, %1, %2, %0, %3, %4 op_sel_hi:[0,0,0] cbsz:2 blgp:2" : "+v"(acc[ai][bj][m][n]) : "v"(Bt##6[n]), "v"(At##6[m]), "v"(sc_w), "v"(sc_a)); } \
      else if (PREC == 1) { _Pragma("unroll") for (int m = 0; m < 4; ++m) _Pragma("unroll") for (int n = 0; n < 2; ++n) \
        asm volatile("v_mfma_scale_f32_16x16x128_f8f6f4 %0, %1, %2, %0, %3, %4 op_sel_hi:[0,0,0]" : "+v"(acc[ai][bj][m][n]) : "v"(Bt##8[n]), "v"(At##8[m]), "v"(sc_w), "v"(sc_a)); } \
      else { _Pragma("unroll") for (int m = 0; m < 4; ++m) _Pragma("unroll") for (int n = 0; n < 2; ++n) _Pragma("unroll") for (int k = 0; k < 2; ++k) \
        acc[ai][bj][m][n] = __builtin_amdgcn_mfma_f32_16x16x32_bf16(Bt[n][k], At[m][k], acc[ai][bj][m][n], 0, 0, 0); } __builtin_amdgcn_s_setprio(0); } while (0)
#define PG8_WAIT_V(n) asm volatile("s_waitcnt vmcnt(" #n ")" ::: "memory")
#define PG8_WAIT_L(n) asm volatile("s_waitcnt lgkmcnt(" #n ")" ::: "memory")
#define PG8_BAR __builtin_amdgcn_s_barrier()
#define PG8_SCHED __builtin_amdgcn_sched_barrier(0)
    Unit cur, nxt; int ui = 0;
    if (!S.next(0, cur)) return;
    f32x4 acc[2][2][4][2];
#pragma unroll
    for (int a = 0; a < 2; ++a)
#pragma unroll
        for (int b = 0; b < 2; ++b)
#pragma unroll
            for (int m = 0; m < 4; ++m)
#pragma unroll
                for (int n = 0; n < 2; ++n) acc[a][b][m][n] = (f32x4){0.f, 0.f, 0.f, 0.f};
    bf16x8 At[4][2], B0[2][2], B1[2][2]; v8i32 At8[4], B08[2], B18[2]; v6i32 At6[4], B06[2], B16[2];
    const int sc_w = 121, sc_a = (PREC == 2) ? 126 : 127;
    PG8_AOFF(vc, 0);
#pragma unroll
    for (int _h = 0; _h < 2; ++_h) { vn[_h][0] = vc[_h][0]; vn[_h][1] = vc[_h][1]; }
    PG8_STAGE(PG8_SB(0, 0), cur.B0, voffB); PG8_STAGE(PG8_SB(0, 1), cur.B1, voffB); PG8_STAGE(PG8_SA(0, 0), cur.A, vc[0]); PG8_STAGE(PG8_SA(0, 1), cur.A, vc[1]);
    if (wr == 1) PG8_BAR;
    PG8_WAIT_V(2); PG8_BAR;
    PG8_STAGE(PG8_SB(1, 0), cur.B0 + kstep, voffB); PG8_STAGE(PG8_SA(1, 0), cur.A + kstep, vc[0]); PG8_STAGE(PG8_SB(1, 1), cur.B1 + kstep, voffB);
    PG8_WAIT_V(6); PG8_BAR;
    for (;;) {
        const bool has_next = S.next(ui + 1, nxt);
        if (GATHER && has_next) PG8_AOFF(vn, ui + 1);
        const char* nA = has_next ? nxt.A : cur.A; const char* nB0 = has_next ? nxt.B0 : cur.B0; const char* nB1 = has_next ? nxt.B1 : cur.B1;
#pragma nounroll
        for (int t = 0; t < nt; t += 2) {
            const bool last = (t == nt - 2);
            const char* a1 = cur.A + (size_t)(t + 1) * kstep;
            const char* a2 = last ? nA : cur.A + (size_t)(t + 2) * kstep;
            const char* b20 = last ? nB0 : cur.B0 + (size_t)(t + 2) * kstep; const char* b21 = last ? nB1 : cur.B1 + (size_t)(t + 2) * kstep;
            const char* a3 = a2 + kstep; const char* b30 = b20 + kstep; const char* b31 = b21 + kstep;
            unsigned v2[2][2];
#pragma unroll
            for (int _h = 0; _h < 2; ++_h) { v2[_h][0] = (GATHER && last) ? vn[_h][0] : vc[_h][0]; v2[_h][1] = (GATHER && last) ? vn[_h][1] : vc[_h][1]; }
            PG8_LDB(B0, 0, 0); PG8_LDB(B1, 0, 1); PG8_SCHED; PG8_LDA(At, 0, 0); PG8_STAGE(PG8_SA(1, 1), a1, vc[1]);
            PG8_WAIT_V(8); PG8_WAIT_L(0); PG8_BAR; PG8_MMA(0, 0, At, B0); PG8_MMA(0, 1, At, B1); PG8_BAR; PG8_SCHED;
            PG8_LDA(At, 0, 1); PG8_STAGE(PG8_SB(0, 0), b20, voffB); PG8_STAGE(PG8_SB(0, 1), b21, voffB); PG8_STAGE(PG8_SA(0, 0), a2, v2[0]);
            PG8_WAIT_V(8); PG8_WAIT_L(0); PG8_BAR; PG8_MMA(1, 0, At, B0); PG8_MMA(1, 1, At, B1); PG8_BAR; PG8_SCHED;
            PG8_LDB(B0, 1, 0); PG8_LDB(B1, 1, 1); PG8_SCHED; PG8_LDA(At, 1, 0); PG8_STAGE(PG8_SA(0, 1), a2, v2[1]);
            PG8_WAIT_V(8); PG8_WAIT_L(0); PG8_BAR; PG8_MMA(0, 0, At, B0); PG8_MMA(0, 1, At, B1); PG8_BAR; PG8_SCHED;
            PG8_LDA(At, 1, 1); PG8_STAGE(PG8_SB(1, 0), b30, voffB); PG8_STAGE(PG8_SB(1, 1), b31, voffB); PG8_STAGE(PG8_SA(1, 0), a3, v2[0]);
            PG8_WAIT_V(8); PG8_WAIT_L(0); PG8_BAR; PG8_MMA(1, 0, At, B0); PG8_MMA(1, 1, At, B1); PG8_BAR; PG8_SCHED;
        }
        if constexpr (ALIGN_EPI) { if (wr == 0) PG8_BAR; }
        if (PREC != 0) asm volatile("s_nop 15\n\ts_nop 15\n\ts_nop 15\n\ts_nop 15" ::: "memory");
        E(acc, cur, wr, wc, fr, fq);
        if (!has_next) break;
        bool kp = false; if constexpr (Epi::KEEPS) kp = E.keep(cur);
        if (!kp) {
#pragma unroll
        for (int a = 0; a < 2; ++a)
#pragma unroll
            for (int b = 0; b < 2; ++b)
#pragma unroll
                for (int m = 0; m < 4; ++m)
#pragma unroll
                    for (int n = 0; n < 2; ++n) acc[a][b][m][n] = (f32x4){0.f, 0.f, 0.f, 0.f}; }
        cur = nxt; ++ui;
        if (GATHER) {
#pragma unroll
            for (int _h = 0; _h < 2; ++_h) { vc[_h][0] = vn[_h][0]; vc[_h][1] = vn[_h][1]; } }
        if constexpr (ALIGN_EPI) { if (wr == 1) PG8_BAR; }
    }
    PG8_WAIT_V(0);
    if constexpr (!ALIGN_EPI) { if (wr == 0) PG8_BAR; }
    PG8_BAR;
#undef PG8_AOFF
#undef PG8_SA
#undef PG8_SB
#undef PG8_STAGE
#undef PG8_LDA
#undef PG8_LDB
#undef PG8_MMA
#undef PG8_LD8
#undef PG8_LD6
#undef PG8_WAIT_V
#undef PG8_WAIT_L
#undef PG8_BAR
#undef PG8_SCHED
}

typedef f32x4 Acc[2][2][4][2];

struct EpiProj {
    static constexpr bool PERM = true, KEEPS = false;
    bf16_t* O; const float* bgate;
    __device__ __forceinline__ void operator()(Acc& acc, const Unit& u, int wr, int wc, int fr, int fq) const {
        const int row0 = u.r0 + wr * 64 + fr, col0 = u.c0 + wc * 32 + 8 * fq; const bool gate = u.c0 >= INW;
        f32x4 bv[2][2];
#pragma unroll
        for (int bj = 0; bj < 2; ++bj)
#pragma unroll
            for (int n = 0; n < 2; ++n) bv[bj][n] = gate ? *(const f32x4*)(bgate + (col0 - INW) + bj * HALF + 4 * n) : (f32x4){0.f, 0.f, 0.f, 0.f};
#pragma unroll
        for (int ai = 0; ai < 2; ++ai)
#pragma unroll
            for (int m = 0; m < 4; ++m) { bf16_t* rowp = O + (size_t)(row0 + ai * HALF + m * 16) * NP1 + col0;
#pragma unroll
                for (int bj = 0; bj < 2; ++bj) { f32x4 v0 = acc[ai][bj][m][0] + bv[bj][0], v1 = acc[ai][bj][m][1] + bv[bj][1];
                    if (gate) {
#pragma unroll
                        for (int j = 0; j < 4; ++j) { v0[j] = sigmoidf_fast(v0[j]); v1[j] = sigmoidf_fast(v1[j]); } }
                    u32x4 w; w.x = cvt_pk_bf16(v0[0], v0[1]); w.y = cvt_pk_bf16(v0[2], v0[3]); w.z = cvt_pk_bf16(v1[0], v1[1]); w.w = cvt_pk_bf16(v1[2], v1[3]);
                    *(u32x4*)(rowp + bj * HALF) = w; } }
    }
};
struct EpiBf16 {
    static constexpr bool PERM = true, KEEPS = false;
    bf16_t* O; int ldc; const float* cscale;
    __device__ __forceinline__ void operator()(Acc& acc, const Unit& u, int wr, int wc, int fr, int fq) const {
        const int row0 = u.r0 + wr * 64 + fr, col0 = u.c0 + wc * 32 + 8 * fq;
#pragma unroll
        for (int bj = 0; bj < 2; ++bj) {
            const f32x4 s0 = cscale ? *(const f32x4*)(cscale + col0 + bj * HALF) : (f32x4){1.f, 1.f, 1.f, 1.f}, s1 = cscale ? *(const f32x4*)(cscale + col0 + bj * HALF + 4) : (f32x4){1.f, 1.f, 1.f, 1.f};
#pragma unroll
            for (int ai = 0; ai < 2; ++ai)
#pragma unroll
                for (int m = 0; m < 4; ++m) { bf16_t* rowp = O + (size_t)(row0 + ai * HALF + m * 16) * ldc + col0;
                    const f32x4 v0 = acc[ai][bj][m][0] * s0, v1 = acc[ai][bj][m][1] * s1;
                    u32x4 w; w.x = cvt_pk_bf16(v0[0], v0[1]); w.y = cvt_pk_bf16(v0[2], v0[3]); w.z = cvt_pk_bf16(v1[0], v1[1]); w.w = cvt_pk_bf16(v1[2], v1[3]);
                    *(u32x4*)(rowp + bj * HALF) = w; } }
    }
};
struct EpiBranch {
    static constexpr bool PERM = true, KEEPS = true;
    const bf16_t* PG; bf16_t* MG;
    __device__ __forceinline__ bool keep(const Unit& u) const { return u.x == 0; }
    __device__ __forceinline__ void operator()(Acc& acc, const Unit& u, int wr, int wc, int fr, int fq) const {
        const int row0 = u.r0 + wr * 64 + fr, col0 = u.c0 + wc * 32 + 8 * fq; const int br = u.x;
#pragma unroll
        for (int ai = 0; ai < 2; ++ai)
#pragma unroll
            for (int m = 0; m < 4; ++m) { const size_t row = (size_t)(row0 + ai * HALF + m * 16);
#pragma unroll
                for (int bj = 0; bj < 2; ++bj) { const int col = col0 + bj * HALF;
                    const u32x4 gb = *(const u32x4*)(PG + row * NP1 + INW + D + col);
                    f32x4 h0 = {bf_lo(gb.x), bf_hi(gb.x), bf_lo(gb.y), bf_hi(gb.y)}, h1 = {bf_lo(gb.z), bf_hi(gb.z), bf_lo(gb.w), bf_hi(gb.w)};
#pragma unroll
                    for (int j = 0; j < 4; ++j) { h0[j] = fmaxf(h0[j], 1e-30f); h1[j] = fmaxf(h1[j], 1e-30f); }
                    if (br == 0) { const u32x4 ga = *(const u32x4*)(PG + row * NP1 + INW + col);
                        const f32x4 a0 = {bf_lo(ga.x), bf_hi(ga.x), bf_lo(ga.y), bf_hi(ga.y)}, a1 = {bf_lo(ga.z), bf_hi(ga.z), bf_lo(ga.w), bf_hi(ga.w)};
#pragma unroll
                        for (int j = 0; j < 4; ++j) { acc[ai][bj][m][0][j] *= a0[j] * __builtin_amdgcn_rcpf(h0[j]); acc[ai][bj][m][1][j] *= a1[j] * __builtin_amdgcn_rcpf(h1[j]); } }
                    else { const f32x4 v0 = acc[ai][bj][m][0] * h0, v1 = acc[ai][bj][m][1] * h1;
                        u32x4 w; w.x = cvt_pk_bf16(v0[0], v0[1]); w.y = cvt_pk_bf16(v0[2], v0[3]); w.z = cvt_pk_bf16(v1[0], v1[1]); w.w = cvt_pk_bf16(v1[2], v1[3]);
                        *(u32x4*)(MG + row * D + col) = w; } } }
    }
};
struct EpiResid {
    static constexpr bool PERM = false, KEEPS = false;
    const float* res; float* out; int ldc;
    __device__ __forceinline__ void operator()(Acc& acc, const Unit& u, int wr, int wc, int fr, int fq) const {
        const int row0 = u.r0 + wr * 64 + fr, col0 = u.c0 + wc * 32 + 4 * fq;
#pragma unroll
        for (int ai = 0; ai < 2; ++ai)
#pragma unroll
            for (int m = 0; m < 4; ++m) { const size_t off = (size_t)(row0 + ai * HALF + m * 16) * ldc + col0;
#pragma unroll
                for (int bj = 0; bj < 2; ++bj)
#pragma unroll
                    for (int n = 0; n < 2; ++n) { const f32x4 r = *(const f32x4*)(res + off + bj * HALF + n * 16); *(f32x4*)(out + off + bj * HALF + n * 16) = r + acc[ai][bj][m][n]; }
                asm volatile("" ::: "memory"); }
    }
};
struct EpiUp {
    static constexpr bool PERM = true, KEEPS = false;
    const float* bup; unsigned char* ACT;
    __device__ __forceinline__ void operator()(Acc& acc, const Unit& u, int wr, int wc, int fr, int fq) const {
        const int row0 = u.r0 + wr * 64 + fr, col0 = u.c0 * HALF + wc * 32 + 8 * fq; const float* be = bup + (size_t)u.x * (2 * DFF);
        f32x4 bg[2], bl[2];
#pragma unroll
        for (int n = 0; n < 2; ++n) { bg[n] = *(const f32x4*)(be + col0 + 4 * n); bl[n] = *(const f32x4*)(be + DFF + col0 + 4 * n); }
#pragma unroll
        for (int ai = 0; ai < 2; ++ai)
#pragma unroll
            for (int m = 0; m < 4; ++m) { unsigned char* rowp = ACT + (size_t)(row0 + ai * HALF + m * 16) * DFF + col0; f32x4 o[2];
#pragma unroll
                for (int n = 0; n < 2; ++n) { const f32x4 gv = acc[ai][0][m][n] + bg[n], lv = acc[ai][1][m][n] + bl[n];
#pragma unroll
                    for (int j = 0; j < 4; ++j) { const float g = fminf(gv[j], 7.0f), l = fminf(fmaxf(lv[j], -7.0f), 7.0f); o[n][j] = g * sigmoidf_fast(1.702f * g) * (l + 1.0f); } }
                u32x2 w; w.x = pk4_fp8(o[0][0], o[0][1], o[0][2], o[0][3]); w.y = pk4_fp8(o[1][0], o[1][1], o[1][2], o[1][3]);
                *(u32x2*)rowp = w; }
    }
};
struct EpiDown {
    static constexpr bool PERM = true, KEEPS = false;
    const float* bdn; const int* rslot; const float* gate; unsigned char* SLOT;
    __device__ __forceinline__ void operator()(Acc& acc, const Unit& u, int wr, int wc, int fr, int fq) const {
        const int row0 = u.r0 + wr * 64 + fr, col0 = u.c0 * BM + wc * 32 + 8 * fq; const float* be = bdn + (size_t)u.x * D;
        f32x4 bv[2][2];
#pragma unroll
        for (int bj = 0; bj < 2; ++bj)
#pragma unroll
            for (int n = 0; n < 2; ++n) bv[bj][n] = *(const f32x4*)(be + col0 + bj * HALF + 4 * n);
#pragma unroll
        for (int ai = 0; ai < 2; ++ai)
#pragma unroll
            for (int m = 0; m < 4; ++m) { const int sl = rslot[row0 + ai * HALF + m * 16];
                if (sl >= 0) { const float gt = gate[sl] * 16.0f; unsigned char* rowp = SLOT + (size_t)sl * D + col0;
#pragma unroll
                    for (int bj = 0; bj < 2; ++bj) { const f32x4 v0 = (acc[ai][bj][m][0] + bv[bj][0]) * gt, v1 = (acc[ai][bj][m][1] + bv[bj][1]) * gt;
                        u32x2 w; w.x = pk4_fp8(v0[0], v0[1], v0[2], v0[3]); w.y = pk4_fp8(v1[0], v1[1], v1[2], v1[3]);
                        *(u32x2*)(rowp + bj * HALF) = w; } } }
    }
};
}

struct Frame {
    LAS unsigned char* lds;
    int tid, lane, wave, vcu, G;
};

__device__ __forceinline__ void cvt_item_addr(const float* W, int K, int N, bf16_t* WT, int row_off, int item, int lane, const float*& src, bf16_t*& dst) {
    const int nblk = N >> 5, kb = item / nblk, nb = item - kb * nblk, kl = lane >> 3, nl = lane & 7;
    src = W + (size_t)(64 * kb + 8 * kl) * N + 32 * nb + 4 * nl; dst = WT + (size_t)(row_off + 32 * nb + 4 * nl) * K + 64 * kb + 8 * kl;
}
__device__ __forceinline__ void cvt_store(const f32x4 (&v)[8], bf16_t* dst, int K) {
#pragma unroll
    for (int i = 0; i < 4; ++i) { u32x4 o; o.x = cvt_pk_bf16(v[0][i], v[1][i]); o.y = cvt_pk_bf16(v[2][i], v[3][i]); o.z = cvt_pk_bf16(v[4][i], v[5][i]); o.w = cvt_pk_bf16(v[6][i], v[7][i]);
        *(u32x4*)(dst + (size_t)i * K) = o; }
}
__device__ __forceinline__ void cvt_store8(const f32x4 (&v)[8], unsigned char* dst, int K) {
#pragma unroll
    for (int i = 0; i < 4; ++i) { u32x2 o; o.x = pk4_fp8(v[0][i] * 64.f, v[1][i] * 64.f, v[2][i] * 64.f, v[3][i] * 64.f); o.y = pk4_fp8(v[4][i] * 64.f, v[5][i] * 64.f, v[6][i] * 64.f, v[7][i] * 64.f);
        *(u32x2*)(dst + (size_t)i * K) = o; }
}
__device__ __forceinline__ void cvt_range(const float* W, int K, int N, bf16_t* WT, int row_off, int i0, int cnt, int r, int nw, int lane) {
    int it = i0 + r; const int end = i0 + cnt;
    for (; it + nw < end; it += 2 * nw) {
        const float* s0; bf16_t* d0; const float* s1; bf16_t* d1;
        cvt_item_addr(W, K, N, WT, row_off, it, lane, s0, d0); cvt_item_addr(W, K, N, WT, row_off, it + nw, lane, s1, d1);
        f32x4 a[8], b[8];
#pragma unroll
        for (int j = 0; j < 8; ++j) a[j] = *(const f32x4*)(s0 + (size_t)j * N);
#pragma unroll
        for (int j = 0; j < 8; ++j) b[j] = *(const f32x4*)(s1 + (size_t)j * N);
        cvt_store(a, d0, K); cvt_store(b, d1, K);
    }
    if (it < end) { const float* s0; bf16_t* d0; cvt_item_addr(W, K, N, WT, row_off, it, lane, s0, d0); f32x4 a[8];
#pragma unroll
        for (int j = 0; j < 8; ++j) a[j] = *(const f32x4*)(s0 + (size_t)j * N);
        cvt_store(a, d0, K); }
}
constexpr int CV_UP = NE * (D / 64) * (2 * DFF / 32), CV_DN = NE * (DFF / 64) * (D / 32), CV_ALL = CV_UP + CV_DN;
struct MoeW { const float* w_up; const float* w_down; unsigned char* WUPT; unsigned char* WDNT; };
__device__ __forceinline__ void cvt_moe_addr(const MoeW& mw, int chunk, int w, int h, int lane, const float*& src, unsigned char*& dst, int& N) {
    const int kl = lane >> 3, nl = lane & 7;
    if (chunk < CV_UP / 64) { const int e = chunk >> 6, cc = chunk & 63, kb = 8 * (cc >> 4) + w, nb = 8 * (cc & 15) + h; N = 2 * DFF;
        src = mw.w_up + (size_t)e * D * 2 * DFF + (size_t)(64 * kb + 8 * kl) * (2 * DFF) + 32 * nb + 4 * nl; dst = mw.WUPT + (size_t)e * 2 * DFF * D + (size_t)(32 * nb + 4 * nl) * D + 64 * kb + 8 * kl; }
    else { const int q = chunk - CV_UP / 64, e = q >> 5, cc = q & 31, kb = 8 * (cc >> 3) + w, nb = 8 * (cc & 7) + h; N = D;
        src = mw.w_down + (size_t)e * DFF * D + (size_t)(64 * kb + 8 * kl) * D + 32 * nb + 4 * nl; dst = mw.WDNT + (size_t)e * D * DFF + (size_t)(32 * nb + 4 * nl) * DFF + 64 * kb + 8 * kl; }
}
__device__ __forceinline__ f32x4 ld_nt(const float* p) { return __builtin_nontemporal_load((const f32x4*)p); }
constexpr int CV_WG = 64;
__device__ __forceinline__ int cvt_claim(unsigned* cursor, int cap, unsigned* done, unsigned need) {
    if (done && __hip_atomic_load(done, __ATOMIC_RELAXED, __HIP_MEMORY_SCOPE_AGENT) >= need) return CV_ALL;
    if ((int)__hip_atomic_load(cursor, __ATOMIC_RELAXED, __HIP_MEMORY_SCOPE_AGENT) >= cap) return CV_ALL;
    return (int)__hip_atomic_fetch_add(cursor, (unsigned)CV_WG, __ATOMIC_RELAXED, __HIP_MEMORY_SCOPE_AGENT);
}
__device__ __forceinline__ void cvt_pull(const MoeW& mw, unsigned* cursor, int cap, unsigned* done, unsigned need, volatile LAS int* slot, int tid, int wave, int lane) {
    __syncthreads();
    if (tid == 0) *slot = cvt_claim(cursor, cap, done, need);
    __syncthreads();
    int base = __builtin_amdgcn_readfirstlane(*slot);
    while (base < CV_ALL) {
        int nb = CV_ALL; if (tid == 0) nb = cvt_claim(cursor, cap, done, need);
        const int chunk = base >> 6;
        if (chunk < CV_UP / 64) {
            const int e = chunk >> 6, cc = chunk & 63, nb = 8 * (cc & 15) + wave, kl = lane >> 3, nl = lane & 7;
#pragma unroll 1
            for (int q = 0; q < 2; ++q) { const int kq = 2 * (cc >> 4) + q, kb32 = 8 * kq + kl;
                const float* src = mw.w_up + (size_t)e * D * 2 * DFF + (size_t)(32 * kb32) * (2 * DFF) + 32 * nb + 4 * nl;
                f32x4 a[32];
#pragma unroll
                for (int j = 0; j < 32; ++j) a[j] = ld_nt(src + (size_t)j * (2 * DFF));
                unsigned char* dst = mw.WUPT + (size_t)e * 2 * DFF * D + (size_t)(32 * nb + 4 * nl) * D + 128 * (kb32 >> 2) + 16 * (kb32 & 3);
#pragma unroll
                for (int i = 0; i < 4; ++i) { f32x16 lo, hi;
#pragma unroll
                    for (int j = 0; j < 16; ++j) { lo[j] = a[j][i] * 64.f; hi[j] = a[16 + j][i] * 64.f; }
                    st_fp6_block(dst + (size_t)i * D, pk32_fp6(lo, hi)); } }
        } else
#pragma unroll
        for (int h = 0; h < 8; h += 4) {
            const float* s0; unsigned char* d0; const float* s1; unsigned char* d1; const float* s2; unsigned char* d2; const float* s3; unsigned char* d3; int N0, N1, N2, N3;
            cvt_moe_addr(mw, chunk, wave, h, lane, s0, d0, N0); cvt_moe_addr(mw, chunk, wave, h + 1, lane, s1, d1, N1); cvt_moe_addr(mw, chunk, wave, h + 2, lane, s2, d2, N2); cvt_moe_addr(mw, chunk, wave, h + 3, lane, s3, d3, N3);
            f32x4 a[8], b[8], c[8], d[8];
#pragma unroll
            for (int j = 0; j < 8; ++j) a[j] = ld_nt(s0 + (size_t)j * N0);
#pragma unroll
            for (int j = 0; j < 8; ++j) b[j] = ld_nt(s1 + (size_t)j * N1);
#pragma unroll
            for (int j = 0; j < 8; ++j) c[j] = ld_nt(s2 + (size_t)j * N2);
#pragma unroll
            for (int j = 0; j < 8; ++j) d[j] = ld_nt(s3 + (size_t)j * N3);
            cvt_store8(a, d0, D); cvt_store8(b, d1, D); cvt_store8(c, d2, D); cvt_store8(d, d3, D);
        }
        __syncthreads();
        if (tid == 0) *slot = nb;
        __syncthreads();
        base = __builtin_amdgcn_readfirstlane(*slot);
    }
}
__device__ __forceinline__ void rms_row_to_bf16(const float* xrow, const float* gvec, bf16_t* orow, int lane) {
    const f32x4* xr = (const f32x4*)xrow + lane; f32x4 v[8]; float s = 0.f;
#pragma unroll
    for (int j = 0; j < 8; ++j) { v[j] = xr[64 * j]; s += (v[j].x * v[j].x + v[j].y * v[j].y) + (v[j].z * v[j].z + v[j].w * v[j].w); }
    const float rstd = 1.0f / sqrtf(wave_sum(s) * (1.0f / D) + RMS_EPS);
    const f32x4* gr = (const f32x4*)gvec + lane; u32x2* o8 = (u32x2*)orow + lane;
#pragma unroll
    for (int j = 0; j < 8; ++j) { const f32x4 g = gr[64 * j]; const f32x4 y = v[j] * rstd * g; u32x2 w; w.x = cvt_pk_bf16(y.x, y.y); w.y = cvt_pk_bf16(y.z, y.w); o8[64 * j] = w; }
}

__device__ __forceinline__ unsigned voff_b(unsigned row, unsigned ch) { return 256u * row + 16u * (ch ^ (((row & 3u) << 2) | ((row >> 2) & 3u))); }
__device__ __forceinline__ s16x4 vtr(const LAS unsigned char* p) { return __builtin_bit_cast(s16x4, __builtin_amdgcn_ds_read_tr16_b64_v4i16((LAS s16x4*)p)); }

__device__ __forceinline__ void sb_wg_unit(const bf16_t* PG, bf16_t* OA, int h, int qb, LAS unsigned char* lds, volatile LAS int* flags, int tid, int wave, int lane) {
    const int fr = lane & 15, fq = lane >> 4, q0w = qb * 128 + wave * 16, qi = q0w + fr;
    bf16x8 Qf[4];
    { const bf16_t* qp = PG + (size_t)qi * NP1 + h * HD + 8 * fq;
#pragma unroll
      for (int ks = 0; ks < 4; ++ks) Qf[ks] = *(const bf16x8*)(qp + 32 * ks); }
    f32x4 O[8];
#pragma unroll
    for (int db = 0; db < 8; ++db) O[db] = (f32x4){0.f, 0.f, 0.f, 0.f};
    float carry = 0.f; bool sat = false;
    const float scale = 0.08838834764831845f;
    const unsigned p = fr & 3, qq = fr >> 2;
    const int jt_hi = 2 * qb + 1, jt_w = q0w >> 6;
    const int srow = tid >> 4, sch = tid & 15;
    const bf16_t* kg = PG + (size_t)srow * NP1 + SBW + h * HD + 8 * sch;
    u32x4 kr[2], vr[2];
    __syncthreads();
    if (tid < 8) flags[tid] = 0;
    { const bf16_t* g = kg + (size_t)(jt_hi * 64) * NP1;
#pragma unroll
      for (int i = 0; i < 2; ++i) { kr[i] = *(const u32x4*)(g + (size_t)(32 * i) * NP1); vr[i] = *(const u32x4*)(g + (size_t)(32 * i) * NP1 + SBW); } }
    for (int jt = jt_hi, it = 0; jt >= 0; --jt, ++it) {
        LAS unsigned char* kb = lds + (it & 1) * 32768; LAS unsigned char* vb = kb + 16384;
#pragma unroll
        for (int i = 0; i < 2; ++i) { *(LAS u32x4*)(kb + voff_b(srow + 32 * i, sch)) = kr[i]; *(LAS u32x4*)(vb + voff_b(srow + 32 * i, sch)) = vr[i]; }
        __syncthreads();
        { int ns = 0;
#pragma unroll
          for (int w = 0; w < 8; ++w) ns += flags[w];
          if (__builtin_amdgcn_readfirstlane(ns) == 8) break; }
        if (jt > 0) { const bf16_t* g = kg + (size_t)((jt - 1) * 64) * NP1;
#pragma unroll
            for (int i = 0; i < 2; ++i) { kr[i] = *(const u32x4*)(g + (size_t)(32 * i) * NP1); vr[i] = *(const u32x4*)(g + (size_t)(32 * i) * NP1 + SBW); } }
        if (!sat && jt <= jt_w) {
            const int key0 = jt * 64;
            f32x4 z[4];
#pragma unroll
            for (int sb = 0; sb < 4; ++sb) { z[sb] = (f32x4){0.f, 0.f, 0.f, 0.f};
#pragma unroll
                for (int ks = 0; ks < 4; ++ks) { const bf16x8 kf = *(const LAS bf16x8*)(kb + voff_b(16 * sb + fr, 4 * ks + fq)); z[sb] = __builtin_amdgcn_mfma_f32_16x16x32_bf16(kf, Qf[ks], z[sb], 0, 0, 0); } }
            float sfx[4][4], g[4], lex[4], T[4];
            const bool diag = key0 + 64 > q0w;
#pragma unroll
            for (int sb = 0; sb < 4; ++sb) {
                float sp[4];
#pragma unroll
                for (int i = 0; i < 4; ++i) { const float y = z[sb][i] * (scale * 1.4426950408889634f); z[sb][i] = y;
                    sp[i] = fmaxf(y, 0.f) + __builtin_amdgcn_logf(1.0f + __builtin_amdgcn_exp2f(-fabsf(y))); }
                if (diag) {
#pragma unroll
                    for (int i = 0; i < 4; ++i) { const int key = key0 + 16 * sb + 4 * fq + i; sp[i] = (key < qi) ? sp[i] : 0.f; } }
                sfx[sb][3] = sp[3]; sfx[sb][2] = sp[2] + sfx[sb][3]; sfx[sb][1] = sp[1] + sfx[sb][2]; sfx[sb][0] = sp[0] + sfx[sb][1]; g[sb] = sfx[sb][0];
            }
#pragma unroll
            for (int sb = 0; sb < 4; ++sb) { const float x1 = __shfl_xor(g[sb], 16), x2 = __shfl_xor(g[sb], 32), x3 = __shfl_xor(g[sb], 48);
                T[sb] = (g[sb] + x1) + (x2 + x3); lex[sb] = ((fq & 1) ? 0.f : x1) + ((fq < 2) ? (x2 + x3) : 0.f); }
            float run = carry; bf16x8 Wf[2]; unsigned wpk[8];
#pragma unroll
            for (int sb = 3; sb >= 0; --sb) { const float base = run + lex[sb]; float w[4];
#pragma unroll
                for (int i = 0; i < 4; ++i) w[i] = __builtin_amdgcn_exp2f(z[sb][i] - (base + sfx[sb][i]));
                if (diag) {
#pragma unroll
                    for (int i = 0; i < 4; ++i) { const int key = key0 + 16 * sb + 4 * fq + i; w[i] = (key < qi) ? w[i] : 0.f; } }
                wpk[2 * sb] = cvt_pk_bf16(w[0], w[1]); wpk[2 * sb + 1] = cvt_pk_bf16(w[2], w[3]); run += T[sb]; }
            carry = run;
            { u32x4 a = {wpk[0], wpk[1], wpk[2], wpk[3]}, b = {wpk[4], wpk[5], wpk[6], wpk[7]}; Wf[0] = __builtin_bit_cast(bf16x8, a); Wf[1] = __builtin_bit_cast(bf16x8, b); }
#pragma unroll
            for (int db = 0; db < 8; ++db)
#pragma unroll
                for (int m = 0; m < 2; ++m) { const unsigned r1 = 32 * m + 4 * fq + qq, r2 = r1 + 16;
                    const s16x4 lo = vtr(vb + voff_b(r1, 2 * db + (p >> 1)) + 8 * (p & 1)), hi = vtr(vb + voff_b(r2, 2 * db + (p >> 1)) + 8 * (p & 1));
                    const bf16x8 vf = {lo[0], lo[1], lo[2], lo[3], hi[0], hi[1], hi[2], hi[3]};
                    O[db] = __builtin_amdgcn_mfma_f32_16x16x32_bf16(vf, Wf[m], O[db], 0, 0, 0); }
            if (__all(carry > 150.1f)) { sat = true; if (lane == 0) flags[wave] = 1; }
        }
    }
    { bf16_t* op = OA + (size_t)qi * SBW + h * HD + 4 * fq;
#pragma unroll
      for (int db = 0; db < 8; ++db) { u32x2 w; w.x = cvt_pk_bf16(O[db][0], O[db][1]); w.y = cvt_pk_bf16(O[db][2], O[db][3]); *(u32x2*)(op + 16 * db) = w; } }
}

__device__ __forceinline__ void xa_unit(const bf16_t* QXA, const bf16_t* KVM, bf16_t* OXA, int h, int qb, const LAS unsigned char* vl, int lane) {
    const int fr = lane & 15, fq = lane >> 4, q0 = qb * 16, qi = q0 + fr;
    bf16x8 Qf[4];
    { const bf16_t* qp = QXA + (size_t)qi * XAW + h * HD + 8 * fq;
#pragma unroll
      for (int ks = 0; ks < 4; ++ks) Qf[ks] = *(const bf16x8*)(qp + 32 * ks); }
    f32x4 z[16];
    { const bf16_t* kp = KVM + (size_t)fr * (2 * XAW) + h * HD + 8 * fq;
#pragma unroll
      for (int sb = 0; sb < 16; ++sb) { z[sb] = (f32x4){0.f, 0.f, 0.f, 0.f};
#pragma unroll
          for (int ks = 0; ks < 4; ++ks) { const bf16x8 kf = *(const bf16x8*)(kp + (size_t)(16 * sb) * (2 * XAW) + 32 * ks); z[sb] = __builtin_amdgcn_mfma_f32_16x16x32_bf16(kf, Qf[ks], z[sb], 0, 0, 0); } } }
    const float scale = 0.08838834764831845f * 1.4426950408889634f;
    float mx = -3.0e38f;
#pragma unroll
    for (int sb = 0; sb < 16; ++sb)
#pragma unroll
        for (int i = 0; i < 4; ++i) { z[sb][i] *= scale; mx = fmaxf(mx, z[sb][i]); }
    mx = fmaxf(mx, __shfl_xor(mx, 16)); mx = fmaxf(mx, __shfl_xor(mx, 32));
    float sum = 0.f;
#pragma unroll
    for (int sb = 0; sb < 16; ++sb)
#pragma unroll
        for (int i = 0; i < 4; ++i) { const float e = __builtin_amdgcn_exp2f(z[sb][i] - mx); z[sb][i] = e; sum += e; }
    sum += __shfl_xor(sum, 16); sum += __shfl_xor(sum, 32);
    const float inv = 1.0f / sum;
    f32x4 O[8];
#pragma unroll
    for (int db = 0; db < 8; ++db) O[db] = (f32x4){0.f, 0.f, 0.f, 0.f};
    const unsigned p = fr & 3, qq = fr >> 2;
#pragma unroll
    for (int m = 0; m < 8; ++m) {
        u32x4 a = {cvt_pk_bf16(z[2 * m][0], z[2 * m][1]), cvt_pk_bf16(z[2 * m][2], z[2 * m][3]), cvt_pk_bf16(z[2 * m + 1][0], z[2 * m + 1][1]), cvt_pk_bf16(z[2 * m + 1][2], z[2 * m + 1][3])};
        const bf16x8 Wf = __builtin_bit_cast(bf16x8, a);
#pragma unroll
        for (int db = 0; db < 8; ++db) { const unsigned r1 = 32 * m + 4 * fq + qq, r2 = r1 + 16;
            const s16x4 lo = vtr(vl + voff_b(r1, 2 * db + (p >> 1)) + 8 * (p & 1)), hi = vtr(vl + voff_b(r2, 2 * db + (p >> 1)) + 8 * (p & 1));
            const bf16x8 vf = {lo[0], lo[1], lo[2], lo[3], hi[0], hi[1], hi[2], hi[3]};
            O[db] = __builtin_amdgcn_mfma_f32_16x16x32_bf16(vf, Wf, O[db], 0, 0, 0); }
    }
    { bf16_t* op = OXA + (size_t)qi * XAW + h * HD + 4 * fq;
#pragma unroll
      for (int db = 0; db < 8; ++db) { const f32x4 o = O[db] * inv; u32x2 w; w.x = cvt_pk_bf16(o[0], o[1]); w.y = cvt_pk_bf16(o[2], o[3]); *(u32x2*)(op + 16 * db) = w; } }
}

template <int W>
__device__ __forceinline__ void pool_run(const bf16_t* PG, bf16_t* PO, int t0, int ch) {
    constexpr int NR = W + 7;
    const bf16_t* pp = PG + (size_t)(t0 + 7) * NP1 + 3 * SBW + ch * 8;
    u32x4 v[NR];
#pragma unroll
    for (int k = 0; k < NR; ++k) v[k] = (t0 + 7 - k >= 0) ? *(const u32x4*)(pp - (size_t)k * NP1) : (u32x4){0u, 0u, 0u, 0u};
#pragma unroll
    for (int i = 0; i < 8; ++i) {
        float s[8];
#pragma unroll
        for (int j = 0; j < 8; ++j) s[j] = 0.f;
#pragma unroll
        for (int j = W - 1; j >= 0; --j) { const u32x4 x = v[7 - i + j];
            s[0] += bf_lo(x.x); s[1] += bf_hi(x.x); s[2] += bf_lo(x.y); s[3] += bf_hi(x.y); s[4] += bf_lo(x.z); s[5] += bf_hi(x.z); s[6] += bf_lo(x.w); s[7] += bf_hi(x.w); }
        const int t = t0 + i, n = (t + 1 < W) ? (t + 1) : W; const float inv = 1.0f / (float)n; const u32x4 me = v[7 - i]; u32x4 o;
        o.x = cvt_pk_bf16(s[0] * inv - bf_lo(me.x), s[1] * inv - bf_hi(me.x)); o.y = cvt_pk_bf16(s[2] * inv - bf_lo(me.y), s[3] * inv - bf_hi(me.y));
        o.z = cvt_pk_bf16(s[4] * inv - bf_lo(me.z), s[5] * inv - bf_hi(me.z)); o.w = cvt_pk_bf16(s[6] * inv - bf_lo(me.w), s[7] * inv - bf_hi(me.w));
        *(u32x4*)(PO + (size_t)t * POOLW + ch * 8) = o;
    }
}

constexpr int NPHASE = 15;
struct Args { const float* in[24]; float* out; unsigned char* ws; int ph_lo, ph_hi; };
static_assert(sizeof(Args) == 24 * 8 + 8 + 8 + 8, "Args has no padding");

__global__ void __launch_bounds__(NWAVES * 64, 2) moe_fwd(Args args) {
    extern __shared__ __attribute__((aligned(16))) unsigned char lds_raw[];
    Frame F;
    F.lds = (LAS unsigned char*)lds_raw;
    F.tid = threadIdx.x; F.lane = F.tid & 63; F.wave = __builtin_amdgcn_readfirstlane(F.tid >> 6);
    F.G = gridDim.x; { const int bx = blockIdx.x; F.vcu = (F.G % 8 == 0) ? (bx % 8) * (F.G / 8) + bx / 8 : bx; }
    unsigned char* ws = args.ws;
    unsigned* ctl = (unsigned*)(ws + WS_CTL);
    LAS unsigned char* lx = F.lds + LDS_X_OFF;
    for (int u = F.tid; u < (LDS_BYTES - LDS_X_OFF) / 4; u += NWAVES * 64) ((LAS unsigned*)lx)[u] = 0u;
    __syncthreads();
#if MK_ONE_LAUNCH
    XcdBarrier bar = xcd_barrier_post(ctl + CW_BAR, (volatile LAS unsigned*)(lx + LX_BAR));
#define GRID_BAR() xcd_barrier(bar)
#else
#define GRID_BAR() do {} while (0)
#endif
    const int lo = args.ph_lo, hi = args.ph_hi;
#ifndef PHASE_MASK
#define PHASE_MASK 0x7fff
#endif
#define IN(k) (((PHASE_MASK >> (k)) & 1) && lo <= (k) && (k) < hi)
#define SEAM(k) do { if (IN((k) + 1)) GRID_BAR(); } while (0)

    const float* x = args.in[0]; const float* mem = args.in[1]; const float* norm_mix = args.in[2]; const float* w_in = args.in[3]; const float* pool_lin = args.in[4];
    const float* pool_scale = args.in[5]; const float* w_branch_a = args.in[6]; const float* w_branch_b = args.in[7]; const float* w_gate = args.in[8]; const float* b_gate = args.in[9];
    const float* w_mix_out = args.in[10]; const float* xa_norm = args.in[11]; const float* mem_norm = args.in[12]; const float* xa_wq = args.in[13]; const float* xa_wkv = args.in[14];
    const float* xa_wo = args.in[15]; const float* moe_norm = args.in[16]; const float* w_router = args.in[17]; const float* b_router = args.in[18]; const float* w_up = args.in[19];
    const float* b_up = args.in[20]; const float* w_down = args.in[21]; const float* b_down = args.in[22]; const float* final_norm = args.in[23];
    bf16_t* W1T = (bf16_t*)(ws + WS_W1T); bf16_t* WAT = (bf16_t*)(ws + WS_WAT); bf16_t* WBT = (bf16_t*)(ws + WS_WBT); bf16_t* WMT = (bf16_t*)(ws + WS_WMT); bf16_t* PLT = (bf16_t*)(ws + WS_PLT);
    bf16_t* WQT = (bf16_t*)(ws + WS_WQT); bf16_t* WKVT = (bf16_t*)(ws + WS_WKVT); bf16_t* WOT = (bf16_t*)(ws + WS_WOT); unsigned char* WUPT = ws + WS_WUPT; unsigned char* WDNT = ws + WS_WDNT;
    bf16_t* U = (bf16_t*)(ws + WS_U); bf16_t* MEMN = (bf16_t*)(ws + WS_MEMN); bf16_t* PG = (bf16_t*)(ws + WS_PG); bf16_t* OA = (bf16_t*)(ws + WS_OA); bf16_t* PO = (bf16_t*)(ws + WS_PO);
    bf16_t* OB = (bf16_t*)(ws + WS_OB); float* TMP = (float*)(ws + WS_TMP); bf16_t* MG = (bf16_t*)(ws + WS_MG); float* H1 = (float*)(ws + WS_H1); bf16_t* U2 = (bf16_t*)(ws + WS_U2);
    bf16_t* QXA = (bf16_t*)(ws + WS_QXA); bf16_t* KVM = (bf16_t*)(ws + WS_KVM); bf16_t* OXA = (bf16_t*)(ws + WS_OXA); float* H2 = (float*)(ws + WS_H2); unsigned char* TB = ws + WS_TB;
    bf16_t* ROWS = (bf16_t*)(ws + WS_ROWS); unsigned char* ACT = ws + WS_ACT; unsigned char* SLOT = ws + WS_SLOT;
    int* ASGE = (int*)(ws + WS_ASGE); int* ASGP = (int*)(ws + WS_ASGP); float* GATE = (float*)(ws + WS_GATE); int* RSLOT = (int*)(ws + WS_RSLOT);
    int* CNT = (int*)(ctl + CW_CNT); bf16_t* WRT = (bf16_t*)(ws + WS_WRT);
    const int gw = F.vcu * NWAVES + F.wave, NGW = F.G * NWAVES;
    const MoeW mw{w_up, w_down, WUPT, WDNT};
    unsigned* CUR = ctl + CW_CUR; volatile LAS int* cvs = (volatile LAS int*)(lx + LX_CVS);
#define CVT_PULL(cap) cvt_pull(mw, CUR, (cap), nullptr, 0u, cvs, F.tid, F.wave, F.lane)
#define CVT_BESIDE(cap, ph, need) cvt_pull(mw, CUR, (cap), ctl + CW_DONE + 64 * (ph), (unsigned)(need), cvs, F.tid, F.wave, F.lane)
#define MARK_DONE(ph) do { if (F.tid == 0) __hip_atomic_fetch_add(ctl + CW_DONE + 64 * (ph), 1u, __ATOMIC_RELAXED, __HIP_MEMORY_SCOPE_AGENT); } while (0)

    if (IN(0)) {
        constexpr int I_IN = (D / 64) * (INW / 32), I_BR = (SBW / 64) * (D / 32), I_MX = (D / 64) * (D / 32), I_PL = (256 / 64) * (256 / 32);
        constexpr int I_Q = (D / 64) * (XAW / 32), I_KV = (D / 64) * (2 * XAW / 32), I_O = (XAW / 64) * (D / 32);
        cvt_range(w_in, D, INW, W1T, 0, 0, I_IN, gw, NGW, F.lane);
        cvt_range(w_gate, D, INW, W1T, INW, 0, I_IN, gw, NGW, F.lane);
        for (int m = gw; m < S; m += NGW) rms_row_to_bf16(x + (size_t)m * D, norm_mix, U + (size_t)m * D, F.lane);
        for (int m = gw; m < MEM; m += NGW) rms_row_to_bf16(mem + (size_t)m * D, mem_norm, MEMN + (size_t)m * D, F.lane);
        for (int i = blockIdx.x * (NWAVES * 64) + F.tid; i < NE * D / 2; i += F.G * NWAVES * 64) {
            const int e = i >> 10, c = (i & 1023) * 2; const float a = w_router[(size_t)c * NE + e], b = w_router[(size_t)(c + 1) * NE + e];
            const unsigned hi = cvt_pk_bf16(a, b); const unsigned lo = cvt_pk_bf16(a - bf_lo(hi), b - bf_hi(hi));
            *(unsigned*)(WRT + (size_t)e * D + c) = hi; *(unsigned*)(WRT + (size_t)(NE + e) * D + c) = lo; }
        __syncthreads();
        SEAM(0);
    }

    if (IN(1)) {
        const int gc = (F.G == 256) ? GC_P1 : F.G;
        if ((int)blockIdx.x < gc) {
            pg8::DenseSched Sc{(const char*)U, (const char*)W1T, D, D, S / 256, NP1 / 256, gc, (int)blockIdx.x};
            pg8::EpiProj E{PG, b_gate};
            pg8::gemm_phase<pg8::EpiProj, pg8::DenseSched, true>(F.lds, D, D, D, Sc, E);
            MARK_DONE(1);
        }
        if ((int)blockIdx.x >= gc) {
            constexpr int I_BR = (SBW / 64) * (D / 32), I_MX = (D / 64) * (D / 32), I_PL = (256 / 64) * (256 / 32), I_Q = (D / 64) * (XAW / 32), I_KV = (D / 64) * (2 * XAW / 32), I_O = (XAW / 64) * (D / 32);
            const int cr = ((int)blockIdx.x - gc) * NWAVES + F.wave, cn = (F.G - gc) * NWAVES;
        cvt_range(w_branch_a, SBW, D, WAT, 0, 0, I_BR, cr, cn, F.lane);
        cvt_range(w_branch_b, POOLW, D, WBT, 0, 0, I_BR, cr, cn, F.lane);
        cvt_range(w_mix_out, D, D, WMT, 0, 0, I_MX, cr, cn, F.lane);
        for (int g = 0; g < 4; ++g) cvt_range(pool_lin + (size_t)g * 65536, 256, 256, PLT + (size_t)g * 65536, 0, 0, I_PL, cr, cn, F.lane);
        cvt_range(xa_wq, D, XAW, WQT, 0, 0, I_Q, cr, cn, F.lane);
        cvt_range(xa_wkv, D, 2 * XAW, WKVT, 0, 0, I_KV, cr, cn, F.lane);
        cvt_range(xa_wo, XAW, D, WOT, 0, 0, I_O, cr, cn, F.lane);
        }
        CVT_BESIDE(CV_UP, 1, gc);
        SEAM(1);
    }

    if (IN(2)) {
        for (int it = blockIdx.x * (NWAVES * 64) + F.tid; it < (S / 8) * (POOLW / 8); it += F.G * NWAVES * 64) {
            const int wv = it >> 6, g = wv & 3, rb = (wv >> 2) * 2 + (F.lane >> 5), ch = g * 32 + (F.lane & 31), t0 = rb * 8;
            if (g == 0) pool_run<2>(PG, PO, t0, ch); else if (g == 1) pool_run<4>(PG, PO, t0, ch); else if (g == 2) pool_run<8>(PG, PO, t0, ch); else pool_run<16>(PG, PO, t0, ch);
        }
        for (int it = F.vcu; it < SBH * (S / 128); it += F.G) { const int h = it & 7, qb = (S / 128 - 1) - (it >> 3); sb_wg_unit(PG, OA, h, qb, F.lds, (volatile LAS int*)(lx + LX_SBF), F.tid, F.wave, F.lane); }
        __syncthreads();
        SEAM(2);
    }

    if (IN(3)) {
        pg8::PoolSched Sc{(const char*)PO, (const char*)PLT, F.G, F.vcu};
        pg8::EpiBf16 E{OB, POOLW, pool_scale};
        pg8::gemm_phase<pg8::EpiBf16, pg8::PoolSched, true>(F.lds, 256, POOLW, 256, Sc, E);
        if (F.vcu < (S / 256) * 4) MARK_DONE(3);
        CVT_BESIDE(CV_UP, 3, (S / 256) * 4);
        SEAM(3);
    }

    if (IN(4)) {
        pg8::BranchSched Sc{(const char*)OA, (const char*)OB, (const char*)WAT, (const char*)WBT, SBW, SBW, S / 256, D / 256, F.G, (int)blockIdx.x};
        pg8::EpiBranch E{PG, MG};
        pg8::gemm_phase<pg8::EpiBranch, pg8::BranchSched, true>(F.lds, SBW, SBW, SBW, Sc, E);
        SEAM(4);
    }

    if (IN(5)) {
        pg8::DenseSched Sc{(const char*)MG, (const char*)WMT, D, D, S / 256, D / 256, F.G, (int)blockIdx.x};
        pg8::EpiResid E{x, H1, D};
        pg8::gemm_phase<pg8::EpiResid, pg8::DenseSched, true>(F.lds, D, D, D, Sc, E);
        SEAM(5);
    }

    if (IN(6)) {
        for (int m = gw; m < S; m += NGW) rms_row_to_bf16(H1 + (size_t)m * D, xa_norm, U2 + (size_t)m * D, F.lane);
        SEAM(6);
    }

    if (IN(7)) {
        { pg8::DenseSched Sc{(const char*)U2, (const char*)WQT, D, D, S / 256, XAW / 256, F.G, (int)blockIdx.x};
          pg8::EpiBf16 E{QXA, XAW, nullptr};
          pg8::gemm_phase<pg8::EpiBf16, pg8::DenseSched, true>(F.lds, D, D, D, Sc, E); }
        { const int c2 = ((int)blockIdx.x >= 64) ? (int)blockIdx.x - 64 : (int)blockIdx.x + F.G - 64;
          pg8::DenseSched Sc{(const char*)MEMN, (const char*)WKVT, D, D, MEM / 256, 2 * XAW / 256, F.G, c2};
          pg8::EpiBf16 E{KVM, 2 * XAW, nullptr};
          pg8::gemm_phase<pg8::EpiBf16, pg8::DenseSched, true>(F.lds, D, D, D, Sc, E); }
        if ((int)blockIdx.x < 68) MARK_DONE(7);
        CVT_BESIDE(CV_UP, 7, 68);
        SEAM(7);
    }

    if (IN(8)) {
        for (int it = F.vcu; it < XAH * (S / 128); it += F.G) {
            const int h = it & 3, qg = it >> 2;
            __syncthreads();
#pragma unroll
            for (int t = 0; t < 8; ++t) { const int c = t * 512 + F.tid, row = c >> 4, ch = c & 15;
                const u32x4 vv = *(const u32x4*)(KVM + (size_t)row * (2 * XAW) + XAW + h * HD + 8 * ch); *(LAS u32x4*)(F.lds + voff_b(row, ch)) = vv; }
            __syncthreads();
            xa_unit(QXA, KVM, OXA, h, qg * 8 + F.wave, F.lds, F.lane);
        }
        __syncthreads();
        SEAM(8);
    }

    if (IN(9)) {
        pg8::DenseSched Sc{(const char*)OXA, (const char*)WOT, XAW, XAW, S / 256, D / 256, F.G, (int)blockIdx.x};
        pg8::EpiResid E{H1, H2, D};
        pg8::gemm_phase<pg8::EpiResid, pg8::DenseSched, true>(F.lds, XAW, XAW, XAW, Sc, E);
        SEAM(9);
    }

    if (IN(10)) {
        for (int i = blockIdx.x * (NWAVES * 64) + F.tid; i < PROWS; i += F.G * NWAVES * 64) RSLOT[i] = -1;
        LAS unsigned char* thi = F.lds;
        LAS float* lg = (LAS float*)(lx + LX_LOG);
        LAS float* part = (LAS float*)(lx + LX_RPART);
        for (int rg = F.vcu; rg < S / 16; rg += F.G) {
            __syncthreads();
#pragma unroll
            for (int rr = 0; rr < 2; ++rr) { const int r = 2 * F.wave + rr, m = rg * 16 + r;
                const f32x4* xr = (const f32x4*)(H2 + (size_t)m * D) + F.lane; f32x4 v[8]; float s = 0.f;
#pragma unroll
                for (int j = 0; j < 8; ++j) { v[j] = xr[64 * j]; s += (v[j].x * v[j].x + v[j].y * v[j].y) + (v[j].z * v[j].z + v[j].w * v[j].w); }
                const float rstd = 1.0f / sqrtf(wave_sum(s) * (1.0f / D) + RMS_EPS);
                const f32x4* gr = (const f32x4*)moe_norm + F.lane;
#pragma unroll
                for (int j = 0; j < 8; ++j) { const f32x4 g = gr[64 * j]; const f32x4 y = v[j] * rstd * g; u32x2 w; w.x = cvt_pk_bf16(y.x, y.y); w.y = cvt_pk_bf16(y.z, y.w);
                    u32x2 l; l.x = cvt_pk_bf16(y.x - bf_lo(w.x), y.y - bf_hi(w.x)); l.y = cvt_pk_bf16(y.z - bf_lo(w.y), y.w - bf_hi(w.y));
                    const unsigned off = (unsigned)r * 4096u + ((((unsigned)F.lane >> 1) + 32u * j) ^ (unsigned)r) * 16u + (F.lane & 1) * 8u;
                    *(LAS u32x2*)(thi + off) = w; *(LAS u32x2*)(thi + 65536 + off) = l; } }
            __syncthreads();
#pragma unroll
            for (int q = 0; q < 2; ++q) { const int blk = F.tid + 512 * q, r = blk >> 6, kb32 = blk & 63; f32x16 lo, hi;
#pragma unroll
                for (int c4 = 0; c4 < 4; ++c4) { const u32x4 v = *(const LAS u32x4*)(thi + r * 4096 + ((unsigned)((4 * kb32 + c4) ^ r) * 16u));
                    const float f[8] = {bf_lo(v.x), bf_hi(v.x), bf_lo(v.y), bf_hi(v.y), bf_lo(v.z), bf_hi(v.z), bf_lo(v.w), bf_hi(v.w)};
#pragma unroll
                    for (int j = 0; j < 8; ++j) { if (c4 < 2) lo[8 * c4 + j] = f[j] * 2.0f; else hi[8 * (c4 - 2) + j] = f[j] * 2.0f; } }
                st_fp6_block(TB + (size_t)(rg * 16 + r) * D + 128 * (kb32 >> 2) + 16 * (kb32 & 3), pk32_fp6(lo, hi)); }
            { const int fr = F.lane & 15, fq = F.lane >> 4; f32x4 c0 = {0.f, 0.f, 0.f, 0.f}, c1 = {0.f, 0.f, 0.f, 0.f};
              const bf16_t* wh = WRT + (size_t)fr * D + 256 * F.wave + 8 * fq;
#pragma unroll
              for (int st = 0; st < 8; ++st) { const unsigned ch = (unsigned)(32 * F.wave + 4 * st + fq);
                  const bf16x8 ah = *(const LAS bf16x8*)(thi + fr * 4096 + ((ch ^ (unsigned)fr) * 16u)), al = *(const LAS bf16x8*)(thi + 65536 + fr * 4096 + ((ch ^ (unsigned)fr) * 16u));
                  const bf16x8 bh0 = *(const bf16x8*)(wh + 32 * st), bh1 = *(const bf16x8*)(wh + (size_t)16 * D + 32 * st), bl0 = *(const bf16x8*)(wh + (size_t)NE * D + 32 * st), bl1 = *(const bf16x8*)(wh + (size_t)(NE + 16) * D + 32 * st);
                  c0 = __builtin_amdgcn_mfma_f32_16x16x32_bf16(ah, bh0, c0, 0, 0, 0); c1 = __builtin_amdgcn_mfma_f32_16x16x32_bf16(ah, bh1, c1, 0, 0, 0);
                  c0 = __builtin_amdgcn_mfma_f32_16x16x32_bf16(ah, bl0, c0, 0, 0, 0); c1 = __builtin_amdgcn_mfma_f32_16x16x32_bf16(ah, bl1, c1, 0, 0, 0);
                  c0 = __builtin_amdgcn_mfma_f32_16x16x32_bf16(al, bh0, c0, 0, 0, 0); c1 = __builtin_amdgcn_mfma_f32_16x16x32_bf16(al, bh1, c1, 0, 0, 0); }
#pragma unroll
              for (int i = 0; i < 4; ++i) { part[(F.wave * 16 + 4 * fq + i) * 32 + fr] = c0[i]; part[(F.wave * 16 + 4 * fq + i) * 32 + 16 + fr] = c1[i]; } }
            __syncthreads();
            { const int r = F.tid >> 5, e = F.tid & 31; float a = 0.f;
#pragma unroll
              for (int w = 0; w < 8; ++w) a += part[(w * 16 + r) * 32 + e];
              lg[r * 32 + e] = a + b_router[e]; }
            __syncthreads();
            if (F.tid < 16) { const int r = F.tid, m = rg * 16 + r; float l[32];
#pragma unroll
                for (int e = 0; e < 32; ++e) l[e] = lg[r * 32 + e];
                int idx[4]; float val[4]; unsigned taken = 0u;
#pragma unroll
                for (int k = 0; k < 4; ++k) { float best = -3.4e38f; int bi = 0;
#pragma unroll
                    for (int e = 0; e < 32; ++e) { const bool ok = !((taken >> e) & 1u) && (l[e] > best); best = ok ? l[e] : best; bi = ok ? e : bi; }
                    idx[k] = bi; val[k] = best; taken |= 1u << bi; }
                const float e0 = 1.0f, e1 = expf(val[1] - val[0]), e2 = expf(val[2] - val[0]), e3 = expf(val[3] - val[0]); const float inv = 1.0f / (((e0 + e1) + e2) + e3);
                const float gk[4] = {e0 * inv, e1 * inv, e2 * inv, e3 * inv};
#pragma unroll
                for (int k = 0; k < 4; ++k) { const int pos = atomicAdd(CNT + idx[k], 1); ASGE[m * 4 + k] = idx[k]; ASGP[m * 4 + k] = pos; GATE[m * 4 + k] = gk[k]; } }
        }
        __syncthreads();
        SEAM(10);
    }

    LAS int* tab = (LAS int*)(lx + LX_TAB);
#define BUILD_TAB(NT) do { __syncthreads(); if (F.tid == 0) { int us = 0, ps = 0; for (int e = 0; e < NE; ++e) { const int c = CNT[e], nb = (c + EBLK - 1) / EBLK; tab[e] = us; tab[33 + e] = ps; tab[66 + e] = nb > 0 ? nb : 1; us += nb * (NT); ps += nb * EBLK; } tab[32] = us; tab[65] = ps; } __syncthreads(); } while (0)

    if (IN(11)) {
        BUILD_TAB(1);
        for (int s = blockIdx.x * (NWAVES * 64) + F.tid; s < NK; s += F.G * NWAVES * 64) { const int e = ASGE[s], pos = ASGP[s]; RSLOT[tab[33 + e] + pos] = s; }
        CVT_PULL(CV_UP);
        SEAM(11);
    }

    if (IN(12)) {
        BUILD_TAB(16);
        const int gc = (F.G == 256) ? GC_P12 : F.G; const int bx = (int)blockIdx.x;
        if ((bx >> 3) < (gc >> 3) || F.G != 256) {
            pg8::MoeSched Sc{(const char*)TB, (const char*)WUPT, 16, (size_t)2 * DFF * D, (size_t)128 * D, (size_t)DFF * D, tab, gc, (F.G == 256) ? (bx & 7) * (gc >> 3) + (bx >> 3) : F.vcu, true, (size_t)D};
            pg8::EpiUp E{b_up, ACT};
            LAS int* gtab = (LAS int*)(lx + LX_RPART);
            { pg8::Unit uu; for (int i = 0; i < 16 && Sc.next(i, uu); ++i) if (F.tid < 256) { const int sl = RSLOT[uu.r0 + F.tid]; gtab[i * 256 + F.tid] = (sl < 0 ? 0 : sl) >> 2; } }
            __syncthreads();
            pg8::gemm_phase<pg8::EpiUp, pg8::MoeSched, true, true, 2>(F.lds, D / 2, D / 2, D / 2, Sc, E, gtab);
            MARK_DONE(12);
        }
        CVT_BESIDE(CV_ALL, 12, gc);
        CVT_PULL(CV_ALL);
        SEAM(12);
    }

    if (IN(13)) {
        BUILD_TAB(8);
        pg8::MoeSched Sc{(const char*)ACT, (const char*)WDNT, 8, (size_t)D * DFF, (size_t)256 * DFF, (size_t)128 * DFF, tab, F.G, F.vcu, false, (size_t)DFF};
        pg8::EpiDown E{b_down, RSLOT, GATE, SLOT};
        pg8::gemm_phase<pg8::EpiDown, pg8::MoeSched, true, false, 1>(F.lds, DFF / 2, DFF / 2, DFF / 2, Sc, E);
        SEAM(13);
    }

    if (IN(14)) {
        for (int m = gw; m < S; m += NGW) {
            const f32x4* xr = (const f32x4*)(H2 + (size_t)m * D) + F.lane; f32x4 v[8]; float s = 0.f;
#pragma unroll
            for (int j = 0; j < 8; ++j) { v[j] = xr[64 * j];
#pragma unroll
                for (int k = 0; k < 4; ++k) { const int w = (int)*((const unsigned*)(SLOT + (size_t)(m * 4 + k) * D) + F.lane + 64 * j); const f32x2 lo = __builtin_amdgcn_cvt_pk_f32_fp8(w, false), hi = __builtin_amdgcn_cvt_pk_f32_fp8(w, true);
                    v[j].x += lo.x * 0.0625f; v[j].y += lo.y * 0.0625f; v[j].z += hi.x * 0.0625f; v[j].w += hi.y * 0.0625f; }
                s += (v[j].x * v[j].x + v[j].y * v[j].y) + (v[j].z * v[j].z + v[j].w * v[j].w); }
            const float rstd = 1.0f / sqrtf(wave_sum(s) * (1.0f / D) + RMS_EPS);
            const f32x4* gr = (const f32x4*)final_norm + F.lane; f32x4* o = (f32x4*)(args.out + (size_t)m * D) + F.lane;
#pragma unroll
            for (int j = 0; j < 8; ++j) o[64 * j] = v[j] * rstd * gr[64 * j];
        }
    }
#undef IN
#undef SEAM
}

extern "C" void kernel_launch(void* const* d_in, const int* in_sizes, int n_in, void* d_out, int out_size, void* d_ws, size_t ws_size, hipStream_t stream) {
    static int grid = 0;
    if (grid == 0) {
        if (n_in != 24 || out_size != S * D || ws_size < WS_END) { fprintf(stderr, "kernel_launch: unexpected shapes (n_in %d out %d ws %zu need %zu)\n", n_in, out_size, ws_size, (size_t)WS_END); grid = -1; return; }
        int dev = 0, cus = 0, per_cu = 0;
        if (hipGetDevice(&dev) != hipSuccess || hipDeviceGetAttribute(&cus, hipDeviceAttributeMultiprocessorCount, dev) != hipSuccess) { grid = -1; return; }
        if (hipFuncSetAttribute((const void*)moe_fwd, hipFuncAttributeMaxDynamicSharedMemorySize, LDS_BYTES) != hipSuccess) { fprintf(stderr, "kernel_launch: hipFuncSetAttribute failed\n"); grid = -1; return; }
        if (hipOccupancyMaxActiveBlocksPerMultiprocessor(&per_cu, (const void*)moe_fwd, NWAVES * 64, LDS_BYTES) != hipSuccess || per_cu < 1) { fprintf(stderr, "kernel_launch: occupancy query says %d\n", per_cu); per_cu = 1; }
        (void)hipGetLastError();
        grid = cus;
    }
    if (grid < 0) return;
    (void)hipMemsetAsync((char*)d_ws + WS_CTL, 0, CTL_ZERO_BYTES, stream);
    Args a{};
    for (int i = 0; i < 24; ++i) a.in[i] = (const float*)d_in[i];
    a.out = (float*)d_out; a.ws = (unsigned char*)d_ws;
#if MK_ONE_LAUNCH
    a.ph_lo = 0; a.ph_hi = NPHASE;
    hipLaunchKernelGGL(moe_fwd, dim3(grid), dim3(NWAVES * 64), LDS_BYTES, stream, a);
#else
    for (int p = 0; p < NPHASE; ++p) { a.ph_lo = p; a.ph_hi = p + 1; for (int rep = 0; rep < (((REPEAT_MASK >> p) & 1) ? 2 : 1); ++rep) hipLaunchKernelGGL(moe_fwd, dim3(grid), dim3(NWAVES * 64), LDS_BYTES, stream, a); }
#endif
}
```

```cpp
#include <hip/hip_runtime.h>
#include <cstdio>
#include <cstdint>

#ifndef MK_ONE_LAUNCH
#define MK_ONE_LAUNCH 1
#endif
#ifndef REPEAT_MASK
#define REPEAT_MASK 0
#endif
#define GC_P1 160
#define GC_P12 216

#define LAS __attribute__((address_space(3)))
#define GAS __attribute__((address_space(1)))
typedef unsigned short bf16_t;
typedef short bf16x8 __attribute__((ext_vector_type(8)));
typedef short s16x4 __attribute__((ext_vector_type(4)));
typedef float f32x4 __attribute__((ext_vector_type(4)));
typedef float f32x2 __attribute__((ext_vector_type(2)));
typedef unsigned u32x4 __attribute__((ext_vector_type(4)));
typedef unsigned u32x2 __attribute__((ext_vector_type(2)));
typedef int v8i32 __attribute__((ext_vector_type(8)));
typedef int v6i32 __attribute__((ext_vector_type(6)));
typedef float f32x16 __attribute__((ext_vector_type(16)));

constexpr int S = 8192, D = 2048, MEM = 256;
constexpr int SBH = 8, HD = 128, SBW = 1024, POOLW = 1024, INW = 4096, NP1 = 8192;
constexpr int XAH = 4, XAW = 512;
constexpr int NE = 32, TOPK = 4, DFF = 2048, NK = S * TOPK, EBLK = 256, MAXBLK = NK / EBLK + NE, PROWS = MAXBLK * EBLK;
constexpr float RMS_EPS = 1e-5f;

constexpr size_t MiB = 1u << 20;
constexpr size_t WS_CTL = 0, CTL_ZERO_BYTES = 1 * MiB;
constexpr size_t WS_W1T = 2 * MiB;
constexpr size_t WS_WAT = WS_W1T + 32 * MiB;
constexpr size_t WS_WBT = WS_WAT + 4 * MiB;
constexpr size_t WS_WMT = WS_WBT + 4 * MiB;
constexpr size_t WS_PLT = WS_WMT + 8 * MiB;
constexpr size_t WS_WQT = WS_PLT + 1 * MiB;
constexpr size_t WS_WKVT = WS_WQT + 2 * MiB;
constexpr size_t WS_WOT = WS_WKVT + 4 * MiB;
constexpr size_t WS_WUPT = WS_WOT + 2 * MiB;
constexpr size_t WS_WDNT = WS_WUPT + 512 * MiB;
constexpr size_t WS_U = WS_WDNT + 256 * MiB;
constexpr size_t WS_MEMN = WS_U + 32 * MiB;
constexpr size_t WS_PG = WS_MEMN + 1 * MiB;
constexpr size_t WS_OA = WS_PG + 128 * MiB;
constexpr size_t WS_PO = WS_OA + 16 * MiB;
constexpr size_t WS_OB = WS_PO + 16 * MiB;
constexpr size_t WS_TMP = WS_OB + 16 * MiB;
constexpr size_t WS_MG = WS_TMP + 64 * MiB;
constexpr size_t WS_H1 = WS_MG + 32 * MiB;
constexpr size_t WS_U2 = WS_H1 + 64 * MiB;
constexpr size_t WS_QXA = WS_U2 + 32 * MiB;
constexpr size_t WS_KVM = WS_QXA + 8 * MiB;
constexpr size_t WS_OXA = WS_KVM + 1 * MiB;
constexpr size_t WS_H2 = WS_OXA + 8 * MiB;
constexpr size_t WS_TB = WS_H2 + 64 * MiB;
constexpr size_t WS_ROWS = WS_TB + 32 * MiB;
constexpr size_t WS_ACT = WS_ROWS + 160 * MiB;
constexpr size_t WS_SLOT = WS_ACT + 160 * MiB;
constexpr size_t WS_ASGE = WS_SLOT + 128 * MiB;
constexpr size_t WS_ASGP = WS_ASGE + 1 * MiB;
constexpr size_t WS_GATE = WS_ASGP + 1 * MiB;
constexpr size_t WS_RSLOT = WS_GATE + 1 * MiB;
constexpr size_t WS_WRT = WS_RSLOT + 1 * MiB;
constexpr size_t WS_END = WS_WRT + 1 * MiB;
constexpr int CW_CNT = 64;
constexpr int CW_CUR = 192;  constexpr int CW_DONE = 256;
constexpr int CW_BAR = 4096;

constexpr int RING_BYTES = 131072;
constexpr int LDS_X_OFF = RING_BYTES;
constexpr int LDS_BYTES = 163840;
constexpr int LX_BAR = 0;
constexpr int LX_TAB = 64;
constexpr int LX_CVS = 32;
constexpr int LX_SBF = 128;
constexpr int LX_LOG = 1024;
constexpr int LX_RPART = 4096;

constexpr int NWAVES = 8;

__device__ __forceinline__ unsigned cvt_pk_bf16(float lo, float hi) { unsigned r; asm volatile("v_cvt_pk_bf16_f32 %0, %1, %2" : "=v"(r) : "v"(lo), "v"(hi)); return r; }
__device__ __forceinline__ unsigned pk4_fp8(float a, float b, float c, float d) { int p = __builtin_amdgcn_cvt_pk_fp8_f32(a, b, 0, false); p = __builtin_amdgcn_cvt_pk_fp8_f32(c, d, p, true); return (unsigned)p; }
__device__ __forceinline__ v6i32 pk32_fp6(const f32x16& lo, const f32x16& hi) { return __builtin_amdgcn_cvt_scalef32_2xpk16_fp6_f32(lo, hi, 1.0f); }
__device__ __forceinline__ void st_fp6_block(unsigned char* p, const v6i32& b) { *(u32x4*)p = (u32x4){(unsigned)b[0], (unsigned)b[1], (unsigned)b[2], (unsigned)b[3]}; *(u32x4*)(p + 64) = (u32x4){(unsigned)b[4], (unsigned)b[5], 0u, 0u}; }
__device__ __forceinline__ float bf_lo(unsigned w) { return __uint_as_float(w << 16); }
__device__ __forceinline__ float bf_hi(unsigned w) { return __uint_as_float(w & 0xffff0000u); }
__device__ __forceinline__ float wave_sum(float v) {
#pragma unroll
    for (int o = 1; o < 64; o <<= 1) v += __shfl_xor(v, o);
    return v;
}
__device__ __forceinline__ float sigmoidf_fast(float x) { return __builtin_amdgcn_rcpf(1.0f + __builtin_amdgcn_exp2f(x * -1.4426950408889634f)); }

#define XB_TMO      128
#define XB_XCNT(j)  (256  + 64 * (j))
#define XB_XSUB(j)  (1280 + 64 * (j))
#define XB_XGEN(j)  (2304 + 64 * (j))
#define XB_TOP      3328
#define XB_TOPGEN   3392
#define XCD_BAR_WORDS 3456
#define XB_SPIN_CAP (1u << 18)
__device__ __forceinline__ unsigned xb_ld(unsigned* p)              { return __hip_atomic_load(p, __ATOMIC_RELAXED, __HIP_MEMORY_SCOPE_AGENT); }
__device__ __forceinline__ unsigned xb_add(unsigned* p, unsigned v) { return __hip_atomic_fetch_add(p, v, __ATOMIC_RELAXED, __HIP_MEMORY_SCOPE_AGENT); }
__device__ __forceinline__ unsigned xb_xcc_id() { return (unsigned)__builtin_amdgcn_s_getreg((3 << 11) | 20) & 0xFu; }
#define XB_SPIN(cond, bar) do { unsigned _sp = 0; while (cond) { __builtin_amdgcn_s_sleep(1); \
    if ((++_sp & 255u) == 0u) { if (xb_ld(&(bar)[XB_TMO])) break; if (_sp > XB_SPIN_CAP) { atomicAdd(&(bar)[XB_TMO], 1u); break; } } } } while (0)
struct XcdBarrier { unsigned* bar; unsigned x; volatile LAS unsigned* st; };
__device__ __forceinline__ XcdBarrier xcd_barrier_post(unsigned* bar, volatile LAS unsigned* st) {
    XcdBarrier b; b.bar = bar; b.x = xb_xcc_id(); b.st = st;
    if (threadIdx.x == 0) (void)xb_add(&bar[XB_XCNT(b.x)], 1u);
    return b;
}
__device__ __forceinline__ void xcd_barrier_complete(unsigned* bar, unsigned x, unsigned& nloc, unsigned& nx) {
    const unsigned G = gridDim.x * gridDim.y * gridDim.z;
    unsigned sum, cnt, mine, sp = 0u;
    for (;;) {
        sum = 0u; cnt = 0u; mine = 0u;
#pragma unroll
        for (unsigned j = 0; j < 16; ++j) { const unsigned c = xb_ld(&bar[XB_XCNT(j)]); sum += c; cnt += (c > 0u) ? 1u : 0u; mine = (j == x) ? c : mine; }
        if (sum == G) break;
        __builtin_amdgcn_s_sleep(1);
        if ((++sp & 255u) == 0u) { if (xb_ld(&bar[XB_TMO])) break; if (sp > XB_SPIN_CAP) { atomicAdd(&bar[XB_TMO], 1u); break; } }
    }
    nloc = mine > 0u ? mine : 1u; nx = cnt > 0u ? cnt : 1u;
}
__device__ __forceinline__ void xcd_barrier(const XcdBarrier& b) {
    asm volatile("s_waitcnt vmcnt(0)" ::: "memory");
    __syncthreads();
    if (threadIdx.x == 0) {
        unsigned* bar = b.bar;
        __builtin_amdgcn_s_waitcnt(0);
        unsigned nloc = b.st[0], nx = b.st[1];
        if (nloc == 0u) { xcd_barrier_complete(bar, b.x, nloc, nx); b.st[0] = nloc; b.st[1] = nx; }
        const unsigned old = xb_add(&bar[XB_XSUB(b.x)], 1u);
        const unsigned gen = old / nloc;
        if (old + 1u == (gen + 1u) * nloc) {
            __builtin_amdgcn_fence(__ATOMIC_RELEASE, "agent");
            asm volatile("s_waitcnt vmcnt(0)" ::: "memory");
            const unsigned og = xb_add(&bar[XB_TOP], 1u);
            const unsigned tg = og / nx;
            if (og + 1u == (tg + 1u) * nx) xb_add(&bar[XB_TOPGEN], 1u);
            else XB_SPIN(xb_ld(&bar[XB_TOPGEN]) == tg, bar);
            __builtin_amdgcn_fence(__ATOMIC_ACQUIRE, "agent");
            xb_add(&bar[XB_XGEN(b.x)], 1u);
            asm volatile("s_waitcnt vmcnt(0)" ::: "memory");
        } else {
            XB_SPIN(xb_ld(&bar[XB_XGEN(b.x)]) == gen, bar);
            __builtin_amdgcn_fence(__ATOMIC_ACQUIRE, "agent");
            asm volatile("s_waitcnt vmcnt(0)" ::: "memory");
        }
    }
    __syncthreads();
}

namespace pg8 {
constexpr int BM = 256, BK = 64, HALF = 128, HTB = HALF * BK * 2, STAGE_BYTES = 8 * HTB, NXCD = 8, WGM = 8;
__host__ __device__ __forceinline__ int lds_byte(int r, int c) { const int st = (r >> 4) * 2 + (c >> 5), rr = r & 15, cc = c & 31, ob = rr * 64 + cc * 2; return st * 1024 + (ob ^ (((ob >> 9) & 1) << 5)); }
__host__ __device__ __forceinline__ void stage_rc(int b, int& R, int& C) { const int st = b / 1024, sb = b % 1024, swz = sb ^ (((sb >> 9) & 1) << 5); R = (st >> 1) * 16 + swz / 64; C = (st & 1) * 32 + (swz % 64) / 2; }
__host__ __device__ __forceinline__ int perm32(int rho) { const int n = rho >> 4, i = rho & 15; return 8 * (i >> 2) + 4 * n + (i & 3); }

struct Unit { const char* A; const char* B0; const char* B1; int r0, c0, x; };

__device__ __forceinline__ void tile_of(int L, int nM, int nN, int& pm, int& pn) {
    const int nwg = nM * nN; int wgid = L;
    { const int q = nwg / NXCD, r = nwg % NXCD, xcd = wgid % NXCD, off = wgid / NXCD; wgid = (xcd < r ? xcd * (q + 1) : r * (q + 1) + (xcd - r) * q) + off; }
    const int nig = WGM * nN, gid = wgid / nig, fm = gid * WGM, gsz = (nM - fm) < WGM ? (nM - fm) : WGM;
    pm = fm + ((wgid % nig) % gsz); pn = (wgid % nig) / gsz;
}
struct DenseSched {
    const char* A; const char* B; int lda, ldb, nM, nN, G, c;
    __device__ __forceinline__ bool next(int i, Unit& u) const {
        const long L = (long)i * G + c; if (L >= (long)nM * nN) return false;
        int pm, pn; tile_of((int)L, nM, nN, pm, pn);
        u.A = A + (size_t)pm * BM * lda * 2; u.B0 = B + (size_t)pn * BM * ldb * 2; u.B1 = u.B0 + (size_t)HALF * ldb * 2; u.r0 = pm * BM; u.c0 = pn * BM; u.x = 0; return true;
    }
};
struct BranchSched {
    const char* A0; const char* A1; const char* B0; const char* B1; int lda, ldb, nM, nN, G, c;
    __device__ __forceinline__ bool next(int i, Unit& u) const {
        const long L = (long)(i >> 1) * G + c; if (L >= (long)nM * nN) return false;
        int pm, pn; tile_of((int)L, nM, nN, pm, pn); const int br = i & 1;
        u.A = (br ? A1 : A0) + (size_t)pm * BM * lda * 2; u.B0 = (br ? B1 : B0) + (size_t)pn * BM * ldb * 2; u.B1 = u.B0 + (size_t)HALF * ldb * 2; u.r0 = pm * BM; u.c0 = pn * BM; u.x = br; return true;
    }
};
struct PoolSched {
    const char* A; const char* B; int G, c;
    __device__ __forceinline__ bool next(int i, Unit& u) const {
        const int L = i * G + c; if (L >= (S / BM) * 4) return false;
        const int pm = L >> 2, g = L & 3;
        u.A = A + ((size_t)pm * BM * POOLW + g * 256) * 2; u.B0 = B + (size_t)g * 256 * 256 * 2; u.B1 = u.B0 + (size_t)HALF * 256 * 2; u.r0 = pm * BM; u.c0 = g * 256; u.x = g; return true;
    }
};
struct MoeSched {
    const char* A; const char* B; int NT; size_t estride; size_t tstride; size_t hoff; const LAS int* tab; int G, c; bool gather; size_t arow;
    __device__ __forceinline__ int tu(int i) const { return __builtin_amdgcn_readfirstlane(tab[i]); }
    __device__ __forceinline__ bool next(int i, Unit& u) const {
        const int L = i * G + c; if (L >= tu(32)) return false;
        int e = 0;
#pragma unroll
        for (int s = 16; s >= 1; s >>= 1) { if (tu(e + s) <= L) e += s; }
        const int r = L - tu(e), nb = tu(66 + e), nt = r / nb, blk = r - nt * nb, prow = tu(33 + e) + blk * EBLK;
        u.A = gather ? A : A + (size_t)prow * arow; u.B0 = B + (size_t)e * estride + (size_t)nt * tstride; u.B1 = u.B0 + hoff; u.r0 = prow; u.c0 = nt; u.x = e; return true;
    }
};

template <class Epi, class Sched, bool ALIGN_EPI, bool GATHER = false, int PREC = 0>
__device__ __forceinline__ void gemm_phase(LAS unsigned char* lds, const int K, const int lda, const int ldb, const Sched& S, const Epi& E, const LAS int* gtab = nullptr) {
    const int tid = threadIdx.x, wid = __builtin_amdgcn_readfirstlane(tid >> 6), lane = tid & 63, wr = wid >> 2, wc = wid & 3, fr = lane & 15, fq = lane >> 4;
    const int nt = K / BK;
    unsigned voffB[2], vc[2][2], vn[2][2]; int RA[2], CA[2];
#pragma unroll
    for (int i = 0; i < 2; ++i) { int R, C; stage_rc(tid * 16 + i * 8192, R, C); const int Rb = Epi::PERM ? ((R & ~31) + perm32(R & 31)) : R; RA[i] = R; CA[i] = C;
        voffB[i] = (unsigned)(Rb * ldb + C) * 2u; }
#define PG8_AOFF(dst, ord) do { _Pragma("unroll") for (int _h = 0; _h < 2; ++_h) _Pragma("unroll") for (int _i = 0; _i < 2; ++_i) \
        dst[_h][_i] = GATHER ? ((unsigned)gtab[(ord) * 256 + _h * HALF + RA[_i]] * (unsigned)lda + (unsigned)CA[_i]) * 2u : (unsigned)((_h * HALF + RA[_i]) * lda + CA[_i]) * 2u; } while (0)
    const size_t kstep = (size_t)(BK * 2);
    const unsigned ldsw = (unsigned)wid * 1024u;
    const int aoff = lds_byte(wr * 64 + fr, fq * 8), boff = lds_byte(wc * 32 + fr, fq * 8);
#define PG8_SA(b, h) (((b) * 2 + (h)) * HTB)
#define PG8_SB(b, h) ((4 + (b) * 2 + (h)) * HTB)
#define PG8_STAGE(bufoff, gbase, voff) do { _Pragma("unroll") for (int _i = 0; _i < 2; ++_i) \
        __builtin_amdgcn_global_load_lds((const unsigned*)((const char*)(gbase) + (voff)[_i]), (LAS unsigned*)(lds + (bufoff) + ldsw + _i * 8192), 16, 0, 0); } while (0)
#define PG8_LD6(off) __builtin_bit_cast(v6i32, __builtin_shufflevector(*(const LAS u32x4*)(lds + (off)), __builtin_shufflevector(*(const LAS u32x2*)(lds + (off) + 1024), *(const LAS u32x2*)(lds + (off) + 1024), 0, 1, -1, -1), 0, 1, 2, 3, 4, 5))
#define PG8_LD8(off) __builtin_bit_cast(v8i32, __builtin_shufflevector(*(const LAS u32x4*)(lds + (off)), *(const LAS u32x4*)(lds + (off) + 1024), 0, 1, 2, 3, 4, 5, 6, 7))
#define PG8_LDA(dst, b, h) do { if (PREC == 2) { _Pragma("unroll") for (int m = 0; m < 4; ++m) dst##6[m] = PG8_LD6(PG8_SA(b, h) + aoff + m * 2048); } \
      else if (PREC == 1) { _Pragma("unroll") for (int m = 0; m < 4; ++m) dst##8[m] = PG8_LD8(PG8_SA(b, h) + aoff + m * 2048); } \
      else { _Pragma("unroll") for (int m = 0; m < 4; ++m) _Pragma("unroll") for (int k = 0; k < 2; ++k) dst[m][k] = *(const LAS bf16x8*)(lds + PG8_SA(b, h) + aoff + m * 2048 + k * 1024); } } while (0)
#define PG8_LDB(dst, b, h) do { if (PREC == 2) { _Pragma("unroll") for (int n = 0; n < 2; ++n) dst##6[n] = PG8_LD6(PG8_SB(b, h) + boff + n * 2048); } \
      else if (PREC == 1) { _Pragma("unroll") for (int n = 0; n < 2; ++n) dst##8[n] = PG8_LD8(PG8_SB(b, h) + boff + n * 2048); } \
      else { _Pragma("unroll") for (int n = 0; n < 2; ++n) _Pragma("unroll") for (int k = 0; k < 2; ++k) dst[n][k] = *(const LAS bf16x8*)(lds + PG8_SB(b, h) + boff + n * 2048 + k * 1024); } } while (0)
#define PG8_MMA(ai, bj, At, Bt) do { __builtin_amdgcn_s_setprio(1); if (PREC == 2) { _Pragma("unroll") for (int m = 0; m < 4; ++m) _Pragma("unroll") for (int n = 0; n < 2; ++n) \
        asm volatile("v_mfma_scale_f32_16x16x128_f8f6f4 %0, %1, %2, %0, %3, %4 op_sel_hi:[0,0,0] cbsz:2 blgp:2" : "+v"(acc[ai][bj][m][n]) : "v"(Bt##6[n]), "v"(At##6[m]), "v"(sc_w), "v"(sc_a)); } \
      else if (PREC == 1) { _Pragma("unroll") for (int m = 0; m < 4; ++m) _Pragma("unroll") for (int n = 0; n < 2; ++n) \
        asm volatile("v_mfma_scale_f32_16x16x128_f8f6f4 %0, %1, %2, %0, %3, %4 op_sel_hi:[0,0,0]" : "+v"(acc[ai][bj][m][n]) : "v"(Bt##8[n]), "v"(At##8[m]), "v"(sc_w), "v"(sc_a)); } \
      else { _Pragma("unroll") for (int m = 0; m < 4; ++m) _Pragma("unroll") for (int n = 0; n < 2; ++n) _Pragma("unroll") for (int k = 0; k < 2; ++k) \
        acc[ai][bj][m][n] = __builtin_amdgcn_mfma_f32_16x16x32_bf16(Bt[n][k], At[m][k], acc[ai][bj][m][n], 0, 0, 0); } __builtin_amdgcn_s_setprio(0); } while (0)
#define PG8_WAIT_V(n) asm volatile("s_waitcnt vmcnt(" #n ")" ::: "memory")
#define PG8_WAIT_L(n) asm volatile("s_waitcnt lgkmcnt(" #n ")" ::: "memory")
#define PG8_BAR __builtin_amdgcn_s_barrier()
#define PG8_SCHED __builtin_amdgcn_sched_barrier(0)
    Unit cur, nxt; int ui = 0;
    if (!S.next(0, cur)) return;
    f32x4 acc[2][2][4][2];
#pragma unroll
    for (int a = 0; a < 2; ++a)
#pragma unroll
        for (int b = 0; b < 2; ++b)
#pragma unroll
            for (int m = 0; m < 4; ++m)
#pragma unroll
                for (int n = 0; n < 2; ++n) acc[a][b][m][n] = (f32x4){0.f, 0.f, 0.f, 0.f};
    bf16x8 At[4][2], B0[2][2], B1[2][2]; v8i32 At8[4], B08[2], B18[2]; v6i32 At6[4], B06[2], B16[2];
    const int sc_w = 121, sc_a = (PREC == 2) ? 126 : 127;
    PG8_AOFF(vc, 0);
#pragma unroll
    for (int _h = 0; _h < 2; ++_h) { vn[_h][0] = vc[_h][0]; vn[_h][1] = vc[_h][1]; }
    PG8_STAGE(PG8_SB(0, 0), cur.B0, voffB); PG8_STAGE(PG8_SB(0, 1), cur.B1, voffB); PG8_STAGE(PG8_SA(0, 0), cur.A, vc[0]); PG8_STAGE(PG8_SA(0, 1), cur.A, vc[1]);
    if (wr == 1) PG8_BAR;
    PG8_WAIT_V(2); PG8_BAR;
    PG8_STAGE(PG8_SB(1, 0), cur.B0 + kstep, voffB); PG8_STAGE(PG8_SA(1, 0), cur.A + kstep, vc[0]); PG8_STAGE(PG8_SB(1, 1), cur.B1 + kstep, voffB);
    PG8_WAIT_V(6); PG8_BAR;
    for (;;) {
        const bool has_next = S.next(ui + 1, nxt);
        if (GATHER && has_next) PG8_AOFF(vn, ui + 1);
        const char* nA = has_next ? nxt.A : cur.A; const char* nB0 = has_next ? nxt.B0 : cur.B0; const char* nB1 = has_next ? nxt.B1 : cur.B1;
#pragma nounroll
        for (int t = 0; t < nt; t += 2) {
            const bool last = (t == nt - 2);
            const char* a1 = cur.A + (size_t)(t + 1) * kstep;
            const char* a2 = last ? nA : cur.A + (size_t)(t + 2) * kstep;
            const char* b20 = last ? nB0 : cur.B0 + (size_t)(t + 2) * kstep; const char* b21 = last ? nB1 : cur.B1 + (size_t)(t + 2) * kstep;
            const char* a3 = a2 + kstep; const char* b30 = b20 + kstep; const char* b31 = b21 + kstep;
            unsigned v2[2][2];
#pragma unroll
            for (int _h = 0; _h < 2; ++_h) { v2[_h][0] = (GATHER && last) ? vn[_h][0] : vc[_h][0]; v2[_h][1] = (GATHER && last) ? vn[_h][1] : vc[_h][1]; }
            PG8_LDB(B0, 0, 0); PG8_LDB(B1, 0, 1); PG8_SCHED; PG8_LDA(At, 0, 0); PG8_STAGE(PG8_SA(1, 1), a1, vc[1]);
            PG8_WAIT_V(8); PG8_WAIT_L(0); PG8_BAR; PG8_MMA(0, 0, At, B0); PG8_MMA(0, 1, At, B1); PG8_BAR; PG8_SCHED;
            PG8_LDA(At, 0, 1); PG8_STAGE(PG8_SB(0, 0), b20, voffB); PG8_STAGE(PG8_SB(0, 1), b21, voffB); PG8_STAGE(PG8_SA(0, 0), a2, v2[0]);
            PG8_WAIT_V(8); PG8_WAIT_L(0); PG8_BAR; PG8_MMA(1, 0, At, B0); PG8_MMA(1, 1, At, B1); PG8_BAR; PG8_SCHED;
            PG8_LDB(B0, 1, 0); PG8_LDB(B1, 1, 1); PG8_SCHED; PG8_LDA(At, 1, 0); PG8_STAGE(PG8_SA(0, 1), a2, v2[1]);
            PG8_WAIT_V(8); PG8_WAIT_L(0); PG8_BAR; PG8_MMA(0, 0, At, B0); PG8_MMA(0, 1, At, B1); PG8_BAR; PG8_SCHED;
            PG8_LDA(At, 1, 1); PG8_STAGE(PG8_SB(1, 0), b30, voffB); PG8_STAGE(PG8_SB(1, 1), b31, voffB); PG8_STAGE(PG8_SA(1, 0), a3, v2[0]);
            PG8_WAIT_V(8); PG8_WAIT_L(0); PG8_BAR; PG8_MMA(1, 0, At, B0); PG8_MMA(1, 1, At, B1); PG8_BAR; PG8_SCHED;
        }
        if constexpr (ALIGN_EPI) { if (wr == 0) PG8_BAR; }
        if (PREC != 0) asm volatile("s_nop 15\n\ts_nop 15\n\ts_nop 15\n\ts_nop 15" ::: "memory");
        E(acc, cur, wr, wc, fr, fq);
        if (!has_next) break;
        bool kp = false; if constexpr (Epi::KEEPS) kp = E.keep(cur);
        if (!kp) {
#pragma unroll
        for (int a = 0; a < 2; ++a)
#pragma unroll
            for (int b = 0; b < 2; ++b)
#pragma unroll
                for (int m = 0; m < 4; ++m)
#pragma unroll
                    for (int n = 0; n < 2; ++n) acc[a][b][m][n] = (f32x4){0.f, 0.f, 0.f, 0.f}; }
        cur = nxt; ++ui;
        if (GATHER) {
#pragma unroll
            for (int _h = 0; _h < 2; ++_h) { vc[_h][0] = vn[_h][0]; vc[_h][1] = vn[_h][1]; } }
        if constexpr (ALIGN_EPI) { if (wr == 1) PG8_BAR; }
    }
    PG8_WAIT_V(0);
    if constexpr (!ALIGN_EPI) { if (wr == 0) PG8_BAR; }
    PG8_BAR;
#undef PG8_AOFF
#undef PG8_SA
#undef PG8_SB
#undef PG8_STAGE
#undef PG8_LDA
#undef PG8_LDB
#undef PG8_MMA
#undef PG8_LD8
#undef PG8_LD6
#undef PG8_WAIT_V
#undef PG8_WAIT_L
#undef PG8_BAR
#undef PG8_SCHED
}

typedef f32x4 Acc[2][2][4][2];

struct EpiProj {
    static constexpr bool PERM = true, KEEPS = false;
    bf16_t* O; const float* bgate;
    __device__ __forceinline__ void operator()(Acc& acc, const Unit& u, int wr, int wc, int fr, int fq) const {
        const int row0 = u.r0 + wr * 64 + fr, col0 = u.c0 + wc * 32 + 8 * fq; const bool gate = u.c0 >= INW;
        f32x4 bv[2][2];
#pragma unroll
        for (int bj = 0; bj < 2; ++bj)
#pragma unroll
            for (int n = 0; n < 2; ++n) bv[bj][n] = gate ? *(const f32x4*)(bgate + (col0 - INW) + bj * HALF + 4 * n) : (f32x4){0.f, 0.f, 0.f, 0.f};
#pragma unroll
        for (int ai = 0; ai < 2; ++ai)
#pragma unroll
            for (int m = 0; m < 4; ++m) { bf16_t* rowp = O + (size_t)(row0 + ai * HALF + m * 16) * NP1 + col0;
#pragma unroll
                for (int bj = 0; bj < 2; ++bj) { f32x4 v0 = acc[ai][bj][m][0] + bv[bj][0], v1 = acc[ai][bj][m][1] + bv[bj][1];
                    if (gate) {
#pragma unroll
                        for (int j = 0; j < 4; ++j) { v0[j] = sigmoidf_fast(v0[j]); v1[j] = sigmoidf_fast(v1[j]); } }
                    u32x4 w; w.x = cvt_pk_bf16(v0[0], v0[1]); w.y = cvt_pk_bf16(v0[2], v0[3]); w.z = cvt_pk_bf16(v1[0], v1[1]); w.w = cvt_pk_bf16(v1[2], v1[3]);
                    *(u32x4*)(rowp + bj * HALF) = w; } }
    }
};
struct EpiBf16 {
    static constexpr bool PERM = true, KEEPS = false;
    bf16_t* O; int ldc; const float* cscale;
    __device__ __forceinline__ void operator()(Acc& acc, const Unit& u, int wr, int wc, int fr, int fq) const {
        const int row0 = u.r0 + wr * 64 + fr, col0 = u.c0 + wc * 32 + 8 * fq;
#pragma unroll
        for (int bj = 0; bj < 2; ++bj) {
            const f32x4 s0 = cscale ? *(const f32x4*)(cscale + col0 + bj * HALF) : (f32x4){1.f, 1.f, 1.f, 1.f}, s1 = cscale ? *(const f32x4*)(cscale + col0 + bj * HALF + 4) : (f32x4){1.f, 1.f, 1.f, 1.f};
#pragma unroll
            for (int ai = 0; ai < 2; ++ai)
#pragma unroll
                for (int m = 0; m < 4; ++m) { bf16_t* rowp = O + (size_t)(row0 + ai * HALF + m * 16) * ldc + col0;
                    const f32x4 v0 = acc[ai][bj][m][0] * s0, v1 = acc[ai][bj][m][1] * s1;
                    u32x4 w; w.x = cvt_pk_bf16(v0[0], v0[1]); w.y = cvt_pk_bf16(v0[2], v0[3]); w.z = cvt_pk_bf16(v1[0], v1[1]); w.w = cvt_pk_bf16(v1[2], v1[3]);
                    *(u32x4*)(rowp + bj * HALF) = w; } }
    }
};
struct EpiBranch {
    static constexpr bool PERM = true, KEEPS = true;
    const bf16_t* PG; bf16_t* MG;
    __device__ __forceinline__ bool keep(const Unit& u) const { return u.x == 0; }
    __device__ __forceinline__ void operator()(Acc& acc, const Unit& u, int wr, int wc, int fr, int fq) const {
        const int row0 = u.r0 + wr * 64 + fr, col0 = u.c0 + wc * 32 + 8 * fq; const int br = u.x;
#pragma unroll
        for (int ai = 0; ai < 2; ++ai)
#pragma unroll
            for (int m = 0; m < 4; ++m) { const size_t row = (size_t)(row0 + ai * HALF + m * 16);
#pragma unroll
                for (int bj = 0; bj < 2; ++bj) { const int col = col0 + bj * HALF;
                    const u32x4 gb = *(const u32x4*)(PG + row * NP1 + INW + D + col);
                    f32x4 h0 = {bf_lo(gb.x), bf_hi(gb.x), bf_lo(gb.y), bf_hi(gb.y)}, h1 = {bf_lo(gb.z), bf_hi(gb.z), bf_lo(gb.w), bf_hi(gb.w)};
#pragma unroll
                    for (int j = 0; j < 4; ++j) { h0[j] = fmaxf(h0[j], 1e-30f); h1[j] = fmaxf(h1[j], 1e-30f); }
                    if (br == 0) { const u32x4 ga = *(const u32x4*)(PG + row * NP1 + INW + col);
                        const f32x4 a0 = {bf_lo(ga.x), bf_hi(ga.x), bf_lo(ga.y), bf_hi(ga.y)}, a1 = {bf_lo(ga.z), bf_hi(ga.z), bf_lo(ga.w), bf_hi(ga.w)};
#pragma unroll
                        for (int j = 0; j < 4; ++j) { acc[ai][bj][m][0][j] *= a0[j] * __builtin_amdgcn_rcpf(h0[j]); acc[ai][bj][m][1][j] *= a1[j] * __builtin_amdgcn_rcpf(h1[j]); } }
                    else { const f32x4 v0 = acc[ai][bj][m][0] * h0, v1 = acc[ai][bj][m][1] * h1;
                        u32x4 w; w.x = cvt_pk_bf16(v0[0], v0[1]); w.y = cvt_pk_bf16(v0[2], v0[3]); w.z = cvt_pk_bf16(v1[0], v1[1]); w.w = cvt_pk_bf16(v1[2], v1[3]);
                        *(u32x4*)(MG + row * D + col) = w; } } }
    }
};
struct EpiResid {
    static constexpr bool PERM = false, KEEPS = false;
    const float* res; float* out; int ldc;
    __device__ __forceinline__ void operator()(Acc& acc, const Unit& u, int wr, int wc, int fr, int fq) const {
        const int row0 = u.r0 + wr * 64 + fr, col0 = u.c0 + wc * 32 + 4 * fq;
#pragma unroll
        for (int ai = 0; ai < 2; ++ai)
#pragma unroll
            for (int m = 0; m < 4; ++m) { const size_t off = (size_t)(row0 + ai * HALF + m * 16) * ldc + col0;
#pragma unroll
                for (int bj = 0; bj < 2; ++bj)
#pragma unroll
                    for (int n = 0; n < 2; ++n) { const f32x4 r = *(const f32x4*)(res + off + bj * HALF + n * 16); *(f32x4*)(out + off + bj * HALF + n * 16) = r + acc[ai][bj][m][n]; }
                asm volatile("" ::: "memory"); }
    }
};
struct EpiUp {
    static constexpr bool PERM = true, KEEPS = false;
    const float* bup; unsigned char* ACT;
    __device__ __forceinline__ void operator()(Acc& acc, const Unit& u, int wr, int wc, int fr, int fq) const {
        const int row0 = u.r0 + wr * 64 + fr, col0 = u.c0 * HALF + wc * 32 + 8 * fq; const float* be = bup + (size_t)u.x * (2 * DFF);
        f32x4 bg[2], bl[2];
#pragma unroll
        for (int n = 0; n < 2; ++n) { bg[n] = *(const f32x4*)(be + col0 + 4 * n); bl[n] = *(const f32x4*)(be + DFF + col0 + 4 * n); }
#pragma unroll
        for (int ai = 0; ai < 2; ++ai)
#pragma unroll
            for (int m = 0; m < 4; ++m) { unsigned char* rowp = ACT + (size_t)(row0 + ai * HALF + m * 16) * DFF + col0; f32x4 o[2];
#pragma unroll
                for (int n = 0; n < 2; ++n) { const f32x4 gv = acc[ai][0][m][n] + bg[n], lv = acc[ai][1][m][n] + bl[n];
#pragma unroll
                    for (int j = 0; j < 4; ++j) { const float g = fminf(gv[j], 7.0f), l = fminf(fmaxf(lv[j], -7.0f), 7.0f); o[n][j] = g * sigmoidf_fast(1.702f * g) * (l + 1.0f); } }
                u32x2 w; w.x = pk4_fp8(o[0][0], o[0][1], o[0][2], o[0][3]); w.y = pk4_fp8(o[1][0], o[1][1], o[1][2], o[1][3]);
                *(u32x2*)rowp = w; }
    }
};
struct EpiDown {
    static constexpr bool PERM = true, KEEPS = false;
    const float* bdn; const int* rslot; const float* gate; unsigned char* SLOT;
    __device__ __forceinline__ void operator()(Acc& acc, const Unit& u, int wr, int wc, int fr, int fq) const {
        const int row0 = u.r0 + wr * 64 + fr, col0 = u.c0 * BM + wc * 32 + 8 * fq; const float* be = bdn + (size_t)u.x * D;
        f32x4 bv[2][2];
#pragma unroll
        for (int bj = 0; bj < 2; ++bj)
#pragma unroll
            for (int n = 0; n < 2; ++n) bv[bj][n] = *(const f32x4*)(be + col0 + bj * HALF + 4 * n);
#pragma unroll
        for (int ai = 0; ai < 2; ++ai)
#pragma unroll
            for (int m = 0; m < 4; ++m) { const int sl = rslot[row0 + ai * HALF + m * 16];
                if (sl >= 0) { const float gt = gate[sl] * 16.0f; unsigned char* rowp = SLOT + (size_t)sl * D + col0;
#pragma unroll
                    for (int bj = 0; bj < 2; ++bj) { const f32x4 v0 = (acc[ai][bj][m][0] + bv[bj][0]) * gt, v1 = (acc[ai][bj][m][1] + bv[bj][1]) * gt;
                        u32x2 w; w.x = pk4_fp8(v0[0], v0[1], v0[2], v0[3]); w.y = pk4_fp8(v1[0], v1[1], v1[2], v1[3]);
                        *(u32x2*)(rowp + bj * HALF) = w; } } }
    }
};
}

struct Frame {
    LAS unsigned char* lds;
    int tid, lane, wave, vcu, G;
};

__device__ __forceinline__ void cvt_item_addr(const float* W, int K, int N, bf16_t* WT, int row_off, int item, int lane, const float*& src, bf16_t*& dst) {
    const int nblk = N >> 5, kb = item / nblk, nb = item - kb * nblk, kl = lane >> 3, nl = lane & 7;
    src = W + (size_t)(64 * kb + 8 * kl) * N + 32 * nb + 4 * nl; dst = WT + (size_t)(row_off + 32 * nb + 4 * nl) * K + 64 * kb + 8 * kl;
}
__device__ __forceinline__ void cvt_store(const f32x4 (&v)[8], bf16_t* dst, int K) {
#pragma unroll
    for (int i = 0; i < 4; ++i) { u32x4 o; o.x = cvt_pk_bf16(v[0][i], v[1][i]); o.y = cvt_pk_bf16(v[2][i], v[3][i]); o.z = cvt_pk_bf16(v[4][i], v[5][i]); o.w = cvt_pk_bf16(v[6][i], v[7][i]);
        *(u32x4*)(dst + (size_t)i * K) = o; }
}
__device__ __forceinline__ void cvt_store8(const f32x4 (&v)[8], unsigned char* dst, int K) {
#pragma unroll
    for (int i = 0; i < 4; ++i) { u32x2 o; o.x = pk4_fp8(v[0][i] * 64.f, v[1][i] * 64.f, v[2][i] * 64.f, v[3][i] * 64.f); o.y = pk4_fp8(v[4][i] * 64.f, v[5][i] * 64.f, v[6][i] * 64.f, v[7][i] * 64.f);
        *(u32x2*)(dst + (size_t)i * K) = o; }
}
__device__ __forceinline__ void cvt_range(const float* W, int K, int N, bf16_t* WT, int row_off, int i0, int cnt, int r, int nw, int lane) {
    int it = i0 + r; const int end = i0 + cnt;
    for (; it + nw < end; it += 2 * nw) {
        const float* s0; bf16_t* d0; const float* s1; bf16_t* d1;
        cvt_item_addr(W, K, N, WT, row_off, it, lane, s0, d0); cvt_item_addr(W, K, N, WT, row_off, it + nw, lane, s1, d1);
        f32x4 a[8], b[8];
#pragma unroll
        for (int j = 0; j < 8; ++j) a[j] = *(const f32x4*)(s0 + (size_t)j * N);
#pragma unroll
        for (int j = 0; j < 8; ++j) b[j] = *(const f32x4*)(s1 + (size_t)j * N);
        cvt_store(a, d0, K); cvt_store(b, d1, K);
    }
    if (it < end) { const float* s0; bf16_t* d0; cvt_item_addr(W, K, N, WT, row_off, it, lane, s0, d0); f32x4 a[8];
#pragma unroll
        for (int j = 0; j < 8; ++j) a[j] = *(const f32x4*)(s0 + (size_t)j * N);
        cvt_store(a, d0, K); }
}
constexpr int CV_UP = NE * (D / 64) * (2 * DFF / 32), CV_DN = NE * (DFF / 64) * (D / 32), CV_ALL = CV_UP + CV_DN;
struct MoeW { const float* w_up; const float* w_down; unsigned char* WUPT; unsigned char* WDNT; };
__device__ __forceinline__ void cvt_moe_addr(const MoeW& mw, int chunk, int w, int h, int lane, const float*& src, unsigned char*& dst, int& N) {
    const int kl = lane >> 3, nl = lane & 7;
    if (chunk < CV_UP / 64) { const int e = chunk >> 6, cc = chunk & 63, kb = 8 * (cc >> 4) + w, nb = 8 * (cc & 15) + h; N = 2 * DFF;
        src = mw.w_up + (size_t)e * D * 2 * DFF + (size_t)(64 * kb + 8 * kl) * (2 * DFF) + 32 * nb + 4 * nl; dst = mw.WUPT + (size_t)e * 2 * DFF * D + (size_t)(32 * nb + 4 * nl) * D + 64 * kb + 8 * kl; }
    else { const int q = chunk - CV_UP / 64, e = q >> 5, cc = q & 31, kb = 8 * (cc >> 3) + w, nb = 8 * (cc & 7) + h; N = D;
        src = mw.w_down + (size_t)e * DFF * D + (size_t)(64 * kb + 8 * kl) * D + 32 * nb + 4 * nl; dst = mw.WDNT + (size_t)e * D * DFF + (size_t)(32 * nb + 4 * nl) * DFF + 64 * kb + 8 * kl; }
}
__device__ __forceinline__ f32x4 ld_nt(const float* p) { return __builtin_nontemporal_load((const f32x4*)p); }
constexpr int CV_WG = 64;
__device__ __forceinline__ int cvt_claim(unsigned* cursor, int cap, unsigned* done, unsigned need) {
    if (done && __hip_atomic_load(done, __ATOMIC_RELAXED, __HIP_MEMORY_SCOPE_AGENT) >= need) return CV_ALL;
    if ((int)__hip_atomic_load(cursor, __ATOMIC_RELAXED, __HIP_MEMORY_SCOPE_AGENT) >= cap) return CV_ALL;
    return (int)__hip_atomic_fetch_add(cursor, (unsigned)CV_WG, __ATOMIC_RELAXED, __HIP_MEMORY_SCOPE_AGENT);
}
__device__ __forceinline__ void cvt_pull(const MoeW& mw, unsigned* cursor, int cap, unsigned* done, unsigned need, volatile LAS int* slot, int tid, int wave, int lane) {
    __syncthreads();
    if (tid == 0) *slot = cvt_claim(cursor, cap, done, need);
    __syncthreads();
    int base = __builtin_amdgcn_readfirstlane(*slot);
    while (base < CV_ALL) {
        int nb = CV_ALL; if (tid == 0) nb = cvt_claim(cursor, cap, done, need);
        const int chunk = base >> 6;
        if (chunk < CV_UP / 64) {
            const int e = chunk >> 6, cc = chunk & 63, nb = 8 * (cc & 15) + wave, kl = lane >> 3, nl = lane & 7;
#pragma unroll 1
            for (int q = 0; q < 2; ++q) { const int kq = 2 * (cc >> 4) + q, kb32 = 8 * kq + kl;
                const float* src = mw.w_up + (size_t)e * D * 2 * DFF + (size_t)(32 * kb32) * (2 * DFF) + 32 * nb + 4 * nl;
                f32x4 a[32];
#pragma unroll
                for (int j = 0; j < 32; ++j) a[j] = ld_nt(src + (size_t)j * (2 * DFF));
                unsigned char* dst = mw.WUPT + (size_t)e * 2 * DFF * D + (size_t)(32 * nb + 4 * nl) * D + 128 * (kb32 >> 2) + 16 * (kb32 & 3);
#pragma unroll
                for (int i = 0; i < 4; ++i) { f32x16 lo, hi;
#pragma unroll
                    for (int j = 0; j < 16; ++j) { lo[j] = a[j][i] * 64.f; hi[j] = a[16 + j][i] * 64.f; }
                    st_fp6_block(dst + (size_t)i * D, pk32_fp6(lo, hi)); } }
        } else
#pragma unroll
        for (int h = 0; h < 8; h += 4) {
            const float* s0; unsigned char* d0; const float* s1; unsigned char* d1; const float* s2; unsigned char* d2; const float* s3; unsigned char* d3; int N0, N1, N2, N3;
            cvt_moe_addr(mw, chunk, wave, h, lane, s0, d0, N0); cvt_moe_addr(mw, chunk, wave, h + 1, lane, s1, d1, N1); cvt_moe_addr(mw, chunk, wave, h + 2, lane, s2, d2, N2); cvt_moe_addr(mw, chunk, wave, h + 3, lane, s3, d3, N3);
            f32x4 a[8], b[8], c[8], d[8];
#pragma unroll
            for (int j = 0; j < 8; ++j) a[j] = ld_nt(s0 + (size_t)j * N0);
#pragma unroll
            for (int j = 0; j < 8; ++j) b[j] = ld_nt(s1 + (size_t)j * N1);
#pragma unroll
            for (int j = 0; j < 8; ++j) c[j] = ld_nt(s2 + (size_t)j * N2);
#pragma unroll
            for (int j = 0; j < 8; ++j) d[j] = ld_nt(s3 + (size_t)j * N3);
            cvt_store8(a, d0, D); cvt_store8(b, d1, D); cvt_store8(c, d2, D); cvt_store8(d, d3, D);
        }
        __syncthreads();
        if (tid == 0) *slot = nb;
        __syncthreads();
        base = __builtin_amdgcn_readfirstlane(*slot);
    }
}
__device__ __forceinline__ void rms_row_to_bf16(const float* xrow, const float* gvec, bf16_t* orow, int lane) {
    const f32x4* xr = (const f32x4*)xrow + lane; f32x4 v[8]; float s = 0.f;
#pragma unroll
    for (int j = 0; j < 8; ++j) { v[j] = xr[64 * j]; s += (v[j].x * v[j].x + v[j].y * v[j].y) + (v[j].z * v[j].z + v[j].w * v[j].w); }
    const float rstd = 1.0f / sqrtf(wave_sum(s) * (1.0f / D) + RMS_EPS);
    const f32x4* gr = (const f32x4*)gvec + lane; u32x2* o8 = (u32x2*)orow + lane;
#pragma unroll
    for (int j = 0; j < 8; ++j) { const f32x4 g = gr[64 * j]; const f32x4 y = v[j] * rstd * g; u32x2 w; w.x = cvt_pk_bf16(y.x, y.y); w.y = cvt_pk_bf16(y.z, y.w); o8[64 * j] = w; }
}

__device__ __forceinline__ unsigned voff_b(unsigned row, unsigned ch) { return 256u * row + 16u * (ch ^ (((row & 3u) << 2) | ((row >> 2) & 3u))); }
__device__ __forceinline__ s16x4 vtr(const LAS unsigned char* p) { return __builtin_bit_cast(s16x4, __builtin_amdgcn_ds_read_tr16_b64_v4i16((LAS s16x4*)p)); }

__device__ __forceinline__ void sb_wg_unit(const bf16_t* PG, bf16_t* OA, int h, int qb, LAS unsigned char* lds, volatile LAS int* flags, int tid, int wave, int lane) {
    const int fr = lane & 15, fq = lane >> 4, q0w = qb * 128 + wave * 16, qi = q0w + fr;
    bf16x8 Qf[4];
    { const bf16_t* qp = PG + (size_t)qi * NP1 + h * HD + 8 * fq;
#pragma unroll
      for (int ks = 0; ks < 4; ++ks) Qf[ks] = *(const bf16x8*)(qp + 32 * ks); }
    f32x4 O[8];
#pragma unroll
    for (int db = 0; db < 8; ++db) O[db] = (f32x4){0.f, 0.f, 0.f, 0.f};
    float carry = 0.f; bool sat = false;
    const float scale = 0.08838834764831845f;
    const unsigned p = fr & 3, qq = fr >> 2;
    const int jt_hi = 2 * qb + 1, jt_w = q0w >> 6;
    const int srow = tid >> 4, sch = tid & 15;
    const bf16_t* kg = PG + (size_t)srow * NP1 + SBW + h * HD + 8 * sch;
    u32x4 kr[2], vr[2];
    __syncthreads();
    if (tid < 8) flags[tid] = 0;
    { const bf16_t* g = kg + (size_t)(jt_hi * 64) * NP1;
#pragma unroll
      for (int i = 0; i < 2; ++i) { kr[i] = *(const u32x4*)(g + (size_t)(32 * i) * NP1); vr[i] = *(const u32x4*)(g + (size_t)(32 * i) * NP1 + SBW); } }
    for (int jt = jt_hi, it = 0; jt >= 0; --jt, ++it) {
        LAS unsigned char* kb = lds + (it & 1) * 32768; LAS unsigned char* vb = kb + 16384;
#pragma unroll
        for (int i = 0; i < 2; ++i) { *(LAS u32x4*)(kb + voff_b(srow + 32 * i, sch)) = kr[i]; *(LAS u32x4*)(vb + voff_b(srow + 32 * i, sch)) = vr[i]; }
        __syncthreads();
        { int ns = 0;
#pragma unroll
          for (int w = 0; w < 8; ++w) ns += flags[w];
          if (__builtin_amdgcn_readfirstlane(ns) == 8) break; }
        if (jt > 0) { const bf16_t* g = kg + (size_t)((jt - 1) * 64) * NP1;
#pragma unroll
            for (int i = 0; i < 2; ++i) { kr[i] = *(const u32x4*)(g + (size_t)(32 * i) * NP1); vr[i] = *(const u32x4*)(g + (size_t)(32 * i) * NP1 + SBW); } }
        if (!sat && jt <= jt_w) {
            const int key0 = jt * 64;
            f32x4 z[4];
#pragma unroll
            for (int sb = 0; sb < 4; ++sb) { z[sb] = (f32x4){0.f, 0.f, 0.f, 0.f};
#pragma unroll
                for (int ks = 0; ks < 4; ++ks) { const bf16x8 kf = *(const LAS bf16x8*)(kb + voff_b(16 * sb + fr, 4 * ks + fq)); z[sb] = __builtin_amdgcn_mfma_f32_16x16x32_bf16(kf, Qf[ks], z[sb], 0, 0, 0); } }
            float sfx[4][4], g[4], lex[4], T[4];
            const bool diag = key0 + 64 > q0w;
#pragma unroll
            for (int sb = 0; sb < 4; ++sb) {
                float sp[4];
#pragma unroll
                for (int i = 0; i < 4; ++i) { const float y = z[sb][i] * (scale * 1.4426950408889634f); z[sb][i] = y;
                    sp[i] = fmaxf(y, 0.f) + __builtin_amdgcn_logf(1.0f + __builtin_amdgcn_exp2f(-fabsf(y))); }
                if (diag) {
#pragma unroll
                    for (int i = 0; i < 4; ++i) { const int key = key0 + 16 * sb + 4 * fq + i; sp[i] = (key < qi) ? sp[i] : 0.f; } }
                sfx[sb][3] = sp[3]; sfx[sb][2] = sp[2] + sfx[sb][3]; sfx[sb][1] = sp[1] + sfx[sb][2]; sfx[sb][0] = sp[0] + sfx[sb][1]; g[sb] = sfx[sb][0];
            }
#pragma unroll
            for (int sb = 0; sb < 4; ++sb) { const float x1 = __shfl_xor(g[sb], 16), x2 = __shfl_xor(g[sb], 32), x3 = __shfl_xor(g[sb], 48);
                T[sb] = (g[sb] + x1) + (x2 + x3); lex[sb] = ((fq & 1) ? 0.f : x1) + ((fq < 2) ? (x2 + x3) : 0.f); }
            float run = carry; bf16x8 Wf[2]; unsigned wpk[8];
#pragma unroll
            for (int sb = 3; sb >= 0; --sb) { const float base = run + lex[sb]; float w[4];
#pragma unroll
                for (int i = 0; i < 4; ++i) w[i] = __builtin_amdgcn_exp2f(z[sb][i] - (base + sfx[sb][i]));
                if (diag) {
#pragma unroll
                    for (int i = 0; i < 4; ++i) { const int key = key0 + 16 * sb + 4 * fq + i; w[i] = (key < qi) ? w[i] : 0.f; } }
                wpk[2 * sb] = cvt_pk_bf16(w[0], w[1]); wpk[2 * sb + 1] = cvt_pk_bf16(w[2], w[3]); run += T[sb]; }
            carry = run;
            { u32x4 a = {wpk[0], wpk[1], wpk[2], wpk[3]}, b = {wpk[4], wpk[5], wpk[6], wpk[7]}; Wf[0] = __builtin_bit_cast(bf16x8, a); Wf[1] = __builtin_bit_cast(bf16x8, b); }
#pragma unroll
            for (int db = 0; db < 8; ++db)
#pragma unroll
                for (int m = 0; m < 2; ++m) { const unsigned r1 = 32 * m + 4 * fq + qq, r2 = r1 + 16;
                    const s16x4 lo = vtr(vb + voff_b(r1, 2 * db + (p >> 1)) + 8 * (p & 1)), hi = vtr(vb + voff_b(r2, 2 * db + (p >> 1)) + 8 * (p & 1));
                    const bf16x8 vf = {lo[0], lo[1], lo[2], lo[3], hi[0], hi[1], hi[2], hi[3]};
                    O[db] = __builtin_amdgcn_mfma_f32_16x16x32_bf16(vf, Wf[m], O[db], 0, 0, 0); }
            if (__all(carry > 150.1f)) { sat = true; if (lane == 0) flags[wave] = 1; }
        }
    }
    { bf16_t* op = OA + (size_t)qi * SBW + h * HD + 4 * fq;
#pragma unroll
      for (int db = 0; db < 8; ++db) { u32x2 w; w.x = cvt_pk_bf16(O[db][0], O[db][1]); w.y = cvt_pk_bf16(O[db][2], O[db][3]); *(u32x2*)(op + 16 * db) = w; } }
}

__device__ __forceinline__ void xa_unit(const bf16_t* QXA, const bf16_t* KVM, bf16_t* OXA, int h, int qb, const LAS unsigned char* vl, int lane) {
    const int fr = lane & 15, fq = lane >> 4, q0 = qb * 16, qi = q0 + fr;
    bf16x8 Qf[4];
    { const bf16_t* qp = QXA + (size_t)qi * XAW + h * HD + 8 * fq;
#pragma unroll
      for (int ks = 0; ks < 4; ++ks) Qf[ks] = *(const bf16x8*)(qp + 32 * ks); }
    f32x4 z[16];
    { const bf16_t* kp = KVM + (size_t)fr * (2 * XAW) + h * HD + 8 * fq;
#pragma unroll
      for (int sb = 0; sb < 16; ++sb) { z[sb] = (f32x4){0.f, 0.f, 0.f, 0.f};
#pragma unroll
          for (int ks = 0; ks < 4; ++ks) { const bf16x8 kf = *(const bf16x8*)(kp + (size_t)(16 * sb) * (2 * XAW) + 32 * ks); z[sb] = __builtin_amdgcn_mfma_f32_16x16x32_bf16(kf, Qf[ks], z[sb], 0, 0, 0); } } }
    const float scale = 0.08838834764831845f * 1.4426950408889634f;
    float mx = -3.0e38f;
#pragma unroll
    for (int sb = 0; sb < 16; ++sb)
#pragma unroll
        for (int i = 0; i < 4; ++i) { z[sb][i] *= scale; mx = fmaxf(mx, z[sb][i]); }
    mx = fmaxf(mx, __shfl_xor(mx, 16)); mx = fmaxf(mx, __shfl_xor(mx, 32));
    float sum = 0.f;
#pragma unroll
    for (int sb = 0; sb < 16; ++sb)
#pragma unroll
        for (int i = 0; i < 4; ++i) { const float e = __builtin_amdgcn_exp2f(z[sb][i] - mx); z[sb][i] = e; sum += e; }
    sum += __shfl_xor(sum, 16); sum += __shfl_xor(sum, 32);
    const float inv = 1.0f / sum;
    f32x4 O[8];
#pragma unroll
    for (int db = 0; db < 8; ++db) O[db] = (f32x4){0.f, 0.f, 0.f, 0.f};
    const unsigned p = fr & 3, qq = fr >> 2;
#pragma unroll
    for (int m = 0; m < 8; ++m) {
        u32x4 a = {cvt_pk_bf16(z[2 * m][0], z[2 * m][1]), cvt_pk_bf16(z[2 * m][2], z[2 * m][3]), cvt_pk_bf16(z[2 * m + 1][0], z[2 * m + 1][1]), cvt_pk_bf16(z[2 * m + 1][2], z[2 * m + 1][3])};
        const bf16x8 Wf = __builtin_bit_cast(bf16x8, a);
#pragma unroll
        for (int db = 0; db < 8; ++db) { const unsigned r1 = 32 * m + 4 * fq + qq, r2 = r1 + 16;
            const s16x4 lo = vtr(vl + voff_b(r1, 2 * db + (p >> 1)) + 8 * (p & 1)), hi = vtr(vl + voff_b(r2, 2 * db + (p >> 1)) + 8 * (p & 1));
            const bf16x8 vf = {lo[0], lo[1], lo[2], lo[3], hi[0], hi[1], hi[2], hi[3]};
            O[db] = __builtin_amdgcn_mfma_f32_16x16x32_bf16(vf, Wf, O[db], 0, 0, 0); }
    }
    { bf16_t* op = OXA + (size_t)qi * XAW + h * HD + 4 * fq;
#pragma unroll
      for (int db = 0; db < 8; ++db) { const f32x4 o = O[db] * inv; u32x2 w; w.x = cvt_pk_bf16(o[0], o[1]); w.y = cvt_pk_bf16(o[2], o[3]); *(u32x2*)(op + 16 * db) = w; } }
}

template <int W>
__device__ __forceinline__ void pool_run(const bf16_t* PG, bf16_t* PO, int t0, int ch) {
    constexpr int NR = W + 7;
    const bf16_t* pp = PG + (size_t)(t0 + 7) * NP1 + 3 * SBW + ch * 8;
    u32x4 v[NR];
#pragma unroll
    for (int k = 0; k < NR; ++k) v[k] = (t0 + 7 - k >= 0) ? *(const u32x4*)(pp - (size_t)k * NP1) : (u32x4){0u, 0u, 0u, 0u};
#pragma unroll
    for (int i = 0; i < 8; ++i) {
        float s[8];
#pragma unroll
        for (int j = 0; j < 8; ++j) s[j] = 0.f;
#pragma unroll
        for (int j = W - 1; j >= 0; --j) { const u32x4 x = v[7 - i + j];
            s[0] += bf_lo(x.x); s[1] += bf_hi(x.x); s[2] += bf_lo(x.y); s[3] += bf_hi(x.y); s[4] += bf_lo(x.z); s[5] += bf_hi(x.z); s[6] += bf_lo(x.w); s[7] += bf_hi(x.w); }
        const int t = t0 + i, n = (t + 1 < W) ? (t + 1) : W; const float inv = 1.0f / (float)n; const u32x4 me = v[7 - i]; u32x4 o;
        o.x = cvt_pk_bf16(s[0] * inv - bf_lo(me.x), s[1] * inv - bf_hi(me.x)); o.y = cvt_pk_bf16(s[2] * inv - bf_lo(me.y), s[3] * inv - bf_hi(me.y));
        o.z = cvt_pk_bf16(s[4] * inv - bf_lo(me.z), s[5] * inv - bf_hi(me.z)); o.w = cvt_pk_bf16(s[6] * inv - bf_lo(me.w), s[7] * inv - bf_hi(me.w));
        *(u32x4*)(PO + (size_t)t * POOLW + ch * 8) = o;
    }
}

constexpr int NPHASE = 15;
struct Args { const float* in[24]; float* out; unsigned char* ws; int ph_lo, ph_hi; };
static_assert(sizeof(Args) == 24 * 8 + 8 + 8 + 8, "Args has no padding");

__global__ void __launch_bounds__(NWAVES * 64, 2) moe_fwd(Args args) {
    extern __shared__ __attribute__((aligned(16))) unsigned char lds_raw[];
    Frame F;
    F.lds = (LAS unsigned char*)lds_raw;
    F.tid = threadIdx.x; F.lane = F.tid & 63; F.wave = __builtin_amdgcn_readfirstlane(F.tid >> 6);
    F.G = gridDim.x; { const int bx = blockIdx.x; F.vcu = (F.G % 8 == 0) ? (bx % 8) * (F.G / 8) + bx / 8 : bx; }
    unsigned char* ws = args.ws;
    unsigned* ctl = (unsigned*)(ws + WS_CTL);
    LAS unsigned char* lx = F.lds + LDS_X_OFF;
    for (int u = F.tid; u < (LDS_BYTES - LDS_X_OFF) / 4; u += NWAVES * 64) ((LAS unsigned*)lx)[u] = 0u;
    __syncthreads();
#if MK_ONE_LAUNCH
    XcdBarrier bar = xcd_barrier_post(ctl + CW_BAR, (volatile LAS unsigned*)(lx + LX_BAR));
#define GRID_BAR() xcd_barrier(bar)
#else
#define GRID_BAR() do {} while (0)
#endif
    const int lo = args.ph_lo, hi = args.ph_hi;
#ifndef PHASE_MASK
#define PHASE_MASK 0x7fff
#endif
#define IN(k) (((PHASE_MASK >> (k)) & 1) && lo <= (k) && (k) < hi)
#define SEAM(k) do { if (IN((k) + 1)) GRID_BAR(); } while (0)

    const float* x = args.in[0]; const float* mem = args.in[1]; const float* norm_mix = args.in[2]; const float* w_in = args.in[3]; const float* pool_lin = args.in[4];
    const float* pool_scale = args.in[5]; const float* w_branch_a = args.in[6]; const float* w_branch_b = args.in[7]; const float* w_gate = args.in[8]; const float* b_gate = args.in[9];
    const float* w_mix_out = args.in[10]; const float* xa_norm = args.in[11]; const float* mem_norm = args.in[12]; const float* xa_wq = args.in[13]; const float* xa_wkv = args.in[14];
    const float* xa_wo = args.in[15]; const float* moe_norm = args.in[16]; const float* w_router = args.in[17]; const float* b_router = args.in[18]; const float* w_up = args.in[19];
    const float* b_up = args.in[20]; const float* w_down = args.in[21]; const float* b_down = args.in[22]; const float* final_norm = args.in[23];
    bf16_t* W1T = (bf16_t*)(ws + WS_W1T); bf16_t* WAT = (bf16_t*)(ws + WS_WAT); bf16_t* WBT = (bf16_t*)(ws + WS_WBT); bf16_t* WMT = (bf16_t*)(ws + WS_WMT); bf16_t* PLT = (bf16_t*)(ws + WS_PLT);
    bf16_t* WQT = (bf16_t*)(ws + WS_WQT); bf16_t* WKVT = (bf16_t*)(ws + WS_WKVT); bf16_t* WOT = (bf16_t*)(ws + WS_WOT); unsigned char* WUPT = ws + WS_WUPT; unsigned char* WDNT = ws + WS_WDNT;
    bf16_t* U = (bf16_t*)(ws + WS_U); bf16_t* MEMN = (bf16_t*)(ws + WS_MEMN); bf16_t* PG = (bf16_t*)(ws + WS_PG); bf16_t* OA = (bf16_t*)(ws + WS_OA); bf16_t* PO = (bf16_t*)(ws + WS_PO);
    bf16_t* OB = (bf16_t*)(ws + WS_OB); float* TMP = (float*)(ws + WS_TMP); bf16_t* MG = (bf16_t*)(ws + WS_MG); float* H1 = (float*)(ws + WS_H1); bf16_t* U2 = (bf16_t*)(ws + WS_U2);
    bf16_t* QXA = (bf16_t*)(ws + WS_QXA); bf16_t* KVM = (bf16_t*)(ws + WS_KVM); bf16_t* OXA = (bf16_t*)(ws + WS_OXA); float* H2 = (float*)(ws + WS_H2); unsigned char* TB = ws + WS_TB;
    bf16_t* ROWS = (bf16_t*)(ws + WS_ROWS); unsigned char* ACT = ws + WS_ACT; unsigned char* SLOT = ws + WS_SLOT;
    int* ASGE = (int*)(ws + WS_ASGE); int* ASGP = (int*)(ws + WS_ASGP); float* GATE = (float*)(ws + WS_GATE); int* RSLOT = (int*)(ws + WS_RSLOT);
    int* CNT = (int*)(ctl + CW_CNT); bf16_t* WRT = (bf16_t*)(ws + WS_WRT);
    const int gw = F.vcu * NWAVES + F.wave, NGW = F.G * NWAVES;
    const MoeW mw{w_up, w_down, WUPT, WDNT};
    unsigned* CUR = ctl + CW_CUR; volatile LAS int* cvs = (volatile LAS int*)(lx + LX_CVS);
#define CVT_PULL(cap) cvt_pull(mw, CUR, (cap), nullptr, 0u, cvs, F.tid, F.wave, F.lane)
#define CVT_BESIDE(cap, ph, need) cvt_pull(mw, CUR, (cap), ctl + CW_DONE + 64 * (ph), (unsigned)(need), cvs, F.tid, F.wave, F.lane)
#define MARK_DONE(ph) do { if (F.tid == 0) __hip_atomic_fetch_add(ctl + CW_DONE + 64 * (ph), 1u, __ATOMIC_RELAXED, __HIP_MEMORY_SCOPE_AGENT); } while (0)

    if (IN(0)) {
        constexpr int I_IN = (D / 64) * (INW / 32), I_BR = (SBW / 64) * (D / 32), I_MX = (D / 64) * (D / 32), I_PL = (256 / 64) * (256 / 32);
        constexpr int I_Q = (D / 64) * (XAW / 32), I_KV = (D / 64) * (2 * XAW / 32), I_O = (XAW / 64) * (D / 32);
        cvt_range(w_in, D, INW, W1T, 0, 0, I_IN, gw, NGW, F.lane);
        cvt_range(w_gate, D, INW, W1T, INW, 0, I_IN, gw, NGW, F.lane);
        for (int m = gw; m < S; m += NGW) rms_row_to_bf16(x + (size_t)m * D, norm_mix, U + (size_t)m * D, F.lane);
        for (int m = gw; m < MEM; m += NGW) rms_row_to_bf16(mem + (size_t)m * D, mem_norm, MEMN + (size_t)m * D, F.lane);
        for (int i = blockIdx.x * (NWAVES * 64) + F.tid; i < NE * D / 2; i += F.G * NWAVES * 64) {
            const int e = i >> 10, c = (i & 1023) * 2; const float a = w_router[(size_t)c * NE + e], b = w_router[(size_t)(c + 1) * NE + e];
            const unsigned hi = cvt_pk_bf16(a, b); const unsigned lo = cvt_pk_bf16(a - bf_lo(hi), b - bf_hi(hi));
            *(unsigned*)(WRT + (size_t)e * D + c) = hi; *(unsigned*)(WRT + (size_t)(NE + e) * D + c) = lo; }
        __syncthreads();
        SEAM(0);
    }

    if (IN(1)) {
        const int gc = (F.G == 256) ? GC_P1 : F.G;
        if ((int)blockIdx.x < gc) {
            pg8::DenseSched Sc{(const char*)U, (const char*)W1T, D, D, S / 256, NP1 / 256, gc, (int)blockIdx.x};
            pg8::EpiProj E{PG, b_gate};
            pg8::gemm_phase<pg8::EpiProj, pg8::DenseSched, true>(F.lds, D, D, D, Sc, E);
            MARK_DONE(1);
        }
        if ((int)blockIdx.x >= gc) {
            constexpr int I_BR = (SBW / 64) * (D / 32), I_MX = (D / 64) * (D / 32), I_PL = (256 / 64) * (256 / 32), I_Q = (D / 64) * (XAW / 32), I_KV = (D / 64) * (2 * XAW / 32), I_O = (XAW / 64) * (D / 32);
            const int cr = ((int)blockIdx.x - gc) * NWAVES + F.wave, cn = (F.G - gc) * NWAVES;
        cvt_range(w_branch_a, SBW, D, WAT, 0, 0, I_BR, cr, cn, F.lane);
        cvt_range(w_branch_b, POOLW, D, WBT, 0, 0, I_BR, cr, cn, F.lane);
        cvt_range(w_mix_out, D, D, WMT, 0, 0, I_MX, cr, cn, F.lane);
        for (int g = 0; g < 4; ++g) cvt_range(pool_lin + (size_t)g * 65536, 256, 256, PLT + (size_t)g * 65536, 0, 0, I_PL, cr, cn, F.lane);
        cvt_range(xa_wq, D, XAW, WQT, 0, 0, I_Q, cr, cn, F.lane);
        cvt_range(xa_wkv, D, 2 * XAW, WKVT, 0, 0, I_KV, cr, cn, F.lane);
        cvt_range(xa_wo, XAW, D, WOT, 0, 0, I_O, cr, cn, F.lane);
        }
        CVT_BESIDE(CV_UP, 1, gc);
        SEAM(1);
    }

    if (IN(2)) {
        for (int it = blockIdx.x * (NWAVES * 64) + F.tid; it < (S / 8) * (POOLW / 8); it += F.G * NWAVES * 64) {
            const int wv = it >> 6, g = wv & 3, rb = (wv >> 2) * 2 + (F.lane >> 5), ch = g * 32 + (F.lane & 31), t0 = rb * 8;
            if (g == 0) pool_run<2>(PG, PO, t0, ch); else if (g == 1) pool_run<4>(PG, PO, t0, ch); else if (g == 2) pool_run<8>(PG, PO, t0, ch); else pool_run<16>(PG, PO, t0, ch);
        }
        for (int it = F.vcu; it < SBH * (S / 128); it += F.G) { const int h = it & 7, qb = (S / 128 - 1) - (it >> 3); sb_wg_unit(PG, OA, h, qb, F.lds, (volatile LAS int*)(lx + LX_SBF), F.tid, F.wave, F.lane); }
        __syncthreads();
        SEAM(2);
    }

    if (IN(3)) {
        pg8::PoolSched Sc{(const char*)PO, (const char*)PLT, F.G, F.vcu};
        pg8::EpiBf16 E{OB, POOLW, pool_scale};
        pg8::gemm_phase<pg8::EpiBf16, pg8::PoolSched, true>(F.lds, 256, POOLW, 256, Sc, E);
        if (F.vcu < (S / 256) * 4) MARK_DONE(3);
        CVT_BESIDE(CV_UP, 3, (S / 256) * 4);
        SEAM(3);
    }

    if (IN(4)) {
        pg8::BranchSched Sc{(const char*)OA, (const char*)OB, (const char*)WAT, (const char*)WBT, SBW, SBW, S / 256, D / 256, F.G, (int)blockIdx.x};
        pg8::EpiBranch E{PG, MG};
        pg8::gemm_phase<pg8::EpiBranch, pg8::BranchSched, true>(F.lds, SBW, SBW, SBW, Sc, E);
        SEAM(4);
    }

    if (IN(5)) {
        pg8::DenseSched Sc{(const char*)MG, (const char*)WMT, D, D, S / 256, D / 256, F.G, (int)blockIdx.x};
        pg8::EpiResid E{x, H1, D};
        pg8::gemm_phase<pg8::EpiResid, pg8::DenseSched, true>(F.lds, D, D, D, Sc, E);
        SEAM(5);
    }

    if (IN(6)) {
        for (int m = gw; m < S; m += NGW) rms_row_to_bf16(H1 + (size_t)m * D, xa_norm, U2 + (size_t)m * D, F.lane);
        SEAM(6);
    }

    if (IN(7)) {
        { pg8::DenseSched Sc{(const char*)U2, (const char*)WQT, D, D, S / 256, XAW / 256, F.G, (int)blockIdx.x};
          pg8::EpiBf16 E{QXA, XAW, nullptr};
          pg8::gemm_phase<pg8::EpiBf16, pg8::DenseSched, true>(F.lds, D, D, D, Sc, E); }
        { const int c2 = ((int)blockIdx.x >= 64) ? (int)blockIdx.x - 64 : (int)blockIdx.x + F.G - 64;
          pg8::DenseSched Sc{(const char*)MEMN, (const char*)WKVT, D, D, MEM / 256, 2 * XAW / 256, F.G, c2};
          pg8::EpiBf16 E{KVM, 2 * XAW, nullptr};
          pg8::gemm_phase<pg8::EpiBf16, pg8::DenseSched, true>(F.lds, D, D, D, Sc, E); }
        if ((int)blockIdx.x < 68) MARK_DONE(7);
        CVT_BESIDE(CV_UP, 7, 68);
        SEAM(7);
    }

    if (IN(8)) {
        for (int it = F.vcu; it < XAH * (S / 128); it += F.G) {
            const int h = it & 3, qg = it >> 2;
            __syncthreads();
#pragma unroll
            for (int t = 0; t < 8; ++t) { const int c = t * 512 + F.tid, row = c >> 4, ch = c & 15;
                const u32x4 vv = *(const u32x4*)(KVM + (size_t)row * (2 * XAW) + XAW + h * HD + 8 * ch); *(LAS u32x4*)(F.lds + voff_b(row, ch)) = vv; }
            __syncthreads();
            xa_unit(QXA, KVM, OXA, h, qg * 8 + F.wave, F.lds, F.lane);
        }
        __syncthreads();
        SEAM(8);
    }

    if (IN(9)) {
        pg8::DenseSched Sc{(const char*)OXA, (const char*)WOT, XAW, XAW, S / 256, D / 256, F.G, (int)blockIdx.x};
        pg8::EpiResid E{H1, H2, D};
        pg8::gemm_phase<pg8::EpiResid, pg8::DenseSched, true>(F.lds, XAW, XAW, XAW, Sc, E);
        SEAM(9);
    }

    if (IN(10)) {
        for (int i = blockIdx.x * (NWAVES * 64) + F.tid; i < PROWS; i += F.G * NWAVES * 64) RSLOT[i] = -1;
        LAS unsigned char* thi = F.lds;
        LAS float* lg = (LAS float*)(lx + LX_LOG);
        LAS float* part = (LAS float*)(lx + LX_RPART);
        for (int rg = F.vcu; rg < S / 16; rg += F.G) {
            __syncthreads();
#pragma unroll
            for (int rr = 0; rr < 2; ++rr) { const int r = 2 * F.wave + rr, m = rg * 16 + r;
                const f32x4* xr = (const f32x4*)(H2 + (size_t)m * D) + F.lane; f32x4 v[8]; float s = 0.f;
#pragma unroll
                for (int j = 0; j < 8; ++j) { v[j] = xr[64 * j]; s += (v[j].x * v[j].x + v[j].y * v[j].y) + (v[j].z * v[j].z + v[j].w * v[j].w); }
                const float rstd = 1.0f / sqrtf(wave_sum(s) * (1.0f / D) + RMS_EPS);
                const f32x4* gr = (const f32x4*)moe_norm + F.lane;
#pragma unroll
                for (int j = 0; j < 8; ++j) { const f32x4 g = gr[64 * j]; const f32x4 y = v[j] * rstd * g; u32x2 w; w.x = cvt_pk_bf16(y.x, y.y); w.y = cvt_pk_bf16(y.z, y.w);
                    u32x2 l; l.x = cvt_pk_bf16(y.x - bf_lo(w.x), y.y - bf_hi(w.x)); l.y = cvt_pk_bf16(y.z - bf_lo(w.y), y.w - bf_hi(w.y));
                    const unsigned off = (unsigned)r * 4096u + ((((unsigned)F.lane >> 1) + 32u * j) ^ (unsigned)r) * 16u + (F.lane & 1) * 8u;
                    *(LAS u32x2*)(thi + off) = w; *(LAS u32x2*)(thi + 65536 + off) = l; } }
            __syncthreads();
#pragma unroll
            for (int q = 0; q < 2; ++q) { const int blk = F.tid + 512 * q, r = blk >> 6, kb32 = blk & 63; f32x16 lo, hi;
#pragma unroll
                for (int c4 = 0; c4 < 4; ++c4) { const u32x4 v = *(const LAS u32x4*)(thi + r * 4096 + ((unsigned)((4 * kb32 + c4) ^ r) * 16u));
                    const float f[8] = {bf_lo(v.x), bf_hi(v.x), bf_lo(v.y), bf_hi(v.y), bf_lo(v.z), bf_hi(v.z), bf_lo(v.w), bf_hi(v.w)};
#pragma unroll
                    for (int j = 0; j < 8; ++j) { if (c4 < 2) lo[8 * c4 + j] = f[j] * 2.0f; else hi[8 * (c4 - 2) + j] = f[j] * 2.0f; } }
                st_fp6_block(TB + (size_t)(rg * 16 + r) * D + 128 * (kb32 >> 2) + 16 * (kb32 & 3), pk32_fp6(lo, hi)); }
            { const int fr = F.lane & 15, fq = F.lane >> 4; f32x4 c0 = {0.f, 0.f, 0.f, 0.f}, c1 = {0.f, 0.f, 0.f, 0.f};
              const bf16_t* wh = WRT + (size_t)fr * D + 256 * F.wave + 8 * fq;
#pragma unroll
              for (int st = 0; st < 8; ++st) { const unsigned ch = (unsigned)(32 * F.wave + 4 * st + fq);
                  const bf16x8 ah = *(const LAS bf16x8*)(thi + fr * 4096 + ((ch ^ (unsigned)fr) * 16u)), al = *(const LAS bf16x8*)(thi + 65536 + fr * 4096 + ((ch ^ (unsigned)fr) * 16u));
                  const bf16x8 bh0 = *(const bf16x8*)(wh + 32 * st), bh1 = *(const bf16x8*)(wh + (size_t)16 * D + 32 * st), bl0 = *(const bf16x8*)(wh + (size_t)NE * D + 32 * st), bl1 = *(const bf16x8*)(wh + (size_t)(NE + 16) * D + 32 * st);
                  c0 = __builtin_amdgcn_mfma_f32_16x16x32_bf16(ah, bh0, c0, 0, 0, 0); c1 = __builtin_amdgcn_mfma_f32_16x16x32_bf16(ah, bh1, c1, 0, 0, 0);
                  c0 = __builtin_amdgcn_mfma_f32_16x16x32_bf16(ah, bl0, c0, 0, 0, 0); c1 = __builtin_amdgcn_mfma_f32_16x16x32_bf16(ah, bl1, c1, 0, 0, 0);
                  c0 = __builtin_amdgcn_mfma_f32_16x16x32_bf16(al, bh0, c0, 0, 0, 0); c1 = __builtin_amdgcn_mfma_f32_16x16x32_bf16(al, bh1, c1, 0, 0, 0); }
#pragma unroll
              for (int i = 0; i < 4; ++i) { part[(F.wave * 16 + 4 * fq + i) * 32 + fr] = c0[i]; part[(F.wave * 16 + 4 * fq + i) * 32 + 16 + fr] = c1[i]; } }
            __syncthreads();
            { const int r = F.tid >> 5, e = F.tid & 31; float a = 0.f;
#pragma unroll
              for (int w = 0; w < 8; ++w) a += part[(w * 16 + r) * 32 + e];
              lg[r * 32 + e] = a + b_router[e]; }
            __syncthreads();
            if (F.tid < 16) { const int r = F.tid, m = rg * 16 + r; float l[32];
#pragma unroll
                for (int e = 0; e < 32; ++e) l[e] = lg[r * 32 + e];
                int idx[4]; float val[4]; unsigned taken = 0u;
#pragma unroll
                for (int k = 0; k < 4; ++k) { float best = -3.4e38f; int bi = 0;
#pragma unroll
                    for (int e = 0; e < 32; ++e) { const bool ok = !((taken >> e) & 1u) && (l[e] > best); best = ok ? l[e] : best; bi = ok ? e : bi; }
                    idx[k] = bi; val[k] = best; taken |= 1u << bi; }
                const float e0 = 1.0f, e1 = expf(val[1] - val[0]), e2 = expf(val[2] - val[0]), e3 = expf(val[3] - val[0]); const float inv = 1.0f / (((e0 + e1) + e2) + e3);
                const float gk[4] = {e0 * inv, e1 * inv, e2 * inv, e3 * inv};
#pragma unroll
                for (int k = 0; k < 4; ++k) { const int pos = atomicAdd(CNT + idx[k], 1); ASGE[m * 4 + k] = idx[k]; ASGP[m * 4 + k] = pos; GATE[m * 4 + k] = gk[k]; } }
        }
        __syncthreads();
        SEAM(10);
    }

    LAS int* tab = (LAS int*)(lx + LX_TAB);
#define BUILD_TAB(NT) do { __syncthreads(); if (F.tid == 0) { int us = 0, ps = 0; for (int e = 0; e < NE; ++e) { const int c = CNT[e], nb = (c + EBLK - 1) / EBLK; tab[e] = us; tab[33 + e] = ps; tab[66 + e] = nb > 0 ? nb : 1; us += nb * (NT); ps += nb * EBLK; } tab[32] = us; tab[65] = ps; } __syncthreads(); } while (0)

    if (IN(11)) {
        BUILD_TAB(1);
        for (int s = blockIdx.x * (NWAVES * 64) + F.tid; s < NK; s += F.G * NWAVES * 64) { const int e = ASGE[s], pos = ASGP[s]; RSLOT[tab[33 + e] + pos] = s; }
        CVT_PULL(CV_UP);
        SEAM(11);
    }

    if (IN(12)) {
        BUILD_TAB(16);
        const int gc = (F.G == 256) ? GC_P12 : F.G; const int bx = (int)blockIdx.x;
        if ((bx >> 3) < (gc >> 3) || F.G != 256) {
            pg8::MoeSched Sc{(const char*)TB, (const char*)WUPT, 16, (size_t)2 * DFF * D, (size_t)128 * D, (size_t)DFF * D, tab, gc, (F.G == 256) ? (bx & 7) * (gc >> 3) + (bx >> 3) : F.vcu, true, (size_t)D};
            pg8::EpiUp E{b_up, ACT};
            LAS int* gtab = (LAS int*)(lx + LX_RPART);
            { pg8::Unit uu; for (int i = 0; i < 16 && Sc.next(i, uu); ++i) if (F.tid < 256) { const int sl = RSLOT[uu.r0 + F.tid]; gtab[i * 256 + F.tid] = (sl < 0 ? 0 : sl) >> 2; } }
            __syncthreads();
            pg8::gemm_phase<pg8::EpiUp, pg8::MoeSched, true, true, 2>(F.lds, D / 2, D / 2, D / 2, Sc, E, gtab);
            MARK_DONE(12);
        }
        CVT_BESIDE(CV_ALL, 12, gc);
        CVT_PULL(CV_ALL);
        SEAM(12);
    }

    if (IN(13)) {
        BUILD_TAB(8);
        pg8::MoeSched Sc{(const char*)ACT, (const char*)WDNT, 8, (size_t)D * DFF, (size_t)256 * DFF, (size_t)128 * DFF, tab, F.G, F.vcu, false, (size_t)DFF};
        pg8::EpiDown E{b_down, RSLOT, GATE, SLOT};
        pg8::gemm_phase<pg8::EpiDown, pg8::MoeSched, true, false, 1>(F.lds, DFF / 2, DFF / 2, DFF / 2, Sc, E);
        SEAM(13);
    }

    if (IN(14)) {
        for (int m = gw; m < S; m += NGW) {
            const f32x4* xr = (const f32x4*)(H2 + (size_t)m * D) + F.lane; f32x4 v[8]; float s = 0.f;
#pragma unroll
            for (int j = 0; j < 8; ++j) { v[j] = xr[64 * j];
#pragma unroll
                for (int k = 0; k < 4; ++k) { const int w = (int)*((const unsigned*)(SLOT + (size_t)(m * 4 + k) * D) + F.lane + 64 * j); const f32x2 lo = __builtin_amdgcn_cvt_pk_f32_fp8(w, false), hi = __builtin_amdgcn_cvt_pk_f32_fp8(w, true);
                    v[j].x += lo.x * 0.0625f; v[j].y += lo.y * 0.0625f; v[j].z += hi.x * 0.0625f; v[j].w += hi.y * 0.0625f; }
                s += (v[j].x * v[j].x + v[j].y * v[j].y) + (v[j].z * v[j].z + v[j].w * v[j].w); }
            const float rstd = 1.0f / sqrtf(wave_sum(s) * (1.0f / D) + RMS_EPS);
            const f32x4* gr = (const f32x4*)final_norm + F.lane; f32x4* o = (f32x4*)(args.out + (size_t)m * D) + F.lane;
#pragma unroll
            for (int j = 0; j < 8; ++j) o[64 * j] = v[j] * rstd * gr[64 * j];
        }
    }
#undef IN
#undef SEAM
}

extern "C" void kernel_launch(void* const* d_in, const int* in_sizes, int n_in, void* d_out, int out_size, void* d_ws, size_t ws_size, hipStream_t stream) {
    static int grid = 0;
    if (grid == 0) {
        if (n_in != 24 || out_size != S * D || ws_size < WS_END) { fprintf(stderr, "kernel_launch: unexpected shapes (n_in %d out %d ws %zu need %zu)\n", n_in, out_size, ws_size, (size_t)WS_END); grid = -1; return; }
        int dev = 0, cus = 0, per_cu = 0;
        if (hipGetDevice(&dev) != hipSuccess || hipDeviceGetAttribute(&cus, hipDeviceAttributeMultiprocessorCount, dev) != hipSuccess) { grid = -1; return; }
        if (hipFuncSetAttribute((const void*)moe_fwd, hipFuncAttributeMaxDynamicSharedMemorySize, LDS_BYTES) != hipSuccess) { fprintf(stderr, "kernel_launch: hipFuncSetAttribute failed\n"); grid = -1; return; }
        if (hipOccupancyMaxActiveBlocksPerMultiprocessor(&per_cu, (const void*)moe_fwd, NWAVES * 64, LDS_BYTES) != hipSuccess || per_cu < 1) { fprintf(stderr, "kernel_launch: occupancy query says %d\n", per_cu); per_cu = 1; }
        (void)hipGetLastError();
        grid = cus;
    }
    if (grid < 0) return;
    (void)hipMemsetAsync((char*)d_ws + WS_CTL, 0, CTL_ZERO_BYTES, stream);
    Args a{};
    for (int i = 0; i < 24; ++i) a.in[i] = (const float*)d_in[i];
    a.out = (float*)d_out; a.ws = (unsigned char*)d_ws;
#if MK_ONE_LAUNCH
    a.ph_lo = 0; a.ph_hi = NPHASE;
    hipLaunchKernelGGL(moe_fwd, dim3(grid), dim3(NWAVES * 64), LDS_BYTES, stream, a);
#else
    for (int p = 0; p < NPHASE; ++p) { a.ph_lo = p; a.ph_hi = p + 1; for (int rep = 0; rep < (((REPEAT_MASK >> p) & 1) ? 2 : 1); ++rep) hipLaunchKernelGGL(moe_fwd, dim3(grid), dim3(NWAVES * 64), LDS_BYTES, stream, a); }
#endif
}
```

```cpp
#include <hip/hip_runtime.h>
#include <cstdio>
#include <cstdint>

#ifndef MK_ONE_LAUNCH
#define MK_ONE_LAUNCH 1
#endif
#ifndef REPEAT_MASK
#define REPEAT_MASK 0
#endif
#define GC_P1 160
#define GC_P12 216

#define LAS __attribute__((address_space(3)))
#define GAS __attribute__((address_space(1)))
typedef unsigned short bf16_t;
typedef short bf16x8 __attribute__((ext_vector_type(8)));
typedef short s16x4 __attribute__((ext_vector_type(4)));
typedef float f32x4 __attribute__((ext_vector_type(4)));
typedef float f32x2 __attribute__((ext_vector_type(2)));
typedef unsigned u32x4 __attribute__((ext_vector_type(4)));
typedef unsigned u32x2 __attribute__((ext_vector_type(2)));
typedef int v8i32 __attribute__((ext_vector_type(8)));
typedef int v6i32 __attribute__((ext_vector_type(6)));
typedef unsigned u32x3 __attribute__((ext_vector_type(3)));
typedef float f32x16 __attribute__((ext_vector_type(16)));

constexpr int S = 8192, D = 2048, MEM = 256;
constexpr int SBH = 8, HD = 128, SBW = 1024, POOLW = 1024, INW = 4096, NP1 = 8192;
constexpr int XAH = 4, XAW = 512;
constexpr int NE = 32, TOPK = 4, DFF = 2048, NK = S * TOPK, EBLK = 256, MAXBLK = NK / EBLK + NE, PROWS = MAXBLK * EBLK;
constexpr float RMS_EPS = 1e-5f;

constexpr size_t MiB = 1u << 20;
constexpr size_t WS_CTL = 0, CTL_ZERO_BYTES = 1 * MiB;
constexpr size_t WS_W1T = 2 * MiB;
constexpr size_t WS_WAT = WS_W1T + 32 * MiB;
constexpr size_t WS_WBT = WS_WAT + 4 * MiB;
constexpr size_t WS_WMT = WS_WBT + 4 * MiB;
constexpr size_t WS_PLT = WS_WMT + 8 * MiB;
constexpr size_t WS_WQT = WS_PLT + 1 * MiB;
constexpr size_t WS_WKVT = WS_WQT + 2 * MiB;
constexpr size_t WS_WOT = WS_WKVT + 4 * MiB;
constexpr size_t WS_WUPT = WS_WOT + 2 * MiB;
constexpr size_t WS_WDNT = WS_WUPT + 512 * MiB;
constexpr size_t WS_U = WS_WDNT + 256 * MiB;
constexpr size_t WS_MEMN = WS_U + 32 * MiB;
constexpr size_t WS_PG = WS_MEMN + 1 * MiB;
constexpr size_t WS_OA = WS_PG + 128 * MiB;
constexpr size_t WS_PO = WS_OA + 16 * MiB;
constexpr size_t WS_OB = WS_PO + 16 * MiB;
constexpr size_t WS_TMP = WS_OB + 16 * MiB;
constexpr size_t WS_MG = WS_TMP + 64 * MiB;
constexpr size_t WS_H1 = WS_MG + 32 * MiB;
constexpr size_t WS_U2 = WS_H1 + 64 * MiB;
constexpr size_t WS_QXA = WS_U2 + 32 * MiB;
constexpr size_t WS_KVM = WS_QXA + 8 * MiB;
constexpr size_t WS_OXA = WS_KVM + 1 * MiB;
constexpr size_t WS_H2 = WS_OXA + 8 * MiB;
constexpr size_t WS_TB = WS_H2 + 64 * MiB;
constexpr size_t WS_ROWS = WS_TB + 32 * MiB;
constexpr size_t WS_ACT = WS_ROWS + 160 * MiB;
constexpr size_t WS_SLOT = WS_ACT + 160 * MiB;
constexpr size_t WS_ASGE = WS_SLOT + 128 * MiB;
constexpr size_t WS_ASGP = WS_ASGE + 1 * MiB;
constexpr size_t WS_GATE = WS_ASGP + 1 * MiB;
constexpr size_t WS_RSLOT = WS_GATE + 1 * MiB;
constexpr size_t WS_WRT = WS_RSLOT + 1 * MiB;
constexpr size_t WS_END = WS_WRT + 1 * MiB;
constexpr int CW_CNT = 64;
constexpr int CW_CUR = 192;  constexpr int CW_DONE = 256;
constexpr int CW_BAR = 4096;

constexpr int RING_BYTES = 131072;
constexpr int LDS_X_OFF = RING_BYTES;
constexpr int LDS_BYTES = 163840;
constexpr int LX_BAR = 0;
constexpr int LX_TAB = 64;
constexpr int LX_CVS = 32;
constexpr int LX_SBF = 128;
constexpr int LX_LOG = 1024;
constexpr int LX_RPART = 4096;

constexpr int NWAVES = 8;

__device__ __forceinline__ unsigned cvt_pk_bf16(float lo, float hi) { unsigned r; asm volatile("v_cvt_pk_bf16_f32 %0, %1, %2" : "=v"(r) : "v"(lo), "v"(hi)); return r; }
__device__ __forceinline__ unsigned pk4_fp8(float a, float b, float c, float d) { int p = __builtin_amdgcn_cvt_pk_fp8_f32(a, b, 0, false); p = __builtin_amdgcn_cvt_pk_fp8_f32(c, d, p, true); return (unsigned)p; }
__device__ __forceinline__ v6i32 pk32_fp6(const f32x16& lo, const f32x16& hi) { return __builtin_amdgcn_cvt_scalef32_2xpk16_fp6_f32(lo, hi, 1.0f); }
__device__ __forceinline__ void st_fp6_block(unsigned char* p, const v6i32& b) { *(u32x4*)p = (u32x4){(unsigned)b[0], (unsigned)b[1], (unsigned)b[2], (unsigned)b[3]}; *(u32x4*)(p + 64) = (u32x4){(unsigned)b[4], (unsigned)b[5], 0u, 0u}; }
__device__ __forceinline__ float bf_lo(unsigned w) { return __uint_as_float(w << 16); }
__device__ __forceinline__ float bf_hi(unsigned w) { return __uint_as_float(w & 0xffff0000u); }
__device__ __forceinline__ float wave_sum(float v) {
#pragma unroll
    for (int o = 1; o < 64; o <<= 1) v += __shfl_xor(v, o);
    return v;
}
__device__ __forceinline__ float sigmoidf_fast(float x) { return __builtin_amdgcn_rcpf(1.0f + __builtin_amdgcn_exp2f(x * -1.4426950408889634f)); }

#define XB_TMO      128
#define XB_XCNT(j)  (256  + 64 * (j))
#define XB_XSUB(j)  (1280 + 64 * (j))
#define XB_XGEN(j)  (2304 + 64 * (j))
#define XB_TOP      3328
#define XB_TOPGEN   3392
#define XCD_BAR_WORDS 3456
#define XB_SPIN_CAP (1u << 18)
__device__ __forceinline__ unsigned xb_ld(unsigned* p)              { return __hip_atomic_load(p, __ATOMIC_RELAXED, __HIP_MEMORY_SCOPE_AGENT); }
__device__ __forceinline__ unsigned xb_add(unsigned* p, unsigned v) { return __hip_atomic_fetch_add(p, v, __ATOMIC_RELAXED, __HIP_MEMORY_SCOPE_AGENT); }
__device__ __forceinline__ unsigned xb_xcc_id() { return (unsigned)__builtin_amdgcn_s_getreg((3 << 11) | 20) & 0xFu; }
#define XB_SPIN(cond, bar) do { unsigned _sp = 0; while (cond) { __builtin_amdgcn_s_sleep(1); \
    if ((++_sp & 255u) == 0u) { if (xb_ld(&(bar)[XB_TMO])) break; if (_sp > XB_SPIN_CAP) { atomicAdd(&(bar)[XB_TMO], 1u); break; } } } } while (0)
struct XcdBarrier { unsigned* bar; unsigned x; volatile LAS unsigned* st; };
__device__ __forceinline__ XcdBarrier xcd_barrier_post(unsigned* bar, volatile LAS unsigned* st) {
    XcdBarrier b; b.bar = bar; b.x = xb_xcc_id(); b.st = st;
    if (threadIdx.x == 0) (void)xb_add(&bar[XB_XCNT(b.x)], 1u);
    return b;
}
__device__ __forceinline__ void xcd_barrier_complete(unsigned* bar, unsigned x, unsigned& nloc, unsigned& nx) {
    const unsigned G = gridDim.x * gridDim.y * gridDim.z;
    unsigned sum, cnt, mine, sp = 0u;
    for (;;) {
        sum = 0u; cnt = 0u; mine = 0u;
#pragma unroll
        for (unsigned j = 0; j < 16; ++j) { const unsigned c = xb_ld(&bar[XB_XCNT(j)]); sum += c; cnt += (c > 0u) ? 1u : 0u; mine = (j == x) ? c : mine; }
        if (sum == G) break;
        __builtin_amdgcn_s_sleep(1);
        if ((++sp & 255u) == 0u) { if (xb_ld(&bar[XB_TMO])) break; if (sp > XB_SPIN_CAP) { atomicAdd(&bar[XB_TMO], 1u); break; } }
    }
    nloc = mine > 0u ? mine : 1u; nx = cnt > 0u ? cnt : 1u;
}
__device__ __forceinline__ void xcd_barrier(const XcdBarrier& b) {
    asm volatile("s_waitcnt vmcnt(0)" ::: "memory");
    __syncthreads();
    if (threadIdx.x == 0) {
        unsigned* bar = b.bar;
        __builtin_amdgcn_s_waitcnt(0);
        unsigned nloc = b.st[0], nx = b.st[1];
        if (nloc == 0u) { xcd_barrier_complete(bar, b.x, nloc, nx); b.st[0] = nloc; b.st[1] = nx; }
        const unsigned old = xb_add(&bar[XB_XSUB(b.x)], 1u);
        const unsigned gen = old / nloc;
        if (old + 1u == (gen + 1u) * nloc) {
            __builtin_amdgcn_fence(__ATOMIC_RELEASE, "agent");
            asm volatile("s_waitcnt vmcnt(0)" ::: "memory");
            const unsigned og = xb_add(&bar[XB_TOP], 1u);
            const unsigned tg = og / nx;
            if (og + 1u == (tg + 1u) * nx) xb_add(&bar[XB_TOPGEN], 1u);
            else XB_SPIN(xb_ld(&bar[XB_TOPGEN]) == tg, bar);
            __builtin_amdgcn_fence(__ATOMIC_ACQUIRE, "agent");
            xb_add(&bar[XB_XGEN(b.x)], 1u);
            asm volatile("s_waitcnt vmcnt(0)" ::: "memory");
        } else {
            XB_SPIN(xb_ld(&bar[XB_XGEN(b.x)]) == gen, bar);
            __builtin_amdgcn_fence(__ATOMIC_ACQUIRE, "agent");
            asm volatile("s_waitcnt vmcnt(0)" ::: "memory");
        }
    }
    __syncthreads();
}

namespace pg8 {
constexpr int BM = 256, BK = 64, HALF = 128, HTB = HALF * BK * 2, STAGE_BYTES = 8 * HTB, NXCD = 8, WGM = 8;
__host__ __device__ __forceinline__ int lds_byte(int r, int c) { const int st = (r >> 4) * 2 + (c >> 5), rr = r & 15, cc = c & 31, ob = rr * 64 + cc * 2; return st * 1024 + (ob ^ (((ob >> 9) & 1) << 5)); }
__host__ __device__ __forceinline__ void stage_rc(int b, int& R, int& C) { const int st = b / 1024, sb = b % 1024, swz = sb ^ (((sb >> 9) & 1) << 5); R = (st >> 1) * 16 + swz / 64; C = (st & 1) * 32 + (swz % 64) / 2; }
__host__ __device__ __forceinline__ int perm32(int rho) { const int n = rho >> 4, i = rho & 15; return 8 * (i >> 2) + 4 * n + (i & 3); }

struct Unit { const char* A; const char* B0; const char* B1; int r0, c0, x; };

__device__ __forceinline__ void tile_of(int L, int nM, int nN, int& pm, int& pn) {
    const int nwg = nM * nN; int wgid = L;
    { const int q = nwg / NXCD, r = nwg % NXCD, xcd = wgid % NXCD, off = wgid / NXCD; wgid = (xcd < r ? xcd * (q + 1) : r * (q + 1) + (xcd - r) * q) + off; }
    const int nig = WGM * nN, gid = wgid / nig, fm = gid * WGM, gsz = (nM - fm) < WGM ? (nM - fm) : WGM;
    pm = fm + ((wgid % nig) % gsz); pn = (wgid % nig) / gsz;
}
struct DenseSched {
    const char* A; const char* B; int lda, ldb, nM, nN, G, c;
    __device__ __forceinline__ bool next(int i, Unit& u) const {
        const long L = (long)i * G + c; if (L >= (long)nM * nN) return false;
        int pm, pn; tile_of((int)L, nM, nN, pm, pn);
        u.A = A + (size_t)pm * BM * lda * 2; u.B0 = B + (size_t)pn * BM * ldb * 2; u.B1 = u.B0 + (size_t)HALF * ldb * 2; u.r0 = pm * BM; u.c0 = pn * BM; u.x = 0; return true;
    }
};
struct BranchSched {
    const char* A0; const char* A1; const char* B0; const char* B1; int lda, ldb, nM, nN, G, c;
    __device__ __forceinline__ bool next(int i, Unit& u) const {
        const long L = (long)(i >> 1) * G + c; if (L >= (long)nM * nN) return false;
        int pm, pn; tile_of((int)L, nM, nN, pm, pn); const int br = i & 1;
        u.A = (br ? A1 : A0) + (size_t)pm * BM * lda * 2; u.B0 = (br ? B1 : B0) + (size_t)pn * BM * ldb * 2; u.B1 = u.B0 + (size_t)HALF * ldb * 2; u.r0 = pm * BM; u.c0 = pn * BM; u.x = br; return true;
    }
};
struct PoolSched {
    const char* A; const char* B; int G, c;
    __device__ __forceinline__ bool next(int i, Unit& u) const {
        const int L = i * G + c; if (L >= (S / BM) * 4) return false;
        const int pm = L >> 2, g = L & 3;
        u.A = A + ((size_t)pm * BM * POOLW + g * 256) * 2; u.B0 = B + (size_t)g * 256 * 256 * 2; u.B1 = u.B0 + (size_t)HALF * 256 * 2; u.r0 = pm * BM; u.c0 = g * 256; u.x = g; return true;
    }
};
struct MoeSched {
    const char* A; const char* B; int NT; size_t estride; size_t tstride; size_t hoff; const LAS int* tab; int G, c; bool gather; size_t arow;
    __device__ __forceinline__ int tu(int i) const { return __builtin_amdgcn_readfirstlane(tab[i]); }
    __device__ __forceinline__ bool next(int i, Unit& u) const {
        const int L = i * G + c; if (L >= tu(32)) return false;
        int e = 0;
#pragma unroll
        for (int s = 16; s >= 1; s >>= 1) { if (tu(e + s) <= L) e += s; }
        const int r = L - tu(e), nb = tu(66 + e), nt = r / nb, blk = r - nt * nb, prow = tu(33 + e) + blk * EBLK;
        u.A = gather ? A : A + (size_t)prow * arow; u.B0 = B + (size_t)e * estride + (size_t)nt * tstride; u.B1 = u.B0 + hoff; u.r0 = prow; u.c0 = nt; u.x = e; return true;
    }
};

template <class Epi, class Sched, bool ALIGN_EPI, bool GATHER = false, int PREC = 0>
__device__ __forceinline__ void gemm_phase(LAS unsigned char* lds, const int K, const int lda, const int ldb, const Sched& S, const Epi& E, const LAS int* gtab = nullptr) {
    const int tid = threadIdx.x, wid = __builtin_amdgcn_readfirstlane(tid >> 6), lane = tid & 63, wr = wid >> 2, wc = wid & 3, fr = lane & 15, fq = lane >> 4;
    const int nt = K / BK;
    unsigned voffB[2], vc[2][2], vn[2][2]; int RA[2], CA[2];
#pragma unroll
    for (int i = 0; i < 2; ++i) { int R, C; stage_rc(tid * 16 + i * 8192, R, C); const int Rb = Epi::PERM ? ((R & ~31) + perm32(R & 31)) : R; RA[i] = R; CA[i] = C;
        voffB[i] = (unsigned)(Rb * ldb + C) * 2u; }
#define PG8_AOFF(dst, ord) do { _Pragma("unroll") for (int _h = 0; _h < 2; ++_h) _Pragma("unroll") for (int _i = 0; _i < 2; ++_i) \
        dst[_h][_i] = GATHER ? ((unsigned)gtab[(ord) * 256 + _h * HALF + RA[_i]] * (unsigned)lda + (unsigned)CA[_i]) * 2u : (unsigned)((_h * HALF + RA[_i]) * lda + CA[_i]) * 2u; } while (0)
    const size_t kstep = (size_t)(BK * 2);
    const unsigned ldsw = (unsigned)wid * 1024u;
    const int aoff = lds_byte(wr * 64 + fr, fq * 8), boff = lds_byte(wc * 32 + fr, fq * 8);
#define PG8_SA(b, h) (((b) * 2 + (h)) * HTB)
#define PG8_SB(b, h) ((4 + (b) * 2 + (h)) * HTB)
#define PG8_STAGE(bufoff, gbase, voff) do { _Pragma("unroll") for (int _i = 0; _i < 2; ++_i) \
        __builtin_amdgcn_global_load_lds((const unsigned*)((const char*)(gbase) + (voff)[_i]), (LAS unsigned*)(lds + (bufoff) + ldsw + _i * 8192), 16, 0, 0); } while (0)
#define PG8_LD6(off) __builtin_bit_cast(v6i32, __builtin_shufflevector(*(const LAS u32x4*)(lds + (off)), __builtin_shufflevector(*(const LAS u32x2*)(lds + (off) + 1024), *(const LAS u32x2*)(lds + (off) + 1024), 0, 1, -1, -1), 0, 1, 2, 3, 4, 5))
#define PG8_LD8(off) __builtin_bit_cast(v8i32, __builtin_shufflevector(*(const LAS u32x4*)(lds + (off)), *(const LAS u32x4*)(lds + (off) + 1024), 0, 1, 2, 3, 4, 5, 6, 7))
#define PG8_LDA(dst, b, h) do { if (PREC == 2) { _Pragma("unroll") for (int m = 0; m < 4; ++m) dst##6[m] = PG8_LD6(PG8_SA(b, h) + aoff + m * 2048); } \
      else if (PREC == 1) { _Pragma("unroll") for (int m = 0; m < 4; ++m) dst##8[m] = PG8_LD8(PG8_SA(b, h) + aoff + m * 2048); } \
      else { _Pragma("unroll") for (int m = 0; m < 4; ++m) _Pragma("unroll") for (int k = 0; k < 2; ++k) dst[m][k] = *(const LAS bf16x8*)(lds + PG8_SA(b, h) + aoff + m * 2048 + k * 1024); } } while (0)
#define PG8_LDB(dst, b, h) do { if (PREC == 2) { _Pragma("unroll") for (int n = 0; n < 2; ++n) dst##6[n] = PG8_LD6(PG8_SB(b, h) + boff + n * 2048); } \
      else if (PREC == 1) { _Pragma("unroll") for (int n = 0; n < 2; ++n) dst##8[n] = PG8_LD8(PG8_SB(b, h) + boff + n * 2048); } \
      else { _Pragma("unroll") for (int n = 0; n < 2; ++n) _Pragma("unroll") for (int k = 0; k < 2; ++k) dst[n][k] = *(const LAS bf16x8*)(lds + PG8_SB(b, h) + boff + n * 2048 + k * 1024); } } while (0)
#define PG8_MMA(ai, bj, At, Bt) do { __builtin_amdgcn_s_setprio(1); if (PREC == 2) { _Pragma("unroll") for (int m = 0; m < 4; ++m) _Pragma("unroll") for (int n = 0; n < 2; ++n) \
        asm volatile("v_mfma_scale_f32_16x16x128_f8f6f4 %0, %1, %2, %0, %3, %4 op_sel_hi:[0,0,0] cbsz:2 blgp:2" : "+v"(acc[ai][bj][m][n]) : "v"(Bt##6[n]), "v"(At##6[m]), "v"(sc_w), "v"(sc_a)); } \
      else if (PREC == 1) { _Pragma("unroll") for (int m = 0; m < 4; ++m) _Pragma("unroll") for (int n = 0; n < 2; ++n) \
        asm volatile("v_mfma_scale_f32_16x16x128_f8f6f4 %0, %1, %2, %0, %3, %4 op_sel_hi:[0,0,0]" : "+v"(acc[ai][bj][m][n]) : "v"(Bt##8[n]), "v"(At##8[m]), "v"(sc_w), "v"(sc_a)); } \
      else { _Pragma("unroll") for (int m = 0; m < 4; ++m) _Pragma("unroll") for (int n = 0; n < 2; ++n) _Pragma("unroll") for (int k = 0; k < 2; ++k) \
        acc[ai][bj][m][n] = __builtin_amdgcn_mfma_f32_16x16x32_bf16(Bt[n][k], At[m][k], acc[ai][bj][m][n], 0, 0, 0); } __builtin_amdgcn_s_setprio(0); } while (0)
#define PG8_WAIT_V(n) asm volatile("s_waitcnt vmcnt(" #n ")" ::: "memory")
#define PG8_WAIT_L(n) asm volatile("s_waitcnt lgkmcnt(" #n ")" ::: "memory")
#define PG8_BAR __builtin_amdgcn_s_barrier()
#define PG8_SCHED __builtin_amdgcn_sched_barrier(0)
    Unit cur, nxt; int ui = 0;
    if (!S.next(0, cur)) return;
    f32x4 acc[2][2][4][2];
#pragma unroll
    for (int a = 0; a < 2; ++a)
#pragma unroll
        for (int b = 0; b < 2; ++b)
#pragma unroll
            for (int m = 0; m < 4; ++m)
#pragma unroll
                for (int n = 0; n < 2; ++n) acc[a][b][m][n] = (f32x4){0.f, 0.f, 0.f, 0.f};
    bf16x8 At[4][2], B0[2][2], B1[2][2]; v8i32 At8[4], B08[2], B18[2]; v6i32 At6[4], B06[2], B16[2];
    const int sc_w = 121, sc_a = (PREC == 2) ? 126 : 127;
    PG8_AOFF(vc, 0);
#pragma unroll
    for (int _h = 0; _h < 2; ++_h) { vn[_h][0] = vc[_h][0]; vn[_h][1] = vc[_h][1]; }
    PG8_STAGE(PG8_SB(0, 0), cur.B0, voffB); PG8_STAGE(PG8_SB(0, 1), cur.B1, voffB); PG8_STAGE(PG8_SA(0, 0), cur.A, vc[0]); PG8_STAGE(PG8_SA(0, 1), cur.A, vc[1]);
    if (wr == 1) PG8_BAR;
    PG8_WAIT_V(2); PG8_BAR;
    PG8_STAGE(PG8_SB(1, 0), cur.B0 + kstep, voffB); PG8_STAGE(PG8_SA(1, 0), cur.A + kstep, vc[0]); PG8_STAGE(PG8_SB(1, 1), cur.B1 + kstep, voffB);
    PG8_WAIT_V(6); PG8_BAR;
    for (;;) {
        const bool has_next = S.next(ui + 1, nxt);
        if (GATHER && has_next) PG8_AOFF(vn, ui + 1);
        const char* nA = has_next ? nxt.A : cur.A; const char* nB0 = has_next ? nxt.B0 : cur.B0; const char* nB1 = has_next ? nxt.B1 : cur.B1;
#pragma nounroll
        for (int t = 0; t < nt; t += 2) {
            const bool last = (t == nt - 2);
            const char* a1 = cur.A + (size_t)(t + 1) * kstep;
            const char* a2 = last ? nA : cur.A + (size_t)(t + 2) * kstep;
            const char* b20 = last ? nB0 : cur.B0 + (size_t)(t + 2) * kstep; const char* b21 = last ? nB1 : cur.B1 + (size_t)(t + 2) * kstep;
            const char* a3 = a2 + kstep; const char* b30 = b20 + kstep; const char* b31 = b21 + kstep;
            unsigned v2[2][2];
#pragma unroll
            for (int _h = 0; _h < 2; ++_h) { v2[_h][0] = (GATHER && last) ? vn[_h][0] : vc[_h][0]; v2[_h][1] = (GATHER && last) ? vn[_h][1] : vc[_h][1]; }
            PG8_LDB(B0, 0, 0); PG8_LDB(B1, 0, 1); PG8_SCHED; PG8_LDA(At, 0, 0); PG8_STAGE(PG8_SA(1, 1), a1, vc[1]);
            PG8_WAIT_V(8); PG8_WAIT_L(0); PG8_BAR; PG8_MMA(0, 0, At, B0); PG8_MMA(0, 1, At, B1); PG8_BAR; PG8_SCHED;
            PG8_LDA(At, 0, 1); PG8_STAGE(PG8_SB(0, 0), b20, voffB); PG8_STAGE(PG8_SB(0, 1), b21, voffB); PG8_STAGE(PG8_SA(0, 0), a2, v2[0]);
            PG8_WAIT_V(8); PG8_WAIT_L(0); PG8_BAR; PG8_MMA(1, 0, At, B0); PG8_MMA(1, 1, At, B1); PG8_BAR; PG8_SCHED;
            PG8_LDB(B0, 1, 0); PG8_LDB(B1, 1, 1); PG8_SCHED; PG8_LDA(At, 1, 0); PG8_STAGE(PG8_SA(0, 1), a2, v2[1]);
            PG8_WAIT_V(8); PG8_WAIT_L(0); PG8_BAR; PG8_MMA(0, 0, At, B0); PG8_MMA(0, 1, At, B1); PG8_BAR; PG8_SCHED;
            PG8_LDA(At, 1, 1); PG8_STAGE(PG8_SB(1, 0), b30, voffB); PG8_STAGE(PG8_SB(1, 1), b31, voffB); PG8_STAGE(PG8_SA(1, 0), a3, v2[0]);
            PG8_WAIT_V(8); PG8_WAIT_L(0); PG8_BAR; PG8_MMA(1, 0, At, B0); PG8_MMA(1, 1, At, B1); PG8_BAR; PG8_SCHED;
        }
        if constexpr (ALIGN_EPI) { if (wr == 0) PG8_BAR; }
        if (PREC != 0) asm volatile("s_nop 15\n\ts_nop 15\n\ts_nop 15\n\ts_nop 15" ::: "memory");
        E(acc, cur, wr, wc, fr, fq);
        if (!has_next) break;
        bool kp = false; if constexpr (Epi::KEEPS) kp = E.keep(cur);
        if (!kp) {
#pragma unroll
        for (int a = 0; a < 2; ++a)
#pragma unroll
            for (int b = 0; b < 2; ++b)
#pragma unroll
                for (int m = 0; m < 4; ++m)
#pragma unroll
                    for (int n = 0; n < 2; ++n) acc[a][b][m][n] = (f32x4){0.f, 0.f, 0.f, 0.f}; }
        cur = nxt; ++ui;
        if (GATHER) {
#pragma unroll
            for (int _h = 0; _h < 2; ++_h) { vc[_h][0] = vn[_h][0]; vc[_h][1] = vn[_h][1]; } }
        if constexpr (ALIGN_EPI) { if (wr == 1) PG8_BAR; }
    }
    PG8_WAIT_V(0);
    if constexpr (!ALIGN_EPI) { if (wr == 0) PG8_BAR; }
    PG8_BAR;
#undef PG8_AOFF
#undef PG8_SA
#undef PG8_SB
#undef PG8_STAGE
#undef PG8_LDA
#undef PG8_LDB
#undef PG8_MMA
#undef PG8_LD8
#undef PG8_LD6
#undef PG8_WAIT_V
#undef PG8_WAIT_L
#undef PG8_BAR
#undef PG8_SCHED
}

template <int OFF>
__device__ __forceinline__ v6i32 ld6x(unsigned addr) {
    u32x4 lo; u32x2 hi;
    asm volatile("ds_read_b128 %0, %1 offset:%2" : "=v"(lo) : "v"(addr), "n"(OFF));
    asm volatile("ds_read_b64 %0, %1 offset:%2" : "=v"(hi) : "v"(addr), "n"(OFF + 1024));
    return (v6i32){(int)lo[0], (int)lo[1], (int)lo[2], (int)lo[3], (int)hi[0], (int)hi[1]};
}
template <class Epi, class Sched>
__device__ __forceinline__ void gemm_phase_db6(LAS unsigned char* lds, const int K, const int lda, const int ldb, const Sched& S, const Epi& E, const LAS int* gtab) {
    const int tid = threadIdx.x, wid = __builtin_amdgcn_readfirstlane(tid >> 6), lane = tid & 63, wr = wid >> 2, wc = wid & 3, fr = lane & 15, fq = lane >> 4;
    const int nt = K / BK;
    unsigned voffB0, vc[2][2]; const size_t bstep = (size_t)64 * ldb * 2;
    { int R, C; stage_rc(tid * 16, R, C); const int Rb = Epi::PERM ? ((R & ~31) + perm32(R & 31)) : R; voffB0 = (unsigned)(Rb * ldb + C) * 2u; }
#define DB_AOFF(dst, ord) do { _Pragma("unroll") for (int _i = 0; _i < 2; ++_i) { int _R, _C; stage_rc((int)threadIdx.x * 16 + _i * 8192, _R, _C); _Pragma("unroll") for (int _h = 0; _h < 2; ++_h) \
        dst[_h][_i] = ((unsigned)gtab[(ord) * 256 + _h * HALF + _R] * (unsigned)lda + (unsigned)_C) * 2u; } } while (0)
    const size_t kstep = (size_t)(BK * 2);
    const unsigned ldsw = (unsigned)wid * 1024u;
    const int aoff = lds_byte(wr * 64 + fr, fq * 8), boff = lds_byte(wc * 32 + fr, fq * 8);
    const unsigned aA = (unsigned)(size_t)(lds + aoff), aB = (unsigned)(size_t)(lds + 4 * HTB + boff);
#define DB_SA(b, h) (((b) * 2 + (h)) * HTB)
#define DB_SB(b, h) ((4 + (b) * 2 + (h)) * HTB)
#define DB_STAGEA(bufoff, gbase, voff) do { _Pragma("unroll") for (int _i = 0; _i < 2; ++_i) \
        __builtin_amdgcn_global_load_lds((const unsigned*)((const char*)(gbase) + (voff)[_i]), (LAS unsigned*)(lds + (bufoff) + ldsw + _i * 8192), 16, 0, 0); } while (0)
#define DB_STAGEB(bufoff, gbase) do { _Pragma("unroll") for (int _i = 0; _i < 2; ++_i) \
        __builtin_amdgcn_global_load_lds((const unsigned*)((const char*)(gbase) + (size_t)_i * bstep + voffB0), (LAS unsigned*)(lds + (bufoff) + ldsw + _i * 8192), 16, 0, 0); } while (0)
#define DB_LDA(dst, b, h) do { dst[0] = ld6x<DB_SA(b, h)>(aA); dst[1] = ld6x<DB_SA(b, h) + 2048>(aA); dst[2] = ld6x<DB_SA(b, h) + 4096>(aA); dst[3] = ld6x<DB_SA(b, h) + 6144>(aA); } while (0)
#define DB_LDB(dst, b, h) do { dst[0] = ld6x<((b) * 2 + (h)) * HTB>(aB); dst[1] = ld6x<((b) * 2 + (h)) * HTB + 2048>(aB); } while (0)
#define DB_MMA(ai, bj, At, Bt) do { __builtin_amdgcn_s_setprio(1); _Pragma("unroll") for (int m = 0; m < 4; ++m) _Pragma("unroll") for (int n = 0; n < 2; ++n) \
        asm volatile("v_mfma_scale_f32_16x16x128_f8f6f4 %0, %1, %2, %0, %3, %4 op_sel_hi:[0,0,0] cbsz:2 blgp:2" : "+v"(acc[ai][bj][m][n]) : "v"(Bt[n]), "v"(At[m]), "v"(sc_w), "v"(sc_a)); __builtin_amdgcn_s_setprio(0); } while (0)
#define DB_SYNC() do { asm volatile("s_waitcnt vmcnt(8) lgkmcnt(0)" ::: "memory"); __builtin_amdgcn_s_barrier(); } while (0)
#define DB_SCHED __builtin_amdgcn_sched_barrier(0)
    Unit cur, nxt; int ui = 0;
    if (!S.next(0, cur)) return;
    f32x4 acc[2][2][4][2];
#pragma unroll
    for (int a = 0; a < 2; ++a)
#pragma unroll
        for (int b = 0; b < 2; ++b)
#pragma unroll
            for (int m = 0; m < 4; ++m)
#pragma unroll
                for (int n = 0; n < 2; ++n) acc[a][b][m][n] = (f32x4){0.f, 0.f, 0.f, 0.f};
    v6i32 A0[4], A1[4], B0[2], B1[2];
    const int sc_w = 121, sc_a = 126;
    DB_AOFF(vc, 0);
    DB_STAGEB(DB_SB(0, 0), cur.B0); DB_STAGEB(DB_SB(0, 1), cur.B1); DB_STAGEA(DB_SA(0, 0), cur.A, vc[0]); DB_STAGEA(DB_SA(0, 1), cur.A, vc[1]);
    DB_STAGEB(DB_SB(1, 0), cur.B0 + kstep); DB_STAGEB(DB_SB(1, 1), cur.B1 + kstep); DB_STAGEA(DB_SA(1, 0), cur.A + kstep, vc[0]); DB_STAGEA(DB_SA(1, 1), cur.A + kstep, vc[1]);
    DB_SYNC();
    DB_LDB(B0, 0, 0); DB_LDB(B1, 0, 1); DB_LDA(A0, 0, 0); DB_SCHED;
    for (;;) {
        const bool has_next = S.next(ui + 1, nxt);
        const char* nA = has_next ? nxt.A : cur.A; const char* nB0 = has_next ? nxt.B0 : cur.B0; const char* nB1 = has_next ? nxt.B1 : cur.B1;
#pragma nounroll
        for (int t = 0; t < nt; t += 2) {
            const bool last = (t == nt - 2);
            const char* a2 = last ? nA : cur.A + (size_t)(t + 2) * kstep;
            const char* b20 = last ? nB0 : cur.B0 + (size_t)(t + 2) * kstep; const char* b21 = last ? nB1 : cur.B1 + (size_t)(t + 2) * kstep;
            const char* a3 = a2 + kstep; const char* b30 = b20 + kstep; const char* b31 = b21 + kstep;
            if (last && has_next) DB_AOFF(vc, ui + 1);
            DB_SYNC(); DB_STAGEB(DB_SB(0, 0), b20); DB_STAGEB(DB_SB(0, 1), b21); DB_STAGEA(DB_SA(0, 0), a2, vc[0]);
            DB_SCHED; DB_LDA(A1, 0, 1); DB_SCHED; DB_MMA(0, 0, A0, B0); DB_MMA(0, 1, A0, B1); DB_SCHED;
            DB_SYNC(); DB_STAGEA(DB_SA(0, 1), a2, vc[1]);
            DB_SCHED; DB_LDA(A0, 1, 0); DB_SCHED; DB_MMA(1, 0, A1, B0); DB_MMA(1, 1, A1, B1); DB_SCHED; DB_LDB(B0, 1, 0); DB_LDB(B1, 1, 1); DB_SCHED;
            DB_SYNC(); DB_STAGEB(DB_SB(1, 0), b30); DB_STAGEB(DB_SB(1, 1), b31); DB_STAGEA(DB_SA(1, 0), a3, vc[0]);
            DB_SCHED; DB_LDA(A1, 1, 1); DB_SCHED; DB_MMA(0, 0, A0, B0); DB_MMA(0, 1, A0, B1); DB_SCHED;
            DB_SYNC(); DB_STAGEA(DB_SA(1, 1), a3, vc[1]);
            DB_SCHED; if (!last) DB_LDA(A0, 0, 0); DB_SCHED; DB_MMA(1, 0, A1, B0); DB_MMA(1, 1, A1, B1); DB_SCHED; if (!last) { DB_LDB(B0, 0, 0); DB_LDB(B1, 0, 1); } DB_SCHED;
        }
        asm volatile("s_nop 15\n\ts_nop 15\n\ts_nop 15\n\ts_nop 15" ::: "memory");
        { const unsigned _l = (unsigned)__builtin_amdgcn_mbcnt_hi(~0u, __builtin_amdgcn_mbcnt_lo(~0u, 0u)); E(acc, cur, wr, wc, (int)(_l & 15u), (int)(_l >> 4)); }
        if (!has_next) break;
#pragma unroll
        for (int a = 0; a < 2; ++a)
#pragma unroll
            for (int b = 0; b < 2; ++b)
#pragma unroll
                for (int m = 0; m < 4; ++m)
#pragma unroll
                    for (int n = 0; n < 2; ++n) acc[a][b][m][n] = (f32x4){0.f, 0.f, 0.f, 0.f};
        cur = nxt; ++ui;
        DB_LDB(B0, 0, 0); DB_LDB(B1, 0, 1); DB_LDA(A0, 0, 0); DB_SCHED;
    }
    asm volatile("s_waitcnt vmcnt(0) lgkmcnt(0)" ::: "memory");
    __builtin_amdgcn_s_barrier();
#undef DB_AOFF
#undef DB_SA
#undef DB_SB
#undef DB_STAGEA
#undef DB_STAGEB
#undef DB_LDA
#undef DB_LDB
#undef DB_MMA
#undef DB_SYNC
#undef DB_SCHED
}

typedef f32x4 Acc[2][2][4][2];

struct EpiProj {
    static constexpr bool PERM = true, KEEPS = false;
    bf16_t* O; const float* bgate;
    __device__ __forceinline__ void operator()(Acc& acc, const Unit& u, int wr, int wc, int fr, int fq) const {
        const int row0 = u.r0 + wr * 64 + fr, col0 = u.c0 + wc * 32 + 8 * fq; const bool gate = u.c0 >= INW;
        f32x4 bv[2][2];
#pragma unroll
        for (int bj = 0; bj < 2; ++bj)
#pragma unroll
            for (int n = 0; n < 2; ++n) bv[bj][n] = gate ? *(const f32x4*)(bgate + (col0 - INW) + bj * HALF + 4 * n) : (f32x4){0.f, 0.f, 0.f, 0.f};
#pragma unroll
        for (int ai = 0; ai < 2; ++ai)
#pragma unroll
            for (int m = 0; m < 4; ++m) { bf16_t* rowp = O + (size_t)(row0 + ai * HALF + m * 16) * NP1 + col0;
#pragma unroll
                for (int bj = 0; bj < 2; ++bj) { f32x4 v0 = acc[ai][bj][m][0] + bv[bj][0], v1 = acc[ai][bj][m][1] + bv[bj][1];
                    if (gate) {
#pragma unroll
                        for (int j = 0; j < 4; ++j) { v0[j] = sigmoidf_fast(v0[j]); v1[j] = sigmoidf_fast(v1[j]); } }
                    u32x4 w; w.x = cvt_pk_bf16(v0[0], v0[1]); w.y = cvt_pk_bf16(v0[2], v0[3]); w.z = cvt_pk_bf16(v1[0], v1[1]); w.w = cvt_pk_bf16(v1[2], v1[3]);
                    *(u32x4*)(rowp + bj * HALF) = w; } }
    }
};
struct EpiBf16 {
    static constexpr bool PERM = true, KEEPS = false;
    bf16_t* O; int ldc; const float* cscale;
    __device__ __forceinline__ void operator()(Acc& acc, const Unit& u, int wr, int wc, int fr, int fq) const {
        const int row0 = u.r0 + wr * 64 + fr, col0 = u.c0 + wc * 32 + 8 * fq;
#pragma unroll
        for (int bj = 0; bj < 2; ++bj) {
            const f32x4 s0 = cscale ? *(const f32x4*)(cscale + col0 + bj * HALF) : (f32x4){1.f, 1.f, 1.f, 1.f}, s1 = cscale ? *(const f32x4*)(cscale + col0 + bj * HALF + 4) : (f32x4){1.f, 1.f, 1.f, 1.f};
#pragma unroll
            for (int ai = 0; ai < 2; ++ai)
#pragma unroll
                for (int m = 0; m < 4; ++m) { bf16_t* rowp = O + (size_t)(row0 + ai * HALF + m * 16) * ldc + col0;
                    const f32x4 v0 = acc[ai][bj][m][0] * s0, v1 = acc[ai][bj][m][1] * s1;
                    u32x4 w; w.x = cvt_pk_bf16(v0[0], v0[1]); w.y = cvt_pk_bf16(v0[2], v0[3]); w.z = cvt_pk_bf16(v1[0], v1[1]); w.w = cvt_pk_bf16(v1[2], v1[3]);
                    *(u32x4*)(rowp + bj * HALF) = w; } }
    }
};
struct EpiBranch {
    static constexpr bool PERM = true, KEEPS = true;
    const bf16_t* PG; bf16_t* MG;
    __device__ __forceinline__ bool keep(const Unit& u) const { return u.x == 0; }
    __device__ __forceinline__ void operator()(Acc& acc, const Unit& u, int wr, int wc, int fr, int fq) const {
        const int row0 = u.r0 + wr * 64 + fr, col0 = u.c0 + wc * 32 + 8 * fq; const int br = u.x;
#pragma unroll
        for (int ai = 0; ai < 2; ++ai)
#pragma unroll
            for (int m = 0; m < 4; ++m) { const size_t row = (size_t)(row0 + ai * HALF + m * 16);
#pragma unroll
                for (int bj = 0; bj < 2; ++bj) { const int col = col0 + bj * HALF;
                    const u32x4 gb = *(const u32x4*)(PG + row * NP1 + INW + D + col);
                    f32x4 h0 = {bf_lo(gb.x), bf_hi(gb.x), bf_lo(gb.y), bf_hi(gb.y)}, h1 = {bf_lo(gb.z), bf_hi(gb.z), bf_lo(gb.w), bf_hi(gb.w)};
#pragma unroll
                    for (int j = 0; j < 4; ++j) { h0[j] = fmaxf(h0[j], 1e-30f); h1[j] = fmaxf(h1[j], 1e-30f); }
                    if (br == 0) { const u32x4 ga = *(const u32x4*)(PG + row * NP1 + INW + col);
                        const f32x4 a0 = {bf_lo(ga.x), bf_hi(ga.x), bf_lo(ga.y), bf_hi(ga.y)}, a1 = {bf_lo(ga.z), bf_hi(ga.z), bf_lo(ga.w), bf_hi(ga.w)};
#pragma unroll
                        for (int j = 0; j < 4; ++j) { acc[ai][bj][m][0][j] *= a0[j] * __builtin_amdgcn_rcpf(h0[j]); acc[ai][bj][m][1][j] *= a1[j] * __builtin_amdgcn_rcpf(h1[j]); } }
                    else { const f32x4 v0 = acc[ai][bj][m][0] * h0, v1 = acc[ai][bj][m][1] * h1;
                        u32x4 w; w.x = cvt_pk_bf16(v0[0], v0[1]); w.y = cvt_pk_bf16(v0[2], v0[3]); w.z = cvt_pk_bf16(v1[0], v1[1]); w.w = cvt_pk_bf16(v1[2], v1[3]);
                        *(u32x4*)(MG + row * D + col) = w; } } }
    }
};
struct EpiResid {
    static constexpr bool PERM = false, KEEPS = false;
    const float* res; float* out; int ldc;
    __device__ __forceinline__ void operator()(Acc& acc, const Unit& u, int wr, int wc, int fr, int fq) const {
        const int row0 = u.r0 + wr * 64 + fr, col0 = u.c0 + wc * 32 + 4 * fq;
#pragma unroll
        for (int ai = 0; ai < 2; ++ai)
#pragma unroll
            for (int m = 0; m < 4; ++m) { const size_t off = (size_t)(row0 + ai * HALF + m * 16) * ldc + col0;
#pragma unroll
                for (int bj = 0; bj < 2; ++bj)
#pragma unroll
                    for (int n = 0; n < 2; ++n) { const f32x4 r = *(const f32x4*)(res + off + bj * HALF + n * 16); *(f32x4*)(out + off + bj * HALF + n * 16) = r + acc[ai][bj][m][n]; }
                asm volatile("" ::: "memory"); }
    }
};
struct EpiUp {
    static constexpr bool PERM = true, KEEPS = false;
    const float* bup; unsigned char* ACT;
    __device__ __forceinline__ void operator()(Acc& acc, const Unit& u, int wr, int wc, int fr, int fq) const {
        const int row0 = u.r0 + wr * 64 + fr, col0 = u.c0 * HALF + wc * 32 + 8 * fq; const float* be = bup + (size_t)u.x * (2 * DFF);
        f32x4 bg[2], bl[2];
#pragma unroll
        for (int n = 0; n < 2; ++n) { bg[n] = *(const f32x4*)(be + col0 + 4 * n); bl[n] = *(const f32x4*)(be + DFF + col0 + 4 * n); }
#pragma unroll
        for (int ai = 0; ai < 2; ++ai)
#pragma unroll
            for (int m = 0; m < 4; ++m) { unsigned char* rowp = ACT + (size_t)(row0 + ai * HALF + m * 16) * DFF + col0; f32x4 o[2];
#pragma unroll
                for (int n = 0; n < 2; ++n) { const f32x4 gv = acc[ai][0][m][n] + bg[n], lv = acc[ai][1][m][n] + bl[n];
#pragma unroll
                    for (int j = 0; j < 4; ++j) { const float g = fminf(gv[j], 7.0f), l = fminf(fmaxf(lv[j], -7.0f), 7.0f); o[n][j] = g * sigmoidf_fast(1.702f * g) * (l + 1.0f); } }
                u32x2 w; w.x = pk4_fp8(o[0][0], o[0][1], o[0][2], o[0][3]); w.y = pk4_fp8(o[1][0], o[1][1], o[1][2], o[1][3]);
                *(u32x2*)rowp = w; }
    }
};
struct EpiDown {
    static constexpr bool PERM = true, KEEPS = false;
    const float* bdn; const int* rslot; const float* gate; unsigned char* SLOT;
    __device__ __forceinline__ void operator()(Acc& acc, const Unit& u, int wr, int wc, int fr, int fq) const {
        const int row0 = u.r0 + wr * 64 + fr, col0 = u.c0 * BM + wc * 32 + 8 * fq; const float* be = bdn + (size_t)u.x * D;
        f32x4 bv[2][2];
#pragma unroll
        for (int bj = 0; bj < 2; ++bj)
#pragma unroll
            for (int n = 0; n < 2; ++n) bv[bj][n] = *(const f32x4*)(be + col0 + bj * HALF + 4 * n);
#pragma unroll
        for (int ai = 0; ai < 2; ++ai)
#pragma unroll
            for (int m = 0; m < 4; ++m) { const int sl = rslot[row0 + ai * HALF + m * 16];
                if (sl >= 0) { const float gt = gate[sl] * 16.0f; unsigned char* rowp = SLOT + (size_t)sl * D + col0;
#pragma unroll
                    for (int bj = 0; bj < 2; ++bj) { const f32x4 v0 = (acc[ai][bj][m][0] + bv[bj][0]) * gt, v1 = (acc[ai][bj][m][1] + bv[bj][1]) * gt;
                        u32x2 w; w.x = pk4_fp8(v0[0], v0[1], v0[2], v0[3]); w.y = pk4_fp8(v1[0], v1[1], v1[2], v1[3]);
                        *(u32x2*)(rowp + bj * HALF) = w; } } }
    }
};
}

struct Frame {
    LAS unsigned char* lds;
    int tid, lane, wave, vcu, G;
};

__device__ __forceinline__ void cvt_item_addr(const float* W, int K, int N, bf16_t* WT, int row_off, int item, int lane, const float*& src, bf16_t*& dst) {
    const int nblk = N >> 5, kb = item / nblk, nb = item - kb * nblk, kl = lane >> 3, nl = lane & 7;
    src = W + (size_t)(64 * kb + 8 * kl) * N + 32 * nb + 4 * nl; dst = WT + (size_t)(row_off + 32 * nb + 4 * nl) * K + 64 * kb + 8 * kl;
}
__device__ __forceinline__ void cvt_store(const f32x4 (&v)[8], bf16_t* dst, int K) {
#pragma unroll
    for (int i = 0; i < 4; ++i) { u32x4 o; o.x = cvt_pk_bf16(v[0][i], v[1][i]); o.y = cvt_pk_bf16(v[2][i], v[3][i]); o.z = cvt_pk_bf16(v[4][i], v[5][i]); o.w = cvt_pk_bf16(v[6][i], v[7][i]);
        *(u32x4*)(dst + (size_t)i * K) = o; }
}
__device__ __forceinline__ void cvt_store8(const f32x4 (&v)[8], unsigned char* dst, int K) {
#pragma unroll
    for (int i = 0; i < 4; ++i) { u32x2 o; o.x = pk4_fp8(v[0][i] * 64.f, v[1][i] * 64.f, v[2][i] * 64.f, v[3][i] * 64.f); o.y = pk4_fp8(v[4][i] * 64.f, v[5][i] * 64.f, v[6][i] * 64.f, v[7][i] * 64.f);
        *(u32x2*)(dst + (size_t)i * K) = o; }
}
__device__ __forceinline__ void cvt_range(const float* W, int K, int N, bf16_t* WT, int row_off, int i0, int cnt, int r, int nw, int lane) {
    int it = i0 + r; const int end = i0 + cnt;
    for (; it + nw < end; it += 2 * nw) {
        const float* s0; bf16_t* d0; const float* s1; bf16_t* d1;
        cvt_item_addr(W, K, N, WT, row_off, it, lane, s0, d0); cvt_item_addr(W, K, N, WT, row_off, it + nw, lane, s1, d1);
        f32x4 a[8], b[8];
#pragma unroll
        for (int j = 0; j < 8; ++j) a[j] = *(const f32x4*)(s0 + (size_t)j * N);
#pragma unroll
        for (int j = 0; j < 8; ++j) b[j] = *(const f32x4*)(s1 + (size_t)j * N);
        cvt_store(a, d0, K); cvt_store(b, d1, K);
    }
    if (it < end) { const float* s0; bf16_t* d0; cvt_item_addr(W, K, N, WT, row_off, it, lane, s0, d0); f32x4 a[8];
#pragma unroll
        for (int j = 0; j < 8; ++j) a[j] = *(const f32x4*)(s0 + (size_t)j * N);
        cvt_store(a, d0, K); }
}
constexpr int CV_UP = NE * (D / 64) * (2 * DFF / 32), CV_DN = NE * (DFF / 64) * (D / 32), CV_ALL = CV_UP + CV_DN;
struct MoeW { const float* w_up; const float* w_down; unsigned char* WUPT; unsigned char* WDNT; };
__device__ __forceinline__ void cvt_moe_addr(const MoeW& mw, int chunk, int w, int h, int lane, const float*& src, unsigned char*& dst, int& N) {
    const int kl = lane >> 3, nl = lane & 7;
    if (chunk < CV_UP / 64) { const int e = chunk >> 6, cc = chunk & 63, kb = 8 * (cc >> 4) + w, nb = 8 * (cc & 15) + h; N = 2 * DFF;
        src = mw.w_up + (size_t)e * D * 2 * DFF + (size_t)(64 * kb + 8 * kl) * (2 * DFF) + 32 * nb + 4 * nl; dst = mw.WUPT + (size_t)e * 2 * DFF * D + (size_t)(32 * nb + 4 * nl) * D + 64 * kb + 8 * kl; }
    else { const int q = chunk - CV_UP / 64, e = q >> 5, cc = q & 31, kb = 8 * (cc >> 3) + w, nb = 8 * (cc & 7) + h; N = D;
        src = mw.w_down + (size_t)e * DFF * D + (size_t)(64 * kb + 8 * kl) * D + 32 * nb + 4 * nl; dst = mw.WDNT + (size_t)e * D * DFF + (size_t)(32 * nb + 4 * nl) * DFF + 64 * kb + 8 * kl; }
}
__device__ __forceinline__ f32x4 ld_nt(const float* p) { return __builtin_nontemporal_load((const f32x4*)p); }
constexpr int CV_WG = 64;
__device__ __forceinline__ int cvt_claim(unsigned* cursor, int cap, unsigned* done, unsigned need) {
    if (done && __hip_atomic_load(done, __ATOMIC_RELAXED, __HIP_MEMORY_SCOPE_AGENT) >= need) return CV_ALL;
    if ((int)__hip_atomic_load(cursor, __ATOMIC_RELAXED, __HIP_MEMORY_SCOPE_AGENT) >= cap) return CV_ALL;
    return (int)__hip_atomic_fetch_add(cursor, (unsigned)CV_WG, __ATOMIC_RELAXED, __HIP_MEMORY_SCOPE_AGENT);
}
__device__ __forceinline__ void cvt_pull(const MoeW& mw, unsigned* cursor, int cap, unsigned* done, unsigned need, volatile LAS int* slot, int tid, int wave, int lane) {
    __syncthreads();
    if (tid == 0) *slot = cvt_claim(cursor, cap, done, need);
    __syncthreads();
    int base = __builtin_amdgcn_readfirstlane(*slot);
    while (base < CV_ALL) {
        int nb = CV_ALL; if (tid == 0) nb = cvt_claim(cursor, cap, done, need);
        const int chunk = base >> 6;
        if (chunk < CV_UP / 64) {
            const int e = chunk >> 6, cc = chunk & 63, nb = 8 * (cc & 15) + wave, kl = lane >> 3, nl = lane & 7;
#pragma unroll 1
            for (int q = 0; q < 2; ++q) { const int kq = 2 * (cc >> 4) + q, kb32 = 8 * kq + kl;
                const float* src = mw.w_up + (size_t)e * D * 2 * DFF + (size_t)(32 * kb32) * (2 * DFF) + 32 * nb + 4 * nl;
                f32x4 a[32];
#pragma unroll
                for (int j = 0; j < 32; ++j) a[j] = ld_nt(src + (size_t)j * (2 * DFF));
                unsigned char* dst = mw.WUPT + (size_t)e * 2 * DFF * D + (size_t)(32 * nb + 4 * nl) * D + 128 * (kb32 >> 2) + 16 * (kb32 & 3);
#pragma unroll
                for (int i = 0; i < 4; ++i) { f32x16 lo, hi;
#pragma unroll
                    for (int j = 0; j < 16; ++j) { lo[j] = a[j][i] * 64.f; hi[j] = a[16 + j][i] * 64.f; }
                    st_fp6_block(dst + (size_t)i * D, pk32_fp6(lo, hi)); } }
        } else
#pragma unroll
        for (int h = 0; h < 8; h += 4) {
            const float* s0; unsigned char* d0; const float* s1; unsigned char* d1; const float* s2; unsigned char* d2; const float* s3; unsigned char* d3; int N0, N1, N2, N3;
            cvt_moe_addr(mw, chunk, wave, h, lane, s0, d0, N0); cvt_moe_addr(mw, chunk, wave, h + 1, lane, s1, d1, N1); cvt_moe_addr(mw, chunk, wave, h + 2, lane, s2, d2, N2); cvt_moe_addr(mw, chunk, wave, h + 3, lane, s3, d3, N3);
            f32x4 a[8], b[8], c[8], d[8];
#pragma unroll
            for (int j = 0; j < 8; ++j) a[j] = ld_nt(s0 + (size_t)j * N0);
#pragma unroll
            for (int j = 0; j < 8; ++j) b[j] = ld_nt(s1 + (size_t)j * N1);
#pragma unroll
            for (int j = 0; j < 8; ++j) c[j] = ld_nt(s2 + (size_t)j * N2);
#pragma unroll
            for (int j = 0; j < 8; ++j) d[j] = ld_nt(s3 + (size_t)j * N3);
            cvt_store8(a, d0, D); cvt_store8(b, d1, D); cvt_store8(c, d2, D); cvt_store8(d, d3, D);
        }
        __syncthreads();
        if (tid == 0) *slot = nb;
        __syncthreads();
        base = __builtin_amdgcn_readfirstlane(*slot);
    }
}
__device__ __forceinline__ void rms_row_to_bf16(const float* xrow, const float* gvec, bf16_t* orow, int lane) {
    const f32x4* xr = (const f32x4*)xrow + lane; f32x4 v[8]; float s = 0.f;
#pragma unroll
    for (int j = 0; j < 8; ++j) { v[j] = xr[64 * j]; s += (v[j].x * v[j].x + v[j].y * v[j].y) + (v[j].z * v[j].z + v[j].w * v[j].w); }
    const float rstd = 1.0f / sqrtf(wave_sum(s) * (1.0f / D) + RMS_EPS);
    const f32x4* gr = (const f32x4*)gvec + lane; u32x2* o8 = (u32x2*)orow + lane;
#pragma unroll
    for (int j = 0; j < 8; ++j) { const f32x4 g = gr[64 * j]; const f32x4 y = v[j] * rstd * g; u32x2 w; w.x = cvt_pk_bf16(y.x, y.y); w.y = cvt_pk_bf16(y.z, y.w); o8[64 * j] = w; }
}

__device__ __forceinline__ unsigned voff_b(unsigned row, unsigned ch) { return 256u * row + 16u * (ch ^ (((row & 3u) << 2) | ((row >> 2) & 3u))); }
__device__ __forceinline__ s16x4 vtr(const LAS unsigned char* p) { return __builtin_bit_cast(s16x4, __builtin_amdgcn_ds_read_tr16_b64_v4i16((LAS s16x4*)p)); }

__device__ __forceinline__ void sb_wg_unit(const bf16_t* PG, bf16_t* OA, int h, int qb, LAS unsigned char* lds, volatile LAS int* flags, int tid, int wave, int lane) {
    const int fr = lane & 15, fq = lane >> 4, q0w = qb * 128 + wave * 16, qi = q0w + fr;
    bf16x8 Qf[4];
    { const bf16_t* qp = PG + (size_t)qi * NP1 + h * HD + 8 * fq;
#pragma unroll
      for (int ks = 0; ks < 4; ++ks) Qf[ks] = *(const bf16x8*)(qp + 32 * ks); }
    f32x4 O[8];
#pragma unroll
    for (int db = 0; db < 8; ++db) O[db] = (f32x4){0.f, 0.f, 0.f, 0.f};
    float carry = 0.f; bool sat = false;
    const float scale = 0.08838834764831845f;
    const unsigned p = fr & 3, qq = fr >> 2;
    const int jt_hi = 2 * qb + 1, jt_w = q0w >> 6;
    const int srow = tid >> 4, sch = tid & 15;
    const bf16_t* kg = PG + (size_t)srow * NP1 + SBW + h * HD + 8 * sch;
    u32x4 kr[2], vr[2];
    __syncthreads();
    if (tid < 8) flags[tid] = 0;
    { const bf16_t* g = kg + (size_t)(jt_hi * 64) * NP1;
#pragma unroll
      for (int i = 0; i < 2; ++i) { kr[i] = *(const u32x4*)(g + (size_t)(32 * i) * NP1); vr[i] = *(const u32x4*)(g + (size_t)(32 * i) * NP1 + SBW); } }
    for (int jt = jt_hi, it = 0; jt >= 0; --jt, ++it) {
        LAS unsigned char* kb = lds + (it & 1) * 32768; LAS unsigned char* vb = kb + 16384;
#pragma unroll
        for (int i = 0; i < 2; ++i) { *(LAS u32x4*)(kb + voff_b(srow + 32 * i, sch)) = kr[i]; *(LAS u32x4*)(vb + voff_b(srow + 32 * i, sch)) = vr[i]; }
        __syncthreads();
        { int ns = 0;
#pragma unroll
          for (int w = 0; w < 8; ++w) ns += flags[w];
          if (__builtin_amdgcn_readfirstlane(ns) == 8) break; }
        if (jt > 0) { const bf16_t* g = kg + (size_t)((jt - 1) * 64) * NP1;
#pragma unroll
            for (int i = 0; i < 2; ++i) { kr[i] = *(const u32x4*)(g + (size_t)(32 * i) * NP1); vr[i] = *(const u32x4*)(g + (size_t)(32 * i) * NP1 + SBW); } }
        if (!sat && jt <= jt_w) {
            const int key0 = jt * 64;
            f32x4 z[4];
#pragma unroll
            for (int sb = 0; sb < 4; ++sb) { z[sb] = (f32x4){0.f, 0.f, 0.f, 0.f};
#pragma unroll
                for (int ks = 0; ks < 4; ++ks) { const bf16x8 kf = *(const LAS bf16x8*)(kb + voff_b(16 * sb + fr, 4 * ks + fq)); z[sb] = __builtin_amdgcn_mfma_f32_16x16x32_bf16(kf, Qf[ks], z[sb], 0, 0, 0); } }
            float sfx[4][4], g[4], lex[4], T[4];
            const bool diag = key0 + 64 > q0w;
#pragma unroll
            for (int sb = 0; sb < 4; ++sb) {
                float sp[4];
#pragma unroll
                for (int i = 0; i < 4; ++i) { const float y = z[sb][i] * (scale * 1.4426950408889634f); z[sb][i] = y;
                    sp[i] = fmaxf(y, 0.f) + __builtin_amdgcn_logf(1.0f + __builtin_amdgcn_exp2f(-fabsf(y))); }
                if (diag) {
#pragma unroll
                    for (int i = 0; i < 4; ++i) { const int key = key0 + 16 * sb + 4 * fq + i; sp[i] = (key < qi) ? sp[i] : 0.f; } }
                sfx[sb][3] = sp[3]; sfx[sb][2] = sp[2] + sfx[sb][3]; sfx[sb][1] = sp[1] + sfx[sb][2]; sfx[sb][0] = sp[0] + sfx[sb][1]; g[sb] = sfx[sb][0];
            }
#pragma unroll
            for (int sb = 0; sb < 4; ++sb) { const float x1 = __shfl_xor(g[sb], 16), x2 = __shfl_xor(g[sb], 32), x3 = __shfl_xor(g[sb], 48);
                T[sb] = (g[sb] + x1) + (x2 + x3); lex[sb] = ((fq & 1) ? 0.f : x1) + ((fq < 2) ? (x2 + x3) : 0.f); }
            float run = carry; bf16x8 Wf[2]; unsigned wpk[8];
#pragma unroll
            for (int sb = 3; sb >= 0; --sb) { const float base = run + lex[sb]; float w[4];
#pragma unroll
                for (int i = 0; i < 4; ++i) w[i] = __builtin_amdgcn_exp2f(z[sb][i] - (base + sfx[sb][i]));
                if (diag) {
#pragma unroll
                    for (int i = 0; i < 4; ++i) { const int key = key0 + 16 * sb + 4 * fq + i; w[i] = (key < qi) ? w[i] : 0.f; } }
                wpk[2 * sb] = cvt_pk_bf16(w[0], w[1]); wpk[2 * sb + 1] = cvt_pk_bf16(w[2], w[3]); run += T[sb]; }
            carry = run;
            { u32x4 a = {wpk[0], wpk[1], wpk[2], wpk[3]}, b = {wpk[4], wpk[5], wpk[6], wpk[7]}; Wf[0] = __builtin_bit_cast(bf16x8, a); Wf[1] = __builtin_bit_cast(bf16x8, b); }
#pragma unroll
            for (int db = 0; db < 8; ++db)
#pragma unroll
                for (int m = 0; m < 2; ++m) { const unsigned r1 = 32 * m + 4 * fq + qq, r2 = r1 + 16;
                    const s16x4 lo = vtr(vb + voff_b(r1, 2 * db + (p >> 1)) + 8 * (p & 1)), hi = vtr(vb + voff_b(r2, 2 * db + (p >> 1)) + 8 * (p & 1));
                    const bf16x8 vf = {lo[0], lo[1], lo[2], lo[3], hi[0], hi[1], hi[2], hi[3]};
                    O[db] = __builtin_amdgcn_mfma_f32_16x16x32_bf16(vf, Wf[m], O[db], 0, 0, 0); }
            if (__all(carry > 150.1f)) { sat = true; if (lane == 0) flags[wave] = 1; }
        }
    }
    { bf16_t* op = OA + (size_t)qi * SBW + h * HD + 4 * fq;
#pragma unroll
      for (int db = 0; db < 8; ++db) { u32x2 w; w.x = cvt_pk_bf16(O[db][0], O[db][1]); w.y = cvt_pk_bf16(O[db][2], O[db][3]); *(u32x2*)(op + 16 * db) = w; } }
}

__device__ __forceinline__ void xa_unit(const bf16_t* QXA, const bf16_t* KVM, bf16_t* OXA, int h, int qb, const LAS unsigned char* vl, int lane) {
    const int fr = lane & 15, fq = lane >> 4, q0 = qb * 16, qi = q0 + fr;
    bf16x8 Qf[4];
    { const bf16_t* qp = QXA + (size_t)qi * XAW + h * HD + 8 * fq;
#pragma unroll
      for (int ks = 0; ks < 4; ++ks) Qf[ks] = *(const bf16x8*)(qp + 32 * ks); }
    f32x4 z[16];
    { const bf16_t* kp = KVM + (size_t)fr * (2 * XAW) + h * HD + 8 * fq;
#pragma unroll
      for (int sb = 0; sb < 16; ++sb) { z[sb] = (f32x4){0.f, 0.f, 0.f, 0.f};
#pragma unroll
          for (int ks = 0; ks < 4; ++ks) { const bf16x8 kf = *(const bf16x8*)(kp + (size_t)(16 * sb) * (2 * XAW) + 32 * ks); z[sb] = __builtin_amdgcn_mfma_f32_16x16x32_bf16(kf, Qf[ks], z[sb], 0, 0, 0); } } }
    const float scale = 0.08838834764831845f * 1.4426950408889634f;
    float mx = -3.0e38f;
#pragma unroll
    for (int sb = 0; sb < 16; ++sb)
#pragma unroll
        for (int i = 0; i < 4; ++i) { z[sb][i] *= scale; mx = fmaxf(mx, z[sb][i]); }
    mx = fmaxf(mx, __shfl_xor(mx, 16)); mx = fmaxf(mx, __shfl_xor(mx, 32));
    float sum = 0.f;
#pragma unroll
    for (int sb = 0; sb < 16; ++sb)
#pragma unroll
        for (int i = 0; i < 4; ++i) { const float e = __builtin_amdgcn_exp2f(z[sb][i] - mx); z[sb][i] = e; sum += e; }
    sum += __shfl_xor(sum, 16); sum += __shfl_xor(sum, 32);
    const float inv = 1.0f / sum;
    f32x4 O[8];
#pragma unroll
    for (int db = 0; db < 8; ++db) O[db] = (f32x4){0.f, 0.f, 0.f, 0.f};
    const unsigned p = fr & 3, qq = fr >> 2;
#pragma unroll
    for (int m = 0; m < 8; ++m) {
        u32x4 a = {cvt_pk_bf16(z[2 * m][0], z[2 * m][1]), cvt_pk_bf16(z[2 * m][2], z[2 * m][3]), cvt_pk_bf16(z[2 * m + 1][0], z[2 * m + 1][1]), cvt_pk_bf16(z[2 * m + 1][2], z[2 * m + 1][3])};
        const bf16x8 Wf = __builtin_bit_cast(bf16x8, a);
#pragma unroll
        for (int db = 0; db < 8; ++db) { const unsigned r1 = 32 * m + 4 * fq + qq, r2 = r1 + 16;
            const s16x4 lo = vtr(vl + voff_b(r1, 2 * db + (p >> 1)) + 8 * (p & 1)), hi = vtr(vl + voff_b(r2, 2 * db + (p >> 1)) + 8 * (p & 1));
            const bf16x8 vf = {lo[0], lo[1], lo[2], lo[3], hi[0], hi[1], hi[2], hi[3]};
            O[db] = __builtin_amdgcn_mfma_f32_16x16x32_bf16(vf, Wf, O[db], 0, 0, 0); }
    }
    { bf16_t* op = OXA + (size_t)qi * XAW + h * HD + 4 * fq;
#pragma unroll
      for (int db = 0; db < 8; ++db) { const f32x4 o = O[db] * inv; u32x2 w; w.x = cvt_pk_bf16(o[0], o[1]); w.y = cvt_pk_bf16(o[2], o[3]); *(u32x2*)(op + 16 * db) = w; } }
}

template <int W>
__device__ __forceinline__ void pool_run(const bf16_t* PG, bf16_t* PO, int t0, int ch) {
    constexpr int NR = W + 7;
    const bf16_t* pp = PG + (size_t)(t0 + 7) * NP1 + 3 * SBW + ch * 8;
    u32x4 v[NR];
#pragma unroll
    for (int k = 0; k < NR; ++k) v[k] = (t0 + 7 - k >= 0) ? *(const u32x4*)(pp - (size_t)k * NP1) : (u32x4){0u, 0u, 0u, 0u};
#pragma unroll
    for (int i = 0; i < 8; ++i) {
        float s[8];
#pragma unroll
        for (int j = 0; j < 8; ++j) s[j] = 0.f;
#pragma unroll
        for (int j = W - 1; j >= 0; --j) { const u32x4 x = v[7 - i + j];
            s[0] += bf_lo(x.x); s[1] += bf_hi(x.x); s[2] += bf_lo(x.y); s[3] += bf_hi(x.y); s[4] += bf_lo(x.z); s[5] += bf_hi(x.z); s[6] += bf_lo(x.w); s[7] += bf_hi(x.w); }
        const int t = t0 + i, n = (t + 1 < W) ? (t + 1) : W; const float inv = 1.0f / (float)n; const u32x4 me = v[7 - i]; u32x4 o;
        o.x = cvt_pk_bf16(s[0] * inv - bf_lo(me.x), s[1] * inv - bf_hi(me.x)); o.y = cvt_pk_bf16(s[2] * inv - bf_lo(me.y), s[3] * inv - bf_hi(me.y));
        o.z = cvt_pk_bf16(s[4] * inv - bf_lo(me.z), s[5] * inv - bf_hi(me.z)); o.w = cvt_pk_bf16(s[6] * inv - bf_lo(me.w), s[7] * inv - bf_hi(me.w));
        *(u32x4*)(PO + (size_t)t * POOLW + ch * 8) = o;
    }
}

constexpr int NPHASE = 15;
struct Args { const float* in[24]; float* out; unsigned char* ws; int ph_lo, ph_hi; };
static_assert(sizeof(Args) == 24 * 8 + 8 + 8 + 8, "Args has no padding");

__global__ void __launch_bounds__(NWAVES * 64, 2) moe_fwd(Args args) {
    extern __shared__ __attribute__((aligned(16))) unsigned char lds_raw[];
    Frame F;
    F.lds = (LAS unsigned char*)lds_raw;
    F.tid = threadIdx.x; F.lane = F.tid & 63; F.wave = __builtin_amdgcn_readfirstlane(F.tid >> 6);
    F.G = gridDim.x; { const int bx = blockIdx.x; F.vcu = (F.G % 8 == 0) ? (bx % 8) * (F.G / 8) + bx / 8 : bx; }
    unsigned char* ws = args.ws;
    unsigned* ctl = (unsigned*)(ws + WS_CTL);
    LAS unsigned char* lx = F.lds + LDS_X_OFF;
    for (int u = F.tid; u < (LDS_BYTES - LDS_X_OFF) / 4; u += NWAVES * 64) ((LAS unsigned*)lx)[u] = 0u;
    __syncthreads();
#if MK_ONE_LAUNCH
    XcdBarrier bar = xcd_barrier_post(ctl + CW_BAR, (volatile LAS unsigned*)(lx + LX_BAR));
#define GRID_BAR() xcd_barrier(bar)
#else
#define GRID_BAR() do {} while (0)
#endif
    const int lo = args.ph_lo, hi = args.ph_hi;
#ifndef PHASE_MASK
#define PHASE_MASK 0x7fff
#endif
#define IN(k) (((PHASE_MASK >> (k)) & 1) && lo <= (k) && (k) < hi)
#define SEAM(k) do { if (IN((k) + 1)) GRID_BAR(); } while (0)

    const float* x = args.in[0]; const float* mem = args.in[1]; const float* norm_mix = args.in[2]; const float* w_in = args.in[3]; const float* pool_lin = args.in[4];
    const float* pool_scale = args.in[5]; const float* w_branch_a = args.in[6]; const float* w_branch_b = args.in[7]; const float* w_gate = args.in[8]; const float* b_gate = args.in[9];
    const float* w_mix_out = args.in[10]; const float* xa_norm = args.in[11]; const float* mem_norm = args.in[12]; const float* xa_wq = args.in[13]; const float* xa_wkv = args.in[14];
    const float* xa_wo = args.in[15]; const float* moe_norm = args.in[16]; const float* w_router = args.in[17]; const float* b_router = args.in[18]; const float* w_up = args.in[19];
    const float* b_up = args.in[20]; const float* w_down = args.in[21]; const float* b_down = args.in[22]; const float* final_norm = args.in[23];
    bf16_t* W1T = (bf16_t*)(ws + WS_W1T); bf16_t* WAT = (bf16_t*)(ws + WS_WAT); bf16_t* WBT = (bf16_t*)(ws + WS_WBT); bf16_t* WMT = (bf16_t*)(ws + WS_WMT); bf16_t* PLT = (bf16_t*)(ws + WS_PLT);
    bf16_t* WQT = (bf16_t*)(ws + WS_WQT); bf16_t* WKVT = (bf16_t*)(ws + WS_WKVT); bf16_t* WOT = (bf16_t*)(ws + WS_WOT); unsigned char* WUPT = ws + WS_WUPT; unsigned char* WDNT = ws + WS_WDNT;
    bf16_t* U = (bf16_t*)(ws + WS_U); bf16_t* MEMN = (bf16_t*)(ws + WS_MEMN); bf16_t* PG = (bf16_t*)(ws + WS_PG); bf16_t* OA = (bf16_t*)(ws + WS_OA); bf16_t* PO = (bf16_t*)(ws + WS_PO);
    bf16_t* OB = (bf16_t*)(ws + WS_OB); float* TMP = (float*)(ws + WS_TMP); bf16_t* MG = (bf16_t*)(ws + WS_MG); float* H1 = (float*)(ws + WS_H1); bf16_t* U2 = (bf16_t*)(ws + WS_U2);
    bf16_t* QXA = (bf16_t*)(ws + WS_QXA); bf16_t* KVM = (bf16_t*)(ws + WS_KVM); bf16_t* OXA = (bf16_t*)(ws + WS_OXA); float* H2 = (float*)(ws + WS_H2); unsigned char* TB = ws + WS_TB;
    bf16_t* ROWS = (bf16_t*)(ws + WS_ROWS); unsigned char* ACT = ws + WS_ACT; unsigned char* SLOT = ws + WS_SLOT;
    int* ASGE = (int*)(ws + WS_ASGE); int* ASGP = (int*)(ws + WS_ASGP); float* GATE = (float*)(ws + WS_GATE); int* RSLOT = (int*)(ws + WS_RSLOT);
    int* CNT = (int*)(ctl + CW_CNT); bf16_t* WRT = (bf16_t*)(ws + WS_WRT);
    const int gw = F.vcu * NWAVES + F.wave, NGW = F.G * NWAVES;
    const MoeW mw{w_up, w_down, WUPT, WDNT};
    unsigned* CUR = ctl + CW_CUR; volatile LAS int* cvs = (volatile LAS int*)(lx + LX_CVS);
#define CVT_PULL(cap) cvt_pull(mw, CUR, (cap), nullptr, 0u, cvs, F.tid, F.wave, F.lane)
#define CVT_BESIDE(cap, ph, need) cvt_pull(mw, CUR, (cap), ctl + CW_DONE + 64 * (ph), (unsigned)(need), cvs, F.tid, F.wave, F.lane)
#define MARK_DONE(ph) do { if (F.tid == 0) __hip_atomic_fetch_add(ctl + CW_DONE + 64 * (ph), 1u, __ATOMIC_RELAXED, __HIP_MEMORY_SCOPE_AGENT); } while (0)

    if (IN(0)) {
        constexpr int I_IN = (D / 64) * (INW / 32), I_BR = (SBW / 64) * (D / 32), I_MX = (D / 64) * (D / 32), I_PL = (256 / 64) * (256 / 32);
        constexpr int I_Q = (D / 64) * (XAW / 32), I_KV = (D / 64) * (2 * XAW / 32), I_O = (XAW / 64) * (D / 32);
        cvt_range(w_in, D, INW, W1T, 0, 0, I_IN, gw, NGW, F.lane);
        cvt_range(w_gate, D, INW, W1T, INW, 0, I_IN, gw, NGW, F.lane);
        for (int m = gw; m < S; m += NGW) rms_row_to_bf16(x + (size_t)m * D, norm_mix, U + (size_t)m * D, F.lane);
        for (int m = gw; m < MEM; m += NGW) rms_row_to_bf16(mem + (size_t)m * D, mem_norm, MEMN + (size_t)m * D, F.lane);
        for (int i = blockIdx.x * (NWAVES * 64) + F.tid; i < NE * D / 2; i += F.G * NWAVES * 64) {
            const int e = i >> 10, c = (i & 1023) * 2; const float a = w_router[(size_t)c * NE + e], b = w_router[(size_t)(c + 1) * NE + e];
            const unsigned hi = cvt_pk_bf16(a, b); const unsigned lo = cvt_pk_bf16(a - bf_lo(hi), b - bf_hi(hi));
            *(unsigned*)(WRT + (size_t)e * D + c) = hi; *(unsigned*)(WRT + (size_t)(NE + e) * D + c) = lo; }
        __syncthreads();
        SEAM(0);
    }

    if (IN(1)) {
        const int gc = (F.G == 256) ? GC_P1 : F.G;
        if ((int)blockIdx.x < gc) {
            pg8::DenseSched Sc{(const char*)U, (const char*)W1T, D, D, S / 256, NP1 / 256, gc, (int)blockIdx.x};
            pg8::EpiProj E{PG, b_gate};
            pg8::gemm_phase<pg8::EpiProj, pg8::DenseSched, true>(F.lds, D, D, D, Sc, E);
            MARK_DONE(1);
        }
        if ((int)blockIdx.x >= gc) {
            constexpr int I_BR = (SBW / 64) * (D / 32), I_MX = (D / 64) * (D / 32), I_PL = (256 / 64) * (256 / 32), I_Q = (D / 64) * (XAW / 32), I_KV = (D / 64) * (2 * XAW / 32), I_O = (XAW / 64) * (D / 32);
            const int cr = ((int)blockIdx.x - gc) * NWAVES + F.wave, cn = (F.G - gc) * NWAVES;
        cvt_range(w_branch_a, SBW, D, WAT, 0, 0, I_BR, cr, cn, F.lane);
        cvt_range(w_branch_b, POOLW, D, WBT, 0, 0, I_BR, cr, cn, F.lane);
        cvt_range(w_mix_out, D, D, WMT, 0, 0, I_MX, cr, cn, F.lane);
        for (int g = 0; g < 4; ++g) cvt_range(pool_lin + (size_t)g * 65536, 256, 256, PLT + (size_t)g * 65536, 0, 0, I_PL, cr, cn, F.lane);
        cvt_range(xa_wq, D, XAW, WQT, 0, 0, I_Q, cr, cn, F.lane);
        cvt_range(xa_wkv, D, 2 * XAW, WKVT, 0, 0, I_KV, cr, cn, F.lane);
        cvt_range(xa_wo, XAW, D, WOT, 0, 0, I_O, cr, cn, F.lane);
        }
        CVT_BESIDE(CV_UP, 1, gc);
        SEAM(1);
    }

    if (IN(2)) {
        for (int it = blockIdx.x * (NWAVES * 64) + F.tid; it < (S / 8) * (POOLW / 8); it += F.G * NWAVES * 64) {
            const int wv = it >> 6, g = wv & 3, rb = (wv >> 2) * 2 + (F.lane >> 5), ch = g * 32 + (F.lane & 31), t0 = rb * 8;
            if (g == 0) pool_run<2>(PG, PO, t0, ch); else if (g == 1) pool_run<4>(PG, PO, t0, ch); else if (g == 2) pool_run<8>(PG, PO, t0, ch); else pool_run<16>(PG, PO, t0, ch);
        }
        for (int it = F.vcu; it < SBH * (S / 128); it += F.G) { const int h = it & 7, qb = (S / 128 - 1) - (it >> 3); sb_wg_unit(PG, OA, h, qb, F.lds, (volatile LAS int*)(lx + LX_SBF), F.tid, F.wave, F.lane); }
        __syncthreads();
        SEAM(2);
    }

    if (IN(3)) {
        pg8::PoolSched Sc{(const char*)PO, (const char*)PLT, F.G, F.vcu};
        pg8::EpiBf16 E{OB, POOLW, pool_scale};
        pg8::gemm_phase<pg8::EpiBf16, pg8::PoolSched, true>(F.lds, 256, POOLW, 256, Sc, E);
        if (F.vcu < (S / 256) * 4) MARK_DONE(3);
        CVT_BESIDE(CV_UP, 3, (S / 256) * 4);
        SEAM(3);
    }

    if (IN(4)) {
        pg8::BranchSched Sc{(const char*)OA, (const char*)OB, (const char*)WAT, (const char*)WBT, SBW, SBW, S / 256, D / 256, F.G, (int)blockIdx.x};
        pg8::EpiBranch E{PG, MG};
        pg8::gemm_phase<pg8::EpiBranch, pg8::BranchSched, true>(F.lds, SBW, SBW, SBW, Sc, E);
        SEAM(4);
    }

    if (IN(5)) {
        pg8::DenseSched Sc{(const char*)MG, (const char*)WMT, D, D, S / 256, D / 256, F.G, (int)blockIdx.x};
        pg8::EpiResid E{x, H1, D};
        pg8::gemm_phase<pg8::EpiResid, pg8::DenseSched, true>(F.lds, D, D, D, Sc, E);
        SEAM(5);
    }

    if (IN(6)) {
        for (int m = gw; m < S; m += NGW) rms_row_to_bf16(H1 + (size_t)m * D, xa_norm, U2 + (size_t)m * D, F.lane);
        SEAM(6);
    }

    if (IN(7)) {
        { pg8::DenseSched Sc{(const char*)U2, (const char*)WQT, D, D, S / 256, XAW / 256, F.G, (int)blockIdx.x};
          pg8::EpiBf16 E{QXA, XAW, nullptr};
          pg8::gemm_phase<pg8::EpiBf16, pg8::DenseSched, true>(F.lds, D, D, D, Sc, E); }
        { const int c2 = ((int)blockIdx.x >= 64) ? (int)blockIdx.x - 64 : (int)blockIdx.x + F.G - 64;
          pg8::DenseSched Sc{(const char*)MEMN, (const char*)WKVT, D, D, MEM / 256, 2 * XAW / 256, F.G, c2};
          pg8::EpiBf16 E{KVM, 2 * XAW, nullptr};
          pg8::gemm_phase<pg8::EpiBf16, pg8::DenseSched, true>(F.lds, D, D, D, Sc, E); }
        if ((int)blockIdx.x < 68) MARK_DONE(7);
        CVT_BESIDE(CV_UP, 7, 68);
        SEAM(7);
    }

    if (IN(8)) {
        for (int it = F.vcu; it < XAH * (S / 128); it += F.G) {
            const int h = it & 3, qg = it >> 2;
            __syncthreads();
#pragma unroll
            for (int t = 0; t < 8; ++t) { const int c = t * 512 + F.tid, row = c >> 4, ch = c & 15;
                const u32x4 vv = *(const u32x4*)(KVM + (size_t)row * (2 * XAW) + XAW + h * HD + 8 * ch); *(LAS u32x4*)(F.lds + voff_b(row, ch)) = vv; }
            __syncthreads();
            xa_unit(QXA, KVM, OXA, h, qg * 8 + F.wave, F.lds, F.lane);
        }
        __syncthreads();
        SEAM(8);
    }

    if (IN(9)) {
        pg8::DenseSched Sc{(const char*)OXA, (const char*)WOT, XAW, XAW, S / 256, D / 256, F.G, (int)blockIdx.x};
        pg8::EpiResid E{H1, H2, D};
        pg8::gemm_phase<pg8::EpiResid, pg8::DenseSched, true>(F.lds, XAW, XAW, XAW, Sc, E);
        SEAM(9);
    }

    if (IN(10)) {
        for (int i = blockIdx.x * (NWAVES * 64) + F.tid; i < PROWS; i += F.G * NWAVES * 64) RSLOT[i] = -1;
        LAS unsigned char* thi = F.lds;
        LAS float* lg = (LAS float*)(lx + LX_LOG);
        LAS float* part = (LAS float*)(lx + LX_RPART);
        for (int rg = F.vcu; rg < S / 16; rg += F.G) {
            __syncthreads();
#pragma unroll
            for (int rr = 0; rr < 2; ++rr) { const int r = 2 * F.wave + rr, m = rg * 16 + r;
                const f32x4* xr = (const f32x4*)(H2 + (size_t)m * D) + F.lane; f32x4 v[8]; float s = 0.f;
#pragma unroll
                for (int j = 0; j < 8; ++j) { v[j] = xr[64 * j]; s += (v[j].x * v[j].x + v[j].y * v[j].y) + (v[j].z * v[j].z + v[j].w * v[j].w); }
                const float rstd = 1.0f / sqrtf(wave_sum(s) * (1.0f / D) + RMS_EPS);
                const f32x4* gr = (const f32x4*)moe_norm + F.lane;
#pragma unroll
                for (int j = 0; j < 8; ++j) { const f32x4 g = gr[64 * j]; const f32x4 y = v[j] * rstd * g; u32x2 w; w.x = cvt_pk_bf16(y.x, y.y); w.y = cvt_pk_bf16(y.z, y.w);
                    u32x2 l; l.x = cvt_pk_bf16(y.x - bf_lo(w.x), y.y - bf_hi(w.x)); l.y = cvt_pk_bf16(y.z - bf_lo(w.y), y.w - bf_hi(w.y));
                    const unsigned off = (unsigned)r * 4096u + ((((unsigned)F.lane >> 1) + 32u * j) ^ (unsigned)r) * 16u + (F.lane & 1) * 8u;
                    *(LAS u32x2*)(thi + off) = w; *(LAS u32x2*)(thi + 65536 + off) = l; } }
            __syncthreads();
#pragma unroll
            for (int q = 0; q < 2; ++q) { const int blk = F.tid + 512 * q, r = blk >> 6, kb32 = blk & 63; f32x16 lo, hi;
#pragma unroll
                for (int c4 = 0; c4 < 4; ++c4) { const u32x4 v = *(const LAS u32x4*)(thi + r * 4096 + ((unsigned)((4 * kb32 + c4) ^ r) * 16u));
                    const float f[8] = {bf_lo(v.x), bf_hi(v.x), bf_lo(v.y), bf_hi(v.y), bf_lo(v.z), bf_hi(v.z), bf_lo(v.w), bf_hi(v.w)};
#pragma unroll
                    for (int j = 0; j < 8; ++j) { if (c4 < 2) lo[8 * c4 + j] = f[j] * 2.0f; else hi[8 * (c4 - 2) + j] = f[j] * 2.0f; } }
                st_fp6_block(TB + (size_t)(rg * 16 + r) * D + 128 * (kb32 >> 2) + 16 * (kb32 & 3), pk32_fp6(lo, hi)); }
            { const int fr = F.lane & 15, fq = F.lane >> 4; f32x4 c0 = {0.f, 0.f, 0.f, 0.f}, c1 = {0.f, 0.f, 0.f, 0.f};
              const bf16_t* wh = WRT + (size_t)fr * D + 256 * F.wave + 8 * fq;
#pragma unroll
              for (int st = 0; st < 8; ++st) { const unsigned ch = (unsigned)(32 * F.wave + 4 * st + fq);
                  const bf16x8 ah = *(const LAS bf16x8*)(thi + fr * 4096 + ((ch ^ (unsigned)fr) * 16u)), al = *(const LAS bf16x8*)(thi + 65536 + fr * 4096 + ((ch ^ (unsigned)fr) * 16u));
                  const bf16x8 bh0 = *(const bf16x8*)(wh + 32 * st), bh1 = *(const bf16x8*)(wh + (size_t)16 * D + 32 * st), bl0 = *(const bf16x8*)(wh + (size_t)NE * D + 32 * st), bl1 = *(const bf16x8*)(wh + (size_t)(NE + 16) * D + 32 * st);
                  c0 = __builtin_amdgcn_mfma_f32_16x16x32_bf16(ah, bh0, c0, 0, 0, 0); c1 = __builtin_amdgcn_mfma_f32_16x16x32_bf16(ah, bh1, c1, 0, 0, 0);
                  c0 = __builtin_amdgcn_mfma_f32_16x16x32_bf16(ah, bl0, c0, 0, 0, 0); c1 = __builtin_amdgcn_mfma_f32_16x16x32_bf16(ah, bl1, c1, 0, 0, 0);
                  c0 = __builtin_amdgcn_mfma_f32_16x16x32_bf16(al, bh0, c0, 0, 0, 0); c1 = __builtin_amdgcn_mfma_f32_16x16x32_bf16(al, bh1, c1, 0, 0, 0); }
#pragma unroll
              for (int i = 0; i < 4; ++i) { part[(F.wave * 16 + 4 * fq + i) * 32 + fr] = c0[i]; part[(F.wave * 16 + 4 * fq + i) * 32 + 16 + fr] = c1[i]; } }
            __syncthreads();
            { const int r = F.tid >> 5, e = F.tid & 31; float a = 0.f;
#pragma unroll
              for (int w = 0; w < 8; ++w) a += part[(w * 16 + r) * 32 + e];
              lg[r * 32 + e] = a + b_router[e]; }
            __syncthreads();
            if (F.tid < 16) { const int r = F.tid, m = rg * 16 + r; float l[32];
#pragma unroll
                for (int e = 0; e < 32; ++e) l[e] = lg[r * 32 + e];
                int idx[4]; float val[4]; unsigned taken = 0u;
#pragma unroll
                for (int k = 0; k < 4; ++k) { float best = -3.4e38f; int bi = 0;
#pragma unroll
                    for (int e = 0; e < 32; ++e) { const bool ok = !((taken >> e) & 1u) && (l[e] > best); best = ok ? l[e] : best; bi = ok ? e : bi; }
                    idx[k] = bi; val[k] = best; taken |= 1u << bi; }
                const float e0 = 1.0f, e1 = expf(val[1] - val[0]), e2 = expf(val[2] - val[0]), e3 = expf(val[3] - val[0]); const float inv = 1.0f / (((e0 + e1) + e2) + e3);
                const float gk[4] = {e0 * inv, e1 * inv, e2 * inv, e3 * inv};
#pragma unroll
                for (int k = 0; k < 4; ++k) { const int pos = atomicAdd(CNT + idx[k], 1); ASGE[m * 4 + k] = idx[k]; ASGP[m * 4 + k] = pos; GATE[m * 4 + k] = gk[k]; } }
        }
        __syncthreads();
        SEAM(10);
    }

    LAS int* tab = (LAS int*)(lx + LX_TAB);
#define BUILD_TAB(NT) do { __syncthreads(); if (F.tid == 0) { int us = 0, ps = 0; for (int e = 0; e < NE; ++e) { const int c = CNT[e], nb = (c + EBLK - 1) / EBLK; tab[e] = us; tab[33 + e] = ps; tab[66 + e] = nb > 0 ? nb : 1; us += nb * (NT); ps += nb * EBLK; } tab[32] = us; tab[65] = ps; } __syncthreads(); } while (0)

    if (IN(11)) {
        BUILD_TAB(1);
        for (int s = blockIdx.x * (NWAVES * 64) + F.tid; s < NK; s += F.G * NWAVES * 64) { const int e = ASGE[s], pos = ASGP[s]; RSLOT[tab[33 + e] + pos] = s; }
        CVT_PULL(CV_UP);
        SEAM(11);
    }

    if (IN(12)) {
        BUILD_TAB(16);
        const int gc = (F.G == 256) ? GC_P12 : F.G; const int bx = (int)blockIdx.x;
        if ((bx >> 3) < (gc >> 3) || F.G != 256) {
            pg8::MoeSched Sc{(const char*)TB, (const char*)WUPT, 16, (size_t)2 * DFF * D, (size_t)128 * D, (size_t)DFF * D, tab, gc, (F.G == 256) ? (bx & 7) * (gc >> 3) + (bx >> 3) : F.vcu, true, (size_t)D};
            pg8::EpiUp E{b_up, ACT};
            LAS int* gtab = (LAS int*)(lx + LX_RPART);
            { pg8::Unit uu; for (int i = 0; i < 16 && Sc.next(i, uu); ++i) if (F.tid < 256) { const int sl = RSLOT[uu.r0 + F.tid]; gtab[i * 256 + F.tid] = (sl < 0 ? 0 : sl) >> 2; } }
            __syncthreads();
            pg8::gemm_phase_db6<pg8::EpiUp, pg8::MoeSched>(F.lds, D / 2, D / 2, D / 2, Sc, E, gtab);
            MARK_DONE(12);
        }
        CVT_BESIDE(CV_ALL, 12, gc);
        CVT_PULL(CV_ALL);
        SEAM(12);
    }

    if (IN(13)) {
        BUILD_TAB(8);
        pg8::MoeSched Sc{(const char*)ACT, (const char*)WDNT, 8, (size_t)D * DFF, (size_t)256 * DFF, (size_t)128 * DFF, tab, F.G, F.vcu, false, (size_t)DFF};
        pg8::EpiDown E{b_down, RSLOT, GATE, SLOT};
        pg8::gemm_phase<pg8::EpiDown, pg8::MoeSched, true, false, 1>(F.lds, DFF / 2, DFF / 2, DFF / 2, Sc, E);
        SEAM(13);
    }

    if (IN(14)) {
        for (int m = gw; m < S; m += NGW) {
            const f32x4* xr = (const f32x4*)(H2 + (size_t)m * D) + F.lane; f32x4 v[8]; float s = 0.f;
#pragma unroll
            for (int j = 0; j < 8; ++j) { v[j] = xr[64 * j];
#pragma unroll
                for (int k = 0; k < 4; ++k) { const int w = (int)*((const unsigned*)(SLOT + (size_t)(m * 4 + k) * D) + F.lane + 64 * j); const f32x2 lo = __builtin_amdgcn_cvt_pk_f32_fp8(w, false), hi = __builtin_amdgcn_cvt_pk_f32_fp8(w, true);
                    v[j].x += lo.x * 0.0625f; v[j].y += lo.y * 0.0625f; v[j].z += hi.x * 0.0625f; v[j].w += hi.y * 0.0625f; }
                s += (v[j].x * v[j].x + v[j].y * v[j].y) + (v[j].z * v[j].z + v[j].w * v[j].w); }
            const float rstd = 1.0f / sqrtf(wave_sum(s) * (1.0f / D) + RMS_EPS);
            const f32x4* gr = (const f32x4*)final_norm + F.lane; f32x4* o = (f32x4*)(args.out + (size_t)m * D) + F.lane;
#pragma unroll
            for (int j = 0; j < 8; ++j) o[64 * j] = v[j] * rstd * gr[64 * j];
        }
    }
#undef IN
#undef SEAM
}

extern "C" void kernel_launch(void* const* d_in, const int* in_sizes, int n_in, void* d_out, int out_size, void* d_ws, size_t ws_size, hipStream_t stream) {
    static int grid = 0;
    if (grid == 0) {
        if (n_in != 24 || out_size != S * D || ws_size < WS_END) { fprintf(stderr, "kernel_launch: unexpected shapes (n_in %d out %d ws %zu need %zu)\n", n_in, out_size, ws_size, (size_t)WS_END); grid = -1; return; }
        int dev = 0, cus = 0, per_cu = 0;
        if (hipGetDevice(&dev) != hipSuccess || hipDeviceGetAttribute(&cus, hipDeviceAttributeMultiprocessorCount, dev) != hipSuccess) { grid = -1; return; }
        if (hipFuncSetAttribute((const void*)moe_fwd, hipFuncAttributeMaxDynamicSharedMemorySize, LDS_BYTES) != hipSuccess) { fprintf(stderr, "kernel_launch: hipFuncSetAttribute failed\n"); grid = -1; return; }
        if (hipOccupancyMaxActiveBlocksPerMultiprocessor(&per_cu, (const void*)moe_fwd, NWAVES * 64, LDS_BYTES) != hipSuccess || per_cu < 1) { fprintf(stderr, "kernel_launch: occupancy query says %d\n", per_cu); per_cu = 1; }
        (void)hipGetLastError();
        grid = cus;
    }
    if (grid < 0) return;
    (void)hipMemsetAsync((char*)d_ws + WS_CTL, 0, CTL_ZERO_BYTES, stream);
    Args a{};
    for (int i = 0; i < 24; ++i) a.in[i] = (const float*)d_in[i];
    a.out = (float*)d_out; a.ws = (unsigned char*)d_ws;
#if MK_ONE_LAUNCH
    a.ph_lo = 0; a.ph_hi = NPHASE;
    hipLaunchKernelGGL(moe_fwd, dim3(grid), dim3(NWAVES * 64), LDS_BYTES, stream, a);
#else
    for (int p = 0; p < NPHASE; ++p) { a.ph_lo = p; a.ph_hi = p + 1; for (int rep = 0; rep < (((REPEAT_MASK >> p) & 1) ? 2 : 1); ++rep) hipLaunchKernelGGL(moe_fwd, dim3(grid), dim3(NWAVES * 64), LDS_BYTES, stream, a); }
#endif
}
```

```cpp
#include <hip/hip_runtime.h>
#include <cstdio>
#include <cstdint>

#ifndef MK_ONE_LAUNCH
#define MK_ONE_LAUNCH 1
#endif
#ifndef REPEAT_MASK
#define REPEAT_MASK 0
#endif
#define GC_P1 160
#define GC_P12 216

#define LAS __attribute__((address_space(3)))
#define GAS __attribute__((address_space(1)))
typedef unsigned short bf16_t;
typedef short bf16x8 __attribute__((ext_vector_type(8)));
typedef short s16x4 __attribute__((ext_vector_type(4)));
typedef float f32x4 __attribute__((ext_vector_type(4)));
typedef float f32x2 __attribute__((ext_vector_type(2)));
typedef unsigned u32x4 __attribute__((ext_vector_type(4)));
typedef unsigned u32x2 __attribute__((ext_vector_type(2)));
typedef int v8i32 __attribute__((ext_vector_type(8)));
typedef int v6i32 __attribute__((ext_vector_type(6)));
typedef unsigned u32x3 __attribute__((ext_vector_type(3)));
typedef float f32x16 __attribute__((ext_vector_type(16)));

constexpr int S = 8192, D = 2048, MEM = 256;
constexpr int SBH = 8, HD = 128, SBW = 1024, POOLW = 1024, INW = 4096, NP1 = 8192;
constexpr int XAH = 4, XAW = 512;
constexpr int NE = 32, TOPK = 4, DFF = 2048, NK = S * TOPK, EBLK = 256, MAXBLK = NK / EBLK + NE, PROWS = MAXBLK * EBLK;
constexpr float RMS_EPS = 1e-5f;

constexpr size_t MiB = 1u << 20;
constexpr size_t WS_CTL = 0, CTL_ZERO_BYTES = 1 * MiB;
constexpr size_t WS_W1T = 2 * MiB;
constexpr size_t WS_WAT = WS_W1T + 32 * MiB;
constexpr size_t WS_WBT = WS_WAT + 4 * MiB;
constexpr size_t WS_WMT = WS_WBT + 4 * MiB;
constexpr size_t WS_PLT = WS_WMT + 8 * MiB;
constexpr size_t WS_WQT = WS_PLT + 1 * MiB;
constexpr size_t WS_WKVT = WS_WQT + 2 * MiB;
constexpr size_t WS_WOT = WS_WKVT + 4 * MiB;
constexpr size_t WS_WUPT = WS_WOT + 2 * MiB;
constexpr size_t WS_WDNT = WS_WUPT + 512 * MiB;
constexpr size_t WS_U = WS_WDNT + 256 * MiB;
constexpr size_t WS_MEMN = WS_U + 32 * MiB;
constexpr size_t WS_PG = WS_MEMN + 1 * MiB;
constexpr size_t WS_OA = WS_PG + 128 * MiB;
constexpr size_t WS_PO = WS_OA + 16 * MiB;
constexpr size_t WS_OB = WS_PO + 16 * MiB;
constexpr size_t WS_TMP = WS_OB + 16 * MiB;
constexpr size_t WS_MG = WS_TMP + 64 * MiB;
constexpr size_t WS_H1 = WS_MG + 32 * MiB;
constexpr size_t WS_U2 = WS_H1 + 64 * MiB;
constexpr size_t WS_QXA = WS_U2 + 32 * MiB;
constexpr size_t WS_KVM = WS_QXA + 8 * MiB;
constexpr size_t WS_OXA = WS_KVM + 1 * MiB;
constexpr size_t WS_H2 = WS_OXA + 8 * MiB;
constexpr size_t WS_TB = WS_H2 + 64 * MiB;
constexpr size_t WS_ROWS = WS_TB + 32 * MiB;
constexpr size_t WS_ACT = WS_ROWS + 160 * MiB;
constexpr size_t WS_SLOT = WS_ACT + 160 * MiB;
constexpr size_t WS_ASGE = WS_SLOT + 128 * MiB;
constexpr size_t WS_ASGP = WS_ASGE + 1 * MiB;
constexpr size_t WS_GATE = WS_ASGP + 1 * MiB;
constexpr size_t WS_RSLOT = WS_GATE + 1 * MiB;
constexpr size_t WS_WRT = WS_RSLOT + 1 * MiB;
constexpr size_t WS_END = WS_WRT + 1 * MiB;
constexpr int CW_CNT = 64;
constexpr int CW_CUR = 192;  constexpr int CW_DONE = 256;
constexpr int CW_BAR = 4096;

constexpr int RING_BYTES = 131072;
constexpr int LDS_X_OFF = RING_BYTES;
constexpr int LDS_BYTES = 163840;
constexpr int LX_BAR = 0;
constexpr int LX_TAB = 64;
constexpr int LX_CVS = 32;
constexpr int LX_SBF = 128;
constexpr int LX_LOG = 1024;
constexpr int LX_RPART = 4096;

constexpr int NWAVES = 8;

__device__ __forceinline__ unsigned cvt_pk_bf16(float lo, float hi) { unsigned r; asm volatile("v_cvt_pk_bf16_f32 %0, %1, %2" : "=v"(r) : "v"(lo), "v"(hi)); return r; }
__device__ __forceinline__ unsigned pk4_fp8(float a, float b, float c, float d) { int p = __builtin_amdgcn_cvt_pk_fp8_f32(a, b, 0, false); p = __builtin_amdgcn_cvt_pk_fp8_f32(c, d, p, true); return (unsigned)p; }
__device__ __forceinline__ v6i32 pk32_fp6(const f32x16& lo, const f32x16& hi) { return __builtin_amdgcn_cvt_scalef32_2xpk16_fp6_f32(lo, hi, 1.0f); }
__device__ __forceinline__ void st_fp6_block(unsigned char* p, const v6i32& b) { *(u32x4*)p = (u32x4){(unsigned)b[0], (unsigned)b[1], (unsigned)b[2], (unsigned)b[3]}; *(u32x4*)(p + 64) = (u32x4){(unsigned)b[4], (unsigned)b[5], 0u, 0u}; }
__device__ __forceinline__ float bf_lo(unsigned w) { return __uint_as_float(w << 16); }
__device__ __forceinline__ float bf_hi(unsigned w) { return __uint_as_float(w & 0xffff0000u); }
__device__ __forceinline__ float wave_sum(float v) {
#pragma unroll
    for (int o = 1; o < 64; o <<= 1) v += __shfl_xor(v, o);
    return v;
}
__device__ __forceinline__ float sigmoidf_fast(float x) { return __builtin_amdgcn_rcpf(1.0f + __builtin_amdgcn_exp2f(x * -1.4426950408889634f)); }

#define XB_TMO      128
#define XB_XCNT(j)  (256  + 64 * (j))
#define XB_XSUB(j)  (1280 + 64 * (j))
#define XB_XGEN(j)  (2304 + 64 * (j))
#define XB_TOP      3328
#define XB_TOPGEN   3392
#define XCD_BAR_WORDS 3456
#define XB_SPIN_CAP (1u << 18)
__device__ __forceinline__ unsigned xb_ld(unsigned* p)              { return __hip_atomic_load(p, __ATOMIC_RELAXED, __HIP_MEMORY_SCOPE_AGENT); }
__device__ __forceinline__ unsigned xb_add(unsigned* p, unsigned v) { return __hip_atomic_fetch_add(p, v, __ATOMIC_RELAXED, __HIP_MEMORY_SCOPE_AGENT); }
__device__ __forceinline__ unsigned xb_xcc_id() { return (unsigned)__builtin_amdgcn_s_getreg((3 << 11) | 20) & 0xFu; }
#define XB_SPIN(cond, bar) do { unsigned _sp = 0; while (cond) { __builtin_amdgcn_s_sleep(1); \
    if ((++_sp & 255u) == 0u) { if (xb_ld(&(bar)[XB_TMO])) break; if (_sp > XB_SPIN_CAP) { atomicAdd(&(bar)[XB_TMO], 1u); break; } } } } while (0)
struct XcdBarrier { unsigned* bar; unsigned x; volatile LAS unsigned* st; };
__device__ __forceinline__ XcdBarrier xcd_barrier_post(unsigned* bar, volatile LAS unsigned* st) {
    XcdBarrier b; b.bar = bar; b.x = xb_xcc_id(); b.st = st;
    if (threadIdx.x == 0) (void)xb_add(&bar[XB_XCNT(b.x)], 1u);
    return b;
}
__device__ __forceinline__ void xcd_barrier_complete(unsigned* bar, unsigned x, unsigned& nloc, unsigned& nx) {
    const unsigned G = gridDim.x * gridDim.y * gridDim.z;
    unsigned sum, cnt, mine, sp = 0u;
    for (;;) {
        sum = 0u; cnt = 0u; mine = 0u;
#pragma unroll
        for (unsigned j = 0; j < 16; ++j) { const unsigned c = xb_ld(&bar[XB_XCNT(j)]); sum += c; cnt += (c > 0u) ? 1u : 0u; mine = (j == x) ? c : mine; }
        if (sum == G) break;
        __builtin_amdgcn_s_sleep(1);
        if ((++sp & 255u) == 0u) { if (xb_ld(&bar[XB_TMO])) break; if (sp > XB_SPIN_CAP) { atomicAdd(&bar[XB_TMO], 1u); break; } }
    }
    nloc = mine > 0u ? mine : 1u; nx = cnt > 0u ? cnt : 1u;
}
__device__ __forceinline__ void xcd_barrier(const XcdBarrier& b) {
    asm volatile("s_waitcnt vmcnt(0)" ::: "memory");
    __syncthreads();
    if (threadIdx.x == 0) {
        unsigned* bar = b.bar;
        __builtin_amdgcn_s_waitcnt(0);
        unsigned nloc = b.st[0], nx = b.st[1];
        if (nloc == 0u) { xcd_barrier_complete(bar, b.x, nloc, nx); b.st[0] = nloc; b.st[1] = nx; }
        const unsigned old = xb_add(&bar[XB_XSUB(b.x)], 1u);
        const unsigned gen = old / nloc;
        if (old + 1u == (gen + 1u) * nloc) {
            __builtin_amdgcn_fence(__ATOMIC_RELEASE, "agent");
            asm volatile("s_waitcnt vmcnt(0)" ::: "memory");
            const unsigned og = xb_add(&bar[XB_TOP], 1u);
            const unsigned tg = og / nx;
            if (og + 1u == (tg + 1u) * nx) xb_add(&bar[XB_TOPGEN], 1u);
            else XB_SPIN(xb_ld(&bar[XB_TOPGEN]) == tg, bar);
            __builtin_amdgcn_fence(__ATOMIC_ACQUIRE, "agent");
            xb_add(&bar[XB_XGEN(b.x)], 1u);
            asm volatile("s_waitcnt vmcnt(0)" ::: "memory");
        } else {
            XB_SPIN(xb_ld(&bar[XB_XGEN(b.x)]) == gen, bar);
            __builtin_amdgcn_fence(__ATOMIC_ACQUIRE, "agent");
            asm volatile("s_waitcnt vmcnt(0)" ::: "memory");
        }
    }
    __syncthreads();
}

namespace pg8 {
constexpr int BM = 256, BK = 64, HALF = 128, HTB = HALF * BK * 2, STAGE_BYTES = 8 * HTB, NXCD = 8, WGM = 8;
__host__ __device__ __forceinline__ int lds_byte(int r, int c) { const int st = (r >> 4) * 2 + (c >> 5), rr = r & 15, cc = c & 31, ob = rr * 64 + cc * 2; return st * 1024 + (ob ^ (((ob >> 9) & 1) << 5)); }
__host__ __device__ __forceinline__ void stage_rc(int b, int& R, int& C) { const int st = b / 1024, sb = b % 1024, swz = sb ^ (((sb >> 9) & 1) << 5); R = (st >> 1) * 16 + swz / 64; C = (st & 1) * 32 + (swz % 64) / 2; }
__host__ __device__ __forceinline__ int perm32(int rho) { const int n = rho >> 4, i = rho & 15; return 8 * (i >> 2) + 4 * n + (i & 3); }

struct Unit { const char* A; const char* B0; const char* B1; int r0, c0, x; };

__device__ __forceinline__ void tile_of(int L, int nM, int nN, int& pm, int& pn) {
    const int nwg = nM * nN; int wgid = L;
    { const int q = nwg / NXCD, r = nwg % NXCD, xcd = wgid % NXCD, off = wgid / NXCD; wgid = (xcd < r ? xcd * (q + 1) : r * (q + 1) + (xcd - r) * q) + off; }
    const int nig = WGM * nN, gid = wgid / nig, fm = gid * WGM, gsz = (nM - fm) < WGM ? (nM - fm) : WGM;
    pm = fm + ((wgid % nig) % gsz); pn = (wgid % nig) / gsz;
}
struct DenseSched {
    const char* A; const char* B; int lda, ldb, nM, nN, G, c;
    __device__ __forceinline__ bool next(int i, Unit& u) const {
        const long L = (long)i * G + c; if (L >= (long)nM * nN) return false;
        int pm, pn; tile_of((int)L, nM, nN, pm, pn);
        u.A = A + (size_t)pm * BM * lda * 2; u.B0 = B + (size_t)pn * BM * ldb * 2; u.B1 = u.B0 + (size_t)HALF * ldb * 2; u.r0 = pm * BM; u.c0 = pn * BM; u.x = 0; return true;
    }
};
struct BranchSched {
    const char* A0; const char* A1; const char* B0; const char* B1; int lda, ldb, nM, nN, G, c;
    __device__ __forceinline__ bool next(int i, Unit& u) const {
        const long L = (long)(i >> 1) * G + c; if (L >= (long)nM * nN) return false;
        int pm, pn; tile_of((int)L, nM, nN, pm, pn); const int br = i & 1;
        u.A = (br ? A1 : A0) + (size_t)pm * BM * lda * 2; u.B0 = (br ? B1 : B0) + (size_t)pn * BM * ldb * 2; u.B1 = u.B0 + (size_t)HALF * ldb * 2; u.r0 = pm * BM; u.c0 = pn * BM; u.x = br; return true;
    }
};
struct PoolSched {
    const char* A; const char* B; int G, c;
    __device__ __forceinline__ bool next(int i, Unit& u) const {
        const int L = i * G + c; if (L >= (S / BM) * 4) return false;
        const int pm = L >> 2, g = L & 3;
        u.A = A + ((size_t)pm * BM * POOLW + g * 256) * 2; u.B0 = B + (size_t)g * 256 * 256 * 2; u.B1 = u.B0 + (size_t)HALF * 256 * 2; u.r0 = pm * BM; u.c0 = g * 256; u.x = g; return true;
    }
};
struct MoeSched {
    const char* A; const char* B; int NT; size_t estride; size_t tstride; size_t hoff; const LAS int* tab; int G, c; bool gather; size_t arow;
    __device__ __forceinline__ int tu(int i) const { return __builtin_amdgcn_readfirstlane(tab[i]); }
    __device__ __forceinline__ bool next(int i, Unit& u) const {
        const int L = i * G + c; if (L >= tu(32)) return false;
        int e = 0;
#pragma unroll
        for (int s = 16; s >= 1; s >>= 1) { if (tu(e + s) <= L) e += s; }
        const int r = L - tu(e), nb = tu(66 + e), nt = r / nb, blk = r - nt * nb, prow = tu(33 + e) + blk * EBLK;
        u.A = gather ? A : A + (size_t)prow * arow; u.B0 = B + (size_t)e * estride + (size_t)nt * tstride; u.B1 = u.B0 + hoff; u.r0 = prow; u.c0 = nt; u.x = e; return true;
    }
};

template <class Epi, class Sched, bool ALIGN_EPI, bool GATHER = false, int PREC = 0>
__device__ __forceinline__ void gemm_phase(LAS unsigned char* lds, const int K, const int lda, const int ldb, const Sched& S, const Epi& E, const LAS int* gtab = nullptr) {
    const int tid = threadIdx.x, wid = __builtin_amdgcn_readfirstlane(tid >> 6), lane = tid & 63, wr = wid >> 2, wc = wid & 3, fr = lane & 15, fq = lane >> 4;
    const int nt = K / BK;
    unsigned voffB[2], vc[2][2], vn[2][2]; int RA[2], CA[2];
#pragma unroll
    for (int i = 0; i < 2; ++i) { int R, C; stage_rc(tid * 16 + i * 8192, R, C); const int Rb = Epi::PERM ? ((R & ~31) + perm32(R & 31)) : R; RA[i] = R; CA[i] = C;
        voffB[i] = (unsigned)(Rb * ldb + C) * 2u; }
#define PG8_AOFF(dst, ord) do { _Pragma("unroll") for (int _h = 0; _h < 2; ++_h) _Pragma("unroll") for (int _i = 0; _i < 2; ++_i) \
        dst[_h][_i] = GATHER ? ((unsigned)gtab[(ord) * 256 + _h * HALF + RA[_i]] * (unsigned)lda + (unsigned)CA[_i]) * 2u : (unsigned)((_h * HALF + RA[_i]) * lda + CA[_i]) * 2u; } while (0)
    const size_t kstep = (size_t)(BK * 2);
    const unsigned ldsw = (unsigned)wid * 1024u;
    const int aoff = lds_byte(wr * 64 + fr, fq * 8), boff = lds_byte(wc * 32 + fr, fq * 8);
#define PG8_SA(b, h) (((b) * 2 + (h)) * HTB)
#define PG8_SB(b, h) ((4 + (b) * 2 + (h)) * HTB)
#define PG8_STAGE(bufoff, gbase, voff) do { _Pragma("unroll") for (int _i = 0; _i < 2; ++_i) \
        __builtin_amdgcn_global_load_lds((const unsigned*)((const char*)(gbase) + (voff)[_i]), (LAS unsigned*)(lds + (bufoff) + ldsw + _i * 8192), 16, 0, 0); } while (0)
#define PG8_LD6(off) __builtin_bit_cast(v6i32, __builtin_shufflevector(*(const LAS u32x4*)(lds + (off)), __builtin_shufflevector(*(const LAS u32x2*)(lds + (off) + 1024), *(const LAS u32x2*)(lds + (off) + 1024), 0, 1, -1, -1), 0, 1, 2, 3, 4, 5))
#define PG8_LD8(off) __builtin_bit_cast(v8i32, __builtin_shufflevector(*(const LAS u32x4*)(lds + (off)), *(const LAS u32x4*)(lds + (off) + 1024), 0, 1, 2, 3, 4, 5, 6, 7))
#define PG8_LDA(dst, b, h) do { if (PREC == 2) { _Pragma("unroll") for (int m = 0; m < 4; ++m) dst##6[m] = PG8_LD6(PG8_SA(b, h) + aoff + m * 2048); } \
      else if (PREC == 1) { _Pragma("unroll") for (int m = 0; m < 4; ++m) dst##8[m] = PG8_LD8(PG8_SA(b, h) + aoff + m * 2048); } \
      else { _Pragma("unroll") for (int m = 0; m < 4; ++m) _Pragma("unroll") for (int k = 0; k < 2; ++k) dst[m][k] = *(const LAS bf16x8*)(lds + PG8_SA(b, h) + aoff + m * 2048 + k * 1024); } } while (0)
#define PG8_LDB(dst, b, h) do { if (PREC == 2) { _Pragma("unroll") for (int n = 0; n < 2; ++n) dst##6[n] = PG8_LD6(PG8_SB(b, h) + boff + n * 2048); } \
      else if (PREC == 1) { _Pragma("unroll") for (int n = 0; n < 2; ++n) dst##8[n] = PG8_LD8(PG8_SB(b, h) + boff + n * 2048); } \
      else { _Pragma("unroll") for (int n = 0; n < 2; ++n) _Pragma("unroll") for (int k = 0; k < 2; ++k) dst[n][k] = *(const LAS bf16x8*)(lds + PG8_SB(b, h) + boff + n * 2048 + k * 1024); } } while (0)
#define PG8_MMA(ai, bj, At, Bt) do { __builtin_amdgcn_s_setprio(1); if (PREC == 2) { _Pragma("unroll") for (int m = 0; m < 4; ++m) _Pragma("unroll") for (int n = 0; n < 2; ++n) \
        asm volatile("v_mfma_scale_f32_16x16x128_f8f6f4 %0, %1, %2, %0, %3, %4 op_sel_hi:[0,0,0] cbsz:2 blgp:2" : "+v"(acc[ai][bj][m][n]) : "v"(Bt##6[n]), "v"(At##6[m]), "v"(sc_w), "v"(sc_a)); } \
      else if (PREC == 1) { _Pragma("unroll") for (int m = 0; m < 4; ++m) _Pragma("unroll") for (int n = 0; n < 2; ++n) \
        asm volatile("v_mfma_scale_f32_16x16x128_f8f6f4 %0, %1, %2, %0, %3, %4 op_sel_hi:[0,0,0]" : "+v"(acc[ai][bj][m][n]) : "v"(Bt##8[n]), "v"(At##8[m]), "v"(sc_w), "v"(sc_a)); } \
      else { _Pragma("unroll") for (int m = 0; m < 4; ++m) _Pragma("unroll") for (int n = 0; n < 2; ++n) _Pragma("unroll") for (int k = 0; k < 2; ++k) \
        acc[ai][bj][m][n] = __builtin_amdgcn_mfma_f32_16x16x32_bf16(Bt[n][k], At[m][k], acc[ai][bj][m][n], 0, 0, 0); } __builtin_amdgcn_s_setprio(0); } while (0)
#define PG8_WAIT_V(n) asm volatile("s_waitcnt vmcnt(" #n ")" ::: "memory")
#define PG8_WAIT_L(n) asm volatile("s_waitcnt lgkmcnt(" #n ")" ::: "memory")
#define PG8_BAR __builtin_amdgcn_s_barrier()
#define PG8_SCHED __builtin_amdgcn_sched_barrier(0)
    Unit cur, nxt; int ui = 0;
    if (!S.next(0, cur)) return;
    f32x4 acc[2][2][4][2];
#pragma unroll
    for (int a = 0; a < 2; ++a)
#pragma unroll
        for (int b = 0; b < 2; ++b)
#pragma unroll
            for (int m = 0; m < 4; ++m)
#pragma unroll
                for (int n = 0; n < 2; ++n) acc[a][b][m][n] = (f32x4){0.f, 0.f, 0.f, 0.f};
    bf16x8 At[4][2], B0[2][2], B1[2][2]; v8i32 At8[4], B08[2], B18[2]; v6i32 At6[4], B06[2], B16[2];
    const int sc_w = 121, sc_a = (PREC == 2) ? 126 : 127;
    PG8_AOFF(vc, 0);
#pragma unroll
    for (int _h = 0; _h < 2; ++_h) { vn[_h][0] = vc[_h][0]; vn[_h][1] = vc[_h][1]; }
    PG8_STAGE(PG8_SB(0, 0), cur.B0, voffB); PG8_STAGE(PG8_SB(0, 1), cur.B1, voffB); PG8_STAGE(PG8_SA(0, 0), cur.A, vc[0]); PG8_STAGE(PG8_SA(0, 1), cur.A, vc[1]);
    if (wr == 1) PG8_BAR;
    PG8_WAIT_V(2); PG8_BAR;
    PG8_STAGE(PG8_SB(1, 0), cur.B0 + kstep, voffB); PG8_STAGE(PG8_SA(1, 0), cur.A + kstep, vc[0]); PG8_STAGE(PG8_SB(1, 1), cur.B1 + kstep, voffB);
    PG8_WAIT_V(6); PG8_BAR;
    for (;;) {
        const bool has_next = S.next(ui + 1, nxt);
        if (GATHER && has_next) PG8_AOFF(vn, ui + 1);
        const char* nA = has_next ? nxt.A : cur.A; const char* nB0 = has_next ? nxt.B0 : cur.B0; const char* nB1 = has_next ? nxt.B1 : cur.B1;
#pragma nounroll
        for (int t = 0; t < nt; t += 2) {
            const bool last = (t == nt - 2);
            const char* a1 = cur.A + (size_t)(t + 1) * kstep;
            const char* a2 = last ? nA : cur.A + (size_t)(t + 2) * kstep;
            const char* b20 = last ? nB0 : cur.B0 + (size_t)(t + 2) * kstep; const char* b21 = last ? nB1 : cur.B1 + (size_t)(t + 2) * kstep;
            const char* a3 = a2 + kstep; const char* b30 = b20 + kstep; const char* b31 = b21 + kstep;
            unsigned v2[2][2];
#pragma unroll
            for (int _h = 0; _h < 2; ++_h) { v2[_h][0] = (GATHER && last) ? vn[_h][0] : vc[_h][0]; v2[_h][1] = (GATHER && last) ? vn[_h][1] : vc[_h][1]; }
            PG8_LDB(B0, 0, 0); PG8_LDB(B1, 0, 1); PG8_SCHED; PG8_LDA(At, 0, 0); PG8_STAGE(PG8_SA(1, 1), a1, vc[1]);
            PG8_WAIT_V(8); PG8_WAIT_L(0); PG8_BAR; PG8_MMA(0, 0, At, B0); PG8_MMA(0, 1, At, B1); PG8_BAR; PG8_SCHED;
            PG8_LDA(At, 0, 1); PG8_STAGE(PG8_SB(0, 0), b20, voffB); PG8_STAGE(PG8_SB(0, 1), b21, voffB); PG8_STAGE(PG8_SA(0, 0), a2, v2[0]);
            PG8_WAIT_V(8); PG8_WAIT_L(0); PG8_BAR; PG8_MMA(1, 0, At, B0); PG8_MMA(1, 1, At, B1); PG8_BAR; PG8_SCHED;
            PG8_LDB(B0, 1, 0); PG8_LDB(B1, 1, 1); PG8_SCHED; PG8_LDA(At, 1, 0); PG8_STAGE(PG8_SA(0, 1), a2, v2[1]);
            PG8_WAIT_V(8); PG8_WAIT_L(0); PG8_BAR; PG8_MMA(0, 0, At, B0); PG8_MMA(0, 1, At, B1); PG8_BAR; PG8_SCHED;
            PG8_LDA(At, 1, 1); PG8_STAGE(PG8_SB(1, 0), b30, voffB); PG8_STAGE(PG8_SB(1, 1), b31, voffB); PG8_STAGE(PG8_SA(1, 0), a3, v2[0]);
            PG8_WAIT_V(8); PG8_WAIT_L(0); PG8_BAR; PG8_MMA(1, 0, At, B0); PG8_MMA(1, 1, At, B1); PG8_BAR; PG8_SCHED;
        }
        if constexpr (ALIGN_EPI) { if (wr == 0) PG8_BAR; }
        if (PREC != 0) asm volatile("s_nop 15\n\ts_nop 15\n\ts_nop 15\n\ts_nop 15" ::: "memory");
        E(acc, cur, wr, wc, fr, fq);
        if (!has_next) break;
        bool kp = false; if constexpr (Epi::KEEPS) kp = E.keep(cur);
        if (!kp) {
#pragma unroll
        for (int a = 0; a < 2; ++a)
#pragma unroll
            for (int b = 0; b < 2; ++b)
#pragma unroll
                for (int m = 0; m < 4; ++m)
#pragma unroll
                    for (int n = 0; n < 2; ++n) acc[a][b][m][n] = (f32x4){0.f, 0.f, 0.f, 0.f}; }
        cur = nxt; ++ui;
        if (GATHER) {
#pragma unroll
            for (int _h = 0; _h < 2; ++_h) { vc[_h][0] = vn[_h][0]; vc[_h][1] = vn[_h][1]; } }
        if constexpr (ALIGN_EPI) { if (wr == 1) PG8_BAR; }
    }
    PG8_WAIT_V(0);
    if constexpr (!ALIGN_EPI) { if (wr == 0) PG8_BAR; }
    PG8_BAR;
#undef PG8_AOFF
#undef PG8_SA
#undef PG8_SB
#undef PG8_STAGE
#undef PG8_LDA
#undef PG8_LDB
#undef PG8_MMA
#undef PG8_LD8
#undef PG8_LD6
#undef PG8_WAIT_V
#undef PG8_WAIT_L
#undef PG8_BAR
#undef PG8_SCHED
}

template <int OFF>
__device__ __forceinline__ v6i32 ld6x(unsigned addr) {
    u32x4 lo; u32x2 hi;
    asm volatile("ds_read_b128 %0, %1 offset:%2" : "=v"(lo) : "v"(addr), "n"(OFF));
    asm volatile("ds_read_b64 %0, %1 offset:%2" : "=v"(hi) : "v"(addr), "n"(OFF + 1024));
    return (v6i32){(int)lo[0], (int)lo[1], (int)lo[2], (int)lo[3], (int)hi[0], (int)hi[1]};
}
template <class Epi, class Sched>
__device__ __forceinline__ void gemm_phase_db6(LAS unsigned char* lds, const int K, const int lda, const int ldb, const Sched& S, const Epi& E, const LAS int* gtab) {
    const int tid = threadIdx.x, wid = __builtin_amdgcn_readfirstlane(tid >> 6), lane = tid & 63, wr = wid >> 2, wc = wid & 3, fr = lane & 15, fq = lane >> 4;
    const int nt = K / BK;
    unsigned voffB0, vc[2][2]; const size_t bstep = (size_t)64 * ldb * 2;
    { int R, C; stage_rc(tid * 16, R, C); const int Rb = Epi::PERM ? ((R & ~31) + perm32(R & 31)) : R; voffB0 = (unsigned)(Rb * ldb + C) * 2u; }
#define DB_AOFF(dst, ord) do { _Pragma("unroll") for (int _i = 0; _i < 2; ++_i) { int _R, _C; stage_rc((int)threadIdx.x * 16 + _i * 8192, _R, _C); _Pragma("unroll") for (int _h = 0; _h < 2; ++_h) \
        dst[_h][_i] = ((unsigned)gtab[(ord) * 256 + _h * HALF + _R] * (unsigned)lda + (unsigned)_C) * 2u; } } while (0)
    const size_t kstep = (size_t)(BK * 2);
    const unsigned ldsw = (unsigned)wid * 1024u;
    const int aoff = lds_byte(wr * 64 + fr, fq * 8), boff = lds_byte(wc * 32 + fr, fq * 8);
    const unsigned aA = (unsigned)(size_t)(lds + aoff), aB = (unsigned)(size_t)(lds + 4 * HTB + boff);
#define DB_SA(b, h) (((b) * 2 + (h)) * HTB)
#define DB_SB(b, h) ((4 + (b) * 2 + (h)) * HTB)
#define DB_STAGEA1(bufoff, gbase, voff, i) __builtin_amdgcn_global_load_lds((const unsigned*)((const char*)(gbase) + (voff)[i]), (LAS unsigned*)(lds + (bufoff) + ldsw + (i) * 8192), 16, 0, 0)
#define DB_STAGEB1(bufoff, gbase, i) __builtin_amdgcn_global_load_lds((const unsigned*)((const char*)(gbase) + (size_t)(i) * bstep + voffB0), (LAS unsigned*)(lds + (bufoff) + ldsw + (i) * 8192), 16, 0, 0)
#define DB_STAGEA(bufoff, gbase, voff) do { DB_STAGEA1(bufoff, gbase, voff, 0); DB_STAGEA1(bufoff, gbase, voff, 1); } while (0)
#define DB_STAGEB(bufoff, gbase) do { DB_STAGEB1(bufoff, gbase, 0); DB_STAGEB1(bufoff, gbase, 1); } while (0)
#define DB_LDA(dst, b, h) do { dst[0] = ld6x<DB_SA(b, h)>(aA); dst[1] = ld6x<DB_SA(b, h) + 2048>(aA); dst[2] = ld6x<DB_SA(b, h) + 4096>(aA); dst[3] = ld6x<DB_SA(b, h) + 6144>(aA); } while (0)
#define DB_LDB(dst, b, h) do { dst[0] = ld6x<((b) * 2 + (h)) * HTB>(aB); dst[1] = ld6x<((b) * 2 + (h)) * HTB + 2048>(aB); } while (0)
#define DB_MMA(ai, bj, At, Bt) do { __builtin_amdgcn_s_setprio(1); _Pragma("unroll") for (int m = 0; m < 4; ++m) _Pragma("unroll") for (int n = 0; n < 2; ++n) \
        asm volatile("v_mfma_scale_f32_16x16x128_f8f6f4 %0, %1, %2, %0, %3, %4 op_sel_hi:[0,0,0] cbsz:2 blgp:2" : "+v"(acc[ai][bj][m][n]) : "v"(Bt[n]), "v"(At[m]), "v"(sc_w), "v"(sc_a)); __builtin_amdgcn_s_setprio(0); } while (0)
#define DB_MMA4(ai, bj, mlo, At, Bt) do { __builtin_amdgcn_s_setprio(1); _Pragma("unroll") for (int m = (mlo); m < (mlo) + 2; ++m) _Pragma("unroll") for (int n = 0; n < 2; ++n) \
        asm volatile("v_mfma_scale_f32_16x16x128_f8f6f4 %0, %1, %2, %0, %3, %4 op_sel_hi:[0,0,0] cbsz:2 blgp:2" : "+v"(acc[ai][bj][m][n]) : "v"(Bt[n]), "v"(At[m]), "v"(sc_w), "v"(sc_a)); __builtin_amdgcn_s_setprio(0); } while (0)
#define DB_SYNC() do { asm volatile("s_waitcnt vmcnt(8) lgkmcnt(0)" ::: "memory"); __builtin_amdgcn_s_barrier(); } while (0)
#define DB_SYNC6() do { asm volatile("s_waitcnt vmcnt(6) lgkmcnt(0)" ::: "memory"); __builtin_amdgcn_s_barrier(); } while (0)
#define DB_STEP(ai, At, sb, sa, gb, ga, vo) do { \
        DB_STAGEB1(sb, gb, 0); DB_SCHED; DB_MMA4(ai, 0, 0, At, B0); DB_SCHED; DB_STAGEB1(sb, gb, 1); DB_SCHED; DB_MMA4(ai, 0, 2, At, B0); DB_SCHED; \
        DB_STAGEA1(sa, ga, vo, 0); DB_SCHED; DB_MMA4(ai, 1, 0, At, B1); DB_SCHED; DB_STAGEA1(sa, ga, vo, 1); DB_SCHED; DB_MMA4(ai, 1, 2, At, B1); DB_SCHED; } while (0)
#define DB_SCHED __builtin_amdgcn_sched_barrier(0)
    Unit cur, nxt; int ui = 0;
    if (!S.next(0, cur)) return;
    f32x4 acc[2][2][4][2];
#pragma unroll
    for (int a = 0; a < 2; ++a)
#pragma unroll
        for (int b = 0; b < 2; ++b)
#pragma unroll
            for (int m = 0; m < 4; ++m)
#pragma unroll
                for (int n = 0; n < 2; ++n) acc[a][b][m][n] = (f32x4){0.f, 0.f, 0.f, 0.f};
    v6i32 A0[4], A1[4], B0[2], B1[2];
    const int sc_w = 121, sc_a = 126;
    DB_AOFF(vc, 0);
    DB_STAGEB(DB_SB(0, 0), cur.B0); DB_STAGEA(DB_SA(0, 0), cur.A, vc[0]); DB_STAGEB(DB_SB(0, 1), cur.B1); DB_STAGEA(DB_SA(0, 1), cur.A, vc[1]);
    DB_STAGEB(DB_SB(1, 0), cur.B0 + kstep); DB_STAGEA(DB_SA(1, 0), cur.A + kstep, vc[0]); DB_STAGEB(DB_SB(1, 1), cur.B1 + kstep); DB_STAGEA(DB_SA(1, 1), cur.A + kstep, vc[1]);
    DB_SYNC();
    DB_LDB(B0, 0, 0); DB_LDB(B1, 0, 1); DB_LDA(A0, 0, 0); DB_SCHED;
    for (;;) {
        const bool has_next = S.next(ui + 1, nxt);
        const char* nA = has_next ? nxt.A : cur.A; const char* nB0 = has_next ? nxt.B0 : cur.B0; const char* nB1 = has_next ? nxt.B1 : cur.B1;
#pragma nounroll
        for (int t = 0; t < nt; t += 2) {
            const bool last = (t == nt - 2);
            const char* a2 = last ? nA : cur.A + (size_t)(t + 2) * kstep;
            const char* b20 = last ? nB0 : cur.B0 + (size_t)(t + 2) * kstep; const char* b21 = last ? nB1 : cur.B1 + (size_t)(t + 2) * kstep;
            const char* a3 = a2 + kstep; const char* b30 = b20 + kstep; const char* b31 = b21 + kstep;
            if (last && has_next) DB_AOFF(vc, ui + 1);
            DB_SYNC(); DB_LDA(A1, 0, 1); DB_SCHED; DB_STEP(0, A0, DB_SB(0, 0), DB_SA(0, 0), b20, a2, vc[0]);
            DB_SYNC6(); DB_LDA(A0, 1, 0); DB_SCHED; DB_STEP(1, A1, DB_SB(0, 1), DB_SA(0, 1), b21, a2, vc[1]); DB_LDB(B0, 1, 0); DB_LDB(B1, 1, 1); DB_SCHED;
            DB_SYNC(); DB_LDA(A1, 1, 1); DB_SCHED; DB_STEP(0, A0, DB_SB(1, 0), DB_SA(1, 0), b30, a3, vc[0]);
            DB_SYNC6(); if (!last) DB_LDA(A0, 0, 0); DB_SCHED; DB_STEP(1, A1, DB_SB(1, 1), DB_SA(1, 1), b31, a3, vc[1]); if (!last) { DB_LDB(B0, 0, 0); DB_LDB(B1, 0, 1); } DB_SCHED;
        }
        asm volatile("s_nop 15\n\ts_nop 15\n\ts_nop 15\n\ts_nop 15" ::: "memory");
        { const unsigned _l = (unsigned)__builtin_amdgcn_mbcnt_hi(~0u, __builtin_amdgcn_mbcnt_lo(~0u, 0u)); E(acc, cur, wr, wc, (int)(_l & 15u), (int)(_l >> 4)); }
        if (!has_next) break;
#pragma unroll
        for (int a = 0; a < 2; ++a)
#pragma unroll
            for (int b = 0; b < 2; ++b)
#pragma unroll
                for (int m = 0; m < 4; ++m)
#pragma unroll
                    for (int n = 0; n < 2; ++n) acc[a][b][m][n] = (f32x4){0.f, 0.f, 0.f, 0.f};
        cur = nxt; ++ui;
        DB_LDB(B0, 0, 0); DB_LDB(B1, 0, 1); DB_LDA(A0, 0, 0); DB_SCHED;
    }
    asm volatile("s_waitcnt vmcnt(0) lgkmcnt(0)" ::: "memory");
    __builtin_amdgcn_s_barrier();
#undef DB_AOFF
#undef DB_SA
#undef DB_SB
#undef DB_STAGEA
#undef DB_STAGEB
#undef DB_LDA
#undef DB_LDB
#undef DB_MMA
#undef DB_SYNC
#undef DB_SYNC6
#undef DB_STEP
#undef DB_MMA4
#undef DB_STAGEA1
#undef DB_STAGEB1
#undef DB_SCHED
}

typedef f32x4 Acc[2][2][4][2];

struct EpiProj {
    static constexpr bool PERM = true, KEEPS = false;
    bf16_t* O; const float* bgate;
    __device__ __forceinline__ void operator()(Acc& acc, const Unit& u, int wr, int wc, int fr, int fq) const {
        const int row0 = u.r0 + wr * 64 + fr, col0 = u.c0 + wc * 32 + 8 * fq; const bool gate = u.c0 >= INW;
        f32x4 bv[2][2];
#pragma unroll
        for (int bj = 0; bj < 2; ++bj)
#pragma unroll
            for (int n = 0; n < 2; ++n) bv[bj][n] = gate ? *(const f32x4*)(bgate + (col0 - INW) + bj * HALF + 4 * n) : (f32x4){0.f, 0.f, 0.f, 0.f};
#pragma unroll
        for (int ai = 0; ai < 2; ++ai)
#pragma unroll
            for (int m = 0; m < 4; ++m) { bf16_t* rowp = O + (size_t)(row0 + ai * HALF + m * 16) * NP1 + col0;
#pragma unroll
                for (int bj = 0; bj < 2; ++bj) { f32x4 v0 = acc[ai][bj][m][0] + bv[bj][0], v1 = acc[ai][bj][m][1] + bv[bj][1];
                    if (gate) {
#pragma unroll
                        for (int j = 0; j < 4; ++j) { v0[j] = sigmoidf_fast(v0[j]); v1[j] = sigmoidf_fast(v1[j]); } }
                    u32x4 w; w.x = cvt_pk_bf16(v0[0], v0[1]); w.y = cvt_pk_bf16(v0[2], v0[3]); w.z = cvt_pk_bf16(v1[0], v1[1]); w.w = cvt_pk_bf16(v1[2], v1[3]);
                    *(u32x4*)(rowp + bj * HALF) = w; } }
    }
};
struct EpiBf16 {
    static constexpr bool PERM = true, KEEPS = false;
    bf16_t* O; int ldc; const float* cscale;
    __device__ __forceinline__ void operator()(Acc& acc, const Unit& u, int wr, int wc, int fr, int fq) const {
        const int row0 = u.r0 + wr * 64 + fr, col0 = u.c0 + wc * 32 + 8 * fq;
#pragma unroll
        for (int bj = 0; bj < 2; ++bj) {
            const f32x4 s0 = cscale ? *(const f32x4*)(cscale + col0 + bj * HALF) : (f32x4){1.f, 1.f, 1.f, 1.f}, s1 = cscale ? *(const f32x4*)(cscale + col0 + bj * HALF + 4) : (f32x4){1.f, 1.f, 1.f, 1.f};
#pragma unroll
            for (int ai = 0; ai < 2; ++ai)
#pragma unroll
                for (int m = 0; m < 4; ++m) { bf16_t* rowp = O + (size_t)(row0 + ai * HALF + m * 16) * ldc + col0;
                    const f32x4 v0 = acc[ai][bj][m][0] * s0, v1 = acc[ai][bj][m][1] * s1;
                    u32x4 w; w.x = cvt_pk_bf16(v0[0], v0[1]); w.y = cvt_pk_bf16(v0[2], v0[3]); w.z = cvt_pk_bf16(v1[0], v1[1]); w.w = cvt_pk_bf16(v1[2], v1[3]);
                    *(u32x4*)(rowp + bj * HALF) = w; } }
    }
};
struct EpiBranch {
    static constexpr bool PERM = true, KEEPS = true;
    const bf16_t* PG; bf16_t* MG;
    __device__ __forceinline__ bool keep(const Unit& u) const { return u.x == 0; }
    __device__ __forceinline__ void operator()(Acc& acc, const Unit& u, int wr, int wc, int fr, int fq) const {
        const int row0 = u.r0 + wr * 64 + fr, col0 = u.c0 + wc * 32 + 8 * fq; const int br = u.x;
#pragma unroll
        for (int ai = 0; ai < 2; ++ai)
#pragma unroll
            for (int m = 0; m < 4; ++m) { const size_t row = (size_t)(row0 + ai * HALF + m * 16);
#pragma unroll
                for (int bj = 0; bj < 2; ++bj) { const int col = col0 + bj * HALF;
                    const u32x4 gb = *(const u32x4*)(PG + row * NP1 + INW + D + col);
                    f32x4 h0 = {bf_lo(gb.x), bf_hi(gb.x), bf_lo(gb.y), bf_hi(gb.y)}, h1 = {bf_lo(gb.z), bf_hi(gb.z), bf_lo(gb.w), bf_hi(gb.w)};
#pragma unroll
                    for (int j = 0; j < 4; ++j) { h0[j] = fmaxf(h0[j], 1e-30f); h1[j] = fmaxf(h1[j], 1e-30f); }
                    if (br == 0) { const u32x4 ga = *(const u32x4*)(PG + row * NP1 + INW + col);
                        const f32x4 a0 = {bf_lo(ga.x), bf_hi(ga.x), bf_lo(ga.y), bf_hi(ga.y)}, a1 = {bf_lo(ga.z), bf_hi(ga.z), bf_lo(ga.w), bf_hi(ga.w)};
#pragma unroll
                        for (int j = 0; j < 4; ++j) { acc[ai][bj][m][0][j] *= a0[j] * __builtin_amdgcn_rcpf(h0[j]); acc[ai][bj][m][1][j] *= a1[j] * __builtin_amdgcn_rcpf(h1[j]); } }
                    else { const f32x4 v0 = acc[ai][bj][m][0] * h0, v1 = acc[ai][bj][m][1] * h1;
                        u32x4 w; w.x = cvt_pk_bf16(v0[0], v0[1]); w.y = cvt_pk_bf16(v0[2], v0[3]); w.z = cvt_pk_bf16(v1[0], v1[1]); w.w = cvt_pk_bf16(v1[2], v1[3]);
                        *(u32x4*)(MG + row * D + col) = w; } } }
    }
};
struct EpiResid {
    static constexpr bool PERM = false, KEEPS = false;
    const float* res; float* out; int ldc;
    __device__ __forceinline__ void operator()(Acc& acc, const Unit& u, int wr, int wc, int fr, int fq) const {
        const int row0 = u.r0 + wr * 64 + fr, col0 = u.c0 + wc * 32 + 4 * fq;
#pragma unroll
        for (int ai = 0; ai < 2; ++ai)
#pragma unroll
            for (int m = 0; m < 4; ++m) { const size_t off = (size_t)(row0 + ai * HALF + m * 16) * ldc + col0;
#pragma unroll
                for (int bj = 0; bj < 2; ++bj)
#pragma unroll
                    for (int n = 0; n < 2; ++n) { const f32x4 r = *(const f32x4*)(res + off + bj * HALF + n * 16); *(f32x4*)(out + off + bj * HALF + n * 16) = r + acc[ai][bj][m][n]; }
                asm volatile("" ::: "memory"); }
    }
};
struct EpiUp {
    static constexpr bool PERM = true, KEEPS = false;
    const float* bup; unsigned char* ACT;
    __device__ __forceinline__ void operator()(Acc& acc, const Unit& u, int wr, int wc, int fr, int fq) const {
        const int row0 = u.r0 + wr * 64 + fr, col0 = u.c0 * HALF + wc * 32 + 8 * fq; const float* be = bup + (size_t)u.x * (2 * DFF);
        f32x4 bg[2], bl[2];
#pragma unroll
        for (int n = 0; n < 2; ++n) { bg[n] = *(const f32x4*)(be + col0 + 4 * n); bl[n] = *(const f32x4*)(be + DFF + col0 + 4 * n); }
#pragma unroll
        for (int ai = 0; ai < 2; ++ai)
#pragma unroll
            for (int m = 0; m < 4; ++m) { unsigned char* rowp = ACT + (size_t)(row0 + ai * HALF + m * 16) * DFF + col0; f32x4 o[2];
#pragma unroll
                for (int n = 0; n < 2; ++n) { const f32x4 gv = acc[ai][0][m][n] + bg[n], lv = acc[ai][1][m][n] + bl[n];
#pragma unroll
                    for (int j = 0; j < 4; ++j) { const float g = fminf(gv[j], 7.0f), l = fminf(fmaxf(lv[j], -7.0f), 7.0f); o[n][j] = g * sigmoidf_fast(1.702f * g) * (l + 1.0f); } }
                u32x2 w; w.x = pk4_fp8(o[0][0], o[0][1], o[0][2], o[0][3]); w.y = pk4_fp8(o[1][0], o[1][1], o[1][2], o[1][3]);
                *(u32x2*)rowp = w; }
    }
};
struct EpiDown {
    static constexpr bool PERM = true, KEEPS = false;
    const float* bdn; const int* rslot; const float* gate; unsigned char* SLOT;
    __device__ __forceinline__ void operator()(Acc& acc, const Unit& u, int wr, int wc, int fr, int fq) const {
        const int row0 = u.r0 + wr * 64 + fr, col0 = u.c0 * BM + wc * 32 + 8 * fq; const float* be = bdn + (size_t)u.x * D;
        f32x4 bv[2][2];
#pragma unroll
        for (int bj = 0; bj < 2; ++bj)
#pragma unroll
            for (int n = 0; n < 2; ++n) bv[bj][n] = *(const f32x4*)(be + col0 + bj * HALF + 4 * n);
#pragma unroll
        for (int ai = 0; ai < 2; ++ai)
#pragma unroll
            for (int m = 0; m < 4; ++m) { const int sl = rslot[row0 + ai * HALF + m * 16];
                if (sl >= 0) { const float gt = gate[sl] * 16.0f; unsigned char* rowp = SLOT + (size_t)sl * D + col0;
#pragma unroll
                    for (int bj = 0; bj < 2; ++bj) { const f32x4 v0 = (acc[ai][bj][m][0] + bv[bj][0]) * gt, v1 = (acc[ai][bj][m][1] + bv[bj][1]) * gt;
                        u32x2 w; w.x = pk4_fp8(v0[0], v0[1], v0[2], v0[3]); w.y = pk4_fp8(v1[0], v1[1], v1[2], v1[3]);
                        *(u32x2*)(rowp + bj * HALF) = w; } } }
    }
};
}

struct Frame {
    LAS unsigned char* lds;
    int tid, lane, wave, vcu, G;
};

__device__ __forceinline__ void cvt_item_addr(const float* W, int K, int N, bf16_t* WT, int row_off, int item, int lane, const float*& src, bf16_t*& dst) {
    const int nblk = N >> 5, kb = item / nblk, nb = item - kb * nblk, kl = lane >> 3, nl = lane & 7;
    src = W + (size_t)(64 * kb + 8 * kl) * N + 32 * nb + 4 * nl; dst = WT + (size_t)(row_off + 32 * nb + 4 * nl) * K + 64 * kb + 8 * kl;
}
__device__ __forceinline__ void cvt_store(const f32x4 (&v)[8], bf16_t* dst, int K) {
#pragma unroll
    for (int i = 0; i < 4; ++i) { u32x4 o; o.x = cvt_pk_bf16(v[0][i], v[1][i]); o.y = cvt_pk_bf16(v[2][i], v[3][i]); o.z = cvt_pk_bf16(v[4][i], v[5][i]); o.w = cvt_pk_bf16(v[6][i], v[7][i]);
        *(u32x4*)(dst + (size_t)i * K) = o; }
}
__device__ __forceinline__ void cvt_store8(const f32x4 (&v)[8], unsigned char* dst, int K) {
#pragma unroll
    for (int i = 0; i < 4; ++i) { u32x2 o; o.x = pk4_fp8(v[0][i] * 64.f, v[1][i] * 64.f, v[2][i] * 64.f, v[3][i] * 64.f); o.y = pk4_fp8(v[4][i] * 64.f, v[5][i] * 64.f, v[6][i] * 64.f, v[7][i] * 64.f);
        *(u32x2*)(dst + (size_t)i * K) = o; }
}
__device__ __forceinline__ void cvt_range(const float* W, int K, int N, bf16_t* WT, int row_off, int i0, int cnt, int r, int nw, int lane) {
    int it = i0 + r; const int end = i0 + cnt;
    for (; it + nw < end; it += 2 * nw) {
        const float* s0; bf16_t* d0; const float* s1; bf16_t* d1;
        cvt_item_addr(W, K, N, WT, row_off, it, lane, s0, d0); cvt_item_addr(W, K, N, WT, row_off, it + nw, lane, s1, d1);
        f32x4 a[8], b[8];
#pragma unroll
        for (int j = 0; j < 8; ++j) a[j] = *(const f32x4*)(s0 + (size_t)j * N);
#pragma unroll
        for (int j = 0; j < 8; ++j) b[j] = *(const f32x4*)(s1 + (size_t)j * N);
        cvt_store(a, d0, K); cvt_store(b, d1, K);
    }
    if (it < end) { const float* s0; bf16_t* d0; cvt_item_addr(W, K, N, WT, row_off, it, lane, s0, d0); f32x4 a[8];
#pragma unroll
        for (int j = 0; j < 8; ++j) a[j] = *(const f32x4*)(s0 + (size_t)j * N);
        cvt_store(a, d0, K); }
}
constexpr int CV_UP = NE * (D / 64) * (2 * DFF / 32), CV_DN = NE * (DFF / 64) * (D / 32), CV_ALL = CV_UP + CV_DN;
struct MoeW { const float* w_up; const float* w_down; unsigned char* WUPT; unsigned char* WDNT; };
__device__ __forceinline__ void cvt_moe_addr(const MoeW& mw, int chunk, int w, int h, int lane, const float*& src, unsigned char*& dst, int& N) {
    const int kl = lane >> 3, nl = lane & 7;
    if (chunk < CV_UP / 64) { const int e = chunk >> 6, cc = chunk & 63, kb = 8 * (cc >> 4) + w, nb = 8 * (cc & 15) + h; N = 2 * DFF;
        src = mw.w_up + (size_t)e * D * 2 * DFF + (size_t)(64 * kb + 8 * kl) * (2 * DFF) + 32 * nb + 4 * nl; dst = mw.WUPT + (size_t)e * 2 * DFF * D + (size_t)(32 * nb + 4 * nl) * D + 64 * kb + 8 * kl; }
    else { const int q = chunk - CV_UP / 64, e = q >> 5, cc = q & 31, kb = 8 * (cc >> 3) + w, nb = 8 * (cc & 7) + h; N = D;
        src = mw.w_down + (size_t)e * DFF * D + (size_t)(64 * kb + 8 * kl) * D + 32 * nb + 4 * nl; dst = mw.WDNT + (size_t)e * D * DFF + (size_t)(32 * nb + 4 * nl) * DFF + 64 * kb + 8 * kl; }
}
__device__ __forceinline__ f32x4 ld_nt(const float* p) { return __builtin_nontemporal_load((const f32x4*)p); }
constexpr int CV_WG = 64;
__device__ __forceinline__ int cvt_claim(unsigned* cursor, int cap, unsigned* done, unsigned need) {
    if (done && __hip_atomic_load(done, __ATOMIC_RELAXED, __HIP_MEMORY_SCOPE_AGENT) >= need) return CV_ALL;
    if ((int)__hip_atomic_load(cursor, __ATOMIC_RELAXED, __HIP_MEMORY_SCOPE_AGENT) >= cap) return CV_ALL;
    return (int)__hip_atomic_fetch_add(cursor, (unsigned)CV_WG, __ATOMIC_RELAXED, __HIP_MEMORY_SCOPE_AGENT);
}
__device__ __forceinline__ void cvt_pull(const MoeW& mw, unsigned* cursor, int cap, unsigned* done, unsigned need, volatile LAS int* slot, int tid, int wave, int lane) {
    __syncthreads();
    if (tid == 0) *slot = cvt_claim(cursor, cap, done, need);
    __syncthreads();
    int base = __builtin_amdgcn_readfirstlane(*slot);
    while (base < CV_ALL) {
        int nb = CV_ALL; if (tid == 0) nb = cvt_claim(cursor, cap, done, need);
        const int chunk = base >> 6;
        if (chunk < CV_UP / 64) {
            const int e = chunk >> 6, cc = chunk & 63, nb = 8 * (cc & 15) + wave, kl = lane >> 3, nl = lane & 7;
#pragma unroll 1
            for (int q = 0; q < 2; ++q) { const int kq = 2 * (cc >> 4) + q, kb32 = 8 * kq + kl;
                const float* src = mw.w_up + (size_t)e * D * 2 * DFF + (size_t)(32 * kb32) * (2 * DFF) + 32 * nb + 4 * nl;
                f32x4 a[32];
#pragma unroll
                for (int j = 0; j < 32; ++j) a[j] = ld_nt(src + (size_t)j * (2 * DFF));
                unsigned char* dst = mw.WUPT + (size_t)e * 2 * DFF * D + (size_t)(32 * nb + 4 * nl) * D + 128 * (kb32 >> 2) + 16 * (kb32 & 3);
#pragma unroll
                for (int i = 0; i < 4; ++i) { f32x16 lo, hi;
#pragma unroll
                    for (int j = 0; j < 16; ++j) { lo[j] = a[j][i] * 64.f; hi[j] = a[16 + j][i] * 64.f; }
                    st_fp6_block(dst + (size_t)i * D, pk32_fp6(lo, hi)); } }
        } else
#pragma unroll
        for (int h = 0; h < 8; h += 4) {
            const float* s0; unsigned char* d0; const float* s1; unsigned char* d1; const float* s2; unsigned char* d2; const float* s3; unsigned char* d3; int N0, N1, N2, N3;
            cvt_moe_addr(mw, chunk, wave, h, lane, s0, d0, N0); cvt_moe_addr(mw, chunk, wave, h + 1, lane, s1, d1, N1); cvt_moe_addr(mw, chunk, wave, h + 2, lane, s2, d2, N2); cvt_moe_addr(mw, chunk, wave, h + 3, lane, s3, d3, N3);
            f32x4 a[8], b[8], c[8], d[8];
#pragma unroll
            for (int j = 0; j < 8; ++j) a[j] = ld_nt(s0 + (size_t)j * N0);
#pragma unroll
            for (int j = 0; j < 8; ++j) b[j] = ld_nt(s1 + (size_t)j * N1);
#pragma unroll
            for (int j = 0; j < 8; ++j) c[j] = ld_nt(s2 + (size_t)j * N2);
#pragma unroll
            for (int j = 0; j < 8; ++j) d[j] = ld_nt(s3 + (size_t)j * N3);
            cvt_store8(a, d0, D); cvt_store8(b, d1, D); cvt_store8(c, d2, D); cvt_store8(d, d3, D);
        }
        __syncthreads();
        if (tid == 0) *slot = nb;
        __syncthreads();
        base = __builtin_amdgcn_readfirstlane(*slot);
    }
}
__device__ __forceinline__ void rms_row_to_bf16(const float* xrow, const float* gvec, bf16_t* orow, int lane) {
    const f32x4* xr = (const f32x4*)xrow + lane; f32x4 v[8]; float s = 0.f;
#pragma unroll
    for (int j = 0; j < 8; ++j) { v[j] = xr[64 * j]; s += (v[j].x * v[j].x + v[j].y * v[j].y) + (v[j].z * v[j].z + v[j].w * v[j].w); }
    const float rstd = 1.0f / sqrtf(wave_sum(s) * (1.0f / D) + RMS_EPS);
    const f32x4* gr = (const f32x4*)gvec + lane; u32x2* o8 = (u32x2*)orow + lane;
#pragma unroll
    for (int j = 0; j < 8; ++j) { const f32x4 g = gr[64 * j]; const f32x4 y = v[j] * rstd * g; u32x2 w; w.x = cvt_pk_bf16(y.x, y.y); w.y = cvt_pk_bf16(y.z, y.w); o8[64 * j] = w; }
}

__device__ __forceinline__ unsigned voff_b(unsigned row, unsigned ch) { return 256u * row + 16u * (ch ^ (((row & 3u) << 2) | ((row >> 2) & 3u))); }
__device__ __forceinline__ s16x4 vtr(const LAS unsigned char* p) { return __builtin_bit_cast(s16x4, __builtin_amdgcn_ds_read_tr16_b64_v4i16((LAS s16x4*)p)); }

__device__ __forceinline__ void sb_wg_unit(const bf16_t* PG, bf16_t* OA, int h, int qb, LAS unsigned char* lds, volatile LAS int* flags, int tid, int wave, int lane) {
    const int fr = lane & 15, fq = lane >> 4, q0w = qb * 128 + wave * 16, qi = q0w + fr;
    bf16x8 Qf[4];
    { const bf16_t* qp = PG + (size_t)qi * NP1 + h * HD + 8 * fq;
#pragma unroll
      for (int ks = 0; ks < 4; ++ks) Qf[ks] = *(const bf16x8*)(qp + 32 * ks); }
    f32x4 O[8];
#pragma unroll
    for (int db = 0; db < 8; ++db) O[db] = (f32x4){0.f, 0.f, 0.f, 0.f};
    float carry = 0.f; bool sat = false;
    const float scale = 0.08838834764831845f;
    const unsigned p = fr & 3, qq = fr >> 2;
    const int jt_hi = 2 * qb + 1, jt_w = q0w >> 6;
    const int srow = tid >> 4, sch = tid & 15;
    const bf16_t* kg = PG + (size_t)srow * NP1 + SBW + h * HD + 8 * sch;
    u32x4 kr[2], vr[2];
    __syncthreads();
    if (tid < 8) flags[tid] = 0;
    { const bf16_t* g = kg + (size_t)(jt_hi * 64) * NP1;
#pragma unroll
      for (int i = 0; i < 2; ++i) { kr[i] = *(const u32x4*)(g + (size_t)(32 * i) * NP1); vr[i] = *(const u32x4*)(g + (size_t)(32 * i) * NP1 + SBW); } }
    for (int jt = jt_hi, it = 0; jt >= 0; --jt, ++it) {
        LAS unsigned char* kb = lds + (it & 1) * 32768; LAS unsigned char* vb = kb + 16384;
#pragma unroll
        for (int i = 0; i < 2; ++i) { *(LAS u32x4*)(kb + voff_b(srow + 32 * i, sch)) = kr[i]; *(LAS u32x4*)(vb + voff_b(srow + 32 * i, sch)) = vr[i]; }
        __syncthreads();
        { int ns = 0;
#pragma unroll
          for (int w = 0; w < 8; ++w) ns += flags[w];
          if (__builtin_amdgcn_readfirstlane(ns) == 8) break; }
        if (jt > 0) { const bf16_t* g = kg + (size_t)((jt - 1) * 64) * NP1;
#pragma unroll
            for (int i = 0; i < 2; ++i) { kr[i] = *(const u32x4*)(g + (size_t)(32 * i) * NP1); vr[i] = *(const u32x4*)(g + (size_t)(32 * i) * NP1 + SBW); } }
        if (!sat && jt <= jt_w) {
            const int key0 = jt * 64;
            f32x4 z[4];
#pragma unroll
            for (int sb = 0; sb < 4; ++sb) { z[sb] = (f32x4){0.f, 0.f, 0.f, 0.f};
#pragma unroll
                for (int ks = 0; ks < 4; ++ks) { const bf16x8 kf = *(const LAS bf16x8*)(kb + voff_b(16 * sb + fr, 4 * ks + fq)); z[sb] = __builtin_amdgcn_mfma_f32_16x16x32_bf16(kf, Qf[ks], z[sb], 0, 0, 0); } }
            float sfx[4][4], g[4], lex[4], T[4];
            const bool diag = key0 + 64 > q0w;
#pragma unroll
            for (int sb = 0; sb < 4; ++sb) {
                float sp[4];
#pragma unroll
                for (int i = 0; i < 4; ++i) { const float y = z[sb][i] * (scale * 1.4426950408889634f); z[sb][i] = y;
                    sp[i] = fmaxf(y, 0.f) + __builtin_amdgcn_logf(1.0f + __builtin_amdgcn_exp2f(-fabsf(y))); }
                if (diag) {
#pragma unroll
                    for (int i = 0; i < 4; ++i) { const int key = key0 + 16 * sb + 4 * fq + i; sp[i] = (key < qi) ? sp[i] : 0.f; } }
                sfx[sb][3] = sp[3]; sfx[sb][2] = sp[2] + sfx[sb][3]; sfx[sb][1] = sp[1] + sfx[sb][2]; sfx[sb][0] = sp[0] + sfx[sb][1]; g[sb] = sfx[sb][0];
            }
#pragma unroll
            for (int sb = 0; sb < 4; ++sb) { const float x1 = __shfl_xor(g[sb], 16), x2 = __shfl_xor(g[sb], 32), x3 = __shfl_xor(g[sb], 48);
                T[sb] = (g[sb] + x1) + (x2 + x3); lex[sb] = ((fq & 1) ? 0.f : x1) + ((fq < 2) ? (x2 + x3) : 0.f); }
            float run = carry; bf16x8 Wf[2]; unsigned wpk[8];
#pragma unroll
            for (int sb = 3; sb >= 0; --sb) { const float base = run + lex[sb]; float w[4];
#pragma unroll
                for (int i = 0; i < 4; ++i) w[i] = __builtin_amdgcn_exp2f(z[sb][i] - (base + sfx[sb][i]));
                if (diag) {
#pragma unroll
                    for (int i = 0; i < 4; ++i) { const int key = key0 + 16 * sb + 4 * fq + i; w[i] = (key < qi) ? w[i] : 0.f; } }
                wpk[2 * sb] = cvt_pk_bf16(w[0], w[1]); wpk[2 * sb + 1] = cvt_pk_bf16(w[2], w[3]); run += T[sb]; }
            carry = run;
            { u32x4 a = {wpk[0], wpk[1], wpk[2], wpk[3]}, b = {wpk[4], wpk[5], wpk[6], wpk[7]}; Wf[0] = __builtin_bit_cast(bf16x8, a); Wf[1] = __builtin_bit_cast(bf16x8, b); }
#pragma unroll
            for (int db = 0; db < 8; ++db)
#pragma unroll
                for (int m = 0; m < 2; ++m) { const unsigned r1 = 32 * m + 4 * fq + qq, r2 = r1 + 16;
                    const s16x4 lo = vtr(vb + voff_b(r1, 2 * db + (p >> 1)) + 8 * (p & 1)), hi = vtr(vb + voff_b(r2, 2 * db + (p >> 1)) + 8 * (p & 1));
                    const bf16x8 vf = {lo[0], lo[1], lo[2], lo[3], hi[0], hi[1], hi[2], hi[3]};
                    O[db] = __builtin_amdgcn_mfma_f32_16x16x32_bf16(vf, Wf[m], O[db], 0, 0, 0); }
            if (__all(carry > 150.1f)) { sat = true; if (lane == 0) flags[wave] = 1; }
        }
    }
    { bf16_t* op = OA + (size_t)qi * SBW + h * HD + 4 * fq;
#pragma unroll
      for (int db = 0; db < 8; ++db) { u32x2 w; w.x = cvt_pk_bf16(O[db][0], O[db][1]); w.y = cvt_pk_bf16(O[db][2], O[db][3]); *(u32x2*)(op + 16 * db) = w; } }
}

__device__ __forceinline__ void xa_unit(const bf16_t* QXA, const bf16_t* KVM, bf16_t* OXA, int h, int qb, const LAS unsigned char* vl, int lane) {
    const int fr = lane & 15, fq = lane >> 4, q0 = qb * 16, qi = q0 + fr;
    bf16x8 Qf[4];
    { const bf16_t* qp = QXA + (size_t)qi * XAW + h * HD + 8 * fq;
#pragma unroll
      for (int ks = 0; ks < 4; ++ks) Qf[ks] = *(const bf16x8*)(qp + 32 * ks); }
    f32x4 z[16];
    { const bf16_t* kp = KVM + (size_t)fr * (2 * XAW) + h * HD + 8 * fq;
#pragma unroll
      for (int sb = 0; sb < 16; ++sb) { z[sb] = (f32x4){0.f, 0.f, 0.f, 0.f};
#pragma unroll
          for (int ks = 0; ks < 4; ++ks) { const bf16x8 kf = *(const bf16x8*)(kp + (size_t)(16 * sb) * (2 * XAW) + 32 * ks); z[sb] = __builtin_amdgcn_mfma_f32_16x16x32_bf16(kf, Qf[ks], z[sb], 0, 0, 0); } } }
    const float scale = 0.08838834764831845f * 1.4426950408889634f;
    float mx = -3.0e38f;
#pragma unroll
    for (int sb = 0; sb < 16; ++sb)
#pragma unroll
        for (int i = 0; i < 4; ++i) { z[sb][i] *= scale; mx = fmaxf(mx, z[sb][i]); }
    mx = fmaxf(mx, __shfl_xor(mx, 16)); mx = fmaxf(mx, __shfl_xor(mx, 32));
    float sum = 0.f;
#pragma unroll
    for (int sb = 0; sb < 16; ++sb)
#pragma unroll
        for (int i = 0; i < 4; ++i) { const float e = __builtin_amdgcn_exp2f(z[sb][i] - mx); z[sb][i] = e; sum += e; }
    sum += __shfl_xor(sum, 16); sum += __shfl_xor(sum, 32);
    const float inv = 1.0f / sum;
    f32x4 O[8];
#pragma unroll
    for (int db = 0; db < 8; ++db) O[db] = (f32x4){0.f, 0.f, 0.f, 0.f};
    const unsigned p = fr & 3, qq = fr >> 2;
#pragma unroll
    for (int m = 0; m < 8; ++m) {
        u32x4 a = {cvt_pk_bf16(z[2 * m][0], z[2 * m][1]), cvt_pk_bf16(z[2 * m][2], z[2 * m][3]), cvt_pk_bf16(z[2 * m + 1][0], z[2 * m + 1][1]), cvt_pk_bf16(z[2 * m + 1][2], z[2 * m + 1][3])};
        const bf16x8 Wf = __builtin_bit_cast(bf16x8, a);
#pragma unroll
        for (int db = 0; db < 8; ++db) { const unsigned r1 = 32 * m + 4 * fq + qq, r2 = r1 + 16;
            const s16x4 lo = vtr(vl + voff_b(r1, 2 * db + (p >> 1)) + 8 * (p & 1)), hi = vtr(vl + voff_b(r2, 2 * db + (p >> 1)) + 8 * (p & 1));
            const bf16x8 vf = {lo[0], lo[1], lo[2], lo[3], hi[0], hi[1], hi[2], hi[3]};
            O[db] = __builtin_amdgcn_mfma_f32_16x16x32_bf16(vf, Wf, O[db], 0, 0, 0); }
    }
    { bf16_t* op = OXA + (size_t)qi * XAW + h * HD + 4 * fq;
#pragma unroll
      for (int db = 0; db < 8; ++db) { const f32x4 o = O[db] * inv; u32x2 w; w.x = cvt_pk_bf16(o[0], o[1]); w.y = cvt_pk_bf16(o[2], o[3]); *(u32x2*)(op + 16 * db) = w; } }
}

template <int W>
__device__ __forceinline__ void pool_run(const bf16_t* PG, bf16_t* PO, int t0, int ch) {
    constexpr int NR = W + 7;
    const bf16_t* pp = PG + (size_t)(t0 + 7) * NP1 + 3 * SBW + ch * 8;
    u32x4 v[NR];
#pragma unroll
    for (int k = 0; k < NR; ++k) v[k] = (t0 + 7 - k >= 0) ? *(const u32x4*)(pp - (size_t)k * NP1) : (u32x4){0u, 0u, 0u, 0u};
#pragma unroll
    for (int i = 0; i < 8; ++i) {
        float s[8];
#pragma unroll
        for (int j = 0; j < 8; ++j) s[j] = 0.f;
#pragma unroll
        for (int j = W - 1; j >= 0; --j) { const u32x4 x = v[7 - i + j];
            s[0] += bf_lo(x.x); s[1] += bf_hi(x.x); s[2] += bf_lo(x.y); s[3] += bf_hi(x.y); s[4] += bf_lo(x.z); s[5] += bf_hi(x.z); s[6] += bf_lo(x.w); s[7] += bf_hi(x.w); }
        const int t = t0 + i, n = (t + 1 < W) ? (t + 1) : W; const float inv = 1.0f / (float)n; const u32x4 me = v[7 - i]; u32x4 o;
        o.x = cvt_pk_bf16(s[0] * inv - bf_lo(me.x), s[1] * inv - bf_hi(me.x)); o.y = cvt_pk_bf16(s[2] * inv - bf_lo(me.y), s[3] * inv - bf_hi(me.y));
        o.z = cvt_pk_bf16(s[4] * inv - bf_lo(me.z), s[5] * inv - bf_hi(me.z)); o.w = cvt_pk_bf16(s[6] * inv - bf_lo(me.w), s[7] * inv - bf_hi(me.w));
        *(u32x4*)(PO + (size_t)t * POOLW + ch * 8) = o;
    }
}

constexpr int NPHASE = 15;
struct Args { const float* in[24]; float* out; unsigned char* ws; int ph_lo, ph_hi; };
static_assert(sizeof(Args) == 24 * 8 + 8 + 8 + 8, "Args has no padding");

__global__ void __launch_bounds__(NWAVES * 64, 2) moe_fwd(Args args) {
    extern __shared__ __attribute__((aligned(16))) unsigned char lds_raw[];
    Frame F;
    F.lds = (LAS unsigned char*)lds_raw;
    F.tid = threadIdx.x; F.lane = F.tid & 63; F.wave = __builtin_amdgcn_readfirstlane(F.tid >> 6);
    F.G = gridDim.x; { const int bx = blockIdx.x; F.vcu = (F.G % 8 == 0) ? (bx % 8) * (F.G / 8) + bx / 8 : bx; }
    unsigned char* ws = args.ws;
    unsigned* ctl = (unsigned*)(ws + WS_CTL);
    LAS unsigned char* lx = F.lds + LDS_X_OFF;
    for (int u = F.tid; u < (LDS_BYTES - LDS_X_OFF) / 4; u += NWAVES * 64) ((LAS unsigned*)lx)[u] = 0u;
    __syncthreads();
#if MK_ONE_LAUNCH
    XcdBarrier bar = xcd_barrier_post(ctl + CW_BAR, (volatile LAS unsigned*)(lx + LX_BAR));
#define GRID_BAR() xcd_barrier(bar)
#else
#define GRID_BAR() do {} while (0)
#endif
    const int lo = args.ph_lo, hi = args.ph_hi;
#ifndef PHASE_MASK
#define PHASE_MASK 0x7fff
#endif
#define IN(k) (((PHASE_MASK >> (k)) & 1) && lo <= (k) && (k) < hi)
#define SEAM(k) do { if (IN((k) + 1)) GRID_BAR(); } while (0)

    const float* x = args.in[0]; const float* mem = args.in[1]; const float* norm_mix = args.in[2]; const float* w_in = args.in[3]; const float* pool_lin = args.in[4];
    const float* pool_scale = args.in[5]; const float* w_branch_a = args.in[6]; const float* w_branch_b = args.in[7]; const float* w_gate = args.in[8]; const float* b_gate = args.in[9];
    const float* w_mix_out = args.in[10]; const float* xa_norm = args.in[11]; const float* mem_norm = args.in[12]; const float* xa_wq = args.in[13]; const float* xa_wkv = args.in[14];
    const float* xa_wo = args.in[15]; const float* moe_norm = args.in[16]; const float* w_router = args.in[17]; const float* b_router = args.in[18]; const float* w_up = args.in[19];
    const float* b_up = args.in[20]; const float* w_down = args.in[21]; const float* b_down = args.in[22]; const float* final_norm = args.in[23];
    bf16_t* W1T = (bf16_t*)(ws + WS_W1T); bf16_t* WAT = (bf16_t*)(ws + WS_WAT); bf16_t* WBT = (bf16_t*)(ws + WS_WBT); bf16_t* WMT = (bf16_t*)(ws + WS_WMT); bf16_t* PLT = (bf16_t*)(ws + WS_PLT);
    bf16_t* WQT = (bf16_t*)(ws + WS_WQT); bf16_t* WKVT = (bf16_t*)(ws + WS_WKVT); bf16_t* WOT = (bf16_t*)(ws + WS_WOT); unsigned char* WUPT = ws + WS_WUPT; unsigned char* WDNT = ws + WS_WDNT;
    bf16_t* U = (bf16_t*)(ws + WS_U); bf16_t* MEMN = (bf16_t*)(ws + WS_MEMN); bf16_t* PG = (bf16_t*)(ws + WS_PG); bf16_t* OA = (bf16_t*)(ws + WS_OA); bf16_t* PO = (bf16_t*)(ws + WS_PO);
    bf16_t* OB = (bf16_t*)(ws + WS_OB); float* TMP = (float*)(ws + WS_TMP); bf16_t* MG = (bf16_t*)(ws + WS_MG); float* H1 = (float*)(ws + WS_H1); bf16_t* U2 = (bf16_t*)(ws + WS_U2);
    bf16_t* QXA = (bf16_t*)(ws + WS_QXA); bf16_t* KVM = (bf16_t*)(ws + WS_KVM); bf16_t* OXA = (bf16_t*)(ws + WS_OXA); float* H2 = (float*)(ws + WS_H2); unsigned char* TB = ws + WS_TB;
    bf16_t* ROWS = (bf16_t*)(ws + WS_ROWS); unsigned char* ACT = ws + WS_ACT; unsigned char* SLOT = ws + WS_SLOT;
    int* ASGE = (int*)(ws + WS_ASGE); int* ASGP = (int*)(ws + WS_ASGP); float* GATE = (float*)(ws + WS_GATE); int* RSLOT = (int*)(ws + WS_RSLOT);
    int* CNT = (int*)(ctl + CW_CNT); bf16_t* WRT = (bf16_t*)(ws + WS_WRT);
    const int gw = F.vcu * NWAVES + F.wave, NGW = F.G * NWAVES;
    const MoeW mw{w_up, w_down, WUPT, WDNT};
    unsigned* CUR = ctl + CW_CUR; volatile LAS int* cvs = (volatile LAS int*)(lx + LX_CVS);
#define CVT_PULL(cap) cvt_pull(mw, CUR, (cap), nullptr, 0u, cvs, F.tid, F.wave, F.lane)
#define CVT_BESIDE(cap, ph, need) cvt_pull(mw, CUR, (cap), ctl + CW_DONE + 64 * (ph), (unsigned)(need), cvs, F.tid, F.wave, F.lane)
#define MARK_DONE(ph) do { if (F.tid == 0) __hip_atomic_fetch_add(ctl + CW_DONE + 64 * (ph), 1u, __ATOMIC_RELAXED, __HIP_MEMORY_SCOPE_AGENT); } while (0)

    if (IN(0)) {
        constexpr int I_IN = (D / 64) * (INW / 32), I_BR = (SBW / 64) * (D / 32), I_MX = (D / 64) * (D / 32), I_PL = (256 / 64) * (256 / 32);
        constexpr int I_Q = (D / 64) * (XAW / 32), I_KV = (D / 64) * (2 * XAW / 32), I_O = (XAW / 64) * (D / 32);
        cvt_range(w_in, D, INW, W1T, 0, 0, I_IN, gw, NGW, F.lane);
        cvt_range(w_gate, D, INW, W1T, INW, 0, I_IN, gw, NGW, F.lane);
        for (int m = gw; m < S; m += NGW) rms_row_to_bf16(x + (size_t)m * D, norm_mix, U + (size_t)m * D, F.lane);
        for (int m = gw; m < MEM; m += NGW) rms_row_to_bf16(mem + (size_t)m * D, mem_norm, MEMN + (size_t)m * D, F.lane);
        for (int i = blockIdx.x * (NWAVES * 64) + F.tid; i < NE * D / 2; i += F.G * NWAVES * 64) {
            const int e = i >> 10, c = (i & 1023) * 2; const float a = w_router[(size_t)c * NE + e], b = w_router[(size_t)(c + 1) * NE + e];
            const unsigned hi = cvt_pk_bf16(a, b); const unsigned lo = cvt_pk_bf16(a - bf_lo(hi), b - bf_hi(hi));
            *(unsigned*)(WRT + (size_t)e * D + c) = hi; *(unsigned*)(WRT + (size_t)(NE + e) * D + c) = lo; }
        __syncthreads();
        SEAM(0);
    }

    if (IN(1)) {
        const int gc = (F.G == 256) ? GC_P1 : F.G;
        if ((int)blockIdx.x < gc) {
            pg8::DenseSched Sc{(const char*)U, (const char*)W1T, D, D, S / 256, NP1 / 256, gc, (int)blockIdx.x};
            pg8::EpiProj E{PG, b_gate};
            pg8::gemm_phase<pg8::EpiProj, pg8::DenseSched, true>(F.lds, D, D, D, Sc, E);
            MARK_DONE(1);
        }
        if ((int)blockIdx.x >= gc) {
            constexpr int I_BR = (SBW / 64) * (D / 32), I_MX = (D / 64) * (D / 32), I_PL = (256 / 64) * (256 / 32), I_Q = (D / 64) * (XAW / 32), I_KV = (D / 64) * (2 * XAW / 32), I_O = (XAW / 64) * (D / 32);
            const int cr = ((int)blockIdx.x - gc) * NWAVES + F.wave, cn = (F.G - gc) * NWAVES;
        cvt_range(w_branch_a, SBW, D, WAT, 0, 0, I_BR, cr, cn, F.lane);
        cvt_range(w_branch_b, POOLW, D, WBT, 0, 0, I_BR, cr, cn, F.lane);
        cvt_range(w_mix_out, D, D, WMT, 0, 0, I_MX, cr, cn, F.lane);
        for (int g = 0; g < 4; ++g) cvt_range(pool_lin + (size_t)g * 65536, 256, 256, PLT + (size_t)g * 65536, 0, 0, I_PL, cr, cn, F.lane);
        cvt_range(xa_wq, D, XAW, WQT, 0, 0, I_Q, cr, cn, F.lane);
        cvt_range(xa_wkv, D, 2 * XAW, WKVT, 0, 0, I_KV, cr, cn, F.lane);
        cvt_range(xa_wo, XAW, D, WOT, 0, 0, I_O, cr, cn, F.lane);
        }
        CVT_BESIDE(CV_UP, 1, gc);
        SEAM(1);
    }

    if (IN(2)) {
        for (int it = blockIdx.x * (NWAVES * 64) + F.tid; it < (S / 8) * (POOLW / 8); it += F.G * NWAVES * 64) {
            const int wv = it >> 6, g = wv & 3, rb = (wv >> 2) * 2 + (F.lane >> 5), ch = g * 32 + (F.lane & 31), t0 = rb * 8;
            if (g == 0) pool_run<2>(PG, PO, t0, ch); else if (g == 1) pool_run<4>(PG, PO, t0, ch); else if (g == 2) pool_run<8>(PG, PO, t0, ch); else pool_run<16>(PG, PO, t0, ch);
        }
        for (int it = F.vcu; it < SBH * (S / 128); it += F.G) { const int h = it & 7, qb = (S / 128 - 1) - (it >> 3); sb_wg_unit(PG, OA, h, qb, F.lds, (volatile LAS int*)(lx + LX_SBF), F.tid, F.wave, F.lane); }
        __syncthreads();
        SEAM(2);
    }

    if (IN(3)) {
        pg8::PoolSched Sc{(const char*)PO, (const char*)PLT, F.G, F.vcu};
        pg8::EpiBf16 E{OB, POOLW, pool_scale};
        pg8::gemm_phase<pg8::EpiBf16, pg8::PoolSched, true>(F.lds, 256, POOLW, 256, Sc, E);
        if (F.vcu < (S / 256) * 4) MARK_DONE(3);
        CVT_BESIDE(CV_UP, 3, (S / 256) * 4);
        SEAM(3);
    }

    if (IN(4)) {
        pg8::BranchSched Sc{(const char*)OA, (const char*)OB, (const char*)WAT, (const char*)WBT, SBW, SBW, S / 256, D / 256, F.G, (int)blockIdx.x};
        pg8::EpiBranch E{PG, MG};
        pg8::gemm_phase<pg8::EpiBranch, pg8::BranchSched, true>(F.lds, SBW, SBW, SBW, Sc, E);
        SEAM(4);
    }

    if (IN(5)) {
        pg8::DenseSched Sc{(const char*)MG, (const char*)WMT, D, D, S / 256, D / 256, F.G, (int)blockIdx.x};
        pg8::EpiResid E{x, H1, D};
        pg8::gemm_phase<pg8::EpiResid, pg8::DenseSched, true>(F.lds, D, D, D, Sc, E);
        SEAM(5);
    }

    if (IN(6)) {
        for (int m = gw; m < S; m += NGW) rms_row_to_bf16(H1 + (size_t)m * D, xa_norm, U2 + (size_t)m * D, F.lane);
        SEAM(6);
    }

    if (IN(7)) {
        { pg8::DenseSched Sc{(const char*)U2, (const char*)WQT, D, D, S / 256, XAW / 256, F.G, (int)blockIdx.x};
          pg8::EpiBf16 E{QXA, XAW, nullptr};
          pg8::gemm_phase<pg8::EpiBf16, pg8::DenseSched, true>(F.lds, D, D, D, Sc, E); }
        { const int c2 = ((int)blockIdx.x >= 64) ? (int)blockIdx.x - 64 : (int)blockIdx.x + F.G - 64;
          pg8::DenseSched Sc{(const char*)MEMN, (const char*)WKVT, D, D, MEM / 256, 2 * XAW / 256, F.G, c2};
          pg8::EpiBf16 E{KVM, 2 * XAW, nullptr};
          pg8::gemm_phase<pg8::EpiBf16, pg8::DenseSched, true>(F.lds, D, D, D, Sc, E); }
        if ((int)blockIdx.x < 68) MARK_DONE(7);
        CVT_BESIDE(CV_UP, 7, 68);
        SEAM(7);
    }

    if (IN(8)) {
        for (int it = F.vcu; it < XAH * (S / 128); it += F.G) {
            const int h = it & 3, qg = it >> 2;
            __syncthreads();
#pragma unroll
            for (int t = 0; t < 8; ++t) { const int c = t * 512 + F.tid, row = c >> 4, ch = c & 15;
                const u32x4 vv = *(const u32x4*)(KVM + (size_t)row * (2 * XAW) + XAW + h * HD + 8 * ch); *(LAS u32x4*)(F.lds + voff_b(row, ch)) = vv; }
            __syncthreads();
            xa_unit(QXA, KVM, OXA, h, qg * 8 + F.wave, F.lds, F.lane);
        }
        __syncthreads();
        SEAM(8);
    }

    if (IN(9)) {
        pg8::DenseSched Sc{(const char*)OXA, (const char*)WOT, XAW, XAW, S / 256, D / 256, F.G, (int)blockIdx.x};
        pg8::EpiResid E{H1, H2, D};
        pg8::gemm_phase<pg8::EpiResid, pg8::DenseSched, true>(F.lds, XAW, XAW, XAW, Sc, E);
        SEAM(9);
    }

    if (IN(10)) {
        for (int i = blockIdx.x * (NWAVES * 64) + F.tid; i < PROWS; i += F.G * NWAVES * 64) RSLOT[i] = -1;
        LAS unsigned char* thi = F.lds;
        LAS float* lg = (LAS float*)(lx + LX_LOG);
        LAS float* part = (LAS float*)(lx + LX_RPART);
        for (int rg = F.vcu; rg < S / 16; rg += F.G) {
            __syncthreads();
#pragma unroll
            for (int rr = 0; rr < 2; ++rr) { const int r = 2 * F.wave + rr, m = rg * 16 + r;
                const f32x4* xr = (const f32x4*)(H2 + (size_t)m * D) + F.lane; f32x4 v[8]; float s = 0.f;
#pragma unroll
                for (int j = 0; j < 8; ++j) { v[j] = xr[64 * j]; s += (v[j].x * v[j].x + v[j].y * v[j].y) + (v[j].z * v[j].z + v[j].w * v[j].w); }
                const float rstd = 1.0f / sqrtf(wave_sum(s) * (1.0f / D) + RMS_EPS);
                const f32x4* gr = (const f32x4*)moe_norm + F.lane;
#pragma unroll
                for (int j = 0; j < 8; ++j) { const f32x4 g = gr[64 * j]; const f32x4 y = v[j] * rstd * g; u32x2 w; w.x = cvt_pk_bf16(y.x, y.y); w.y = cvt_pk_bf16(y.z, y.w);
                    u32x2 l; l.x = cvt_pk_bf16(y.x - bf_lo(w.x), y.y - bf_hi(w.x)); l.y = cvt_pk_bf16(y.z - bf_lo(w.y), y.w - bf_hi(w.y));
                    const unsigned off = (unsigned)r * 4096u + ((((unsigned)F.lane >> 1) + 32u * j) ^ (unsigned)r) * 16u + (F.lane & 1) * 8u;
                    *(LAS u32x2*)(thi + off) = w; *(LAS u32x2*)(thi + 65536 + off) = l; } }
            __syncthreads();
#pragma unroll
            for (int q = 0; q < 2; ++q) { const int blk = F.tid + 512 * q, r = blk >> 6, kb32 = blk & 63; f32x16 lo, hi;
#pragma unroll
                for (int c4 = 0; c4 < 4; ++c4) { const u32x4 v = *(const LAS u32x4*)(thi + r * 4096 + ((unsigned)((4 * kb32 + c4) ^ r) * 16u));
                    const float f[8] = {bf_lo(v.x), bf_hi(v.x), bf_lo(v.y), bf_hi(v.y), bf_lo(v.z), bf_hi(v.z), bf_lo(v.w), bf_hi(v.w)};
#pragma unroll
                    for (int j = 0; j < 8; ++j) { if (c4 < 2) lo[8 * c4 + j] = f[j] * 2.0f; else hi[8 * (c4 - 2) + j] = f[j] * 2.0f; } }
                st_fp6_block(TB + (size_t)(rg * 16 + r) * D + 128 * (kb32 >> 2) + 16 * (kb32 & 3), pk32_fp6(lo, hi)); }
            { const int fr = F.lane & 15, fq = F.lane >> 4; f32x4 c0 = {0.f, 0.f, 0.f, 0.f}, c1 = {0.f, 0.f, 0.f, 0.f};
              const bf16_t* wh = WRT + (size_t)fr * D + 256 * F.wave + 8 * fq;
#pragma unroll
              for (int st = 0; st < 8; ++st) { const unsigned ch = (unsigned)(32 * F.wave + 4 * st + fq);
                  const bf16x8 ah = *(const LAS bf16x8*)(thi + fr * 4096 + ((ch ^ (unsigned)fr) * 16u)), al = *(const LAS bf16x8*)(thi + 65536 + fr * 4096 + ((ch ^ (unsigned)fr) * 16u));
                  const bf16x8 bh0 = *(const bf16x8*)(wh + 32 * st), bh1 = *(const bf16x8*)(wh + (size_t)16 * D + 32 * st), bl0 = *(const bf16x8*)(wh + (size_t)NE * D + 32 * st), bl1 = *(const bf16x8*)(wh + (size_t)(NE + 16) * D + 32 * st);
                  c0 = __builtin_amdgcn_mfma_f32_16x16x32_bf16(ah, bh0, c0, 0, 0, 0); c1 = __builtin_amdgcn_mfma_f32_16x16x32_bf16(ah, bh1, c1, 0, 0, 0);
                  c0 = __builtin_amdgcn_mfma_f32_16x16x32_bf16(ah, bl0, c0, 0, 0, 0); c1 = __builtin_amdgcn_mfma_f32_16x16x32_bf16(ah, bl1, c1, 0, 0, 0);
                  c0 = __builtin_amdgcn_mfma_f32_16x16x32_bf16(al, bh0, c0, 0, 0, 0); c1 = __builtin_amdgcn_mfma_f32_16x16x32_bf16(al, bh1, c1, 0, 0, 0); }
#pragma unroll
              for (int i = 0; i < 4; ++i) { part[(F.wave * 16 + 4 * fq + i) * 32 + fr] = c0[i]; part[(F.wave * 16 + 4 * fq + i) * 32 + 16 + fr] = c1[i]; } }
            __syncthreads();
            { const int r = F.tid >> 5, e = F.tid & 31; float a = 0.f;
#pragma unroll
              for (int w = 0; w < 8; ++w) a += part[(w * 16 + r) * 32 + e];
              lg[r * 32 + e] = a + b_router[e]; }
            __syncthreads();
            if (F.tid < 16) { const int r = F.tid, m = rg * 16 + r; float l[32];
#pragma unroll
                for (int e = 0; e < 32; ++e) l[e] = lg[r * 32 + e];
                int idx[4]; float val[4]; unsigned taken = 0u;
#pragma unroll
                for (int k = 0; k < 4; ++k) { float best = -3.4e38f; int bi = 0;
#pragma unroll
                    for (int e = 0; e < 32; ++e) { const bool ok = !((taken >> e) & 1u) && (l[e] > best); best = ok ? l[e] : best; bi = ok ? e : bi; }
                    idx[k] = bi; val[k] = best; taken |= 1u << bi; }
                const float e0 = 1.0f, e1 = expf(val[1] - val[0]), e2 = expf(val[2] - val[0]), e3 = expf(val[3] - val[0]); const float inv = 1.0f / (((e0 + e1) + e2) + e3);
                const float gk[4] = {e0 * inv, e1 * inv, e2 * inv, e3 * inv};
#pragma unroll
                for (int k = 0; k < 4; ++k) { const int pos = atomicAdd(CNT + idx[k], 1); ASGE[m * 4 + k] = idx[k]; ASGP[m * 4 + k] = pos; GATE[m * 4 + k] = gk[k]; } }
        }
        __syncthreads();
        SEAM(10);
    }

    LAS int* tab = (LAS int*)(lx + LX_TAB);
#define BUILD_TAB(NT) do { __syncthreads(); if (F.tid == 0) { int us = 0, ps = 0; for (int e = 0; e < NE; ++e) { const int c = CNT[e], nb = (c + EBLK - 1) / EBLK; tab[e] = us; tab[33 + e] = ps; tab[66 + e] = nb > 0 ? nb : 1; us += nb * (NT); ps += nb * EBLK; } tab[32] = us; tab[65] = ps; } __syncthreads(); } while (0)

    if (IN(11)) {
        BUILD_TAB(1);
        for (int s = blockIdx.x * (NWAVES * 64) + F.tid; s < NK; s += F.G * NWAVES * 64) { const int e = ASGE[s], pos = ASGP[s]; RSLOT[tab[33 + e] + pos] = s; }
        CVT_PULL(CV_UP);
        SEAM(11);
    }

    if (IN(12)) {
        BUILD_TAB(16);
        const int gc = (F.G == 256) ? GC_P12 : F.G; const int bx = (int)blockIdx.x;
        if ((bx >> 3) < (gc >> 3) || F.G != 256) {
            pg8::MoeSched Sc{(const char*)TB, (const char*)WUPT, 16, (size_t)2 * DFF * D, (size_t)128 * D, (size_t)DFF * D, tab, gc, (F.G == 256) ? (bx & 7) * (gc >> 3) + (bx >> 3) : F.vcu, true, (size_t)D};
            pg8::EpiUp E{b_up, ACT};
            LAS int* gtab = (LAS int*)(lx + LX_RPART);
            { pg8::Unit uu; for (int i = 0; i < 16 && Sc.next(i, uu); ++i) if (F.tid < 256) { const int sl = RSLOT[uu.r0 + F.tid]; gtab[i * 256 + F.tid] = (sl < 0 ? 0 : sl) >> 2; } }
            __syncthreads();
            pg8::gemm_phase_db6<pg8::EpiUp, pg8::MoeSched>(F.lds, D / 2, D / 2, D / 2, Sc, E, gtab);
            MARK_DONE(12);
        }
        CVT_BESIDE(CV_ALL, 12, gc);
        CVT_PULL(CV_ALL);
        SEAM(12);
    }

    if (IN(13)) {
        BUILD_TAB(8);
        pg8::MoeSched Sc{(const char*)ACT, (const char*)WDNT, 8, (size_t)D * DFF, (size_t)256 * DFF, (size_t)128 * DFF, tab, F.G, F.vcu, false, (size_t)DFF};
        pg8::EpiDown E{b_down, RSLOT, GATE, SLOT};
        pg8::gemm_phase<pg8::EpiDown, pg8::MoeSched, true, false, 1>(F.lds, DFF / 2, DFF / 2, DFF / 2, Sc, E);
        SEAM(13);
    }

    if (IN(14)) {
        for (int m = gw; m < S; m += NGW) {
            const f32x4* xr = (const f32x4*)(H2 + (size_t)m * D) + F.lane; f32x4 v[8]; float s = 0.f;
#pragma unroll
            for (int j = 0; j < 8; ++j) { v[j] = xr[64 * j];
#pragma unroll
                for (int k = 0; k < 4; ++k) { const int w = (int)*((const unsigned*)(SLOT + (size_t)(m * 4 + k) * D) + F.lane + 64 * j); const f32x2 lo = __builtin_amdgcn_cvt_pk_f32_fp8(w, false), hi = __builtin_amdgcn_cvt_pk_f32_fp8(w, true);
                    v[j].x += lo.x * 0.0625f; v[j].y += lo.y * 0.0625f; v[j].z += hi.x * 0.0625f; v[j].w += hi.y * 0.0625f; }
                s += (v[j].x * v[j].x + v[j].y * v[j].y) + (v[j].z * v[j].z + v[j].w * v[j].w); }
            const float rstd = 1.0f / sqrtf(wave_sum(s) * (1.0f / D) + RMS_EPS);
            const f32x4* gr = (const f32x4*)final_norm + F.lane; f32x4* o = (f32x4*)(args.out + (size_t)m * D) + F.lane;
#pragma unroll
            for (int j = 0; j < 8; ++j) o[64 * j] = v[j] * rstd * gr[64 * j];
        }
    }
#undef IN
#undef SEAM
}

extern "C" void kernel_launch(void* const* d_in, const int* in_sizes, int n_in, void* d_out, int out_size, void* d_ws, size_t ws_size, hipStream_t stream) {
    static int grid = 0;
    if (grid == 0) {
        if (n_in != 24 || out_size != S * D || ws_size < WS_END) { fprintf(stderr, "kernel_launch: unexpected shapes (n_in %d out %d ws %zu need %zu)\n", n_in, out_size, ws_size, (size_t)WS_END); grid = -1; return; }
        int dev = 0, cus = 0, per_cu = 0;
        if (hipGetDevice(&dev) != hipSuccess || hipDeviceGetAttribute(&cus, hipDeviceAttributeMultiprocessorCount, dev) != hipSuccess) { grid = -1; return; }
        if (hipFuncSetAttribute((const void*)moe_fwd, hipFuncAttributeMaxDynamicSharedMemorySize, LDS_BYTES) != hipSuccess) { fprintf(stderr, "kernel_launch: hipFuncSetAttribute failed\n"); grid = -1; return; }
        if (hipOccupancyMaxActiveBlocksPerMultiprocessor(&per_cu, (const void*)moe_fwd, NWAVES * 64, LDS_BYTES) != hipSuccess || per_cu < 1) { fprintf(stderr, "kernel_launch: occupancy query says %d\n", per_cu); per_cu = 1; }
        (void)hipGetLastError();
        grid = cus;
    }
    if (grid < 0) return;
    (void)hipMemsetAsync((char*)d_ws + WS_CTL, 0, CTL_ZERO_BYTES, stream);
    Args a{};
    for (int i = 0; i < 24; ++i) a.in[i] = (const float*)d_in[i];
    a.out = (float*)d_out; a.ws = (unsigned char*)d_ws;
#if MK_ONE_LAUNCH
    a.ph_lo = 0; a.ph_hi = NPHASE;
    hipLaunchKernelGGL(moe_fwd, dim3(grid), dim3(NWAVES * 64), LDS_BYTES, stream, a);
#else
    for (int p = 0; p < NPHASE; ++p) { a.ph_lo = p; a.ph_hi = p + 1; for (int rep = 0; rep < (((REPEAT_MASK >> p) & 1) ? 2 : 1); ++rep) hipLaunchKernelGGL(moe_fwd, dim3(grid), dim3(NWAVES * 64), LDS_BYTES, stream, a); }
#endif
}
```

```cpp
#include <hip/hip_runtime.h>
#include <cstdio>
#include <cstdint>

#ifndef MK_ONE_LAUNCH
#define MK_ONE_LAUNCH 1
#endif
#ifndef REPEAT_MASK
#define REPEAT_MASK 0
#endif
#define GC_P1 160
#define GC_P12 224

#define LAS __attribute__((address_space(3)))
#define GAS __attribute__((address_space(1)))
typedef unsigned short bf16_t;
typedef short bf16x8 __attribute__((ext_vector_type(8)));
typedef short s16x4 __attribute__((ext_vector_type(4)));
typedef float f32x4 __attribute__((ext_vector_type(4)));
typedef float f32x2 __attribute__((ext_vector_type(2)));
typedef unsigned u32x4 __attribute__((ext_vector_type(4)));
typedef unsigned u32x2 __attribute__((ext_vector_type(2)));
typedef int v8i32 __attribute__((ext_vector_type(8)));
typedef int v6i32 __attribute__((ext_vector_type(6)));
typedef unsigned u32x3 __attribute__((ext_vector_type(3)));
typedef float f32x16 __attribute__((ext_vector_type(16)));

constexpr int S = 8192, D = 2048, MEM = 256;
constexpr int SBH = 8, HD = 128, SBW = 1024, POOLW = 1024, INW = 4096, NP1 = 8192;
constexpr int XAH = 4, XAW = 512;
constexpr int NE = 32, TOPK = 4, DFF = 2048, NK = S * TOPK, EBLK = 256, MAXBLK = NK / EBLK + NE, PROWS = MAXBLK * EBLK;
constexpr float RMS_EPS = 1e-5f;

constexpr size_t MiB = 1u << 20;
constexpr size_t WS_CTL = 0, CTL_ZERO_BYTES = 1 * MiB;
constexpr size_t WS_W1T = 2 * MiB;
constexpr size_t WS_WAT = WS_W1T + 32 * MiB;
constexpr size_t WS_WBT = WS_WAT + 4 * MiB;
constexpr size_t WS_WMT = WS_WBT + 4 * MiB;
constexpr size_t WS_PLT = WS_WMT + 8 * MiB;
constexpr size_t WS_WQT = WS_PLT + 1 * MiB;
constexpr size_t WS_WKVT = WS_WQT + 2 * MiB;
constexpr size_t WS_WOT = WS_WKVT + 4 * MiB;
constexpr size_t WS_WUPT = WS_WOT + 2 * MiB;
constexpr size_t WS_WDNT = WS_WUPT + 512 * MiB;
constexpr size_t WS_U = WS_WDNT + 256 * MiB;
constexpr size_t WS_MEMN = WS_U + 32 * MiB;
constexpr size_t WS_PG = WS_MEMN + 1 * MiB;
constexpr size_t WS_OA = WS_PG + 128 * MiB;
constexpr size_t WS_PO = WS_OA + 16 * MiB;
constexpr size_t WS_OB = WS_PO + 16 * MiB;
constexpr size_t WS_TMP = WS_OB + 16 * MiB;
constexpr size_t WS_MG = WS_TMP + 64 * MiB;
constexpr size_t WS_H1 = WS_MG + 32 * MiB;
constexpr size_t WS_U2 = WS_H1 + 64 * MiB;
constexpr size_t WS_QXA = WS_U2 + 32 * MiB;
constexpr size_t WS_KVM = WS_QXA + 8 * MiB;
constexpr size_t WS_OXA = WS_KVM + 1 * MiB;
constexpr size_t WS_H2 = WS_OXA + 8 * MiB;
constexpr size_t WS_TB = WS_H2 + 64 * MiB;
constexpr size_t WS_ROWS = WS_TB + 32 * MiB;
constexpr size_t WS_ACT = WS_ROWS + 160 * MiB;
constexpr size_t WS_SLOT = WS_ACT + 160 * MiB;
constexpr size_t WS_ASGE = WS_SLOT + 128 * MiB;
constexpr size_t WS_ASGP = WS_ASGE + 1 * MiB;
constexpr size_t WS_GATE = WS_ASGP + 1 * MiB;
constexpr size_t WS_RSLOT = WS_GATE + 1 * MiB;
constexpr size_t WS_WRT = WS_RSLOT + 1 * MiB;
constexpr size_t WS_END = WS_WRT + 1 * MiB;
constexpr int CW_CNT = 64;
constexpr int CW_CUR = 192;  constexpr int CW_DONE = 256;
constexpr int CW_BAR = 4096;

constexpr int RING_BYTES = 131072;
constexpr int LDS_X_OFF = RING_BYTES;
constexpr int LDS_BYTES = 163840;
constexpr int LX_BAR = 0;
constexpr int LX_TAB = 64;
constexpr int LX_CVS = 32;
constexpr int LX_SBF = 128;
constexpr int LX_LOG = 1024;
constexpr int LX_RPART = 4096;

constexpr int NWAVES = 8;

__device__ __forceinline__ unsigned cvt_pk_bf16(float lo, float hi) { unsigned r; asm volatile("v_cvt_pk_bf16_f32 %0, %1, %2" : "=v"(r) : "v"(lo), "v"(hi)); return r; }
__device__ __forceinline__ unsigned pk4_fp8(float a, float b, float c, float d) { int p = __builtin_amdgcn_cvt_pk_fp8_f32(a, b, 0, false); p = __builtin_amdgcn_cvt_pk_fp8_f32(c, d, p, true); return (unsigned)p; }
__device__ __forceinline__ v6i32 pk32_fp6(const f32x16& lo, const f32x16& hi) { return __builtin_amdgcn_cvt_scalef32_2xpk16_fp6_f32(lo, hi, 1.0f); }
__device__ __forceinline__ void st_fp6_block(unsigned char* p, const v6i32& b) { *(u32x4*)p = (u32x4){(unsigned)b[0], (unsigned)b[1], (unsigned)b[2], (unsigned)b[3]}; *(u32x4*)(p + 64) = (u32x4){(unsigned)b[4], (unsigned)b[5], 0u, 0u}; }
__device__ __forceinline__ float bf_lo(unsigned w) { return __uint_as_float(w << 16); }
__device__ __forceinline__ float bf_hi(unsigned w) { return __uint_as_float(w & 0xffff0000u); }
__device__ __forceinline__ float wave_sum(float v) {
#pragma unroll
    for (int o = 1; o < 64; o <<= 1) v += __shfl_xor(v, o);
    return v;
}
__device__ __forceinline__ float sigmoidf_fast(float x) { return __builtin_amdgcn_rcpf(1.0f + __builtin_amdgcn_exp2f(x * -1.4426950408889634f)); }

#define XB_TMO      128
#define XB_XCNT(j)  (256  + 64 * (j))
#define XB_XSUB(j)  (1280 + 64 * (j))
#define XB_XGEN(j)  (2304 + 64 * (j))
#define XB_TOP      3328
#define XB_TOPGEN   3392
#define XCD_BAR_WORDS 3456
#define XB_SPIN_CAP (1u << 18)
__device__ __forceinline__ unsigned xb_ld(unsigned* p)              { return __hip_atomic_load(p, __ATOMIC_RELAXED, __HIP_MEMORY_SCOPE_AGENT); }
__device__ __forceinline__ unsigned xb_add(unsigned* p, unsigned v) { return __hip_atomic_fetch_add(p, v, __ATOMIC_RELAXED, __HIP_MEMORY_SCOPE_AGENT); }
__device__ __forceinline__ unsigned xb_xcc_id() { return (unsigned)__builtin_amdgcn_s_getreg((3 << 11) | 20) & 0xFu; }
#define XB_SPIN(cond, bar) do { unsigned _sp = 0; while (cond) { __builtin_amdgcn_s_sleep(1); \
    if ((++_sp & 255u) == 0u) { if (xb_ld(&(bar)[XB_TMO])) break; if (_sp > XB_SPIN_CAP) { atomicAdd(&(bar)[XB_TMO], 1u); break; } } } } while (0)
struct XcdBarrier { unsigned* bar; unsigned x; volatile LAS unsigned* st; };
__device__ __forceinline__ XcdBarrier xcd_barrier_post(unsigned* bar, volatile LAS unsigned* st) {
    XcdBarrier b; b.bar = bar; b.x = xb_xcc_id(); b.st = st;
    if (threadIdx.x == 0) (void)xb_add(&bar[XB_XCNT(b.x)], 1u);
    return b;
}
__device__ __forceinline__ void xcd_barrier_complete(unsigned* bar, unsigned x, unsigned& nloc, unsigned& nx) {
    const unsigned G = gridDim.x * gridDim.y * gridDim.z;
    unsigned sum, cnt, mine, sp = 0u;
    for (;;) {
        sum = 0u; cnt = 0u; mine = 0u;
#pragma unroll
        for (unsigned j = 0; j < 16; ++j) { const unsigned c = xb_ld(&bar[XB_XCNT(j)]); sum += c; cnt += (c > 0u) ? 1u : 0u; mine = (j == x) ? c : mine; }
        if (sum == G) break;
        __builtin_amdgcn_s_sleep(1);
        if ((++sp & 255u) == 0u) { if (xb_ld(&bar[XB_TMO])) break; if (sp > XB_SPIN_CAP) { atomicAdd(&bar[XB_TMO], 1u); break; } }
    }
    nloc = mine > 0u ? mine : 1u; nx = cnt > 0u ? cnt : 1u;
}
__device__ __forceinline__ void xcd_barrier(const XcdBarrier& b) {
    asm volatile("s_waitcnt vmcnt(0)" ::: "memory");
    __syncthreads();
    if (threadIdx.x == 0) {
        unsigned* bar = b.bar;
        __builtin_amdgcn_s_waitcnt(0);
        unsigned nloc = b.st[0], nx = b.st[1];
        if (nloc == 0u) { xcd_barrier_complete(bar, b.x, nloc, nx); b.st[0] = nloc; b.st[1] = nx; }
        const unsigned old = xb_add(&bar[XB_XSUB(b.x)], 1u);
        const unsigned gen = old / nloc;
        if (old + 1u == (gen + 1u) * nloc) {
            __builtin_amdgcn_fence(__ATOMIC_RELEASE, "agent");
            asm volatile("s_waitcnt vmcnt(0)" ::: "memory");
            const unsigned og = xb_add(&bar[XB_TOP], 1u);
            const unsigned tg = og / nx;
            if (og + 1u == (tg + 1u) * nx) xb_add(&bar[XB_TOPGEN], 1u);
            else XB_SPIN(xb_ld(&bar[XB_TOPGEN]) == tg, bar);
            __builtin_amdgcn_fence(__ATOMIC_ACQUIRE, "agent");
            xb_add(&bar[XB_XGEN(b.x)], 1u);
            asm volatile("s_waitcnt vmcnt(0)" ::: "memory");
        } else {
            XB_SPIN(xb_ld(&bar[XB_XGEN(b.x)]) == gen, bar);
            __builtin_amdgcn_fence(__ATOMIC_ACQUIRE, "agent");
            asm volatile("s_waitcnt vmcnt(0)" ::: "memory");
        }
    }
    __syncthreads();
}

namespace pg8 {
constexpr int BM = 256, BK = 64, HALF = 128, HTB = HALF * BK * 2, STAGE_BYTES = 8 * HTB, NXCD = 8, WGM = 8;
__host__ __device__ __forceinline__ int lds_byte(int r, int c) { const int st = (r >> 4) * 2 + (c >> 5), rr = r & 15, cc = c & 31, ob = rr * 64 + cc * 2; return st * 1024 + (ob ^ (((ob >> 9) & 1) << 5)); }
__host__ __device__ __forceinline__ void stage_rc(int b, int& R, int& C) { const int st = b / 1024, sb = b % 1024, swz = sb ^ (((sb >> 9) & 1) << 5); R = (st >> 1) * 16 + swz / 64; C = (st & 1) * 32 + (swz % 64) / 2; }
__host__ __device__ __forceinline__ int perm32(int rho) { const int n = rho >> 4, i = rho & 15; return 8 * (i >> 2) + 4 * n + (i & 3); }

struct Unit { const char* A; const char* B0; const char* B1; int r0, c0, x; };

__device__ __forceinline__ void tile_of(int L, int nM, int nN, int& pm, int& pn) {
    const int nwg = nM * nN; int wgid = L;
    { const int q = nwg / NXCD, r = nwg % NXCD, xcd = wgid % NXCD, off = wgid / NXCD; wgid = (xcd < r ? xcd * (q + 1) : r * (q + 1) + (xcd - r) * q) + off; }
    const int nig = WGM * nN, gid = wgid / nig, fm = gid * WGM, gsz = (nM - fm) < WGM ? (nM - fm) : WGM;
    pm = fm + ((wgid % nig) % gsz); pn = (wgid % nig) / gsz;
}
struct DenseSched {
    const char* A; const char* B; int lda, ldb, nM, nN, G, c;
    __device__ __forceinline__ bool next(int i, Unit& u) const {
        const long L = (long)i * G + c; if (L >= (long)nM * nN) return false;
        int pm, pn; tile_of((int)L, nM, nN, pm, pn);
        u.A = A + (size_t)pm * BM * lda * 2; u.B0 = B + (size_t)pn * BM * ldb * 2; u.B1 = u.B0 + (size_t)HALF * ldb * 2; u.r0 = pm * BM; u.c0 = pn * BM; u.x = 0; return true;
    }
};
struct BranchSched {
    const char* A0; const char* A1; const char* B0; const char* B1; int lda, ldb, nM, nN, G, c;
    __device__ __forceinline__ bool next(int i, Unit& u) const {
        const long L = (long)(i >> 1) * G + c; if (L >= (long)nM * nN) return false;
        int pm, pn; tile_of((int)L, nM, nN, pm, pn); const int br = i & 1;
        u.A = (br ? A1 : A0) + (size_t)pm * BM * lda * 2; u.B0 = (br ? B1 : B0) + (size_t)pn * BM * ldb * 2; u.B1 = u.B0 + (size_t)HALF * ldb * 2; u.r0 = pm * BM; u.c0 = pn * BM; u.x = br; return true;
    }
};
struct PoolSched {
    const char* A; const char* B; int G, c;
    __device__ __forceinline__ bool next(int i, Unit& u) const {
        const int L = i * G + c; if (L >= (S / BM) * 4) return false;
        const int pm = L >> 2, g = L & 3;
        u.A = A + ((size_t)pm * BM * POOLW + g * 256) * 2; u.B0 = B + (size_t)g * 256 * 256 * 2; u.B1 = u.B0 + (size_t)HALF * 256 * 2; u.r0 = pm * BM; u.c0 = g * 256; u.x = g; return true;
    }
};
struct MoeSched {
    const char* A; const char* B; int NT; size_t estride; size_t tstride; size_t hoff; const LAS int* tab; int G, c; bool gather; size_t arow;
    __device__ __forceinline__ int tu(int i) const { return __builtin_amdgcn_readfirstlane(tab[i]); }
    __device__ __forceinline__ bool next(int i, Unit& u) const {
        const int L = i * G + c; if (L >= tu(32)) return false;
        int e = 0;
#pragma unroll
        for (int s = 16; s >= 1; s >>= 1) { if (tu(e + s) <= L) e += s; }
        const int r = L - tu(e), nb = tu(66 + e), nt = r / nb, blk = r - nt * nb, prow = tu(33 + e) + blk * EBLK;
        u.A = gather ? A : A + (size_t)prow * arow; u.B0 = B + (size_t)e * estride + (size_t)nt * tstride; u.B1 = u.B0 + hoff; u.r0 = prow; u.c0 = nt; u.x = e; return true;
    }
};

template <class Epi, class Sched, bool ALIGN_EPI, bool GATHER = false, int PREC = 0>
__device__ __forceinline__ void gemm_phase(LAS unsigned char* lds, const int K, const int lda, const int ldb, const Sched& S, const Epi& E, const LAS int* gtab = nullptr) {
    const int tid = threadIdx.x, wid = __builtin_amdgcn_readfirstlane(tid >> 6), lane = tid & 63, wr = wid >> 2, wc = wid & 3, fr = lane & 15, fq = lane >> 4;
    const int nt = K / BK;
    unsigned voffB[2], vc[2][2], vn[2][2]; int RA[2], CA[2];
#pragma unroll
    for (int i = 0; i < 2; ++i) { int R, C; stage_rc(tid * 16 + i * 8192, R, C); const int Rb = Epi::PERM ? ((R & ~31) + perm32(R & 31)) : R; RA[i] = R; CA[i] = C;
        voffB[i] = (unsigned)(Rb * ldb + C) * 2u; }
#define PG8_AOFF(dst, ord) do { _Pragma("unroll") for (int _h = 0; _h < 2; ++_h) _Pragma("unroll") for (int _i = 0; _i < 2; ++_i) \
        dst[_h][_i] = GATHER ? ((unsigned)gtab[(ord) * 256 + _h * HALF + RA[_i]] * (unsigned)lda + (unsigned)CA[_i]) * 2u : (unsigned)((_h * HALF + RA[_i]) * lda + CA[_i]) * 2u; } while (0)
    const size_t kstep = (size_t)(BK * 2);
    const unsigned ldsw = (unsigned)wid * 1024u;
    const int aoff = lds_byte(wr * 64 + fr, fq * 8), boff = lds_byte(wc * 32 + fr, fq * 8);
#define PG8_SA(b, h) (((b) * 2 + (h)) * HTB)
#define PG8_SB(b, h) ((4 + (b) * 2 + (h)) * HTB)
#define PG8_STAGE(bufoff, gbase, voff) do { _Pragma("unroll") for (int _i = 0; _i < 2; ++_i) \
        __builtin_amdgcn_global_load_lds((const unsigned*)((const char*)(gbase) + (voff)[_i]), (LAS unsigned*)(lds + (bufoff) + ldsw + _i * 8192), 16, 0, 0); } while (0)
#define PG8_LD6(off) __builtin_bit_cast(v6i32, __builtin_shufflevector(*(const LAS u32x4*)(lds + (off)), __builtin_shufflevector(*(const LAS u32x2*)(lds + (off) + 1024), *(const LAS u32x2*)(lds + (off) + 1024), 0, 1, -1, -1), 0, 1, 2, 3, 4, 5))
#define PG8_LD8(off) __builtin_bit_cast(v8i32, __builtin_shufflevector(*(const LAS u32x4*)(lds + (off)), *(const LAS u32x4*)(lds + (off) + 1024), 0, 1, 2, 3, 4, 5, 6, 7))
#define PG8_LDA(dst, b, h) do { if (PREC == 2) { _Pragma("unroll") for (int m = 0; m < 4; ++m) dst##6[m] = PG8_LD6(PG8_SA(b, h) + aoff + m * 2048); } \
      else if (PREC == 1) { _Pragma("unroll") for (int m = 0; m < 4; ++m) dst##8[m] = PG8_LD8(PG8_SA(b, h) + aoff + m * 2048); } \
      else { _Pragma("unroll") for (int m = 0; m < 4; ++m) _Pragma("unroll") for (int k = 0; k < 2; ++k) dst[m][k] = *(const LAS bf16x8*)(lds + PG8_SA(b, h) + aoff + m * 2048 + k * 1024); } } while (0)
#define PG8_LDB(dst, b, h) do { if (PREC == 2) { _Pragma("unroll") for (int n = 0; n < 2; ++n) dst##6[n] = PG8_LD6(PG8_SB(b, h) + boff + n * 2048); } \
      else if (PREC == 1) { _Pragma("unroll") for (int n = 0; n < 2; ++n) dst##8[n] = PG8_LD8(PG8_SB(b, h) + boff + n * 2048); } \
      else { _Pragma("unroll") for (int n = 0; n < 2; ++n) _Pragma("unroll") for (int k = 0; k < 2; ++k) dst[n][k] = *(const LAS bf16x8*)(lds + PG8_SB(b, h) + boff + n * 2048 + k * 1024); } } while (0)
#define PG8_MMA(ai, bj, At, Bt) do { __builtin_amdgcn_s_setprio(1); if (PREC == 2) { _Pragma("unroll") for (int m = 0; m < 4; ++m) _Pragma("unroll") for (int n = 0; n < 2; ++n) \
        asm volatile("v_mfma_scale_f32_16x16x128_f8f6f4 %0, %1, %2, %0, %3, %4 op_sel_hi:[0,0,0] cbsz:2 blgp:2" : "+v"(acc[ai][bj][m][n]) : "v"(Bt##6[n]), "v"(At##6[m]), "v"(sc_w), "v"(sc_a)); } \
      else if (PREC == 1) { _Pragma("unroll") for (int m = 0; m < 4; ++m) _Pragma("unroll") for (int n = 0; n < 2; ++n) \
        asm volatile("v_mfma_scale_f32_16x16x128_f8f6f4 %0, %1, %2, %0, %3, %4 op_sel_hi:[0,0,0]" : "+v"(acc[ai][bj][m][n]) : "v"(Bt##8[n]), "v"(At##8[m]), "v"(sc_w), "v"(sc_a)); } \
      else { _Pragma("unroll") for (int m = 0; m < 4; ++m) _Pragma("unroll") for (int n = 0; n < 2; ++n) _Pragma("unroll") for (int k = 0; k < 2; ++k) \
        acc[ai][bj][m][n] = __builtin_amdgcn_mfma_f32_16x16x32_bf16(Bt[n][k], At[m][k], acc[ai][bj][m][n], 0, 0, 0); } __builtin_amdgcn_s_setprio(0); } while (0)
#define PG8_WAIT_V(n) asm volatile("s_waitcnt vmcnt(" #n ")" ::: "memory")
#define PG8_WAIT_L(n) asm volatile("s_waitcnt lgkmcnt(" #n ")" ::: "memory")
#define PG8_BAR __builtin_amdgcn_s_barrier()
#define PG8_SCHED __builtin_amdgcn_sched_barrier(0)
    Unit cur, nxt; int ui = 0;
    if (!S.next(0, cur)) return;
    f32x4 acc[2][2][4][2];
#pragma unroll
    for (int a = 0; a < 2; ++a)
#pragma unroll
        for (int b = 0; b < 2; ++b)
#pragma unroll
            for (int m = 0; m < 4; ++m)
#pragma unroll
                for (int n = 0; n < 2; ++n) acc[a][b][m][n] = (f32x4){0.f, 0.f, 0.f, 0.f};
    bf16x8 At[4][2], B0[2][2], B1[2][2]; v8i32 At8[4], B08[2], B18[2]; v6i32 At6[4], B06[2], B16[2];
    const int sc_w = 121, sc_a = (PREC == 2) ? 126 : 127;
    PG8_AOFF(vc, 0);
#pragma unroll
    for (int _h = 0; _h < 2; ++_h) { vn[_h][0] = vc[_h][0]; vn[_h][1] = vc[_h][1]; }
    PG8_STAGE(PG8_SB(0, 0), cur.B0, voffB); PG8_STAGE(PG8_SB(0, 1), cur.B1, voffB); PG8_STAGE(PG8_SA(0, 0), cur.A, vc[0]); PG8_STAGE(PG8_SA(0, 1), cur.A, vc[1]);
    if (wr == 1) PG8_BAR;
    PG8_WAIT_V(2); PG8_BAR;
    PG8_STAGE(PG8_SB(1, 0), cur.B0 + kstep, voffB); PG8_STAGE(PG8_SA(1, 0), cur.A + kstep, vc[0]); PG8_STAGE(PG8_SB(1, 1), cur.B1 + kstep, voffB);
    PG8_WAIT_V(6); PG8_BAR;
    for (;;) {
        const bool has_next = S.next(ui + 1, nxt);
        if (GATHER && has_next) PG8_AOFF(vn, ui + 1);
        const char* nA = has_next ? nxt.A : cur.A; const char* nB0 = has_next ? nxt.B0 : cur.B0; const char* nB1 = has_next ? nxt.B1 : cur.B1;
#pragma nounroll
        for (int t = 0; t < nt; t += 2) {
            const bool last = (t == nt - 2);
            const char* a1 = cur.A + (size_t)(t + 1) * kstep;
            const char* a2 = last ? nA : cur.A + (size_t)(t + 2) * kstep;
            const char* b20 = last ? nB0 : cur.B0 + (size_t)(t + 2) * kstep; const char* b21 = last ? nB1 : cur.B1 + (size_t)(t + 2) * kstep;
            const char* a3 = a2 + kstep; const char* b30 = b20 + kstep; const char* b31 = b21 + kstep;
            unsigned v2[2][2];
#pragma unroll
            for (int _h = 0; _h < 2; ++_h) { v2[_h][0] = (GATHER && last) ? vn[_h][0] : vc[_h][0]; v2[_h][1] = (GATHER && last) ? vn[_h][1] : vc[_h][1]; }
            PG8_LDB(B0, 0, 0); PG8_LDB(B1, 0, 1); PG8_SCHED; PG8_LDA(At, 0, 0); PG8_STAGE(PG8_SA(1, 1), a1, vc[1]);
            PG8_WAIT_V(8); PG8_WAIT_L(0); PG8_BAR; PG8_MMA(0, 0, At, B0); PG8_MMA(0, 1, At, B1); PG8_BAR; PG8_SCHED;
            PG8_LDA(At, 0, 1); PG8_STAGE(PG8_SB(0, 0), b20, voffB); PG8_STAGE(PG8_SB(0, 1), b21, voffB); PG8_STAGE(PG8_SA(0, 0), a2, v2[0]);
            PG8_WAIT_V(8); PG8_WAIT_L(0); PG8_BAR; PG8_MMA(1, 0, At, B0); PG8_MMA(1, 1, At, B1); PG8_BAR; PG8_SCHED;
            PG8_LDB(B0, 1, 0); PG8_LDB(B1, 1, 1); PG8_SCHED; PG8_LDA(At, 1, 0); PG8_STAGE(PG8_SA(0, 1), a2, v2[1]);
            PG8_WAIT_V(8); PG8_WAIT_L(0); PG8_BAR; PG8_MMA(0, 0, At, B0); PG8_MMA(0, 1, At, B1); PG8_BAR; PG8_SCHED;
            PG8_LDA(At, 1, 1); PG8_STAGE(PG8_SB(1, 0), b30, voffB); PG8_STAGE(PG8_SB(1, 1), b31, voffB); PG8_STAGE(PG8_SA(1, 0), a3, v2[0]);
            PG8_WAIT_V(8); PG8_WAIT_L(0); PG8_BAR; PG8_MMA(1, 0, At, B0); PG8_MMA(1, 1, At, B1); PG8_BAR; PG8_SCHED;
        }
        if constexpr (ALIGN_EPI) { if (wr == 0) PG8_BAR; }
        if (PREC != 0) asm volatile("s_nop 15\n\ts_nop 15\n\ts_nop 15\n\ts_nop 15" ::: "memory");
        E(acc, cur, wr, wc, fr, fq);
        if (!has_next) break;
        bool kp = false; if constexpr (Epi::KEEPS) kp = E.keep(cur);
        if (!kp) {
#pragma unroll
        for (int a = 0; a < 2; ++a)
#pragma unroll
            for (int b = 0; b < 2; ++b)
#pragma unroll
                for (int m = 0; m < 4; ++m)
#pragma unroll
                    for (int n = 0; n < 2; ++n) acc[a][b][m][n] = (f32x4){0.f, 0.f, 0.f, 0.f}; }
        cur = nxt; ++ui;
        if (GATHER) {
#pragma unroll
            for (int _h = 0; _h < 2; ++_h) { vc[_h][0] = vn[_h][0]; vc[_h][1] = vn[_h][1]; } }
        if constexpr (ALIGN_EPI) { if (wr == 1) PG8_BAR; }
    }
    PG8_WAIT_V(0);
    if constexpr (!ALIGN_EPI) { if (wr == 0) PG8_BAR; }
    PG8_BAR;
#undef PG8_AOFF
#undef PG8_SA
#undef PG8_SB
#undef PG8_STAGE
#undef PG8_LDA
#undef PG8_LDB
#undef PG8_MMA
#undef PG8_LD8
#undef PG8_LD6
#undef PG8_WAIT_V
#undef PG8_WAIT_L
#undef PG8_BAR
#undef PG8_SCHED
}

template <int OFF>
__device__ __forceinline__ v6i32 ld6x(unsigned addr) {
    u32x4 lo; u32x2 hi;
    asm volatile("ds_read_b128 %0, %1 offset:%2" : "=v"(lo) : "v"(addr), "n"(OFF));
    asm volatile("ds_read_b64 %0, %1 offset:%2" : "=v"(hi) : "v"(addr), "n"(OFF + 1024));
    return (v6i32){(int)lo[0], (int)lo[1], (int)lo[2], (int)lo[3], (int)hi[0], (int)hi[1]};
}
template <class Epi, class Sched>
__device__ __forceinline__ void gemm_phase_db6(LAS unsigned char* lds, const int K, const int lda, const int ldb, const Sched& S, const Epi& E, const LAS int* gtab) {
    const int tid = threadIdx.x, wid = __builtin_amdgcn_readfirstlane(tid >> 6), lane = tid & 63, wr = wid >> 2, wc = wid & 3, fr = lane & 15, fq = lane >> 4;
    const int nt = K / BK;
    unsigned voffB0, vc[2][2]; const size_t bstep = (size_t)64 * ldb * 2;
    { int R, C; stage_rc(tid * 16, R, C); const int Rb = Epi::PERM ? ((R & ~31) + perm32(R & 31)) : R; voffB0 = (unsigned)(Rb * ldb + C) * 2u; }
#define DB_AOFF(dst, ord) do { _Pragma("unroll") for (int _i = 0; _i < 2; ++_i) { int _R, _C; stage_rc((int)threadIdx.x * 16 + _i * 8192, _R, _C); _Pragma("unroll") for (int _h = 0; _h < 2; ++_h) \
        dst[_h][_i] = ((unsigned)gtab[(ord) * 256 + _h * HALF + _R] * (unsigned)lda + (unsigned)_C) * 2u; } } while (0)
    const size_t kstep = (size_t)(BK * 2);
    const unsigned ldsw = (unsigned)wid * 1024u;
    const int aoff = lds_byte(wr * 64 + fr, fq * 8), boff = lds_byte(wc * 32 + fr, fq * 8);
    const unsigned aA = (unsigned)(size_t)(lds + aoff), aB = (unsigned)(size_t)(lds + 4 * HTB + boff);
#define DB_SA(b, h) (((b) * 2 + (h)) * HTB)
#define DB_SB(b, h) ((4 + (b) * 2 + (h)) * HTB)
#define DB_STAGEA1(bufoff, gbase, voff, i) __builtin_amdgcn_global_load_lds((const unsigned*)((const char*)(gbase) + (voff)[i]), (LAS unsigned*)(lds + (bufoff) + ldsw + (i) * 8192), 16, 0, 0)
#define DB_STAGEB1(bufoff, gbase, i) __builtin_amdgcn_global_load_lds((const unsigned*)((const char*)(gbase) + (size_t)(i) * bstep + voffB0), (LAS unsigned*)(lds + (bufoff) + ldsw + (i) * 8192), 16, 0, 0)
#define DB_STAGEA(bufoff, gbase, voff) do { DB_STAGEA1(bufoff, gbase, voff, 0); DB_STAGEA1(bufoff, gbase, voff, 1); } while (0)
#define DB_STAGEB(bufoff, gbase) do { DB_STAGEB1(bufoff, gbase, 0); DB_STAGEB1(bufoff, gbase, 1); } while (0)
#define DB_LDA(dst, b, h) do { dst[0] = ld6x<DB_SA(b, h)>(aA); dst[1] = ld6x<DB_SA(b, h) + 2048>(aA); dst[2] = ld6x<DB_SA(b, h) + 4096>(aA); dst[3] = ld6x<DB_SA(b, h) + 6144>(aA); } while (0)
#define DB_LDB(dst, b, h) do { dst[0] = ld6x<((b) * 2 + (h)) * HTB>(aB); dst[1] = ld6x<((b) * 2 + (h)) * HTB + 2048>(aB); } while (0)
#define DB_MMA(ai, bj, At, Bt) do { __builtin_amdgcn_s_setprio(1); _Pragma("unroll") for (int m = 0; m < 4; ++m) _Pragma("unroll") for (int n = 0; n < 2; ++n) \
        asm volatile("v_mfma_scale_f32_16x16x128_f8f6f4 %0, %1, %2, %0, %3, %4 op_sel_hi:[0,0,0] cbsz:2 blgp:2" : "+v"(acc[ai][bj][m][n]) : "v"(Bt[n]), "v"(At[m]), "v"(sc_w), "v"(sc_a)); __builtin_amdgcn_s_setprio(0); } while (0)
#define DB_MMA4(ai, bj, mlo, At, Bt) do { __builtin_amdgcn_s_setprio(1); _Pragma("unroll") for (int m = (mlo); m < (mlo) + 2; ++m) _Pragma("unroll") for (int n = 0; n < 2; ++n) \
        asm volatile("v_mfma_scale_f32_16x16x128_f8f6f4 %0, %1, %2, %0, %3, %4 op_sel_hi:[0,0,0] cbsz:2 blgp:2" : "+v"(acc[ai][bj][m][n]) : "v"(Bt[n]), "v"(At[m]), "v"(sc_w), "v"(sc_a)); __builtin_amdgcn_s_setprio(0); } while (0)
#define DB_SYNC() do { asm volatile("s_waitcnt vmcnt(8) lgkmcnt(0)" ::: "memory"); __builtin_amdgcn_s_barrier(); } while (0)
#define DB_SYNC6() do { asm volatile("s_waitcnt vmcnt(6) lgkmcnt(0)" ::: "memory"); __builtin_amdgcn_s_barrier(); } while (0)
#define DB_STEP(ai, At, sb, sa, gb, ga, vo) do { \
        DB_STAGEB1(sb, gb, 0); DB_SCHED; DB_MMA4(ai, 0, 0, At, B0); DB_SCHED; DB_STAGEB1(sb, gb, 1); DB_SCHED; DB_MMA4(ai, 0, 2, At, B0); DB_SCHED; \
        DB_STAGEA1(sa, ga, vo, 0); DB_SCHED; DB_MMA4(ai, 1, 0, At, B1); DB_SCHED; DB_STAGEA1(sa, ga, vo, 1); DB_SCHED; DB_MMA4(ai, 1, 2, At, B1); DB_SCHED; } while (0)
#define DB_SCHED __builtin_amdgcn_sched_barrier(0)
    Unit cur, nxt; int ui = 0;
    if (!S.next(0, cur)) return;
    f32x4 acc[2][2][4][2]; typename Epi::Pre pre;
    E.prefetch(pre, cur, wc, fq); E.init(acc, pre);
    v6i32 A0[4], A1[4], B0[2], B1[2];
    const int sc_w = 121, sc_a = 126;
    DB_AOFF(vc, 0);
    DB_STAGEB(DB_SB(0, 0), cur.B0); DB_STAGEA(DB_SA(0, 0), cur.A, vc[0]); DB_STAGEB(DB_SB(0, 1), cur.B1); DB_STAGEA(DB_SA(0, 1), cur.A, vc[1]);
    DB_STAGEB(DB_SB(1, 0), cur.B0 + kstep); DB_STAGEA(DB_SA(1, 0), cur.A + kstep, vc[0]); DB_STAGEB(DB_SB(1, 1), cur.B1 + kstep); DB_STAGEA(DB_SA(1, 1), cur.A + kstep, vc[1]);
    DB_SYNC();
    DB_LDB(B0, 0, 0); DB_LDB(B1, 0, 1); DB_LDA(A0, 0, 0); DB_SCHED;
    for (;;) {
        const bool has_next = S.next(ui + 1, nxt);
        const char* nA = has_next ? nxt.A : cur.A; const char* nB0 = has_next ? nxt.B0 : cur.B0; const char* nB1 = has_next ? nxt.B1 : cur.B1;
#pragma nounroll
        for (int t = 0; t < nt; t += 2) {
            const bool last = (t == nt - 2);
            const char* a2 = last ? nA : cur.A + (size_t)(t + 2) * kstep;
            const char* b20 = last ? nB0 : cur.B0 + (size_t)(t + 2) * kstep; const char* b21 = last ? nB1 : cur.B1 + (size_t)(t + 2) * kstep;
            const char* a3 = a2 + kstep; const char* b30 = b20 + kstep; const char* b31 = b21 + kstep;
            if (last && has_next) DB_AOFF(vc, ui + 1);
            DB_SYNC(); DB_LDA(A1, 0, 1); DB_SCHED; DB_STEP(0, A0, DB_SB(0, 0), DB_SA(0, 0), b20, a2, vc[0]);
            DB_SYNC6(); DB_LDA(A0, 1, 0); DB_SCHED; DB_STEP(1, A1, DB_SB(0, 1), DB_SA(0, 1), b21, a2, vc[1]); DB_LDB(B0, 1, 0); DB_LDB(B1, 1, 1); DB_SCHED;
            DB_SYNC(); DB_LDA(A1, 1, 1); DB_SCHED; DB_STEP(0, A0, DB_SB(1, 0), DB_SA(1, 0), b30, a3, vc[0]);
            DB_SYNC6(); if (!last) DB_LDA(A0, 0, 0); DB_SCHED; DB_STEP(1, A1, DB_SB(1, 1), DB_SA(1, 1), b31, a3, vc[1]); if (!last) { DB_LDB(B0, 0, 0); DB_LDB(B1, 0, 1); } DB_SCHED;
        }
        asm volatile("s_nop 15\n\ts_nop 15\n\ts_nop 15\n\ts_nop 15" ::: "memory");
        { const unsigned _l = (unsigned)__builtin_amdgcn_mbcnt_hi(~0u, __builtin_amdgcn_mbcnt_lo(~0u, 0u)); if (has_next) E.prefetch(pre, nxt, wc, (int)(_l >> 4)); E(acc, cur, wr, wc, (int)(_l & 15u), (int)(_l >> 4)); }
        if (!has_next) break;
        E.init(acc, pre);
        cur = nxt; ++ui;
        DB_LDB(B0, 0, 0); DB_LDB(B1, 0, 1); DB_LDA(A0, 0, 0); DB_SCHED;
    }
    asm volatile("s_waitcnt vmcnt(0) lgkmcnt(0)" ::: "memory");
    __builtin_amdgcn_s_barrier();
#undef DB_AOFF
#undef DB_SA
#undef DB_SB
#undef DB_STAGEA
#undef DB_STAGEB
#undef DB_LDA
#undef DB_LDB
#undef DB_MMA
#undef DB_SYNC
#undef DB_SYNC6
#undef DB_STEP
#undef DB_MMA4
#undef DB_STAGEA1
#undef DB_STAGEB1
#undef DB_SCHED
}

typedef f32x4 Acc[2][2][4][2];

struct EpiProj {
    static constexpr bool PERM = true, KEEPS = false;
    bf16_t* O; const float* bgate;
    __device__ __forceinline__ void operator()(Acc& acc, const Unit& u, int wr, int wc, int fr, int fq) const {
        const int row0 = u.r0 + wr * 64 + fr, col0 = u.c0 + wc * 32 + 8 * fq; const bool gate = u.c0 >= INW;
        f32x4 bv[2][2];
#pragma unroll
        for (int bj = 0; bj < 2; ++bj)
#pragma unroll
            for (int n = 0; n < 2; ++n) bv[bj][n] = gate ? *(const f32x4*)(bgate + (col0 - INW) + bj * HALF + 4 * n) : (f32x4){0.f, 0.f, 0.f, 0.f};
#pragma unroll
        for (int ai = 0; ai < 2; ++ai)
#pragma unroll
            for (int m = 0; m < 4; ++m) { bf16_t* rowp = O + (size_t)(row0 + ai * HALF + m * 16) * NP1 + col0;
#pragma unroll
                for (int bj = 0; bj < 2; ++bj) { f32x4 v0 = acc[ai][bj][m][0] + bv[bj][0], v1 = acc[ai][bj][m][1] + bv[bj][1];
                    if (gate) {
#pragma unroll
                        for (int j = 0; j < 4; ++j) { v0[j] = sigmoidf_fast(v0[j]); v1[j] = sigmoidf_fast(v1[j]); } }
                    u32x4 w; w.x = cvt_pk_bf16(v0[0], v0[1]); w.y = cvt_pk_bf16(v0[2], v0[3]); w.z = cvt_pk_bf16(v1[0], v1[1]); w.w = cvt_pk_bf16(v1[2], v1[3]);
                    *(u32x4*)(rowp + bj * HALF) = w; } }
    }
};
struct EpiBf16 {
    static constexpr bool PERM = true, KEEPS = false;
    bf16_t* O; int ldc; const float* cscale;
    __device__ __forceinline__ void operator()(Acc& acc, const Unit& u, int wr, int wc, int fr, int fq) const {
        const int row0 = u.r0 + wr * 64 + fr, col0 = u.c0 + wc * 32 + 8 * fq;
#pragma unroll
        for (int bj = 0; bj < 2; ++bj) {
            const f32x4 s0 = cscale ? *(const f32x4*)(cscale + col0 + bj * HALF) : (f32x4){1.f, 1.f, 1.f, 1.f}, s1 = cscale ? *(const f32x4*)(cscale + col0 + bj * HALF + 4) : (f32x4){1.f, 1.f, 1.f, 1.f};
#pragma unroll
            for (int ai = 0; ai < 2; ++ai)
#pragma unroll
                for (int m = 0; m < 4; ++m) { bf16_t* rowp = O + (size_t)(row0 + ai * HALF + m * 16) * ldc + col0;
                    const f32x4 v0 = acc[ai][bj][m][0] * s0, v1 = acc[ai][bj][m][1] * s1;
                    u32x4 w; w.x = cvt_pk_bf16(v0[0], v0[1]); w.y = cvt_pk_bf16(v0[2], v0[3]); w.z = cvt_pk_bf16(v1[0], v1[1]); w.w = cvt_pk_bf16(v1[2], v1[3]);
                    *(u32x4*)(rowp + bj * HALF) = w; } }
    }
};
struct EpiBranch {
    static constexpr bool PERM = true, KEEPS = true;
    const bf16_t* PG; bf16_t* MG;
    __device__ __forceinline__ bool keep(const Unit& u) const { return u.x == 0; }
    __device__ __forceinline__ void operator()(Acc& acc, const Unit& u, int wr, int wc, int fr, int fq) const {
        const int row0 = u.r0 + wr * 64 + fr, col0 = u.c0 + wc * 32 + 8 * fq; const int br = u.x;
#pragma unroll
        for (int ai = 0; ai < 2; ++ai)
#pragma unroll
            for (int m = 0; m < 4; ++m) { const size_t row = (size_t)(row0 + ai * HALF + m * 16);
#pragma unroll
                for (int bj = 0; bj < 2; ++bj) { const int col = col0 + bj * HALF;
                    const u32x4 gb = *(const u32x4*)(PG + row * NP1 + INW + D + col);
                    f32x4 h0 = {bf_lo(gb.x), bf_hi(gb.x), bf_lo(gb.y), bf_hi(gb.y)}, h1 = {bf_lo(gb.z), bf_hi(gb.z), bf_lo(gb.w), bf_hi(gb.w)};
#pragma unroll
                    for (int j = 0; j < 4; ++j) { h0[j] = fmaxf(h0[j], 1e-30f); h1[j] = fmaxf(h1[j], 1e-30f); }
                    if (br == 0) { const u32x4 ga = *(const u32x4*)(PG + row * NP1 + INW + col);
                        const f32x4 a0 = {bf_lo(ga.x), bf_hi(ga.x), bf_lo(ga.y), bf_hi(ga.y)}, a1 = {bf_lo(ga.z), bf_hi(ga.z), bf_lo(ga.w), bf_hi(ga.w)};
#pragma unroll
                        for (int j = 0; j < 4; ++j) { acc[ai][bj][m][0][j] *= a0[j] * __builtin_amdgcn_rcpf(h0[j]); acc[ai][bj][m][1][j] *= a1[j] * __builtin_amdgcn_rcpf(h1[j]); } }
                    else { const f32x4 v0 = acc[ai][bj][m][0] * h0, v1 = acc[ai][bj][m][1] * h1;
                        u32x4 w; w.x = cvt_pk_bf16(v0[0], v0[1]); w.y = cvt_pk_bf16(v0[2], v0[3]); w.z = cvt_pk_bf16(v1[0], v1[1]); w.w = cvt_pk_bf16(v1[2], v1[3]);
                        *(u32x4*)(MG + row * D + col) = w; } } }
    }
};
struct EpiResid {
    static constexpr bool PERM = false, KEEPS = false;
    const float* res; float* out; int ldc;
    __device__ __forceinline__ void operator()(Acc& acc, const Unit& u, int wr, int wc, int fr, int fq) const {
        const int row0 = u.r0 + wr * 64 + fr, col0 = u.c0 + wc * 32 + 4 * fq;
#pragma unroll
        for (int ai = 0; ai < 2; ++ai)
#pragma unroll
            for (int m = 0; m < 4; ++m) { const size_t off = (size_t)(row0 + ai * HALF + m * 16) * ldc + col0;
#pragma unroll
                for (int bj = 0; bj < 2; ++bj)
#pragma unroll
                    for (int n = 0; n < 2; ++n) { const f32x4 r = *(const f32x4*)(res + off + bj * HALF + n * 16); *(f32x4*)(out + off + bj * HALF + n * 16) = r + acc[ai][bj][m][n]; }
                asm volatile("" ::: "memory"); }
    }
};
struct EpiUp {
    static constexpr bool PERM = true, KEEPS = false;
    const float* bup; unsigned char* ACT;
    struct Pre { f32x4 bg[2], bl[2]; };
    __device__ __forceinline__ void prefetch(Pre& p, const Unit& u, int wc, int fq) const {
        const float* be = bup + (size_t)u.x * (2 * DFF) + u.c0 * HALF + wc * 32 + 8 * fq;
#pragma unroll
        for (int n = 0; n < 2; ++n) { p.bg[n] = *(const f32x4*)(be + 4 * n); p.bl[n] = *(const f32x4*)(be + DFF + 4 * n) + 1.0f; }
    }
    __device__ __forceinline__ void init(Acc& acc, const Pre& p) const {
#pragma unroll
        for (int ai = 0; ai < 2; ++ai)
#pragma unroll
            for (int m = 0; m < 4; ++m)
#pragma unroll
                for (int n = 0; n < 2; ++n) { acc[ai][0][m][n] = p.bg[n]; acc[ai][1][m][n] = p.bl[n]; }
    }
    __device__ __forceinline__ void operator()(Acc& acc, const Unit& u, int wr, int wc, int fr, int fq) const {
        const int row0 = u.r0 + wr * 64 + fr, col0 = u.c0 * HALF + wc * 32 + 8 * fq;
        typedef float f32x2v __attribute__((ext_vector_type(2)));
#pragma unroll
        for (int ai = 0; ai < 2; ++ai)
#pragma unroll
            for (int m = 0; m < 4; ++m) { unsigned char* rowp = ACT + (size_t)(row0 + ai * HALF + m * 16) * DFF + col0; f32x4 o[2];
#pragma unroll
                for (int n = 0; n < 2; ++n) { const f32x4 gv = acc[ai][0][m][n], lv = acc[ai][1][m][n];
#pragma unroll
                    for (int j = 0; j < 4; j += 2) {
                        const f32x2v g = {__builtin_amdgcn_fmed3f(gv[j], -3.0e38f, 7.0f), __builtin_amdgcn_fmed3f(gv[j + 1], -3.0e38f, 7.0f)}, l = {__builtin_amdgcn_fmed3f(lv[j], -6.0f, 8.0f), __builtin_amdgcn_fmed3f(lv[j + 1], -6.0f, 8.0f)};
                        const f32x2v t = g * -2.4554669595930156f; const f32x2v e = {__builtin_amdgcn_exp2f(t.x), __builtin_amdgcn_exp2f(t.y)}; const f32x2v d = e + 1.0f;
                        const f32x2v r = {__builtin_amdgcn_rcpf(d.x), __builtin_amdgcn_rcpf(d.y)}; const f32x2v q = (g * l) * r; o[n][j] = q.x; o[n][j + 1] = q.y; } }
                u32x2 w; w.x = pk4_fp8(o[0][0], o[0][1], o[0][2], o[0][3]); w.y = pk4_fp8(o[1][0], o[1][1], o[1][2], o[1][3]);
                *(u32x2*)rowp = w; }
    }
};
struct EpiDown {
    static constexpr bool PERM = true, KEEPS = false;
    const float* bdn; const int* rslot; const float* gate; unsigned char* SLOT;
    __device__ __forceinline__ void operator()(Acc& acc, const Unit& u, int wr, int wc, int fr, int fq) const {
        const int row0 = u.r0 + wr * 64 + fr, col0 = u.c0 * BM + wc * 32 + 8 * fq; const float* be = bdn + (size_t)u.x * D;
        f32x4 bv[2][2];
#pragma unroll
        for (int bj = 0; bj < 2; ++bj)
#pragma unroll
            for (int n = 0; n < 2; ++n) bv[bj][n] = *(const f32x4*)(be + col0 + bj * HALF + 4 * n);
#pragma unroll
        for (int ai = 0; ai < 2; ++ai)
#pragma unroll
            for (int m = 0; m < 4; ++m) { const int sl = rslot[row0 + ai * HALF + m * 16];
                if (sl >= 0) { const float gt = gate[sl] * 16.0f; unsigned char* rowp = SLOT + (size_t)sl * D + col0;
#pragma unroll
                    for (int bj = 0; bj < 2; ++bj) { const f32x4 v0 = (acc[ai][bj][m][0] + bv[bj][0]) * gt, v1 = (acc[ai][bj][m][1] + bv[bj][1]) * gt;
                        u32x2 w; w.x = pk4_fp8(v0[0], v0[1], v0[2], v0[3]); w.y = pk4_fp8(v1[0], v1[1], v1[2], v1[3]);
                        *(u32x2*)(rowp + bj * HALF) = w; } } }
    }
};
}

struct Frame {
    LAS unsigned char* lds;
    int tid, lane, wave, vcu, G;
};

__device__ __forceinline__ void cvt_item_addr(const float* W, int K, int N, bf16_t* WT, int row_off, int item, int lane, const float*& src, bf16_t*& dst) {
    const int nblk = N >> 5, kb = item / nblk, nb = item - kb * nblk, kl = lane >> 3, nl = lane & 7;
    src = W + (size_t)(64 * kb + 8 * kl) * N + 32 * nb + 4 * nl; dst = WT + (size_t)(row_off + 32 * nb + 4 * nl) * K + 64 * kb + 8 * kl;
}
__device__ __forceinline__ void cvt_store(const f32x4 (&v)[8], bf16_t* dst, int K) {
#pragma unroll
    for (int i = 0; i < 4; ++i) { u32x4 o; o.x = cvt_pk_bf16(v[0][i], v[1][i]); o.y = cvt_pk_bf16(v[2][i], v[3][i]); o.z = cvt_pk_bf16(v[4][i], v[5][i]); o.w = cvt_pk_bf16(v[6][i], v[7][i]);
        *(u32x4*)(dst + (size_t)i * K) = o; }
}
__device__ __forceinline__ void cvt_store8(const f32x4 (&v)[8], unsigned char* dst, int K) {
#pragma unroll
    for (int i = 0; i < 4; ++i) { u32x2 o; o.x = pk4_fp8(v[0][i] * 64.f, v[1][i] * 64.f, v[2][i] * 64.f, v[3][i] * 64.f); o.y = pk4_fp8(v[4][i] * 64.f, v[5][i] * 64.f, v[6][i] * 64.f, v[7][i] * 64.f);
        *(u32x2*)(dst + (size_t)i * K) = o; }
}
__device__ __forceinline__ void cvt_range(const float* W, int K, int N, bf16_t* WT, int row_off, int i0, int cnt, int r, int nw, int lane) {
    int it = i0 + r; const int end = i0 + cnt;
    for (; it + nw < end; it += 2 * nw) {
        const float* s0; bf16_t* d0; const float* s1; bf16_t* d1;
        cvt_item_addr(W, K, N, WT, row_off, it, lane, s0, d0); cvt_item_addr(W, K, N, WT, row_off, it + nw, lane, s1, d1);
        f32x4 a[8], b[8];
#pragma unroll
        for (int j = 0; j < 8; ++j) a[j] = *(const f32x4*)(s0 + (size_t)j * N);
#pragma unroll
        for (int j = 0; j < 8; ++j) b[j] = *(const f32x4*)(s1 + (size_t)j * N);
        cvt_store(a, d0, K); cvt_store(b, d1, K);
    }
    if (it < end) { const float* s0; bf16_t* d0; cvt_item_addr(W, K, N, WT, row_off, it, lane, s0, d0); f32x4 a[8];
#pragma unroll
        for (int j = 0; j < 8; ++j) a[j] = *(const f32x4*)(s0 + (size_t)j * N);
        cvt_store(a, d0, K); }
}
constexpr int CV_UP = NE * (D / 64) * (2 * DFF / 32), CV_DN = NE * (DFF / 64) * (D / 32), CV_ALL = CV_UP + CV_DN;
struct MoeW { const float* w_up; const float* w_down; unsigned char* WUPT; unsigned char* WDNT; };
__device__ __forceinline__ void cvt_moe_addr(const MoeW& mw, int chunk, int w, int h, int lane, const float*& src, unsigned char*& dst, int& N) {
    const int kl = lane >> 3, nl = lane & 7;
    if (chunk < CV_UP / 64) { const int e = chunk >> 6, cc = chunk & 63, kb = 8 * (cc >> 4) + w, nb = 8 * (cc & 15) + h; N = 2 * DFF;
        src = mw.w_up + (size_t)e * D * 2 * DFF + (size_t)(64 * kb + 8 * kl) * (2 * DFF) + 32 * nb + 4 * nl; dst = mw.WUPT + (size_t)e * 2 * DFF * D + (size_t)(32 * nb + 4 * nl) * D + 64 * kb + 8 * kl; }
    else { const int q = chunk - CV_UP / 64, e = q >> 5, cc = q & 31, kb = 8 * (cc >> 3) + w, nb = 8 * (cc & 7) + h; N = D;
        src = mw.w_down + (size_t)e * DFF * D + (size_t)(64 * kb + 8 * kl) * D + 32 * nb + 4 * nl; dst = mw.WDNT + (size_t)e * D * DFF + (size_t)(32 * nb + 4 * nl) * DFF + 64 * kb + 8 * kl; }
}
__device__ __forceinline__ f32x4 ld_nt(const float* p) { return __builtin_nontemporal_load((const f32x4*)p); }
constexpr int CV_WG = 64;
__device__ __forceinline__ int cvt_claim(unsigned* cursor, int cap, unsigned* done, unsigned need) {
    if (done && __hip_atomic_load(done, __ATOMIC_RELAXED, __HIP_MEMORY_SCOPE_AGENT) >= need) return CV_ALL;
    if ((int)__hip_atomic_load(cursor, __ATOMIC_RELAXED, __HIP_MEMORY_SCOPE_AGENT) >= cap) return CV_ALL;
    return (int)__hip_atomic_fetch_add(cursor, (unsigned)CV_WG, __ATOMIC_RELAXED, __HIP_MEMORY_SCOPE_AGENT);
}
__device__ __forceinline__ void cvt_pull(const MoeW& mw, unsigned* cursor, int cap, unsigned* done, unsigned need, volatile LAS int* slot, int tid, int wave, int lane) {
    __syncthreads();
    if (tid == 0) *slot = cvt_claim(cursor, cap, done, need);
    __syncthreads();
    int base = __builtin_amdgcn_readfirstlane(*slot);
    while (base < CV_ALL) {
        int nb = CV_ALL; if (tid == 0) nb = cvt_claim(cursor, cap, done, need);
        const int chunk = base >> 6;
        if (chunk < CV_UP / 64) {
            const int e = chunk >> 6, cc = chunk & 63, nb = 8 * (cc & 15) + wave, kl = lane >> 3, nl = lane & 7;
#pragma unroll 1
            for (int q = 0; q < 2; ++q) { const int kq = 2 * (cc >> 4) + q, kb32 = 8 * kq + kl;
                const float* src = mw.w_up + (size_t)e * D * 2 * DFF + (size_t)(32 * kb32) * (2 * DFF) + 32 * nb + 4 * nl;
                f32x4 a[32];
#pragma unroll
                for (int j = 0; j < 32; ++j) a[j] = ld_nt(src + (size_t)j * (2 * DFF));
                unsigned char* dst = mw.WUPT + (size_t)e * 2 * DFF * D + (size_t)(32 * nb + 4 * nl) * D + 128 * (kb32 >> 2) + 16 * (kb32 & 3);
#pragma unroll
                for (int i = 0; i < 4; ++i) { f32x16 lo, hi;
#pragma unroll
                    for (int j = 0; j < 16; ++j) { lo[j] = a[j][i] * 64.f; hi[j] = a[16 + j][i] * 64.f; }
                    st_fp6_block(dst + (size_t)i * D, pk32_fp6(lo, hi)); } }
        } else
#pragma unroll
        for (int h = 0; h < 8; h += 4) {
            const float* s0; unsigned char* d0; const float* s1; unsigned char* d1; const float* s2; unsigned char* d2; const float* s3; unsigned char* d3; int N0, N1, N2, N3;
            cvt_moe_addr(mw, chunk, wave, h, lane, s0, d0, N0); cvt_moe_addr(mw, chunk, wave, h + 1, lane, s1, d1, N1); cvt_moe_addr(mw, chunk, wave, h + 2, lane, s2, d2, N2); cvt_moe_addr(mw, chunk, wave, h + 3, lane, s3, d3, N3);
            f32x4 a[8], b[8], c[8], d[8];
#pragma unroll
            for (int j = 0; j < 8; ++j) a[j] = ld_nt(s0 + (size_t)j * N0);
#pragma unroll
            for (int j = 0; j < 8; ++j) b[j] = ld_nt(s1 + (size_t)j * N1);
#pragma unroll
            for (int j = 0; j < 8; ++j) c[j] = ld_nt(s2 + (size_t)j * N2);
#pragma unroll
            for (int j = 0; j < 8; ++j) d[j] = ld_nt(s3 + (size_t)j * N3);
            cvt_store8(a, d0, D); cvt_store8(b, d1, D); cvt_store8(c, d2, D); cvt_store8(d, d3, D);
        }
        __syncthreads();
        if (tid == 0) *slot = nb;
        __syncthreads();
        base = __builtin_amdgcn_readfirstlane(*slot);
    }
}
__device__ __forceinline__ void rms_row_to_bf16(const float* xrow, const float* gvec, bf16_t* orow, int lane) {
    const f32x4* xr = (const f32x4*)xrow + lane; f32x4 v[8]; float s = 0.f;
#pragma unroll
    for (int j = 0; j < 8; ++j) { v[j] = xr[64 * j]; s += (v[j].x * v[j].x + v[j].y * v[j].y) + (v[j].z * v[j].z + v[j].w * v[j].w); }
    const float rstd = 1.0f / sqrtf(wave_sum(s) * (1.0f / D) + RMS_EPS);
    const f32x4* gr = (const f32x4*)gvec + lane; u32x2* o8 = (u32x2*)orow + lane;
#pragma unroll
    for (int j = 0; j < 8; ++j) { const f32x4 g = gr[64 * j]; const f32x4 y = v[j] * rstd * g; u32x2 w; w.x = cvt_pk_bf16(y.x, y.y); w.y = cvt_pk_bf16(y.z, y.w); o8[64 * j] = w; }
}

__device__ __forceinline__ unsigned voff_b(unsigned row, unsigned ch) { return 256u * row + 16u * (ch ^ (((row & 3u) << 2) | ((row >> 2) & 3u))); }
__device__ __forceinline__ s16x4 vtr(const LAS unsigned char* p) { return __builtin_bit_cast(s16x4, __builtin_amdgcn_ds_read_tr16_b64_v4i16((LAS s16x4*)p)); }

__device__ __forceinline__ void sb_wg_unit(const bf16_t* PG, bf16_t* OA, int h, int qb, LAS unsigned char* lds, volatile LAS int* flags, int tid, int wave, int lane) {
    const int fr = lane & 15, fq = lane >> 4, q0w = qb * 128 + wave * 16, qi = q0w + fr;
    bf16x8 Qf[4];
    { const bf16_t* qp = PG + (size_t)qi * NP1 + h * HD + 8 * fq;
#pragma unroll
      for (int ks = 0; ks < 4; ++ks) Qf[ks] = *(const bf16x8*)(qp + 32 * ks); }
    f32x4 O[8];
#pragma unroll
    for (int db = 0; db < 8; ++db) O[db] = (f32x4){0.f, 0.f, 0.f, 0.f};
    float carry = 0.f; bool sat = false;
    const float scale = 0.08838834764831845f;
    const unsigned p = fr & 3, qq = fr >> 2;
    const int jt_hi = 2 * qb + 1, jt_w = q0w >> 6;
    const int srow = tid >> 4, sch = tid & 15;
    const bf16_t* kg = PG + (size_t)srow * NP1 + SBW + h * HD + 8 * sch;
    u32x4 kr[2], vr[2];
    __syncthreads();
    if (tid < 8) flags[tid] = 0;
    { const bf16_t* g = kg + (size_t)(jt_hi * 64) * NP1;
#pragma unroll
      for (int i = 0; i < 2; ++i) { kr[i] = *(const u32x4*)(g + (size_t)(32 * i) * NP1); vr[i] = *(const u32x4*)(g + (size_t)(32 * i) * NP1 + SBW); } }
    for (int jt = jt_hi, it = 0; jt >= 0; --jt, ++it) {
        LAS unsigned char* kb = lds + (it & 1) * 32768; LAS unsigned char* vb = kb + 16384;
#pragma unroll
        for (int i = 0; i < 2; ++i) { *(LAS u32x4*)(kb + voff_b(srow + 32 * i, sch)) = kr[i]; *(LAS u32x4*)(vb + voff_b(srow + 32 * i, sch)) = vr[i]; }
        __syncthreads();
        { int ns = 0;
#pragma unroll
          for (int w = 0; w < 8; ++w) ns += flags[w];
          if (__builtin_amdgcn_readfirstlane(ns) == 8) break; }
        if (jt > 0) { const bf16_t* g = kg + (size_t)((jt - 1) * 64) * NP1;
#pragma unroll
            for (int i = 0; i < 2; ++i) { kr[i] = *(const u32x4*)(g + (size_t)(32 * i) * NP1); vr[i] = *(const u32x4*)(g + (size_t)(32 * i) * NP1 + SBW); } }
        if (!sat && jt <= jt_w) {
            const int key0 = jt * 64;
            f32x4 z[4];
#pragma unroll
            for (int sb = 0; sb < 4; ++sb) { z[sb] = (f32x4){0.f, 0.f, 0.f, 0.f};
#pragma unroll
                for (int ks = 0; ks < 4; ++ks) { const bf16x8 kf = *(const LAS bf16x8*)(kb + voff_b(16 * sb + fr, 4 * ks + fq)); z[sb] = __builtin_amdgcn_mfma_f32_16x16x32_bf16(kf, Qf[ks], z[sb], 0, 0, 0); } }
            float sfx[4][4], g[4], lex[4], T[4];
            const bool diag = key0 + 64 > q0w;
#pragma unroll
            for (int sb = 0; sb < 4; ++sb) {
                float sp[4];
#pragma unroll
                for (int i = 0; i < 4; ++i) { const float y = z[sb][i] * (scale * 1.4426950408889634f); z[sb][i] = y;
                    sp[i] = fmaxf(y, 0.f) + __builtin_amdgcn_logf(1.0f + __builtin_amdgcn_exp2f(-fabsf(y))); }
                if (diag) {
#pragma unroll
                    for (int i = 0; i < 4; ++i) { const int key = key0 + 16 * sb + 4 * fq + i; sp[i] = (key < qi) ? sp[i] : 0.f; } }
                sfx[sb][3] = sp[3]; sfx[sb][2] = sp[2] + sfx[sb][3]; sfx[sb][1] = sp[1] + sfx[sb][2]; sfx[sb][0] = sp[0] + sfx[sb][1]; g[sb] = sfx[sb][0];
            }
#pragma unroll
            for (int sb = 0; sb < 4; ++sb) { const float x1 = __shfl_xor(g[sb], 16), x2 = __shfl_xor(g[sb], 32), x3 = __shfl_xor(g[sb], 48);
                T[sb] = (g[sb] + x1) + (x2 + x3); lex[sb] = ((fq & 1) ? 0.f : x1) + ((fq < 2) ? (x2 + x3) : 0.f); }
            float run = carry; bf16x8 Wf[2]; unsigned wpk[8];
#pragma unroll
            for (int sb = 3; sb >= 0; --sb) { const float base = run + lex[sb]; float w[4];
#pragma unroll
                for (int i = 0; i < 4; ++i) w[i] = __builtin_amdgcn_exp2f(z[sb][i] - (base + sfx[sb][i]));
                if (diag) {
#pragma unroll
                    for (int i = 0; i < 4; ++i) { const int key = key0 + 16 * sb + 4 * fq + i; w[i] = (key < qi) ? w[i] : 0.f; } }
                wpk[2 * sb] = cvt_pk_bf16(w[0], w[1]); wpk[2 * sb + 1] = cvt_pk_bf16(w[2], w[3]); run += T[sb]; }
            carry = run;
            { u32x4 a = {wpk[0], wpk[1], wpk[2], wpk[3]}, b = {wpk[4], wpk[5], wpk[6], wpk[7]}; Wf[0] = __builtin_bit_cast(bf16x8, a); Wf[1] = __builtin_bit_cast(bf16x8, b); }
#pragma unroll
            for (int db = 0; db < 8; ++db)
#pragma unroll
                for (int m = 0; m < 2; ++m) { const unsigned r1 = 32 * m + 4 * fq + qq, r2 = r1 + 16;
                    const s16x4 lo = vtr(vb + voff_b(r1, 2 * db + (p >> 1)) + 8 * (p & 1)), hi = vtr(vb + voff_b(r2, 2 * db + (p >> 1)) + 8 * (p & 1));
                    const bf16x8 vf = {lo[0], lo[1], lo[2], lo[3], hi[0], hi[1], hi[2], hi[3]};
                    O[db] = __builtin_amdgcn_mfma_f32_16x16x32_bf16(vf, Wf[m], O[db], 0, 0, 0); }
            if (__all(carry > 150.1f)) { sat = true; if (lane == 0) flags[wave] = 1; }
        }
    }
    { bf16_t* op = OA + (size_t)qi * SBW + h * HD + 4 * fq;
#pragma unroll
      for (int db = 0; db < 8; ++db) { u32x2 w; w.x = cvt_pk_bf16(O[db][0], O[db][1]); w.y = cvt_pk_bf16(O[db][2], O[db][3]); *(u32x2*)(op + 16 * db) = w; } }
}

__device__ __forceinline__ void xa_unit(const bf16_t* QXA, const bf16_t* KVM, bf16_t* OXA, int h, int qb, const LAS unsigned char* vl, int lane) {
    const int fr = lane & 15, fq = lane >> 4, q0 = qb * 16, qi = q0 + fr;
    bf16x8 Qf[4];
    { const bf16_t* qp = QXA + (size_t)qi * XAW + h * HD + 8 * fq;
#pragma unroll
      for (int ks = 0; ks < 4; ++ks) Qf[ks] = *(const bf16x8*)(qp + 32 * ks); }
    f32x4 z[16];
    { const bf16_t* kp = KVM + (size_t)fr * (2 * XAW) + h * HD + 8 * fq;
#pragma unroll
      for (int sb = 0; sb < 16; ++sb) { z[sb] = (f32x4){0.f, 0.f, 0.f, 0.f};
#pragma unroll
          for (int ks = 0; ks < 4; ++ks) { const bf16x8 kf = *(const bf16x8*)(kp + (size_t)(16 * sb) * (2 * XAW) + 32 * ks); z[sb] = __builtin_amdgcn_mfma_f32_16x16x32_bf16(kf, Qf[ks], z[sb], 0, 0, 0); } } }
    const float scale = 0.08838834764831845f * 1.4426950408889634f;
    float mx = -3.0e38f;
#pragma unroll
    for (int sb = 0; sb < 16; ++sb)
#pragma unroll
        for (int i = 0; i < 4; ++i) { z[sb][i] *= scale; mx = fmaxf(mx, z[sb][i]); }
    mx = fmaxf(mx, __shfl_xor(mx, 16)); mx = fmaxf(mx, __shfl_xor(mx, 32));
    float sum = 0.f;
#pragma unroll
    for (int sb = 0; sb < 16; ++sb)
#pragma unroll
        for (int i = 0; i < 4; ++i) { const float e = __builtin_amdgcn_exp2f(z[sb][i] - mx); z[sb][i] = e; sum += e; }
    sum += __shfl_xor(sum, 16); sum += __shfl_xor(sum, 32);
    const float inv = 1.0f / sum;
    f32x4 O[8];
#pragma unroll
    for (int db = 0; db < 8; ++db) O[db] = (f32x4){0.f, 0.f, 0.f, 0.f};
    const unsigned p = fr & 3, qq = fr >> 2;
#pragma unroll
    for (int m = 0; m < 8; ++m) {
        u32x4 a = {cvt_pk_bf16(z[2 * m][0], z[2 * m][1]), cvt_pk_bf16(z[2 * m][2], z[2 * m][3]), cvt_pk_bf16(z[2 * m + 1][0], z[2 * m + 1][1]), cvt_pk_bf16(z[2 * m + 1][2], z[2 * m + 1][3])};
        const bf16x8 Wf = __builtin_bit_cast(bf16x8, a);
#pragma unroll
        for (int db = 0; db < 8; ++db) { const unsigned r1 = 32 * m + 4 * fq + qq, r2 = r1 + 16;
            const s16x4 lo = vtr(vl + voff_b(r1, 2 * db + (p >> 1)) + 8 * (p & 1)), hi = vtr(vl + voff_b(r2, 2 * db + (p >> 1)) + 8 * (p & 1));
            const bf16x8 vf = {lo[0], lo[1], lo[2], lo[3], hi[0], hi[1], hi[2], hi[3]};
            O[db] = __builtin_amdgcn_mfma_f32_16x16x32_bf16(vf, Wf, O[db], 0, 0, 0); }
    }
    { bf16_t* op = OXA + (size_t)qi * XAW + h * HD + 4 * fq;
#pragma unroll
      for (int db = 0; db < 8; ++db) { const f32x4 o = O[db] * inv; u32x2 w; w.x = cvt_pk_bf16(o[0], o[1]); w.y = cvt_pk_bf16(o[2], o[3]); *(u32x2*)(op + 16 * db) = w; } }
}

template <int W>
__device__ __forceinline__ void pool_run(const bf16_t* PG, bf16_t* PO, int t0, int ch) {
    constexpr int NR = W + 7;
    const bf16_t* pp = PG + (size_t)(t0 + 7) * NP1 + 3 * SBW + ch * 8;
    u32x4 v[NR];
#pragma unroll
    for (int k = 0; k < NR; ++k) v[k] = (t0 + 7 - k >= 0) ? *(const u32x4*)(pp - (size_t)k * NP1) : (u32x4){0u, 0u, 0u, 0u};
#pragma unroll
    for (int i = 0; i < 8; ++i) {
        float s[8];
#pragma unroll
        for (int j = 0; j < 8; ++j) s[j] = 0.f;
#pragma unroll
        for (int j = W - 1; j >= 0; --j) { const u32x4 x = v[7 - i + j];
            s[0] += bf_lo(x.x); s[1] += bf_hi(x.x); s[2] += bf_lo(x.y); s[3] += bf_hi(x.y); s[4] += bf_lo(x.z); s[5] += bf_hi(x.z); s[6] += bf_lo(x.w); s[7] += bf_hi(x.w); }
        const int t = t0 + i, n = (t + 1 < W) ? (t + 1) : W; const float inv = 1.0f / (float)n; const u32x4 me = v[7 - i]; u32x4 o;
        o.x = cvt_pk_bf16(s[0] * inv - bf_lo(me.x), s[1] * inv - bf_hi(me.x)); o.y = cvt_pk_bf16(s[2] * inv - bf_lo(me.y), s[3] * inv - bf_hi(me.y));
        o.z = cvt_pk_bf16(s[4] * inv - bf_lo(me.z), s[5] * inv - bf_hi(me.z)); o.w = cvt_pk_bf16(s[6] * inv - bf_lo(me.w), s[7] * inv - bf_hi(me.w));
        *(u32x4*)(PO + (size_t)t * POOLW + ch * 8) = o;
    }
}

constexpr int NPHASE = 15;
struct Args { const float* in[24]; float* out; unsigned char* ws; int ph_lo, ph_hi; };
static_assert(sizeof(Args) == 24 * 8 + 8 + 8 + 8, "Args has no padding");

__global__ void __launch_bounds__(NWAVES * 64, 2) moe_fwd(Args args) {
    extern __shared__ __attribute__((aligned(16))) unsigned char lds_raw[];
    Frame F;
    F.lds = (LAS unsigned char*)lds_raw;
    F.tid = threadIdx.x; F.lane = F.tid & 63; F.wave = __builtin_amdgcn_readfirstlane(F.tid >> 6);
    F.G = gridDim.x; { const int bx = blockIdx.x; F.vcu = (F.G % 8 == 0) ? (bx % 8) * (F.G / 8) + bx / 8 : bx; }
    unsigned char* ws = args.ws;
    unsigned* ctl = (unsigned*)(ws + WS_CTL);
    LAS unsigned char* lx = F.lds + LDS_X_OFF;
    for (int u = F.tid; u < (LDS_BYTES - LDS_X_OFF) / 4; u += NWAVES * 64) ((LAS unsigned*)lx)[u] = 0u;
    __syncthreads();
#if MK_ONE_LAUNCH
    XcdBarrier bar = xcd_barrier_post(ctl + CW_BAR, (volatile LAS unsigned*)(lx + LX_BAR));
#define GRID_BAR() xcd_barrier(bar)
#else
#define GRID_BAR() do {} while (0)
#endif
    const int lo = args.ph_lo, hi = args.ph_hi;
#ifndef PHASE_MASK
#define PHASE_MASK 0x7fff
#endif
#define IN(k) (((PHASE_MASK >> (k)) & 1) && lo <= (k) && (k) < hi)
#define SEAM(k) do { if (IN((k) + 1)) GRID_BAR(); } while (0)

    const float* x = args.in[0]; const float* mem = args.in[1]; const float* norm_mix = args.in[2]; const float* w_in = args.in[3]; const float* pool_lin = args.in[4];
    const float* pool_scale = args.in[5]; const float* w_branch_a = args.in[6]; const float* w_branch_b = args.in[7]; const float* w_gate = args.in[8]; const float* b_gate = args.in[9];
    const float* w_mix_out = args.in[10]; const float* xa_norm = args.in[11]; const float* mem_norm = args.in[12]; const float* xa_wq = args.in[13]; const float* xa_wkv = args.in[14];
    const float* xa_wo = args.in[15]; const float* moe_norm = args.in[16]; const float* w_router = args.in[17]; const float* b_router = args.in[18]; const float* w_up = args.in[19];
    const float* b_up = args.in[20]; const float* w_down = args.in[21]; const float* b_down = args.in[22]; const float* final_norm = args.in[23];
    bf16_t* W1T = (bf16_t*)(ws + WS_W1T); bf16_t* WAT = (bf16_t*)(ws + WS_WAT); bf16_t* WBT = (bf16_t*)(ws + WS_WBT); bf16_t* WMT = (bf16_t*)(ws + WS_WMT); bf16_t* PLT = (bf16_t*)(ws + WS_PLT);
    bf16_t* WQT = (bf16_t*)(ws + WS_WQT); bf16_t* WKVT = (bf16_t*)(ws + WS_WKVT); bf16_t* WOT = (bf16_t*)(ws + WS_WOT); unsigned char* WUPT = ws + WS_WUPT; unsigned char* WDNT = ws + WS_WDNT;
    bf16_t* U = (bf16_t*)(ws + WS_U); bf16_t* MEMN = (bf16_t*)(ws + WS_MEMN); bf16_t* PG = (bf16_t*)(ws + WS_PG); bf16_t* OA = (bf16_t*)(ws + WS_OA); bf16_t* PO = (bf16_t*)(ws + WS_PO);
    bf16_t* OB = (bf16_t*)(ws + WS_OB); float* TMP = (float*)(ws + WS_TMP); bf16_t* MG = (bf16_t*)(ws + WS_MG); float* H1 = (float*)(ws + WS_H1); bf16_t* U2 = (bf16_t*)(ws + WS_U2);
    bf16_t* QXA = (bf16_t*)(ws + WS_QXA); bf16_t* KVM = (bf16_t*)(ws + WS_KVM); bf16_t* OXA = (bf16_t*)(ws + WS_OXA); float* H2 = (float*)(ws + WS_H2); unsigned char* TB = ws + WS_TB;
    bf16_t* ROWS = (bf16_t*)(ws + WS_ROWS); unsigned char* ACT = ws + WS_ACT; unsigned char* SLOT = ws + WS_SLOT;
    int* ASGE = (int*)(ws + WS_ASGE); int* ASGP = (int*)(ws + WS_ASGP); float* GATE = (float*)(ws + WS_GATE); int* RSLOT = (int*)(ws + WS_RSLOT);
    int* CNT = (int*)(ctl + CW_CNT); bf16_t* WRT = (bf16_t*)(ws + WS_WRT);
    const int gw = F.vcu * NWAVES + F.wave, NGW = F.G * NWAVES;
    const MoeW mw{w_up, w_down, WUPT, WDNT};
    unsigned* CUR = ctl + CW_CUR; volatile LAS int* cvs = (volatile LAS int*)(lx + LX_CVS);
#define CVT_PULL(cap) cvt_pull(mw, CUR, (cap), nullptr, 0u, cvs, F.tid, F.wave, F.lane)
#define CVT_BESIDE(cap, ph, need) cvt_pull(mw, CUR, (cap), ctl + CW_DONE + 64 * (ph), (unsigned)(need), cvs, F.tid, F.wave, F.lane)
#define MARK_DONE(ph) do { if (F.tid == 0) __hip_atomic_fetch_add(ctl + CW_DONE + 64 * (ph), 1u, __ATOMIC_RELAXED, __HIP_MEMORY_SCOPE_AGENT); } while (0)

    if (IN(0)) {
        constexpr int I_IN = (D / 64) * (INW / 32), I_BR = (SBW / 64) * (D / 32), I_MX = (D / 64) * (D / 32), I_PL = (256 / 64) * (256 / 32);
        constexpr int I_Q = (D / 64) * (XAW / 32), I_KV = (D / 64) * (2 * XAW / 32), I_O = (XAW / 64) * (D / 32);
        cvt_range(w_in, D, INW, W1T, 0, 0, I_IN, gw, NGW, F.lane);
        cvt_range(w_gate, D, INW, W1T, INW, 0, I_IN, gw, NGW, F.lane);
        for (int m = gw; m < S; m += NGW) rms_row_to_bf16(x + (size_t)m * D, norm_mix, U + (size_t)m * D, F.lane);
        for (int m = gw; m < MEM; m += NGW) rms_row_to_bf16(mem + (size_t)m * D, mem_norm, MEMN + (size_t)m * D, F.lane);
        for (int i = blockIdx.x * (NWAVES * 64) + F.tid; i < NE * D / 2; i += F.G * NWAVES * 64) {
            const int e = i >> 10, c = (i & 1023) * 2; const float a = w_router[(size_t)c * NE + e], b = w_router[(size_t)(c + 1) * NE + e];
            const unsigned hi = cvt_pk_bf16(a, b); const unsigned lo = cvt_pk_bf16(a - bf_lo(hi), b - bf_hi(hi));
            *(unsigned*)(WRT + (size_t)e * D + c) = hi; *(unsigned*)(WRT + (size_t)(NE + e) * D + c) = lo; }
        __syncthreads();
        SEAM(0);
    }

    if (IN(1)) {
        const int gc = (F.G == 256) ? GC_P1 : F.G;
        if ((int)blockIdx.x < gc) {
            pg8::DenseSched Sc{(const char*)U, (const char*)W1T, D, D, S / 256, NP1 / 256, gc, (int)blockIdx.x};
            pg8::EpiProj E{PG, b_gate};
            pg8::gemm_phase<pg8::EpiProj, pg8::DenseSched, true>(F.lds, D, D, D, Sc, E);
            MARK_DONE(1);
        }
        if ((int)blockIdx.x >= gc) {
            constexpr int I_BR = (SBW / 64) * (D / 32), I_MX = (D / 64) * (D / 32), I_PL = (256 / 64) * (256 / 32), I_Q = (D / 64) * (XAW / 32), I_KV = (D / 64) * (2 * XAW / 32), I_O = (XAW / 64) * (D / 32);
            const int cr = ((int)blockIdx.x - gc) * NWAVES + F.wave, cn = (F.G - gc) * NWAVES;
        cvt_range(w_branch_a, SBW, D, WAT, 0, 0, I_BR, cr, cn, F.lane);
        cvt_range(w_branch_b, POOLW, D, WBT, 0, 0, I_BR, cr, cn, F.lane);
        cvt_range(w_mix_out, D, D, WMT, 0, 0, I_MX, cr, cn, F.lane);
        for (int g = 0; g < 4; ++g) cvt_range(pool_lin + (size_t)g * 65536, 256, 256, PLT + (size_t)g * 65536, 0, 0, I_PL, cr, cn, F.lane);
        cvt_range(xa_wq, D, XAW, WQT, 0, 0, I_Q, cr, cn, F.lane);
        cvt_range(xa_wkv, D, 2 * XAW, WKVT, 0, 0, I_KV, cr, cn, F.lane);
        cvt_range(xa_wo, XAW, D, WOT, 0, 0, I_O, cr, cn, F.lane);
        }
        CVT_BESIDE(CV_UP, 1, gc);
        SEAM(1);
    }

    if (IN(2)) {
        for (int it = blockIdx.x * (NWAVES * 64) + F.tid; it < (S / 8) * (POOLW / 8); it += F.G * NWAVES * 64) {
            const int wv = it >> 6, g = wv & 3, rb = (wv >> 2) * 2 + (F.lane >> 5), ch = g * 32 + (F.lane & 31), t0 = rb * 8;
            if (g == 0) pool_run<2>(PG, PO, t0, ch); else if (g == 1) pool_run<4>(PG, PO, t0, ch); else if (g == 2) pool_run<8>(PG, PO, t0, ch); else pool_run<16>(PG, PO, t0, ch);
        }
        for (int it = F.vcu; it < SBH * (S / 128); it += F.G) { const int h = it & 7, qb = (S / 128 - 1) - (it >> 3); sb_wg_unit(PG, OA, h, qb, F.lds, (volatile LAS int*)(lx + LX_SBF), F.tid, F.wave, F.lane); }
        __syncthreads();
        SEAM(2);
    }

    if (IN(3)) {
        pg8::PoolSched Sc{(const char*)PO, (const char*)PLT, F.G, F.vcu};
        pg8::EpiBf16 E{OB, POOLW, pool_scale};
        pg8::gemm_phase<pg8::EpiBf16, pg8::PoolSched, true>(F.lds, 256, POOLW, 256, Sc, E);
        if (F.vcu < (S / 256) * 4) MARK_DONE(3);
        CVT_BESIDE(CV_UP, 3, (S / 256) * 4);
        SEAM(3);
    }

    if (IN(4)) {
        pg8::BranchSched Sc{(const char*)OA, (const char*)OB, (const char*)WAT, (const char*)WBT, SBW, SBW, S / 256, D / 256, F.G, (int)blockIdx.x};
        pg8::EpiBranch E{PG, MG};
        pg8::gemm_phase<pg8::EpiBranch, pg8::BranchSched, true>(F.lds, SBW, SBW, SBW, Sc, E);
        SEAM(4);
    }

    if (IN(5)) {
        pg8::DenseSched Sc{(const char*)MG, (const char*)WMT, D, D, S / 256, D / 256, F.G, (int)blockIdx.x};
        pg8::EpiResid E{x, H1, D};
        pg8::gemm_phase<pg8::EpiResid, pg8::DenseSched, true>(F.lds, D, D, D, Sc, E);
        SEAM(5);
    }

    if (IN(6)) {
        for (int m = gw; m < S; m += NGW) rms_row_to_bf16(H1 + (size_t)m * D, xa_norm, U2 + (size_t)m * D, F.lane);
        SEAM(6);
    }

    if (IN(7)) {
        { pg8::DenseSched Sc{(const char*)U2, (const char*)WQT, D, D, S / 256, XAW / 256, F.G, (int)blockIdx.x};
          pg8::EpiBf16 E{QXA, XAW, nullptr};
          pg8::gemm_phase<pg8::EpiBf16, pg8::DenseSched, true>(F.lds, D, D, D, Sc, E); }
        { const int c2 = ((int)blockIdx.x >= 64) ? (int)blockIdx.x - 64 : (int)blockIdx.x + F.G - 64;
          pg8::DenseSched Sc{(const char*)MEMN, (const char*)WKVT, D, D, MEM / 256, 2 * XAW / 256, F.G, c2};
          pg8::EpiBf16 E{KVM, 2 * XAW, nullptr};
          pg8::gemm_phase<pg8::EpiBf16, pg8::DenseSched, true>(F.lds, D, D, D, Sc, E); }
        if ((int)blockIdx.x < 68) MARK_DONE(7);
        CVT_BESIDE(CV_UP, 7, 68);
        SEAM(7);
    }

    if (IN(8)) {
        for (int it = F.vcu; it < XAH * (S / 128); it += F.G) {
            const int h = it & 3, qg = it >> 2;
            __syncthreads();
#pragma unroll
            for (int t = 0; t < 8; ++t) { const int c = t * 512 + F.tid, row = c >> 4, ch = c & 15;
                const u32x4 vv = *(const u32x4*)(KVM + (size_t)row * (2 * XAW) + XAW + h * HD + 8 * ch); *(LAS u32x4*)(F.lds + voff_b(row, ch)) = vv; }
            __syncthreads();
            xa_unit(QXA, KVM, OXA, h, qg * 8 + F.wave, F.lds, F.lane);
        }
        __syncthreads();
        SEAM(8);
    }

    if (IN(9)) {
        pg8::DenseSched Sc{(const char*)OXA, (const char*)WOT, XAW, XAW, S / 256, D / 256, F.G, (int)blockIdx.x};
        pg8::EpiResid E{H1, H2, D};
        pg8::gemm_phase<pg8::EpiResid, pg8::DenseSched, true>(F.lds, XAW, XAW, XAW, Sc, E);
        SEAM(9);
    }

    if (IN(10)) {
        for (int i = blockIdx.x * (NWAVES * 64) + F.tid; i < PROWS; i += F.G * NWAVES * 64) RSLOT[i] = -1;
        LAS unsigned char* thi = F.lds;
        LAS float* lg = (LAS float*)(lx + LX_LOG);
        LAS float* part = (LAS float*)(lx + LX_RPART);
        for (int rg = F.vcu; rg < S / 16; rg += F.G) {
            __syncthreads();
#pragma unroll
            for (int rr = 0; rr < 2; ++rr) { const int r = 2 * F.wave + rr, m = rg * 16 + r;
                const f32x4* xr = (const f32x4*)(H2 + (size_t)m * D) + F.lane; f32x4 v[8]; float s = 0.f;
#pragma unroll
                for (int j = 0; j < 8; ++j) { v[j] = xr[64 * j]; s += (v[j].x * v[j].x + v[j].y * v[j].y) + (v[j].z * v[j].z + v[j].w * v[j].w); }
                const float rstd = 1.0f / sqrtf(wave_sum(s) * (1.0f / D) + RMS_EPS);
                const f32x4* gr = (const f32x4*)moe_norm + F.lane;
#pragma unroll
                for (int j = 0; j < 8; ++j) { const f32x4 g = gr[64 * j]; const f32x4 y = v[j] * rstd * g; u32x2 w; w.x = cvt_pk_bf16(y.x, y.y); w.y = cvt_pk_bf16(y.z, y.w);
                    u32x2 l; l.x = cvt_pk_bf16(y.x - bf_lo(w.x), y.y - bf_hi(w.x)); l.y = cvt_pk_bf16(y.z - bf_lo(w.y), y.w - bf_hi(w.y));
                    const unsigned off = (unsigned)r * 4096u + ((((unsigned)F.lane >> 1) + 32u * j) ^ (unsigned)r) * 16u + (F.lane & 1) * 8u;
                    *(LAS u32x2*)(thi + off) = w; *(LAS u32x2*)(thi + 65536 + off) = l; } }
            __syncthreads();
#pragma unroll
            for (int q = 0; q < 2; ++q) { const int blk = F.tid + 512 * q, r = blk >> 6, kb32 = blk & 63; f32x16 lo, hi;
#pragma unroll
                for (int c4 = 0; c4 < 4; ++c4) { const u32x4 v = *(const LAS u32x4*)(thi + r * 4096 + ((unsigned)((4 * kb32 + c4) ^ r) * 16u));
                    const float f[8] = {bf_lo(v.x), bf_hi(v.x), bf_lo(v.y), bf_hi(v.y), bf_lo(v.z), bf_hi(v.z), bf_lo(v.w), bf_hi(v.w)};
#pragma unroll
                    for (int j = 0; j < 8; ++j) { if (c4 < 2) lo[8 * c4 + j] = f[j] * 2.0f; else hi[8 * (c4 - 2) + j] = f[j] * 2.0f; } }
                st_fp6_block(TB + (size_t)(rg * 16 + r) * D + 128 * (kb32 >> 2) + 16 * (kb32 & 3), pk32_fp6(lo, hi)); }
            { const int fr = F.lane & 15, fq = F.lane >> 4; f32x4 c0 = {0.f, 0.f, 0.f, 0.f}, c1 = {0.f, 0.f, 0.f, 0.f};
              const bf16_t* wh = WRT + (size_t)fr * D + 256 * F.wave + 8 * fq;
#pragma unroll
              for (int st = 0; st < 8; ++st) { const unsigned ch = (unsigned)(32 * F.wave + 4 * st + fq);
                  const bf16x8 ah = *(const LAS bf16x8*)(thi + fr * 4096 + ((ch ^ (unsigned)fr) * 16u)), al = *(const LAS bf16x8*)(thi + 65536 + fr * 4096 + ((ch ^ (unsigned)fr) * 16u));
                  const bf16x8 bh0 = *(const bf16x8*)(wh + 32 * st), bh1 = *(const bf16x8*)(wh + (size_t)16 * D + 32 * st), bl0 = *(const bf16x8*)(wh + (size_t)NE * D + 32 * st), bl1 = *(const bf16x8*)(wh + (size_t)(NE + 16) * D + 32 * st);
                  c0 = __builtin_amdgcn_mfma_f32_16x16x32_bf16(ah, bh0, c0, 0, 0, 0); c1 = __builtin_amdgcn_mfma_f32_16x16x32_bf16(ah, bh1, c1, 0, 0, 0);
                  c0 = __builtin_amdgcn_mfma_f32_16x16x32_bf16(ah, bl0, c0, 0, 0, 0); c1 = __builtin_amdgcn_mfma_f32_16x16x32_bf16(ah, bl1, c1, 0, 0, 0);
                  c0 = __builtin_amdgcn_mfma_f32_16x16x32_bf16(al, bh0, c0, 0, 0, 0); c1 = __builtin_amdgcn_mfma_f32_16x16x32_bf16(al, bh1, c1, 0, 0, 0); }
#pragma unroll
              for (int i = 0; i < 4; ++i) { part[(F.wave * 16 + 4 * fq + i) * 32 + fr] = c0[i]; part[(F.wave * 16 + 4 * fq + i) * 32 + 16 + fr] = c1[i]; } }
            __syncthreads();
            { const int r = F.tid >> 5, e = F.tid & 31; float a = 0.f;
#pragma unroll
              for (int w = 0; w < 8; ++w) a += part[(w * 16 + r) * 32 + e];
              lg[r * 32 + e] = a + b_router[e]; }
            __syncthreads();
            if (F.tid < 16) { const int r = F.tid, m = rg * 16 + r; float l[32];
#pragma unroll
                for (int e = 0; e < 32; ++e) l[e] = lg[r * 32 + e];
                int idx[4]; float val[4]; unsigned taken = 0u;
#pragma unroll
                for (int k = 0; k < 4; ++k) { float best = -3.4e38f; int bi = 0;
#pragma unroll
                    for (int e = 0; e < 32; ++e) { const bool ok = !((taken >> e) & 1u) && (l[e] > best); best = ok ? l[e] : best; bi = ok ? e : bi; }
                    idx[k] = bi; val[k] = best; taken |= 1u << bi; }
                const float e0 = 1.0f, e1 = expf(val[1] - val[0]), e2 = expf(val[2] - val[0]), e3 = expf(val[3] - val[0]); const float inv = 1.0f / (((e0 + e1) + e2) + e3);
                const float gk[4] = {e0 * inv, e1 * inv, e2 * inv, e3 * inv};
#pragma unroll
                for (int k = 0; k < 4; ++k) { const int pos = atomicAdd(CNT + idx[k], 1); ASGE[m * 4 + k] = idx[k]; ASGP[m * 4 + k] = pos; GATE[m * 4 + k] = gk[k]; } }
        }
        __syncthreads();
        SEAM(10);
    }

    LAS int* tab = (LAS int*)(lx + LX_TAB);
#define BUILD_TAB(NT) do { __syncthreads(); if (F.tid == 0) { int us = 0, ps = 0; for (int e = 0; e < NE; ++e) { const int c = CNT[e], nb = (c + EBLK - 1) / EBLK; tab[e] = us; tab[33 + e] = ps; tab[66 + e] = nb > 0 ? nb : 1; us += nb * (NT); ps += nb * EBLK; } tab[32] = us; tab[65] = ps; } __syncthreads(); } while (0)

    if (IN(11)) {
        BUILD_TAB(1);
        for (int s = blockIdx.x * (NWAVES * 64) + F.tid; s < NK; s += F.G * NWAVES * 64) { const int e = ASGE[s], pos = ASGP[s]; RSLOT[tab[33 + e] + pos] = s; }
        CVT_PULL(CV_UP);
        SEAM(11);
    }

    if (IN(12)) {
        BUILD_TAB(16);
        const int gc = (F.G == 256) ? GC_P12 : F.G; const int bx = (int)blockIdx.x;
        if ((bx >> 3) < (gc >> 3) || F.G != 256) {
            pg8::MoeSched Sc{(const char*)TB, (const char*)WUPT, 16, (size_t)2 * DFF * D, (size_t)128 * D, (size_t)DFF * D, tab, gc, (F.G == 256) ? (bx & 7) * (gc >> 3) + (bx >> 3) : F.vcu, true, (size_t)D};
            pg8::EpiUp E{b_up, ACT};
            LAS int* gtab = (LAS int*)(lx + LX_RPART);
            { pg8::Unit uu; for (int i = 0; i < 16 && Sc.next(i, uu); ++i) if (F.tid < 256) { const int sl = RSLOT[uu.r0 + F.tid]; gtab[i * 256 + F.tid] = (sl < 0 ? 0 : sl) >> 2; } }
            __syncthreads();
            pg8::gemm_phase_db6<pg8::EpiUp, pg8::MoeSched>(F.lds, D / 2, D / 2, D / 2, Sc, E, gtab);
            MARK_DONE(12);
        }
        CVT_BESIDE(CV_ALL, 12, gc);
        CVT_PULL(CV_ALL);
        SEAM(12);
    }

    if (IN(13)) {
        BUILD_TAB(8);
        pg8::MoeSched Sc{(const char*)ACT, (const char*)WDNT, 8, (size_t)D * DFF, (size_t)256 * DFF, (size_t)128 * DFF, tab, F.G, F.vcu, false, (size_t)DFF};
        pg8::EpiDown E{b_down, RSLOT, GATE, SLOT};
        pg8::gemm_phase<pg8::EpiDown, pg8::MoeSched, true, false, 1>(F.lds, DFF / 2, DFF / 2, DFF / 2, Sc, E);
        SEAM(13);
    }

    if (IN(14)) {
        for (int m = gw; m < S; m += NGW) {
            const f32x4* xr = (const f32x4*)(H2 + (size_t)m * D) + F.lane; f32x4 v[8]; float s = 0.f;
#pragma unroll
            for (int j = 0; j < 8; ++j) { v[j] = xr[64 * j];
#pragma unroll
                for (int k = 0; k < 4; ++k) { const int w = (int)*((const unsigned*)(SLOT + (size_t)(m * 4 + k) * D) + F.lane + 64 * j); const f32x2 lo = __builtin_amdgcn_cvt_pk_f32_fp8(w, false), hi = __builtin_amdgcn_cvt_pk_f32_fp8(w, true);
                    v[j].x += lo.x * 0.0625f; v[j].y += lo.y * 0.0625f; v[j].z += hi.x * 0.0625f; v[j].w += hi.y * 0.0625f; }
                s += (v[j].x * v[j].x + v[j].y * v[j].y) + (v[j].z * v[j].z + v[j].w * v[j].w); }
            const float rstd = 1.0f / sqrtf(wave_sum(s) * (1.0f / D) + RMS_EPS);
            const f32x4* gr = (const f32x4*)final_norm + F.lane; f32x4* o = (f32x4*)(args.out + (size_t)m * D) + F.lane;
#pragma unroll
            for (int j = 0; j < 8; ++j) o[64 * j] = v[j] * rstd * gr[64 * j];
        }
    }
#undef IN
#undef SEAM
}

extern "C" void kernel_launch(void* const* d_in, const int* in_sizes, int n_in, void* d_out, int out_size, void* d_ws, size_t ws_size, hipStream_t stream) {
    static int grid = 0;
    if (grid == 0) {
        if (n_in != 24 || out_size != S * D || ws_size < WS_END) { fprintf(stderr, "kernel_launch: unexpected shapes (n_in %d out %d ws %zu need %zu)\n", n_in, out_size, ws_size, (size_t)WS_END); grid = -1; return; }
        int dev = 0, cus = 0, per_cu = 0;
        if (hipGetDevice(&dev) != hipSuccess || hipDeviceGetAttribute(&cus, hipDeviceAttributeMultiprocessorCount, dev) != hipSuccess) { grid = -1; return; }
        if (hipFuncSetAttribute((const void*)moe_fwd, hipFuncAttributeMaxDynamicSharedMemorySize, LDS_BYTES) != hipSuccess) { fprintf(stderr, "kernel_launch: hipFuncSetAttribute failed\n"); grid = -1; return; }
        if (hipOccupancyMaxActiveBlocksPerMultiprocessor(&per_cu, (const void*)moe_fwd, NWAVES * 64, LDS_BYTES) != hipSuccess || per_cu < 1) { fprintf(stderr, "kernel_launch: occupancy query says %d\n", per_cu); per_cu = 1; }
        (void)hipGetLastError();
        grid = cus;
    }
    if (grid < 0) return;
    (void)hipMemsetAsync((char*)d_ws + WS_CTL, 0, CTL_ZERO_BYTES, stream);
    Args a{};
    for (int i = 0; i < 24; ++i) a.in[i] = (const float*)d_in[i];
    a.out = (float*)d_out; a.ws = (unsigned char*)d_ws;
#if MK_ONE_LAUNCH
    a.ph_lo = 0; a.ph_hi = NPHASE;
    hipLaunchKernelGGL(moe_fwd, dim3(grid), dim3(NWAVES * 64), LDS_BYTES, stream, a);
#else
    for (int p = 0; p < NPHASE; ++p) { a.ph_lo = p; a.ph_hi = p + 1; for (int rep = 0; rep < (((REPEAT_MASK >> p) & 1) ? 2 : 1); ++rep) hipLaunchKernelGGL(moe_fwd, dim3(grid), dim3(NWAVES * 64), LDS_BYTES, stream, a); }
#endif
}
```

```cpp
#include <hip/hip_runtime.h>
#include <cstdio>
#include <cstdint>

#ifndef MK_ONE_LAUNCH
#define MK_ONE_LAUNCH 1
#endif
#ifndef REPEAT_MASK
#define REPEAT_MASK 0
#endif
#define GC_P1 160
#define GC_P12 224

#define LAS __attribute__((address_space(3)))
#define GAS __attribute__((address_space(1)))
typedef unsigned short bf16_t;
typedef short bf16x8 __attribute__((ext_vector_type(8)));
typedef short s16x4 __attribute__((ext_vector_type(4)));
typedef float f32x4 __attribute__((ext_vector_type(4)));
typedef float f32x2 __attribute__((ext_vector_type(2)));
typedef unsigned u32x4 __attribute__((ext_vector_type(4)));
typedef unsigned u32x2 __attribute__((ext_vector_type(2)));
typedef int v8i32 __attribute__((ext_vector_type(8)));
typedef int v6i32 __attribute__((ext_vector_type(6)));
typedef unsigned u32x3 __attribute__((ext_vector_type(3)));
typedef float f32x16 __attribute__((ext_vector_type(16)));

constexpr int S = 8192, D = 2048, MEM = 256;
constexpr int SBH = 8, HD = 128, SBW = 1024, POOLW = 1024, INW = 4096, NP1 = 8192;
constexpr int XAH = 4, XAW = 512;
constexpr int NE = 32, TOPK = 4, DFF = 2048, NK = S * TOPK, EBLK = 256, MAXBLK = NK / EBLK + NE, PROWS = MAXBLK * EBLK;
constexpr float RMS_EPS = 1e-5f;

constexpr size_t MiB = 1u << 20;
constexpr size_t WS_CTL = 0, CTL_ZERO_BYTES = 1 * MiB;
constexpr size_t WS_W1T = 2 * MiB;
constexpr size_t WS_WAT = WS_W1T + 32 * MiB;
constexpr size_t WS_WBT = WS_WAT + 4 * MiB;
constexpr size_t WS_WMT = WS_WBT + 4 * MiB;
constexpr size_t WS_PLT = WS_WMT + 8 * MiB;
constexpr size_t WS_WQT = WS_PLT + 1 * MiB;
constexpr size_t WS_WKVT = WS_WQT + 2 * MiB;
constexpr size_t WS_WOT = WS_WKVT + 4 * MiB;
constexpr size_t WS_WUPT = WS_WOT + 2 * MiB;
constexpr size_t WS_WDNT = WS_WUPT + 512 * MiB;
constexpr size_t WS_U = WS_WDNT + 256 * MiB;
constexpr size_t WS_MEMN = WS_U + 32 * MiB;
constexpr size_t WS_PG = WS_MEMN + 1 * MiB;
constexpr size_t WS_OA = WS_PG + 128 * MiB;
constexpr size_t WS_PO = WS_OA + 16 * MiB;
constexpr size_t WS_OB = WS_PO + 16 * MiB;
constexpr size_t WS_TMP = WS_OB + 16 * MiB;
constexpr size_t WS_MG = WS_TMP + 64 * MiB;
constexpr size_t WS_H1 = WS_MG + 32 * MiB;
constexpr size_t WS_U2 = WS_H1 + 64 * MiB;
constexpr size_t WS_QXA = WS_U2 + 32 * MiB;
constexpr size_t WS_KVM = WS_QXA + 8 * MiB;
constexpr size_t WS_OXA = WS_KVM + 1 * MiB;
constexpr size_t WS_H2 = WS_OXA + 8 * MiB;
constexpr size_t WS_TB = WS_H2 + 64 * MiB;
constexpr size_t WS_ROWS = WS_TB + 32 * MiB;
constexpr size_t WS_ACT = WS_ROWS + 160 * MiB;
constexpr size_t WS_SLOT = WS_ACT + 160 * MiB;
constexpr size_t WS_ASGE = WS_SLOT + 128 * MiB;
constexpr size_t WS_ASGP = WS_ASGE + 1 * MiB;
constexpr size_t WS_GATE = WS_ASGP + 1 * MiB;
constexpr size_t WS_RSLOT = WS_GATE + 1 * MiB;
constexpr size_t WS_WRT = WS_RSLOT + 1 * MiB;
constexpr size_t WS_END = WS_WRT + 1 * MiB;
constexpr int CW_CNT = 64;
constexpr int CW_CUR = 192;  constexpr int CW_DONE = 256;
constexpr int CW_BAR = 4096;

constexpr int RING_BYTES = 131072;
constexpr int LDS_X_OFF = RING_BYTES;
constexpr int LDS_BYTES = 163840;
constexpr int LX_BAR = 0;
constexpr int LX_TAB = 64;
constexpr int LX_CVS = 32;
constexpr int LX_SBF = 128;
constexpr int LX_LOG = 1024;
constexpr int LX_RPART = 4096;

constexpr int NWAVES = 8;

__device__ __forceinline__ unsigned cvt_pk_bf16(float lo, float hi) { unsigned r; asm volatile("v_cvt_pk_bf16_f32 %0, %1, %2" : "=v"(r) : "v"(lo), "v"(hi)); return r; }
__device__ __forceinline__ unsigned pk4_fp8(float a, float b, float c, float d) { int p = __builtin_amdgcn_cvt_pk_fp8_f32(a, b, 0, false); p = __builtin_amdgcn_cvt_pk_fp8_f32(c, d, p, true); return (unsigned)p; }
__device__ __forceinline__ v6i32 pk32_fp6(const f32x16& lo, const f32x16& hi) { return __builtin_amdgcn_cvt_scalef32_2xpk16_fp6_f32(lo, hi, 1.0f); }
__device__ __forceinline__ void st_fp6_block(unsigned char* p, const v6i32& b) { *(u32x4*)p = (u32x4){(unsigned)b[0], (unsigned)b[1], (unsigned)b[2], (unsigned)b[3]}; *(u32x4*)(p + 64) = (u32x4){(unsigned)b[4], (unsigned)b[5], 0u, 0u}; }
__device__ __forceinline__ float bf_lo(unsigned w) { return __uint_as_float(w << 16); }
__device__ __forceinline__ float bf_hi(unsigned w) { return __uint_as_float(w & 0xffff0000u); }
__device__ __forceinline__ float wave_sum(float v) {
#pragma unroll
    for (int o = 1; o < 64; o <<= 1) v += __shfl_xor(v, o);
    return v;
}
__device__ __forceinline__ float sigmoidf_fast(float x) { return __builtin_amdgcn_rcpf(1.0f + __builtin_amdgcn_exp2f(x * -1.4426950408889634f)); }

#define XB_TMO      128
#define XB_XCNT(j)  (256  + 64 * (j))
#define XB_XSUB(j)  (1280 + 64 * (j))
#define XB_XGEN(j)  (2304 + 64 * (j))
#define XB_TOP      3328
#define XB_TOPGEN   3392
#define XCD_BAR_WORDS 3456
#define XB_SPIN_CAP (1u << 18)
__device__ __forceinline__ unsigned xb_ld(unsigned* p)              { return __hip_atomic_load(p, __ATOMIC_RELAXED, __HIP_MEMORY_SCOPE_AGENT); }
__device__ __forceinline__ unsigned xb_add(unsigned* p, unsigned v) { return __hip_atomic_fetch_add(p, v, __ATOMIC_RELAXED, __HIP_MEMORY_SCOPE_AGENT); }
__device__ __forceinline__ unsigned xb_xcc_id() { return (unsigned)__builtin_amdgcn_s_getreg((3 << 11) | 20) & 0xFu; }
#define XB_SPIN(cond, bar) do { unsigned _sp = 0; while (cond) { __builtin_amdgcn_s_sleep(1); \
    if ((++_sp & 255u) == 0u) { if (xb_ld(&(bar)[XB_TMO])) break; if (_sp > XB_SPIN_CAP) { atomicAdd(&(bar)[XB_TMO], 1u); break; } } } } while (0)
struct XcdBarrier { unsigned* bar; unsigned x; volatile LAS unsigned* st; };
__device__ __forceinline__ XcdBarrier xcd_barrier_post(unsigned* bar, volatile LAS unsigned* st) {
    XcdBarrier b; b.bar = bar; b.x = xb_xcc_id(); b.st = st;
    if (threadIdx.x == 0) (void)xb_add(&bar[XB_XCNT(b.x)], 1u);
    return b;
}
__device__ __forceinline__ void xcd_barrier_complete(unsigned* bar, unsigned x, unsigned& nloc, unsigned& nx) {
    const unsigned G = gridDim.x * gridDim.y * gridDim.z;
    unsigned sum, cnt, mine, sp = 0u;
    for (;;) {
        sum = 0u; cnt = 0u; mine = 0u;
#pragma unroll
        for (unsigned j = 0; j < 16; ++j) { const unsigned c = xb_ld(&bar[XB_XCNT(j)]); sum += c; cnt += (c > 0u) ? 1u : 0u; mine = (j == x) ? c : mine; }
        if (sum == G) break;
        __builtin_amdgcn_s_sleep(1);
        if ((++sp & 255u) == 0u) { if (xb_ld(&bar[XB_TMO])) break; if (sp > XB_SPIN_CAP) { atomicAdd(&bar[XB_TMO], 1u); break; } }
    }
    nloc = mine > 0u ? mine : 1u; nx = cnt > 0u ? cnt : 1u;
}
__device__ __forceinline__ void xcd_barrier(const XcdBarrier& b) {
    asm volatile("s_waitcnt vmcnt(0)" ::: "memory");
    __syncthreads();
    if (threadIdx.x == 0) {
        unsigned* bar = b.bar;
        __builtin_amdgcn_s_waitcnt(0);
        unsigned nloc = b.st[0], nx = b.st[1];
        if (nloc == 0u) { xcd_barrier_complete(bar, b.x, nloc, nx); b.st[0] = nloc; b.st[1] = nx; }
        const unsigned old = xb_add(&bar[XB_XSUB(b.x)], 1u);
        const unsigned gen = old / nloc;
        if (old + 1u == (gen + 1u) * nloc) {
            __builtin_amdgcn_fence(__ATOMIC_RELEASE, "agent");
            asm volatile("s_waitcnt vmcnt(0)" ::: "memory");
            const unsigned og = xb_add(&bar[XB_TOP], 1u);
            const unsigned tg = og / nx;
            if (og + 1u == (tg + 1u) * nx) xb_add(&bar[XB_TOPGEN], 1u);
            else XB_SPIN(xb_ld(&bar[XB_TOPGEN]) == tg, bar);
            __builtin_amdgcn_fence(__ATOMIC_ACQUIRE, "agent");
            xb_add(&bar[XB_XGEN(b.x)], 1u);
            asm volatile("s_waitcnt vmcnt(0)" ::: "memory");
        } else {
            XB_SPIN(xb_ld(&bar[XB_XGEN(b.x)]) == gen, bar);
            __builtin_amdgcn_fence(__ATOMIC_ACQUIRE, "agent");
            asm volatile("s_waitcnt vmcnt(0)" ::: "memory");
        }
    }
    __syncthreads();
}

namespace pg8 {
constexpr int BM = 256, BK = 64, HALF = 128, HTB = HALF * BK * 2, STAGE_BYTES = 8 * HTB, NXCD = 8, WGM = 8;
__host__ __device__ __forceinline__ int lds_byte(int r, int c) { const int st = (r >> 4) * 2 + (c >> 5), rr = r & 15, cc = c & 31, ob = rr * 64 + cc * 2; return st * 1024 + (ob ^ (((ob >> 9) & 1) << 5)); }
__host__ __device__ __forceinline__ void stage_rc(int b, int& R, int& C) { const int st = b / 1024, sb = b % 1024, swz = sb ^ (((sb >> 9) & 1) << 5); R = (st >> 1) * 16 + swz / 64; C = (st & 1) * 32 + (swz % 64) / 2; }
__host__ __device__ __forceinline__ int perm32(int rho) { const int n = rho >> 4, i = rho & 15; return 8 * (i >> 2) + 4 * n + (i & 3); }

struct Unit { const char* A; const char* B0; const char* B1; int r0, c0, x; };

__device__ __forceinline__ void tile_of(int L, int nM, int nN, int& pm, int& pn) {
    const int nwg = nM * nN; int wgid = L;
    { const int q = nwg / NXCD, r = nwg % NXCD, xcd = wgid % NXCD, off = wgid / NXCD; wgid = (xcd < r ? xcd * (q + 1) : r * (q + 1) + (xcd - r) * q) + off; }
    const int nig = WGM * nN, gid = wgid / nig, fm = gid * WGM, gsz = (nM - fm) < WGM ? (nM - fm) : WGM;
    pm = fm + ((wgid % nig) % gsz); pn = (wgid % nig) / gsz;
}
struct DenseSched {
    const char* A; const char* B; int lda, ldb, nM, nN, G, c;
    __device__ __forceinline__ bool next(int i, Unit& u) const {
        const long L = (long)i * G + c; if (L >= (long)nM * nN) return false;
        int pm, pn; tile_of((int)L, nM, nN, pm, pn);
        u.A = A + (size_t)pm * BM * lda * 2; u.B0 = B + (size_t)pn * BM * ldb * 2; u.B1 = u.B0 + (size_t)HALF * ldb * 2; u.r0 = pm * BM; u.c0 = pn * BM; u.x = 0; return true;
    }
};
struct BranchSched {
    const char* A0; const char* A1; const char* B0; const char* B1; int lda, ldb, nM, nN, G, c;
    __device__ __forceinline__ bool next(int i, Unit& u) const {
        const long L = (long)(i >> 1) * G + c; if (L >= (long)nM * nN) return false;
        int pm, pn; tile_of((int)L, nM, nN, pm, pn); const int br = i & 1;
        u.A = (br ? A1 : A0) + (size_t)pm * BM * lda * 2; u.B0 = (br ? B1 : B0) + (size_t)pn * BM * ldb * 2; u.B1 = u.B0 + (size_t)HALF * ldb * 2; u.r0 = pm * BM; u.c0 = pn * BM; u.x = br; return true;
    }
};
struct PoolSched {
    const char* A; const char* B; int G, c;
    __device__ __forceinline__ bool next(int i, Unit& u) const {
        const int L = i * G + c; if (L >= (S / BM) * 4) return false;
        const int pm = L >> 2, g = L & 3;
        u.A = A + ((size_t)pm * BM * POOLW + g * 256) * 2; u.B0 = B + (size_t)g * 256 * 256 * 2; u.B1 = u.B0 + (size_t)HALF * 256 * 2; u.r0 = pm * BM; u.c0 = g * 256; u.x = g; return true;
    }
};
struct MoeSched {
    const char* A; const char* B; int NT; size_t estride; size_t tstride; size_t hoff; const LAS int* tab; int G, c; bool gather; size_t arow;
    __device__ __forceinline__ int tu(int i) const { return __builtin_amdgcn_readfirstlane(tab[i]); }
    __device__ __forceinline__ bool next(int i, Unit& u) const {
        const int L = i * G + c; if (L >= tu(32)) return false;
        int e = 0;
#pragma unroll
        for (int s = 16; s >= 1; s >>= 1) { if (tu(e + s) <= L) e += s; }
        const int r = L - tu(e), nb = tu(66 + e), nt = r / nb, blk = r - nt * nb, prow = tu(33 + e) + blk * EBLK;
        u.A = gather ? A : A + (size_t)prow * arow; u.B0 = B + (size_t)e * estride + (size_t)nt * tstride; u.B1 = u.B0 + hoff; u.r0 = prow; u.c0 = nt; u.x = e; return true;
    }
};

template <class Epi, class Sched, bool ALIGN_EPI, bool GATHER = false, int PREC = 0>
__device__ __forceinline__ void gemm_phase(LAS unsigned char* lds, const int K, const int lda, const int ldb, const Sched& S, const Epi& E, const LAS int* gtab = nullptr) {
    const int tid = threadIdx.x, wid = __builtin_amdgcn_readfirstlane(tid >> 6), lane = tid & 63, wr = wid >> 2, wc = wid & 3, fr = lane & 15, fq = lane >> 4;
    const int nt = K / BK;
    unsigned voffB[2], vc[2][2], vn[2][2]; int RA[2], CA[2];
#pragma unroll
    for (int i = 0; i < 2; ++i) { int R, C; stage_rc(tid * 16 + i * 8192, R, C); const int Rb = Epi::PERM ? ((R & ~31) + perm32(R & 31)) : R; RA[i] = R; CA[i] = C;
        voffB[i] = (unsigned)(Rb * ldb + C) * 2u; }
#define PG8_AOFF(dst, ord) do { _Pragma("unroll") for (int _h = 0; _h < 2; ++_h) _Pragma("unroll") for (int _i = 0; _i < 2; ++_i) \
        dst[_h][_i] = GATHER ? ((unsigned)gtab[(ord) * 256 + _h * HALF + RA[_i]] * (unsigned)lda + (unsigned)CA[_i]) * 2u : (unsigned)((_h * HALF + RA[_i]) * lda + CA[_i]) * 2u; } while (0)
    const size_t kstep = (size_t)(BK * 2);
    const unsigned ldsw = (unsigned)wid * 1024u;
    const int aoff = lds_byte(wr * 64 + fr, fq * 8), boff = lds_byte(wc * 32 + fr, fq * 8);
#define PG8_SA(b, h) (((b) * 2 + (h)) * HTB)
#define PG8_SB(b, h) ((4 + (b) * 2 + (h)) * HTB)
#define PG8_STAGE(bufoff, gbase, voff) do { _Pragma("unroll") for (int _i = 0; _i < 2; ++_i) \
        __builtin_amdgcn_global_load_lds((const unsigned*)((const char*)(gbase) + (voff)[_i]), (LAS unsigned*)(lds + (bufoff) + ldsw + _i * 8192), 16, 0, 0); } while (0)
#define PG8_LD6(off) __builtin_bit_cast(v6i32, __builtin_shufflevector(*(const LAS u32x4*)(lds + (off)), __builtin_shufflevector(*(const LAS u32x2*)(lds + (off) + 1024), *(const LAS u32x2*)(lds + (off) + 1024), 0, 1, -1, -1), 0, 1, 2, 3, 4, 5))
#define PG8_LD8(off) __builtin_bit_cast(v8i32, __builtin_shufflevector(*(const LAS u32x4*)(lds + (off)), *(const LAS u32x4*)(lds + (off) + 1024), 0, 1, 2, 3, 4, 5, 6, 7))
#define PG8_LDA(dst, b, h) do { if (PREC == 2) { _Pragma("unroll") for (int m = 0; m < 4; ++m) dst##6[m] = PG8_LD6(PG8_SA(b, h) + aoff + m * 2048); } \
      else if (PREC == 1) { _Pragma("unroll") for (int m = 0; m < 4; ++m) dst##8[m] = PG8_LD8(PG8_SA(b, h) + aoff + m * 2048); } \
      else { _Pragma("unroll") for (int m = 0; m < 4; ++m) _Pragma("unroll") for (int k = 0; k < 2; ++k) dst[m][k] = *(const LAS bf16x8*)(lds + PG8_SA(b, h) + aoff + m * 2048 + k * 1024); } } while (0)
#define PG8_LDB(dst, b, h) do { if (PREC == 2) { _Pragma("unroll") for (int n = 0; n < 2; ++n) dst##6[n] = PG8_LD6(PG8_SB(b, h) + boff + n * 2048); } \
      else if (PREC == 1) { _Pragma("unroll") for (int n = 0; n < 2; ++n) dst##8[n] = PG8_LD8(PG8_SB(b, h) + boff + n * 2048); } \
      else { _Pragma("unroll") for (int n = 0; n < 2; ++n) _Pragma("unroll") for (int k = 0; k < 2; ++k) dst[n][k] = *(const LAS bf16x8*)(lds + PG8_SB(b, h) + boff + n * 2048 + k * 1024); } } while (0)
#define PG8_MMA(ai, bj, At, Bt) do { __builtin_amdgcn_s_setprio(1); if (PREC == 2) { _Pragma("unroll") for (int m = 0; m < 4; ++m) _Pragma("unroll") for (int n = 0; n < 2; ++n) \
        asm volatile("v_mfma_scale_f32_16x16x128_f8f6f4 %0, %1, %2, %0, %3, %4 op_sel_hi:[0,0,0] cbsz:2 blgp:2" : "+v"(acc[ai][bj][m][n]) : "v"(Bt##6[n]), "v"(At##6[m]), "v"(sc_w), "v"(sc_a)); } \
      else if (PREC == 1) { _Pragma("unroll") for (int m = 0; m < 4; ++m) _Pragma("unroll") for (int n = 0; n < 2; ++n) \
        asm volatile("v_mfma_scale_f32_16x16x128_f8f6f4 %0, %1, %2, %0, %3, %4 op_sel_hi:[0,0,0]" : "+v"(acc[ai][bj][m][n]) : "v"(Bt##8[n]), "v"(At##8[m]), "v"(sc_w), "v"(sc_a)); } \
      else { _Pragma("unroll") for (int m = 0; m < 4; ++m) _Pragma("unroll") for (int n = 0; n < 2; ++n) _Pragma("unroll") for (int k = 0; k < 2; ++k) \
        acc[ai][bj][m][n] = __builtin_amdgcn_mfma_f32_16x16x32_bf16(Bt[n][k], At[m][k], acc[ai][bj][m][n], 0, 0, 0); } __builtin_amdgcn_s_setprio(0); } while (0)
#define PG8_WAIT_V(n) asm volatile("s_waitcnt vmcnt(" #n ")" ::: "memory")
#define PG8_WAIT_L(n) asm volatile("s_waitcnt lgkmcnt(" #n ")" ::: "memory")
#define PG8_BAR __builtin_amdgcn_s_barrier()
#define PG8_SCHED __builtin_amdgcn_sched_barrier(0)
    Unit cur, nxt; int ui = 0;
    if (!S.next(0, cur)) return;
    f32x4 acc[2][2][4][2];
#pragma unroll
    for (int a = 0; a < 2; ++a)
#pragma unroll
        for (int b = 0; b < 2; ++b)
#pragma unroll
            for (int m = 0; m < 4; ++m)
#pragma unroll
                for (int n = 0; n < 2; ++n) acc[a][b][m][n] = (f32x4){0.f, 0.f, 0.f, 0.f};
    bf16x8 At[4][2], B0[2][2], B1[2][2]; v8i32 At8[4], B08[2], B18[2]; v6i32 At6[4], B06[2], B16[2];
    const int sc_w = 121, sc_a = (PREC == 2) ? 126 : 127;
    PG8_AOFF(vc, 0);
#pragma unroll
    for (int _h = 0; _h < 2; ++_h) { vn[_h][0] = vc[_h][0]; vn[_h][1] = vc[_h][1]; }
    PG8_STAGE(PG8_SB(0, 0), cur.B0, voffB); PG8_STAGE(PG8_SB(0, 1), cur.B1, voffB); PG8_STAGE(PG8_SA(0, 0), cur.A, vc[0]); PG8_STAGE(PG8_SA(0, 1), cur.A, vc[1]);
    if (wr == 1) PG8_BAR;
    PG8_WAIT_V(2); PG8_BAR;
    PG8_STAGE(PG8_SB(1, 0), cur.B0 + kstep, voffB); PG8_STAGE(PG8_SA(1, 0), cur.A + kstep, vc[0]); PG8_STAGE(PG8_SB(1, 1), cur.B1 + kstep, voffB);
    PG8_WAIT_V(6); PG8_BAR;
    for (;;) {
        const bool has_next = S.next(ui + 1, nxt);
        if (GATHER && has_next) PG8_AOFF(vn, ui + 1);
        const char* nA = has_next ? nxt.A : cur.A; const char* nB0 = has_next ? nxt.B0 : cur.B0; const char* nB1 = has_next ? nxt.B1 : cur.B1;
#pragma nounroll
        for (int t = 0; t < nt; t += 2) {
            const bool last = (t == nt - 2);
            const char* a1 = cur.A + (size_t)(t + 1) * kstep;
            const char* a2 = last ? nA : cur.A + (size_t)(t + 2) * kstep;
            const char* b20 = last ? nB0 : cur.B0 + (size_t)(t + 2) * kstep; const char* b21 = last ? nB1 : cur.B1 + (size_t)(t + 2) * kstep;
            const char* a3 = a2 + kstep; const char* b30 = b20 + kstep; const char* b31 = b21 + kstep;
            unsigned v2[2][2];
#pragma unroll
            for (int _h = 0; _h < 2; ++_h) { v2[_h][0] = (GATHER && last) ? vn[_h][0] : vc[_h][0]; v2[_h][1] = (GATHER && last) ? vn[_h][1] : vc[_h][1]; }
            PG8_LDB(B0, 0, 0); PG8_LDB(B1, 0, 1); PG8_SCHED; PG8_LDA(At, 0, 0); PG8_STAGE(PG8_SA(1, 1), a1, vc[1]);
            PG8_WAIT_V(8); PG8_WAIT_L(0); PG8_BAR; PG8_MMA(0, 0, At, B0); PG8_MMA(0, 1, At, B1); PG8_BAR; PG8_SCHED;
            PG8_LDA(At, 0, 1); PG8_STAGE(PG8_SB(0, 0), b20, voffB); PG8_STAGE(PG8_SB(0, 1), b21, voffB); PG8_STAGE(PG8_SA(0, 0), a2, v2[0]);
            PG8_WAIT_V(8); PG8_WAIT_L(0); PG8_BAR; PG8_MMA(1, 0, At, B0); PG8_MMA(1, 1, At, B1); PG8_BAR; PG8_SCHED;
            PG8_LDB(B0, 1, 0); PG8_LDB(B1, 1, 1); PG8_SCHED; PG8_LDA(At, 1, 0); PG8_STAGE(PG8_SA(0, 1), a2, v2[1]);
            PG8_WAIT_V(8); PG8_WAIT_L(0); PG8_BAR; PG8_MMA(0, 0, At, B0); PG8_MMA(0, 1, At, B1); PG8_BAR; PG8_SCHED;
            PG8_LDA(At, 1, 1); PG8_STAGE(PG8_SB(1, 0), b30, voffB); PG8_STAGE(PG8_SB(1, 1), b31, voffB); PG8_STAGE(PG8_SA(1, 0), a3, v2[0]);
            PG8_WAIT_V(8); PG8_WAIT_L(0); PG8_BAR; PG8_MMA(1, 0, At, B0); PG8_MMA(1, 1, At, B1); PG8_BAR; PG8_SCHED;
        }
        if constexpr (ALIGN_EPI) { if (wr == 0) PG8_BAR; }
        if (PREC != 0) asm volatile("s_nop 15\n\ts_nop 15\n\ts_nop 15\n\ts_nop 15" ::: "memory");
        E(acc, cur, wr, wc, fr, fq);
        if (!has_next) break;
        bool kp = false; if constexpr (Epi::KEEPS) kp = E.keep(cur);
        if (!kp) {
#pragma unroll
        for (int a = 0; a < 2; ++a)
#pragma unroll
            for (int b = 0; b < 2; ++b)
#pragma unroll
                for (int m = 0; m < 4; ++m)
#pragma unroll
                    for (int n = 0; n < 2; ++n) acc[a][b][m][n] = (f32x4){0.f, 0.f, 0.f, 0.f}; }
        cur = nxt; ++ui;
        if (GATHER) {
#pragma unroll
            for (int _h = 0; _h < 2; ++_h) { vc[_h][0] = vn[_h][0]; vc[_h][1] = vn[_h][1]; } }
        if constexpr (ALIGN_EPI) { if (wr == 1) PG8_BAR; }
    }
    PG8_WAIT_V(0);
    if constexpr (!ALIGN_EPI) { if (wr == 0) PG8_BAR; }
    PG8_BAR;
#undef PG8_AOFF
#undef PG8_SA
#undef PG8_SB
#undef PG8_STAGE
#undef PG8_LDA
#undef PG8_LDB
#undef PG8_MMA
#undef PG8_LD8
#undef PG8_LD6
#undef PG8_WAIT_V
#undef PG8_WAIT_L
#undef PG8_BAR
#undef PG8_SCHED
}

template <int OFF>
__device__ __forceinline__ v6i32 ld6x(unsigned addr) {
    u32x4 lo; u32x2 hi;
    asm volatile("ds_read_b128 %0, %1 offset:%2" : "=v"(lo) : "v"(addr), "n"(OFF));
    asm volatile("ds_read_b64 %0, %1 offset:%2" : "=v"(hi) : "v"(addr), "n"(OFF + 1024));
    return (v6i32){(int)lo[0], (int)lo[1], (int)lo[2], (int)lo[3], (int)hi[0], (int)hi[1]};
}
template <class Epi, class Sched>
__device__ __forceinline__ void gemm_phase_db6(LAS unsigned char* lds, const int K, const int lda, const int ldb, const Sched& S, const Epi& E, const LAS int* gtab) {
    const int tid = threadIdx.x, wid = __builtin_amdgcn_readfirstlane(tid >> 6), lane = tid & 63, wr = wid >> 2, wc = wid & 3, fr = lane & 15, fq = lane >> 4;
    const int nt = K / BK;
    unsigned voffB0, vc[2][2]; const size_t bstep = (size_t)64 * ldb * 2;
    { int R, C; stage_rc(tid * 16, R, C); const int Rb = Epi::PERM ? ((R & ~31) + perm32(R & 31)) : R; voffB0 = (unsigned)(Rb * ldb + C) * 2u; }
#define DB_AOFF(dst, ord) do { _Pragma("unroll") for (int _i = 0; _i < 2; ++_i) { int _R, _C; stage_rc((int)threadIdx.x * 16 + _i * 8192, _R, _C); _Pragma("unroll") for (int _h = 0; _h < 2; ++_h) \
        dst[_h][_i] = ((unsigned)gtab[(ord) * 256 + _h * HALF + _R] * (unsigned)lda + (unsigned)_C) * 2u; } } while (0)
    const size_t kstep = (size_t)(BK * 2);
    const unsigned ldsw = (unsigned)wid * 1024u;
    const int aoff = lds_byte(wr * 64 + fr, fq * 8), boff = lds_byte(wc * 32 + fr, fq * 8);
    const unsigned aA = (unsigned)(size_t)(lds + aoff), aB = (unsigned)(size_t)(lds + 4 * HTB + boff);
#define DB_SA(b, h) (((b) * 2 + (h)) * HTB)
#define DB_SB(b, h) ((4 + (b) * 2 + (h)) * HTB)
#define DB_STAGEA1(bufoff, gbase, voff, i) __builtin_amdgcn_global_load_lds((const unsigned*)((const char*)(gbase) + (voff)[i]), (LAS unsigned*)(lds + (bufoff) + ldsw + (i) * 8192), 16, 0, 0)
#define DB_STAGEB1(bufoff, gbase, i) __builtin_amdgcn_global_load_lds((const unsigned*)((const char*)(gbase) + (size_t)(i) * bstep + voffB0), (LAS unsigned*)(lds + (bufoff) + ldsw + (i) * 8192), 16, 0, 0)
#define DB_STAGEA(bufoff, gbase, voff) do { DB_STAGEA1(bufoff, gbase, voff, 0); DB_STAGEA1(bufoff, gbase, voff, 1); } while (0)
#define DB_STAGEB(bufoff, gbase) do { DB_STAGEB1(bufoff, gbase, 0); DB_STAGEB1(bufoff, gbase, 1); } while (0)
#define DB_LDA(dst, b, h) do { dst[0] = ld6x<DB_SA(b, h)>(aA); dst[1] = ld6x<DB_SA(b, h) + 2048>(aA); dst[2] = ld6x<DB_SA(b, h) + 4096>(aA); dst[3] = ld6x<DB_SA(b, h) + 6144>(aA); } while (0)
#define DB_LDB(dst, b, h) do { dst[0] = ld6x<((b) * 2 + (h)) * HTB>(aB); dst[1] = ld6x<((b) * 2 + (h)) * HTB + 2048>(aB); } while (0)
#define DB_MMA(ai, bj, At, Bt) do { __builtin_amdgcn_s_setprio(1); _Pragma("unroll") for (int m = 0; m < 4; ++m) _Pragma("unroll") for (int n = 0; n < 2; ++n) \
        asm volatile("v_mfma_scale_f32_16x16x128_f8f6f4 %0, %1, %2, %0, %3, %4 op_sel_hi:[0,0,0] cbsz:2 blgp:2" : "+v"(acc[ai][bj][m][n]) : "v"(Bt[n]), "v"(At[m]), "v"(sc_w), "v"(sc_a)); __builtin_amdgcn_s_setprio(0); } while (0)
#define DB_MMA4(ai, bj, mlo, At, Bt) do { _Pragma("unroll") for (int m = (mlo); m < (mlo) + 2; ++m) _Pragma("unroll") for (int n = 0; n < 2; ++n) \
        asm volatile("v_mfma_scale_f32_16x16x128_f8f6f4 %0, %1, %2, %0, %3, %4 op_sel_hi:[0,0,0] cbsz:2 blgp:2" : "+v"(acc[ai][bj][m][n]) : "v"(Bt[n]), "v"(At[m]), "v"(sc_w), "v"(sc_a)); } while (0)
#define DB_SYNC() do { asm volatile("s_waitcnt vmcnt(8) lgkmcnt(0)" ::: "memory"); __builtin_amdgcn_s_barrier(); } while (0)
#define DB_SYNC6() do { asm volatile("s_waitcnt vmcnt(6) lgkmcnt(0)" ::: "memory"); __builtin_amdgcn_s_barrier(); } while (0)
#define DB_STEP(ai, At, sb, sa, gb, ga, vo) do { \
        DB_STAGEB1(sb, gb, 0); DB_SCHED; DB_MMA4(ai, 0, 0, At, B0); DB_SCHED; DB_STAGEB1(sb, gb, 1); DB_SCHED; DB_MMA4(ai, 0, 2, At, B0); DB_SCHED; \
        DB_STAGEA1(sa, ga, vo, 0); DB_SCHED; DB_MMA4(ai, 1, 0, At, B1); DB_SCHED; DB_STAGEA1(sa, ga, vo, 1); DB_SCHED; DB_MMA4(ai, 1, 2, At, B1); DB_SCHED; } while (0)
#define DB_SCHED __builtin_amdgcn_sched_barrier(0)
    Unit cur, nxt; int ui = 0;
    if (!S.next(0, cur)) return;
    f32x4 acc[2][2][4][2]; typename Epi::Pre pre;
    E.prefetch(pre, cur, wc, fq); E.init(acc, pre);
    v6i32 A0[4], A1[4], B0[2], B1[2];
    const int sc_w = 121, sc_a = 126;
    if (wid >= 4) __builtin_amdgcn_s_setprio(1);
    DB_AOFF(vc, 0);
    DB_STAGEB(DB_SB(0, 0), cur.B0); DB_STAGEA(DB_SA(0, 0), cur.A, vc[0]); DB_STAGEB(DB_SB(0, 1), cur.B1); DB_STAGEA(DB_SA(0, 1), cur.A, vc[1]);
    DB_STAGEB(DB_SB(1, 0), cur.B0 + kstep); DB_STAGEA(DB_SA(1, 0), cur.A + kstep, vc[0]); DB_STAGEB(DB_SB(1, 1), cur.B1 + kstep); DB_STAGEA(DB_SA(1, 1), cur.A + kstep, vc[1]);
    DB_SYNC();
    DB_LDB(B0, 0, 0); DB_LDB(B1, 0, 1); DB_LDA(A0, 0, 0); DB_SCHED;
    for (;;) {
        const bool has_next = S.next(ui + 1, nxt);
        const char* nA = has_next ? nxt.A : cur.A; const char* nB0 = has_next ? nxt.B0 : cur.B0; const char* nB1 = has_next ? nxt.B1 : cur.B1;
#pragma nounroll
        for (int t = 0; t < nt; t += 2) {
            const bool last = (t == nt - 2);
            const char* a2 = last ? nA : cur.A + (size_t)(t + 2) * kstep;
            const char* b20 = last ? nB0 : cur.B0 + (size_t)(t + 2) * kstep; const char* b21 = last ? nB1 : cur.B1 + (size_t)(t + 2) * kstep;
            const char* a3 = a2 + kstep; const char* b30 = b20 + kstep; const char* b31 = b21 + kstep;
            if (last && has_next) DB_AOFF(vc, ui + 1);
            DB_SYNC(); DB_LDA(A1, 0, 1); DB_SCHED; DB_STEP(0, A0, DB_SB(0, 0), DB_SA(0, 0), b20, a2, vc[0]);
            DB_SYNC6(); DB_LDA(A0, 1, 0); DB_SCHED; DB_STEP(1, A1, DB_SB(0, 1), DB_SA(0, 1), b21, a2, vc[1]); DB_LDB(B0, 1, 0); DB_LDB(B1, 1, 1); DB_SCHED;
            DB_SYNC(); DB_LDA(A1, 1, 1); DB_SCHED; DB_STEP(0, A0, DB_SB(1, 0), DB_SA(1, 0), b30, a3, vc[0]);
            DB_SYNC6(); if (!last) DB_LDA(A0, 0, 0); DB_SCHED; DB_STEP(1, A1, DB_SB(1, 1), DB_SA(1, 1), b31, a3, vc[1]); if (!last) { DB_LDB(B0, 0, 0); DB_LDB(B1, 0, 1); } DB_SCHED;
        }
        asm volatile("s_nop 15\n\ts_nop 15\n\ts_nop 15\n\ts_nop 15" ::: "memory");
        { const unsigned _l = (unsigned)__builtin_amdgcn_mbcnt_hi(~0u, __builtin_amdgcn_mbcnt_lo(~0u, 0u)); if (has_next) E.prefetch(pre, nxt, wc, (int)(_l >> 4)); E(acc, cur, wr, wc, (int)(_l & 15u), (int)(_l >> 4)); }
        if (!has_next) break;
        E.init(acc, pre);
        cur = nxt; ++ui;
        DB_LDB(B0, 0, 0); DB_LDB(B1, 0, 1); DB_LDA(A0, 0, 0); DB_SCHED;
    }
    asm volatile("s_waitcnt vmcnt(0) lgkmcnt(0)" ::: "memory");
    __builtin_amdgcn_s_setprio(0);
    __builtin_amdgcn_s_barrier();
#undef DB_AOFF
#undef DB_SA
#undef DB_SB
#undef DB_STAGEA
#undef DB_STAGEB
#undef DB_LDA
#undef DB_LDB
#undef DB_MMA
#undef DB_SYNC
#undef DB_SYNC6
#undef DB_STEP
#undef DB_MMA4
#undef DB_STAGEA1
#undef DB_STAGEB1
#undef DB_SCHED
}

typedef f32x4 Acc[2][2][4][2];

struct EpiProj {
    static constexpr bool PERM = true, KEEPS = false;
    bf16_t* O; const float* bgate;
    __device__ __forceinline__ void operator()(Acc& acc, const Unit& u, int wr, int wc, int fr, int fq) const {
        const int row0 = u.r0 + wr * 64 + fr, col0 = u.c0 + wc * 32 + 8 * fq; const bool gate = u.c0 >= INW;
        f32x4 bv[2][2];
#pragma unroll
        for (int bj = 0; bj < 2; ++bj)
#pragma unroll
            for (int n = 0; n < 2; ++n) bv[bj][n] = gate ? *(const f32x4*)(bgate + (col0 - INW) + bj * HALF + 4 * n) : (f32x4){0.f, 0.f, 0.f, 0.f};
#pragma unroll
        for (int ai = 0; ai < 2; ++ai)
#pragma unroll
            for (int m = 0; m < 4; ++m) { bf16_t* rowp = O + (size_t)(row0 + ai * HALF + m * 16) * NP1 + col0;
#pragma unroll
                for (int bj = 0; bj < 2; ++bj) { f32x4 v0 = acc[ai][bj][m][0] + bv[bj][0], v1 = acc[ai][bj][m][1] + bv[bj][1];
                    if (gate) {
#pragma unroll
                        for (int j = 0; j < 4; ++j) { v0[j] = sigmoidf_fast(v0[j]); v1[j] = sigmoidf_fast(v1[j]); } }
                    u32x4 w; w.x = cvt_pk_bf16(v0[0], v0[1]); w.y = cvt_pk_bf16(v0[2], v0[3]); w.z = cvt_pk_bf16(v1[0], v1[1]); w.w = cvt_pk_bf16(v1[2], v1[3]);
                    *(u32x4*)(rowp + bj * HALF) = w; } }
    }
};
struct EpiBf16 {
    static constexpr bool PERM = true, KEEPS = false;
    bf16_t* O; int ldc; const float* cscale;
    __device__ __forceinline__ void operator()(Acc& acc, const Unit& u, int wr, int wc, int fr, int fq) const {
        const int row0 = u.r0 + wr * 64 + fr, col0 = u.c0 + wc * 32 + 8 * fq;
#pragma unroll
        for (int bj = 0; bj < 2; ++bj) {
            const f32x4 s0 = cscale ? *(const f32x4*)(cscale + col0 + bj * HALF) : (f32x4){1.f, 1.f, 1.f, 1.f}, s1 = cscale ? *(const f32x4*)(cscale + col0 + bj * HALF + 4) : (f32x4){1.f, 1.f, 1.f, 1.f};
#pragma unroll
            for (int ai = 0; ai < 2; ++ai)
#pragma unroll
                for (int m = 0; m < 4; ++m) { bf16_t* rowp = O + (size_t)(row0 + ai * HALF + m * 16) * ldc + col0;
                    const f32x4 v0 = acc[ai][bj][m][0] * s0, v1 = acc[ai][bj][m][1] * s1;
                    u32x4 w; w.x = cvt_pk_bf16(v0[0], v0[1]); w.y = cvt_pk_bf16(v0[2], v0[3]); w.z = cvt_pk_bf16(v1[0], v1[1]); w.w = cvt_pk_bf16(v1[2], v1[3]);
                    *(u32x4*)(rowp + bj * HALF) = w; } }
    }
};
struct EpiBranch {
    static constexpr bool PERM = true, KEEPS = true;
    const bf16_t* PG; bf16_t* MG;
    __device__ __forceinline__ bool keep(const Unit& u) const { return u.x == 0; }
    __device__ __forceinline__ void operator()(Acc& acc, const Unit& u, int wr, int wc, int fr, int fq) const {
        const int row0 = u.r0 + wr * 64 + fr, col0 = u.c0 + wc * 32 + 8 * fq; const int br = u.x;
#pragma unroll
        for (int ai = 0; ai < 2; ++ai)
#pragma unroll
            for (int m = 0; m < 4; ++m) { const size_t row = (size_t)(row0 + ai * HALF + m * 16);
#pragma unroll
                for (int bj = 0; bj < 2; ++bj) { const int col = col0 + bj * HALF;
                    const u32x4 gb = *(const u32x4*)(PG + row * NP1 + INW + D + col);
                    f32x4 h0 = {bf_lo(gb.x), bf_hi(gb.x), bf_lo(gb.y), bf_hi(gb.y)}, h1 = {bf_lo(gb.z), bf_hi(gb.z), bf_lo(gb.w), bf_hi(gb.w)};
#pragma unroll
                    for (int j = 0; j < 4; ++j) { h0[j] = fmaxf(h0[j], 1e-30f); h1[j] = fmaxf(h1[j], 1e-30f); }
                    if (br == 0) { const u32x4 ga = *(const u32x4*)(PG + row * NP1 + INW + col);
                        const f32x4 a0 = {bf_lo(ga.x), bf_hi(ga.x), bf_lo(ga.y), bf_hi(ga.y)}, a1 = {bf_lo(ga.z), bf_hi(ga.z), bf_lo(ga.w), bf_hi(ga.w)};
#pragma unroll
                        for (int j = 0; j < 4; ++j) { acc[ai][bj][m][0][j] *= a0[j] * __builtin_amdgcn_rcpf(h0[j]); acc[ai][bj][m][1][j] *= a1[j] * __builtin_amdgcn_rcpf(h1[j]); } }
                    else { const f32x4 v0 = acc[ai][bj][m][0] * h0, v1 = acc[ai][bj][m][1] * h1;
                        u32x4 w; w.x = cvt_pk_bf16(v0[0], v0[1]); w.y = cvt_pk_bf16(v0[2], v0[3]); w.z = cvt_pk_bf16(v1[0], v1[1]); w.w = cvt_pk_bf16(v1[2], v1[3]);
                        *(u32x4*)(MG + row * D + col) = w; } } }
    }
};
struct EpiResid {
    static constexpr bool PERM = false, KEEPS = false;
    const float* res; float* out; int ldc;
    __device__ __forceinline__ void operator()(Acc& acc, const Unit& u, int wr, int wc, int fr, int fq) const {
        const int row0 = u.r0 + wr * 64 + fr, col0 = u.c0 + wc * 32 + 4 * fq;
#pragma unroll
        for (int ai = 0; ai < 2; ++ai)
#pragma unroll
            for (int m = 0; m < 4; ++m) { const size_t off = (size_t)(row0 + ai * HALF + m * 16) * ldc + col0;
#pragma unroll
                for (int bj = 0; bj < 2; ++bj)
#pragma unroll
                    for (int n = 0; n < 2; ++n) { const f32x4 r = *(const f32x4*)(res + off + bj * HALF + n * 16); *(f32x4*)(out + off + bj * HALF + n * 16) = r + acc[ai][bj][m][n]; }
                asm volatile("" ::: "memory"); }
    }
};
struct EpiUp {
    static constexpr bool PERM = true, KEEPS = false;
    const float* bup; unsigned char* ACT;
    struct Pre { f32x4 bg[2], bl[2]; };
    __device__ __forceinline__ void prefetch(Pre& p, const Unit& u, int wc, int fq) const {
        const float* be = bup + (size_t)u.x * (2 * DFF) + u.c0 * HALF + wc * 32 + 8 * fq;
#pragma unroll
        for (int n = 0; n < 2; ++n) { p.bg[n] = *(const f32x4*)(be + 4 * n); p.bl[n] = *(const f32x4*)(be + DFF + 4 * n) + 1.0f; }
    }
    __device__ __forceinline__ void init(Acc& acc, const Pre& p) const {
#pragma unroll
        for (int ai = 0; ai < 2; ++ai)
#pragma unroll
            for (int m = 0; m < 4; ++m)
#pragma unroll
                for (int n = 0; n < 2; ++n) { acc[ai][0][m][n] = p.bg[n]; acc[ai][1][m][n] = p.bl[n]; }
    }
    __device__ __forceinline__ void operator()(Acc& acc, const Unit& u, int wr, int wc, int fr, int fq) const {
        const int row0 = u.r0 + wr * 64 + fr, col0 = u.c0 * HALF + wc * 32 + 8 * fq;
        typedef float f32x2v __attribute__((ext_vector_type(2)));
#pragma unroll
        for (int ai = 0; ai < 2; ++ai)
#pragma unroll
            for (int m = 0; m < 4; ++m) { unsigned char* rowp = ACT + (size_t)(row0 + ai * HALF + m * 16) * DFF + col0; f32x4 o[2];
#pragma unroll
                for (int n = 0; n < 2; ++n) { const f32x4 gv = acc[ai][0][m][n], lv = acc[ai][1][m][n];
#pragma unroll
                    for (int j = 0; j < 4; j += 2) {
                        const f32x2v g = {__builtin_amdgcn_fmed3f(gv[j], -3.0e38f, 7.0f), __builtin_amdgcn_fmed3f(gv[j + 1], -3.0e38f, 7.0f)}, l = {__builtin_amdgcn_fmed3f(lv[j], -6.0f, 8.0f), __builtin_amdgcn_fmed3f(lv[j + 1], -6.0f, 8.0f)};
                        const f32x2v t = g * -2.4554669595930156f; const f32x2v e = {__builtin_amdgcn_exp2f(t.x), __builtin_amdgcn_exp2f(t.y)}; const f32x2v d = e + 1.0f;
                        const f32x2v r = {__builtin_amdgcn_rcpf(d.x), __builtin_amdgcn_rcpf(d.y)}; const f32x2v q = (g * l) * r; o[n][j] = q.x; o[n][j + 1] = q.y; } }
                u32x2 w; w.x = pk4_fp8(o[0][0], o[0][1], o[0][2], o[0][3]); w.y = pk4_fp8(o[1][0], o[1][1], o[1][2], o[1][3]);
                *(u32x2*)rowp = w; }
    }
};
struct EpiDown {
    static constexpr bool PERM = true, KEEPS = false;
    const float* bdn; const int* rslot; const float* gate; unsigned char* SLOT;
    __device__ __forceinline__ void operator()(Acc& acc, const Unit& u, int wr, int wc, int fr, int fq) const {
        const int row0 = u.r0 + wr * 64 + fr, col0 = u.c0 * BM + wc * 32 + 8 * fq; const float* be = bdn + (size_t)u.x * D;
        f32x4 bv[2][2];
#pragma unroll
        for (int bj = 0; bj < 2; ++bj)
#pragma unroll
            for (int n = 0; n < 2; ++n) bv[bj][n] = *(const f32x4*)(be + col0 + bj * HALF + 4 * n);
#pragma unroll
        for (int ai = 0; ai < 2; ++ai)
#pragma unroll
            for (int m = 0; m < 4; ++m) { const int sl = rslot[row0 + ai * HALF + m * 16];
                if (sl >= 0) { const float gt = gate[sl] * 16.0f; unsigned char* rowp = SLOT + (size_t)sl * D + col0;
#pragma unroll
                    for (int bj = 0; bj < 2; ++bj) { const f32x4 v0 = (acc[ai][bj][m][0] + bv[bj][0]) * gt, v1 = (acc[ai][bj][m][1] + bv[bj][1]) * gt;
                        u32x2 w; w.x = pk4_fp8(v0[0], v0[1], v0[2], v0[3]); w.y = pk4_fp8(v1[0], v1[1], v1[2], v1[3]);
                        *(u32x2*)(rowp + bj * HALF) = w; } } }
    }
};
}

struct Frame {
    LAS unsigned char* lds;
    int tid, lane, wave, vcu, G;
};

__device__ __forceinline__ void cvt_item_addr(const float* W, int K, int N, bf16_t* WT, int row_off, int item, int lane, const float*& src, bf16_t*& dst) {
    const int nblk = N >> 5, kb = item / nblk, nb = item - kb * nblk, kl = lane >> 3, nl = lane & 7;
    src = W + (size_t)(64 * kb + 8 * kl) * N + 32 * nb + 4 * nl; dst = WT + (size_t)(row_off + 32 * nb + 4 * nl) * K + 64 * kb + 8 * kl;
}
__device__ __forceinline__ void cvt_store(const f32x4 (&v)[8], bf16_t* dst, int K) {
#pragma unroll
    for (int i = 0; i < 4; ++i) { u32x4 o; o.x = cvt_pk_bf16(v[0][i], v[1][i]); o.y = cvt_pk_bf16(v[2][i], v[3][i]); o.z = cvt_pk_bf16(v[4][i], v[5][i]); o.w = cvt_pk_bf16(v[6][i], v[7][i]);
        *(u32x4*)(dst + (size_t)i * K) = o; }
}
__device__ __forceinline__ void cvt_store8(const f32x4 (&v)[8], unsigned char* dst, int K) {
#pragma unroll
    for (int i = 0; i < 4; ++i) { u32x2 o; o.x = pk4_fp8(v[0][i] * 64.f, v[1][i] * 64.f, v[2][i] * 64.f, v[3][i] * 64.f); o.y = pk4_fp8(v[4][i] * 64.f, v[5][i] * 64.f, v[6][i] * 64.f, v[7][i] * 64.f);
        *(u32x2*)(dst + (size_t)i * K) = o; }
}
__device__ __forceinline__ void cvt_range(const float* W, int K, int N, bf16_t* WT, int row_off, int i0, int cnt, int r, int nw, int lane) {
    int it = i0 + r; const int end = i0 + cnt;
    for (; it + nw < end; it += 2 * nw) {
        const float* s0; bf16_t* d0; const float* s1; bf16_t* d1;
        cvt_item_addr(W, K, N, WT, row_off, it, lane, s0, d0); cvt_item_addr(W, K, N, WT, row_off, it + nw, lane, s1, d1);
        f32x4 a[8], b[8];
#pragma unroll
        for (int j = 0; j < 8; ++j) a[j] = *(const f32x4*)(s0 + (size_t)j * N);
#pragma unroll
        for (int j = 0; j < 8; ++j) b[j] = *(const f32x4*)(s1 + (size_t)j * N);
        cvt_store(a, d0, K); cvt_store(b, d1, K);
    }
    if (it < end) { const float* s0; bf16_t* d0; cvt_item_addr(W, K, N, WT, row_off, it, lane, s0, d0); f32x4 a[8];
#pragma unroll
        for (int j = 0; j < 8; ++j) a[j] = *(const f32x4*)(s0 + (size_t)j * N);
        cvt_store(a, d0, K); }
}
constexpr int CV_UP = NE * (D / 64) * (2 * DFF / 32), CV_DN = NE * (DFF / 64) * (D / 32), CV_ALL = CV_UP + CV_DN;
struct MoeW { const float* w_up; const float* w_down; unsigned char* WUPT; unsigned char* WDNT; };
__device__ __forceinline__ void cvt_moe_addr(const MoeW& mw, int chunk, int w, int h, int lane, const float*& src, unsigned char*& dst, int& N) {
    const int kl = lane >> 3, nl = lane & 7;
    if (chunk < CV_UP / 64) { const int e = chunk >> 6, cc = chunk & 63, kb = 8 * (cc >> 4) + w, nb = 8 * (cc & 15) + h; N = 2 * DFF;
        src = mw.w_up + (size_t)e * D * 2 * DFF + (size_t)(64 * kb + 8 * kl) * (2 * DFF) + 32 * nb + 4 * nl; dst = mw.WUPT + (size_t)e * 2 * DFF * D + (size_t)(32 * nb + 4 * nl) * D + 64 * kb + 8 * kl; }
    else { const int q = chunk - CV_UP / 64, e = q >> 5, cc = q & 31, kb = 8 * (cc >> 3) + w, nb = 8 * (cc & 7) + h; N = D;
        src = mw.w_down + (size_t)e * DFF * D + (size_t)(64 * kb + 8 * kl) * D + 32 * nb + 4 * nl; dst = mw.WDNT + (size_t)e * D * DFF + (size_t)(32 * nb + 4 * nl) * DFF + 64 * kb + 8 * kl; }
}
__device__ __forceinline__ f32x4 ld_nt(const float* p) { return __builtin_nontemporal_load((const f32x4*)p); }
constexpr int CV_WG = 64;
__device__ __forceinline__ int cvt_claim(unsigned* cursor, int cap, unsigned* done, unsigned need) {
    if (done && __hip_atomic_load(done, __ATOMIC_RELAXED, __HIP_MEMORY_SCOPE_AGENT) >= need) return CV_ALL;
    if ((int)__hip_atomic_load(cursor, __ATOMIC_RELAXED, __HIP_MEMORY_SCOPE_AGENT) >= cap) return CV_ALL;
    return (int)__hip_atomic_fetch_add(cursor, (unsigned)CV_WG, __ATOMIC_RELAXED, __HIP_MEMORY_SCOPE_AGENT);
}
__device__ __forceinline__ void cvt_pull(const MoeW& mw, unsigned* cursor, int cap, unsigned* done, unsigned need, volatile LAS int* slot, int tid, int wave, int lane) {
    __syncthreads();
    if (tid == 0) *slot = cvt_claim(cursor, cap, done, need);
    __syncthreads();
    int base = __builtin_amdgcn_readfirstlane(*slot);
    while (base < CV_ALL) {
        int nb = CV_ALL; if (tid == 0) nb = cvt_claim(cursor, cap, done, need);
        const int chunk = base >> 6;
        if (chunk < CV_UP / 64) {
            const int e = chunk >> 6, cc = chunk & 63, nb = 8 * (cc & 15) + wave, kl = lane >> 3, nl = lane & 7;
#pragma unroll 1
            for (int q = 0; q < 2; ++q) { const int kq = 2 * (cc >> 4) + q, kb32 = 8 * kq + kl;
                const float* src = mw.w_up + (size_t)e * D * 2 * DFF + (size_t)(32 * kb32) * (2 * DFF) + 32 * nb + 4 * nl;
                f32x4 a[32];
#pragma unroll
                for (int j = 0; j < 32; ++j) a[j] = ld_nt(src + (size_t)j * (2 * DFF));
                unsigned char* dst = mw.WUPT + (size_t)e * 2 * DFF * D + (size_t)(32 * nb + 4 * nl) * D + 128 * (kb32 >> 2) + 16 * (kb32 & 3);
#pragma unroll
                for (int i = 0; i < 4; ++i) { f32x16 lo, hi;
#pragma unroll
                    for (int j = 0; j < 16; ++j) { lo[j] = a[j][i] * 64.f; hi[j] = a[16 + j][i] * 64.f; }
                    st_fp6_block(dst + (size_t)i * D, pk32_fp6(lo, hi)); } }
        } else
#pragma unroll
        for (int h = 0; h < 8; h += 4) {
            const float* s0; unsigned char* d0; const float* s1; unsigned char* d1; const float* s2; unsigned char* d2; const float* s3; unsigned char* d3; int N0, N1, N2, N3;
            cvt_moe_addr(mw, chunk, wave, h, lane, s0, d0, N0); cvt_moe_addr(mw, chunk, wave, h + 1, lane, s1, d1, N1); cvt_moe_addr(mw, chunk, wave, h + 2, lane, s2, d2, N2); cvt_moe_addr(mw, chunk, wave, h + 3, lane, s3, d3, N3);
            f32x4 a[8], b[8], c[8], d[8];
#pragma unroll
            for (int j = 0; j < 8; ++j) a[j] = ld_nt(s0 + (size_t)j * N0);
#pragma unroll
            for (int j = 0; j < 8; ++j) b[j] = ld_nt(s1 + (size_t)j * N1);
#pragma unroll
            for (int j = 0; j < 8; ++j) c[j] = ld_nt(s2 + (size_t)j * N2);
#pragma unroll
            for (int j = 0; j < 8; ++j) d[j] = ld_nt(s3 + (size_t)j * N3);
            cvt_store8(a, d0, D); cvt_store8(b, d1, D); cvt_store8(c, d2, D); cvt_store8(d, d3, D);
        }
        __syncthreads();
        if (tid == 0) *slot = nb;
        __syncthreads();
        base = __builtin_amdgcn_readfirstlane(*slot);
    }
}
__device__ __forceinline__ void rms_row_to_bf16(const float* xrow, const float* gvec, bf16_t* orow, int lane) {
    const f32x4* xr = (const f32x4*)xrow + lane; f32x4 v[8]; float s = 0.f;
#pragma unroll
    for (int j = 0; j < 8; ++j) { v[j] = xr[64 * j]; s += (v[j].x * v[j].x + v[j].y * v[j].y) + (v[j].z * v[j].z + v[j].w * v[j].w); }
    const float rstd = 1.0f / sqrtf(wave_sum(s) * (1.0f / D) + RMS_EPS);
    const f32x4* gr = (const f32x4*)gvec + lane; u32x2* o8 = (u32x2*)orow + lane;
#pragma unroll
    for (int j = 0; j < 8; ++j) { const f32x4 g = gr[64 * j]; const f32x4 y = v[j] * rstd * g; u32x2 w; w.x = cvt_pk_bf16(y.x, y.y); w.y = cvt_pk_bf16(y.z, y.w); o8[64 * j] = w; }
}

__device__ __forceinline__ unsigned voff_b(unsigned row, unsigned ch) { return 256u * row + 16u * (ch ^ (((row & 3u) << 2) | ((row >> 2) & 3u))); }
__device__ __forceinline__ s16x4 vtr(const LAS unsigned char* p) { return __builtin_bit_cast(s16x4, __builtin_amdgcn_ds_read_tr16_b64_v4i16((LAS s16x4*)p)); }

__device__ __forceinline__ void sb_wg_unit(const bf16_t* PG, bf16_t* OA, int h, int qb, LAS unsigned char* lds, volatile LAS int* flags, int tid, int wave, int lane) {
    const int fr = lane & 15, fq = lane >> 4, q0w = qb * 128 + wave * 16, qi = q0w + fr;
    bf16x8 Qf[4];
    { const bf16_t* qp = PG + (size_t)qi * NP1 + h * HD + 8 * fq;
#pragma unroll
      for (int ks = 0; ks < 4; ++ks) Qf[ks] = *(const bf16x8*)(qp + 32 * ks); }
    f32x4 O[8];
#pragma unroll
    for (int db = 0; db < 8; ++db) O[db] = (f32x4){0.f, 0.f, 0.f, 0.f};
    float carry = 0.f; bool sat = false;
    const float scale = 0.08838834764831845f;
    const unsigned p = fr & 3, qq = fr >> 2;
    const int jt_hi = 2 * qb + 1, jt_w = q0w >> 6;
    const int srow = tid >> 4, sch = tid & 15;
    const bf16_t* kg = PG + (size_t)srow * NP1 + SBW + h * HD + 8 * sch;
    u32x4 kr[2], vr[2];
    __syncthreads();
    if (tid < 8) flags[tid] = 0;
    { const bf16_t* g = kg + (size_t)(jt_hi * 64) * NP1;
#pragma unroll
      for (int i = 0; i < 2; ++i) { kr[i] = *(const u32x4*)(g + (size_t)(32 * i) * NP1); vr[i] = *(const u32x4*)(g + (size_t)(32 * i) * NP1 + SBW); } }
    for (int jt = jt_hi, it = 0; jt >= 0; --jt, ++it) {
        LAS unsigned char* kb = lds + (it & 1) * 32768; LAS unsigned char* vb = kb + 16384;
#pragma unroll
        for (int i = 0; i < 2; ++i) { *(LAS u32x4*)(kb + voff_b(srow + 32 * i, sch)) = kr[i]; *(LAS u32x4*)(vb + voff_b(srow + 32 * i, sch)) = vr[i]; }
        __syncthreads();
        { int ns = 0;
#pragma unroll
          for (int w = 0; w < 8; ++w) ns += flags[w];
          if (__builtin_amdgcn_readfirstlane(ns) == 8) break; }
        if (jt > 0) { const bf16_t* g = kg + (size_t)((jt - 1) * 64) * NP1;
#pragma unroll
            for (int i = 0; i < 2; ++i) { kr[i] = *(const u32x4*)(g + (size_t)(32 * i) * NP1); vr[i] = *(const u32x4*)(g + (size_t)(32 * i) * NP1 + SBW); } }
        if (!sat && jt <= jt_w) {
            const int key0 = jt * 64;
            f32x4 z[4];
#pragma unroll
            for (int sb = 0; sb < 4; ++sb) { z[sb] = (f32x4){0.f, 0.f, 0.f, 0.f};
#pragma unroll
                for (int ks = 0; ks < 4; ++ks) { const bf16x8 kf = *(const LAS bf16x8*)(kb + voff_b(16 * sb + fr, 4 * ks + fq)); z[sb] = __builtin_amdgcn_mfma_f32_16x16x32_bf16(kf, Qf[ks], z[sb], 0, 0, 0); } }
            float sfx[4][4], g[4], lex[4], T[4];
            const bool diag = key0 + 64 > q0w;
#pragma unroll
            for (int sb = 0; sb < 4; ++sb) {
                float sp[4];
#pragma unroll
                for (int i = 0; i < 4; ++i) { const float y = z[sb][i] * (scale * 1.4426950408889634f); z[sb][i] = y;
                    sp[i] = fmaxf(y, 0.f) + __builtin_amdgcn_logf(1.0f + __builtin_amdgcn_exp2f(-fabsf(y))); }
                if (diag) {
#pragma unroll
                    for (int i = 0; i < 4; ++i) { const int key = key0 + 16 * sb + 4 * fq + i; sp[i] = (key < qi) ? sp[i] : 0.f; } }
                sfx[sb][3] = sp[3]; sfx[sb][2] = sp[2] + sfx[sb][3]; sfx[sb][1] = sp[1] + sfx[sb][2]; sfx[sb][0] = sp[0] + sfx[sb][1]; g[sb] = sfx[sb][0];
            }
#pragma unroll
            for (int sb = 0; sb < 4; ++sb) { const float x1 = __shfl_xor(g[sb], 16), x2 = __shfl_xor(g[sb], 32), x3 = __shfl_xor(g[sb], 48);
                T[sb] = (g[sb] + x1) + (x2 + x3); lex[sb] = ((fq & 1) ? 0.f : x1) + ((fq < 2) ? (x2 + x3) : 0.f); }
            float run = carry; bf16x8 Wf[2]; unsigned wpk[8];
#pragma unroll
            for (int sb = 3; sb >= 0; --sb) { const float base = run + lex[sb]; float w[4];
#pragma unroll
                for (int i = 0; i < 4; ++i) w[i] = __builtin_amdgcn_exp2f(z[sb][i] - (base + sfx[sb][i]));
                if (diag) {
#pragma unroll
                    for (int i = 0; i < 4; ++i) { const int key = key0 + 16 * sb + 4 * fq + i; w[i] = (key < qi) ? w[i] : 0.f; } }
                wpk[2 * sb] = cvt_pk_bf16(w[0], w[1]); wpk[2 * sb + 1] = cvt_pk_bf16(w[2], w[3]); run += T[sb]; }
            carry = run;
            { u32x4 a = {wpk[0], wpk[1], wpk[2], wpk[3]}, b = {wpk[4], wpk[5], wpk[6], wpk[7]}; Wf[0] = __builtin_bit_cast(bf16x8, a); Wf[1] = __builtin_bit_cast(bf16x8, b); }
#pragma unroll
            for (int db = 0; db < 8; ++db)
#pragma unroll
                for (int m = 0; m < 2; ++m) { const unsigned r1 = 32 * m + 4 * fq + qq, r2 = r1 + 16;
                    const s16x4 lo = vtr(vb + voff_b(r1, 2 * db + (p >> 1)) + 8 * (p & 1)), hi = vtr(vb + voff_b(r2, 2 * db + (p >> 1)) + 8 * (p & 1));
                    const bf16x8 vf = {lo[0], lo[1], lo[2], lo[3], hi[0], hi[1], hi[2], hi[3]};
                    O[db] = __builtin_amdgcn_mfma_f32_16x16x32_bf16(vf, Wf[m], O[db], 0, 0, 0); }
            if (__all(carry > 150.1f)) { sat = true; if (lane == 0) flags[wave] = 1; }
        }
    }
    { bf16_t* op = OA + (size_t)qi * SBW + h * HD + 4 * fq;
#pragma unroll
      for (int db = 0; db < 8; ++db) { u32x2 w; w.x = cvt_pk_bf16(O[db][0], O[db][1]); w.y = cvt_pk_bf16(O[db][2], O[db][3]); *(u32x2*)(op + 16 * db) = w; } }
}

__device__ __forceinline__ void xa_unit(const bf16_t* QXA, const bf16_t* KVM, bf16_t* OXA, int h, int qb, const LAS unsigned char* vl, int lane) {
    const int fr = lane & 15, fq = lane >> 4, q0 = qb * 16, qi = q0 + fr;
    bf16x8 Qf[4];
    { const bf16_t* qp = QXA + (size_t)qi * XAW + h * HD + 8 * fq;
#pragma unroll
      for (int ks = 0; ks < 4; ++ks) Qf[ks] = *(const bf16x8*)(qp + 32 * ks); }
    f32x4 z[16];
    { const bf16_t* kp = KVM + (size_t)fr * (2 * XAW) + h * HD + 8 * fq;
#pragma unroll
      for (int sb = 0; sb < 16; ++sb) { z[sb] = (f32x4){0.f, 0.f, 0.f, 0.f};
#pragma unroll
          for (int ks = 0; ks < 4; ++ks) { const bf16x8 kf = *(const bf16x8*)(kp + (size_t)(16 * sb) * (2 * XAW) + 32 * ks); z[sb] = __builtin_amdgcn_mfma_f32_16x16x32_bf16(kf, Qf[ks], z[sb], 0, 0, 0); } } }
    const float scale = 0.08838834764831845f * 1.4426950408889634f;
    float mx = -3.0e38f;
#pragma unroll
    for (int sb = 0; sb < 16; ++sb)
#pragma unroll
        for (int i = 0; i < 4; ++i) { z[sb][i] *= scale; mx = fmaxf(mx, z[sb][i]); }
    mx = fmaxf(mx, __shfl_xor(mx, 16)); mx = fmaxf(mx, __shfl_xor(mx, 32));
    float sum = 0.f;
#pragma unroll
    for (int sb = 0; sb < 16; ++sb)
#pragma unroll
        for (int i = 0; i < 4; ++i) { const float e = __builtin_amdgcn_exp2f(z[sb][i] - mx); z[sb][i] = e; sum += e; }
    sum += __shfl_xor(sum, 16); sum += __shfl_xor(sum, 32);
    const float inv = 1.0f / sum;
    f32x4 O[8];
#pragma unroll
    for (int db = 0; db < 8; ++db) O[db] = (f32x4){0.f, 0.f, 0.f, 0.f};
    const unsigned p = fr & 3, qq = fr >> 2;
#pragma unroll
    for (int m = 0; m < 8; ++m) {
        u32x4 a = {cvt_pk_bf16(z[2 * m][0], z[2 * m][1]), cvt_pk_bf16(z[2 * m][2], z[2 * m][3]), cvt_pk_bf16(z[2 * m + 1][0], z[2 * m + 1][1]), cvt_pk_bf16(z[2 * m + 1][2], z[2 * m + 1][3])};
        const bf16x8 Wf = __builtin_bit_cast(bf16x8, a);
#pragma unroll
        for (int db = 0; db < 8; ++db) { const unsigned r1 = 32 * m + 4 * fq + qq, r2 = r1 + 16;
            const s16x4 lo = vtr(vl + voff_b(r1, 2 * db + (p >> 1)) + 8 * (p & 1)), hi = vtr(vl + voff_b(r2, 2 * db + (p >> 1)) + 8 * (p & 1));
            const bf16x8 vf = {lo[0], lo[1], lo[2], lo[3], hi[0], hi[1], hi[2], hi[3]};
            O[db] = __builtin_amdgcn_mfma_f32_16x16x32_bf16(vf, Wf, O[db], 0, 0, 0); }
    }
    { bf16_t* op = OXA + (size_t)qi * XAW + h * HD + 4 * fq;
#pragma unroll
      for (int db = 0; db < 8; ++db) { const f32x4 o = O[db] * inv; u32x2 w; w.x = cvt_pk_bf16(o[0], o[1]); w.y = cvt_pk_bf16(o[2], o[3]); *(u32x2*)(op + 16 * db) = w; } }
}

template <int W>
__device__ __forceinline__ void pool_run(const bf16_t* PG, bf16_t* PO, int t0, int ch) {
    constexpr int NR = W + 7;
    const bf16_t* pp = PG + (size_t)(t0 + 7) * NP1 + 3 * SBW + ch * 8;
    u32x4 v[NR];
#pragma unroll
    for (int k = 0; k < NR; ++k) v[k] = (t0 + 7 - k >= 0) ? *(const u32x4*)(pp - (size_t)k * NP1) : (u32x4){0u, 0u, 0u, 0u};
#pragma unroll
    for (int i = 0; i < 8; ++i) {
        float s[8];
#pragma unroll
        for (int j = 0; j < 8; ++j) s[j] = 0.f;
#pragma unroll
        for (int j = W - 1; j >= 0; --j) { const u32x4 x = v[7 - i + j];
            s[0] += bf_lo(x.x); s[1] += bf_hi(x.x); s[2] += bf_lo(x.y); s[3] += bf_hi(x.y); s[4] += bf_lo(x.z); s[5] += bf_hi(x.z); s[6] += bf_lo(x.w); s[7] += bf_hi(x.w); }
        const int t = t0 + i, n = (t + 1 < W) ? (t + 1) : W; const float inv = 1.0f / (float)n; const u32x4 me = v[7 - i]; u32x4 o;
        o.x = cvt_pk_bf16(s[0] * inv - bf_lo(me.x), s[1] * inv - bf_hi(me.x)); o.y = cvt_pk_bf16(s[2] * inv - bf_lo(me.y), s[3] * inv - bf_hi(me.y));
        o.z = cvt_pk_bf16(s[4] * inv - bf_lo(me.z), s[5] * inv - bf_hi(me.z)); o.w = cvt_pk_bf16(s[6] * inv - bf_lo(me.w), s[7] * inv - bf_hi(me.w));
        *(u32x4*)(PO + (size_t)t * POOLW + ch * 8) = o;
    }
}

constexpr int NPHASE = 15;
struct Args { const float* in[24]; float* out; unsigned char* ws; int ph_lo, ph_hi; };
static_assert(sizeof(Args) == 24 * 8 + 8 + 8 + 8, "Args has no padding");

__global__ void __launch_bounds__(NWAVES * 64, 2) moe_fwd(Args args) {
    extern __shared__ __attribute__((aligned(16))) unsigned char lds_raw[];
    Frame F;
    F.lds = (LAS unsigned char*)lds_raw;
    F.tid = threadIdx.x; F.lane = F.tid & 63; F.wave = __builtin_amdgcn_readfirstlane(F.tid >> 6);
    F.G = gridDim.x; { const int bx = blockIdx.x; F.vcu = (F.G % 8 == 0) ? (bx % 8) * (F.G / 8) + bx / 8 : bx; }
    unsigned char* ws = args.ws;
    unsigned* ctl = (unsigned*)(ws + WS_CTL);
    LAS unsigned char* lx = F.lds + LDS_X_OFF;
    for (int u = F.tid; u < (LDS_BYTES - LDS_X_OFF) / 4; u += NWAVES * 64) ((LAS unsigned*)lx)[u] = 0u;
    __syncthreads();
#if MK_ONE_LAUNCH
    XcdBarrier bar = xcd_barrier_post(ctl + CW_BAR, (volatile LAS unsigned*)(lx + LX_BAR));
#define GRID_BAR() xcd_barrier(bar)
#else
#define GRID_BAR() do {} while (0)
#endif
    const int lo = args.ph_lo, hi = args.ph_hi;
#ifndef PHASE_MASK
#define PHASE_MASK 0x7fff
#endif
#define IN(k) (((PHASE_MASK >> (k)) & 1) && lo <= (k) && (k) < hi)
#define SEAM(k) do { if (IN((k) + 1)) GRID_BAR(); } while (0)

    const float* x = args.in[0]; const float* mem = args.in[1]; const float* norm_mix = args.in[2]; const float* w_in = args.in[3]; const float* pool_lin = args.in[4];
    const float* pool_scale = args.in[5]; const float* w_branch_a = args.in[6]; const float* w_branch_b = args.in[7]; const float* w_gate = args.in[8]; const float* b_gate = args.in[9];
    const float* w_mix_out = args.in[10]; const float* xa_norm = args.in[11]; const float* mem_norm = args.in[12]; const float* xa_wq = args.in[13]; const float* xa_wkv = args.in[14];
    const float* xa_wo = args.in[15]; const float* moe_norm = args.in[16]; const float* w_router = args.in[17]; const float* b_router = args.in[18]; const float* w_up = args.in[19];
    const float* b_up = args.in[20]; const float* w_down = args.in[21]; const float* b_down = args.in[22]; const float* final_norm = args.in[23];
    bf16_t* W1T = (bf16_t*)(ws + WS_W1T); bf16_t* WAT = (bf16_t*)(ws + WS_WAT); bf16_t* WBT = (bf16_t*)(ws + WS_WBT); bf16_t* WMT = (bf16_t*)(ws + WS_WMT); bf16_t* PLT = (bf16_t*)(ws + WS_PLT);
    bf16_t* WQT = (bf16_t*)(ws + WS_WQT); bf16_t* WKVT = (bf16_t*)(ws + WS_WKVT); bf16_t* WOT = (bf16_t*)(ws + WS_WOT); unsigned char* WUPT = ws + WS_WUPT; unsigned char* WDNT = ws + WS_WDNT;
    bf16_t* U = (bf16_t*)(ws + WS_U); bf16_t* MEMN = (bf16_t*)(ws + WS_MEMN); bf16_t* PG = (bf16_t*)(ws + WS_PG); bf16_t* OA = (bf16_t*)(ws + WS_OA); bf16_t* PO = (bf16_t*)(ws + WS_PO);
    bf16_t* OB = (bf16_t*)(ws + WS_OB); float* TMP = (float*)(ws + WS_TMP); bf16_t* MG = (bf16_t*)(ws + WS_MG); float* H1 = (float*)(ws + WS_H1); bf16_t* U2 = (bf16_t*)(ws + WS_U2);
    bf16_t* QXA = (bf16_t*)(ws + WS_QXA); bf16_t* KVM = (bf16_t*)(ws + WS_KVM); bf16_t* OXA = (bf16_t*)(ws + WS_OXA); float* H2 = (float*)(ws + WS_H2); unsigned char* TB = ws + WS_TB;
    bf16_t* ROWS = (bf16_t*)(ws + WS_ROWS); unsigned char* ACT = ws + WS_ACT; unsigned char* SLOT = ws + WS_SLOT;
    int* ASGE = (int*)(ws + WS_ASGE); int* ASGP = (int*)(ws + WS_ASGP); float* GATE = (float*)(ws + WS_GATE); int* RSLOT = (int*)(ws + WS_RSLOT);
    int* CNT = (int*)(ctl + CW_CNT); bf16_t* WRT = (bf16_t*)(ws + WS_WRT);
    const int gw = F.vcu * NWAVES + F.wave, NGW = F.G * NWAVES;
    const MoeW mw{w_up, w_down, WUPT, WDNT};
    unsigned* CUR = ctl + CW_CUR; volatile LAS int* cvs = (volatile LAS int*)(lx + LX_CVS);
#define CVT_PULL(cap) cvt_pull(mw, CUR, (cap), nullptr, 0u, cvs, F.tid, F.wave, F.lane)
#define CVT_BESIDE(cap, ph, need) cvt_pull(mw, CUR, (cap), ctl + CW_DONE + 64 * (ph), (unsigned)(need), cvs, F.tid, F.wave, F.lane)
#define MARK_DONE(ph) do { if (F.tid == 0) __hip_atomic_fetch_add(ctl + CW_DONE + 64 * (ph), 1u, __ATOMIC_RELAXED, __HIP_MEMORY_SCOPE_AGENT); } while (0)

    if (IN(0)) {
        constexpr int I_IN = (D / 64) * (INW / 32), I_BR = (SBW / 64) * (D / 32), I_MX = (D / 64) * (D / 32), I_PL = (256 / 64) * (256 / 32);
        constexpr int I_Q = (D / 64) * (XAW / 32), I_KV = (D / 64) * (2 * XAW / 32), I_O = (XAW / 64) * (D / 32);
        cvt_range(w_in, D, INW, W1T, 0, 0, I_IN, gw, NGW, F.lane);
        cvt_range(w_gate, D, INW, W1T, INW, 0, I_IN, gw, NGW, F.lane);
        for (int m = gw; m < S; m += NGW) rms_row_to_bf16(x + (size_t)m * D, norm_mix, U + (size_t)m * D, F.lane);
        for (int m = gw; m < MEM; m += NGW) rms_row_to_bf16(mem + (size_t)m * D, mem_norm, MEMN + (size_t)m * D, F.lane);
        for (int i = blockIdx.x * (NWAVES * 64) + F.tid; i < NE * D / 2; i += F.G * NWAVES * 64) {
            const int e = i >> 10, c = (i & 1023) * 2; const float a = w_router[(size_t)c * NE + e], b = w_router[(size_t)(c + 1) * NE + e];
            const unsigned hi = cvt_pk_bf16(a, b); const unsigned lo = cvt_pk_bf16(a - bf_lo(hi), b - bf_hi(hi));
            *(unsigned*)(WRT + (size_t)e * D + c) = hi; *(unsigned*)(WRT + (size_t)(NE + e) * D + c) = lo; }
        __syncthreads();
        SEAM(0);
    }

    if (IN(1)) {
        const int gc = (F.G == 256) ? GC_P1 : F.G;
        if ((int)blockIdx.x < gc) {
            pg8::DenseSched Sc{(const char*)U, (const char*)W1T, D, D, S / 256, NP1 / 256, gc, (int)blockIdx.x};
            pg8::EpiProj E{PG, b_gate};
            pg8::gemm_phase<pg8::EpiProj, pg8::DenseSched, true>(F.lds, D, D, D, Sc, E);
            MARK_DONE(1);
        }
        if ((int)blockIdx.x >= gc) {
            constexpr int I_BR = (SBW / 64) * (D / 32), I_MX = (D / 64) * (D / 32), I_PL = (256 / 64) * (256 / 32), I_Q = (D / 64) * (XAW / 32), I_KV = (D / 64) * (2 * XAW / 32), I_O = (XAW / 64) * (D / 32);
            const int cr = ((int)blockIdx.x - gc) * NWAVES + F.wave, cn = (F.G - gc) * NWAVES;
        cvt_range(w_branch_a, SBW, D, WAT, 0, 0, I_BR, cr, cn, F.lane);
        cvt_range(w_branch_b, POOLW, D, WBT, 0, 0, I_BR, cr, cn, F.lane);
        cvt_range(w_mix_out, D, D, WMT, 0, 0, I_MX, cr, cn, F.lane);
        for (int g = 0; g < 4; ++g) cvt_range(pool_lin + (size_t)g * 65536, 256, 256, PLT + (size_t)g * 65536, 0, 0, I_PL, cr, cn, F.lane);
        cvt_range(xa_wq, D, XAW, WQT, 0, 0, I_Q, cr, cn, F.lane);
        cvt_range(xa_wkv, D, 2 * XAW, WKVT, 0, 0, I_KV, cr, cn, F.lane);
        cvt_range(xa_wo, XAW, D, WOT, 0, 0, I_O, cr, cn, F.lane);
        }
        CVT_BESIDE(CV_UP, 1, gc);
        SEAM(1);
    }

    if (IN(2)) {
        for (int it = blockIdx.x * (NWAVES * 64) + F.tid; it < (S / 8) * (POOLW / 8); it += F.G * NWAVES * 64) {
            const int wv = it >> 6, g = wv & 3, rb = (wv >> 2) * 2 + (F.lane >> 5), ch = g * 32 + (F.lane & 31), t0 = rb * 8;
            if (g == 0) pool_run<2>(PG, PO, t0, ch); else if (g == 1) pool_run<4>(PG, PO, t0, ch); else if (g == 2) pool_run<8>(PG, PO, t0, ch); else pool_run<16>(PG, PO, t0, ch);
        }
        for (int it = F.vcu; it < SBH * (S / 128); it += F.G) { const int h = it & 7, qb = (S / 128 - 1) - (it >> 3); sb_wg_unit(PG, OA, h, qb, F.lds, (volatile LAS int*)(lx + LX_SBF), F.tid, F.wave, F.lane); }
        __syncthreads();
        SEAM(2);
    }

    if (IN(3)) {
        pg8::PoolSched Sc{(const char*)PO, (const char*)PLT, F.G, F.vcu};
        pg8::EpiBf16 E{OB, POOLW, pool_scale};
        pg8::gemm_phase<pg8::EpiBf16, pg8::PoolSched, true>(F.lds, 256, POOLW, 256, Sc, E);
        if (F.vcu < (S / 256) * 4) MARK_DONE(3);
        CVT_BESIDE(CV_UP, 3, (S / 256) * 4);
        SEAM(3);
    }

    if (IN(4)) {
        pg8::BranchSched Sc{(const char*)OA, (const char*)OB, (const char*)WAT, (const char*)WBT, SBW, SBW, S / 256, D / 256, F.G, (int)blockIdx.x};
        pg8::EpiBranch E{PG, MG};
        pg8::gemm_phase<pg8::EpiBranch, pg8::BranchSched, true>(F.lds, SBW, SBW, SBW, Sc, E);
        SEAM(4);
    }

    if (IN(5)) {
        pg8::DenseSched Sc{(const char*)MG, (const char*)WMT, D, D, S / 256, D / 256, F.G, (int)blockIdx.x};
        pg8::EpiResid E{x, H1, D};
        pg8::gemm_phase<pg8::EpiResid, pg8::DenseSched, true>(F.lds, D, D, D, Sc, E);
        SEAM(5);
    }

    if (IN(6)) {
        for (int m = gw; m < S; m += NGW) rms_row_to_bf16(H1 + (size_t)m * D, xa_norm, U2 + (size_t)m * D, F.lane);
        SEAM(6);
    }

    if (IN(7)) {
        { pg8::DenseSched Sc{(const char*)U2, (const char*)WQT, D, D, S / 256, XAW / 256, F.G, (int)blockIdx.x};
          pg8::EpiBf16 E{QXA, XAW, nullptr};
          pg8::gemm_phase<pg8::EpiBf16, pg8::DenseSched, true>(F.lds, D, D, D, Sc, E); }
        { const int c2 = ((int)blockIdx.x >= 64) ? (int)blockIdx.x - 64 : (int)blockIdx.x + F.G - 64;
          pg8::DenseSched Sc{(const char*)MEMN, (const char*)WKVT, D, D, MEM / 256, 2 * XAW / 256, F.G, c2};
          pg8::EpiBf16 E{KVM, 2 * XAW, nullptr};
          pg8::gemm_phase<pg8::EpiBf16, pg8::DenseSched, true>(F.lds, D, D, D, Sc, E); }
        if ((int)blockIdx.x < 68) MARK_DONE(7);
        CVT_BESIDE(CV_UP, 7, 68);
        SEAM(7);
    }

    if (IN(8)) {
        for (int it = F.vcu; it < XAH * (S / 128); it += F.G) {
            const int h = it & 3, qg = it >> 2;
            __syncthreads();
#pragma unroll
            for (int t = 0; t < 8; ++t) { const int c = t * 512 + F.tid, row = c >> 4, ch = c & 15;
                const u32x4 vv = *(const u32x4*)(KVM + (size_t)row * (2 * XAW) + XAW + h * HD + 8 * ch); *(LAS u32x4*)(F.lds + voff_b(row, ch)) = vv; }
            __syncthreads();
            xa_unit(QXA, KVM, OXA, h, qg * 8 + F.wave, F.lds, F.lane);
        }
        __syncthreads();
        SEAM(8);
    }

    if (IN(9)) {
        pg8::DenseSched Sc{(const char*)OXA, (const char*)WOT, XAW, XAW, S / 256, D / 256, F.G, (int)blockIdx.x};
        pg8::EpiResid E{H1, H2, D};
        pg8::gemm_phase<pg8::EpiResid, pg8::DenseSched, true>(F.lds, XAW, XAW, XAW, Sc, E);
        SEAM(9);
    }

    if (IN(10)) {
        for (int i = blockIdx.x * (NWAVES * 64) + F.tid; i < PROWS; i += F.G * NWAVES * 64) RSLOT[i] = -1;
        LAS unsigned char* thi = F.lds;
        LAS float* lg = (LAS float*)(lx + LX_LOG);
        LAS float* part = (LAS float*)(lx + LX_RPART);
        for (int rg = F.vcu; rg < S / 16; rg += F.G) {
            __syncthreads();
#pragma unroll
            for (int rr = 0; rr < 2; ++rr) { const int r = 2 * F.wave + rr, m = rg * 16 + r;
                const f32x4* xr = (const f32x4*)(H2 + (size_t)m * D) + F.lane; f32x4 v[8]; float s = 0.f;
#pragma unroll
                for (int j = 0; j < 8; ++j) { v[j] = xr[64 * j]; s += (v[j].x * v[j].x + v[j].y * v[j].y) + (v[j].z * v[j].z + v[j].w * v[j].w); }
                const float rstd = 1.0f / sqrtf(wave_sum(s) * (1.0f / D) + RMS_EPS);
                const f32x4* gr = (const f32x4*)moe_norm + F.lane;
#pragma unroll
                for (int j = 0; j < 8; ++j) { const f32x4 g = gr[64 * j]; const f32x4 y = v[j] * rstd * g; u32x2 w; w.x = cvt_pk_bf16(y.x, y.y); w.y = cvt_pk_bf16(y.z, y.w);
                    u32x2 l; l.x = cvt_pk_bf16(y.x - bf_lo(w.x), y.y - bf_hi(w.x)); l.y = cvt_pk_bf16(y.z - bf_lo(w.y), y.w - bf_hi(w.y));
                    const unsigned off = (unsigned)r * 4096u + ((((unsigned)F.lane >> 1) + 32u * j) ^ (unsigned)r) * 16u + (F.lane & 1) * 8u;
                    *(LAS u32x2*)(thi + off) = w; *(LAS u32x2*)(thi + 65536 + off) = l; } }
            __syncthreads();
#pragma unroll
            for (int q = 0; q < 2; ++q) { const int blk = F.tid + 512 * q, r = blk >> 6, kb32 = blk & 63; f32x16 lo, hi;
#pragma unroll
                for (int c4 = 0; c4 < 4; ++c4) { const u32x4 v = *(const LAS u32x4*)(thi + r * 4096 + ((unsigned)((4 * kb32 + c4) ^ r) * 16u));
                    const float f[8] = {bf_lo(v.x), bf_hi(v.x), bf_lo(v.y), bf_hi(v.y), bf_lo(v.z), bf_hi(v.z), bf_lo(v.w), bf_hi(v.w)};
#pragma unroll
                    for (int j = 0; j < 8; ++j) { if (c4 < 2) lo[8 * c4 + j] = f[j] * 2.0f; else hi[8 * (c4 - 2) + j] = f[j] * 2.0f; } }
                st_fp6_block(TB + (size_t)(rg * 16 + r) * D + 128 * (kb32 >> 2) + 16 * (kb32 & 3), pk32_fp6(lo, hi)); }
            { const int fr = F.lane & 15, fq = F.lane >> 4; f32x4 c0 = {0.f, 0.f, 0.f, 0.f}, c1 = {0.f, 0.f, 0.f, 0.f};
              const bf16_t* wh = WRT + (size_t)fr * D + 256 * F.wave + 8 * fq;
#pragma unroll
              for (int st = 0; st < 8; ++st) { const unsigned ch = (unsigned)(32 * F.wave + 4 * st + fq);
                  const bf16x8 ah = *(const LAS bf16x8*)(thi + fr * 4096 + ((ch ^ (unsigned)fr) * 16u)), al = *(const LAS bf16x8*)(thi + 65536 + fr * 4096 + ((ch ^ (unsigned)fr) * 16u));
                  const bf16x8 bh0 = *(const bf16x8*)(wh + 32 * st), bh1 = *(const bf16x8*)(wh + (size_t)16 * D + 32 * st), bl0 = *(const bf16x8*)(wh + (size_t)NE * D + 32 * st), bl1 = *(const bf16x8*)(wh + (size_t)(NE + 16) * D + 32 * st);
                  c0 = __builtin_amdgcn_mfma_f32_16x16x32_bf16(ah, bh0, c0, 0, 0, 0); c1 = __builtin_amdgcn_mfma_f32_16x16x32_bf16(ah, bh1, c1, 0, 0, 0);
                  c0 = __builtin_amdgcn_mfma_f32_16x16x32_bf16(ah, bl0, c0, 0, 0, 0); c1 = __builtin_amdgcn_mfma_f32_16x16x32_bf16(ah, bl1, c1, 0, 0, 0);
                  c0 = __builtin_amdgcn_mfma_f32_16x16x32_bf16(al, bh0, c0, 0, 0, 0); c1 = __builtin_amdgcn_mfma_f32_16x16x32_bf16(al, bh1, c1, 0, 0, 0); }
#pragma unroll
              for (int i = 0; i < 4; ++i) { part[(F.wave * 16 + 4 * fq + i) * 32 + fr] = c0[i]; part[(F.wave * 16 + 4 * fq + i) * 32 + 16 + fr] = c1[i]; } }
            __syncthreads();
            { const int r = F.tid >> 5, e = F.tid & 31; float a = 0.f;
#pragma unroll
              for (int w = 0; w < 8; ++w) a += part[(w * 16 + r) * 32 + e];
              lg[r * 32 + e] = a + b_router[e]; }
            __syncthreads();
            if (F.tid < 16) { const int r = F.tid, m = rg * 16 + r; float l[32];
#pragma unroll
                for (int e = 0; e < 32; ++e) l[e] = lg[r * 32 + e];
                int idx[4]; float val[4]; unsigned taken = 0u;
#pragma unroll
                for (int k = 0; k < 4; ++k) { float best = -3.4e38f; int bi = 0;
#pragma unroll
                    for (int e = 0; e < 32; ++e) { const bool ok = !((taken >> e) & 1u) && (l[e] > best); best = ok ? l[e] : best; bi = ok ? e : bi; }
                    idx[k] = bi; val[k] = best; taken |= 1u << bi; }
                const float e0 = 1.0f, e1 = expf(val[1] - val[0]), e2 = expf(val[2] - val[0]), e3 = expf(val[3] - val[0]); const float inv = 1.0f / (((e0 + e1) + e2) + e3);
                const float gk[4] = {e0 * inv, e1 * inv, e2 * inv, e3 * inv};
#pragma unroll
                for (int k = 0; k < 4; ++k) { const int pos = atomicAdd(CNT + idx[k], 1); ASGE[m * 4 + k] = idx[k]; ASGP[m * 4 + k] = pos; GATE[m * 4 + k] = gk[k]; } }
        }
        __syncthreads();
        SEAM(10);
    }

    LAS int* tab = (LAS int*)(lx + LX_TAB);
#define BUILD_TAB(NT) do { __syncthreads(); if (F.tid == 0) { int us = 0, ps = 0; for (int e = 0; e < NE; ++e) { const int c = CNT[e], nb = (c + EBLK - 1) / EBLK; tab[e] = us; tab[33 + e] = ps; tab[66 + e] = nb > 0 ? nb : 1; us += nb * (NT); ps += nb * EBLK; } tab[32] = us; tab[65] = ps; } __syncthreads(); } while (0)

    if (IN(11)) {
        BUILD_TAB(1);
        for (int s = blockIdx.x * (NWAVES * 64) + F.tid; s < NK; s += F.G * NWAVES * 64) { const int e = ASGE[s], pos = ASGP[s]; RSLOT[tab[33 + e] + pos] = s; }
        CVT_PULL(CV_UP);
        SEAM(11);
    }

    if (IN(12)) {
        BUILD_TAB(16);
        const int gc = (F.G == 256) ? GC_P12 : F.G; const int bx = (int)blockIdx.x;
        if ((bx >> 3) < (gc >> 3) || F.G != 256) {
            pg8::MoeSched Sc{(const char*)TB, (const char*)WUPT, 16, (size_t)2 * DFF * D, (size_t)128 * D, (size_t)DFF * D, tab, gc, (F.G == 256) ? (bx & 7) * (gc >> 3) + (bx >> 3) : F.vcu, true, (size_t)D};
            pg8::EpiUp E{b_up, ACT};
            LAS int* gtab = (LAS int*)(lx + LX_RPART);
            { pg8::Unit uu; for (int i = 0; i < 16 && Sc.next(i, uu); ++i) if (F.tid < 256) { const int sl = RSLOT[uu.r0 + F.tid]; gtab[i * 256 + F.tid] = (sl < 0 ? 0 : sl) >> 2; } }
            __syncthreads();
            pg8::gemm_phase_db6<pg8::EpiUp, pg8::MoeSched>(F.lds, D / 2, D / 2, D / 2, Sc, E, gtab);
            MARK_DONE(12);
        }
        CVT_BESIDE(CV_ALL, 12, gc);
        CVT_PULL(CV_ALL);
        SEAM(12);
    }

    if (IN(13)) {
        BUILD_TAB(8);
        pg8::MoeSched Sc{(const char*)ACT, (const char*)WDNT, 8, (size_t)D * DFF, (size_t)256 * DFF, (size_t)128 * DFF, tab, F.G, F.vcu, false, (size_t)DFF};
        pg8::EpiDown E{b_down, RSLOT, GATE, SLOT};
        pg8::gemm_phase<pg8::EpiDown, pg8::MoeSched, true, false, 1>(F.lds, DFF / 2, DFF / 2, DFF / 2, Sc, E);
        SEAM(13);
    }

    if (IN(14)) {
        for (int m = gw; m < S; m += NGW) {
            const f32x4* xr = (const f32x4*)(H2 + (size_t)m * D) + F.lane; f32x4 v[8]; float s = 0.f;
#pragma unroll
            for (int j = 0; j < 8; ++j) { v[j] = xr[64 * j];
#pragma unroll
                for (int k = 0; k < 4; ++k) { const int w = (int)*((const unsigned*)(SLOT + (size_t)(m * 4 + k) * D) + F.lane + 64 * j); const f32x2 lo = __builtin_amdgcn_cvt_pk_f32_fp8(w, false), hi = __builtin_amdgcn_cvt_pk_f32_fp8(w, true);
                    v[j].x += lo.x * 0.0625f; v[j].y += lo.y * 0.0625f; v[j].z += hi.x * 0.0625f; v[j].w += hi.y * 0.0625f; }
                s += (v[j].x * v[j].x + v[j].y * v[j].y) + (v[j].z * v[j].z + v[j].w * v[j].w); }
            const float rstd = 1.0f / sqrtf(wave_sum(s) * (1.0f / D) + RMS_EPS);
            const f32x4* gr = (const f32x4*)final_norm + F.lane; f32x4* o = (f32x4*)(args.out + (size_t)m * D) + F.lane;
#pragma unroll
            for (int j = 0; j < 8; ++j) o[64 * j] = v[j] * rstd * gr[64 * j];
        }
    }
#undef IN
#undef SEAM
}

extern "C" void kernel_launch(void* const* d_in, const int* in_sizes, int n_in, void* d_out, int out_size, void* d_ws, size_t ws_size, hipStream_t stream) {
    static int grid = 0;
    if (grid == 0) {
        if (n_in != 24 || out_size != S * D || ws_size < WS_END) { fprintf(stderr, "kernel_launch: unexpected shapes (n_in %d out %d ws %zu need %zu)\n", n_in, out_size, ws_size, (size_t)WS_END); grid = -1; return; }
        int dev = 0, cus = 0, per_cu = 0;
        if (hipGetDevice(&dev) != hipSuccess || hipDeviceGetAttribute(&cus, hipDeviceAttributeMultiprocessorCount, dev) != hipSuccess) { grid = -1; return; }
        if (hipFuncSetAttribute((const void*)moe_fwd, hipFuncAttributeMaxDynamicSharedMemorySize, LDS_BYTES) != hipSuccess) { fprintf(stderr, "kernel_launch: hipFuncSetAttribute failed\n"); grid = -1; return; }
        if (hipOccupancyMaxActiveBlocksPerMultiprocessor(&per_cu, (const void*)moe_fwd, NWAVES * 64, LDS_BYTES) != hipSuccess || per_cu < 1) { fprintf(stderr, "kernel_launch: occupancy query says %d\n", per_cu); per_cu = 1; }
        (void)hipGetLastError();
        grid = cus;
    }
    if (grid < 0) return;
    (void)hipMemsetAsync((char*)d_ws + WS_CTL, 0, CTL_ZERO_BYTES, stream);
    Args a{};
    for (int i = 0; i < 24; ++i) a.in[i] = (const float*)d_in[i];
    a.out = (float*)d_out; a.ws = (unsigned char*)d_ws;
#if MK_ONE_LAUNCH
    a.ph_lo = 0; a.ph_hi = NPHASE;
    hipLaunchKernelGGL(moe_fwd, dim3(grid), dim3(NWAVES * 64), LDS_BYTES, stream, a);
#else
    for (int p = 0; p < NPHASE; ++p) { a.ph_lo = p; a.ph_hi = p + 1; for (int rep = 0; rep < (((REPEAT_MASK >> p) & 1) ? 2 : 1); ++rep) hipLaunchKernelGGL(moe_fwd, dim3(grid), dim3(NWAVES * 64), LDS_BYTES, stream, a); }
#endif
}
```

```cpp
#include <hip/hip_runtime.h>
#include <cstdio>
#include <cstdint>

#ifndef MK_ONE_LAUNCH
#define MK_ONE_LAUNCH 1
#endif
#ifndef REPEAT_MASK
#define REPEAT_MASK 0
#endif
#define GC_P1 160
#define GC_P12 224

#define LAS __attribute__((address_space(3)))
#define GAS __attribute__((address_space(1)))
typedef unsigned short bf16_t;
typedef short bf16x8 __attribute__((ext_vector_type(8)));
typedef short s16x4 __attribute__((ext_vector_type(4)));
typedef float f32x4 __attribute__((ext_vector_type(4)));
typedef float f32x2 __attribute__((ext_vector_type(2)));
typedef unsigned u32x4 __attribute__((ext_vector_type(4)));
typedef unsigned u32x2 __attribute__((ext_vector_type(2)));
typedef int v8i32 __attribute__((ext_vector_type(8)));
typedef int v6i32 __attribute__((ext_vector_type(6)));
typedef unsigned u32x3 __attribute__((ext_vector_type(3)));
typedef float f32x16 __attribute__((ext_vector_type(16)));

constexpr int S = 8192, D = 2048, MEM = 256;
constexpr int SBH = 8, HD = 128, SBW = 1024, POOLW = 1024, INW = 4096, NP1 = 8192;
constexpr int XAH = 4, XAW = 512;
constexpr int NE = 32, TOPK = 4, DFF = 2048, NK = S * TOPK, EBLK = 256, MAXBLK = NK / EBLK + NE, PROWS = MAXBLK * EBLK;
constexpr float RMS_EPS = 1e-5f;

constexpr size_t MiB = 1u << 20;
constexpr size_t WS_CTL = 0, CTL_ZERO_BYTES = 1 * MiB;
constexpr size_t WS_W1T = 2 * MiB;
constexpr size_t WS_WAT = WS_W1T + 32 * MiB;
constexpr size_t WS_WBT = WS_WAT + 4 * MiB;
constexpr size_t WS_WMT = WS_WBT + 4 * MiB;
constexpr size_t WS_PLT = WS_WMT + 8 * MiB;
constexpr size_t WS_WQT = WS_PLT + 1 * MiB;
constexpr size_t WS_WKVT = WS_WQT + 2 * MiB;
constexpr size_t WS_WOT = WS_WKVT + 4 * MiB;
constexpr size_t WS_WUPT = WS_WOT + 2 * MiB;
constexpr size_t WS_WDNT = WS_WUPT + 512 * MiB;
constexpr size_t WS_U = WS_WDNT + 256 * MiB;
constexpr size_t WS_MEMN = WS_U + 32 * MiB;
constexpr size_t WS_PG = WS_MEMN + 1 * MiB;
constexpr size_t WS_OA = WS_PG + 128 * MiB;
constexpr size_t WS_PO = WS_OA + 16 * MiB;
constexpr size_t WS_OB = WS_PO + 16 * MiB;
constexpr size_t WS_TMP = WS_OB + 16 * MiB;
constexpr size_t WS_MG = WS_TMP + 64 * MiB;
constexpr size_t WS_H1 = WS_MG + 32 * MiB;
constexpr size_t WS_U2 = WS_H1 + 64 * MiB;
constexpr size_t WS_QXA = WS_U2 + 32 * MiB;
constexpr size_t WS_KVM = WS_QXA + 8 * MiB;
constexpr size_t WS_OXA = WS_KVM + 1 * MiB;
constexpr size_t WS_H2 = WS_OXA + 8 * MiB;
constexpr size_t WS_TB = WS_H2 + 64 * MiB;
constexpr size_t WS_ROWS = WS_TB + 32 * MiB;
constexpr size_t WS_ACT = WS_ROWS + 160 * MiB;
constexpr size_t WS_SLOT = WS_ACT + 160 * MiB;
constexpr size_t WS_ASGE = WS_SLOT + 128 * MiB;
constexpr size_t WS_ASGP = WS_ASGE + 1 * MiB;
constexpr size_t WS_GATE = WS_ASGP + 1 * MiB;
constexpr size_t WS_RSLOT = WS_GATE + 1 * MiB;
constexpr size_t WS_WRT = WS_RSLOT + 1 * MiB;
constexpr size_t WS_END = WS_WRT + 1 * MiB;
constexpr int CW_CNT = 64;
constexpr int CW_CUR = 192;  constexpr int CW_DONE = 256;
constexpr int CW_BAR = 4096;

constexpr int RING_BYTES = 131072;
constexpr int LDS_X_OFF = RING_BYTES;
constexpr int LDS_BYTES = 163840;
constexpr int LX_BAR = 0;
constexpr int LX_TAB = 64;
constexpr int LX_CVS = 32;
constexpr int LX_SBF = 128;
constexpr int LX_LOG = 1024;
constexpr int LX_RPART = 4096;

constexpr int NWAVES = 8;

__device__ __forceinline__ unsigned cvt_pk_bf16(float lo, float hi) { unsigned r; asm volatile("v_cvt_pk_bf16_f32 %0, %1, %2" : "=v"(r) : "v"(lo), "v"(hi)); return r; }
__device__ __forceinline__ unsigned pk4_fp8(float a, float b, float c, float d) { int p = __builtin_amdgcn_cvt_pk_fp8_f32(a, b, 0, false); p = __builtin_amdgcn_cvt_pk_fp8_f32(c, d, p, true); return (unsigned)p; }
__device__ __forceinline__ v6i32 pk32_fp6(const f32x16& lo, const f32x16& hi) { return __builtin_amdgcn_cvt_scalef32_2xpk16_fp6_f32(lo, hi, 1.0f); }
__device__ __forceinline__ void st_fp6_block(unsigned char* p, const v6i32& b) { *(u32x4*)p = (u32x4){(unsigned)b[0], (unsigned)b[1], (unsigned)b[2], (unsigned)b[3]}; *(u32x4*)(p + 64) = (u32x4){(unsigned)b[4], (unsigned)b[5], 0u, 0u}; }
__device__ __forceinline__ float bf_lo(unsigned w) { return __uint_as_float(w << 16); }
__device__ __forceinline__ float bf_hi(unsigned w) { return __uint_as_float(w & 0xffff0000u); }
__device__ __forceinline__ float wave_sum(float v) {
#pragma unroll
    for (int o = 1; o < 64; o <<= 1) v += __shfl_xor(v, o);
    return v;
}
__device__ __forceinline__ float sigmoidf_fast(float x) { return __builtin_amdgcn_rcpf(1.0f + __builtin_amdgcn_exp2f(x * -1.4426950408889634f)); }

#define XB_TMO      128
#define XB_XCNT(j)  (256  + 64 * (j))
#define XB_XSUB(j)  (1280 + 64 * (j))
#define XB_XGEN(j)  (2304 + 64 * (j))
#define XB_TOP      3328
#define XB_TOPGEN   3392
#define XCD_BAR_WORDS 3456
#define XB_SPIN_CAP (1u << 18)
__device__ __forceinline__ unsigned xb_ld(unsigned* p)              { return __hip_atomic_load(p, __ATOMIC_RELAXED, __HIP_MEMORY_SCOPE_AGENT); }
__device__ __forceinline__ unsigned xb_add(unsigned* p, unsigned v) { return __hip_atomic_fetch_add(p, v, __ATOMIC_RELAXED, __HIP_MEMORY_SCOPE_AGENT); }
__device__ __forceinline__ unsigned xb_xcc_id() { return (unsigned)__builtin_amdgcn_s_getreg((3 << 11) | 20) & 0xFu; }
#define XB_SPIN(cond, bar) do { unsigned _sp = 0; while (cond) { __builtin_amdgcn_s_sleep(1); \
    if ((++_sp & 255u) == 0u) { if (xb_ld(&(bar)[XB_TMO])) break; if (_sp > XB_SPIN_CAP) { atomicAdd(&(bar)[XB_TMO], 1u); break; } } } } while (0)
struct XcdBarrier { unsigned* bar; unsigned x; volatile LAS unsigned* st; };
__device__ __forceinline__ XcdBarrier xcd_barrier_post(unsigned* bar, volatile LAS unsigned* st) {
    XcdBarrier b; b.bar = bar; b.x = xb_xcc_id(); b.st = st;
    if (threadIdx.x == 0) (void)xb_add(&bar[XB_XCNT(b.x)], 1u);
    return b;
}
__device__ __forceinline__ void xcd_barrier_complete(unsigned* bar, unsigned x, unsigned& nloc, unsigned& nx) {
    const unsigned G = gridDim.x * gridDim.y * gridDim.z;
    unsigned sum, cnt, mine, sp = 0u;
    for (;;) {
        sum = 0u; cnt = 0u; mine = 0u;
#pragma unroll
        for (unsigned j = 0; j < 16; ++j) { const unsigned c = xb_ld(&bar[XB_XCNT(j)]); sum += c; cnt += (c > 0u) ? 1u : 0u; mine = (j == x) ? c : mine; }
        if (sum == G) break;
        __builtin_amdgcn_s_sleep(1);
        if ((++sp & 255u) == 0u) { if (xb_ld(&bar[XB_TMO])) break; if (sp > XB_SPIN_CAP) { atomicAdd(&bar[XB_TMO], 1u); break; } }
    }
    nloc = mine > 0u ? mine : 1u; nx = cnt > 0u ? cnt : 1u;
}
__device__ __forceinline__ void xcd_barrier(const XcdBarrier& b) {
    asm volatile("s_waitcnt vmcnt(0)" ::: "memory");
    __syncthreads();
    if (threadIdx.x == 0) {
        unsigned* bar = b.bar;
        __builtin_amdgcn_s_waitcnt(0);
        unsigned nloc = b.st[0], nx = b.st[1];
        if (nloc == 0u) { xcd_barrier_complete(bar, b.x, nloc, nx); b.st[0] = nloc; b.st[1] = nx; }
        const unsigned old = xb_add(&bar[XB_XSUB(b.x)], 1u);
        const unsigned gen = old / nloc;
        if (old + 1u == (gen + 1u) * nloc) {
            __builtin_amdgcn_fence(__ATOMIC_RELEASE, "agent");
            asm volatile("s_waitcnt vmcnt(0)" ::: "memory");
            const unsigned og = xb_add(&bar[XB_TOP], 1u);
            const unsigned tg = og / nx;
            if (og + 1u == (tg + 1u) * nx) xb_add(&bar[XB_TOPGEN], 1u);
            else XB_SPIN(xb_ld(&bar[XB_TOPGEN]) == tg, bar);
            __builtin_amdgcn_fence(__ATOMIC_ACQUIRE, "agent");
            xb_add(&bar[XB_XGEN(b.x)], 1u);
            asm volatile("s_waitcnt vmcnt(0)" ::: "memory");
        } else {
            XB_SPIN(xb_ld(&bar[XB_XGEN(b.x)]) == gen, bar);
            __builtin_amdgcn_fence(__ATOMIC_ACQUIRE, "agent");
            asm volatile("s_waitcnt vmcnt(0)" ::: "memory");
        }
    }
    __syncthreads();
}

namespace pg8 {
constexpr int BM = 256, BK = 64, HALF = 128, HTB = HALF * BK * 2, STAGE_BYTES = 8 * HTB, NXCD = 8, WGM = 8;
__host__ __device__ __forceinline__ int lds_byte(int r, int c) { const int st = (r >> 4) * 2 + (c >> 5), rr = r & 15, cc = c & 31, ob = rr * 64 + cc * 2; return st * 1024 + (ob ^ (((ob >> 9) & 1) << 5)); }
__host__ __device__ __forceinline__ void stage_rc(int b, int& R, int& C) { const int st = b / 1024, sb = b % 1024, swz = sb ^ (((sb >> 9) & 1) << 5); R = (st >> 1) * 16 + swz / 64; C = (st & 1) * 32 + (swz % 64) / 2; }
__host__ __device__ __forceinline__ int perm32(int rho) { const int n = rho >> 4, i = rho & 15; return 8 * (i >> 2) + 4 * n + (i & 3); }

struct Unit { const char* A; const char* B0; const char* B1; int r0, c0, x; };

__device__ __forceinline__ void tile_of(int L, int nM, int nN, int& pm, int& pn) {
    const int nwg = nM * nN; int wgid = L;
    { const int q = nwg / NXCD, r = nwg % NXCD, xcd = wgid % NXCD, off = wgid / NXCD; wgid = (xcd < r ? xcd * (q + 1) : r * (q + 1) + (xcd - r) * q) + off; }
    const int nig = WGM * nN, gid = wgid / nig, fm = gid * WGM, gsz = (nM - fm) < WGM ? (nM - fm) : WGM;
    pm = fm + ((wgid % nig) % gsz); pn = (wgid % nig) / gsz;
}
struct DenseSched {
    const char* A; const char* B; int lda, ldb, nM, nN, G, c;
    __device__ __forceinline__ bool next(int i, Unit& u) const {
        const long L = (long)i * G + c; if (L >= (long)nM * nN) return false;
        int pm, pn; tile_of((int)L, nM, nN, pm, pn);
        u.A = A + (size_t)pm * BM * lda * 2; u.B0 = B + (size_t)pn * BM * ldb * 2; u.B1 = u.B0 + (size_t)HALF * ldb * 2; u.r0 = pm * BM; u.c0 = pn * BM; u.x = 0; return true;
    }
};
struct BranchSched {
    const char* A0; const char* A1; const char* B0; const char* B1; int lda, ldb, nM, nN, G, c;
    __device__ __forceinline__ bool next(int i, Unit& u) const {
        const long L = (long)(i >> 1) * G + c; if (L >= (long)nM * nN) return false;
        int pm, pn; tile_of((int)L, nM, nN, pm, pn); const int br = i & 1;
        u.A = (br ? A1 : A0) + (size_t)pm * BM * lda * 2; u.B0 = (br ? B1 : B0) + (size_t)pn * BM * ldb * 2; u.B1 = u.B0 + (size_t)HALF * ldb * 2; u.r0 = pm * BM; u.c0 = pn * BM; u.x = br; return true;
    }
};
struct PoolSched {
    const char* A; const char* B; int G, c;
    __device__ __forceinline__ bool next(int i, Unit& u) const {
        const int L = i * G + c; if (L >= (S / BM) * 4) return false;
        const int pm = L >> 2, g = L & 3;
        u.A = A + ((size_t)pm * BM * POOLW + g * 256) * 2; u.B0 = B + (size_t)g * 256 * 256 * 2; u.B1 = u.B0 + (size_t)HALF * 256 * 2; u.r0 = pm * BM; u.c0 = g * 256; u.x = g; return true;
    }
};
struct MoeSched {
    const char* A; const char* B; int NT; size_t estride; size_t tstride; size_t hoff; const LAS int* tab; int G, c; bool gather; size_t arow;
    __device__ __forceinline__ int tu(int i) const { return __builtin_amdgcn_readfirstlane(tab[i]); }
    __device__ __forceinline__ bool next(int i, Unit& u) const {
        const int L = i * G + c; if (L >= tu(32)) return false;
        int e = 0;
#pragma unroll
        for (int s = 16; s >= 1; s >>= 1) { if (tu(e + s) <= L) e += s; }
        const int r = L - tu(e), nb = tu(66 + e), nt = r / nb, blk = r - nt * nb, prow = tu(33 + e) + blk * EBLK;
        u.A = gather ? A : A + (size_t)prow * arow; u.B0 = B + (size_t)e * estride + (size_t)nt * tstride; u.B1 = u.B0 + hoff; u.r0 = prow; u.c0 = nt; u.x = e; return true;
    }
};

template <class Epi, class Sched, bool ALIGN_EPI, bool GATHER = false, int PREC = 0>
__device__ __forceinline__ void gemm_phase(LAS unsigned char* lds, const int K, const int lda, const int ldb, const Sched& S, const Epi& E, const LAS int* gtab = nullptr) {
    const int tid = threadIdx.x, wid = __builtin_amdgcn_readfirstlane(tid >> 6), lane = tid & 63, wr = wid >> 2, wc = wid & 3, fr = lane & 15, fq = lane >> 4;
    const int nt = K / BK;
    unsigned voffB[2], vc[2][2], vn[2][2]; int RA[2], CA[2];
#pragma unroll
    for (int i = 0; i < 2; ++i) { int R, C; stage_rc(tid * 16 + i * 8192, R, C); const int Rb = Epi::PERM ? ((R & ~31) + perm32(R & 31)) : R; RA[i] = R; CA[i] = C;
        voffB[i] = (unsigned)(Rb * ldb + C) * 2u; }
#define PG8_AOFF(dst, ord) do { _Pragma("unroll") for (int _h = 0; _h < 2; ++_h) _Pragma("unroll") for (int _i = 0; _i < 2; ++_i) \
        dst[_h][_i] = GATHER ? ((unsigned)gtab[(ord) * 256 + _h * HALF + RA[_i]] * (unsigned)lda + (unsigned)CA[_i]) * 2u : (unsigned)((_h * HALF + RA[_i]) * lda + CA[_i]) * 2u; } while (0)
    const size_t kstep = (size_t)(BK * 2);
    const unsigned ldsw = (unsigned)wid * 1024u;
    const int aoff = lds_byte(wr * 64 + fr, fq * 8), boff = lds_byte(wc * 32 + fr, fq * 8);
#define PG8_SA(b, h) (((b) * 2 + (h)) * HTB)
#define PG8_SB(b, h) ((4 + (b) * 2 + (h)) * HTB)
#define PG8_STAGE(bufoff, gbase, voff) do { _Pragma("unroll") for (int _i = 0; _i < 2; ++_i) \
        __builtin_amdgcn_global_load_lds((const unsigned*)((const char*)(gbase) + (voff)[_i]), (LAS unsigned*)(lds + (bufoff) + ldsw + _i * 8192), 16, 0, 0); } while (0)
#define PG8_LD6(off) __builtin_bit_cast(v6i32, __builtin_shufflevector(*(const LAS u32x4*)(lds + (off)), __builtin_shufflevector(*(const LAS u32x2*)(lds + (off) + 1024), *(const LAS u32x2*)(lds + (off) + 1024), 0, 1, -1, -1), 0, 1, 2, 3, 4, 5))
#define PG8_LD8(off) __builtin_bit_cast(v8i32, __builtin_shufflevector(*(const LAS u32x4*)(lds + (off)), *(const LAS u32x4*)(lds + (off) + 1024), 0, 1, 2, 3, 4, 5, 6, 7))
#define PG8_LDA(dst, b, h) do { if (PREC == 2) { _Pragma("unroll") for (int m = 0; m < 4; ++m) dst##6[m] = PG8_LD6(PG8_SA(b, h) + aoff + m * 2048); } \
      else if (PREC == 1) { _Pragma("unroll") for (int m = 0; m < 4; ++m) dst##8[m] = PG8_LD8(PG8_SA(b, h) + aoff + m * 2048); } \
      else { _Pragma("unroll") for (int m = 0; m < 4; ++m) _Pragma("unroll") for (int k = 0; k < 2; ++k) dst[m][k] = *(const LAS bf16x8*)(lds + PG8_SA(b, h) + aoff + m * 2048 + k * 1024); } } while (0)
#define PG8_LDB(dst, b, h) do { if (PREC == 2) { _Pragma("unroll") for (int n = 0; n < 2; ++n) dst##6[n] = PG8_LD6(PG8_SB(b, h) + boff + n * 2048); } \
      else if (PREC == 1) { _Pragma("unroll") for (int n = 0; n < 2; ++n) dst##8[n] = PG8_LD8(PG8_SB(b, h) + boff + n * 2048); } \
      else { _Pragma("unroll") for (int n = 0; n < 2; ++n) _Pragma("unroll") for (int k = 0; k < 2; ++k) dst[n][k] = *(const LAS bf16x8*)(lds + PG8_SB(b, h) + boff + n * 2048 + k * 1024); } } while (0)
#define PG8_MMA(ai, bj, At, Bt) do { __builtin_amdgcn_s_setprio(1); if (PREC == 2) { _Pragma("unroll") for (int m = 0; m < 4; ++m) _Pragma("unroll") for (int n = 0; n < 2; ++n) \
        asm volatile("v_mfma_scale_f32_16x16x128_f8f6f4 %0, %1, %2, %0, %3, %4 op_sel_hi:[0,0,0] cbsz:2 blgp:2" : "+v"(acc[ai][bj][m][n]) : "v"(Bt##6[n]), "v"(At##6[m]), "v"(sc_w), "v"(sc_a)); } \
      else if (PREC == 1) { _Pragma("unroll") for (int m = 0; m < 4; ++m) _Pragma("unroll") for (int n = 0; n < 2; ++n) \
        asm volatile("v_mfma_scale_f32_16x16x128_f8f6f4 %0, %1, %2, %0, %3, %4 op_sel_hi:[0,0,0]" : "+v"(acc[ai][bj][m][n]) : "v"(Bt##8[n]), "v"(At##8[m]), "v"(sc_w), "v"(sc_a)); } \
      else { _Pragma("unroll") for (int m = 0; m < 4; ++m) _Pragma("unroll") for (int n = 0; n < 2; ++n) _Pragma("unroll") for (int k = 0; k < 2; ++k) \
        acc[ai][bj][m][n] = __builtin_amdgcn_mfma_f32_16x16x32_bf16(Bt[n][k], At[m][k], acc[ai][bj][m][n], 0, 0, 0); } __builtin_amdgcn_s_setprio(0); } while (0)
#define PG8_WAIT_V(n) asm volatile("s_waitcnt vmcnt(" #n ")" ::: "memory")
#define PG8_WAIT_L(n) asm volatile("s_waitcnt lgkmcnt(" #n ")" ::: "memory")
#define PG8_BAR __builtin_amdgcn_s_barrier()
#define PG8_SCHED __builtin_amdgcn_sched_barrier(0)
    Unit cur, nxt; int ui = 0;
    if (!S.next(0, cur)) return;
    f32x4 acc[2][2][4][2];
#pragma unroll
    for (int a = 0; a < 2; ++a)
#pragma unroll
        for (int b = 0; b < 2; ++b)
#pragma unroll
            for (int m = 0; m < 4; ++m)
#pragma unroll
                for (int n = 0; n < 2; ++n) acc[a][b][m][n] = (f32x4){0.f, 0.f, 0.f, 0.f};
    bf16x8 At[4][2], B0[2][2], B1[2][2]; v8i32 At8[4], B08[2], B18[2]; v6i32 At6[4], B06[2], B16[2];
    const int sc_w = 121, sc_a = (PREC == 2) ? 126 : 127;
    PG8_AOFF(vc, 0);
#pragma unroll
    for (int _h = 0; _h < 2; ++_h) { vn[_h][0] = vc[_h][0]; vn[_h][1] = vc[_h][1]; }
    PG8_STAGE(PG8_SB(0, 0), cur.B0, voffB); PG8_STAGE(PG8_SB(0, 1), cur.B1, voffB); PG8_STAGE(PG8_SA(0, 0), cur.A, vc[0]); PG8_STAGE(PG8_SA(0, 1), cur.A, vc[1]);
    if (wr == 1) PG8_BAR;
    PG8_WAIT_V(2); PG8_BAR;
    PG8_STAGE(PG8_SB(1, 0), cur.B0 + kstep, voffB); PG8_STAGE(PG8_SA(1, 0), cur.A + kstep, vc[0]); PG8_STAGE(PG8_SB(1, 1), cur.B1 + kstep, voffB);
    PG8_WAIT_V(6); PG8_BAR;
    for (;;) {
        const bool has_next = S.next(ui + 1, nxt);
        if (GATHER && has_next) PG8_AOFF(vn, ui + 1);
        const char* nA = has_next ? nxt.A : cur.A; const char* nB0 = has_next ? nxt.B0 : cur.B0; const char* nB1 = has_next ? nxt.B1 : cur.B1;
#pragma nounroll
        for (int t = 0; t < nt; t += 2) {
            const bool last = (t == nt - 2);
            const char* a1 = cur.A + (size_t)(t + 1) * kstep;
            const char* a2 = last ? nA : cur.A + (size_t)(t + 2) * kstep;
            const char* b20 = last ? nB0 : cur.B0 + (size_t)(t + 2) * kstep; const char* b21 = last ? nB1 : cur.B1 + (size_t)(t + 2) * kstep;
            const char* a3 = a2 + kstep; const char* b30 = b20 + kstep; const char* b31 = b21 + kstep;
            unsigned v2[2][2];
#pragma unroll
            for (int _h = 0; _h < 2; ++_h) { v2[_h][0] = (GATHER && last) ? vn[_h][0] : vc[_h][0]; v2[_h][1] = (GATHER && last) ? vn[_h][1] : vc[_h][1]; }
            PG8_LDB(B0, 0, 0); PG8_LDB(B1, 0, 1); PG8_SCHED; PG8_LDA(At, 0, 0); PG8_STAGE(PG8_SA(1, 1), a1, vc[1]);
            PG8_WAIT_V(8); PG8_WAIT_L(0); PG8_BAR; PG8_MMA(0, 0, At, B0); PG8_MMA(0, 1, At, B1); PG8_BAR; PG8_SCHED;
            PG8_LDA(At, 0, 1); PG8_STAGE(PG8_SB(0, 0), b20, voffB); PG8_STAGE(PG8_SB(0, 1), b21, voffB); PG8_STAGE(PG8_SA(0, 0), a2, v2[0]);
            PG8_WAIT_V(8); PG8_WAIT_L(0); PG8_BAR; PG8_MMA(1, 0, At, B0); PG8_MMA(1, 1, At, B1); PG8_BAR; PG8_SCHED;
            PG8_LDB(B0, 1, 0); PG8_LDB(B1, 1, 1); PG8_SCHED; PG8_LDA(At, 1, 0); PG8_STAGE(PG8_SA(0, 1), a2, v2[1]);
            PG8_WAIT_V(8); PG8_WAIT_L(0); PG8_BAR; PG8_MMA(0, 0, At, B0); PG8_MMA(0, 1, At, B1); PG8_BAR; PG8_SCHED;
            PG8_LDA(At, 1, 1); PG8_STAGE(PG8_SB(1, 0), b30, voffB); PG8_STAGE(PG8_SB(1, 1), b31, voffB); PG8_STAGE(PG8_SA(1, 0), a3, v2[0]);
            PG8_WAIT_V(8); PG8_WAIT_L(0); PG8_BAR; PG8_MMA(1, 0, At, B0); PG8_MMA(1, 1, At, B1); PG8_BAR; PG8_SCHED;
        }
        if constexpr (ALIGN_EPI) { if (wr == 0) PG8_BAR; }
        if (PREC != 0) asm volatile("s_nop 15\n\ts_nop 15\n\ts_nop 15\n\ts_nop 15" ::: "memory");
        E(acc, cur, wr, wc, fr, fq);
        if (!has_next) break;
        bool kp = false; if constexpr (Epi::KEEPS) kp = E.keep(cur);
        if (!kp) {
#pragma unroll
        for (int a = 0; a < 2; ++a)
#pragma unroll
            for (int b = 0; b < 2; ++b)
#pragma unroll
                for (int m = 0; m < 4; ++m)
#pragma unroll
                    for (int n = 0; n < 2; ++n) acc[a][b][m][n] = (f32x4){0.f, 0.f, 0.f, 0.f}; }
        cur = nxt; ++ui;
        if (GATHER) {
#pragma unroll
            for (int _h = 0; _h < 2; ++_h) { vc[_h][0] = vn[_h][0]; vc[_h][1] = vn[_h][1]; } }
        if constexpr (ALIGN_EPI) { if (wr == 1) PG8_BAR; }
    }
    PG8_WAIT_V(0);
    if constexpr (!ALIGN_EPI) { if (wr == 0) PG8_BAR; }
    PG8_BAR;
#undef PG8_AOFF
#undef PG8_SA
#undef PG8_SB
#undef PG8_STAGE
#undef PG8_LDA
#undef PG8_LDB
#undef PG8_MMA
#undef PG8_LD8
#undef PG8_LD6
#undef PG8_WAIT_V
#undef PG8_WAIT_L
#undef PG8_BAR
#undef PG8_SCHED
}

template <int OFF>
__device__ __forceinline__ v6i32 ld6x(unsigned addr) {
    u32x4 lo; u32x2 hi;
    asm volatile("ds_read_b128 %0, %1 offset:%2" : "=v"(lo) : "v"(addr), "n"(OFF));
    asm volatile("ds_read_b64 %0, %1 offset:%2" : "=v"(hi) : "v"(addr), "n"(OFF + 1024));
    return (v6i32){(int)lo[0], (int)lo[1], (int)lo[2], (int)lo[3], (int)hi[0], (int)hi[1]};
}
template <class Epi, class Sched>
__device__ __forceinline__ void gemm_phase_db6(LAS unsigned char* lds, const int K, const int lda, const int ldb, const Sched& S, const Epi& E, const LAS int* gtab) {
    const int tid = threadIdx.x, wid = __builtin_amdgcn_readfirstlane(tid >> 6), lane = tid & 63, wr = wid >> 2, wc = wid & 3, fr = lane & 15, fq = lane >> 4;
    const int nt = K / BK;
    unsigned voffB0, vc[2][2]; const size_t bstep = (size_t)64 * ldb * 2;
    { int R, C; stage_rc(tid * 16, R, C); const int Rb = Epi::PERM ? ((R & ~31) + perm32(R & 31)) : R; voffB0 = (unsigned)(Rb * ldb + C) * 2u; }
#define DB_AOFF(dst, ord) do { _Pragma("unroll") for (int _i = 0; _i < 2; ++_i) { int _R, _C; stage_rc((int)threadIdx.x * 16 + _i * 8192, _R, _C); _Pragma("unroll") for (int _h = 0; _h < 2; ++_h) \
        dst[_h][_i] = ((unsigned)gtab[(ord) * 256 + _h * HALF + _R] * (unsigned)lda + (unsigned)_C) * 2u; } } while (0)
    const size_t kstep = (size_t)(BK * 2);
    const unsigned ldsw = (unsigned)wid * 1024u;
    const int aoff = lds_byte(wr * 64 + fr, fq * 8), boff = lds_byte(wc * 32 + fr, fq * 8);
    const unsigned aA = (unsigned)(size_t)(lds + aoff), aB = (unsigned)(size_t)(lds + 4 * HTB + boff);
#define DB_SA(b, h) (((b) * 2 + (h)) * HTB)
#define DB_SB(b, h) ((4 + (b) * 2 + (h)) * HTB)
#define DB_STAGEA1(bufoff, gbase, voff, i) __builtin_amdgcn_global_load_lds((const unsigned*)((const char*)(gbase) + (voff)[i]), (LAS unsigned*)(lds + (bufoff) + ldsw + (i) * 8192), 16, 0, 0)
#define DB_STAGEB1(bufoff, gbase, i) __builtin_amdgcn_global_load_lds((const unsigned*)((const char*)(gbase) + (size_t)(i) * bstep + voffB0), (LAS unsigned*)(lds + (bufoff) + ldsw + (i) * 8192), 16, 0, 0)
#define DB_STAGEA(bufoff, gbase, voff) do { DB_STAGEA1(bufoff, gbase, voff, 0); DB_STAGEA1(bufoff, gbase, voff, 1); } while (0)
#define DB_STAGEB(bufoff, gbase) do { DB_STAGEB1(bufoff, gbase, 0); DB_STAGEB1(bufoff, gbase, 1); } while (0)
#define DB_LDA(dst, b, h) do { dst[0] = ld6x<DB_SA(b, h)>(aA); dst[1] = ld6x<DB_SA(b, h) + 2048>(aA); dst[2] = ld6x<DB_SA(b, h) + 4096>(aA); dst[3] = ld6x<DB_SA(b, h) + 6144>(aA); } while (0)
#define DB_LDB(dst, b, h) do { dst[0] = ld6x<((b) * 2 + (h)) * HTB>(aB); dst[1] = ld6x<((b) * 2 + (h)) * HTB + 2048>(aB); } while (0)
#define DB_MMA(ai, bj, At, Bt) do { __builtin_amdgcn_s_setprio(1); _Pragma("unroll") for (int m = 0; m < 4; ++m) _Pragma("unroll") for (int n = 0; n < 2; ++n) \
        asm volatile("v_mfma_scale_f32_16x16x128_f8f6f4 %0, %1, %2, %0, %3, %4 op_sel_hi:[0,0,0] cbsz:2 blgp:2" : "+v"(acc[ai][bj][m][n]) : "v"(Bt[n]), "v"(At[m]), "v"(sc_w), "v"(sc_a)); __builtin_amdgcn_s_setprio(0); } while (0)
#define DB_MMA4(ai, bj, mlo, At, Bt) do { _Pragma("unroll") for (int m = (mlo); m < (mlo) + 2; ++m) _Pragma("unroll") for (int n = 0; n < 2; ++n) \
        asm volatile("v_mfma_scale_f32_16x16x128_f8f6f4 %0, %1, %2, %0, %3, %4 op_sel_hi:[0,0,0] cbsz:2 blgp:2" : "+v"(acc[ai][bj][m][n]) : "v"(Bt[n]), "v"(At[m]), "v"(sc_w), "v"(sc_a)); } while (0)
#define DB_SYNC() do { asm volatile("s_waitcnt vmcnt(8) lgkmcnt(0)" ::: "memory"); __builtin_amdgcn_s_barrier(); } while (0)
#define DB_SYNC6() do { asm volatile("s_waitcnt vmcnt(6) lgkmcnt(0)" ::: "memory"); __builtin_amdgcn_s_barrier(); } while (0)
#define DB_STEP(ai, At, sb, sa, gb, ga, vo) do { \
        DB_STAGEB1(sb, gb, 0); DB_SCHED; DB_MMA4(ai, 0, 0, At, B0); DB_SCHED; DB_STAGEB1(sb, gb, 1); DB_SCHED; DB_MMA4(ai, 0, 2, At, B0); DB_SCHED; \
        DB_STAGEA1(sa, ga, vo, 0); DB_SCHED; DB_MMA4(ai, 1, 0, At, B1); DB_SCHED; DB_STAGEA1(sa, ga, vo, 1); DB_SCHED; DB_MMA4(ai, 1, 2, At, B1); DB_SCHED; } while (0)
#define DB_SCHED __builtin_amdgcn_sched_barrier(0)
    Unit cur, nxt; int ui = 0;
    if (!S.next(0, cur)) return;
    f32x4 acc[2][2][4][2]; typename Epi::Pre pre;
    E.prefetch(pre, cur, wc, fq); E.init(acc, pre);
    v6i32 A0[4], A1[4], B0[2], B1[2];
    const int sc_w = 121, sc_a = 126;
    if (wid >= 4) __builtin_amdgcn_s_setprio(1);
    DB_AOFF(vc, 0);
    DB_STAGEB(DB_SB(0, 0), cur.B0); DB_STAGEA(DB_SA(0, 0), cur.A, vc[0]); DB_STAGEB(DB_SB(0, 1), cur.B1); DB_STAGEA(DB_SA(0, 1), cur.A, vc[1]);
    DB_STAGEB(DB_SB(1, 0), cur.B0 + kstep); DB_STAGEA(DB_SA(1, 0), cur.A + kstep, vc[0]); DB_STAGEB(DB_SB(1, 1), cur.B1 + kstep); DB_STAGEA(DB_SA(1, 1), cur.A + kstep, vc[1]);
    DB_SYNC();
    DB_LDB(B0, 0, 0); DB_LDB(B1, 0, 1); DB_LDA(A0, 0, 0); DB_SCHED;
    for (;;) {
        const bool has_next = S.next(ui + 1, nxt);
        const char* nA = has_next ? nxt.A : cur.A; const char* nB0 = has_next ? nxt.B0 : cur.B0; const char* nB1 = has_next ? nxt.B1 : cur.B1;
#pragma nounroll
        for (int t = 0; t < nt; t += 2) {
            const bool last = (t == nt - 2);
            const char* a2 = last ? nA : cur.A + (size_t)(t + 2) * kstep;
            const char* b20 = last ? nB0 : cur.B0 + (size_t)(t + 2) * kstep; const char* b21 = last ? nB1 : cur.B1 + (size_t)(t + 2) * kstep;
            const char* a3 = a2 + kstep; const char* b30 = b20 + kstep; const char* b31 = b21 + kstep;
            if (last && has_next) DB_AOFF(vc, ui + 1);
            DB_SYNC(); DB_LDA(A1, 0, 1); DB_SCHED; DB_STEP(0, A0, DB_SB(0, 0), DB_SA(0, 0), b20, a2, vc[0]);
            DB_SYNC6(); DB_LDA(A0, 1, 0); DB_SCHED; DB_STEP(1, A1, DB_SB(0, 1), DB_SA(0, 1), b21, a2, vc[1]); DB_LDB(B0, 1, 0); DB_LDB(B1, 1, 1); DB_SCHED;
            DB_SYNC(); DB_LDA(A1, 1, 1); DB_SCHED; DB_STEP(0, A0, DB_SB(1, 0), DB_SA(1, 0), b30, a3, vc[0]);
            DB_SYNC6(); if (!last) DB_LDA(A0, 0, 0); DB_SCHED; DB_STEP(1, A1, DB_SB(1, 1), DB_SA(1, 1), b31, a3, vc[1]); if (!last) { DB_LDB(B0, 0, 0); DB_LDB(B1, 0, 1); } DB_SCHED;
        }
        asm volatile("s_nop 15\n\ts_nop 15\n\ts_nop 15\n\ts_nop 15" ::: "memory");
        { const unsigned _l = (unsigned)__builtin_amdgcn_mbcnt_hi(~0u, __builtin_amdgcn_mbcnt_lo(~0u, 0u)); if (has_next) E.prefetch(pre, nxt, wc, (int)(_l >> 4)); E(acc, cur, wr, wc, (int)(_l & 15u), (int)(_l >> 4)); }
        if (!has_next) break;
        E.init(acc, pre);
        cur = nxt; ++ui;
        DB_LDB(B0, 0, 0); DB_LDB(B1, 0, 1); DB_LDA(A0, 0, 0); DB_SCHED;
    }
    asm volatile("s_waitcnt vmcnt(0) lgkmcnt(0)" ::: "memory");
    __builtin_amdgcn_s_setprio(0);
    __builtin_amdgcn_s_barrier();
#undef DB_AOFF
#undef DB_SA
#undef DB_SB
#undef DB_STAGEA
#undef DB_STAGEB
#undef DB_LDA
#undef DB_LDB
#undef DB_MMA
#undef DB_SYNC
#undef DB_SYNC6
#undef DB_STEP
#undef DB_MMA4
#undef DB_STAGEA1
#undef DB_STAGEB1
#undef DB_SCHED
}

typedef f32x4 Acc[2][2][4][2];

struct EpiProj {
    static constexpr bool PERM = true, KEEPS = false;
    bf16_t* O; const float* bgate;
    __device__ __forceinline__ void operator()(Acc& acc, const Unit& u, int wr, int wc, int fr, int fq) const {
        const int row0 = u.r0 + wr * 64 + fr, col0 = u.c0 + wc * 32 + 8 * fq; const bool gate = u.c0 >= INW;
        f32x4 bv[2][2];
#pragma unroll
        for (int bj = 0; bj < 2; ++bj)
#pragma unroll
            for (int n = 0; n < 2; ++n) bv[bj][n] = gate ? *(const f32x4*)(bgate + (col0 - INW) + bj * HALF + 4 * n) : (f32x4){0.f, 0.f, 0.f, 0.f};
#pragma unroll
        for (int ai = 0; ai < 2; ++ai)
#pragma unroll
            for (int m = 0; m < 4; ++m) { bf16_t* rowp = O + (size_t)(row0 + ai * HALF + m * 16) * NP1 + col0;
#pragma unroll
                for (int bj = 0; bj < 2; ++bj) { f32x4 v0 = acc[ai][bj][m][0] + bv[bj][0], v1 = acc[ai][bj][m][1] + bv[bj][1];
                    if (gate) {
#pragma unroll
                        for (int j = 0; j < 4; ++j) { v0[j] = sigmoidf_fast(v0[j]); v1[j] = sigmoidf_fast(v1[j]); } }
                    u32x4 w; w.x = cvt_pk_bf16(v0[0], v0[1]); w.y = cvt_pk_bf16(v0[2], v0[3]); w.z = cvt_pk_bf16(v1[0], v1[1]); w.w = cvt_pk_bf16(v1[2], v1[3]);
                    *(u32x4*)(rowp + bj * HALF) = w; } }
    }
};
struct EpiBf16 {
    static constexpr bool PERM = true, KEEPS = false;
    bf16_t* O; int ldc; const float* cscale;
    __device__ __forceinline__ void operator()(Acc& acc, const Unit& u, int wr, int wc, int fr, int fq) const {
        const int row0 = u.r0 + wr * 64 + fr, col0 = u.c0 + wc * 32 + 8 * fq;
#pragma unroll
        for (int bj = 0; bj < 2; ++bj) {
            const f32x4 s0 = cscale ? *(const f32x4*)(cscale + col0 + bj * HALF) : (f32x4){1.f, 1.f, 1.f, 1.f}, s1 = cscale ? *(const f32x4*)(cscale + col0 + bj * HALF + 4) : (f32x4){1.f, 1.f, 1.f, 1.f};
#pragma unroll
            for (int ai = 0; ai < 2; ++ai)
#pragma unroll
                for (int m = 0; m < 4; ++m) { bf16_t* rowp = O + (size_t)(row0 + ai * HALF + m * 16) * ldc + col0;
                    const f32x4 v0 = acc[ai][bj][m][0] * s0, v1 = acc[ai][bj][m][1] * s1;
                    u32x4 w; w.x = cvt_pk_bf16(v0[0], v0[1]); w.y = cvt_pk_bf16(v0[2], v0[3]); w.z = cvt_pk_bf16(v1[0], v1[1]); w.w = cvt_pk_bf16(v1[2], v1[3]);
                    *(u32x4*)(rowp + bj * HALF) = w; } }
    }
};
struct EpiBranch {
    static constexpr bool PERM = true, KEEPS = true;
    const bf16_t* PG; bf16_t* MG;
    __device__ __forceinline__ bool keep(const Unit& u) const { return u.x == 0; }
    __device__ __forceinline__ void operator()(Acc& acc, const Unit& u, int wr, int wc, int fr, int fq) const {
        const int row0 = u.r0 + wr * 64 + fr, col0 = u.c0 + wc * 32 + 8 * fq; const int br = u.x;
#pragma unroll
        for (int ai = 0; ai < 2; ++ai)
#pragma unroll
            for (int m = 0; m < 4; ++m) { const size_t row = (size_t)(row0 + ai * HALF + m * 16);
#pragma unroll
                for (int bj = 0; bj < 2; ++bj) { const int col = col0 + bj * HALF;
                    const u32x4 gb = *(const u32x4*)(PG + row * NP1 + INW + D + col);
                    f32x4 h0 = {bf_lo(gb.x), bf_hi(gb.x), bf_lo(gb.y), bf_hi(gb.y)}, h1 = {bf_lo(gb.z), bf_hi(gb.z), bf_lo(gb.w), bf_hi(gb.w)};
#pragma unroll
                    for (int j = 0; j < 4; ++j) { h0[j] = fmaxf(h0[j], 1e-30f); h1[j] = fmaxf(h1[j], 1e-30f); }
                    if (br == 0) { const u32x4 ga = *(const u32x4*)(PG + row * NP1 + INW + col);
                        const f32x4 a0 = {bf_lo(ga.x), bf_hi(ga.x), bf_lo(ga.y), bf_hi(ga.y)}, a1 = {bf_lo(ga.z), bf_hi(ga.z), bf_lo(ga.w), bf_hi(ga.w)};
#pragma unroll
                        for (int j = 0; j < 4; ++j) { acc[ai][bj][m][0][j] *= a0[j] * __builtin_amdgcn_rcpf(h0[j]); acc[ai][bj][m][1][j] *= a1[j] * __builtin_amdgcn_rcpf(h1[j]); } }
                    else { const f32x4 v0 = acc[ai][bj][m][0] * h0, v1 = acc[ai][bj][m][1] * h1;
                        u32x4 w; w.x = cvt_pk_bf16(v0[0], v0[1]); w.y = cvt_pk_bf16(v0[2], v0[3]); w.z = cvt_pk_bf16(v1[0], v1[1]); w.w = cvt_pk_bf16(v1[2], v1[3]);
                        *(u32x4*)(MG + row * D + col) = w; } } }
    }
};
struct EpiResid {
    static constexpr bool PERM = false, KEEPS = false;
    const float* res; float* out; int ldc;
    __device__ __forceinline__ void operator()(Acc& acc, const Unit& u, int wr, int wc, int fr, int fq) const {
        const int row0 = u.r0 + wr * 64 + fr, col0 = u.c0 + wc * 32 + 4 * fq;
#pragma unroll
        for (int ai = 0; ai < 2; ++ai) {
            f32x4 r[4][2][2];
#pragma unroll
            for (int m = 0; m < 4; ++m) { const size_t off = (size_t)(row0 + ai * HALF + m * 16) * ldc + col0;
#pragma unroll
                for (int bj = 0; bj < 2; ++bj)
#pragma unroll
                    for (int n = 0; n < 2; ++n) r[m][bj][n] = *(const f32x4*)(res + off + bj * HALF + n * 16); }
            asm volatile("" ::: "memory");
#pragma unroll
            for (int m = 0; m < 4; ++m) { const size_t off = (size_t)(row0 + ai * HALF + m * 16) * ldc + col0;
#pragma unroll
                for (int bj = 0; bj < 2; ++bj)
#pragma unroll
                    for (int n = 0; n < 2; ++n) *(f32x4*)(out + off + bj * HALF + n * 16) = r[m][bj][n] + acc[ai][bj][m][n]; }
            asm volatile("" ::: "memory"); }
    }
};
struct EpiUp {
    static constexpr bool PERM = true, KEEPS = false;
    const float* bup; unsigned char* ACT;
    struct Pre { f32x4 bg[2], bl[2]; };
    __device__ __forceinline__ void prefetch(Pre& p, const Unit& u, int wc, int fq) const {
        const float* be = bup + (size_t)u.x * (2 * DFF) + u.c0 * HALF + wc * 32 + 8 * fq;
#pragma unroll
        for (int n = 0; n < 2; ++n) { p.bg[n] = *(const f32x4*)(be + 4 * n); p.bl[n] = *(const f32x4*)(be + DFF + 4 * n) + 1.0f; }
    }
    __device__ __forceinline__ void init(Acc& acc, const Pre& p) const {
#pragma unroll
        for (int ai = 0; ai < 2; ++ai)
#pragma unroll
            for (int m = 0; m < 4; ++m)
#pragma unroll
                for (int n = 0; n < 2; ++n) { acc[ai][0][m][n] = p.bg[n]; acc[ai][1][m][n] = p.bl[n]; }
    }
    __device__ __forceinline__ void operator()(Acc& acc, const Unit& u, int wr, int wc, int fr, int fq) const {
        const int row0 = u.r0 + wr * 64 + fr, col0 = u.c0 * HALF + wc * 32 + 8 * fq;
        typedef float f32x2v __attribute__((ext_vector_type(2)));
#pragma unroll
        for (int ai = 0; ai < 2; ++ai)
#pragma unroll
            for (int m = 0; m < 4; ++m) { unsigned char* rowp = ACT + (size_t)(row0 + ai * HALF + m * 16) * DFF + col0; f32x4 o[2];
#pragma unroll
                for (int n = 0; n < 2; ++n) { const f32x4 gv = acc[ai][0][m][n], lv = acc[ai][1][m][n];
#pragma unroll
                    for (int j = 0; j < 4; j += 2) {
                        const f32x2v g = {__builtin_amdgcn_fmed3f(gv[j], -3.0e38f, 7.0f), __builtin_amdgcn_fmed3f(gv[j + 1], -3.0e38f, 7.0f)}, l = {__builtin_amdgcn_fmed3f(lv[j], -6.0f, 8.0f), __builtin_amdgcn_fmed3f(lv[j + 1], -6.0f, 8.0f)};
                        const f32x2v t = g * -2.4554669595930156f; const f32x2v e = {__builtin_amdgcn_exp2f(t.x), __builtin_amdgcn_exp2f(t.y)}; const f32x2v d = e + 1.0f;
                        const f32x2v r = {__builtin_amdgcn_rcpf(d.x), __builtin_amdgcn_rcpf(d.y)}; const f32x2v q = (g * l) * r; o[n][j] = q.x; o[n][j + 1] = q.y; } }
                u32x2 w; w.x = pk4_fp8(o[0][0], o[0][1], o[0][2], o[0][3]); w.y = pk4_fp8(o[1][0], o[1][1], o[1][2], o[1][3]);
                *(u32x2*)rowp = w; }
    }
};
struct EpiDown {
    static constexpr bool PERM = true, KEEPS = false;
    const float* bdn; const int* rslot; const float* gate; unsigned char* SLOT;
    __device__ __forceinline__ void operator()(Acc& acc, const Unit& u, int wr, int wc, int fr, int fq) const {
        const int row0 = u.r0 + wr * 64 + fr, col0 = u.c0 * BM + wc * 32 + 8 * fq; const float* be = bdn + (size_t)u.x * D;
        int sl[2][4]; float gt[2][4];
#pragma unroll
        for (int ai = 0; ai < 2; ++ai)
#pragma unroll
            for (int m = 0; m < 4; ++m) sl[ai][m] = rslot[row0 + ai * HALF + m * 16];
#pragma unroll
        for (int ai = 0; ai < 2; ++ai)
#pragma unroll
            for (int m = 0; m < 4; ++m) gt[ai][m] = gate[sl[ai][m] < 0 ? 0 : sl[ai][m]] * 16.0f;
        f32x4 bv[2][2];
#pragma unroll
        for (int bj = 0; bj < 2; ++bj)
#pragma unroll
            for (int n = 0; n < 2; ++n) bv[bj][n] = *(const f32x4*)(be + col0 + bj * HALF + 4 * n);
#pragma unroll
        for (int ai = 0; ai < 2; ++ai)
#pragma unroll
            for (int m = 0; m < 4; ++m) {
                if (sl[ai][m] >= 0) { const float g = gt[ai][m]; unsigned char* rowp = SLOT + (size_t)sl[ai][m] * D + col0;
#pragma unroll
                    for (int bj = 0; bj < 2; ++bj) { const f32x4 v0 = (acc[ai][bj][m][0] + bv[bj][0]) * g, v1 = (acc[ai][bj][m][1] + bv[bj][1]) * g;
                        u32x2 w; w.x = pk4_fp8(v0[0], v0[1], v0[2], v0[3]); w.y = pk4_fp8(v1[0], v1[1], v1[2], v1[3]);
                        *(u32x2*)(rowp + bj * HALF) = w; } } }
    }
};
}

struct Frame {
    LAS unsigned char* lds;
    int tid, lane, wave, vcu, G;
};

__device__ __forceinline__ void cvt_item_addr(const float* W, int K, int N, bf16_t* WT, int row_off, int item, int lane, const float*& src, bf16_t*& dst) {
    const int nblk = N >> 5, kb = item / nblk, nb = item - kb * nblk, kl = lane >> 3, nl = lane & 7;
    src = W + (size_t)(64 * kb + 8 * kl) * N + 32 * nb + 4 * nl; dst = WT + (size_t)(row_off + 32 * nb + 4 * nl) * K + 64 * kb + 8 * kl;
}
__device__ __forceinline__ void cvt_store(const f32x4 (&v)[8], bf16_t* dst, int K) {
#pragma unroll
    for (int i = 0; i < 4; ++i) { u32x4 o; o.x = cvt_pk_bf16(v[0][i], v[1][i]); o.y = cvt_pk_bf16(v[2][i], v[3][i]); o.z = cvt_pk_bf16(v[4][i], v[5][i]); o.w = cvt_pk_bf16(v[6][i], v[7][i]);
        *(u32x4*)(dst + (size_t)i * K) = o; }
}
__device__ __forceinline__ void cvt_store8(const f32x4 (&v)[8], unsigned char* dst, int K) {
#pragma unroll
    for (int i = 0; i < 4; ++i) { u32x2 o; o.x = pk4_fp8(v[0][i] * 64.f, v[1][i] * 64.f, v[2][i] * 64.f, v[3][i] * 64.f); o.y = pk4_fp8(v[4][i] * 64.f, v[5][i] * 64.f, v[6][i] * 64.f, v[7][i] * 64.f);
        *(u32x2*)(dst + (size_t)i * K) = o; }
}
__device__ __forceinline__ void cvt_range(const float* W, int K, int N, bf16_t* WT, int row_off, int i0, int cnt, int r, int nw, int lane) {
    int it = i0 + r; const int end = i0 + cnt;
    for (; it + nw < end; it += 2 * nw) {
        const float* s0; bf16_t* d0; const float* s1; bf16_t* d1;
        cvt_item_addr(W, K, N, WT, row_off, it, lane, s0, d0); cvt_item_addr(W, K, N, WT, row_off, it + nw, lane, s1, d1);
        f32x4 a[8], b[8];
#pragma unroll
        for (int j = 0; j < 8; ++j) a[j] = *(const f32x4*)(s0 + (size_t)j * N);
#pragma unroll
        for (int j = 0; j < 8; ++j) b[j] = *(const f32x4*)(s1 + (size_t)j * N);
        cvt_store(a, d0, K); cvt_store(b, d1, K);
    }
    if (it < end) { const float* s0; bf16_t* d0; cvt_item_addr(W, K, N, WT, row_off, it, lane, s0, d0); f32x4 a[8];
#pragma unroll
        for (int j = 0; j < 8; ++j) a[j] = *(const f32x4*)(s0 + (size_t)j * N);
        cvt_store(a, d0, K); }
}
constexpr int CV_UP = NE * (D / 64) * (2 * DFF / 32), CV_DN = NE * (DFF / 64) * (D / 32), CV_ALL = CV_UP + CV_DN;
struct MoeW { const float* w_up; const float* w_down; unsigned char* WUPT; unsigned char* WDNT; };
__device__ __forceinline__ void cvt_moe_addr(const MoeW& mw, int chunk, int w, int h, int lane, const float*& src, unsigned char*& dst, int& N) {
    const int kl = lane >> 3, nl = lane & 7;
    if (chunk < CV_UP / 64) { const int e = chunk >> 6, cc = chunk & 63, kb = 8 * (cc >> 4) + w, nb = 8 * (cc & 15) + h; N = 2 * DFF;
        src = mw.w_up + (size_t)e * D * 2 * DFF + (size_t)(64 * kb + 8 * kl) * (2 * DFF) + 32 * nb + 4 * nl; dst = mw.WUPT + (size_t)e * 2 * DFF * D + (size_t)(32 * nb + 4 * nl) * D + 64 * kb + 8 * kl; }
    else { const int q = chunk - CV_UP / 64, e = q >> 5, cc = q & 31, kb = 8 * (cc >> 3) + w, nb = 8 * (cc & 7) + h; N = D;
        src = mw.w_down + (size_t)e * DFF * D + (size_t)(64 * kb + 8 * kl) * D + 32 * nb + 4 * nl; dst = mw.WDNT + (size_t)e * D * DFF + (size_t)(32 * nb + 4 * nl) * DFF + 64 * kb + 8 * kl; }
}
__device__ __forceinline__ f32x4 ld_nt(const float* p) { return __builtin_nontemporal_load((const f32x4*)p); }
constexpr int CV_WG = 64;
__device__ __forceinline__ int cvt_claim(unsigned* cursor, int cap, unsigned* done, unsigned need) {
    if (done && __hip_atomic_load(done, __ATOMIC_RELAXED, __HIP_MEMORY_SCOPE_AGENT) >= need) return CV_ALL;
    if ((int)__hip_atomic_load(cursor, __ATOMIC_RELAXED, __HIP_MEMORY_SCOPE_AGENT) >= cap) return CV_ALL;
    return (int)__hip_atomic_fetch_add(cursor, (unsigned)CV_WG, __ATOMIC_RELAXED, __HIP_MEMORY_SCOPE_AGENT);
}
__device__ __forceinline__ void cvt_pull(const MoeW& mw, unsigned* cursor, int cap, unsigned* done, unsigned need, volatile LAS int* slot, int tid, int wave, int lane) {
    __syncthreads();
    if (tid == 0) *slot = cvt_claim(cursor, cap, done, need);
    __syncthreads();
    int base = __builtin_amdgcn_readfirstlane(*slot);
    while (base < CV_ALL) {
        int nb = CV_ALL; if (tid == 0) nb = cvt_claim(cursor, cap, done, need);
        const int chunk = base >> 6;
        if (chunk < CV_UP / 64) {
            const int e = chunk >> 6, cc = chunk & 63, nb = 8 * (cc & 15) + wave, kl = lane >> 3, nl = lane & 7;
#pragma unroll 1
            for (int q = 0; q < 2; ++q) { const int kq = 2 * (cc >> 4) + q, kb32 = 8 * kq + kl;
                const float* src = mw.w_up + (size_t)e * D * 2 * DFF + (size_t)(32 * kb32) * (2 * DFF) + 32 * nb + 4 * nl;
                f32x4 a[32];
#pragma unroll
                for (int j = 0; j < 32; ++j) a[j] = ld_nt(src + (size_t)j * (2 * DFF));
                unsigned char* dst = mw.WUPT + (size_t)e * 2 * DFF * D + (size_t)(32 * nb + 4 * nl) * D + 128 * (kb32 >> 2) + 16 * (kb32 & 3);
#pragma unroll
                for (int i = 0; i < 4; ++i) { f32x16 lo, hi;
#pragma unroll
                    for (int j = 0; j < 16; ++j) { lo[j] = a[j][i] * 64.f; hi[j] = a[16 + j][i] * 64.f; }
                    st_fp6_block(dst + (size_t)i * D, pk32_fp6(lo, hi)); } }
        } else
#pragma unroll
        for (int h = 0; h < 8; h += 4) {
            const float* s0; unsigned char* d0; const float* s1; unsigned char* d1; const float* s2; unsigned char* d2; const float* s3; unsigned char* d3; int N0, N1, N2, N3;
            cvt_moe_addr(mw, chunk, wave, h, lane, s0, d0, N0); cvt_moe_addr(mw, chunk, wave, h + 1, lane, s1, d1, N1); cvt_moe_addr(mw, chunk, wave, h + 2, lane, s2, d2, N2); cvt_moe_addr(mw, chunk, wave, h + 3, lane, s3, d3, N3);
            f32x4 a[8], b[8], c[8], d[8];
#pragma unroll
            for (int j = 0; j < 8; ++j) a[j] = ld_nt(s0 + (size_t)j * N0);
#pragma unroll
            for (int j = 0; j < 8; ++j) b[j] = ld_nt(s1 + (size_t)j * N1);
#pragma unroll
            for (int j = 0; j < 8; ++j) c[j] = ld_nt(s2 + (size_t)j * N2);
#pragma unroll
            for (int j = 0; j < 8; ++j) d[j] = ld_nt(s3 + (size_t)j * N3);
            cvt_store8(a, d0, D); cvt_store8(b, d1, D); cvt_store8(c, d2, D); cvt_store8(d, d3, D);
        }
        __syncthreads();
        if (tid == 0) *slot = nb;
        __syncthreads();
        base = __builtin_amdgcn_readfirstlane(*slot);
    }
}
__device__ __forceinline__ void rms_row_to_bf16(const float* xrow, const float* gvec, bf16_t* orow, int lane) {
    const f32x4* xr = (const f32x4*)xrow + lane; f32x4 v[8]; float s = 0.f;
#pragma unroll
    for (int j = 0; j < 8; ++j) { v[j] = xr[64 * j]; s += (v[j].x * v[j].x + v[j].y * v[j].y) + (v[j].z * v[j].z + v[j].w * v[j].w); }
    const float rstd = 1.0f / sqrtf(wave_sum(s) * (1.0f / D) + RMS_EPS);
    const f32x4* gr = (const f32x4*)gvec + lane; u32x2* o8 = (u32x2*)orow + lane;
#pragma unroll
    for (int j = 0; j < 8; ++j) { const f32x4 g = gr[64 * j]; const f32x4 y = v[j] * rstd * g; u32x2 w; w.x = cvt_pk_bf16(y.x, y.y); w.y = cvt_pk_bf16(y.z, y.w); o8[64 * j] = w; }
}

__device__ __forceinline__ unsigned voff_b(unsigned row, unsigned ch) { return 256u * row + 16u * (ch ^ (((row & 3u) << 2) | ((row >> 2) & 3u))); }
__device__ __forceinline__ s16x4 vtr(const LAS unsigned char* p) { return __builtin_bit_cast(s16x4, __builtin_amdgcn_ds_read_tr16_b64_v4i16((LAS s16x4*)p)); }

__device__ __forceinline__ void sb_wg_unit(const bf16_t* PG, bf16_t* OA, int h, int qb, LAS unsigned char* lds, volatile LAS int* flags, int tid, int wave, int lane) {
    const int fr = lane & 15, fq = lane >> 4, q0w = qb * 128 + wave * 16, qi = q0w + fr;
    bf16x8 Qf[4];
    { const bf16_t* qp = PG + (size_t)qi * NP1 + h * HD + 8 * fq;
#pragma unroll
      for (int ks = 0; ks < 4; ++ks) Qf[ks] = *(const bf16x8*)(qp + 32 * ks); }
    f32x4 O[8];
#pragma unroll
    for (int db = 0; db < 8; ++db) O[db] = (f32x4){0.f, 0.f, 0.f, 0.f};
    float carry = 0.f; bool sat = false;
    const float scale = 0.08838834764831845f;
    const unsigned p = fr & 3, qq = fr >> 2;
    const int jt_hi = 2 * qb + 1, jt_w = q0w >> 6;
    const int srow = tid >> 4, sch = tid & 15;
    const bf16_t* kg = PG + (size_t)srow * NP1 + SBW + h * HD + 8 * sch;
    u32x4 kr[2], vr[2];
    __syncthreads();
    if (tid < 8) flags[tid] = 0;
    { const bf16_t* g = kg + (size_t)(jt_hi * 64) * NP1;
#pragma unroll
      for (int i = 0; i < 2; ++i) { kr[i] = *(const u32x4*)(g + (size_t)(32 * i) * NP1); vr[i] = *(const u32x4*)(g + (size_t)(32 * i) * NP1 + SBW); } }
    for (int jt = jt_hi, it = 0; jt >= 0; --jt, ++it) {
        LAS unsigned char* kb = lds + (it & 1) * 32768; LAS unsigned char* vb = kb + 16384;
#pragma unroll
        for (int i = 0; i < 2; ++i) { *(LAS u32x4*)(kb + voff_b(srow + 32 * i, sch)) = kr[i]; *(LAS u32x4*)(vb + voff_b(srow + 32 * i, sch)) = vr[i]; }
        __syncthreads();
        { int ns = 0;
#pragma unroll
          for (int w = 0; w < 8; ++w) ns += flags[w];
          if (__builtin_amdgcn_readfirstlane(ns) == 8) break; }
        if (jt > 0) { const bf16_t* g = kg + (size_t)((jt - 1) * 64) * NP1;
#pragma unroll
            for (int i = 0; i < 2; ++i) { kr[i] = *(const u32x4*)(g + (size_t)(32 * i) * NP1); vr[i] = *(const u32x4*)(g + (size_t)(32 * i) * NP1 + SBW); } }
        if (!sat && jt <= jt_w) {
            const int key0 = jt * 64;
            f32x4 z[4];
#pragma unroll
            for (int sb = 0; sb < 4; ++sb) { z[sb] = (f32x4){0.f, 0.f, 0.f, 0.f};
#pragma unroll
                for (int ks = 0; ks < 4; ++ks) { const bf16x8 kf = *(const LAS bf16x8*)(kb + voff_b(16 * sb + fr, 4 * ks + fq)); z[sb] = __builtin_amdgcn_mfma_f32_16x16x32_bf16(kf, Qf[ks], z[sb], 0, 0, 0); } }
            float sfx[4][4], g[4], lex[4], T[4];
            const bool diag = key0 + 64 > q0w;
#pragma unroll
            for (int sb = 0; sb < 4; ++sb) {
                float sp[4];
#pragma unroll
                for (int i = 0; i < 4; ++i) { const float y = z[sb][i] * (scale * 1.4426950408889634f); z[sb][i] = y;
                    sp[i] = fmaxf(y, 0.f) + __builtin_amdgcn_logf(1.0f + __builtin_amdgcn_exp2f(-fabsf(y))); }
                if (diag) {
#pragma unroll
                    for (int i = 0; i < 4; ++i) { const int key = key0 + 16 * sb + 4 * fq + i; sp[i] = (key < qi) ? sp[i] : 0.f; } }
                sfx[sb][3] = sp[3]; sfx[sb][2] = sp[2] + sfx[sb][3]; sfx[sb][1] = sp[1] + sfx[sb][2]; sfx[sb][0] = sp[0] + sfx[sb][1]; g[sb] = sfx[sb][0];
            }
#pragma unroll
            for (int sb = 0; sb < 4; ++sb) { const float x1 = __shfl_xor(g[sb], 16), x2 = __shfl_xor(g[sb], 32), x3 = __shfl_xor(g[sb], 48);
                T[sb] = (g[sb] + x1) + (x2 + x3); lex[sb] = ((fq & 1) ? 0.f : x1) + ((fq < 2) ? (x2 + x3) : 0.f); }
            float run = carry; bf16x8 Wf[2]; unsigned wpk[8];
#pragma unroll
            for (int sb = 3; sb >= 0; --sb) { const float base = run + lex[sb]; float w[4];
#pragma unroll
                for (int i = 0; i < 4; ++i) w[i] = __builtin_amdgcn_exp2f(z[sb][i] - (base + sfx[sb][i]));
                if (diag) {
#pragma unroll
                    for (int i = 0; i < 4; ++i) { const int key = key0 + 16 * sb + 4 * fq + i; w[i] = (key < qi) ? w[i] : 0.f; } }
                wpk[2 * sb] = cvt_pk_bf16(w[0], w[1]); wpk[2 * sb + 1] = cvt_pk_bf16(w[2], w[3]); run += T[sb]; }
            carry = run;
            { u32x4 a = {wpk[0], wpk[1], wpk[2], wpk[3]}, b = {wpk[4], wpk[5], wpk[6], wpk[7]}; Wf[0] = __builtin_bit_cast(bf16x8, a); Wf[1] = __builtin_bit_cast(bf16x8, b); }
#pragma unroll
            for (int db = 0; db < 8; ++db)
#pragma unroll
                for (int m = 0; m < 2; ++m) { const unsigned r1 = 32 * m + 4 * fq + qq, r2 = r1 + 16;
                    const s16x4 lo = vtr(vb + voff_b(r1, 2 * db + (p >> 1)) + 8 * (p & 1)), hi = vtr(vb + voff_b(r2, 2 * db + (p >> 1)) + 8 * (p & 1));
                    const bf16x8 vf = {lo[0], lo[1], lo[2], lo[3], hi[0], hi[1], hi[2], hi[3]};
                    O[db] = __builtin_amdgcn_mfma_f32_16x16x32_bf16(vf, Wf[m], O[db], 0, 0, 0); }
            if (__all(carry > 150.1f)) { sat = true; if (lane == 0) flags[wave] = 1; }
        }
    }
    { bf16_t* op = OA + (size_t)qi * SBW + h * HD + 4 * fq;
#pragma unroll
      for (int db = 0; db < 8; ++db) { u32x2 w; w.x = cvt_pk_bf16(O[db][0], O[db][1]); w.y = cvt_pk_bf16(O[db][2], O[db][3]); *(u32x2*)(op + 16 * db) = w; } }
}

__device__ __forceinline__ void xa_unit(const bf16_t* QXA, const bf16_t* KVM, bf16_t* OXA, int h, int qb, const LAS unsigned char* vl, int lane) {
    const int fr = lane & 15, fq = lane >> 4, q0 = qb * 16, qi = q0 + fr;
    bf16x8 Qf[4];
    { const bf16_t* qp = QXA + (size_t)qi * XAW + h * HD + 8 * fq;
#pragma unroll
      for (int ks = 0; ks < 4; ++ks) Qf[ks] = *(const bf16x8*)(qp + 32 * ks); }
    f32x4 z[16];
    { const bf16_t* kp = KVM + (size_t)fr * (2 * XAW) + h * HD + 8 * fq;
#pragma unroll
      for (int sb = 0; sb < 16; ++sb) { z[sb] = (f32x4){0.f, 0.f, 0.f, 0.f};
#pragma unroll
          for (int ks = 0; ks < 4; ++ks) { const bf16x8 kf = *(const bf16x8*)(kp + (size_t)(16 * sb) * (2 * XAW) + 32 * ks); z[sb] = __builtin_amdgcn_mfma_f32_16x16x32_bf16(kf, Qf[ks], z[sb], 0, 0, 0); } } }
    const float scale = 0.08838834764831845f * 1.4426950408889634f;
    float mx = -3.0e38f;
#pragma unroll
    for (int sb = 0; sb < 16; ++sb)
#pragma unroll
        for (int i = 0; i < 4; ++i) { z[sb][i] *= scale; mx = fmaxf(mx, z[sb][i]); }
    mx = fmaxf(mx, __shfl_xor(mx, 16)); mx = fmaxf(mx, __shfl_xor(mx, 32));
    float sum = 0.f;
#pragma unroll
    for (int sb = 0; sb < 16; ++sb)
#pragma unroll
        for (int i = 0; i < 4; ++i) { const float e = __builtin_amdgcn_exp2f(z[sb][i] - mx); z[sb][i] = e; sum += e; }
    sum += __shfl_xor(sum, 16); sum += __shfl_xor(sum, 32);
    const float inv = 1.0f / sum;
    f32x4 O[8];
#pragma unroll
    for (int db = 0; db < 8; ++db) O[db] = (f32x4){0.f, 0.f, 0.f, 0.f};
    const unsigned p = fr & 3, qq = fr >> 2;
#pragma unroll
    for (int m = 0; m < 8; ++m) {
        u32x4 a = {cvt_pk_bf16(z[2 * m][0], z[2 * m][1]), cvt_pk_bf16(z[2 * m][2], z[2 * m][3]), cvt_pk_bf16(z[2 * m + 1][0], z[2 * m + 1][1]), cvt_pk_bf16(z[2 * m + 1][2], z[2 * m + 1][3])};
        const bf16x8 Wf = __builtin_bit_cast(bf16x8, a);
#pragma unroll
        for (int db = 0; db < 8; ++db) { const unsigned r1 = 32 * m + 4 * fq + qq, r2 = r1 + 16;
            const s16x4 lo = vtr(vl + voff_b(r1, 2 * db + (p >> 1)) + 8 * (p & 1)), hi = vtr(vl + voff_b(r2, 2 * db + (p >> 1)) + 8 * (p & 1));
            const bf16x8 vf = {lo[0], lo[1], lo[2], lo[3], hi[0], hi[1], hi[2], hi[3]};
            O[db] = __builtin_amdgcn_mfma_f32_16x16x32_bf16(vf, Wf, O[db], 0, 0, 0); }
    }
    { bf16_t* op = OXA + (size_t)qi * XAW + h * HD + 4 * fq;
#pragma unroll
      for (int db = 0; db < 8; ++db) { const f32x4 o = O[db] * inv; u32x2 w; w.x = cvt_pk_bf16(o[0], o[1]); w.y = cvt_pk_bf16(o[2], o[3]); *(u32x2*)(op + 16 * db) = w; } }
}

template <int W>
__device__ __forceinline__ void pool_run(const bf16_t* PG, bf16_t* PO, int t0, int ch) {
    constexpr int NR = W + 7;
    const bf16_t* pp = PG + (size_t)(t0 + 7) * NP1 + 3 * SBW + ch * 8;
    u32x4 v[NR];
#pragma unroll
    for (int k = 0; k < NR; ++k) v[k] = (t0 + 7 - k >= 0) ? *(const u32x4*)(pp - (size_t)k * NP1) : (u32x4){0u, 0u, 0u, 0u};
#pragma unroll
    for (int i = 0; i < 8; ++i) {
        float s[8];
#pragma unroll
        for (int j = 0; j < 8; ++j) s[j] = 0.f;
#pragma unroll
        for (int j = W - 1; j >= 0; --j) { const u32x4 x = v[7 - i + j];
            s[0] += bf_lo(x.x); s[1] += bf_hi(x.x); s[2] += bf_lo(x.y); s[3] += bf_hi(x.y); s[4] += bf_lo(x.z); s[5] += bf_hi(x.z); s[6] += bf_lo(x.w); s[7] += bf_hi(x.w); }
        const int t = t0 + i, n = (t + 1 < W) ? (t + 1) : W; const float inv = 1.0f / (float)n; const u32x4 me = v[7 - i]; u32x4 o;
        o.x = cvt_pk_bf16(s[0] * inv - bf_lo(me.x), s[1] * inv - bf_hi(me.x)); o.y = cvt_pk_bf16(s[2] * inv - bf_lo(me.y), s[3] * inv - bf_hi(me.y));
        o.z = cvt_pk_bf16(s[4] * inv - bf_lo(me.z), s[5] * inv - bf_hi(me.z)); o.w = cvt_pk_bf16(s[6] * inv - bf_lo(me.w), s[7] * inv - bf_hi(me.w));
        *(u32x4*)(PO + (size_t)t * POOLW + ch * 8) = o;
    }
}

constexpr int NPHASE = 15;
struct Args { const float* in[24]; float* out; unsigned char* ws; int ph_lo, ph_hi; };
static_assert(sizeof(Args) == 24 * 8 + 8 + 8 + 8, "Args has no padding");

__global__ void __launch_bounds__(NWAVES * 64, 2) moe_fwd(Args args) {
    extern __shared__ __attribute__((aligned(16))) unsigned char lds_raw[];
    Frame F;
    F.lds = (LAS unsigned char*)lds_raw;
    F.tid = threadIdx.x; F.lane = F.tid & 63; F.wave = __builtin_amdgcn_readfirstlane(F.tid >> 6);
    F.G = gridDim.x; { const int bx = blockIdx.x; F.vcu = (F.G % 8 == 0) ? (bx % 8) * (F.G / 8) + bx / 8 : bx; }
    unsigned char* ws = args.ws;
    unsigned* ctl = (unsigned*)(ws + WS_CTL);
    LAS unsigned char* lx = F.lds + LDS_X_OFF;
    for (int u = F.tid; u < (LDS_BYTES - LDS_X_OFF) / 4; u += NWAVES * 64) ((LAS unsigned*)lx)[u] = 0u;
    __syncthreads();
#if MK_ONE_LAUNCH
    XcdBarrier bar = xcd_barrier_post(ctl + CW_BAR, (volatile LAS unsigned*)(lx + LX_BAR));
#define GRID_BAR() xcd_barrier(bar)
#else
#define GRID_BAR() do {} while (0)
#endif
    const int lo = args.ph_lo, hi = args.ph_hi;
#ifndef PHASE_MASK
#define PHASE_MASK 0x7fff
#endif
#define IN(k) (((PHASE_MASK >> (k)) & 1) && lo <= (k) && (k) < hi)
#define SEAM(k) do { if (IN((k) + 1)) GRID_BAR(); } while (0)

    const float* x = args.in[0]; const float* mem = args.in[1]; const float* norm_mix = args.in[2]; const float* w_in = args.in[3]; const float* pool_lin = args.in[4];
    const float* pool_scale = args.in[5]; const float* w_branch_a = args.in[6]; const float* w_branch_b = args.in[7]; const float* w_gate = args.in[8]; const float* b_gate = args.in[9];
    const float* w_mix_out = args.in[10]; const float* xa_norm = args.in[11]; const float* mem_norm = args.in[12]; const float* xa_wq = args.in[13]; const float* xa_wkv = args.in[14];
    const float* xa_wo = args.in[15]; const float* moe_norm = args.in[16]; const float* w_router = args.in[17]; const float* b_router = args.in[18]; const float* w_up = args.in[19];
    const float* b_up = args.in[20]; const float* w_down = args.in[21]; const float* b_down = args.in[22]; const float* final_norm = args.in[23];
    bf16_t* W1T = (bf16_t*)(ws + WS_W1T); bf16_t* WAT = (bf16_t*)(ws + WS_WAT); bf16_t* WBT = (bf16_t*)(ws + WS_WBT); bf16_t* WMT = (bf16_t*)(ws + WS_WMT); bf16_t* PLT = (bf16_t*)(ws + WS_PLT);
    bf16_t* WQT = (bf16_t*)(ws + WS_WQT); bf16_t* WKVT = (bf16_t*)(ws + WS_WKVT); bf16_t* WOT = (bf16_t*)(ws + WS_WOT); unsigned char* WUPT = ws + WS_WUPT; unsigned char* WDNT = ws + WS_WDNT;
    bf16_t* U = (bf16_t*)(ws + WS_U); bf16_t* MEMN = (bf16_t*)(ws + WS_MEMN); bf16_t* PG = (bf16_t*)(ws + WS_PG); bf16_t* OA = (bf16_t*)(ws + WS_OA); bf16_t* PO = (bf16_t*)(ws + WS_PO);
    bf16_t* OB = (bf16_t*)(ws + WS_OB); float* TMP = (float*)(ws + WS_TMP); bf16_t* MG = (bf16_t*)(ws + WS_MG); float* H1 = (float*)(ws + WS_H1); bf16_t* U2 = (bf16_t*)(ws + WS_U2);
    bf16_t* QXA = (bf16_t*)(ws + WS_QXA); bf16_t* KVM = (bf16_t*)(ws + WS_KVM); bf16_t* OXA = (bf16_t*)(ws + WS_OXA); float* H2 = (float*)(ws + WS_H2); unsigned char* TB = ws + WS_TB;
    bf16_t* ROWS = (bf16_t*)(ws + WS_ROWS); unsigned char* ACT = ws + WS_ACT; unsigned char* SLOT = ws + WS_SLOT;
    int* ASGE = (int*)(ws + WS_ASGE); int* ASGP = (int*)(ws + WS_ASGP); float* GATE = (float*)(ws + WS_GATE); int* RSLOT = (int*)(ws + WS_RSLOT);
    int* CNT = (int*)(ctl + CW_CNT); bf16_t* WRT = (bf16_t*)(ws + WS_WRT);
    const int gw = F.vcu * NWAVES + F.wave, NGW = F.G * NWAVES;
    const MoeW mw{w_up, w_down, WUPT, WDNT};
    unsigned* CUR = ctl + CW_CUR; volatile LAS int* cvs = (volatile LAS int*)(lx + LX_CVS);
#define CVT_PULL(cap) cvt_pull(mw, CUR, (cap), nullptr, 0u, cvs, F.tid, F.wave, F.lane)
#define CVT_BESIDE(cap, ph, need) cvt_pull(mw, CUR, (cap), ctl + CW_DONE + 64 * (ph), (unsigned)(need), cvs, F.tid, F.wave, F.lane)
#define MARK_DONE(ph) do { if (F.tid == 0) __hip_atomic_fetch_add(ctl + CW_DONE + 64 * (ph), 1u, __ATOMIC_RELAXED, __HIP_MEMORY_SCOPE_AGENT); } while (0)

    if (IN(0)) {
        constexpr int I_IN = (D / 64) * (INW / 32), I_BR = (SBW / 64) * (D / 32), I_MX = (D / 64) * (D / 32), I_PL = (256 / 64) * (256 / 32);
        constexpr int I_Q = (D / 64) * (XAW / 32), I_KV = (D / 64) * (2 * XAW / 32), I_O = (XAW / 64) * (D / 32);
        cvt_range(w_in, D, INW, W1T, 0, 0, I_IN, gw, NGW, F.lane);
        cvt_range(w_gate, D, INW, W1T, INW, 0, I_IN, gw, NGW, F.lane);
        for (int m = gw; m < S; m += NGW) rms_row_to_bf16(x + (size_t)m * D, norm_mix, U + (size_t)m * D, F.lane);
        for (int m = gw; m < MEM; m += NGW) rms_row_to_bf16(mem + (size_t)m * D, mem_norm, MEMN + (size_t)m * D, F.lane);
        for (int i = blockIdx.x * (NWAVES * 64) + F.tid; i < NE * D / 2; i += F.G * NWAVES * 64) {
            const int e = i >> 10, c = (i & 1023) * 2; const float a = w_router[(size_t)c * NE + e], b = w_router[(size_t)(c + 1) * NE + e];
            const unsigned hi = cvt_pk_bf16(a, b); const unsigned lo = cvt_pk_bf16(a - bf_lo(hi), b - bf_hi(hi));
            *(unsigned*)(WRT + (size_t)e * D + c) = hi; *(unsigned*)(WRT + (size_t)(NE + e) * D + c) = lo; }
        __syncthreads();
        SEAM(0);
    }

    if (IN(1)) {
        const int gc = (F.G == 256) ? GC_P1 : F.G;
        if ((int)blockIdx.x < gc) {
            pg8::DenseSched Sc{(const char*)U, (const char*)W1T, D, D, S / 256, NP1 / 256, gc, (int)blockIdx.x};
            pg8::EpiProj E{PG, b_gate};
            pg8::gemm_phase<pg8::EpiProj, pg8::DenseSched, true>(F.lds, D, D, D, Sc, E);
            MARK_DONE(1);
        }
        if ((int)blockIdx.x >= gc) {
            constexpr int I_BR = (SBW / 64) * (D / 32), I_MX = (D / 64) * (D / 32), I_PL = (256 / 64) * (256 / 32), I_Q = (D / 64) * (XAW / 32), I_KV = (D / 64) * (2 * XAW / 32), I_O = (XAW / 64) * (D / 32);
            const int cr = ((int)blockIdx.x - gc) * NWAVES + F.wave, cn = (F.G - gc) * NWAVES;
        cvt_range(w_branch_a, SBW, D, WAT, 0, 0, I_BR, cr, cn, F.lane);
        cvt_range(w_branch_b, POOLW, D, WBT, 0, 0, I_BR, cr, cn, F.lane);
        cvt_range(w_mix_out, D, D, WMT, 0, 0, I_MX, cr, cn, F.lane);
        for (int g = 0; g < 4; ++g) cvt_range(pool_lin + (size_t)g * 65536, 256, 256, PLT + (size_t)g * 65536, 0, 0, I_PL, cr, cn, F.lane);
        cvt_range(xa_wq, D, XAW, WQT, 0, 0, I_Q, cr, cn, F.lane);
        cvt_range(xa_wkv, D, 2 * XAW, WKVT, 0, 0, I_KV, cr, cn, F.lane);
        cvt_range(xa_wo, XAW, D, WOT, 0, 0, I_O, cr, cn, F.lane);
        }
        CVT_BESIDE(CV_UP, 1, gc);
        SEAM(1);
    }

    if (IN(2)) {
        for (int it = blockIdx.x * (NWAVES * 64) + F.tid; it < (S / 8) * (POOLW / 8); it += F.G * NWAVES * 64) {
            const int wv = it >> 6, g = wv & 3, rb = (wv >> 2) * 2 + (F.lane >> 5), ch = g * 32 + (F.lane & 31), t0 = rb * 8;
            if (g == 0) pool_run<2>(PG, PO, t0, ch); else if (g == 1) pool_run<4>(PG, PO, t0, ch); else if (g == 2) pool_run<8>(PG, PO, t0, ch); else pool_run<16>(PG, PO, t0, ch);
        }
        for (int it = F.vcu; it < SBH * (S / 128); it += F.G) { const int h = it & 7, qb = (S / 128 - 1) - (it >> 3); sb_wg_unit(PG, OA, h, qb, F.lds, (volatile LAS int*)(lx + LX_SBF), F.tid, F.wave, F.lane); }
        __syncthreads();
        SEAM(2);
    }

    if (IN(3)) {
        pg8::PoolSched Sc{(const char*)PO, (const char*)PLT, F.G, F.vcu};
        pg8::EpiBf16 E{OB, POOLW, pool_scale};
        pg8::gemm_phase<pg8::EpiBf16, pg8::PoolSched, true>(F.lds, 256, POOLW, 256, Sc, E);
        if (F.vcu < (S / 256) * 4) MARK_DONE(3);
        CVT_BESIDE(CV_UP, 3, (S / 256) * 4);
        SEAM(3);
    }

    if (IN(4)) {
        pg8::BranchSched Sc{(const char*)OA, (const char*)OB, (const char*)WAT, (const char*)WBT, SBW, SBW, S / 256, D / 256, F.G, (int)blockIdx.x};
        pg8::EpiBranch E{PG, MG};
        pg8::gemm_phase<pg8::EpiBranch, pg8::BranchSched, true>(F.lds, SBW, SBW, SBW, Sc, E);
        SEAM(4);
    }

    if (IN(5)) {
        pg8::DenseSched Sc{(const char*)MG, (const char*)WMT, D, D, S / 256, D / 256, F.G, (int)blockIdx.x};
        pg8::EpiResid E{x, H1, D};
        pg8::gemm_phase<pg8::EpiResid, pg8::DenseSched, true>(F.lds, D, D, D, Sc, E);
        SEAM(5);
    }

    if (IN(6)) {
        for (int m = gw; m < S; m += NGW) rms_row_to_bf16(H1 + (size_t)m * D, xa_norm, U2 + (size_t)m * D, F.lane);
        SEAM(6);
    }

    if (IN(7)) {
        { pg8::DenseSched Sc{(const char*)U2, (const char*)WQT, D, D, S / 256, XAW / 256, F.G, (int)blockIdx.x};
          pg8::EpiBf16 E{QXA, XAW, nullptr};
          pg8::gemm_phase<pg8::EpiBf16, pg8::DenseSched, true>(F.lds, D, D, D, Sc, E); }
        { const int c2 = ((int)blockIdx.x >= 64) ? (int)blockIdx.x - 64 : (int)blockIdx.x + F.G - 64;
          pg8::DenseSched Sc{(const char*)MEMN, (const char*)WKVT, D, D, MEM / 256, 2 * XAW / 256, F.G, c2};
          pg8::EpiBf16 E{KVM, 2 * XAW, nullptr};
          pg8::gemm_phase<pg8::EpiBf16, pg8::DenseSched, true>(F.lds, D, D, D, Sc, E); }
        if ((int)blockIdx.x < 68) MARK_DONE(7);
        CVT_BESIDE(CV_UP, 7, 68);
        SEAM(7);
    }

    if (IN(8)) {
        for (int it = F.vcu; it < XAH * (S / 128); it += F.G) {
            const int h = it & 3, qg = it >> 2;
            __syncthreads();
#pragma unroll
            for (int t = 0; t < 8; ++t) { const int c = t * 512 + F.tid, row = c >> 4, ch = c & 15;
                const u32x4 vv = *(const u32x4*)(KVM + (size_t)row * (2 * XAW) + XAW + h * HD + 8 * ch); *(LAS u32x4*)(F.lds + voff_b(row, ch)) = vv; }
            __syncthreads();
            xa_unit(QXA, KVM, OXA, h, qg * 8 + F.wave, F.lds, F.lane);
        }
        __syncthreads();
        SEAM(8);
    }

    if (IN(9)) {
        pg8::DenseSched Sc{(const char*)OXA, (const char*)WOT, XAW, XAW, S / 256, D / 256, F.G, (int)blockIdx.x};
        pg8::EpiResid E{H1, H2, D};
        pg8::gemm_phase<pg8::EpiResid, pg8::DenseSched, true>(F.lds, XAW, XAW, XAW, Sc, E);
        SEAM(9);
    }

    if (IN(10)) {
        for (int i = blockIdx.x * (NWAVES * 64) + F.tid; i < PROWS; i += F.G * NWAVES * 64) RSLOT[i] = -1;
        LAS unsigned char* thi = F.lds;
        LAS float* lg = (LAS float*)(lx + LX_LOG);
        LAS float* part = (LAS float*)(lx + LX_RPART);
        for (int rg = F.vcu; rg < S / 16; rg += F.G) {
            __syncthreads();
#pragma unroll
            for (int rr = 0; rr < 2; ++rr) { const int r = 2 * F.wave + rr, m = rg * 16 + r;
                const f32x4* xr = (const f32x4*)(H2 + (size_t)m * D) + F.lane; f32x4 v[8]; float s = 0.f;
#pragma unroll
                for (int j = 0; j < 8; ++j) { v[j] = xr[64 * j]; s += (v[j].x * v[j].x + v[j].y * v[j].y) + (v[j].z * v[j].z + v[j].w * v[j].w); }
                const float rstd = 1.0f / sqrtf(wave_sum(s) * (1.0f / D) + RMS_EPS);
                const f32x4* gr = (const f32x4*)moe_norm + F.lane;
#pragma unroll
                for (int j = 0; j < 8; ++j) { const f32x4 g = gr[64 * j]; const f32x4 y = v[j] * rstd * g; u32x2 w; w.x = cvt_pk_bf16(y.x, y.y); w.y = cvt_pk_bf16(y.z, y.w);
                    u32x2 l; l.x = cvt_pk_bf16(y.x - bf_lo(w.x), y.y - bf_hi(w.x)); l.y = cvt_pk_bf16(y.z - bf_lo(w.y), y.w - bf_hi(w.y));
                    const unsigned off = (unsigned)r * 4096u + ((((unsigned)F.lane >> 1) + 32u * j) ^ (unsigned)r) * 16u + (F.lane & 1) * 8u;
                    *(LAS u32x2*)(thi + off) = w; *(LAS u32x2*)(thi + 65536 + off) = l; } }
            __syncthreads();
#pragma unroll
            for (int q = 0; q < 2; ++q) { const int blk = F.tid + 512 * q, r = blk >> 6, kb32 = blk & 63; f32x16 lo, hi;
#pragma unroll
                for (int c4 = 0; c4 < 4; ++c4) { const u32x4 v = *(const LAS u32x4*)(thi + r * 4096 + ((unsigned)((4 * kb32 + c4) ^ r) * 16u));
                    const float f[8] = {bf_lo(v.x), bf_hi(v.x), bf_lo(v.y), bf_hi(v.y), bf_lo(v.z), bf_hi(v.z), bf_lo(v.w), bf_hi(v.w)};
#pragma unroll
                    for (int j = 0; j < 8; ++j) { if (c4 < 2) lo[8 * c4 + j] = f[j] * 2.0f; else hi[8 * (c4 - 2) + j] = f[j] * 2.0f; } }
                st_fp6_block(TB + (size_t)(rg * 16 + r) * D + 128 * (kb32 >> 2) + 16 * (kb32 & 3), pk32_fp6(lo, hi)); }
            { const int fr = F.lane & 15, fq = F.lane >> 4; f32x4 c0 = {0.f, 0.f, 0.f, 0.f}, c1 = {0.f, 0.f, 0.f, 0.f};
              const bf16_t* wh = WRT + (size_t)fr * D + 256 * F.wave + 8 * fq;
#pragma unroll
              for (int st = 0; st < 8; ++st) { const unsigned ch = (unsigned)(32 * F.wave + 4 * st + fq);
                  const bf16x8 ah = *(const LAS bf16x8*)(thi + fr * 4096 + ((ch ^ (unsigned)fr) * 16u)), al = *(const LAS bf16x8*)(thi + 65536 + fr * 4096 + ((ch ^ (unsigned)fr) * 16u));
                  const bf16x8 bh0 = *(const bf16x8*)(wh + 32 * st), bh1 = *(const bf16x8*)(wh + (size_t)16 * D + 32 * st), bl0 = *(const bf16x8*)(wh + (size_t)NE * D + 32 * st), bl1 = *(const bf16x8*)(wh + (size_t)(NE + 16) * D + 32 * st);
                  c0 = __builtin_amdgcn_mfma_f32_16x16x32_bf16(ah, bh0, c0, 0, 0, 0); c1 = __builtin_amdgcn_mfma_f32_16x16x32_bf16(ah, bh1, c1, 0, 0, 0);
                  c0 = __builtin_amdgcn_mfma_f32_16x16x32_bf16(ah, bl0, c0, 0, 0, 0); c1 = __builtin_amdgcn_mfma_f32_16x16x32_bf16(ah, bl1, c1, 0, 0, 0);
                  c0 = __builtin_amdgcn_mfma_f32_16x16x32_bf16(al, bh0, c0, 0, 0, 0); c1 = __builtin_amdgcn_mfma_f32_16x16x32_bf16(al, bh1, c1, 0, 0, 0); }
#pragma unroll
              for (int i = 0; i < 4; ++i) { part[(F.wave * 16 + 4 * fq + i) * 32 + fr] = c0[i]; part[(F.wave * 16 + 4 * fq + i) * 32 + 16 + fr] = c1[i]; } }
            __syncthreads();
            { const int r = F.tid >> 5, e = F.tid & 31; float a = 0.f;
#pragma unroll
              for (int w = 0; w < 8; ++w) a += part[(w * 16 + r) * 32 + e];
              lg[r * 32 + e] = a + b_router[e]; }
            __syncthreads();
            if (F.tid < 16) { const int r = F.tid, m = rg * 16 + r; float l[32];
#pragma unroll
                for (int e = 0; e < 32; ++e) l[e] = lg[r * 32 + e];
                int idx[4]; float val[4]; unsigned taken = 0u;
#pragma unroll
                for (int k = 0; k < 4; ++k) { float best = -3.4e38f; int bi = 0;
#pragma unroll
                    for (int e = 0; e < 32; ++e) { const bool ok = !((taken >> e) & 1u) && (l[e] > best); best = ok ? l[e] : best; bi = ok ? e : bi; }
                    idx[k] = bi; val[k] = best; taken |= 1u << bi; }
                const float e0 = 1.0f, e1 = expf(val[1] - val[0]), e2 = expf(val[2] - val[0]), e3 = expf(val[3] - val[0]); const float inv = 1.0f / (((e0 + e1) + e2) + e3);
                const float gk[4] = {e0 * inv, e1 * inv, e2 * inv, e3 * inv};
#pragma unroll
                for (int k = 0; k < 4; ++k) { const int pos = atomicAdd(CNT + idx[k], 1); ASGE[m * 4 + k] = idx[k]; ASGP[m * 4 + k] = pos; GATE[m * 4 + k] = gk[k]; } }
        }
        __syncthreads();
        SEAM(10);
    }

    LAS int* tab = (LAS int*)(lx + LX_TAB);
#define BUILD_TAB(NT) do { __syncthreads(); if (F.tid == 0) { int us = 0, ps = 0; for (int e = 0; e < NE; ++e) { const int c = CNT[e], nb = (c + EBLK - 1) / EBLK; tab[e] = us; tab[33 + e] = ps; tab[66 + e] = nb > 0 ? nb : 1; us += nb * (NT); ps += nb * EBLK; } tab[32] = us; tab[65] = ps; } __syncthreads(); } while (0)

    if (IN(11)) {
        BUILD_TAB(1);
        for (int s = blockIdx.x * (NWAVES * 64) + F.tid; s < NK; s += F.G * NWAVES * 64) { const int e = ASGE[s], pos = ASGP[s]; RSLOT[tab[33 + e] + pos] = s; }
        CVT_PULL(CV_UP);
        SEAM(11);
    }

    if (IN(12)) {
        BUILD_TAB(16);
        const int gc = (F.G == 256) ? GC_P12 : F.G; const int bx = (int)blockIdx.x;
        if ((bx >> 3) < (gc >> 3) || F.G != 256) {
            pg8::MoeSched Sc{(const char*)TB, (const char*)WUPT, 16, (size_t)2 * DFF * D, (size_t)128 * D, (size_t)DFF * D, tab, gc, (F.G == 256) ? (bx & 7) * (gc >> 3) + (bx >> 3) : F.vcu, true, (size_t)D};
            pg8::EpiUp E{b_up, ACT};
            LAS int* gtab = (LAS int*)(lx + LX_RPART);
            { pg8::Unit uu; for (int i = 0; i < 16 && Sc.next(i, uu); ++i) if (F.tid < 256) { const int sl = RSLOT[uu.r0 + F.tid]; gtab[i * 256 + F.tid] = (sl < 0 ? 0 : sl) >> 2; } }
            __syncthreads();
            pg8::gemm_phase_db6<pg8::EpiUp, pg8::MoeSched>(F.lds, D / 2, D / 2, D / 2, Sc, E, gtab);
            MARK_DONE(12);
        }
        CVT_BESIDE(CV_ALL, 12, gc);
        CVT_PULL(CV_ALL);
        SEAM(12);
    }

    if (IN(13)) {
        BUILD_TAB(8);
        pg8::MoeSched Sc{(const char*)ACT, (const char*)WDNT, 8, (size_t)D * DFF, (size_t)256 * DFF, (size_t)128 * DFF, tab, F.G, F.vcu, false, (size_t)DFF};
        pg8::EpiDown E{b_down, RSLOT, GATE, SLOT};
        pg8::gemm_phase<pg8::EpiDown, pg8::MoeSched, true, false, 1>(F.lds, DFF / 2, DFF / 2, DFF / 2, Sc, E);
        SEAM(13);
    }

    if (IN(14)) {
        for (int m = gw; m < S; m += NGW) {
            const f32x4* xr = (const f32x4*)(H2 + (size_t)m * D) + F.lane; f32x4 v[8]; float s = 0.f;
#pragma unroll
            for (int j = 0; j < 8; ++j) { v[j] = xr[64 * j];
#pragma unroll
                for (int k = 0; k < 4; ++k) { const int w = (int)*((const unsigned*)(SLOT + (size_t)(m * 4 + k) * D) + F.lane + 64 * j); const f32x2 lo = __builtin_amdgcn_cvt_pk_f32_fp8(w, false), hi = __builtin_amdgcn_cvt_pk_f32_fp8(w, true);
                    v[j].x += lo.x * 0.0625f; v[j].y += lo.y * 0.0625f; v[j].z += hi.x * 0.0625f; v[j].w += hi.y * 0.0625f; }
                s += (v[j].x * v[j].x + v[j].y * v[j].y) + (v[j].z * v[j].z + v[j].w * v[j].w); }
            const float rstd = 1.0f / sqrtf(wave_sum(s) * (1.0f / D) + RMS_EPS);
            const f32x4* gr = (const f32x4*)final_norm + F.lane; f32x4* o = (f32x4*)(args.out + (size_t)m * D) + F.lane;
#pragma unroll
            for (int j = 0; j < 8; ++j) o[64 * j] = v[j] * rstd * gr[64 * j];
        }
    }
#undef IN
#undef SEAM
}

extern "C" void kernel_launch(void* const* d_in, const int* in_sizes, int n_in, void* d_out, int out_size, void* d_ws, size_t ws_size, hipStream_t stream) {
    static int grid = 0;
    if (grid == 0) {
        if (n_in != 24 || out_size != S * D || ws_size < WS_END) { fprintf(stderr, "kernel_launch: unexpected shapes (n_in %d out %d ws %zu need %zu)\n", n_in, out_size, ws_size, (size_t)WS_END); grid = -1; return; }
        int dev = 0, cus = 0, per_cu = 0;
        if (hipGetDevice(&dev) != hipSuccess || hipDeviceGetAttribute(&cus, hipDeviceAttributeMultiprocessorCount, dev) != hipSuccess) { grid = -1; return; }
        if (hipFuncSetAttribute((const void*)moe_fwd, hipFuncAttributeMaxDynamicSharedMemorySize, LDS_BYTES) != hipSuccess) { fprintf(stderr, "kernel_launch: hipFuncSetAttribute failed\n"); grid = -1; return; }
        if (hipOccupancyMaxActiveBlocksPerMultiprocessor(&per_cu, (const void*)moe_fwd, NWAVES * 64, LDS_BYTES) != hipSuccess || per_cu < 1) { fprintf(stderr, "kernel_launch: occupancy query says %d\n", per_cu); per_cu = 1; }
        (void)hipGetLastError();
        grid = cus;
    }
    if (grid < 0) return;
    (void)hipMemsetAsync((char*)d_ws + WS_CTL, 0, CTL_ZERO_BYTES, stream);
    Args a{};
    for (int i = 0; i < 24; ++i) a.in[i] = (const float*)d_in[i];
    a.out = (float*)d_out; a.ws = (unsigned char*)d_ws;
#if MK_ONE_LAUNCH
    a.ph_lo = 0; a.ph_hi = NPHASE;
    hipLaunchKernelGGL(moe_fwd, dim3(grid), dim3(NWAVES * 64), LDS_BYTES, stream, a);
#else
    for (int p = 0; p < NPHASE; ++p) { a.ph_lo = p; a.ph_hi = p + 1; for (int rep = 0; rep < (((REPEAT_MASK >> p) & 1) ? 2 : 1); ++rep) hipLaunchKernelGGL(moe_fwd, dim3(grid), dim3(NWAVES * 64), LDS_BYTES, stream, a); }
#endif
}
```

```cpp
#include <hip/hip_runtime.h>
#include <cstdio>
#include <cstdint>

#ifndef MK_ONE_LAUNCH
#define MK_ONE_LAUNCH 1
#endif
#ifndef REPEAT_MASK
#define REPEAT_MASK 0
#endif
#define GC_P1 160
#define GC_P12 224

#define LAS __attribute__((address_space(3)))
#define GAS __attribute__((address_space(1)))
typedef unsigned short bf16_t;
typedef short bf16x8 __attribute__((ext_vector_type(8)));
typedef short s16x4 __attribute__((ext_vector_type(4)));
typedef float f32x4 __attribute__((ext_vector_type(4)));
typedef float f32x2 __attribute__((ext_vector_type(2)));
typedef unsigned u32x4 __attribute__((ext_vector_type(4)));
typedef unsigned u32x2 __attribute__((ext_vector_type(2)));
typedef int v8i32 __attribute__((ext_vector_type(8)));
typedef int v6i32 __attribute__((ext_vector_type(6)));
typedef unsigned u32x3 __attribute__((ext_vector_type(3)));
typedef float f32x16 __attribute__((ext_vector_type(16)));

constexpr int S = 8192, D = 2048, MEM = 256;
constexpr int SBH = 8, HD = 128, SBW = 1024, POOLW = 1024, INW = 4096, NP1 = 8192;
constexpr int XAH = 4, XAW = 512;
constexpr int NE = 32, TOPK = 4, DFF = 2048, NK = S * TOPK, EBLK = 256, MAXBLK = NK / EBLK + NE, PROWS = MAXBLK * EBLK;
constexpr float RMS_EPS = 1e-5f;

constexpr size_t MiB = 1u << 20;
constexpr size_t WS_CTL = 0, CTL_ZERO_BYTES = 1 * MiB;
constexpr size_t WS_W1T = 2 * MiB;
constexpr size_t WS_WAT = WS_W1T + 32 * MiB;
constexpr size_t WS_WBT = WS_WAT + 4 * MiB;
constexpr size_t WS_WMT = WS_WBT + 4 * MiB;
constexpr size_t WS_PLT = WS_WMT + 8 * MiB;
constexpr size_t WS_WQT = WS_PLT + 1 * MiB;
constexpr size_t WS_WKVT = WS_WQT + 2 * MiB;
constexpr size_t WS_WOT = WS_WKVT + 4 * MiB;
constexpr size_t WS_WUPT = WS_WOT + 2 * MiB;
constexpr size_t WS_WDNT = WS_WUPT + 512 * MiB;
constexpr size_t WS_U = WS_WDNT + 256 * MiB;
constexpr size_t WS_MEMN = WS_U + 32 * MiB;
constexpr size_t WS_PG = WS_MEMN + 1 * MiB;
constexpr size_t WS_OA = WS_PG + 128 * MiB;
constexpr size_t WS_PO = WS_OA + 16 * MiB;
constexpr size_t WS_OB = WS_PO + 16 * MiB;
constexpr size_t WS_TMP = WS_OB + 16 * MiB;
constexpr size_t WS_MG = WS_TMP + 64 * MiB;
constexpr size_t WS_H1 = WS_MG + 32 * MiB;
constexpr size_t WS_U2 = WS_H1 + 64 * MiB;
constexpr size_t WS_QXA = WS_U2 + 32 * MiB;
constexpr size_t WS_KVM = WS_QXA + 8 * MiB;
constexpr size_t WS_OXA = WS_KVM + 1 * MiB;
constexpr size_t WS_H2 = WS_OXA + 8 * MiB;
constexpr size_t WS_TB = WS_H2 + 64 * MiB;
constexpr size_t WS_ROWS = WS_TB + 32 * MiB;
constexpr size_t WS_ACT = WS_ROWS + 160 * MiB;
constexpr size_t WS_SLOT = WS_ACT + 160 * MiB;
constexpr size_t WS_ASGE = WS_SLOT + 128 * MiB;
constexpr size_t WS_ASGP = WS_ASGE + 1 * MiB;
constexpr size_t WS_GATE = WS_ASGP + 1 * MiB;
constexpr size_t WS_RSLOT = WS_GATE + 1 * MiB;
constexpr size_t WS_WRT = WS_RSLOT + 1 * MiB;
constexpr size_t WS_END = WS_WRT + 1 * MiB;
constexpr int CW_CNT = 64;
constexpr int CW_CUR = 192;  constexpr int CW_DONE = 256;
constexpr int CW_BAR = 4096;

constexpr int RING_BYTES = 131072;
constexpr int LDS_X_OFF = RING_BYTES;
constexpr int LDS_BYTES = 163840;
constexpr int LX_BAR = 0;
constexpr int LX_TAB = 64;
constexpr int LX_CVS = 32;
constexpr int LX_SBF = 128;
constexpr int LX_LOG = 1024;
constexpr int LX_RPART = 4096;

constexpr int NWAVES = 8;

__device__ __forceinline__ unsigned cvt_pk_bf16(float lo, float hi) { unsigned r; asm volatile("v_cvt_pk_bf16_f32 %0, %1, %2" : "=v"(r) : "v"(lo), "v"(hi)); return r; }
__device__ __forceinline__ unsigned pk4_fp8(float a, float b, float c, float d) { int p = __builtin_amdgcn_cvt_pk_fp8_f32(a, b, 0, false); p = __builtin_amdgcn_cvt_pk_fp8_f32(c, d, p, true); return (unsigned)p; }
__device__ __forceinline__ v6i32 pk32_fp6(const f32x16& lo, const f32x16& hi) { return __builtin_amdgcn_cvt_scalef32_2xpk16_fp6_f32(lo, hi, 1.0f); }
__device__ __forceinline__ void st_fp6_block(unsigned char* p, const v6i32& b) { *(u32x4*)p = (u32x4){(unsigned)b[0], (unsigned)b[1], (unsigned)b[2], (unsigned)b[3]}; *(u32x4*)(p + 64) = (u32x4){(unsigned)b[4], (unsigned)b[5], 0u, 0u}; }
__device__ __forceinline__ float bf_lo(unsigned w) { return __uint_as_float(w << 16); }
__device__ __forceinline__ float bf_hi(unsigned w) { return __uint_as_float(w & 0xffff0000u); }
__device__ __forceinline__ float wave_sum(float v) {
#pragma unroll
    for (int o = 1; o < 64; o <<= 1) v += __shfl_xor(v, o);
    return v;
}
__device__ __forceinline__ float sigmoidf_fast(float x) { return __builtin_amdgcn_rcpf(1.0f + __builtin_amdgcn_exp2f(x * -1.4426950408889634f)); }

#define XB_TMO      128
#define XB_XCNT(j)  (256  + 64 * (j))
#define XB_XSUB(j)  (1280 + 64 * (j))
#define XB_XGEN(j)  (2304 + 64 * (j))
#define XB_TOP      3328
#define XB_TOPGEN   3392
#define XCD_BAR_WORDS 3456
#define XB_SPIN_CAP (1u << 18)
__device__ __forceinline__ unsigned xb_ld(unsigned* p)              { return __hip_atomic_load(p, __ATOMIC_RELAXED, __HIP_MEMORY_SCOPE_AGENT); }
__device__ __forceinline__ unsigned xb_add(unsigned* p, unsigned v) { return __hip_atomic_fetch_add(p, v, __ATOMIC_RELAXED, __HIP_MEMORY_SCOPE_AGENT); }
__device__ __forceinline__ unsigned xb_xcc_id() { return (unsigned)__builtin_amdgcn_s_getreg((3 << 11) | 20) & 0xFu; }
#define XB_SPIN(cond, bar) do { unsigned _sp = 0; while (cond) { __builtin_amdgcn_s_sleep(1); \
    if ((++_sp & 255u) == 0u) { if (xb_ld(&(bar)[XB_TMO])) break; if (_sp > XB_SPIN_CAP) { atomicAdd(&(bar)[XB_TMO], 1u); break; } } } } while (0)
struct XcdBarrier { unsigned* bar; unsigned x; volatile LAS unsigned* st; };
__device__ __forceinline__ XcdBarrier xcd_barrier_post(unsigned* bar, volatile LAS unsigned* st) {
    XcdBarrier b; b.bar = bar; b.x = xb_xcc_id(); b.st = st;
    if (threadIdx.x == 0) (void)xb_add(&bar[XB_XCNT(b.x)], 1u);
    return b;
}
__device__ __forceinline__ void xcd_barrier_complete(unsigned* bar, unsigned x, unsigned& nloc, unsigned& nx) {
    const unsigned G = gridDim.x * gridDim.y * gridDim.z;
    unsigned sum, cnt, mine, sp = 0u;
    for (;;) {
        sum = 0u; cnt = 0u; mine = 0u;
#pragma unroll
        for (unsigned j = 0; j < 16; ++j) { const unsigned c = xb_ld(&bar[XB_XCNT(j)]); sum += c; cnt += (c > 0u) ? 1u : 0u; mine = (j == x) ? c : mine; }
        if (sum == G) break;
        __builtin_amdgcn_s_sleep(1);
        if ((++sp & 255u) == 0u) { if (xb_ld(&bar[XB_TMO])) break; if (sp > XB_SPIN_CAP) { atomicAdd(&bar[XB_TMO], 1u); break; } }
    }
    nloc = mine > 0u ? mine : 1u; nx = cnt > 0u ? cnt : 1u;
}
__device__ __forceinline__ void xcd_barrier(const XcdBarrier& b) {
    asm volatile("s_waitcnt vmcnt(0)" ::: "memory");
    __syncthreads();
    if (threadIdx.x == 0) {
        unsigned* bar = b.bar;
        __builtin_amdgcn_s_waitcnt(0);
        unsigned nloc = b.st[0], nx = b.st[1];
        if (nloc == 0u) { xcd_barrier_complete(bar, b.x, nloc, nx); b.st[0] = nloc; b.st[1] = nx; }
        const unsigned old = xb_add(&bar[XB_XSUB(b.x)], 1u);
        const unsigned gen = old / nloc;
        if (old + 1u == (gen + 1u) * nloc) {
            __builtin_amdgcn_fence(__ATOMIC_RELEASE, "agent");
            asm volatile("s_waitcnt vmcnt(0)" ::: "memory");
            const unsigned og = xb_add(&bar[XB_TOP], 1u);
            const unsigned tg = og / nx;
            if (og + 1u == (tg + 1u) * nx) xb_add(&bar[XB_TOPGEN], 1u);
            else XB_SPIN(xb_ld(&bar[XB_TOPGEN]) == tg, bar);
            __builtin_amdgcn_fence(__ATOMIC_ACQUIRE, "agent");
            xb_add(&bar[XB_XGEN(b.x)], 1u);
            asm volatile("s_waitcnt vmcnt(0)" ::: "memory");
        } else {
            XB_SPIN(xb_ld(&bar[XB_XGEN(b.x)]) == gen, bar);
            __builtin_amdgcn_fence(__ATOMIC_ACQUIRE, "agent");
            asm volatile("s_waitcnt vmcnt(0)" ::: "memory");
        }
    }
    __syncthreads();
}

namespace pg8 {
constexpr int BM = 256, BK = 64, HALF = 128, HTB = HALF * BK * 2, STAGE_BYTES = 8 * HTB, NXCD = 8, WGM = 8;
__host__ __device__ __forceinline__ int lds_byte(int r, int c) { const int st = (r >> 4) * 2 + (c >> 5), rr = r & 15, cc = c & 31, ob = rr * 64 + cc * 2; return st * 1024 + (ob ^ (((ob >> 9) & 1) << 5)); }
__host__ __device__ __forceinline__ void stage_rc(int b, int& R, int& C) { const int st = b / 1024, sb = b % 1024, swz = sb ^ (((sb >> 9) & 1) << 5); R = (st >> 1) * 16 + swz / 64; C = (st & 1) * 32 + (swz % 64) / 2; }
__host__ __device__ __forceinline__ int perm32(int rho) { const int n = rho >> 4, i = rho & 15; return 8 * (i >> 2) + 4 * n + (i & 3); }

struct Unit { const char* A; const char* B0; const char* B1; int r0, c0, x; };

__device__ __forceinline__ void tile_of(int L, int nM, int nN, int& pm, int& pn) {
    const int nwg = nM * nN; int wgid = L;
    { const int q = nwg / NXCD, r = nwg % NXCD, xcd = wgid % NXCD, off = wgid / NXCD; wgid = (xcd < r ? xcd * (q + 1) : r * (q + 1) + (xcd - r) * q) + off; }
    const int nig = WGM * nN, gid = wgid / nig, fm = gid * WGM, gsz = (nM - fm) < WGM ? (nM - fm) : WGM;
    pm = fm + ((wgid % nig) % gsz); pn = (wgid % nig) / gsz;
}
struct DenseSched {
    const char* A; const char* B; int lda, ldb, nM, nN, G, c;
    __device__ __forceinline__ bool next(int i, Unit& u) const {
        const long L = (long)i * G + c; if (L >= (long)nM * nN) return false;
        int pm, pn; tile_of((int)L, nM, nN, pm, pn);
        u.A = A + (size_t)pm * BM * lda * 2; u.B0 = B + (size_t)pn * BM * ldb * 2; u.B1 = u.B0 + (size_t)HALF * ldb * 2; u.r0 = pm * BM; u.c0 = pn * BM; u.x = 0; return true;
    }
};
struct BranchSched {
    const char* A0; const char* A1; const char* B0; const char* B1; int lda, ldb, nM, nN, G, c;
    __device__ __forceinline__ bool next(int i, Unit& u) const {
        const long L = (long)(i >> 1) * G + c; if (L >= (long)nM * nN) return false;
        int pm, pn; tile_of((int)L, nM, nN, pm, pn); const int br = i & 1;
        u.A = (br ? A1 : A0) + (size_t)pm * BM * lda * 2; u.B0 = (br ? B1 : B0) + (size_t)pn * BM * ldb * 2; u.B1 = u.B0 + (size_t)HALF * ldb * 2; u.r0 = pm * BM; u.c0 = pn * BM; u.x = br; return true;
    }
};
struct PoolSched {
    const char* A; const char* B; int G, c;
    __device__ __forceinline__ bool next(int i, Unit& u) const {
        const int L = i * G + c; if (L >= (S / BM) * 4) return false;
        const int pm = L >> 2, g = L & 3;
        u.A = A + ((size_t)pm * BM * POOLW + g * 256) * 2; u.B0 = B + (size_t)g * 256 * 256 * 2; u.B1 = u.B0 + (size_t)HALF * 256 * 2; u.r0 = pm * BM; u.c0 = g * 256; u.x = g; return true;
    }
};
struct MoeSched {
    const char* A; const char* B; int NT; size_t estride; size_t tstride; size_t hoff; const LAS int* tab; int G, c; bool gather; size_t arow;
    __device__ __forceinline__ int tu(int i) const { return __builtin_amdgcn_readfirstlane(tab[i]); }
    __device__ __forceinline__ bool next(int i, Unit& u) const {
        const int L = i * G + c; if (L >= tu(32)) return false;
        int e = 0;
#pragma unroll
        for (int s = 16; s >= 1; s >>= 1) { if (tu(e + s) <= L) e += s; }
        const int r = L - tu(e), nb = tu(66 + e), nt = r / nb, blk = r - nt * nb, prow = tu(33 + e) + blk * EBLK;
        u.A = gather ? A : A + (size_t)prow * arow; u.B0 = B + (size_t)e * estride + (size_t)nt * tstride; u.B1 = u.B0 + hoff; u.r0 = prow; u.c0 = nt; u.x = e; return true;
    }
};

template <class Epi, class Sched, bool ALIGN_EPI, bool GATHER = false, int PREC = 0>
__device__ __forceinline__ void gemm_phase(LAS unsigned char* lds, const int K, const int lda, const int ldb, const Sched& S, const Epi& E, const LAS int* gtab = nullptr) {
    const int tid = threadIdx.x, wid = __builtin_amdgcn_readfirstlane(tid >> 6), lane = tid & 63, wr = wid >> 2, wc = wid & 3, fr = lane & 15, fq = lane >> 4;
    const int nt = K / BK;
    unsigned voffB[2], vc[2][2], vn[2][2]; int RA[2], CA[2];
#pragma unroll
    for (int i = 0; i < 2; ++i) { int R, C; stage_rc(tid * 16 + i * 8192, R, C); const int Rb = Epi::PERM ? ((R & ~31) + perm32(R & 31)) : R; RA[i] = R; CA[i] = C;
        voffB[i] = (unsigned)(Rb * ldb + C) * 2u; }
#define PG8_AOFF(dst, ord) do { _Pragma("unroll") for (int _h = 0; _h < 2; ++_h) _Pragma("unroll") for (int _i = 0; _i < 2; ++_i) \
        dst[_h][_i] = GATHER ? ((unsigned)gtab[(ord) * 256 + _h * HALF + RA[_i]] * (unsigned)lda + (unsigned)CA[_i]) * 2u : (unsigned)((_h * HALF + RA[_i]) * lda + CA[_i]) * 2u; } while (0)
    const size_t kstep = (size_t)(BK * 2);
    const unsigned ldsw = (unsigned)wid * 1024u;
    const int aoff = lds_byte(wr * 64 + fr, fq * 8), boff = lds_byte(wc * 32 + fr, fq * 8);
#define PG8_SA(b, h) (((b) * 2 + (h)) * HTB)
#define PG8_SB(b, h) ((4 + (b) * 2 + (h)) * HTB)
#define PG8_STAGE(bufoff, gbase, voff) do { _Pragma("unroll") for (int _i = 0; _i < 2; ++_i) \
        __builtin_amdgcn_global_load_lds((const unsigned*)((const char*)(gbase) + (voff)[_i]), (LAS unsigned*)(lds + (bufoff) + ldsw + _i * 8192), 16, 0, 0); } while (0)
#define PG8_LD6(off) __builtin_bit_cast(v6i32, __builtin_shufflevector(*(const LAS u32x4*)(lds + (off)), __builtin_shufflevector(*(const LAS u32x2*)(lds + (off) + 1024), *(const LAS u32x2*)(lds + (off) + 1024), 0, 1, -1, -1), 0, 1, 2, 3, 4, 5))
#define PG8_LD8(off) __builtin_bit_cast(v8i32, __builtin_shufflevector(*(const LAS u32x4*)(lds + (off)), *(const LAS u32x4*)(lds + (off) + 1024), 0, 1, 2, 3, 4, 5, 6, 7))
#define PG8_LDA(dst, b, h) do { if (PREC == 2) { _Pragma("unroll") for (int m = 0; m < 4; ++m) dst##6[m] = PG8_LD6(PG8_SA(b, h) + aoff + m * 2048); } \
      else if (PREC == 1) { _Pragma("unroll") for (int m = 0; m < 4; ++m) dst##8[m] = PG8_LD8(PG8_SA(b, h) + aoff + m * 2048); } \
      else { _Pragma("unroll") for (int m = 0; m < 4; ++m) _Pragma("unroll") for (int k = 0; k < 2; ++k) dst[m][k] = *(const LAS bf16x8*)(lds + PG8_SA(b, h) + aoff + m * 2048 + k * 1024); } } while (0)
#define PG8_LDB(dst, b, h) do { if (PREC == 2) { _Pragma("unroll") for (int n = 0; n < 2; ++n) dst##6[n] = PG8_LD6(PG8_SB(b, h) + boff + n * 2048); } \
      else if (PREC == 1) { _Pragma("unroll") for (int n = 0; n < 2; ++n) dst##8[n] = PG8_LD8(PG8_SB(b, h) + boff + n * 2048); } \
      else { _Pragma("unroll") for (int n = 0; n < 2; ++n) _Pragma("unroll") for (int k = 0; k < 2; ++k) dst[n][k] = *(const LAS bf16x8*)(lds + PG8_SB(b, h) + boff + n * 2048 + k * 1024); } } while (0)
#define PG8_MMA(ai, bj, At, Bt) do { __builtin_amdgcn_s_setprio(1); if (PREC == 2) { _Pragma("unroll") for (int m = 0; m < 4; ++m) _Pragma("unroll") for (int n = 0; n < 2; ++n) \
        asm volatile("v_mfma_scale_f32_16x16x128_f8f6f4 %0, %1, %2, %0, %3, %4 op_sel_hi:[0,0,0] cbsz:2 blgp:2" : "+v"(acc[ai][bj][m][n]) : "v"(Bt##6[n]), "v"(At##6[m]), "v"(sc_w), "v"(sc_a)); } \
      else if (PREC == 1) { _Pragma("unroll") for (int m = 0; m < 4; ++m) _Pragma("unroll") for (int n = 0; n < 2; ++n) \
        asm volatile("v_mfma_scale_f32_16x16x128_f8f6f4 %0, %1, %2, %0, %3, %4 op_sel_hi:[0,0,0]" : "+v"(acc[ai][bj][m][n]) : "v"(Bt##8[n]), "v"(At##8[m]), "v"(sc_w), "v"(sc_a)); } \
      else { _Pragma("unroll") for (int m = 0; m < 4; ++m) _Pragma("unroll") for (int n = 0; n < 2; ++n) _Pragma("unroll") for (int k = 0; k < 2; ++k) \
        acc[ai][bj][m][n] = __builtin_amdgcn_mfma_f32_16x16x32_bf16(Bt[n][k], At[m][k], acc[ai][bj][m][n], 0, 0, 0); } __builtin_amdgcn_s_setprio(0); } while (0)
#define PG8_WAIT_V(n) asm volatile("s_waitcnt vmcnt(" #n ")" ::: "memory")
#define PG8_WAIT_L(n) asm volatile("s_waitcnt lgkmcnt(" #n ")" ::: "memory")
#define PG8_BAR __builtin_amdgcn_s_barrier()
#define PG8_SCHED __builtin_amdgcn_sched_barrier(0)
    Unit cur, nxt; int ui = 0;
    if (!S.next(0, cur)) return;
    f32x4 acc[2][2][4][2];
#pragma unroll
    for (int a = 0; a < 2; ++a)
#pragma unroll
        for (int b = 0; b < 2; ++b)
#pragma unroll
            for (int m = 0; m < 4; ++m)
#pragma unroll
                for (int n = 0; n < 2; ++n) acc[a][b][m][n] = (f32x4){0.f, 0.f, 0.f, 0.f};
    bf16x8 At[4][2], B0[2][2], B1[2][2]; v8i32 At8[4], B08[2], B18[2]; v6i32 At6[4], B06[2], B16[2];
    const int sc_w = 121, sc_a = (PREC == 2) ? 126 : 127;
    PG8_AOFF(vc, 0);
#pragma unroll
    for (int _h = 0; _h < 2; ++_h) { vn[_h][0] = vc[_h][0]; vn[_h][1] = vc[_h][1]; }
    PG8_STAGE(PG8_SB(0, 0), cur.B0, voffB); PG8_STAGE(PG8_SB(0, 1), cur.B1, voffB); PG8_STAGE(PG8_SA(0, 0), cur.A, vc[0]); PG8_STAGE(PG8_SA(0, 1), cur.A, vc[1]);
    if (wr == 1) PG8_BAR;
    PG8_WAIT_V(2); PG8_BAR;
    PG8_STAGE(PG8_SB(1, 0), cur.B0 + kstep, voffB); PG8_STAGE(PG8_SA(1, 0), cur.A + kstep, vc[0]); PG8_STAGE(PG8_SB(1, 1), cur.B1 + kstep, voffB);
    PG8_WAIT_V(6); PG8_BAR;
    for (;;) {
        const bool has_next = S.next(ui + 1, nxt);
        if (GATHER && has_next) PG8_AOFF(vn, ui + 1);
        const char* nA = has_next ? nxt.A : cur.A; const char* nB0 = has_next ? nxt.B0 : cur.B0; const char* nB1 = has_next ? nxt.B1 : cur.B1;
#pragma nounroll
        for (int t = 0; t < nt; t += 2) {
            const bool last = (t == nt - 2);
            const char* a1 = cur.A + (size_t)(t + 1) * kstep;
            const char* a2 = last ? nA : cur.A + (size_t)(t + 2) * kstep;
            const char* b20 = last ? nB0 : cur.B0 + (size_t)(t + 2) * kstep; const char* b21 = last ? nB1 : cur.B1 + (size_t)(t + 2) * kstep;
            const char* a3 = a2 + kstep; const char* b30 = b20 + kstep; const char* b31 = b21 + kstep;
            unsigned v2[2][2];
#pragma unroll
            for (int _h = 0; _h < 2; ++_h) { v2[_h][0] = (GATHER && last) ? vn[_h][0] : vc[_h][0]; v2[_h][1] = (GATHER && last) ? vn[_h][1] : vc[_h][1]; }
            PG8_LDB(B0, 0, 0); PG8_LDB(B1, 0, 1); PG8_SCHED; PG8_LDA(At, 0, 0); PG8_STAGE(PG8_SA(1, 1), a1, vc[1]);
            PG8_WAIT_V(8); PG8_WAIT_L(0); PG8_BAR; PG8_MMA(0, 0, At, B0); PG8_MMA(0, 1, At, B1); PG8_BAR; PG8_SCHED;
            PG8_LDA(At, 0, 1); PG8_STAGE(PG8_SB(0, 0), b20, voffB); PG8_STAGE(PG8_SB(0, 1), b21, voffB); PG8_STAGE(PG8_SA(0, 0), a2, v2[0]);
            PG8_WAIT_V(8); PG8_WAIT_L(0); PG8_BAR; PG8_MMA(1, 0, At, B0); PG8_MMA(1, 1, At, B1); PG8_BAR; PG8_SCHED;
            PG8_LDB(B0, 1, 0); PG8_LDB(B1, 1, 1); PG8_SCHED; PG8_LDA(At, 1, 0); PG8_STAGE(PG8_SA(0, 1), a2, v2[1]);
            PG8_WAIT_V(8); PG8_WAIT_L(0); PG8_BAR; PG8_MMA(0, 0, At, B0); PG8_MMA(0, 1, At, B1); PG8_BAR; PG8_SCHED;
            PG8_LDA(At, 1, 1); PG8_STAGE(PG8_SB(1, 0), b30, voffB); PG8_STAGE(PG8_SB(1, 1), b31, voffB); PG8_STAGE(PG8_SA(1, 0), a3, v2[0]);
            PG8_WAIT_V(8); PG8_WAIT_L(0); PG8_BAR; PG8_MMA(1, 0, At, B0); PG8_MMA(1, 1, At, B1); PG8_BAR; PG8_SCHED;
        }
        if constexpr (ALIGN_EPI) { if (wr == 0) PG8_BAR; }
        if (PREC != 0) asm volatile("s_nop 15\n\ts_nop 15\n\ts_nop 15\n\ts_nop 15" ::: "memory");
        E(acc, cur, wr, wc, fr, fq);
        if (!has_next) break;
        bool kp = false; if constexpr (Epi::KEEPS) kp = E.keep(cur);
        if (!kp) {
#pragma unroll
        for (int a = 0; a < 2; ++a)
#pragma unroll
            for (int b = 0; b < 2; ++b)
#pragma unroll
                for (int m = 0; m < 4; ++m)
#pragma unroll
                    for (int n = 0; n < 2; ++n) acc[a][b][m][n] = (f32x4){0.f, 0.f, 0.f, 0.f}; }
        cur = nxt; ++ui;
        if (GATHER) {
#pragma unroll
            for (int _h = 0; _h < 2; ++_h) { vc[_h][0] = vn[_h][0]; vc[_h][1] = vn[_h][1]; } }
        if constexpr (ALIGN_EPI) { if (wr == 1) PG8_BAR; }
    }
    PG8_WAIT_V(0);
    if constexpr (!ALIGN_EPI) { if (wr == 0) PG8_BAR; }
    PG8_BAR;
#undef PG8_AOFF
#undef PG8_SA
#undef PG8_SB
#undef PG8_STAGE
#undef PG8_LDA
#undef PG8_LDB
#undef PG8_MMA
#undef PG8_LD8
#undef PG8_LD6
#undef PG8_WAIT_V
#undef PG8_WAIT_L
#undef PG8_BAR
#undef PG8_SCHED
}

template <int OFF>
__device__ __forceinline__ v6i32 ld6x(unsigned addr) {
    u32x4 lo; u32x2 hi;
    asm volatile("ds_read_b128 %0, %1 offset:%2" : "=v"(lo) : "v"(addr), "n"(OFF));
    asm volatile("ds_read_b64 %0, %1 offset:%2" : "=v"(hi) : "v"(addr), "n"(OFF + 1024));
    return (v6i32){(int)lo[0], (int)lo[1], (int)lo[2], (int)lo[3], (int)hi[0], (int)hi[1]};
}
template <class Epi, class Sched>
__device__ __forceinline__ void gemm_phase_db6(LAS unsigned char* lds, const int K, const int lda, const int ldb, const Sched& S, const Epi& E, const LAS int* gtab) {
    const int tid = threadIdx.x, wid = __builtin_amdgcn_readfirstlane(tid >> 6), lane = tid & 63, wr = wid >> 2, wc = wid & 3, fr = lane & 15, fq = lane >> 4;
    const int nt = K / BK;
    unsigned voffB0, vc[2][2]; const size_t bstep = (size_t)64 * ldb * 2;
    { int R, C; stage_rc(tid * 16, R, C); const int Rb = Epi::PERM ? ((R & ~31) + perm32(R & 31)) : R; voffB0 = (unsigned)(Rb * ldb + C) * 2u; }
#define DB_AOFF(dst, ord) do { _Pragma("unroll") for (int _i = 0; _i < 2; ++_i) { int _R, _C; stage_rc((int)threadIdx.x * 16 + _i * 8192, _R, _C); _Pragma("unroll") for (int _h = 0; _h < 2; ++_h) \
        dst[_h][_i] = ((unsigned)gtab[(ord) * 256 + _h * HALF + _R] * (unsigned)lda + (unsigned)_C) * 2u; } } while (0)
    const size_t kstep = (size_t)(BK * 2);
    const unsigned ldsw = (unsigned)wid * 1024u;
    const int aoff = lds_byte(wr * 64 + fr, fq * 8), boff = lds_byte(wc * 32 + fr, fq * 8);
    const unsigned aA = (unsigned)(size_t)(lds + aoff), aB = (unsigned)(size_t)(lds + 4 * HTB + boff);
#define DB_SA(b, h) (((b) * 2 + (h)) * HTB)
#define DB_SB(b, h) ((4 + (b) * 2 + (h)) * HTB)
#define DB_STAGEA1(bufoff, gbase, voff, i) __builtin_amdgcn_global_load_lds((const unsigned*)((const char*)(gbase) + (voff)[i]), (LAS unsigned*)(lds + (bufoff) + ldsw + (i) * 8192), 16, 0, 0)
#define DB_STAGEB1(bufoff, gbase, i) __builtin_amdgcn_global_load_lds((const unsigned*)((const char*)(gbase) + (size_t)(i) * bstep + voffB0), (LAS unsigned*)(lds + (bufoff) + ldsw + (i) * 8192), 16, 0, 0)
#define DB_STAGEA(bufoff, gbase, voff) do { DB_STAGEA1(bufoff, gbase, voff, 0); DB_STAGEA1(bufoff, gbase, voff, 1); } while (0)
#define DB_STAGEB(bufoff, gbase) do { DB_STAGEB1(bufoff, gbase, 0); DB_STAGEB1(bufoff, gbase, 1); } while (0)
#define DB_LDA(dst, b, h) do { dst[0] = ld6x<DB_SA(b, h)>(aA); dst[1] = ld6x<DB_SA(b, h) + 2048>(aA); dst[2] = ld6x<DB_SA(b, h) + 4096>(aA); dst[3] = ld6x<DB_SA(b, h) + 6144>(aA); } while (0)
#define DB_LDB(dst, b, h) do { dst[0] = ld6x<((b) * 2 + (h)) * HTB>(aB); dst[1] = ld6x<((b) * 2 + (h)) * HTB + 2048>(aB); } while (0)
#define DB_MMA(ai, bj, At, Bt) do { __builtin_amdgcn_s_setprio(1); _Pragma("unroll") for (int m = 0; m < 4; ++m) _Pragma("unroll") for (int n = 0; n < 2; ++n) \
        asm volatile("v_mfma_scale_f32_16x16x128_f8f6f4 %0, %1, %2, %0, %3, %4 op_sel_hi:[0,0,0] cbsz:2 blgp:2" : "+v"(acc[ai][bj][m][n]) : "v"(Bt[n]), "v"(At[m]), "v"(sc_w), "v"(sc_a)); __builtin_amdgcn_s_setprio(0); } while (0)
#define DB_MMA4(ai, bj, mlo, At, Bt) do { _Pragma("unroll") for (int m = (mlo); m < (mlo) + 2; ++m) _Pragma("unroll") for (int n = 0; n < 2; ++n) \
        asm volatile("v_mfma_scale_f32_16x16x128_f8f6f4 %0, %1, %2, %0, %3, %4 op_sel_hi:[0,0,0] cbsz:2 blgp:2" : "+v"(acc[ai][bj][m][n]) : "v"(Bt[n]), "v"(At[m]), "v"(sc_w), "v"(sc_a)); } while (0)
#define DB_SYNC() do { asm volatile("s_waitcnt vmcnt(8) lgkmcnt(0)" ::: "memory"); __builtin_amdgcn_s_barrier(); } while (0)
#define DB_SYNC6() do { asm volatile("s_waitcnt vmcnt(6) lgkmcnt(0)" ::: "memory"); __builtin_amdgcn_s_barrier(); } while (0)
#define DB_STEP(ai, At, sb, sa, gb, ga, vo) do { \
        DB_STAGEB1(sb, gb, 0); DB_SCHED; DB_MMA4(ai, 0, 0, At, B0); DB_SCHED; DB_STAGEB1(sb, gb, 1); DB_SCHED; DB_MMA4(ai, 0, 2, At, B0); DB_SCHED; \
        DB_STAGEA1(sa, ga, vo, 0); DB_SCHED; DB_MMA4(ai, 1, 0, At, B1); DB_SCHED; DB_STAGEA1(sa, ga, vo, 1); DB_SCHED; DB_MMA4(ai, 1, 2, At, B1); DB_SCHED; } while (0)
#define DB_SCHED __builtin_amdgcn_sched_barrier(0)
    Unit cur, nxt; int ui = 0;
    if (!S.next(0, cur)) return;
    f32x4 acc[2][2][4][2]; typename Epi::Pre pre;
    E.prefetch(pre, cur, wc, fq); E.init(acc, pre);
    v6i32 A0[4], A1[4], B0[2], B1[2];
    const int sc_w = 121, sc_a = 126;
    if (wid >= 4) __builtin_amdgcn_s_setprio(1);
    DB_AOFF(vc, 0);
    DB_STAGEB(DB_SB(0, 0), cur.B0); DB_STAGEA(DB_SA(0, 0), cur.A, vc[0]); DB_STAGEB(DB_SB(0, 1), cur.B1); DB_STAGEA(DB_SA(0, 1), cur.A, vc[1]);
    DB_STAGEB(DB_SB(1, 0), cur.B0 + kstep); DB_STAGEA(DB_SA(1, 0), cur.A + kstep, vc[0]); DB_STAGEB(DB_SB(1, 1), cur.B1 + kstep); DB_STAGEA(DB_SA(1, 1), cur.A + kstep, vc[1]);
    DB_SYNC();
    DB_LDB(B0, 0, 0); DB_LDB(B1, 0, 1); DB_LDA(A0, 0, 0); DB_SCHED;
    for (;;) {
        const bool has_next = S.next(ui + 1, nxt);
        const char* nA = has_next ? nxt.A : cur.A; const char* nB0 = has_next ? nxt.B0 : cur.B0; const char* nB1 = has_next ? nxt.B1 : cur.B1;
#pragma nounroll
        for (int t = 0; t < nt; t += 2) {
            const bool last = (t == nt - 2);
            const char* a2 = last ? nA : cur.A + (size_t)(t + 2) * kstep;
            const char* b20 = last ? nB0 : cur.B0 + (size_t)(t + 2) * kstep; const char* b21 = last ? nB1 : cur.B1 + (size_t)(t + 2) * kstep;
            const char* a3 = a2 + kstep; const char* b30 = b20 + kstep; const char* b31 = b21 + kstep;
            if (last && has_next) DB_AOFF(vc, ui + 1);
            DB_SYNC(); DB_LDA(A1, 0, 1); DB_SCHED; DB_STEP(0, A0, DB_SB(0, 0), DB_SA(0, 0), b20, a2, vc[0]);
            DB_SYNC6(); DB_LDA(A0, 1, 0); DB_SCHED; DB_STEP(1, A1, DB_SB(0, 1), DB_SA(0, 1), b21, a2, vc[1]); DB_LDB(B0, 1, 0); DB_LDB(B1, 1, 1); DB_SCHED;
            DB_SYNC(); DB_LDA(A1, 1, 1); DB_SCHED; DB_STEP(0, A0, DB_SB(1, 0), DB_SA(1, 0), b30, a3, vc[0]);
            DB_SYNC6(); if (!last) DB_LDA(A0, 0, 0); DB_SCHED; DB_STEP(1, A1, DB_SB(1, 1), DB_SA(1, 1), b31, a3, vc[1]); if (!last) { DB_LDB(B0, 0, 0); DB_LDB(B1, 0, 1); } DB_SCHED;
        }
        asm volatile("s_nop 15\n\ts_nop 15\n\ts_nop 15\n\ts_nop 15" ::: "memory");
        { const unsigned _l = (unsigned)__builtin_amdgcn_mbcnt_hi(~0u, __builtin_amdgcn_mbcnt_lo(~0u, 0u)); if (has_next) E.prefetch(pre, nxt, wc, (int)(_l >> 4)); E(acc, cur, wr, wc, (int)(_l & 15u), (int)(_l >> 4)); }
        if (!has_next) break;
        E.init(acc, pre);
        cur = nxt; ++ui;
        DB_LDB(B0, 0, 0); DB_LDB(B1, 0, 1); DB_LDA(A0, 0, 0); DB_SCHED;
    }
    asm volatile("s_waitcnt vmcnt(0) lgkmcnt(0)" ::: "memory");
    __builtin_amdgcn_s_setprio(0);
    __builtin_amdgcn_s_barrier();
#undef DB_AOFF
#undef DB_SA
#undef DB_SB
#undef DB_STAGEA
#undef DB_STAGEB
#undef DB_LDA
#undef DB_LDB
#undef DB_MMA
#undef DB_SYNC
#undef DB_SYNC6
#undef DB_STEP
#undef DB_MMA4
#undef DB_STAGEA1
#undef DB_STAGEB1
#undef DB_SCHED
}

typedef f32x4 Acc[2][2][4][2];

struct EpiProj {
    static constexpr bool PERM = true, KEEPS = false;
    bf16_t* O; const float* bgate;
    __device__ __forceinline__ void operator()(Acc& acc, const Unit& u, int wr, int wc, int fr, int fq) const {
        const int row0 = u.r0 + wr * 64 + fr, col0 = u.c0 + wc * 32 + 8 * fq; const bool gate = u.c0 >= INW;
        f32x4 bv[2][2];
#pragma unroll
        for (int bj = 0; bj < 2; ++bj)
#pragma unroll
            for (int n = 0; n < 2; ++n) bv[bj][n] = gate ? *(const f32x4*)(bgate + (col0 - INW) + bj * HALF + 4 * n) : (f32x4){0.f, 0.f, 0.f, 0.f};
#pragma unroll
        for (int ai = 0; ai < 2; ++ai)
#pragma unroll
            for (int m = 0; m < 4; ++m) { bf16_t* rowp = O + (size_t)(row0 + ai * HALF + m * 16) * NP1 + col0;
#pragma unroll
                for (int bj = 0; bj < 2; ++bj) { f32x4 v0 = acc[ai][bj][m][0] + bv[bj][0], v1 = acc[ai][bj][m][1] + bv[bj][1];
                    if (gate) {
#pragma unroll
                        for (int j = 0; j < 4; ++j) { v0[j] = sigmoidf_fast(v0[j]); v1[j] = sigmoidf_fast(v1[j]); } }
                    u32x4 w; w.x = cvt_pk_bf16(v0[0], v0[1]); w.y = cvt_pk_bf16(v0[2], v0[3]); w.z = cvt_pk_bf16(v1[0], v1[1]); w.w = cvt_pk_bf16(v1[2], v1[3]);
                    *(u32x4*)(rowp + bj * HALF) = w; } }
    }
};
struct EpiBf16 {
    static constexpr bool PERM = true, KEEPS = false;
    bf16_t* O; int ldc; const float* cscale;
    __device__ __forceinline__ void operator()(Acc& acc, const Unit& u, int wr, int wc, int fr, int fq) const {
        const int row0 = u.r0 + wr * 64 + fr, col0 = u.c0 + wc * 32 + 8 * fq;
#pragma unroll
        for (int bj = 0; bj < 2; ++bj) {
            const f32x4 s0 = cscale ? *(const f32x4*)(cscale + col0 + bj * HALF) : (f32x4){1.f, 1.f, 1.f, 1.f}, s1 = cscale ? *(const f32x4*)(cscale + col0 + bj * HALF + 4) : (f32x4){1.f, 1.f, 1.f, 1.f};
#pragma unroll
            for (int ai = 0; ai < 2; ++ai)
#pragma unroll
                for (int m = 0; m < 4; ++m) { bf16_t* rowp = O + (size_t)(row0 + ai * HALF + m * 16) * ldc + col0;
                    const f32x4 v0 = acc[ai][bj][m][0] * s0, v1 = acc[ai][bj][m][1] * s1;
                    u32x4 w; w.x = cvt_pk_bf16(v0[0], v0[1]); w.y = cvt_pk_bf16(v0[2], v0[3]); w.z = cvt_pk_bf16(v1[0], v1[1]); w.w = cvt_pk_bf16(v1[2], v1[3]);
                    *(u32x4*)(rowp + bj * HALF) = w; } }
    }
};
struct EpiBranch {
    static constexpr bool PERM = true, KEEPS = true;
    const bf16_t* PG; bf16_t* MG;
    __device__ __forceinline__ bool keep(const Unit& u) const { return u.x == 0; }
    __device__ __forceinline__ void operator()(Acc& acc, const Unit& u, int wr, int wc, int fr, int fq) const {
        const int row0 = u.r0 + wr * 64 + fr, col0 = u.c0 + wc * 32 + 8 * fq; const int br = u.x;
#pragma unroll
        for (int ai = 0; ai < 2; ++ai)
#pragma unroll
            for (int m = 0; m < 4; ++m) { const size_t row = (size_t)(row0 + ai * HALF + m * 16);
#pragma unroll
                for (int bj = 0; bj < 2; ++bj) { const int col = col0 + bj * HALF;
                    const u32x4 gb = *(const u32x4*)(PG + row * NP1 + INW + D + col);
                    f32x4 h0 = {bf_lo(gb.x), bf_hi(gb.x), bf_lo(gb.y), bf_hi(gb.y)}, h1 = {bf_lo(gb.z), bf_hi(gb.z), bf_lo(gb.w), bf_hi(gb.w)};
#pragma unroll
                    for (int j = 0; j < 4; ++j) { h0[j] = fmaxf(h0[j], 1e-30f); h1[j] = fmaxf(h1[j], 1e-30f); }
                    if (br == 0) { const u32x4 ga = *(const u32x4*)(PG + row * NP1 + INW + col);
                        const f32x4 a0 = {bf_lo(ga.x), bf_hi(ga.x), bf_lo(ga.y), bf_hi(ga.y)}, a1 = {bf_lo(ga.z), bf_hi(ga.z), bf_lo(ga.w), bf_hi(ga.w)};
#pragma unroll
                        for (int j = 0; j < 4; ++j) { acc[ai][bj][m][0][j] *= a0[j] * __builtin_amdgcn_rcpf(h0[j]); acc[ai][bj][m][1][j] *= a1[j] * __builtin_amdgcn_rcpf(h1[j]); } }
                    else { const f32x4 v0 = acc[ai][bj][m][0] * h0, v1 = acc[ai][bj][m][1] * h1;
                        u32x4 w; w.x = cvt_pk_bf16(v0[0], v0[1]); w.y = cvt_pk_bf16(v0[2], v0[3]); w.z = cvt_pk_bf16(v1[0], v1[1]); w.w = cvt_pk_bf16(v1[2], v1[3]);
                        *(u32x4*)(MG + row * D + col) = w; } } }
    }
};
struct EpiResid {
    static constexpr bool PERM = false, KEEPS = false;
    const float* res; float* out; int ldc;
    __device__ __forceinline__ void operator()(Acc& acc, const Unit& u, int wr, int wc, int fr, int fq) const {
        const int row0 = u.r0 + wr * 64 + fr, col0 = u.c0 + wc * 32 + 4 * fq;
#pragma unroll
        for (int ai = 0; ai < 2; ++ai) {
            f32x4 r[4][2][2];
#pragma unroll
            for (int m = 0; m < 4; ++m) { const size_t off = (size_t)(row0 + ai * HALF + m * 16) * ldc + col0;
#pragma unroll
                for (int bj = 0; bj < 2; ++bj)
#pragma unroll
                    for (int n = 0; n < 2; ++n) r[m][bj][n] = *(const f32x4*)(res + off + bj * HALF + n * 16); }
            asm volatile("" ::: "memory");
#pragma unroll
            for (int m = 0; m < 4; ++m) { const size_t off = (size_t)(row0 + ai * HALF + m * 16) * ldc + col0;
#pragma unroll
                for (int bj = 0; bj < 2; ++bj)
#pragma unroll
                    for (int n = 0; n < 2; ++n) *(f32x4*)(out + off + bj * HALF + n * 16) = r[m][bj][n] + acc[ai][bj][m][n]; }
            asm volatile("" ::: "memory"); }
    }
};
struct EpiUp {
    static constexpr bool PERM = true, KEEPS = false;
    const float* bup; unsigned char* ACT;
    struct Pre { f32x4 bg[2], bl[2]; };
    __device__ __forceinline__ void prefetch(Pre& p, const Unit& u, int wc, int fq) const {
        const float* be = bup + (size_t)u.x * (2 * DFF) + u.c0 * HALF + wc * 32 + 8 * fq;
#pragma unroll
        for (int n = 0; n < 2; ++n) { p.bg[n] = *(const f32x4*)(be + 4 * n); p.bl[n] = *(const f32x4*)(be + DFF + 4 * n) + 1.0f; }
    }
    __device__ __forceinline__ void init(Acc& acc, const Pre& p) const {
#pragma unroll
        for (int ai = 0; ai < 2; ++ai)
#pragma unroll
            for (int m = 0; m < 4; ++m)
#pragma unroll
                for (int n = 0; n < 2; ++n) { acc[ai][0][m][n] = p.bg[n]; acc[ai][1][m][n] = p.bl[n]; }
    }
    __device__ __forceinline__ void operator()(Acc& acc, const Unit& u, int wr, int wc, int fr, int fq) const {
        const int row0 = u.r0 + wr * 64 + fr, col0 = u.c0 * HALF + wc * 32 + 8 * fq;
        typedef float f32x2v __attribute__((ext_vector_type(2)));
#pragma unroll
        for (int ai = 0; ai < 2; ++ai)
#pragma unroll
            for (int m = 0; m < 4; ++m) { unsigned char* rowp = ACT + (size_t)(row0 + ai * HALF + m * 16) * DFF + col0; f32x4 o[2];
#pragma unroll
                for (int n = 0; n < 2; ++n) { const f32x4 gv = acc[ai][0][m][n], lv = acc[ai][1][m][n];
#pragma unroll
                    for (int j = 0; j < 4; j += 2) {
                        const f32x2v g = {__builtin_amdgcn_fmed3f(gv[j], -3.0e38f, 7.0f), __builtin_amdgcn_fmed3f(gv[j + 1], -3.0e38f, 7.0f)}, l = {__builtin_amdgcn_fmed3f(lv[j], -6.0f, 8.0f), __builtin_amdgcn_fmed3f(lv[j + 1], -6.0f, 8.0f)};
                        const f32x2v t = g * -2.4554669595930156f; const f32x2v e = {__builtin_amdgcn_exp2f(t.x), __builtin_amdgcn_exp2f(t.y)}; const f32x2v d = e + 1.0f;
                        const f32x2v r = {__builtin_amdgcn_rcpf(d.x), __builtin_amdgcn_rcpf(d.y)}; const f32x2v q = (g * l) * r; o[n][j] = q.x; o[n][j + 1] = q.y; } }
                u32x2 w; w.x = pk4_fp8(o[0][0], o[0][1], o[0][2], o[0][3]); w.y = pk4_fp8(o[1][0], o[1][1], o[1][2], o[1][3]);
                *(u32x2*)rowp = w; }
    }
};
struct EpiDown {
    static constexpr bool PERM = true, KEEPS = false;
    const float* bdn; const int* rslot; const float* gate; unsigned char* SLOT;
    __device__ __forceinline__ void operator()(Acc& acc, const Unit& u, int wr, int wc, int fr, int fq) const {
        const int row0 = u.r0 + wr * 64 + fr, col0 = u.c0 * BM + wc * 32 + 8 * fq; const float* be = bdn + (size_t)u.x * D;
        int sl[2][4]; float gt[2][4];
#pragma unroll
        for (int ai = 0; ai < 2; ++ai)
#pragma unroll
            for (int m = 0; m < 4; ++m) sl[ai][m] = rslot[row0 + ai * HALF + m * 16];
#pragma unroll
        for (int ai = 0; ai < 2; ++ai)
#pragma unroll
            for (int m = 0; m < 4; ++m) gt[ai][m] = gate[sl[ai][m] < 0 ? 0 : sl[ai][m]] * 16.0f;
        f32x4 bv[2][2];
#pragma unroll
        for (int bj = 0; bj < 2; ++bj)
#pragma unroll
            for (int n = 0; n < 2; ++n) bv[bj][n] = *(const f32x4*)(be + col0 + bj * HALF + 4 * n);
#pragma unroll
        for (int ai = 0; ai < 2; ++ai)
#pragma unroll
            for (int m = 0; m < 4; ++m) {
                if (sl[ai][m] >= 0) { const float g = gt[ai][m]; unsigned char* rowp = SLOT + (size_t)sl[ai][m] * D + col0;
#pragma unroll
                    for (int bj = 0; bj < 2; ++bj) { const f32x4 v0 = (acc[ai][bj][m][0] + bv[bj][0]) * g, v1 = (acc[ai][bj][m][1] + bv[bj][1]) * g;
                        u32x2 w; w.x = pk4_fp8(v0[0], v0[1], v0[2], v0[3]); w.y = pk4_fp8(v1[0], v1[1], v1[2], v1[3]);
                        *(u32x2*)(rowp + bj * HALF) = w; } } }
    }
};
}

struct Frame {
    LAS unsigned char* lds;
    int tid, lane, wave, vcu, G;
};

__device__ __forceinline__ void cvt_item_addr(const float* W, int K, int N, bf16_t* WT, int row_off, int item, int lane, const float*& src, bf16_t*& dst) {
    const int nblk = N >> 5, kb = item / nblk, nb = item - kb * nblk, kl = lane >> 3, nl = lane & 7;
    src = W + (size_t)(64 * kb + 8 * kl) * N + 32 * nb + 4 * nl; dst = WT + (size_t)(row_off + 32 * nb + 4 * nl) * K + 64 * kb + 8 * kl;
}
__device__ __forceinline__ void cvt_store(const f32x4 (&v)[8], bf16_t* dst, int K) {
#pragma unroll
    for (int i = 0; i < 4; ++i) { u32x4 o; o.x = cvt_pk_bf16(v[0][i], v[1][i]); o.y = cvt_pk_bf16(v[2][i], v[3][i]); o.z = cvt_pk_bf16(v[4][i], v[5][i]); o.w = cvt_pk_bf16(v[6][i], v[7][i]);
        *(u32x4*)(dst + (size_t)i * K) = o; }
}
__device__ __forceinline__ void cvt_store8(const f32x4 (&v)[8], unsigned char* dst, int K) {
#pragma unroll
    for (int i = 0; i < 4; ++i) { u32x2 o; o.x = pk4_fp8(v[0][i] * 64.f, v[1][i] * 64.f, v[2][i] * 64.f, v[3][i] * 64.f); o.y = pk4_fp8(v[4][i] * 64.f, v[5][i] * 64.f, v[6][i] * 64.f, v[7][i] * 64.f);
        *(u32x2*)(dst + (size_t)i * K) = o; }
}
__device__ __forceinline__ void cvt_range(const float* W, int K, int N, bf16_t* WT, int row_off, int i0, int cnt, int r, int nw, int lane) {
    int it = i0 + r; const int end = i0 + cnt;
    for (; it + nw < end; it += 2 * nw) {
        const float* s0; bf16_t* d0; const float* s1; bf16_t* d1;
        cvt_item_addr(W, K, N, WT, row_off, it, lane, s0, d0); cvt_item_addr(W, K, N, WT, row_off, it + nw, lane, s1, d1);
        f32x4 a[8], b[8];
#pragma unroll
        for (int j = 0; j < 8; ++j) a[j] = *(const f32x4*)(s0 + (size_t)j * N);
#pragma unroll
        for (int j = 0; j < 8; ++j) b[j] = *(const f32x4*)(s1 + (size_t)j * N);
        cvt_store(a, d0, K); cvt_store(b, d1, K);
    }
    if (it < end) { const float* s0; bf16_t* d0; cvt_item_addr(W, K, N, WT, row_off, it, lane, s0, d0); f32x4 a[8];
#pragma unroll
        for (int j = 0; j < 8; ++j) a[j] = *(const f32x4*)(s0 + (size_t)j * N);
        cvt_store(a, d0, K); }
}
constexpr int CV_UP = NE * (D / 64) * (2 * DFF / 32), CV_DN = NE * (DFF / 64) * (D / 32), CV_ALL = CV_UP + CV_DN;
struct MoeW { const float* w_up; const float* w_down; unsigned char* WUPT; unsigned char* WDNT; };
__device__ __forceinline__ void cvt_moe_addr(const MoeW& mw, int chunk, int w, int h, int lane, const float*& src, unsigned char*& dst, int& N) {
    const int kl = lane >> 3, nl = lane & 7;
    if (chunk < CV_UP / 64) { const int e = chunk >> 6, cc = chunk & 63, kb = 8 * (cc >> 4) + w, nb = 8 * (cc & 15) + h; N = 2 * DFF;
        src = mw.w_up + (size_t)e * D * 2 * DFF + (size_t)(64 * kb + 8 * kl) * (2 * DFF) + 32 * nb + 4 * nl; dst = mw.WUPT + (size_t)e * 2 * DFF * D + (size_t)(32 * nb + 4 * nl) * D + 64 * kb + 8 * kl; }
    else { const int q = chunk - CV_UP / 64, e = q >> 5, cc = q & 31, kb = 8 * (cc >> 3) + w, nb = 8 * (cc & 7) + h; N = D;
        src = mw.w_down + (size_t)e * DFF * D + (size_t)(64 * kb + 8 * kl) * D + 32 * nb + 4 * nl; dst = mw.WDNT + (size_t)e * D * DFF + (size_t)(32 * nb + 4 * nl) * DFF + 64 * kb + 8 * kl; }
}
__device__ __forceinline__ f32x4 ld_nt(const float* p) { return __builtin_nontemporal_load((const f32x4*)p); }
constexpr int CV_WG = 64;
__device__ __forceinline__ int cvt_claim(unsigned* cursor, int cap, unsigned* done, unsigned need) {
    if (done && __hip_atomic_load(done, __ATOMIC_RELAXED, __HIP_MEMORY_SCOPE_AGENT) >= need) return CV_ALL;
    if ((int)__hip_atomic_load(cursor, __ATOMIC_RELAXED, __HIP_MEMORY_SCOPE_AGENT) >= cap) return CV_ALL;
    return (int)__hip_atomic_fetch_add(cursor, (unsigned)CV_WG, __ATOMIC_RELAXED, __HIP_MEMORY_SCOPE_AGENT);
}
__device__ __forceinline__ void cvt_pull(const MoeW& mw, unsigned* cursor, int cap, unsigned* done, unsigned need, volatile LAS int* slot, int tid, int wave, int lane) {
    __syncthreads();
    if (tid == 0) *slot = cvt_claim(cursor, cap, done, need);
    __syncthreads();
    int base = __builtin_amdgcn_readfirstlane(*slot);
    while (base < CV_ALL) {
        int nb = CV_ALL; if (tid == 0) nb = cvt_claim(cursor, cap, done, need);
        const int chunk = base >> 6;
        if (chunk < CV_UP / 64) {
            const int e = chunk >> 6, cc = chunk & 63, nb = 8 * (cc & 15) + wave, kl = lane >> 3, nl = lane & 7;
#pragma unroll 1
            for (int q = 0; q < 2; ++q) { const int kq = 2 * (cc >> 4) + q, kb32 = 8 * kq + kl;
                const float* src = mw.w_up + (size_t)e * D * 2 * DFF + (size_t)(32 * kb32) * (2 * DFF) + 32 * nb + 4 * nl;
                f32x4 a[32];
#pragma unroll
                for (int j = 0; j < 32; ++j) a[j] = ld_nt(src + (size_t)j * (2 * DFF));
                unsigned char* dst = mw.WUPT + (size_t)e * 2 * DFF * D + (size_t)(32 * nb + 4 * nl) * D + 128 * (kb32 >> 2) + 16 * (kb32 & 3);
#pragma unroll
                for (int i = 0; i < 4; ++i) { f32x16 lo, hi;
#pragma unroll
                    for (int j = 0; j < 16; ++j) { lo[j] = a[j][i] * 64.f; hi[j] = a[16 + j][i] * 64.f; }
                    st_fp6_block(dst + (size_t)i * D, pk32_fp6(lo, hi)); } }
        } else
#pragma unroll
        for (int h = 0; h < 8; h += 4) {
            const float* s0; unsigned char* d0; const float* s1; unsigned char* d1; const float* s2; unsigned char* d2; const float* s3; unsigned char* d3; int N0, N1, N2, N3;
            cvt_moe_addr(mw, chunk, wave, h, lane, s0, d0, N0); cvt_moe_addr(mw, chunk, wave, h + 1, lane, s1, d1, N1); cvt_moe_addr(mw, chunk, wave, h + 2, lane, s2, d2, N2); cvt_moe_addr(mw, chunk, wave, h + 3, lane, s3, d3, N3);
            f32x4 a[8], b[8], c[8], d[8];
#pragma unroll
            for (int j = 0; j < 8; ++j) a[j] = ld_nt(s0 + (size_t)j * N0);
#pragma unroll
            for (int j = 0; j < 8; ++j) b[j] = ld_nt(s1 + (size_t)j * N1);
#pragma unroll
            for (int j = 0; j < 8; ++j) c[j] = ld_nt(s2 + (size_t)j * N2);
#pragma unroll
            for (int j = 0; j < 8; ++j) d[j] = ld_nt(s3 + (size_t)j * N3);
            cvt_store8(a, d0, D); cvt_store8(b, d1, D); cvt_store8(c, d2, D); cvt_store8(d, d3, D);
        }
        __syncthreads();
        if (tid == 0) *slot = nb;
        __syncthreads();
        base = __builtin_amdgcn_readfirstlane(*slot);
    }
}
__device__ __forceinline__ void rms_row_to_bf16(const float* xrow, const float* gvec, bf16_t* orow, int lane) {
    const f32x4* xr = (const f32x4*)xrow + lane; f32x4 v[8]; float s = 0.f;
#pragma unroll
    for (int j = 0; j < 8; ++j) { v[j] = xr[64 * j]; s += (v[j].x * v[j].x + v[j].y * v[j].y) + (v[j].z * v[j].z + v[j].w * v[j].w); }
    const float rstd = 1.0f / sqrtf(wave_sum(s) * (1.0f / D) + RMS_EPS);
    const f32x4* gr = (const f32x4*)gvec + lane; u32x2* o8 = (u32x2*)orow + lane;
#pragma unroll
    for (int j = 0; j < 8; ++j) { const f32x4 g = gr[64 * j]; const f32x4 y = v[j] * rstd * g; u32x2 w; w.x = cvt_pk_bf16(y.x, y.y); w.y = cvt_pk_bf16(y.z, y.w); o8[64 * j] = w; }
}

__device__ __forceinline__ unsigned voff_b(unsigned row, unsigned ch) { return 256u * row + 16u * (ch ^ (((row & 3u) << 2) | ((row >> 2) & 3u))); }
__device__ __forceinline__ s16x4 vtr(const LAS unsigned char* p) { return __builtin_bit_cast(s16x4, __builtin_amdgcn_ds_read_tr16_b64_v4i16((LAS s16x4*)p)); }

__device__ __forceinline__ void sb_wg_unit(const bf16_t* PG, bf16_t* OA, int h, int qb, LAS unsigned char* lds, volatile LAS int* flags, int tid, int wave, int lane) {
    const int fr = lane & 15, fq = lane >> 4, q0w = qb * 128 + wave * 16, qi = q0w + fr;
    bf16x8 Qf[4];
    { const bf16_t* qp = PG + (size_t)qi * NP1 + h * HD + 8 * fq;
#pragma unroll
      for (int ks = 0; ks < 4; ++ks) Qf[ks] = *(const bf16x8*)(qp + 32 * ks); }
    f32x4 O[8];
#pragma unroll
    for (int db = 0; db < 8; ++db) O[db] = (f32x4){0.f, 0.f, 0.f, 0.f};
    float carry = 0.f; bool sat = false;
    const float scale = 0.08838834764831845f;
    const unsigned p = fr & 3, qq = fr >> 2;
    const int jt_hi = 2 * qb + 1, jt_w = q0w >> 6;
    const int srow = tid >> 4, sch = tid & 15;
    const bf16_t* kg = PG + (size_t)srow * NP1 + SBW + h * HD + 8 * sch;
    u32x4 kr[2], vr[2];
    __syncthreads();
    if (tid < 8) flags[tid] = 0;
    { const bf16_t* g = kg + (size_t)(jt_hi * 64) * NP1;
#pragma unroll
      for (int i = 0; i < 2; ++i) { kr[i] = *(const u32x4*)(g + (size_t)(32 * i) * NP1); vr[i] = *(const u32x4*)(g + (size_t)(32 * i) * NP1 + SBW); } }
    for (int jt = jt_hi, it = 0; jt >= 0; --jt, ++it) {
        LAS unsigned char* kb = lds + (it & 1) * 32768; LAS unsigned char* vb = kb + 16384;
#pragma unroll
        for (int i = 0; i < 2; ++i) { *(LAS u32x4*)(kb + voff_b(srow + 32 * i, sch)) = kr[i]; *(LAS u32x4*)(vb + voff_b(srow + 32 * i, sch)) = vr[i]; }
        __syncthreads();
        { int ns = 0;
#pragma unroll
          for (int w = 0; w < 8; ++w) ns += flags[w];
          if (__builtin_amdgcn_readfirstlane(ns) == 8) break; }
        if (jt > 0) { const bf16_t* g = kg + (size_t)((jt - 1) * 64) * NP1;
#pragma unroll
            for (int i = 0; i < 2; ++i) { kr[i] = *(const u32x4*)(g + (size_t)(32 * i) * NP1); vr[i] = *(const u32x4*)(g + (size_t)(32 * i) * NP1 + SBW); } }
        if (!sat && jt <= jt_w) {
            const int key0 = jt * 64;
            f32x4 z[4];
#pragma unroll
            for (int sb = 0; sb < 4; ++sb) { z[sb] = (f32x4){0.f, 0.f, 0.f, 0.f};
#pragma unroll
                for (int ks = 0; ks < 4; ++ks) { const bf16x8 kf = *(const LAS bf16x8*)(kb + voff_b(16 * sb + fr, 4 * ks + fq)); z[sb] = __builtin_amdgcn_mfma_f32_16x16x32_bf16(kf, Qf[ks], z[sb], 0, 0, 0); } }
            float sfx[4][4], g[4], lex[4], T[4];
            const bool diag = key0 + 64 > q0w;
#pragma unroll
            for (int sb = 0; sb < 4; ++sb) {
                float sp[4];
#pragma unroll
                for (int i = 0; i < 4; ++i) { const float y = z[sb][i] * (scale * 1.4426950408889634f); z[sb][i] = y;
                    sp[i] = fmaxf(y, 0.f) + __builtin_amdgcn_logf(1.0f + __builtin_amdgcn_exp2f(-fabsf(y))); }
                if (diag) {
#pragma unroll
                    for (int i = 0; i < 4; ++i) { const int key = key0 + 16 * sb + 4 * fq + i; sp[i] = (key < qi) ? sp[i] : 0.f; } }
                sfx[sb][3] = sp[3]; sfx[sb][2] = sp[2] + sfx[sb][3]; sfx[sb][1] = sp[1] + sfx[sb][2]; sfx[sb][0] = sp[0] + sfx[sb][1]; g[sb] = sfx[sb][0];
            }
#pragma unroll
            for (int sb = 0; sb < 4; ++sb) { const float x1 = __shfl_xor(g[sb], 16), x2 = __shfl_xor(g[sb], 32), x3 = __shfl_xor(g[sb], 48);
                T[sb] = (g[sb] + x1) + (x2 + x3); lex[sb] = ((fq & 1) ? 0.f : x1) + ((fq < 2) ? (x2 + x3) : 0.f); }
            float run = carry; bf16x8 Wf[2]; unsigned wpk[8];
#pragma unroll
            for (int sb = 3; sb >= 0; --sb) { const float base = run + lex[sb]; float w[4];
#pragma unroll
                for (int i = 0; i < 4; ++i) w[i] = __builtin_amdgcn_exp2f(z[sb][i] - (base + sfx[sb][i]));
                if (diag) {
#pragma unroll
                    for (int i = 0; i < 4; ++i) { const int key = key0 + 16 * sb + 4 * fq + i; w[i] = (key < qi) ? w[i] : 0.f; } }
                wpk[2 * sb] = cvt_pk_bf16(w[0], w[1]); wpk[2 * sb + 1] = cvt_pk_bf16(w[2], w[3]); run += T[sb]; }
            carry = run;
            { u32x4 a = {wpk[0], wpk[1], wpk[2], wpk[3]}, b = {wpk[4], wpk[5], wpk[6], wpk[7]}; Wf[0] = __builtin_bit_cast(bf16x8, a); Wf[1] = __builtin_bit_cast(bf16x8, b); }
#pragma unroll
            for (int db = 0; db < 8; ++db)
#pragma unroll
                for (int m = 0; m < 2; ++m) { const unsigned r1 = 32 * m + 4 * fq + qq, r2 = r1 + 16;
                    const s16x4 lo = vtr(vb + voff_b(r1, 2 * db + (p >> 1)) + 8 * (p & 1)), hi = vtr(vb + voff_b(r2, 2 * db + (p >> 1)) + 8 * (p & 1));
                    const bf16x8 vf = {lo[0], lo[1], lo[2], lo[3], hi[0], hi[1], hi[2], hi[3]};
                    O[db] = __builtin_amdgcn_mfma_f32_16x16x32_bf16(vf, Wf[m], O[db], 0, 0, 0); }
            if (__all(carry > 150.1f)) { sat = true; if (lane == 0) flags[wave] = 1; }
        }
    }
    { bf16_t* op = OA + (size_t)qi * SBW + h * HD + 4 * fq;
#pragma unroll
      for (int db = 0; db < 8; ++db) { u32x2 w; w.x = cvt_pk_bf16(O[db][0], O[db][1]); w.y = cvt_pk_bf16(O[db][2], O[db][3]); *(u32x2*)(op + 16 * db) = w; } }
}

__device__ __forceinline__ void xa_unit(const bf16_t* QXA, const bf16_t* KVM, bf16_t* OXA, int h, int qb, const LAS unsigned char* vl, int lane) {
    const int fr = lane & 15, fq = lane >> 4, q0 = qb * 16, qi = q0 + fr;
    bf16x8 Qf[4];
    { const bf16_t* qp = QXA + (size_t)qi * XAW + h * HD + 8 * fq;
#pragma unroll
      for (int ks = 0; ks < 4; ++ks) Qf[ks] = *(const bf16x8*)(qp + 32 * ks); }
    f32x4 z[16];
    { const bf16_t* kp = KVM + (size_t)fr * (2 * XAW) + h * HD + 8 * fq;
#pragma unroll
      for (int sb = 0; sb < 16; ++sb) { z[sb] = (f32x4){0.f, 0.f, 0.f, 0.f};
#pragma unroll
          for (int ks = 0; ks < 4; ++ks) { const bf16x8 kf = *(const bf16x8*)(kp + (size_t)(16 * sb) * (2 * XAW) + 32 * ks); z[sb] = __builtin_amdgcn_mfma_f32_16x16x32_bf16(kf, Qf[ks], z[sb], 0, 0, 0); } } }
    const float scale = 0.08838834764831845f * 1.4426950408889634f;
    float mx = -3.0e38f;
#pragma unroll
    for (int sb = 0; sb < 16; ++sb)
#pragma unroll
        for (int i = 0; i < 4; ++i) { z[sb][i] *= scale; mx = fmaxf(mx, z[sb][i]); }
    mx = fmaxf(mx, __shfl_xor(mx, 16)); mx = fmaxf(mx, __shfl_xor(mx, 32));
    float sum = 0.f;
#pragma unroll
    for (int sb = 0; sb < 16; ++sb)
#pragma unroll
        for (int i = 0; i < 4; ++i) { const float e = __builtin_amdgcn_exp2f(z[sb][i] - mx); z[sb][i] = e; sum += e; }
    sum += __shfl_xor(sum, 16); sum += __shfl_xor(sum, 32);
    const float inv = 1.0f / sum;
    f32x4 O[8];
#pragma unroll
    for (int db = 0; db < 8; ++db) O[db] = (f32x4){0.f, 0.f, 0.f, 0.f};
    const unsigned p = fr & 3, qq = fr >> 2;
#pragma unroll
    for (int m = 0; m < 8; ++m) {
        u32x4 a = {cvt_pk_bf16(z[2 * m][0], z[2 * m][1]), cvt_pk_bf16(z[2 * m][2], z[2 * m][3]), cvt_pk_bf16(z[2 * m + 1][0], z[2 * m + 1][1]), cvt_pk_bf16(z[2 * m + 1][2], z[2 * m + 1][3])};
        const bf16x8 Wf = __builtin_bit_cast(bf16x8, a);
#pragma unroll
        for (int db = 0; db < 8; ++db) { const unsigned r1 = 32 * m + 4 * fq + qq, r2 = r1 + 16;
            const s16x4 lo = vtr(vl + voff_b(r1, 2 * db + (p >> 1)) + 8 * (p & 1)), hi = vtr(vl + voff_b(r2, 2 * db + (p >> 1)) + 8 * (p & 1));
            const bf16x8 vf = {lo[0], lo[1], lo[2], lo[3], hi[0], hi[1], hi[2], hi[3]};
            O[db] = __builtin_amdgcn_mfma_f32_16x16x32_bf16(vf, Wf, O[db], 0, 0, 0); }
    }
    { bf16_t* op = OXA + (size_t)qi * XAW + h * HD + 4 * fq;
#pragma unroll
      for (int db = 0; db < 8; ++db) { const f32x4 o = O[db] * inv; u32x2 w; w.x = cvt_pk_bf16(o[0], o[1]); w.y = cvt_pk_bf16(o[2], o[3]); *(u32x2*)(op + 16 * db) = w; } }
}

template <int W>
__device__ __forceinline__ void pool_run(const bf16_t* PG, bf16_t* PO, int t0, int ch) {
    constexpr int NR = W + 7;
    const bf16_t* pp = PG + (size_t)(t0 + 7) * NP1 + 3 * SBW + ch * 8;
    u32x4 v[NR];
#pragma unroll
    for (int k = 0; k < NR; ++k) v[k] = (t0 + 7 - k >= 0) ? *(const u32x4*)(pp - (size_t)k * NP1) : (u32x4){0u, 0u, 0u, 0u};
#pragma unroll
    for (int i = 0; i < 8; ++i) {
        float s[8];
#pragma unroll
        for (int j = 0; j < 8; ++j) s[j] = 0.f;
#pragma unroll
        for (int j = W - 1; j >= 0; --j) { const u32x4 x = v[7 - i + j];
            s[0] += bf_lo(x.x); s[1] += bf_hi(x.x); s[2] += bf_lo(x.y); s[3] += bf_hi(x.y); s[4] += bf_lo(x.z); s[5] += bf_hi(x.z); s[6] += bf_lo(x.w); s[7] += bf_hi(x.w); }
        const int t = t0 + i, n = (t + 1 < W) ? (t + 1) : W; const float inv = 1.0f / (float)n; const u32x4 me = v[7 - i]; u32x4 o;
        o.x = cvt_pk_bf16(s[0] * inv - bf_lo(me.x), s[1] * inv - bf_hi(me.x)); o.y = cvt_pk_bf16(s[2] * inv - bf_lo(me.y), s[3] * inv - bf_hi(me.y));
        o.z = cvt_pk_bf16(s[4] * inv - bf_lo(me.z), s[5] * inv - bf_hi(me.z)); o.w = cvt_pk_bf16(s[6] * inv - bf_lo(me.w), s[7] * inv - bf_hi(me.w));
        *(u32x4*)(PO + (size_t)t * POOLW + ch * 8) = o;
    }
}

constexpr int NPHASE = 15;
struct Args { const float* in[24]; float* out; unsigned char* ws; int ph_lo, ph_hi; };
static_assert(sizeof(Args) == 24 * 8 + 8 + 8 + 8, "Args has no padding");

__global__ void __launch_bounds__(NWAVES * 64, 2) moe_fwd(Args args) {
    extern __shared__ __attribute__((aligned(16))) unsigned char lds_raw[];
    Frame F;
    F.lds = (LAS unsigned char*)lds_raw;
    F.tid = threadIdx.x; F.lane = F.tid & 63; F.wave = __builtin_amdgcn_readfirstlane(F.tid >> 6);
    F.G = gridDim.x; { const int bx = blockIdx.x; F.vcu = (F.G % 8 == 0) ? (bx % 8) * (F.G / 8) + bx / 8 : bx; }
    unsigned char* ws = args.ws;
    unsigned* ctl = (unsigned*)(ws + WS_CTL);
    LAS unsigned char* lx = F.lds + LDS_X_OFF;
    for (int u = F.tid; u < (LDS_BYTES - LDS_X_OFF) / 4; u += NWAVES * 64) ((LAS unsigned*)lx)[u] = 0u;
    __syncthreads();
#if MK_ONE_LAUNCH
    XcdBarrier bar = xcd_barrier_post(ctl + CW_BAR, (volatile LAS unsigned*)(lx + LX_BAR));
#define GRID_BAR() xcd_barrier(bar)
#else
#define GRID_BAR() do {} while (0)
#endif
    const int lo = args.ph_lo, hi = args.ph_hi;
#ifndef PHASE_MASK
#define PHASE_MASK 0x7fff
#endif
#define IN(k) (((PHASE_MASK >> (k)) & 1) && lo <= (k) && (k) < hi)
#define SEAM(k) do { if (IN((k) + 1)) GRID_BAR(); } while (0)

    const float* x = args.in[0]; const float* mem = args.in[1]; const float* norm_mix = args.in[2]; const float* w_in = args.in[3]; const float* pool_lin = args.in[4];
    const float* pool_scale = args.in[5]; const float* w_branch_a = args.in[6]; const float* w_branch_b = args.in[7]; const float* w_gate = args.in[8]; const float* b_gate = args.in[9];
    const float* w_mix_out = args.in[10]; const float* xa_norm = args.in[11]; const float* mem_norm = args.in[12]; const float* xa_wq = args.in[13]; const float* xa_wkv = args.in[14];
    const float* xa_wo = args.in[15]; const float* moe_norm = args.in[16]; const float* w_router = args.in[17]; const float* b_router = args.in[18]; const float* w_up = args.in[19];
    const float* b_up = args.in[20]; const float* w_down = args.in[21]; const float* b_down = args.in[22]; const float* final_norm = args.in[23];
    bf16_t* W1T = (bf16_t*)(ws + WS_W1T); bf16_t* WAT = (bf16_t*)(ws + WS_WAT); bf16_t* WBT = (bf16_t*)(ws + WS_WBT); bf16_t* WMT = (bf16_t*)(ws + WS_WMT); bf16_t* PLT = (bf16_t*)(ws + WS_PLT);
    bf16_t* WQT = (bf16_t*)(ws + WS_WQT); bf16_t* WKVT = (bf16_t*)(ws + WS_WKVT); bf16_t* WOT = (bf16_t*)(ws + WS_WOT); unsigned char* WUPT = ws + WS_WUPT; unsigned char* WDNT = ws + WS_WDNT;
    bf16_t* U = (bf16_t*)(ws + WS_U); bf16_t* MEMN = (bf16_t*)(ws + WS_MEMN); bf16_t* PG = (bf16_t*)(ws + WS_PG); bf16_t* OA = (bf16_t*)(ws + WS_OA); bf16_t* PO = (bf16_t*)(ws + WS_PO);
    bf16_t* OB = (bf16_t*)(ws + WS_OB); float* TMP = (float*)(ws + WS_TMP); bf16_t* MG = (bf16_t*)(ws + WS_MG); float* H1 = (float*)(ws + WS_H1); bf16_t* U2 = (bf16_t*)(ws + WS_U2);
    bf16_t* QXA = (bf16_t*)(ws + WS_QXA); bf16_t* KVM = (bf16_t*)(ws + WS_KVM); bf16_t* OXA = (bf16_t*)(ws + WS_OXA); float* H2 = (float*)(ws + WS_H2); unsigned char* TB = ws + WS_TB;
    bf16_t* ROWS = (bf16_t*)(ws + WS_ROWS); unsigned char* ACT = ws + WS_ACT; unsigned char* SLOT = ws + WS_SLOT;
    int* ASGE = (int*)(ws + WS_ASGE); int* ASGP = (int*)(ws + WS_ASGP); float* GATE = (float*)(ws + WS_GATE); int* RSLOT = (int*)(ws + WS_RSLOT);
    int* CNT = (int*)(ctl + CW_CNT); bf16_t* WRT = (bf16_t*)(ws + WS_WRT);
    const int gw = F.vcu * NWAVES + F.wave, NGW = F.G * NWAVES;
    const MoeW mw{w_up, w_down, WUPT, WDNT};
    unsigned* CUR = ctl + CW_CUR; volatile LAS int* cvs = (volatile LAS int*)(lx + LX_CVS);
#define CVT_PULL(cap) cvt_pull(mw, CUR, (cap), nullptr, 0u, cvs, F.tid, F.wave, F.lane)
#define CVT_BESIDE(cap, ph, need) cvt_pull(mw, CUR, (cap), ctl + CW_DONE + 64 * (ph), (unsigned)(need), cvs, F.tid, F.wave, F.lane)
#define MARK_DONE(ph) do { if (F.tid == 0) __hip_atomic_fetch_add(ctl + CW_DONE + 64 * (ph), 1u, __ATOMIC_RELAXED, __HIP_MEMORY_SCOPE_AGENT); } while (0)

    if (IN(0)) {
        constexpr int I_IN = (D / 64) * (INW / 32), I_BR = (SBW / 64) * (D / 32), I_MX = (D / 64) * (D / 32), I_PL = (256 / 64) * (256 / 32);
        constexpr int I_Q = (D / 64) * (XAW / 32), I_KV = (D / 64) * (2 * XAW / 32), I_O = (XAW / 64) * (D / 32);
        cvt_range(w_in, D, INW, W1T, 0, 0, I_IN, gw, NGW, F.lane);
        cvt_range(w_gate, D, INW, W1T, INW, 0, I_IN, gw, NGW, F.lane);
        for (int m = gw; m < S; m += NGW) rms_row_to_bf16(x + (size_t)m * D, norm_mix, U + (size_t)m * D, F.lane);
        for (int m = gw; m < MEM; m += NGW) rms_row_to_bf16(mem + (size_t)m * D, mem_norm, MEMN + (size_t)m * D, F.lane);
        for (int i = blockIdx.x * (NWAVES * 64) + F.tid; i < NE * D / 2; i += F.G * NWAVES * 64) {
            const int e = i >> 10, c = (i & 1023) * 2; const float a = w_router[(size_t)c * NE + e], b = w_router[(size_t)(c + 1) * NE + e];
            const unsigned hi = cvt_pk_bf16(a, b); const unsigned lo = cvt_pk_bf16(a - bf_lo(hi), b - bf_hi(hi));
            *(unsigned*)(WRT + (size_t)e * D + c) = hi; *(unsigned*)(WRT + (size_t)(NE + e) * D + c) = lo; }
        __syncthreads();
        SEAM(0);
    }

    if (IN(1)) {
        const int gc = (F.G == 256) ? GC_P1 : F.G;
        if ((int)blockIdx.x < gc) {
            pg8::DenseSched Sc{(const char*)U, (const char*)W1T, D, D, S / 256, NP1 / 256, gc, (int)blockIdx.x};
            pg8::EpiProj E{PG, b_gate};
            pg8::gemm_phase<pg8::EpiProj, pg8::DenseSched, true>(F.lds, D, D, D, Sc, E);
            MARK_DONE(1);
        }
        if ((int)blockIdx.x >= gc) {
            constexpr int I_BR = (SBW / 64) * (D / 32), I_MX = (D / 64) * (D / 32), I_PL = (256 / 64) * (256 / 32), I_Q = (D / 64) * (XAW / 32), I_KV = (D / 64) * (2 * XAW / 32), I_O = (XAW / 64) * (D / 32);
            const int cr = ((int)blockIdx.x - gc) * NWAVES + F.wave, cn = (F.G - gc) * NWAVES;
        cvt_range(w_branch_a, SBW, D, WAT, 0, 0, I_BR, cr, cn, F.lane);
        cvt_range(w_branch_b, POOLW, D, WBT, 0, 0, I_BR, cr, cn, F.lane);
        cvt_range(w_mix_out, D, D, WMT, 0, 0, I_MX, cr, cn, F.lane);
        for (int g = 0; g < 4; ++g) cvt_range(pool_lin + (size_t)g * 65536, 256, 256, PLT + (size_t)g * 65536, 0, 0, I_PL, cr, cn, F.lane);
        cvt_range(xa_wq, D, XAW, WQT, 0, 0, I_Q, cr, cn, F.lane);
        cvt_range(xa_wkv, D, 2 * XAW, WKVT, 0, 0, I_KV, cr, cn, F.lane);
        cvt_range(xa_wo, XAW, D, WOT, 0, 0, I_O, cr, cn, F.lane);
        }
        CVT_BESIDE(CV_UP, 1, gc);
        SEAM(1);
    }

    if (IN(2)) {
        for (int it = blockIdx.x * (NWAVES * 64) + F.tid; it < (S / 8) * (POOLW / 8); it += F.G * NWAVES * 64) {
            const int wv = it >> 6, g = wv & 3, rb = (wv >> 2) * 2 + (F.lane >> 5), ch = g * 32 + (F.lane & 31), t0 = rb * 8;
            if (g == 0) pool_run<2>(PG, PO, t0, ch); else if (g == 1) pool_run<4>(PG, PO, t0, ch); else if (g == 2) pool_run<8>(PG, PO, t0, ch); else pool_run<16>(PG, PO, t0, ch);
        }
        for (int it = F.vcu; it < SBH * (S / 128); it += F.G) { const int h = it & 7, qb = (S / 128 - 1) - (it >> 3); sb_wg_unit(PG, OA, h, qb, F.lds, (volatile LAS int*)(lx + LX_SBF), F.tid, F.wave, F.lane); }
        __syncthreads();
        SEAM(2);
    }

    if (IN(3)) {
        pg8::PoolSched Sc{(const char*)PO, (const char*)PLT, F.G, F.vcu};
        pg8::EpiBf16 E{OB, POOLW, pool_scale};
        pg8::gemm_phase<pg8::EpiBf16, pg8::PoolSched, true>(F.lds, 256, POOLW, 256, Sc, E);
        if (F.vcu < (S / 256) * 4) MARK_DONE(3);
        CVT_BESIDE(CV_UP, 3, (S / 256) * 4);
        SEAM(3);
    }

    if (IN(4)) {
        pg8::BranchSched Sc{(const char*)OA, (const char*)OB, (const char*)WAT, (const char*)WBT, SBW, SBW, S / 256, D / 256, F.G, (int)blockIdx.x};
        pg8::EpiBranch E{PG, MG};
        pg8::gemm_phase<pg8::EpiBranch, pg8::BranchSched, true>(F.lds, SBW, SBW, SBW, Sc, E);
        SEAM(4);
    }

    if (IN(5)) {
        pg8::DenseSched Sc{(const char*)MG, (const char*)WMT, D, D, S / 256, D / 256, F.G, (int)blockIdx.x};
        pg8::EpiResid E{x, H1, D};
        pg8::gemm_phase<pg8::EpiResid, pg8::DenseSched, true>(F.lds, D, D, D, Sc, E);
        SEAM(5);
    }

    if (IN(6)) {
        for (int m = gw; m < S; m += NGW) rms_row_to_bf16(H1 + (size_t)m * D, xa_norm, U2 + (size_t)m * D, F.lane);
        SEAM(6);
    }

    if (IN(7)) {
        { pg8::DenseSched Sc{(const char*)U2, (const char*)WQT, D, D, S / 256, XAW / 256, F.G, (int)blockIdx.x};
          pg8::EpiBf16 E{QXA, XAW, nullptr};
          pg8::gemm_phase<pg8::EpiBf16, pg8::DenseSched, true>(F.lds, D, D, D, Sc, E); }
        { const int c2 = ((int)blockIdx.x >= 64) ? (int)blockIdx.x - 64 : (int)blockIdx.x + F.G - 64;
          pg8::DenseSched Sc{(const char*)MEMN, (const char*)WKVT, D, D, MEM / 256, 2 * XAW / 256, F.G, c2};
          pg8::EpiBf16 E{KVM, 2 * XAW, nullptr};
          pg8::gemm_phase<pg8::EpiBf16, pg8::DenseSched, true>(F.lds, D, D, D, Sc, E); }
        if ((int)blockIdx.x < 68) MARK_DONE(7);
        CVT_BESIDE(CV_UP, 7, 68);
        SEAM(7);
    }

    if (IN(8)) {
        for (int it = F.vcu; it < XAH * (S / 128); it += F.G) {
            const int h = it & 3, qg = it >> 2;
            __syncthreads();
#pragma unroll
            for (int t = 0; t < 8; ++t) { const int c = t * 512 + F.tid, row = c >> 4, ch = c & 15;
                const u32x4 vv = *(const u32x4*)(KVM + (size_t)row * (2 * XAW) + XAW + h * HD + 8 * ch); *(LAS u32x4*)(F.lds + voff_b(row, ch)) = vv; }
            __syncthreads();
            xa_unit(QXA, KVM, OXA, h, qg * 8 + F.wave, F.lds, F.lane);
        }
        __syncthreads();
        SEAM(8);
    }

    if (IN(9)) {
        pg8::DenseSched Sc{(const char*)OXA, (const char*)WOT, XAW, XAW, S / 256, D / 256, F.G, (int)blockIdx.x};
        pg8::EpiResid E{H1, H2, D};
        pg8::gemm_phase<pg8::EpiResid, pg8::DenseSched, true>(F.lds, XAW, XAW, XAW, Sc, E);
        SEAM(9);
    }

    if (IN(10)) {
        for (int i = blockIdx.x * (NWAVES * 64) + F.tid; i < PROWS; i += F.G * NWAVES * 64) RSLOT[i] = -1;
        LAS unsigned char* thi = F.lds;
        LAS float* lg = (LAS float*)(lx + LX_LOG);
        LAS float* part = (LAS float*)(lx + LX_RPART);
        for (int rg = F.vcu; rg < S / 16; rg += F.G) {
            __syncthreads();
#pragma unroll
            for (int rr = 0; rr < 2; ++rr) { const int r = 2 * F.wave + rr, m = rg * 16 + r;
                const f32x4* xr = (const f32x4*)(H2 + (size_t)m * D) + F.lane; f32x4 v[8]; float s = 0.f;
#pragma unroll
                for (int j = 0; j < 8; ++j) { v[j] = xr[64 * j]; s += (v[j].x * v[j].x + v[j].y * v[j].y) + (v[j].z * v[j].z + v[j].w * v[j].w); }
                const float rstd = 1.0f / sqrtf(wave_sum(s) * (1.0f / D) + RMS_EPS);
                const f32x4* gr = (const f32x4*)moe_norm + F.lane;
#pragma unroll
                for (int j = 0; j < 8; ++j) { const f32x4 g = gr[64 * j]; const f32x4 y = v[j] * rstd * g; u32x2 w; w.x = cvt_pk_bf16(y.x, y.y); w.y = cvt_pk_bf16(y.z, y.w);
                    u32x2 l; l.x = cvt_pk_bf16(y.x - bf_lo(w.x), y.y - bf_hi(w.x)); l.y = cvt_pk_bf16(y.z - bf_lo(w.y), y.w - bf_hi(w.y));
                    const unsigned off = (unsigned)r * 4096u + ((((unsigned)F.lane >> 1) + 32u * j) ^ (unsigned)r) * 16u + (F.lane & 1) * 8u;
                    *(LAS u32x2*)(thi + off) = w; *(LAS u32x2*)(thi + 65536 + off) = l; } }
            __syncthreads();
#pragma unroll
            for (int q = 0; q < 2; ++q) { const int blk = F.tid + 512 * q, r = blk >> 6, kb32 = blk & 63; f32x16 lo, hi;
#pragma unroll
                for (int c4 = 0; c4 < 4; ++c4) { const u32x4 v = *(const LAS u32x4*)(thi + r * 4096 + ((unsigned)((4 * kb32 + c4) ^ r) * 16u));
                    const float f[8] = {bf_lo(v.x), bf_hi(v.x), bf_lo(v.y), bf_hi(v.y), bf_lo(v.z), bf_hi(v.z), bf_lo(v.w), bf_hi(v.w)};
#pragma unroll
                    for (int j = 0; j < 8; ++j) { if (c4 < 2) lo[8 * c4 + j] = f[j] * 2.0f; else hi[8 * (c4 - 2) + j] = f[j] * 2.0f; } }
                st_fp6_block(TB + (size_t)(rg * 16 + r) * D + 128 * (kb32 >> 2) + 16 * (kb32 & 3), pk32_fp6(lo, hi)); }
            { const int fr = F.lane & 15, fq = F.lane >> 4; f32x4 c0 = {0.f, 0.f, 0.f, 0.f}, c1 = {0.f, 0.f, 0.f, 0.f};
              const bf16_t* wh = WRT + (size_t)fr * D + 256 * F.wave + 8 * fq;
#pragma unroll
              for (int st = 0; st < 8; ++st) { const unsigned ch = (unsigned)(32 * F.wave + 4 * st + fq);
                  const bf16x8 ah = *(const LAS bf16x8*)(thi + fr * 4096 + ((ch ^ (unsigned)fr) * 16u)), al = *(const LAS bf16x8*)(thi + 65536 + fr * 4096 + ((ch ^ (unsigned)fr) * 16u));
                  const bf16x8 bh0 = *(const bf16x8*)(wh + 32 * st), bh1 = *(const bf16x8*)(wh + (size_t)16 * D + 32 * st), bl0 = *(const bf16x8*)(wh + (size_t)NE * D + 32 * st), bl1 = *(const bf16x8*)(wh + (size_t)(NE + 16) * D + 32 * st);
                  c0 = __builtin_amdgcn_mfma_f32_16x16x32_bf16(ah, bh0, c0, 0, 0, 0); c1 = __builtin_amdgcn_mfma_f32_16x16x32_bf16(ah, bh1, c1, 0, 0, 0);
                  c0 = __builtin_amdgcn_mfma_f32_16x16x32_bf16(ah, bl0, c0, 0, 0, 0); c1 = __builtin_amdgcn_mfma_f32_16x16x32_bf16(ah, bl1, c1, 0, 0, 0);
                  c0 = __builtin_amdgcn_mfma_f32_16x16x32_bf16(al, bh0, c0, 0, 0, 0); c1 = __builtin_amdgcn_mfma_f32_16x16x32_bf16(al, bh1, c1, 0, 0, 0); }
#pragma unroll
              for (int i = 0; i < 4; ++i) { part[(F.wave * 16 + 4 * fq + i) * 32 + fr] = c0[i]; part[(F.wave * 16 + 4 * fq + i) * 32 + 16 + fr] = c1[i]; } }
            __syncthreads();
            { const int r = F.tid >> 5, e = F.tid & 31; float a = 0.f;
#pragma unroll
              for (int w = 0; w < 8; ++w) a += part[(w * 16 + r) * 32 + e];
              lg[r * 32 + e] = a + b_router[e]; }
            __syncthreads();
            if (F.tid < 16) { const int r = F.tid, m = rg * 16 + r; float l[32];
#pragma unroll
                for (int e = 0; e < 32; ++e) l[e] = lg[r * 32 + e];
                int idx[4]; float val[4]; unsigned taken = 0u;
#pragma unroll
                for (int k = 0; k < 4; ++k) { float best = -3.4e38f; int bi = 0;
#pragma unroll
                    for (int e = 0; e < 32; ++e) { const bool ok = !((taken >> e) & 1u) && (l[e] > best); best = ok ? l[e] : best; bi = ok ? e : bi; }
                    idx[k] = bi; val[k] = best; taken |= 1u << bi; }
                const float e0 = 1.0f, e1 = expf(val[1] - val[0]), e2 = expf(val[2] - val[0]), e3 = expf(val[3] - val[0]); const float inv = 1.0f / (((e0 + e1) + e2) + e3);
                const float gk[4] = {e0 * inv, e1 * inv, e2 * inv, e3 * inv};
#pragma unroll
                for (int k = 0; k < 4; ++k) { const int pos = atomicAdd(CNT + idx[k], 1); ASGE[m * 4 + k] = idx[k]; ASGP[m * 4 + k] = pos; GATE[m * 4 + k] = gk[k]; } }
        }
        __syncthreads();
        SEAM(10);
    }

    LAS int* tab = (LAS int*)(lx + LX_TAB);
#define BUILD_TAB(NT) do { __syncthreads(); if (F.tid == 0) { int us = 0, ps = 0; for (int e = 0; e < NE; ++e) { const int c = CNT[e], nb = (c + EBLK - 1) / EBLK; tab[e] = us; tab[33 + e] = ps; tab[66 + e] = nb > 0 ? nb : 1; us += nb * (NT); ps += nb * EBLK; } tab[32] = us; tab[65] = ps; } __syncthreads(); } while (0)

    if (IN(11)) {
        BUILD_TAB(1);
        for (int s = blockIdx.x * (NWAVES * 64) + F.tid; s < NK; s += F.G * NWAVES * 64) { const int e = ASGE[s], pos = ASGP[s]; RSLOT[tab[33 + e] + pos] = s; }
        CVT_PULL(CV_UP);
        SEAM(11);
    }

    if (IN(12)) {
        BUILD_TAB(16);
        const int gc = (F.G == 256) ? GC_P12 : F.G; const int bx = (int)blockIdx.x;
        if ((bx >> 3) < (gc >> 3) || F.G != 256) {
            pg8::MoeSched Sc{(const char*)TB, (const char*)WUPT, 16, (size_t)2 * DFF * D, (size_t)128 * D, (size_t)DFF * D, tab, gc, (F.G == 256) ? (bx & 7) * (gc >> 3) + (bx >> 3) : F.vcu, true, (size_t)D};
            pg8::EpiUp E{b_up, ACT};
            LAS int* gtab = (LAS int*)(lx + LX_RPART);
            { int slv[8]; bool okv[8];
#pragma unroll
              for (int k = 0; k < 8; ++k) { pg8::Unit uu; okv[k] = Sc.next(2 * k + (F.tid >> 8), uu); slv[k] = okv[k] ? RSLOT[uu.r0 + (F.tid & 255)] : 0; }
#pragma unroll
              for (int k = 0; k < 8; ++k) if (okv[k]) gtab[(2 * k + (F.tid >> 8)) * 256 + (F.tid & 255)] = (slv[k] < 0 ? 0 : slv[k]) >> 2; }
            __syncthreads();
            pg8::gemm_phase_db6<pg8::EpiUp, pg8::MoeSched>(F.lds, D / 2, D / 2, D / 2, Sc, E, gtab);
            MARK_DONE(12);
        }
        CVT_BESIDE(CV_ALL, 12, gc);
        CVT_PULL(CV_ALL);
        SEAM(12);
    }

    if (IN(13)) {
        BUILD_TAB(8);
        pg8::MoeSched Sc{(const char*)ACT, (const char*)WDNT, 8, (size_t)D * DFF, (size_t)256 * DFF, (size_t)128 * DFF, tab, F.G, F.vcu, false, (size_t)DFF};
        pg8::EpiDown E{b_down, RSLOT, GATE, SLOT};
        pg8::gemm_phase<pg8::EpiDown, pg8::MoeSched, true, false, 1>(F.lds, DFF / 2, DFF / 2, DFF / 2, Sc, E);
        SEAM(13);
    }

    if (IN(14)) {
        for (int m = gw; m < S; m += NGW) {
            const f32x4* xr = (const f32x4*)(H2 + (size_t)m * D) + F.lane; f32x4 v[8]; float s = 0.f;
#pragma unroll
            for (int j = 0; j < 8; ++j) { v[j] = xr[64 * j];
#pragma unroll
                for (int k = 0; k < 4; ++k) { const int w = (int)*((const unsigned*)(SLOT + (size_t)(m * 4 + k) * D) + F.lane + 64 * j); const f32x2 lo = __builtin_amdgcn_cvt_pk_f32_fp8(w, false), hi = __builtin_amdgcn_cvt_pk_f32_fp8(w, true);
                    v[j].x += lo.x * 0.0625f; v[j].y += lo.y * 0.0625f; v[j].z += hi.x * 0.0625f; v[j].w += hi.y * 0.0625f; }
                s += (v[j].x * v[j].x + v[j].y * v[j].y) + (v[j].z * v[j].z + v[j].w * v[j].w); }
            const float rstd = 1.0f / sqrtf(wave_sum(s) * (1.0f / D) + RMS_EPS);
            const f32x4* gr = (const f32x4*)final_norm + F.lane; f32x4* o = (f32x4*)(args.out + (size_t)m * D) + F.lane;
#pragma unroll
            for (int j = 0; j < 8; ++j) o[64 * j] = v[j] * rstd * gr[64 * j];
        }
    }
#undef IN
#undef SEAM
}

extern "C" void kernel_launch(void* const* d_in, const int* in_sizes, int n_in, void* d_out, int out_size, void* d_ws, size_t ws_size, hipStream_t stream) {
    static int grid = 0;
    if (grid == 0) {
        if (n_in != 24 || out_size != S * D || ws_size < WS_END) { fprintf(stderr, "kernel_launch: unexpected shapes (n_in %d out %d ws %zu need %zu)\n", n_in, out_size, ws_size, (size_t)WS_END); grid = -1; return; }
        int dev = 0, cus = 0, per_cu = 0;
        if (hipGetDevice(&dev) != hipSuccess || hipDeviceGetAttribute(&cus, hipDeviceAttributeMultiprocessorCount, dev) != hipSuccess) { grid = -1; return; }
        if (hipFuncSetAttribute((const void*)moe_fwd, hipFuncAttributeMaxDynamicSharedMemorySize, LDS_BYTES) != hipSuccess) { fprintf(stderr, "kernel_launch: hipFuncSetAttribute failed\n"); grid = -1; return; }
        if (hipOccupancyMaxActiveBlocksPerMultiprocessor(&per_cu, (const void*)moe_fwd, NWAVES * 64, LDS_BYTES) != hipSuccess || per_cu < 1) { fprintf(stderr, "kernel_launch: occupancy query says %d\n", per_cu); per_cu = 1; }
        (void)hipGetLastError();
        grid = cus;
    }
    if (grid < 0) return;
    (void)hipMemsetAsync((char*)d_ws + WS_CTL, 0, CTL_ZERO_BYTES, stream);
    Args a{};
    for (int i = 0; i < 24; ++i) a.in[i] = (const float*)d_in[i];
    a.out = (float*)d_out; a.ws = (unsigned char*)d_ws;
#if MK_ONE_LAUNCH
    a.ph_lo = 0; a.ph_hi = NPHASE;
    hipLaunchKernelGGL(moe_fwd, dim3(grid), dim3(NWAVES * 64), LDS_BYTES, stream, a);
#else
    for (int p = 0; p < NPHASE; ++p) { a.ph_lo = p; a.ph_hi = p + 1; for (int rep = 0; rep < (((REPEAT_MASK >> p) & 1) ? 2 : 1); ++rep) hipLaunchKernelGGL(moe_fwd, dim3(grid), dim3(NWAVES * 64), LDS_BYTES, stream, a); }
#endif
}
```

```cpp
#include <hip/hip_runtime.h>
#include <cstdio>
#include <cstdint>

#ifndef MK_ONE_LAUNCH
#define MK_ONE_LAUNCH 1
#endif
#ifndef REPEAT_MASK
#define REPEAT_MASK 0
#endif
#define GC_P1 160
#define GC_P12 224

#define LAS __attribute__((address_space(3)))
#define GAS __attribute__((address_space(1)))
typedef unsigned short bf16_t;
typedef short bf16x8 __attribute__((ext_vector_type(8)));
typedef short s16x4 __attribute__((ext_vector_type(4)));
typedef float f32x4 __attribute__((ext_vector_type(4)));
typedef float f32x2 __attribute__((ext_vector_type(2)));
typedef unsigned u32x4 __attribute__((ext_vector_type(4)));
typedef unsigned u32x2 __attribute__((ext_vector_type(2)));
typedef int v8i32 __attribute__((ext_vector_type(8)));
typedef int v6i32 __attribute__((ext_vector_type(6)));
typedef unsigned u32x3 __attribute__((ext_vector_type(3)));
typedef float f32x16 __attribute__((ext_vector_type(16)));

constexpr int S = 8192, D = 2048, MEM = 256;
constexpr int SBH = 8, HD = 128, SBW = 1024, POOLW = 1024, INW = 4096, NP1 = 8192;
constexpr int XAH = 4, XAW = 512;
constexpr int NE = 32, TOPK = 4, DFF = 2048, NK = S * TOPK, EBLK = 256, MAXBLK = NK / EBLK + NE, PROWS = MAXBLK * EBLK;
constexpr float RMS_EPS = 1e-5f;

constexpr size_t MiB = 1u << 20;
constexpr size_t WS_CTL = 0, CTL_ZERO_BYTES = 1 * MiB;
constexpr size_t WS_W1T = 2 * MiB;
constexpr size_t WS_WAT = WS_W1T + 32 * MiB;
constexpr size_t WS_WBT = WS_WAT + 4 * MiB;
constexpr size_t WS_WMT = WS_WBT + 4 * MiB;
constexpr size_t WS_PLT = WS_WMT + 8 * MiB;
constexpr size_t WS_WQT = WS_PLT + 1 * MiB;
constexpr size_t WS_WKVT = WS_WQT + 2 * MiB;
constexpr size_t WS_WOT = WS_WKVT + 4 * MiB;
constexpr size_t WS_WUPT = WS_WOT + 2 * MiB;
constexpr size_t WS_WDNT = WS_WUPT + 512 * MiB;
constexpr size_t WS_U = WS_WDNT + 256 * MiB;
constexpr size_t WS_MEMN = WS_U + 32 * MiB;
constexpr size_t WS_PG = WS_MEMN + 1 * MiB;
constexpr size_t WS_OA = WS_PG + 128 * MiB;
constexpr size_t WS_PO = WS_OA + 16 * MiB;
constexpr size_t WS_OB = WS_PO + 16 * MiB;
constexpr size_t WS_TMP = WS_OB + 16 * MiB;
constexpr size_t WS_MG = WS_TMP + 64 * MiB;
constexpr size_t WS_H1 = WS_MG + 32 * MiB;
constexpr size_t WS_U2 = WS_H1 + 64 * MiB;
constexpr size_t WS_QXA = WS_U2 + 32 * MiB;
constexpr size_t WS_KVM = WS_QXA + 8 * MiB;
constexpr size_t WS_OXA = WS_KVM + 1 * MiB;
constexpr size_t WS_H2 = WS_OXA + 8 * MiB;
constexpr size_t WS_TB = WS_H2 + 64 * MiB;
constexpr size_t WS_ROWS = WS_TB + 32 * MiB;
constexpr size_t WS_ACT = WS_ROWS + 160 * MiB;
constexpr size_t WS_SLOT = WS_ACT + 160 * MiB;
constexpr size_t WS_ASGE = WS_SLOT + 128 * MiB;
constexpr size_t WS_ASGP = WS_ASGE + 1 * MiB;
constexpr size_t WS_GATE = WS_ASGP + 1 * MiB;
constexpr size_t WS_RSLOT = WS_GATE + 1 * MiB;
constexpr size_t WS_WRT = WS_RSLOT + 1 * MiB;
constexpr size_t WS_END = WS_WRT + 1 * MiB;
constexpr int CW_CNT = 64;
constexpr int CW_CUR = 192;  constexpr int CW_DONE = 256;
constexpr int CW_BAR = 4096;

constexpr int RING_BYTES = 131072;
constexpr int LDS_X_OFF = RING_BYTES;
constexpr int LDS_BYTES = 163840;
constexpr int LX_BAR = 0;
constexpr int LX_TAB = 64;
constexpr int LX_CVS = 32;
constexpr int LX_SBF = 128;
constexpr int LX_LOG = 1024;
constexpr int LX_RPART = 4096;

constexpr int NWAVES = 8;

__device__ __forceinline__ unsigned cvt_pk_bf16(float lo, float hi) { unsigned r; asm volatile("v_cvt_pk_bf16_f32 %0, %1, %2" : "=v"(r) : "v"(lo), "v"(hi)); return r; }
__device__ __forceinline__ unsigned pk4_fp8(float a, float b, float c, float d) { int p = __builtin_amdgcn_cvt_pk_fp8_f32(a, b, 0, false); p = __builtin_amdgcn_cvt_pk_fp8_f32(c, d, p, true); return (unsigned)p; }
__device__ __forceinline__ v6i32 pk32_fp6(const f32x16& lo, const f32x16& hi) { return __builtin_amdgcn_cvt_scalef32_2xpk16_fp6_f32(lo, hi, 1.0f); }
__device__ __forceinline__ void st_fp6_block(unsigned char* p, const v6i32& b) { *(u32x4*)p = (u32x4){(unsigned)b[0], (unsigned)b[1], (unsigned)b[2], (unsigned)b[3]}; *(u32x4*)(p + 64) = (u32x4){(unsigned)b[4], (unsigned)b[5], 0u, 0u}; }
__device__ __forceinline__ float bf_lo(unsigned w) { return __uint_as_float(w << 16); }
__device__ __forceinline__ float bf_hi(unsigned w) { return __uint_as_float(w & 0xffff0000u); }
__device__ __forceinline__ float wave_sum(float v) {
#pragma unroll
    for (int o = 1; o < 64; o <<= 1) v += __shfl_xor(v, o);
    return v;
}
__device__ __forceinline__ float sigmoidf_fast(float x) { return __builtin_amdgcn_rcpf(1.0f + __builtin_amdgcn_exp2f(x * -1.4426950408889634f)); }

#define XB_TMO      128
#define XB_XCNT(j)  (256  + 64 * (j))
#define XB_XSUB(j)  (1280 + 64 * (j))
#define XB_XGEN(j)  (2304 + 64 * (j))
#define XB_TOP      3328
#define XB_TOPGEN   3392
#define XCD_BAR_WORDS 3456
#define XB_SPIN_CAP (1u << 18)
__device__ __forceinline__ unsigned xb_ld(unsigned* p)              { return __hip_atomic_load(p, __ATOMIC_RELAXED, __HIP_MEMORY_SCOPE_AGENT); }
__device__ __forceinline__ unsigned xb_add(unsigned* p, unsigned v) { return __hip_atomic_fetch_add(p, v, __ATOMIC_RELAXED, __HIP_MEMORY_SCOPE_AGENT); }
__device__ __forceinline__ unsigned xb_xcc_id() { return (unsigned)__builtin_amdgcn_s_getreg((3 << 11) | 20) & 0xFu; }
#define XB_SPIN(cond, bar) do { unsigned _sp = 0; while (cond) { __builtin_amdgcn_s_sleep(1); \
    if ((++_sp & 255u) == 0u) { if (xb_ld(&(bar)[XB_TMO])) break; if (_sp > XB_SPIN_CAP) { atomicAdd(&(bar)[XB_TMO], 1u); break; } } } } while (0)
struct XcdBarrier { unsigned* bar; unsigned x; volatile LAS unsigned* st; };
__device__ __forceinline__ XcdBarrier xcd_barrier_post(unsigned* bar, volatile LAS unsigned* st) {
    XcdBarrier b; b.bar = bar; b.x = xb_xcc_id(); b.st = st;
    if (threadIdx.x == 0) (void)xb_add(&bar[XB_XCNT(b.x)], 1u);
    return b;
}
__device__ __forceinline__ void xcd_barrier_complete(unsigned* bar, unsigned x, unsigned& nloc, unsigned& nx) {
    const unsigned G = gridDim.x * gridDim.y * gridDim.z;
    unsigned sum, cnt, mine, sp = 0u;
    for (;;) {
        sum = 0u; cnt = 0u; mine = 0u;
#pragma unroll
        for (unsigned j = 0; j < 16; ++j) { const unsigned c = xb_ld(&bar[XB_XCNT(j)]); sum += c; cnt += (c > 0u) ? 1u : 0u; mine = (j == x) ? c : mine; }
        if (sum == G) break;
        __builtin_amdgcn_s_sleep(1);
        if ((++sp & 255u) == 0u) { if (xb_ld(&bar[XB_TMO])) break; if (sp > XB_SPIN_CAP) { atomicAdd(&bar[XB_TMO], 1u); break; } }
    }
    nloc = mine > 0u ? mine : 1u; nx = cnt > 0u ? cnt : 1u;
}
__device__ __forceinline__ void xcd_barrier(const XcdBarrier& b) {
    asm volatile("s_waitcnt vmcnt(0)" ::: "memory");
    __syncthreads();
    if (threadIdx.x == 0) {
        unsigned* bar = b.bar;
        __builtin_amdgcn_s_waitcnt(0);
        unsigned nloc = b.st[0], nx = b.st[1];
        if (nloc == 0u) { xcd_barrier_complete(bar, b.x, nloc, nx); b.st[0] = nloc; b.st[1] = nx; }
        const unsigned old = xb_add(&bar[XB_XSUB(b.x)], 1u);
        const unsigned gen = old / nloc;
        if (old + 1u == (gen + 1u) * nloc) {
            __builtin_amdgcn_fence(__ATOMIC_RELEASE, "agent");
            asm volatile("s_waitcnt vmcnt(0)" ::: "memory");
            const unsigned og = xb_add(&bar[XB_TOP], 1u);
            const unsigned tg = og / nx;
            if (og + 1u == (tg + 1u) * nx) xb_add(&bar[XB_TOPGEN], 1u);
            else XB_SPIN(xb_ld(&bar[XB_TOPGEN]) == tg, bar);
            __builtin_amdgcn_fence(__ATOMIC_ACQUIRE, "agent");
            xb_add(&bar[XB_XGEN(b.x)], 1u);
            asm volatile("s_waitcnt vmcnt(0)" ::: "memory");
        } else {
            XB_SPIN(xb_ld(&bar[XB_XGEN(b.x)]) == gen, bar);
            __builtin_amdgcn_fence(__ATOMIC_ACQUIRE, "agent");
            asm volatile("s_waitcnt vmcnt(0)" ::: "memory");
        }
    }
    __syncthreads();
}

namespace pg8 {
constexpr int BM = 256, BK = 64, HALF = 128, HTB = HALF * BK * 2, STAGE_BYTES = 8 * HTB, NXCD = 8, WGM = 8;
__host__ __device__ __forceinline__ int lds_byte(int r, int c) { const int st = (r >> 4) * 2 + (c >> 5), rr = r & 15, cc = c & 31, ob = rr * 64 + cc * 2; return st * 1024 + (ob ^ (((ob >> 9) & 1) << 5)); }
__host__ __device__ __forceinline__ void stage_rc(int b, int& R, int& C) { const int st = b / 1024, sb = b % 1024, swz = sb ^ (((sb >> 9) & 1) << 5); R = (st >> 1) * 16 + swz / 64; C = (st & 1) * 32 + (swz % 64) / 2; }
__host__ __device__ __forceinline__ int perm32(int rho) { const int n = rho >> 4, i = rho & 15; return 8 * (i >> 2) + 4 * n + (i & 3); }

struct Unit { const char* A; const char* B0; const char* B1; int r0, c0, x; };

__device__ __forceinline__ void tile_of(int L, int nM, int nN, int& pm, int& pn) {
    const int nwg = nM * nN; int wgid = L;
    { const int q = nwg / NXCD, r = nwg % NXCD, xcd = wgid % NXCD, off = wgid / NXCD; wgid = (xcd < r ? xcd * (q + 1) : r * (q + 1) + (xcd - r) * q) + off; }
    const int nig = WGM * nN, gid = wgid / nig, fm = gid * WGM, gsz = (nM - fm) < WGM ? (nM - fm) : WGM;
    pm = fm + ((wgid % nig) % gsz); pn = (wgid % nig) / gsz;
}
struct DenseSched {
    const char* A; const char* B; int lda, ldb, nM, nN, G, c;
    __device__ __forceinline__ bool next(int i, Unit& u) const {
        const long L = (long)i * G + c; if (L >= (long)nM * nN) return false;
        int pm, pn; tile_of((int)L, nM, nN, pm, pn);
        u.A = A + (size_t)pm * BM * lda * 2; u.B0 = B + (size_t)pn * BM * ldb * 2; u.B1 = u.B0 + (size_t)HALF * ldb * 2; u.r0 = pm * BM; u.c0 = pn * BM; u.x = 0; return true;
    }
};
struct BranchSched {
    const char* A0; const char* A1; const char* B0; const char* B1; int lda, ldb, nM, nN, G, c;
    __device__ __forceinline__ bool next(int i, Unit& u) const {
        const long L = (long)(i >> 1) * G + c; if (L >= (long)nM * nN) return false;
        int pm, pn; tile_of((int)L, nM, nN, pm, pn); const int br = i & 1;
        u.A = (br ? A1 : A0) + (size_t)pm * BM * lda * 2; u.B0 = (br ? B1 : B0) + (size_t)pn * BM * ldb * 2; u.B1 = u.B0 + (size_t)HALF * ldb * 2; u.r0 = pm * BM; u.c0 = pn * BM; u.x = br; return true;
    }
};
struct PoolSched {
    const char* A; const char* B; int G, c;
    __device__ __forceinline__ bool next(int i, Unit& u) const {
        const int L = i * G + c; if (L >= (S / BM) * 4) return false;
        const int pm = L >> 2, g = L & 3;
        u.A = A + ((size_t)pm * BM * POOLW + g * 256) * 2; u.B0 = B + (size_t)g * 256 * 256 * 2; u.B1 = u.B0 + (size_t)HALF * 256 * 2; u.r0 = pm * BM; u.c0 = g * 256; u.x = g; return true;
    }
};
struct MoeSched {
    const char* A; const char* B; int NT; size_t estride; size_t tstride; size_t hoff; const LAS int* tab; int G, c; bool gather; size_t arow;
    __device__ __forceinline__ int tu(int i) const { return __builtin_amdgcn_readfirstlane(tab[i]); }
    __device__ __forceinline__ bool next(int i, Unit& u) const {
        const int L = i * G + c; if (L >= tu(32)) return false;
        int e = 0;
#pragma unroll
        for (int s = 16; s >= 1; s >>= 1) { if (tu(e + s) <= L) e += s; }
        const int r = L - tu(e), nb = tu(66 + e), nt = r / nb, blk = r - nt * nb, prow = tu(33 + e) + blk * EBLK;
        u.A = gather ? A : A + (size_t)prow * arow; u.B0 = B + (size_t)e * estride + (size_t)nt * tstride; u.B1 = u.B0 + hoff; u.r0 = prow; u.c0 = nt; u.x = e; return true;
    }
};

template <class Epi, class Sched, bool ALIGN_EPI, bool GATHER = false, int PREC = 0>
__device__ __forceinline__ void gemm_phase(LAS unsigned char* lds, const int K, const int lda, const int ldb, const Sched& S, const Epi& E, const LAS int* gtab = nullptr) {
    const int tid = threadIdx.x, wid = __builtin_amdgcn_readfirstlane(tid >> 6), lane = tid & 63, wr = wid >> 2, wc = wid & 3, fr = lane & 15, fq = lane >> 4;
    const int nt = K / BK;
    unsigned voffB[2], vc[2][2], vn[2][2]; int RA[2], CA[2];
#pragma unroll
    for (int i = 0; i < 2; ++i) { int R, C; stage_rc(tid * 16 + i * 8192, R, C); const int Rb = Epi::PERM ? ((R & ~31) + perm32(R & 31)) : R; RA[i] = R; CA[i] = C;
        voffB[i] = (unsigned)(Rb * ldb + C) * 2u; }
#define PG8_AOFF(dst, ord) do { _Pragma("unroll") for (int _h = 0; _h < 2; ++_h) _Pragma("unroll") for (int _i = 0; _i < 2; ++_i) \
        dst[_h][_i] = GATHER ? ((unsigned)gtab[(ord) * 256 + _h * HALF + RA[_i]] * (unsigned)lda + (unsigned)CA[_i]) * 2u : (unsigned)((_h * HALF + RA[_i]) * lda + CA[_i]) * 2u; } while (0)
    const size_t kstep = (size_t)(BK * 2);
    const unsigned ldsw = (unsigned)wid * 1024u;
    const int aoff = lds_byte(wr * 64 + fr, fq * 8), boff = lds_byte(wc * 32 + fr, fq * 8);
#define PG8_SA(b, h) (((b) * 2 + (h)) * HTB)
#define PG8_SB(b, h) ((4 + (b) * 2 + (h)) * HTB)
#define PG8_STAGE(bufoff, gbase, voff) do { _Pragma("unroll") for (int _i = 0; _i < 2; ++_i) \
        __builtin_amdgcn_global_load_lds((const unsigned*)((const char*)(gbase) + (voff)[_i]), (LAS unsigned*)(lds + (bufoff) + ldsw + _i * 8192), 16, 0, 0); } while (0)
#define PG8_LD6(off) __builtin_bit_cast(v6i32, __builtin_shufflevector(*(const LAS u32x4*)(lds + (off)), __builtin_shufflevector(*(const LAS u32x2*)(lds + (off) + 1024), *(const LAS u32x2*)(lds + (off) + 1024), 0, 1, -1, -1), 0, 1, 2, 3, 4, 5))
#define PG8_LD8(off) __builtin_bit_cast(v8i32, __builtin_shufflevector(*(const LAS u32x4*)(lds + (off)), *(const LAS u32x4*)(lds + (off) + 1024), 0, 1, 2, 3, 4, 5, 6, 7))
#define PG8_LDA(dst, b, h) do { if (PREC == 2) { _Pragma("unroll") for (int m = 0; m < 4; ++m) dst##6[m] = PG8_LD6(PG8_SA(b, h) + aoff + m * 2048); } \
      else if (PREC == 1) { _Pragma("unroll") for (int m = 0; m < 4; ++m) dst##8[m] = PG8_LD8(PG8_SA(b, h) + aoff + m * 2048); } \
      else { _Pragma("unroll") for (int m = 0; m < 4; ++m) _Pragma("unroll") for (int k = 0; k < 2; ++k) dst[m][k] = *(const LAS bf16x8*)(lds + PG8_SA(b, h) + aoff + m * 2048 + k * 1024); } } while (0)
#define PG8_LDB(dst, b, h) do { if (PREC == 2) { _Pragma("unroll") for (int n = 0; n < 2; ++n) dst##6[n] = PG8_LD6(PG8_SB(b, h) + boff + n * 2048); } \
      else if (PREC == 1) { _Pragma("unroll") for (int n = 0; n < 2; ++n) dst##8[n] = PG8_LD8(PG8_SB(b, h) + boff + n * 2048); } \
      else { _Pragma("unroll") for (int n = 0; n < 2; ++n) _Pragma("unroll") for (int k = 0; k < 2; ++k) dst[n][k] = *(const LAS bf16x8*)(lds + PG8_SB(b, h) + boff + n * 2048 + k * 1024); } } while (0)
#define PG8_MMA(ai, bj, At, Bt) do { __builtin_amdgcn_s_setprio(1); if (PREC == 2) { _Pragma("unroll") for (int m = 0; m < 4; ++m) _Pragma("unroll") for (int n = 0; n < 2; ++n) \
        asm volatile("v_mfma_scale_f32_16x16x128_f8f6f4 %0, %1, %2, %0, %3, %4 op_sel_hi:[0,0,0] cbsz:2 blgp:2" : "+v"(acc[ai][bj][m][n]) : "v"(Bt##6[n]), "v"(At##6[m]), "v"(sc_w), "v"(sc_a)); } \
      else if (PREC == 1) { _Pragma("unroll") for (int m = 0; m < 4; ++m) _Pragma("unroll") for (int n = 0; n < 2; ++n) \
        asm volatile("v_mfma_scale_f32_16x16x128_f8f6f4 %0, %1, %2, %0, %3, %4 op_sel_hi:[0,0,0]" : "+v"(acc[ai][bj][m][n]) : "v"(Bt##8[n]), "v"(At##8[m]), "v"(sc_w), "v"(sc_a)); } \
      else { _Pragma("unroll") for (int m = 0; m < 4; ++m) _Pragma("unroll") for (int n = 0; n < 2; ++n) _Pragma("unroll") for (int k = 0; k < 2; ++k) \
        acc[ai][bj][m][n] = __builtin_amdgcn_mfma_f32_16x16x32_bf16(Bt[n][k], At[m][k], acc[ai][bj][m][n], 0, 0, 0); } __builtin_amdgcn_s_setprio(0); } while (0)
#define PG8_WAIT_V(n) asm volatile("s_waitcnt vmcnt(" #n ")" ::: "memory")
#define PG8_WAIT_L(n) asm volatile("s_waitcnt lgkmcnt(" #n ")" ::: "memory")
#define PG8_BAR __builtin_amdgcn_s_barrier()
#define PG8_SCHED __builtin_amdgcn_sched_barrier(0)
    Unit cur, nxt; int ui = 0;
    if (!S.next(0, cur)) return;
    f32x4 acc[2][2][4][2];
#pragma unroll
    for (int a = 0; a < 2; ++a)
#pragma unroll
        for (int b = 0; b < 2; ++b)
#pragma unroll
            for (int m = 0; m < 4; ++m)
#pragma unroll
                for (int n = 0; n < 2; ++n) acc[a][b][m][n] = (f32x4){0.f, 0.f, 0.f, 0.f};
    bf16x8 At[4][2], B0[2][2], B1[2][2]; v8i32 At8[4], B08[2], B18[2]; v6i32 At6[4], B06[2], B16[2];
    const int sc_w = 121, sc_a = (PREC == 2) ? 126 : 127;
    PG8_AOFF(vc, 0);
#pragma unroll
    for (int _h = 0; _h < 2; ++_h) { vn[_h][0] = vc[_h][0]; vn[_h][1] = vc[_h][1]; }
    PG8_STAGE(PG8_SB(0, 0), cur.B0, voffB); PG8_STAGE(PG8_SB(0, 1), cur.B1, voffB); PG8_STAGE(PG8_SA(0, 0), cur.A, vc[0]); PG8_STAGE(PG8_SA(0, 1), cur.A, vc[1]);
    if (wr == 1) PG8_BAR;
    PG8_WAIT_V(2); PG8_BAR;
    PG8_STAGE(PG8_SB(1, 0), cur.B0 + kstep, voffB); PG8_STAGE(PG8_SA(1, 0), cur.A + kstep, vc[0]); PG8_STAGE(PG8_SB(1, 1), cur.B1 + kstep, voffB);
    PG8_WAIT_V(6); PG8_BAR;
    for (;;) {
        const bool has_next = S.next(ui + 1, nxt);
        if (GATHER && has_next) PG8_AOFF(vn, ui + 1);
        const char* nA = has_next ? nxt.A : cur.A; const char* nB0 = has_next ? nxt.B0 : cur.B0; const char* nB1 = has_next ? nxt.B1 : cur.B1;
#pragma nounroll
        for (int t = 0; t < nt; t += 2) {
            const bool last = (t == nt - 2);
            const char* a1 = cur.A + (size_t)(t + 1) * kstep;
            const char* a2 = last ? nA : cur.A + (size_t)(t + 2) * kstep;
            const char* b20 = last ? nB0 : cur.B0 + (size_t)(t + 2) * kstep; const char* b21 = last ? nB1 : cur.B1 + (size_t)(t + 2) * kstep;
            const char* a3 = a2 + kstep; const char* b30 = b20 + kstep; const char* b31 = b21 + kstep;
            unsigned v2[2][2];
#pragma unroll
            for (int _h = 0; _h < 2; ++_h) { v2[_h][0] = (GATHER && last) ? vn[_h][0] : vc[_h][0]; v2[_h][1] = (GATHER && last) ? vn[_h][1] : vc[_h][1]; }
            PG8_LDB(B0, 0, 0); PG8_LDB(B1, 0, 1); PG8_SCHED; PG8_LDA(At, 0, 0); PG8_STAGE(PG8_SA(1, 1), a1, vc[1]);
            PG8_WAIT_V(8); PG8_WAIT_L(0); PG8_BAR; PG8_MMA(0, 0, At, B0); PG8_MMA(0, 1, At, B1); PG8_BAR; PG8_SCHED;
            PG8_LDA(At, 0, 1); PG8_STAGE(PG8_SB(0, 0), b20, voffB); PG8_STAGE(PG8_SB(0, 1), b21, voffB); PG8_STAGE(PG8_SA(0, 0), a2, v2[0]);
            PG8_WAIT_V(8); PG8_WAIT_L(0); PG8_BAR; PG8_MMA(1, 0, At, B0); PG8_MMA(1, 1, At, B1); PG8_BAR; PG8_SCHED;
            PG8_LDB(B0, 1, 0); PG8_LDB(B1, 1, 1); PG8_SCHED; PG8_LDA(At, 1, 0); PG8_STAGE(PG8_SA(0, 1), a2, v2[1]);
            PG8_WAIT_V(8); PG8_WAIT_L(0); PG8_BAR; PG8_MMA(0, 0, At, B0); PG8_MMA(0, 1, At, B1); PG8_BAR; PG8_SCHED;
            PG8_LDA(At, 1, 1); PG8_STAGE(PG8_SB(1, 0), b30, voffB); PG8_STAGE(PG8_SB(1, 1), b31, voffB); PG8_STAGE(PG8_SA(1, 0), a3, v2[0]);
            PG8_WAIT_V(8); PG8_WAIT_L(0); PG8_BAR; PG8_MMA(1, 0, At, B0); PG8_MMA(1, 1, At, B1); PG8_BAR; PG8_SCHED;
        }
        if constexpr (ALIGN_EPI) { if (wr == 0) PG8_BAR; }
        if (PREC != 0) asm volatile("s_nop 15\n\ts_nop 15\n\ts_nop 15\n\ts_nop 15" ::: "memory");
        E(acc, cur, wr, wc, fr, fq);
        if (!has_next) break;
        bool kp = false; if constexpr (Epi::KEEPS) kp = E.keep(cur);
        if (!kp) {
#pragma unroll
        for (int a = 0; a < 2; ++a)
#pragma unroll
            for (int b = 0; b < 2; ++b)
#pragma unroll
                for (int m = 0; m < 4; ++m)
#pragma unroll
                    for (int n = 0; n < 2; ++n) acc[a][b][m][n] = (f32x4){0.f, 0.f, 0.f, 0.f}; }
        cur = nxt; ++ui;
        if (GATHER) {
#pragma unroll
            for (int _h = 0; _h < 2; ++_h) { vc[_h][0] = vn[_h][0]; vc[_h][1] = vn[_h][1]; } }
        if constexpr (ALIGN_EPI) { if (wr == 1) PG8_BAR; }
    }
    PG8_WAIT_V(0);
    if constexpr (!ALIGN_EPI) { if (wr == 0) PG8_BAR; }
    PG8_BAR;
#undef PG8_AOFF
#undef PG8_SA
#undef PG8_SB
#undef PG8_STAGE
#undef PG8_LDA
#undef PG8_LDB
#undef PG8_MMA
#undef PG8_LD8
#undef PG8_LD6
#undef PG8_WAIT_V
#undef PG8_WAIT_L
#undef PG8_BAR
#undef PG8_SCHED
}

template <int OFF>
__device__ __forceinline__ v6i32 ld6x(unsigned addr) {
    u32x4 lo; u32x2 hi;
    asm volatile("ds_read_b128 %0, %1 offset:%2" : "=v"(lo) : "v"(addr), "n"(OFF));
    asm volatile("ds_read_b64 %0, %1 offset:%2" : "=v"(hi) : "v"(addr), "n"(OFF + 1024));
    return (v6i32){(int)lo[0], (int)lo[1], (int)lo[2], (int)lo[3], (int)hi[0], (int)hi[1]};
}
template <class Epi, class Sched>
__device__ __forceinline__ void gemm_phase_db6(LAS unsigned char* lds, const int K, const int lda, const int ldb, const Sched& S, const Epi& E, const LAS int* gtab) {
    const int tid = threadIdx.x, wid = __builtin_amdgcn_readfirstlane(tid >> 6), lane = tid & 63, wr = wid >> 2, wc = wid & 3, fr = lane & 15, fq = lane >> 4;
    const int nt = K / BK;
    unsigned voffB0, vc[2][2]; const size_t bstep = (size_t)64 * ldb * 2;
    { int R, C; stage_rc(tid * 16, R, C); const int Rb = Epi::PERM ? ((R & ~31) + perm32(R & 31)) : R; voffB0 = (unsigned)(Rb * ldb + C) * 2u; }
#define DB_AOFF(dst, ord) do { _Pragma("unroll") for (int _i = 0; _i < 2; ++_i) { int _R, _C; stage_rc((int)threadIdx.x * 16 + _i * 8192, _R, _C); _Pragma("unroll") for (int _h = 0; _h < 2; ++_h) \
        dst[_h][_i] = ((unsigned)gtab[(ord) * 256 + _h * HALF + _R] * (unsigned)lda + (unsigned)_C) * 2u; } } while (0)
    const size_t kstep = (size_t)(BK * 2);
    const unsigned ldsw = (unsigned)wid * 1024u;
    const int aoff = lds_byte(wr * 64 + fr, fq * 8), boff = lds_byte(wc * 32 + fr, fq * 8);
    const unsigned aA = (unsigned)(size_t)(lds + aoff), aB = (unsigned)(size_t)(lds + 4 * HTB + boff);
#define DB_SA(b, h) (((b) * 2 + (h)) * HTB)
#define DB_SB(b, h) ((4 + (b) * 2 + (h)) * HTB)
#define DB_STAGEA1(bufoff, gbase, voff, i) __builtin_amdgcn_global_load_lds((const unsigned*)((const char*)(gbase) + (voff)[i]), (LAS unsigned*)(lds + (bufoff) + ldsw + (i) * 8192), 16, 0, 0)
#define DB_STAGEB1(bufoff, gbase, i) __builtin_amdgcn_global_load_lds((const unsigned*)((const char*)(gbase) + (size_t)(i) * bstep + voffB0), (LAS unsigned*)(lds + (bufoff) + ldsw + (i) * 8192), 16, 0, 0)
#define DB_STAGEA(bufoff, gbase, voff) do { DB_STAGEA1(bufoff, gbase, voff, 0); DB_STAGEA1(bufoff, gbase, voff, 1); } while (0)
#define DB_STAGEB(bufoff, gbase) do { DB_STAGEB1(bufoff, gbase, 0); DB_STAGEB1(bufoff, gbase, 1); } while (0)
#define DB_LDA(dst, b, h) do { dst[0] = ld6x<DB_SA(b, h)>(aA); dst[1] = ld6x<DB_SA(b, h) + 2048>(aA); dst[2] = ld6x<DB_SA(b, h) + 4096>(aA); dst[3] = ld6x<DB_SA(b, h) + 6144>(aA); } while (0)
#define DB_LDB(dst, b, h) do { dst[0] = ld6x<((b) * 2 + (h)) * HTB>(aB); dst[1] = ld6x<((b) * 2 + (h)) * HTB + 2048>(aB); } while (0)
#define DB_MMA(ai, bj, At, Bt) do { __builtin_amdgcn_s_setprio(1); _Pragma("unroll") for (int m = 0; m < 4; ++m) _Pragma("unroll") for (int n = 0; n < 2; ++n) \
        asm volatile("v_mfma_scale_f32_16x16x128_f8f6f4 %0, %1, %2, %0, %3, %4 op_sel_hi:[0,0,0] cbsz:2 blgp:2" : "+v"(acc[ai][bj][m][n]) : "v"(Bt[n]), "v"(At[m]), "v"(sc_w), "v"(sc_a)); __builtin_amdgcn_s_setprio(0); } while (0)
#define DB_MMA4(ai, bj, mlo, At, Bt) do { _Pragma("unroll") for (int m = (mlo); m < (mlo) + 2; ++m) _Pragma("unroll") for (int n = 0; n < 2; ++n) \
        asm volatile("v_mfma_scale_f32_16x16x128_f8f6f4 %0, %1, %2, %0, %3, %4 op_sel_hi:[0,0,0] cbsz:2 blgp:2" : "+v"(acc[ai][bj][m][n]) : "v"(Bt[n]), "v"(At[m]), "v"(sc_w), "v"(sc_a)); } while (0)
#define DB_SYNC() do { asm volatile("s_waitcnt vmcnt(8) lgkmcnt(0)" ::: "memory"); __builtin_amdgcn_s_barrier(); } while (0)
#define DB_SYNC6() do { asm volatile("s_waitcnt vmcnt(6) lgkmcnt(0)" ::: "memory"); __builtin_amdgcn_s_barrier(); } while (0)
#define DB_STEP(ai, At, sb, sa, gb, ga, vo) do { \
        DB_STAGEB1(sb, gb, 0); DB_SCHED; DB_MMA4(ai, 0, 0, At, B0); DB_SCHED; DB_STAGEB1(sb, gb, 1); DB_SCHED; DB_MMA4(ai, 0, 2, At, B0); DB_SCHED; \
        DB_STAGEA1(sa, ga, vo, 0); DB_SCHED; DB_MMA4(ai, 1, 0, At, B1); DB_SCHED; DB_STAGEA1(sa, ga, vo, 1); DB_SCHED; DB_MMA4(ai, 1, 2, At, B1); DB_SCHED; } while (0)
#define DB_SCHED __builtin_amdgcn_sched_barrier(0)
    Unit cur, nxt; int ui = 0;
    if (!S.next(0, cur)) return;
    f32x4 acc[2][2][4][2]; typename Epi::Pre pre;
    E.prefetch(pre, cur, wc, fq); E.init(acc, pre);
    v6i32 A0[4], A1[4], B0[2], B1[2];
    const int sc_w = 121, sc_a = 126;
    if (wid >= 4) __builtin_amdgcn_s_setprio(1);
    DB_AOFF(vc, 0);
    DB_STAGEB(DB_SB(0, 0), cur.B0); DB_STAGEA(DB_SA(0, 0), cur.A, vc[0]); DB_STAGEB(DB_SB(0, 1), cur.B1); DB_STAGEA(DB_SA(0, 1), cur.A, vc[1]);
    DB_STAGEB(DB_SB(1, 0), cur.B0 + kstep); DB_STAGEA(DB_SA(1, 0), cur.A + kstep, vc[0]); DB_STAGEB(DB_SB(1, 1), cur.B1 + kstep); DB_STAGEA(DB_SA(1, 1), cur.A + kstep, vc[1]);
    DB_SYNC();
    DB_LDB(B0, 0, 0); DB_LDB(B1, 0, 1); DB_LDA(A0, 0, 0); DB_SCHED;
    for (;;) {
        const bool has_next = S.next(ui + 1, nxt);
        const char* nA = has_next ? nxt.A : cur.A; const char* nB0 = has_next ? nxt.B0 : cur.B0; const char* nB1 = has_next ? nxt.B1 : cur.B1;
#pragma nounroll
        for (int t = 0; t < nt; t += 2) {
            const bool last = (t == nt - 2);
            const char* a2 = last ? nA : cur.A + (size_t)(t + 2) * kstep;
            const char* b20 = last ? nB0 : cur.B0 + (size_t)(t + 2) * kstep; const char* b21 = last ? nB1 : cur.B1 + (size_t)(t + 2) * kstep;
            const char* a3 = a2 + kstep; const char* b30 = b20 + kstep; const char* b31 = b21 + kstep;
            if (last && has_next) DB_AOFF(vc, ui + 1);
            DB_SYNC(); DB_LDA(A1, 0, 1); DB_SCHED; DB_STEP(0, A0, DB_SB(0, 0), DB_SA(0, 0), b20, a2, vc[0]);
            DB_SYNC6(); DB_LDA(A0, 1, 0); DB_SCHED; DB_STEP(1, A1, DB_SB(0, 1), DB_SA(0, 1), b21, a2, vc[1]); DB_LDB(B0, 1, 0); DB_LDB(B1, 1, 1); DB_SCHED;
            DB_SYNC(); DB_LDA(A1, 1, 1); DB_SCHED; DB_STEP(0, A0, DB_SB(1, 0), DB_SA(1, 0), b30, a3, vc[0]);
            DB_SYNC6(); if (!last) DB_LDA(A0, 0, 0); DB_SCHED; DB_STEP(1, A1, DB_SB(1, 1), DB_SA(1, 1), b31, a3, vc[1]); if (!last) { DB_LDB(B0, 0, 0); DB_LDB(B1, 0, 1); } DB_SCHED;
        }
        asm volatile("s_nop 15\n\ts_nop 15\n\ts_nop 15\n\ts_nop 15" ::: "memory");
        { const unsigned _l = (unsigned)__builtin_amdgcn_mbcnt_hi(~0u, __builtin_amdgcn_mbcnt_lo(~0u, 0u)); if (has_next) E.prefetch(pre, nxt, wc, (int)(_l >> 4)); E(acc, cur, wr, wc, (int)(_l & 15u), (int)(_l >> 4)); }
        if (!has_next) break;
        E.init(acc, pre);
        cur = nxt; ++ui;
        DB_LDB(B0, 0, 0); DB_LDB(B1, 0, 1); DB_LDA(A0, 0, 0); DB_SCHED;
    }
    asm volatile("s_waitcnt vmcnt(0) lgkmcnt(0)" ::: "memory");
    __builtin_amdgcn_s_setprio(0);
    __builtin_amdgcn_s_barrier();
#undef DB_AOFF
#undef DB_SA
#undef DB_SB
#undef DB_STAGEA
#undef DB_STAGEB
#undef DB_LDA
#undef DB_LDB
#undef DB_MMA
#undef DB_SYNC
#undef DB_SYNC6
#undef DB_STEP
#undef DB_MMA4
#undef DB_STAGEA1
#undef DB_STAGEB1
#undef DB_SCHED
}

typedef f32x4 Acc[2][2][4][2];

struct EpiProj {
    static constexpr bool PERM = true, KEEPS = false;
    bf16_t* O; const float* bgate;
    __device__ __forceinline__ void operator()(Acc& acc, const Unit& u, int wr, int wc, int fr, int fq) const {
        const int row0 = u.r0 + wr * 64 + fr, col0 = u.c0 + wc * 32 + 8 * fq; const bool gate = u.c0 >= INW;
        f32x4 bv[2][2];
#pragma unroll
        for (int bj = 0; bj < 2; ++bj)
#pragma unroll
            for (int n = 0; n < 2; ++n) bv[bj][n] = gate ? *(const f32x4*)(bgate + (col0 - INW) + bj * HALF + 4 * n) : (f32x4){0.f, 0.f, 0.f, 0.f};
#pragma unroll
        for (int ai = 0; ai < 2; ++ai)
#pragma unroll
            for (int m = 0; m < 4; ++m) { bf16_t* rowp = O + (size_t)(row0 + ai * HALF + m * 16) * NP1 + col0;
#pragma unroll
                for (int bj = 0; bj < 2; ++bj) { f32x4 v0 = acc[ai][bj][m][0] + bv[bj][0], v1 = acc[ai][bj][m][1] + bv[bj][1];
                    if (gate) {
#pragma unroll
                        for (int j = 0; j < 4; ++j) { v0[j] = sigmoidf_fast(v0[j]); v1[j] = sigmoidf_fast(v1[j]); } }
                    u32x4 w; w.x = cvt_pk_bf16(v0[0], v0[1]); w.y = cvt_pk_bf16(v0[2], v0[3]); w.z = cvt_pk_bf16(v1[0], v1[1]); w.w = cvt_pk_bf16(v1[2], v1[3]);
                    *(u32x4*)(rowp + bj * HALF) = w; } }
    }
};
struct EpiBf16 {
    static constexpr bool PERM = true, KEEPS = false;
    bf16_t* O; int ldc; const float* cscale;
    __device__ __forceinline__ void operator()(Acc& acc, const Unit& u, int wr, int wc, int fr, int fq) const {
        const int row0 = u.r0 + wr * 64 + fr, col0 = u.c0 + wc * 32 + 8 * fq;
#pragma unroll
        for (int bj = 0; bj < 2; ++bj) {
            const f32x4 s0 = cscale ? *(const f32x4*)(cscale + col0 + bj * HALF) : (f32x4){1.f, 1.f, 1.f, 1.f}, s1 = cscale ? *(const f32x4*)(cscale + col0 + bj * HALF + 4) : (f32x4){1.f, 1.f, 1.f, 1.f};
#pragma unroll
            for (int ai = 0; ai < 2; ++ai)
#pragma unroll
                for (int m = 0; m < 4; ++m) { bf16_t* rowp = O + (size_t)(row0 + ai * HALF + m * 16) * ldc + col0;
                    const f32x4 v0 = acc[ai][bj][m][0] * s0, v1 = acc[ai][bj][m][1] * s1;
                    u32x4 w; w.x = cvt_pk_bf16(v0[0], v0[1]); w.y = cvt_pk_bf16(v0[2], v0[3]); w.z = cvt_pk_bf16(v1[0], v1[1]); w.w = cvt_pk_bf16(v1[2], v1[3]);
                    *(u32x4*)(rowp + bj * HALF) = w; } }
    }
};
struct EpiBranch {
    static constexpr bool PERM = true, KEEPS = true;
    const bf16_t* PG; bf16_t* MG;
    __device__ __forceinline__ bool keep(const Unit& u) const { return u.x == 0; }
    __device__ __forceinline__ void operator()(Acc& acc, const Unit& u, int wr, int wc, int fr, int fq) const {
        const int row0 = u.r0 + wr * 64 + fr, col0 = u.c0 + wc * 32 + 8 * fq;
        if (u.x == 0) {
#pragma unroll
            for (int ai = 0; ai < 2; ++ai) { u32x4 gb[4][2], ga[4][2];
#pragma unroll
                for (int m = 0; m < 4; ++m)
#pragma unroll
                    for (int bj = 0; bj < 2; ++bj) { const bf16_t* gp = PG + (size_t)(row0 + ai * HALF + m * 16) * NP1 + INW + col0 + bj * HALF; gb[m][bj] = *(const u32x4*)(gp + D); ga[m][bj] = *(const u32x4*)gp; }
                asm volatile("" ::: "memory");
#pragma unroll
                for (int m = 0; m < 4; ++m)
#pragma unroll
                    for (int bj = 0; bj < 2; ++bj) { const u32x4 g = gb[m][bj], a = ga[m][bj];
                        const f32x4 h0 = {bf_lo(g.x), bf_hi(g.x), bf_lo(g.y), bf_hi(g.y)}, h1 = {bf_lo(g.z), bf_hi(g.z), bf_lo(g.w), bf_hi(g.w)};
                        const f32x4 a0 = {bf_lo(a.x), bf_hi(a.x), bf_lo(a.y), bf_hi(a.y)}, a1 = {bf_lo(a.z), bf_hi(a.z), bf_lo(a.w), bf_hi(a.w)};
#pragma unroll
                        for (int j = 0; j < 4; ++j) { acc[ai][bj][m][0][j] *= a0[j] * __builtin_amdgcn_rcpf(fmaxf(h0[j], 1e-30f)); acc[ai][bj][m][1][j] *= a1[j] * __builtin_amdgcn_rcpf(fmaxf(h1[j], 1e-30f)); } }
                asm volatile("" ::: "memory"); }
        } else {
#pragma unroll
            for (int ai = 0; ai < 2; ++ai) { u32x4 gb[4][2];
#pragma unroll
                for (int m = 0; m < 4; ++m)
#pragma unroll
                    for (int bj = 0; bj < 2; ++bj) gb[m][bj] = *(const u32x4*)(PG + (size_t)(row0 + ai * HALF + m * 16) * NP1 + INW + D + col0 + bj * HALF);
                asm volatile("" ::: "memory");
#pragma unroll
                for (int m = 0; m < 4; ++m)
#pragma unroll
                    for (int bj = 0; bj < 2; ++bj) { const u32x4 g = gb[m][bj];
                        f32x4 h0 = {bf_lo(g.x), bf_hi(g.x), bf_lo(g.y), bf_hi(g.y)}, h1 = {bf_lo(g.z), bf_hi(g.z), bf_lo(g.w), bf_hi(g.w)};
#pragma unroll
                        for (int j = 0; j < 4; ++j) { h0[j] = fmaxf(h0[j], 1e-30f); h1[j] = fmaxf(h1[j], 1e-30f); }
                        const f32x4 v0 = acc[ai][bj][m][0] * h0, v1 = acc[ai][bj][m][1] * h1;
                        u32x4 w; w.x = cvt_pk_bf16(v0[0], v0[1]); w.y = cvt_pk_bf16(v0[2], v0[3]); w.z = cvt_pk_bf16(v1[0], v1[1]); w.w = cvt_pk_bf16(v1[2], v1[3]);
                        *(u32x4*)(MG + (size_t)(row0 + ai * HALF + m * 16) * D + col0 + bj * HALF) = w; }
                asm volatile("" ::: "memory"); }
        }
    }
};
struct EpiResid {
    static constexpr bool PERM = false, KEEPS = false;
    const float* res; float* out; int ldc;
    __device__ __forceinline__ void operator()(Acc& acc, const Unit& u, int wr, int wc, int fr, int fq) const {
        const int row0 = u.r0 + wr * 64 + fr, col0 = u.c0 + wc * 32 + 4 * fq;
#pragma unroll
        for (int ai = 0; ai < 2; ++ai) {
            f32x4 r[4][2][2];
#pragma unroll
            for (int m = 0; m < 4; ++m) { const size_t off = (size_t)(row0 + ai * HALF + m * 16) * ldc + col0;
#pragma unroll
                for (int bj = 0; bj < 2; ++bj)
#pragma unroll
                    for (int n = 0; n < 2; ++n) r[m][bj][n] = *(const f32x4*)(res + off + bj * HALF + n * 16); }
            asm volatile("" ::: "memory");
#pragma unroll
            for (int m = 0; m < 4; ++m) { const size_t off = (size_t)(row0 + ai * HALF + m * 16) * ldc + col0;
#pragma unroll
                for (int bj = 0; bj < 2; ++bj)
#pragma unroll
                    for (int n = 0; n < 2; ++n) *(f32x4*)(out + off + bj * HALF + n * 16) = r[m][bj][n] + acc[ai][bj][m][n]; }
            asm volatile("" ::: "memory"); }
    }
};
struct EpiUp {
    static constexpr bool PERM = true, KEEPS = false;
    const float* bup; unsigned char* ACT;
    struct Pre { f32x4 bg[2], bl[2]; };
    __device__ __forceinline__ void prefetch(Pre& p, const Unit& u, int wc, int fq) const {
        const float* be = bup + (size_t)u.x * (2 * DFF) + u.c0 * HALF + wc * 32 + 8 * fq;
#pragma unroll
        for (int n = 0; n < 2; ++n) { p.bg[n] = *(const f32x4*)(be + 4 * n); p.bl[n] = *(const f32x4*)(be + DFF + 4 * n) + 1.0f; }
    }
    __device__ __forceinline__ void init(Acc& acc, const Pre& p) const {
#pragma unroll
        for (int ai = 0; ai < 2; ++ai)
#pragma unroll
            for (int m = 0; m < 4; ++m)
#pragma unroll
                for (int n = 0; n < 2; ++n) { acc[ai][0][m][n] = p.bg[n]; acc[ai][1][m][n] = p.bl[n]; }
    }
    __device__ __forceinline__ void operator()(Acc& acc, const Unit& u, int wr, int wc, int fr, int fq) const {
        const int row0 = u.r0 + wr * 64 + fr, col0 = u.c0 * HALF + wc * 32 + 8 * fq;
        typedef float f32x2v __attribute__((ext_vector_type(2)));
#pragma unroll
        for (int ai = 0; ai < 2; ++ai)
#pragma unroll
            for (int m = 0; m < 4; ++m) { unsigned char* rowp = ACT + (size_t)(row0 + ai * HALF + m * 16) * DFF + col0; f32x4 o[2];
#pragma unroll
                for (int n = 0; n < 2; ++n) { const f32x4 gv = acc[ai][0][m][n], lv = acc[ai][1][m][n];
#pragma unroll
                    for (int j = 0; j < 4; j += 2) {
                        const f32x2v g = {__builtin_amdgcn_fmed3f(gv[j], -3.0e38f, 7.0f), __builtin_amdgcn_fmed3f(gv[j + 1], -3.0e38f, 7.0f)}, l = {__builtin_amdgcn_fmed3f(lv[j], -6.0f, 8.0f), __builtin_amdgcn_fmed3f(lv[j + 1], -6.0f, 8.0f)};
                        const f32x2v t = g * -2.4554669595930156f; const f32x2v e = {__builtin_amdgcn_exp2f(t.x), __builtin_amdgcn_exp2f(t.y)}; const f32x2v d = e + 1.0f;
                        const f32x2v r = {__builtin_amdgcn_rcpf(d.x), __builtin_amdgcn_rcpf(d.y)}; const f32x2v q = (g * l) * r; o[n][j] = q.x; o[n][j + 1] = q.y; } }
                u32x2 w; w.x = pk4_fp8(o[0][0], o[0][1], o[0][2], o[0][3]); w.y = pk4_fp8(o[1][0], o[1][1], o[1][2], o[1][3]);
                *(u32x2*)rowp = w; }
    }
};
struct EpiDown {
    static constexpr bool PERM = true, KEEPS = false;
    const float* bdn; const int* rslot; const float* gate; unsigned char* SLOT;
    __device__ __forceinline__ void operator()(Acc& acc, const Unit& u, int wr, int wc, int fr, int fq) const {
        const int row0 = u.r0 + wr * 64 + fr, col0 = u.c0 * BM + wc * 32 + 8 * fq; const float* be = bdn + (size_t)u.x * D;
        int sl[2][4]; float gt[2][4];
#pragma unroll
        for (int ai = 0; ai < 2; ++ai)
#pragma unroll
            for (int m = 0; m < 4; ++m) sl[ai][m] = rslot[row0 + ai * HALF + m * 16];
#pragma unroll
        for (int ai = 0; ai < 2; ++ai)
#pragma unroll
            for (int m = 0; m < 4; ++m) gt[ai][m] = gate[sl[ai][m] < 0 ? 0 : sl[ai][m]] * 16.0f;
        f32x4 bv[2][2];
#pragma unroll
        for (int bj = 0; bj < 2; ++bj)
#pragma unroll
            for (int n = 0; n < 2; ++n) bv[bj][n] = *(const f32x4*)(be + col0 + bj * HALF + 4 * n);
#pragma unroll
        for (int ai = 0; ai < 2; ++ai)
#pragma unroll
            for (int m = 0; m < 4; ++m) {
                if (sl[ai][m] >= 0) { const float g = gt[ai][m]; unsigned char* rowp = SLOT + (size_t)sl[ai][m] * D + col0;
#pragma unroll
                    for (int bj = 0; bj < 2; ++bj) { const f32x4 v0 = (acc[ai][bj][m][0] + bv[bj][0]) * g, v1 = (acc[ai][bj][m][1] + bv[bj][1]) * g;
                        u32x2 w; w.x = pk4_fp8(v0[0], v0[1], v0[2], v0[3]); w.y = pk4_fp8(v1[0], v1[1], v1[2], v1[3]);
                        *(u32x2*)(rowp + bj * HALF) = w; } } }
    }
};
}

struct Frame {
    LAS unsigned char* lds;
    int tid, lane, wave, vcu, G;
};

__device__ __forceinline__ void cvt_item_addr(const float* W, int K, int N, bf16_t* WT, int row_off, int item, int lane, const float*& src, bf16_t*& dst) {
    const int nblk = N >> 5, kb = item / nblk, nb = item - kb * nblk, kl = lane >> 3, nl = lane & 7;
    src = W + (size_t)(64 * kb + 8 * kl) * N + 32 * nb + 4 * nl; dst = WT + (size_t)(row_off + 32 * nb + 4 * nl) * K + 64 * kb + 8 * kl;
}
__device__ __forceinline__ void cvt_store(const f32x4 (&v)[8], bf16_t* dst, int K) {
#pragma unroll
    for (int i = 0; i < 4; ++i) { u32x4 o; o.x = cvt_pk_bf16(v[0][i], v[1][i]); o.y = cvt_pk_bf16(v[2][i], v[3][i]); o.z = cvt_pk_bf16(v[4][i], v[5][i]); o.w = cvt_pk_bf16(v[6][i], v[7][i]);
        *(u32x4*)(dst + (size_t)i * K) = o; }
}
__device__ __forceinline__ void cvt_store8(const f32x4 (&v)[8], unsigned char* dst, int K) {
#pragma unroll
    for (int i = 0; i < 4; ++i) { u32x2 o; o.x = pk4_fp8(v[0][i] * 64.f, v[1][i] * 64.f, v[2][i] * 64.f, v[3][i] * 64.f); o.y = pk4_fp8(v[4][i] * 64.f, v[5][i] * 64.f, v[6][i] * 64.f, v[7][i] * 64.f);
        *(u32x2*)(dst + (size_t)i * K) = o; }
}
__device__ __forceinline__ void cvt_range(const float* W, int K, int N, bf16_t* WT, int row_off, int i0, int cnt, int r, int nw, int lane) {
    int it = i0 + r; const int end = i0 + cnt;
    for (; it + nw < end; it += 2 * nw) {
        const float* s0; bf16_t* d0; const float* s1; bf16_t* d1;
        cvt_item_addr(W, K, N, WT, row_off, it, lane, s0, d0); cvt_item_addr(W, K, N, WT, row_off, it + nw, lane, s1, d1);
        f32x4 a[8], b[8];
#pragma unroll
        for (int j = 0; j < 8; ++j) a[j] = *(const f32x4*)(s0 + (size_t)j * N);
#pragma unroll
        for (int j = 0; j < 8; ++j) b[j] = *(const f32x4*)(s1 + (size_t)j * N);
        cvt_store(a, d0, K); cvt_store(b, d1, K);
    }
    if (it < end) { const float* s0; bf16_t* d0; cvt_item_addr(W, K, N, WT, row_off, it, lane, s0, d0); f32x4 a[8];
#pragma unroll
        for (int j = 0; j < 8; ++j) a[j] = *(const f32x4*)(s0 + (size_t)j * N);
        cvt_store(a, d0, K); }
}
constexpr int CV_UP = NE * (D / 64) * (2 * DFF / 32), CV_DN = NE * (DFF / 64) * (D / 32), CV_ALL = CV_UP + CV_DN;
struct MoeW { const float* w_up; const float* w_down; unsigned char* WUPT; unsigned char* WDNT; };
__device__ __forceinline__ void cvt_moe_addr(const MoeW& mw, int chunk, int w, int h, int lane, const float*& src, unsigned char*& dst, int& N) {
    const int kl = lane >> 3, nl = lane & 7;
    if (chunk < CV_UP / 64) { const int e = chunk >> 6, cc = chunk & 63, kb = 8 * (cc >> 4) + w, nb = 8 * (cc & 15) + h; N = 2 * DFF;
        src = mw.w_up + (size_t)e * D * 2 * DFF + (size_t)(64 * kb + 8 * kl) * (2 * DFF) + 32 * nb + 4 * nl; dst = mw.WUPT + (size_t)e * 2 * DFF * D + (size_t)(32 * nb + 4 * nl) * D + 64 * kb + 8 * kl; }
    else { const int q = chunk - CV_UP / 64, e = q >> 5, cc = q & 31, kb = 8 * (cc >> 3) + w, nb = 8 * (cc & 7) + h; N = D;
        src = mw.w_down + (size_t)e * DFF * D + (size_t)(64 * kb + 8 * kl) * D + 32 * nb + 4 * nl; dst = mw.WDNT + (size_t)e * D * DFF + (size_t)(32 * nb + 4 * nl) * DFF + 64 * kb + 8 * kl; }
}
__device__ __forceinline__ f32x4 ld_nt(const float* p) { return __builtin_nontemporal_load((const f32x4*)p); }
constexpr int CV_WG = 64;
__device__ __forceinline__ int cvt_claim(unsigned* cursor, int cap, unsigned* done, unsigned need) {
    if (done && __hip_atomic_load(done, __ATOMIC_RELAXED, __HIP_MEMORY_SCOPE_AGENT) >= need) return CV_ALL;
    if ((int)__hip_atomic_load(cursor, __ATOMIC_RELAXED, __HIP_MEMORY_SCOPE_AGENT) >= cap) return CV_ALL;
    return (int)__hip_atomic_fetch_add(cursor, (unsigned)CV_WG, __ATOMIC_RELAXED, __HIP_MEMORY_SCOPE_AGENT);
}
__device__ __forceinline__ void cvt_pull(const MoeW& mw, unsigned* cursor, int cap, unsigned* done, unsigned need, volatile LAS int* slot, int tid, int wave, int lane) {
    __syncthreads();
    if (tid == 0) *slot = cvt_claim(cursor, cap, done, need);
    __syncthreads();
    int base = __builtin_amdgcn_readfirstlane(*slot);
    while (base < CV_ALL) {
        int nb = CV_ALL; if (tid == 0) nb = cvt_claim(cursor, cap, done, need);
        const int chunk = base >> 6;
        if (chunk < CV_UP / 64) {
            const int e = chunk >> 6, cc = chunk & 63, nb = 8 * (cc & 15) + wave, kl = lane >> 3, nl = lane & 7;
#pragma unroll 1
            for (int q = 0; q < 2; ++q) { const int kq = 2 * (cc >> 4) + q, kb32 = 8 * kq + kl;
                const float* src = mw.w_up + (size_t)e * D * 2 * DFF + (size_t)(32 * kb32) * (2 * DFF) + 32 * nb + 4 * nl;
                f32x4 a[32];
#pragma unroll
                for (int j = 0; j < 32; ++j) a[j] = ld_nt(src + (size_t)j * (2 * DFF));
                unsigned char* dst = mw.WUPT + (size_t)e * 2 * DFF * D + (size_t)(32 * nb + 4 * nl) * D + 128 * (kb32 >> 2) + 16 * (kb32 & 3);
#pragma unroll
                for (int i = 0; i < 4; ++i) { f32x16 lo, hi;
#pragma unroll
                    for (int j = 0; j < 16; ++j) { lo[j] = a[j][i] * 64.f; hi[j] = a[16 + j][i] * 64.f; }
                    st_fp6_block(dst + (size_t)i * D, pk32_fp6(lo, hi)); } }
        } else
#pragma unroll
        for (int h = 0; h < 8; h += 4) {
            const float* s0; unsigned char* d0; const float* s1; unsigned char* d1; const float* s2; unsigned char* d2; const float* s3; unsigned char* d3; int N0, N1, N2, N3;
            cvt_moe_addr(mw, chunk, wave, h, lane, s0, d0, N0); cvt_moe_addr(mw, chunk, wave, h + 1, lane, s1, d1, N1); cvt_moe_addr(mw, chunk, wave, h + 2, lane, s2, d2, N2); cvt_moe_addr(mw, chunk, wave, h + 3, lane, s3, d3, N3);
            f32x4 a[8], b[8], c[8], d[8];
#pragma unroll
            for (int j = 0; j < 8; ++j) a[j] = ld_nt(s0 + (size_t)j * N0);
#pragma unroll
            for (int j = 0; j < 8; ++j) b[j] = ld_nt(s1 + (size_t)j * N1);
#pragma unroll
            for (int j = 0; j < 8; ++j) c[j] = ld_nt(s2 + (size_t)j * N2);
#pragma unroll
            for (int j = 0; j < 8; ++j) d[j] = ld_nt(s3 + (size_t)j * N3);
            cvt_store8(a, d0, D); cvt_store8(b, d1, D); cvt_store8(c, d2, D); cvt_store8(d, d3, D);
        }
        __syncthreads();
        if (tid == 0) *slot = nb;
        __syncthreads();
        base = __builtin_amdgcn_readfirstlane(*slot);
    }
}
__device__ __forceinline__ void rms_row_to_bf16(const float* xrow, const float* gvec, bf16_t* orow, int lane) {
    const f32x4* xr = (const f32x4*)xrow + lane; const f32x4* gr = (const f32x4*)gvec + lane; f32x4 v[8], g[8]; float s = 0.f;
#pragma unroll
    for (int j = 0; j < 8; ++j) { v[j] = xr[64 * j]; g[j] = gr[64 * j]; }
#pragma unroll
    for (int j = 0; j < 8; ++j) s += (v[j].x * v[j].x + v[j].y * v[j].y) + (v[j].z * v[j].z + v[j].w * v[j].w);
    const float rstd = 1.0f / sqrtf(wave_sum(s) * (1.0f / D) + RMS_EPS);
    u32x2* o8 = (u32x2*)orow + lane;
#pragma unroll
    for (int j = 0; j < 8; ++j) { const f32x4 y = v[j] * rstd * g[j]; u32x2 w; w.x = cvt_pk_bf16(y.x, y.y); w.y = cvt_pk_bf16(y.z, y.w); o8[64 * j] = w; }
}

__device__ __forceinline__ unsigned voff_b(unsigned row, unsigned ch) { return 256u * row + 16u * (ch ^ (((row & 3u) << 2) | ((row >> 2) & 3u))); }
__device__ __forceinline__ s16x4 vtr(const LAS unsigned char* p) { return __builtin_bit_cast(s16x4, __builtin_amdgcn_ds_read_tr16_b64_v4i16((LAS s16x4*)p)); }

__device__ __forceinline__ void sb_wg_unit(const bf16_t* PG, bf16_t* OA, int h, int qb, LAS unsigned char* lds, volatile LAS int* flags, int tid, int wave, int lane) {
    const int fr = lane & 15, fq = lane >> 4, q0w = qb * 128 + wave * 16, qi = q0w + fr;
    bf16x8 Qf[4];
    { const bf16_t* qp = PG + (size_t)qi * NP1 + h * HD + 8 * fq;
#pragma unroll
      for (int ks = 0; ks < 4; ++ks) Qf[ks] = *(const bf16x8*)(qp + 32 * ks); }
    f32x4 O[8];
#pragma unroll
    for (int db = 0; db < 8; ++db) O[db] = (f32x4){0.f, 0.f, 0.f, 0.f};
    float carry = 0.f; bool sat = false;
    const float scale = 0.08838834764831845f;
    const unsigned p = fr & 3, qq = fr >> 2;
    const int jt_hi = 2 * qb + 1, jt_w = q0w >> 6;
    const int srow = tid >> 4, sch = tid & 15;
    const bf16_t* kg = PG + (size_t)srow * NP1 + SBW + h * HD + 8 * sch;
    u32x4 kr[2], vr[2];
    __syncthreads();
    if (tid < 8) flags[tid] = 0;
    { const bf16_t* g = kg + (size_t)(jt_hi * 64) * NP1;
#pragma unroll
      for (int i = 0; i < 2; ++i) { kr[i] = *(const u32x4*)(g + (size_t)(32 * i) * NP1); vr[i] = *(const u32x4*)(g + (size_t)(32 * i) * NP1 + SBW); } }
    for (int jt = jt_hi, it = 0; jt >= 0; --jt, ++it) {
        LAS unsigned char* kb = lds + (it & 1) * 32768; LAS unsigned char* vb = kb + 16384;
#pragma unroll
        for (int i = 0; i < 2; ++i) { *(LAS u32x4*)(kb + voff_b(srow + 32 * i, sch)) = kr[i]; *(LAS u32x4*)(vb + voff_b(srow + 32 * i, sch)) = vr[i]; }
        __syncthreads();
        { int ns = 0;
#pragma unroll
          for (int w = 0; w < 8; ++w) ns += flags[w];
          if (__builtin_amdgcn_readfirstlane(ns) == 8) break; }
        if (jt > 0) { const bf16_t* g = kg + (size_t)((jt - 1) * 64) * NP1;
#pragma unroll
            for (int i = 0; i < 2; ++i) { kr[i] = *(const u32x4*)(g + (size_t)(32 * i) * NP1); vr[i] = *(const u32x4*)(g + (size_t)(32 * i) * NP1 + SBW); } }
        if (!sat && jt <= jt_w) {
            const int key0 = jt * 64;
            f32x4 z[4];
#pragma unroll
            for (int sb = 0; sb < 4; ++sb) { z[sb] = (f32x4){0.f, 0.f, 0.f, 0.f};
#pragma unroll
                for (int ks = 0; ks < 4; ++ks) { const bf16x8 kf = *(const LAS bf16x8*)(kb + voff_b(16 * sb + fr, 4 * ks + fq)); z[sb] = __builtin_amdgcn_mfma_f32_16x16x32_bf16(kf, Qf[ks], z[sb], 0, 0, 0); } }
            float sfx[4][4], g[4], lex[4], T[4];
            const bool diag = key0 + 64 > q0w;
#pragma unroll
            for (int sb = 0; sb < 4; ++sb) {
                float sp[4];
#pragma unroll
                for (int i = 0; i < 4; ++i) { const float y = z[sb][i] * (scale * 1.4426950408889634f); z[sb][i] = y;
                    sp[i] = fmaxf(y, 0.f) + __builtin_amdgcn_logf(1.0f + __builtin_amdgcn_exp2f(-fabsf(y))); }
                if (diag) {
#pragma unroll
                    for (int i = 0; i < 4; ++i) { const int key = key0 + 16 * sb + 4 * fq + i; sp[i] = (key < qi) ? sp[i] : 0.f; } }
                sfx[sb][3] = sp[3]; sfx[sb][2] = sp[2] + sfx[sb][3]; sfx[sb][1] = sp[1] + sfx[sb][2]; sfx[sb][0] = sp[0] + sfx[sb][1]; g[sb] = sfx[sb][0];
            }
#pragma unroll
            for (int sb = 0; sb < 4; ++sb) { const float x1 = __shfl_xor(g[sb], 16), x2 = __shfl_xor(g[sb], 32), x3 = __shfl_xor(g[sb], 48);
                T[sb] = (g[sb] + x1) + (x2 + x3); lex[sb] = ((fq & 1) ? 0.f : x1) + ((fq < 2) ? (x2 + x3) : 0.f); }
            float run = carry; bf16x8 Wf[2]; unsigned wpk[8];
#pragma unroll
            for (int sb = 3; sb >= 0; --sb) { const float base = run + lex[sb]; float w[4];
#pragma unroll
                for (int i = 0; i < 4; ++i) w[i] = __builtin_amdgcn_exp2f(z[sb][i] - (base + sfx[sb][i]));
                if (diag) {
#pragma unroll
                    for (int i = 0; i < 4; ++i) { const int key = key0 + 16 * sb + 4 * fq + i; w[i] = (key < qi) ? w[i] : 0.f; } }
                wpk[2 * sb] = cvt_pk_bf16(w[0], w[1]); wpk[2 * sb + 1] = cvt_pk_bf16(w[2], w[3]); run += T[sb]; }
            carry = run;
            { u32x4 a = {wpk[0], wpk[1], wpk[2], wpk[3]}, b = {wpk[4], wpk[5], wpk[6], wpk[7]}; Wf[0] = __builtin_bit_cast(bf16x8, a); Wf[1] = __builtin_bit_cast(bf16x8, b); }
#pragma unroll
            for (int db = 0; db < 8; ++db)
#pragma unroll
                for (int m = 0; m < 2; ++m) { const unsigned r1 = 32 * m + 4 * fq + qq, r2 = r1 + 16;
                    const s16x4 lo = vtr(vb + voff_b(r1, 2 * db + (p >> 1)) + 8 * (p & 1)), hi = vtr(vb + voff_b(r2, 2 * db + (p >> 1)) + 8 * (p & 1));
                    const bf16x8 vf = {lo[0], lo[1], lo[2], lo[3], hi[0], hi[1], hi[2], hi[3]};
                    O[db] = __builtin_amdgcn_mfma_f32_16x16x32_bf16(vf, Wf[m], O[db], 0, 0, 0); }
            if (__all(carry > 150.1f)) { sat = true; if (lane == 0) flags[wave] = 1; }
        }
    }
    { bf16_t* op = OA + (size_t)qi * SBW + h * HD + 4 * fq;
#pragma unroll
      for (int db = 0; db < 8; ++db) { u32x2 w; w.x = cvt_pk_bf16(O[db][0], O[db][1]); w.y = cvt_pk_bf16(O[db][2], O[db][3]); *(u32x2*)(op + 16 * db) = w; } }
}

__device__ __forceinline__ void xa_unit(const bf16_t* QXA, const bf16_t* KVM, bf16_t* OXA, int h, int qb, const LAS unsigned char* vl, int lane) {
    const int fr = lane & 15, fq = lane >> 4, q0 = qb * 16, qi = q0 + fr;
    bf16x8 Qf[4];
    { const bf16_t* qp = QXA + (size_t)qi * XAW + h * HD + 8 * fq;
#pragma unroll
      for (int ks = 0; ks < 4; ++ks) Qf[ks] = *(const bf16x8*)(qp + 32 * ks); }
    f32x4 z[16];
    { const bf16_t* kp = KVM + (size_t)fr * (2 * XAW) + h * HD + 8 * fq;
#pragma unroll
      for (int sb = 0; sb < 16; ++sb) { z[sb] = (f32x4){0.f, 0.f, 0.f, 0.f};
#pragma unroll
          for (int ks = 0; ks < 4; ++ks) { const bf16x8 kf = *(const bf16x8*)(kp + (size_t)(16 * sb) * (2 * XAW) + 32 * ks); z[sb] = __builtin_amdgcn_mfma_f32_16x16x32_bf16(kf, Qf[ks], z[sb], 0, 0, 0); } } }
    const float scale = 0.08838834764831845f * 1.4426950408889634f;
    float mx = -3.0e38f;
#pragma unroll
    for (int sb = 0; sb < 16; ++sb)
#pragma unroll
        for (int i = 0; i < 4; ++i) { z[sb][i] *= scale; mx = fmaxf(mx, z[sb][i]); }
    mx = fmaxf(mx, __shfl_xor(mx, 16)); mx = fmaxf(mx, __shfl_xor(mx, 32));
    float sum = 0.f;
#pragma unroll
    for (int sb = 0; sb < 16; ++sb)
#pragma unroll
        for (int i = 0; i < 4; ++i) { const float e = __builtin_amdgcn_exp2f(z[sb][i] - mx); z[sb][i] = e; sum += e; }
    sum += __shfl_xor(sum, 16); sum += __shfl_xor(sum, 32);
    const float inv = 1.0f / sum;
    f32x4 O[8];
#pragma unroll
    for (int db = 0; db < 8; ++db) O[db] = (f32x4){0.f, 0.f, 0.f, 0.f};
    const unsigned p = fr & 3, qq = fr >> 2;
#pragma unroll
    for (int m = 0; m < 8; ++m) {
        u32x4 a = {cvt_pk_bf16(z[2 * m][0], z[2 * m][1]), cvt_pk_bf16(z[2 * m][2], z[2 * m][3]), cvt_pk_bf16(z[2 * m + 1][0], z[2 * m + 1][1]), cvt_pk_bf16(z[2 * m + 1][2], z[2 * m + 1][3])};
        const bf16x8 Wf = __builtin_bit_cast(bf16x8, a);
#pragma unroll
        for (int db = 0; db < 8; ++db) { const unsigned r1 = 32 * m + 4 * fq + qq, r2 = r1 + 16;
            const s16x4 lo = vtr(vl + voff_b(r1, 2 * db + (p >> 1)) + 8 * (p & 1)), hi = vtr(vl + voff_b(r2, 2 * db + (p >> 1)) + 8 * (p & 1));
            const bf16x8 vf = {lo[0], lo[1], lo[2], lo[3], hi[0], hi[1], hi[2], hi[3]};
            O[db] = __builtin_amdgcn_mfma_f32_16x16x32_bf16(vf, Wf, O[db], 0, 0, 0); }
    }
    { bf16_t* op = OXA + (size_t)qi * XAW + h * HD + 4 * fq;
#pragma unroll
      for (int db = 0; db < 8; ++db) { const f32x4 o = O[db] * inv; u32x2 w; w.x = cvt_pk_bf16(o[0], o[1]); w.y = cvt_pk_bf16(o[2], o[3]); *(u32x2*)(op + 16 * db) = w; } }
}

template <int W>
__device__ __forceinline__ void pool_run(const bf16_t* PG, bf16_t* PO, int t0, int ch) {
    constexpr int NR = W + 7;
    const bf16_t* pp = PG + (size_t)(t0 + 7) * NP1 + 3 * SBW + ch * 8;
    u32x4 v[NR];
#pragma unroll
    for (int k = 0; k < NR; ++k) v[k] = (t0 + 7 - k >= 0) ? *(const u32x4*)(pp - (size_t)k * NP1) : (u32x4){0u, 0u, 0u, 0u};
#pragma unroll
    for (int i = 0; i < 8; ++i) {
        float s[8];
#pragma unroll
        for (int j = 0; j < 8; ++j) s[j] = 0.f;
#pragma unroll
        for (int j = W - 1; j >= 0; --j) { const u32x4 x = v[7 - i + j];
            s[0] += bf_lo(x.x); s[1] += bf_hi(x.x); s[2] += bf_lo(x.y); s[3] += bf_hi(x.y); s[4] += bf_lo(x.z); s[5] += bf_hi(x.z); s[6] += bf_lo(x.w); s[7] += bf_hi(x.w); }
        const int t = t0 + i, n = (t + 1 < W) ? (t + 1) : W; const float inv = 1.0f / (float)n; const u32x4 me = v[7 - i]; u32x4 o;
        o.x = cvt_pk_bf16(s[0] * inv - bf_lo(me.x), s[1] * inv - bf_hi(me.x)); o.y = cvt_pk_bf16(s[2] * inv - bf_lo(me.y), s[3] * inv - bf_hi(me.y));
        o.z = cvt_pk_bf16(s[4] * inv - bf_lo(me.z), s[5] * inv - bf_hi(me.z)); o.w = cvt_pk_bf16(s[6] * inv - bf_lo(me.w), s[7] * inv - bf_hi(me.w));
        *(u32x4*)(PO + (size_t)t * POOLW + ch * 8) = o;
    }
}

constexpr int NPHASE = 15;
struct Args { const float* in[24]; float* out; unsigned char* ws; int ph_lo, ph_hi; };
static_assert(sizeof(Args) == 24 * 8 + 8 + 8 + 8, "Args has no padding");

__global__ void __launch_bounds__(NWAVES * 64, 2) moe_fwd(Args args) {
    extern __shared__ __attribute__((aligned(16))) unsigned char lds_raw[];
    Frame F;
    F.lds = (LAS unsigned char*)lds_raw;
    F.tid = threadIdx.x; F.lane = F.tid & 63; F.wave = __builtin_amdgcn_readfirstlane(F.tid >> 6);
    F.G = gridDim.x; { const int bx = blockIdx.x; F.vcu = (F.G % 8 == 0) ? (bx % 8) * (F.G / 8) + bx / 8 : bx; }
    unsigned char* ws = args.ws;
    unsigned* ctl = (unsigned*)(ws + WS_CTL);
    LAS unsigned char* lx = F.lds + LDS_X_OFF;
    for (int u = F.tid; u < (LDS_BYTES - LDS_X_OFF) / 4; u += NWAVES * 64) ((LAS unsigned*)lx)[u] = 0u;
    __syncthreads();
#if MK_ONE_LAUNCH
    XcdBarrier bar = xcd_barrier_post(ctl + CW_BAR, (volatile LAS unsigned*)(lx + LX_BAR));
#define GRID_BAR() xcd_barrier(bar)
#else
#define GRID_BAR() do {} while (0)
#endif
    const int lo = args.ph_lo, hi = args.ph_hi;
#ifndef PHASE_MASK
#define PHASE_MASK 0x7fff
#endif
#define IN(k) (((PHASE_MASK >> (k)) & 1) && lo <= (k) && (k) < hi)
#define SEAM(k) do { if (IN((k) + 1)) GRID_BAR(); } while (0)

    const float* x = args.in[0]; const float* mem = args.in[1]; const float* norm_mix = args.in[2]; const float* w_in = args.in[3]; const float* pool_lin = args.in[4];
    const float* pool_scale = args.in[5]; const float* w_branch_a = args.in[6]; const float* w_branch_b = args.in[7]; const float* w_gate = args.in[8]; const float* b_gate = args.in[9];
    const float* w_mix_out = args.in[10]; const float* xa_norm = args.in[11]; const float* mem_norm = args.in[12]; const float* xa_wq = args.in[13]; const float* xa_wkv = args.in[14];
    const float* xa_wo = args.in[15]; const float* moe_norm = args.in[16]; const float* w_router = args.in[17]; const float* b_router = args.in[18]; const float* w_up = args.in[19];
    const float* b_up = args.in[20]; const float* w_down = args.in[21]; const float* b_down = args.in[22]; const float* final_norm = args.in[23];
    bf16_t* W1T = (bf16_t*)(ws + WS_W1T); bf16_t* WAT = (bf16_t*)(ws + WS_WAT); bf16_t* WBT = (bf16_t*)(ws + WS_WBT); bf16_t* WMT = (bf16_t*)(ws + WS_WMT); bf16_t* PLT = (bf16_t*)(ws + WS_PLT);
    bf16_t* WQT = (bf16_t*)(ws + WS_WQT); bf16_t* WKVT = (bf16_t*)(ws + WS_WKVT); bf16_t* WOT = (bf16_t*)(ws + WS_WOT); unsigned char* WUPT = ws + WS_WUPT; unsigned char* WDNT = ws + WS_WDNT;
    bf16_t* U = (bf16_t*)(ws + WS_U); bf16_t* MEMN = (bf16_t*)(ws + WS_MEMN); bf16_t* PG = (bf16_t*)(ws + WS_PG); bf16_t* OA = (bf16_t*)(ws + WS_OA); bf16_t* PO = (bf16_t*)(ws + WS_PO);
    bf16_t* OB = (bf16_t*)(ws + WS_OB); float* TMP = (float*)(ws + WS_TMP); bf16_t* MG = (bf16_t*)(ws + WS_MG); float* H1 = (float*)(ws + WS_H1); bf16_t* U2 = (bf16_t*)(ws + WS_U2);
    bf16_t* QXA = (bf16_t*)(ws + WS_QXA); bf16_t* KVM = (bf16_t*)(ws + WS_KVM); bf16_t* OXA = (bf16_t*)(ws + WS_OXA); float* H2 = (float*)(ws + WS_H2); unsigned char* TB = ws + WS_TB;
    bf16_t* ROWS = (bf16_t*)(ws + WS_ROWS); unsigned char* ACT = ws + WS_ACT; unsigned char* SLOT = ws + WS_SLOT;
    int* ASGE = (int*)(ws + WS_ASGE); int* ASGP = (int*)(ws + WS_ASGP); float* GATE = (float*)(ws + WS_GATE); int* RSLOT = (int*)(ws + WS_RSLOT);
    int* CNT = (int*)(ctl + CW_CNT); bf16_t* WRT = (bf16_t*)(ws + WS_WRT);
    const int gw = F.vcu * NWAVES + F.wave, NGW = F.G * NWAVES;
    const MoeW mw{w_up, w_down, WUPT, WDNT};
    unsigned* CUR = ctl + CW_CUR; volatile LAS int* cvs = (volatile LAS int*)(lx + LX_CVS);
#define CVT_PULL(cap) cvt_pull(mw, CUR, (cap), nullptr, 0u, cvs, F.tid, F.wave, F.lane)
#define CVT_BESIDE(cap, ph, need) cvt_pull(mw, CUR, (cap), ctl + CW_DONE + 64 * (ph), (unsigned)(need), cvs, F.tid, F.wave, F.lane)
#define MARK_DONE(ph) do { if (F.tid == 0) __hip_atomic_fetch_add(ctl + CW_DONE + 64 * (ph), 1u, __ATOMIC_RELAXED, __HIP_MEMORY_SCOPE_AGENT); } while (0)

    if (IN(0)) {
        constexpr int I_IN = (D / 64) * (INW / 32), I_BR = (SBW / 64) * (D / 32), I_MX = (D / 64) * (D / 32), I_PL = (256 / 64) * (256 / 32);
        constexpr int I_Q = (D / 64) * (XAW / 32), I_KV = (D / 64) * (2 * XAW / 32), I_O = (XAW / 64) * (D / 32);
        cvt_range(w_in, D, INW, W1T, 0, 0, I_IN, gw, NGW, F.lane);
        cvt_range(w_gate, D, INW, W1T, INW, 0, I_IN, gw, NGW, F.lane);
        for (int m = gw; m < S; m += NGW) rms_row_to_bf16(x + (size_t)m * D, norm_mix, U + (size_t)m * D, F.lane);
        for (int m = gw; m < MEM; m += NGW) rms_row_to_bf16(mem + (size_t)m * D, mem_norm, MEMN + (size_t)m * D, F.lane);
        for (int i = blockIdx.x * (NWAVES * 64) + F.tid; i < NE * D / 2; i += F.G * NWAVES * 64) {
            const int e = i >> 10, c = (i & 1023) * 2; const float a = w_router[(size_t)c * NE + e], b = w_router[(size_t)(c + 1) * NE + e];
            const unsigned hi = cvt_pk_bf16(a, b); const unsigned lo = cvt_pk_bf16(a - bf_lo(hi), b - bf_hi(hi));
            *(unsigned*)(WRT + (size_t)e * D + c) = hi; *(unsigned*)(WRT + (size_t)(NE + e) * D + c) = lo; }
        __syncthreads();
        SEAM(0);
    }

    if (IN(1)) {
        const int gc = (F.G == 256) ? GC_P1 : F.G;
        if ((int)blockIdx.x < gc) {
            pg8::DenseSched Sc{(const char*)U, (const char*)W1T, D, D, S / 256, NP1 / 256, gc, (int)blockIdx.x};
            pg8::EpiProj E{PG, b_gate};
            pg8::gemm_phase<pg8::EpiProj, pg8::DenseSched, true>(F.lds, D, D, D, Sc, E);
            MARK_DONE(1);
        }
        if ((int)blockIdx.x >= gc) {
            constexpr int I_BR = (SBW / 64) * (D / 32), I_MX = (D / 64) * (D / 32), I_PL = (256 / 64) * (256 / 32), I_Q = (D / 64) * (XAW / 32), I_KV = (D / 64) * (2 * XAW / 32), I_O = (XAW / 64) * (D / 32);
            const int cr = ((int)blockIdx.x - gc) * NWAVES + F.wave, cn = (F.G - gc) * NWAVES;
        cvt_range(w_branch_a, SBW, D, WAT, 0, 0, I_BR, cr, cn, F.lane);
        cvt_range(w_branch_b, POOLW, D, WBT, 0, 0, I_BR, cr, cn, F.lane);
        cvt_range(w_mix_out, D, D, WMT, 0, 0, I_MX, cr, cn, F.lane);
        for (int g = 0; g < 4; ++g) cvt_range(pool_lin + (size_t)g * 65536, 256, 256, PLT + (size_t)g * 65536, 0, 0, I_PL, cr, cn, F.lane);
        cvt_range(xa_wq, D, XAW, WQT, 0, 0, I_Q, cr, cn, F.lane);
        cvt_range(xa_wkv, D, 2 * XAW, WKVT, 0, 0, I_KV, cr, cn, F.lane);
        cvt_range(xa_wo, XAW, D, WOT, 0, 0, I_O, cr, cn, F.lane);
        }
        CVT_BESIDE(CV_UP, 1, gc);
        SEAM(1);
    }

    if (IN(2)) {
        for (int it = blockIdx.x * (NWAVES * 64) + F.tid; it < (S / 8) * (POOLW / 8); it += F.G * NWAVES * 64) {
            const int wv = it >> 6, g = wv & 3, rb = (wv >> 2) * 2 + (F.lane >> 5), ch = g * 32 + (F.lane & 31), t0 = rb * 8;
            if (g == 0) pool_run<2>(PG, PO, t0, ch); else if (g == 1) pool_run<4>(PG, PO, t0, ch); else if (g == 2) pool_run<8>(PG, PO, t0, ch); else pool_run<16>(PG, PO, t0, ch);
        }
        for (int it = F.vcu; it < SBH * (S / 128); it += F.G) { const int h = it & 7, qb = (S / 128 - 1) - (it >> 3); sb_wg_unit(PG, OA, h, qb, F.lds, (volatile LAS int*)(lx + LX_SBF), F.tid, F.wave, F.lane); }
        __syncthreads();
        SEAM(2);
    }

    if (IN(3)) {
        pg8::PoolSched Sc{(const char*)PO, (const char*)PLT, F.G, F.vcu};
        pg8::EpiBf16 E{OB, POOLW, pool_scale};
        pg8::gemm_phase<pg8::EpiBf16, pg8::PoolSched, true>(F.lds, 256, POOLW, 256, Sc, E);
        if (F.vcu < (S / 256) * 4) MARK_DONE(3);
        CVT_BESIDE(CV_UP, 3, (S / 256) * 4);
        SEAM(3);
    }

    if (IN(4)) {
        pg8::BranchSched Sc{(const char*)OA, (const char*)OB, (const char*)WAT, (const char*)WBT, SBW, SBW, S / 256, D / 256, F.G, (int)blockIdx.x};
        pg8::EpiBranch E{PG, MG};
        pg8::gemm_phase<pg8::EpiBranch, pg8::BranchSched, true>(F.lds, SBW, SBW, SBW, Sc, E);
        SEAM(4);
    }

    if (IN(5)) {
        pg8::DenseSched Sc{(const char*)MG, (const char*)WMT, D, D, S / 256, D / 256, F.G, (int)blockIdx.x};
        pg8::EpiResid E{x, H1, D};
        pg8::gemm_phase<pg8::EpiResid, pg8::DenseSched, true>(F.lds, D, D, D, Sc, E);
        SEAM(5);
    }

    if (IN(6)) {
        for (int m = gw; m < S; m += NGW) rms_row_to_bf16(H1 + (size_t)m * D, xa_norm, U2 + (size_t)m * D, F.lane);
        SEAM(6);
    }

    if (IN(7)) {
        { pg8::DenseSched Sc{(const char*)U2, (const char*)WQT, D, D, S / 256, XAW / 256, F.G, (int)blockIdx.x};
          pg8::EpiBf16 E{QXA, XAW, nullptr};
          pg8::gemm_phase<pg8::EpiBf16, pg8::DenseSched, true>(F.lds, D, D, D, Sc, E); }
        { const int c2 = ((int)blockIdx.x >= 64) ? (int)blockIdx.x - 64 : (int)blockIdx.x + F.G - 64;
          pg8::DenseSched Sc{(const char*)MEMN, (const char*)WKVT, D, D, MEM / 256, 2 * XAW / 256, F.G, c2};
          pg8::EpiBf16 E{KVM, 2 * XAW, nullptr};
          pg8::gemm_phase<pg8::EpiBf16, pg8::DenseSched, true>(F.lds, D, D, D, Sc, E); }
        if ((int)blockIdx.x < 68) MARK_DONE(7);
        CVT_BESIDE(CV_UP, 7, 68);
        SEAM(7);
    }

    if (IN(8)) {
        for (int it = F.vcu; it < XAH * (S / 128); it += F.G) {
            const int h = it & 3, qg = it >> 2;
            __syncthreads();
#pragma unroll
            for (int t = 0; t < 8; ++t) { const int c = t * 512 + F.tid, row = c >> 4, ch = c & 15;
                const u32x4 vv = *(const u32x4*)(KVM + (size_t)row * (2 * XAW) + XAW + h * HD + 8 * ch); *(LAS u32x4*)(F.lds + voff_b(row, ch)) = vv; }
            __syncthreads();
            xa_unit(QXA, KVM, OXA, h, qg * 8 + F.wave, F.lds, F.lane);
        }
        __syncthreads();
        SEAM(8);
    }

    if (IN(9)) {
        pg8::DenseSched Sc{(const char*)OXA, (const char*)WOT, XAW, XAW, S / 256, D / 256, F.G, (int)blockIdx.x};
        pg8::EpiResid E{H1, H2, D};
        pg8::gemm_phase<pg8::EpiResid, pg8::DenseSched, true>(F.lds, XAW, XAW, XAW, Sc, E);
        SEAM(9);
    }

    if (IN(10)) {
        for (int i = blockIdx.x * (NWAVES * 64) + F.tid; i < PROWS; i += F.G * NWAVES * 64) RSLOT[i] = -1;
        LAS unsigned char* thi = F.lds;
        LAS float* lg = (LAS float*)(lx + LX_LOG);
        LAS float* part = (LAS float*)(lx + LX_RPART);
        for (int rg = F.vcu; rg < S / 16; rg += F.G) {
            __syncthreads();
#pragma unroll
            for (int rr = 0; rr < 2; ++rr) { const int r = 2 * F.wave + rr, m = rg * 16 + r;
                const f32x4* xr = (const f32x4*)(H2 + (size_t)m * D) + F.lane; f32x4 v[8]; float s = 0.f;
#pragma unroll
                for (int j = 0; j < 8; ++j) { v[j] = xr[64 * j]; s += (v[j].x * v[j].x + v[j].y * v[j].y) + (v[j].z * v[j].z + v[j].w * v[j].w); }
                const float rstd = 1.0f / sqrtf(wave_sum(s) * (1.0f / D) + RMS_EPS);
                const f32x4* gr = (const f32x4*)moe_norm + F.lane; f32x4 gv[8];
#pragma unroll
                for (int j = 0; j < 8; ++j) gv[j] = gr[64 * j];
#pragma unroll
                for (int j = 0; j < 8; ++j) { const f32x4 g = gv[j]; const f32x4 y = v[j] * rstd * g; u32x2 w; w.x = cvt_pk_bf16(y.x, y.y); w.y = cvt_pk_bf16(y.z, y.w);
                    u32x2 l; l.x = cvt_pk_bf16(y.x - bf_lo(w.x), y.y - bf_hi(w.x)); l.y = cvt_pk_bf16(y.z - bf_lo(w.y), y.w - bf_hi(w.y));
                    const unsigned off = (unsigned)r * 4096u + ((((unsigned)F.lane >> 1) + 32u * j) ^ (unsigned)r) * 16u + (F.lane & 1) * 8u;
                    *(LAS u32x2*)(thi + off) = w; *(LAS u32x2*)(thi + 65536 + off) = l; } }
            __syncthreads();
#pragma unroll
            for (int q = 0; q < 2; ++q) { const int blk = F.tid + 512 * q, r = blk >> 6, kb32 = blk & 63; f32x16 lo, hi;
#pragma unroll
                for (int c4 = 0; c4 < 4; ++c4) { const u32x4 v = *(const LAS u32x4*)(thi + r * 4096 + ((unsigned)((4 * kb32 + c4) ^ r) * 16u));
                    const float f[8] = {bf_lo(v.x), bf_hi(v.x), bf_lo(v.y), bf_hi(v.y), bf_lo(v.z), bf_hi(v.z), bf_lo(v.w), bf_hi(v.w)};
#pragma unroll
                    for (int j = 0; j < 8; ++j) { if (c4 < 2) lo[8 * c4 + j] = f[j] * 2.0f; else hi[8 * (c4 - 2) + j] = f[j] * 2.0f; } }
                st_fp6_block(TB + (size_t)(rg * 16 + r) * D + 128 * (kb32 >> 2) + 16 * (kb32 & 3), pk32_fp6(lo, hi)); }
            { const int fr = F.lane & 15, fq = F.lane >> 4; f32x4 c0 = {0.f, 0.f, 0.f, 0.f}, c1 = {0.f, 0.f, 0.f, 0.f};
              const bf16_t* wh = WRT + (size_t)fr * D + 256 * F.wave + 8 * fq;
#pragma unroll
              for (int st = 0; st < 8; ++st) { const unsigned ch = (unsigned)(32 * F.wave + 4 * st + fq);
                  const bf16x8 ah = *(const LAS bf16x8*)(thi + fr * 4096 + ((ch ^ (unsigned)fr) * 16u)), al = *(const LAS bf16x8*)(thi + 65536 + fr * 4096 + ((ch ^ (unsigned)fr) * 16u));
                  const bf16x8 bh0 = *(const bf16x8*)(wh + 32 * st), bh1 = *(const bf16x8*)(wh + (size_t)16 * D + 32 * st), bl0 = *(const bf16x8*)(wh + (size_t)NE * D + 32 * st), bl1 = *(const bf16x8*)(wh + (size_t)(NE + 16) * D + 32 * st);
                  c0 = __builtin_amdgcn_mfma_f32_16x16x32_bf16(ah, bh0, c0, 0, 0, 0); c1 = __builtin_amdgcn_mfma_f32_16x16x32_bf16(ah, bh1, c1, 0, 0, 0);
                  c0 = __builtin_amdgcn_mfma_f32_16x16x32_bf16(ah, bl0, c0, 0, 0, 0); c1 = __builtin_amdgcn_mfma_f32_16x16x32_bf16(ah, bl1, c1, 0, 0, 0);
                  c0 = __builtin_amdgcn_mfma_f32_16x16x32_bf16(al, bh0, c0, 0, 0, 0); c1 = __builtin_amdgcn_mfma_f32_16x16x32_bf16(al, bh1, c1, 0, 0, 0); }
#pragma unroll
              for (int i = 0; i < 4; ++i) { part[(F.wave * 16 + 4 * fq + i) * 32 + fr] = c0[i]; part[(F.wave * 16 + 4 * fq + i) * 32 + 16 + fr] = c1[i]; } }
            __syncthreads();
            { const int r = F.tid >> 5, e = F.tid & 31; float a = 0.f;
#pragma unroll
              for (int w = 0; w < 8; ++w) a += part[(w * 16 + r) * 32 + e];
              lg[r * 32 + e] = a + b_router[e]; }
            __syncthreads();
            if (F.tid < 16) { const int r = F.tid, m = rg * 16 + r; float l[32];
#pragma unroll
                for (int e = 0; e < 32; ++e) l[e] = lg[r * 32 + e];
                int idx[4]; float val[4]; unsigned taken = 0u;
#pragma unroll
                for (int k = 0; k < 4; ++k) { float best = -3.4e38f; int bi = 0;
#pragma unroll
                    for (int e = 0; e < 32; ++e) { const bool ok = !((taken >> e) & 1u) && (l[e] > best); best = ok ? l[e] : best; bi = ok ? e : bi; }
                    idx[k] = bi; val[k] = best; taken |= 1u << bi; }
                const float e0 = 1.0f, e1 = expf(val[1] - val[0]), e2 = expf(val[2] - val[0]), e3 = expf(val[3] - val[0]); const float inv = 1.0f / (((e0 + e1) + e2) + e3);
                const float gk[4] = {e0 * inv, e1 * inv, e2 * inv, e3 * inv};
#pragma unroll
                for (int k = 0; k < 4; ++k) { const int pos = atomicAdd(CNT + idx[k], 1); ASGE[m * 4 + k] = idx[k]; ASGP[m * 4 + k] = pos; GATE[m * 4 + k] = gk[k]; } }
        }
        __syncthreads();
        SEAM(10);
    }

    LAS int* tab = (LAS int*)(lx + LX_TAB);
#define BUILD_TAB(NT) do { __syncthreads(); if (F.tid == 0) { int us = 0, ps = 0; for (int e = 0; e < NE; ++e) { const int c = CNT[e], nb = (c + EBLK - 1) / EBLK; tab[e] = us; tab[33 + e] = ps; tab[66 + e] = nb > 0 ? nb : 1; us += nb * (NT); ps += nb * EBLK; } tab[32] = us; tab[65] = ps; } __syncthreads(); } while (0)

    if (IN(11)) {
        BUILD_TAB(1);
        for (int s = blockIdx.x * (NWAVES * 64) + F.tid; s < NK; s += F.G * NWAVES * 64) { const int e = ASGE[s], pos = ASGP[s]; RSLOT[tab[33 + e] + pos] = s; }
        CVT_PULL(CV_UP);
        SEAM(11);
    }

    if (IN(12)) {
        BUILD_TAB(16);
        const int gc = (F.G == 256) ? GC_P12 : F.G; const int bx = (int)blockIdx.x;
        if ((bx >> 3) < (gc >> 3) || F.G != 256) {
            pg8::MoeSched Sc{(const char*)TB, (const char*)WUPT, 16, (size_t)2 * DFF * D, (size_t)128 * D, (size_t)DFF * D, tab, gc, (F.G == 256) ? (bx & 7) * (gc >> 3) + (bx >> 3) : F.vcu, true, (size_t)D};
            pg8::EpiUp E{b_up, ACT};
            LAS int* gtab = (LAS int*)(lx + LX_RPART);
            { int slv[8]; bool okv[8];
#pragma unroll
              for (int k = 0; k < 8; ++k) { pg8::Unit uu; okv[k] = Sc.next(2 * k + (F.tid >> 8), uu); slv[k] = RSLOT[(okv[k] ? uu.r0 : 0) + (F.tid & 255)]; }
#pragma unroll
              for (int k = 0; k < 8; ++k) if (okv[k]) gtab[(2 * k + (F.tid >> 8)) * 256 + (F.tid & 255)] = (slv[k] < 0 ? 0 : slv[k]) >> 2; }
            __syncthreads();
            pg8::gemm_phase_db6<pg8::EpiUp, pg8::MoeSched>(F.lds, D / 2, D / 2, D / 2, Sc, E, gtab);
            MARK_DONE(12);
        }
        CVT_BESIDE(CV_ALL, 12, gc);
        CVT_PULL(CV_ALL);
        SEAM(12);
    }

    if (IN(13)) {
        BUILD_TAB(8);
        pg8::MoeSched Sc{(const char*)ACT, (const char*)WDNT, 8, (size_t)D * DFF, (size_t)256 * DFF, (size_t)128 * DFF, tab, F.G, F.vcu, false, (size_t)DFF};
        pg8::EpiDown E{b_down, RSLOT, GATE, SLOT};
        pg8::gemm_phase<pg8::EpiDown, pg8::MoeSched, true, false, 1>(F.lds, DFF / 2, DFF / 2, DFF / 2, Sc, E);
        SEAM(13);
    }

    if (IN(14)) {
        for (int m = gw; m < S; m += NGW) {
            const f32x4* xr = (const f32x4*)(H2 + (size_t)m * D) + F.lane; f32x4 v[8]; float s = 0.f;
#pragma unroll
            for (int j = 0; j < 8; ++j) { v[j] = xr[64 * j];
#pragma unroll
                for (int k = 0; k < 4; ++k) { const int w = (int)*((const unsigned*)(SLOT + (size_t)(m * 4 + k) * D) + F.lane + 64 * j); const f32x2 lo = __builtin_amdgcn_cvt_pk_f32_fp8(w, false), hi = __builtin_amdgcn_cvt_pk_f32_fp8(w, true);
                    v[j].x += lo.x * 0.0625f; v[j].y += lo.y * 0.0625f; v[j].z += hi.x * 0.0625f; v[j].w += hi.y * 0.0625f; }
                s += (v[j].x * v[j].x + v[j].y * v[j].y) + (v[j].z * v[j].z + v[j].w * v[j].w); }
            const float rstd = 1.0f / sqrtf(wave_sum(s) * (1.0f / D) + RMS_EPS);
            const f32x4* gr = (const f32x4*)final_norm + F.lane; f32x4* o = (f32x4*)(args.out + (size_t)m * D) + F.lane; f32x4 gv[8];
#pragma unroll
            for (int j = 0; j < 8; ++j) gv[j] = gr[64 * j];
#pragma unroll
            for (int j = 0; j < 8; ++j) o[64 * j] = v[j] * rstd * gv[j];
        }
    }
#undef IN
#undef SEAM
}

extern "C" void kernel_launch(void* const* d_in, const int* in_sizes, int n_in, void* d_out, int out_size, void* d_ws, size_t ws_size, hipStream_t stream) {
    static int grid = 0;
    if (grid == 0) {
        if (n_in != 24 || out_size != S * D || ws_size < WS_END) { fprintf(stderr, "kernel_launch: unexpected shapes (n_in %d out %d ws %zu need %zu)\n", n_in, out_size, ws_size, (size_t)WS_END); grid = -1; return; }
        int dev = 0, cus = 0, per_cu = 0;
        if (hipGetDevice(&dev) != hipSuccess || hipDeviceGetAttribute(&cus, hipDeviceAttributeMultiprocessorCount, dev) != hipSuccess) { grid = -1; return; }
        if (hipFuncSetAttribute((const void*)moe_fwd, hipFuncAttributeMaxDynamicSharedMemorySize, LDS_BYTES) != hipSuccess) { fprintf(stderr, "kernel_launch: hipFuncSetAttribute failed\n"); grid = -1; return; }
        if (hipOccupancyMaxActiveBlocksPerMultiprocessor(&per_cu, (const void*)moe_fwd, NWAVES * 64, LDS_BYTES) != hipSuccess || per_cu < 1) { fprintf(stderr, "kernel_launch: occupancy query says %d\n", per_cu); per_cu = 1; }
        (void)hipGetLastError();
        grid = cus;
    }
    if (grid < 0) return;
    (void)hipMemsetAsync((char*)d_ws + WS_CTL, 0, CTL_ZERO_BYTES, stream);
    Args a{};
    for (int i = 0; i < 24; ++i) a.in[i] = (const float*)d_in[i];
    a.out = (float*)d_out; a.ws = (unsigned char*)d_ws;
#if MK_ONE_LAUNCH
    a.ph_lo = 0; a.ph_hi = NPHASE;
    hipLaunchKernelGGL(moe_fwd, dim3(grid), dim3(NWAVES * 64), LDS_BYTES, stream, a);
#else
    for (int p = 0; p < NPHASE; ++p) { a.ph_lo = p; a.ph_hi = p + 1; for (int rep = 0; rep < (((REPEAT_MASK >> p) & 1) ? 2 : 1); ++rep) hipLaunchKernelGGL(moe_fwd, dim3(grid), dim3(NWAVES * 64), LDS_BYTES, stream, a); }
#endif
}
```

```cpp
#include <hip/hip_runtime.h>
#include <cstdio>
#include <cstdint>

#ifndef MK_ONE_LAUNCH
#define MK_ONE_LAUNCH 1
#endif
#ifndef REPEAT_MASK
#define REPEAT_MASK 0
#endif
#define GC_P1 160
#define GC_P12 224

#define LAS __attribute__((address_space(3)))
#define GAS __attribute__((address_space(1)))
typedef unsigned short bf16_t;
typedef short bf16x8 __attribute__((ext_vector_type(8)));
typedef short s16x4 __attribute__((ext_vector_type(4)));
typedef float f32x4 __attribute__((ext_vector_type(4)));
typedef float f32x2 __attribute__((ext_vector_type(2)));
typedef unsigned u32x4 __attribute__((ext_vector_type(4)));
typedef unsigned u32x2 __attribute__((ext_vector_type(2)));
typedef int v8i32 __attribute__((ext_vector_type(8)));
typedef int v6i32 __attribute__((ext_vector_type(6)));
typedef unsigned u32x3 __attribute__((ext_vector_type(3)));
typedef float f32x16 __attribute__((ext_vector_type(16)));

constexpr int S = 8192, D = 2048, MEM = 256;
constexpr int SBH = 8, HD = 128, SBW = 1024, POOLW = 1024, INW = 4096, NP1 = 8192;
constexpr int XAH = 4, XAW = 512;
constexpr int NE = 32, TOPK = 4, DFF = 2048, NK = S * TOPK, EBLK = 256, MAXBLK = NK / EBLK + NE, PROWS = MAXBLK * EBLK;
constexpr float RMS_EPS = 1e-5f;

constexpr size_t MiB = 1u << 20;
constexpr size_t WS_CTL = 0, CTL_ZERO_BYTES = 1 * MiB;
constexpr size_t WS_W1T = 2 * MiB;
constexpr size_t WS_WAT = WS_W1T + 32 * MiB;
constexpr size_t WS_WBT = WS_WAT + 4 * MiB;
constexpr size_t WS_WMT = WS_WBT + 4 * MiB;
constexpr size_t WS_PLT = WS_WMT + 8 * MiB;
constexpr size_t WS_WQT = WS_PLT + 1 * MiB;
constexpr size_t WS_WKVT = WS_WQT + 2 * MiB;
constexpr size_t WS_WOT = WS_WKVT + 4 * MiB;
constexpr size_t WS_WUPT = WS_WOT + 2 * MiB;
constexpr size_t WS_WDNT = WS_WUPT + 512 * MiB;
constexpr size_t WS_U = WS_WDNT + 256 * MiB;
constexpr size_t WS_MEMN = WS_U + 32 * MiB;
constexpr size_t WS_PG = WS_MEMN + 1 * MiB;
constexpr size_t WS_OA = WS_PG + 128 * MiB;
constexpr size_t WS_PO = WS_OA + 16 * MiB;
constexpr size_t WS_OB = WS_PO + 16 * MiB;
constexpr size_t WS_TMP = WS_OB + 16 * MiB;
constexpr size_t WS_MG = WS_TMP + 64 * MiB;
constexpr size_t WS_H1 = WS_MG + 32 * MiB;
constexpr size_t WS_U2 = WS_H1 + 64 * MiB;
constexpr size_t WS_QXA = WS_U2 + 32 * MiB;
constexpr size_t WS_KVM = WS_QXA + 8 * MiB;
constexpr size_t WS_OXA = WS_KVM + 1 * MiB;
constexpr size_t WS_H2 = WS_OXA + 8 * MiB;
constexpr size_t WS_TB = WS_H2 + 64 * MiB;
constexpr size_t WS_ROWS = WS_TB + 32 * MiB;
constexpr size_t WS_ACT = WS_ROWS + 160 * MiB;
constexpr size_t WS_SLOT = WS_ACT + 160 * MiB;
constexpr size_t WS_ASGE = WS_SLOT + 128 * MiB;
constexpr size_t WS_ASGP = WS_ASGE + 1 * MiB;
constexpr size_t WS_GATE = WS_ASGP + 1 * MiB;
constexpr size_t WS_RSLOT = WS_GATE + 1 * MiB;
constexpr size_t WS_WRT = WS_RSLOT + 1 * MiB;
constexpr size_t WS_END = WS_WRT + 1 * MiB;
constexpr int CW_CNT = 64;
constexpr int CW_CUR = 192;  constexpr int CW_DONE = 256;
constexpr int CW_BAR = 4096;

constexpr int RING_BYTES = 131072;
constexpr int LDS_X_OFF = RING_BYTES;
constexpr int LDS_BYTES = 163840;
constexpr int LX_BAR = 0;
constexpr int LX_TAB = 64;
constexpr int LX_CVS = 32;
constexpr int LX_SBF = 128;
constexpr int LX_LOG = 1024;
constexpr int LX_RPART = 4096;

constexpr int NWAVES = 8;

__device__ __forceinline__ unsigned cvt_pk_bf16(float lo, float hi) { unsigned r; asm volatile("v_cvt_pk_bf16_f32 %0, %1, %2" : "=v"(r) : "v"(lo), "v"(hi)); return r; }
__device__ __forceinline__ unsigned pk4_fp8(float a, float b, float c, float d) { int p = __builtin_amdgcn_cvt_pk_fp8_f32(a, b, 0, false); p = __builtin_amdgcn_cvt_pk_fp8_f32(c, d, p, true); return (unsigned)p; }
__device__ __forceinline__ v6i32 pk32_fp6(const f32x16& lo, const f32x16& hi) { return __builtin_amdgcn_cvt_scalef32_2xpk16_fp6_f32(lo, hi, 1.0f); }
__device__ __forceinline__ void st_fp6_block(unsigned char* p, const v6i32& b) { *(u32x4*)p = (u32x4){(unsigned)b[0], (unsigned)b[1], (unsigned)b[2], (unsigned)b[3]}; *(u32x4*)(p + 64) = (u32x4){(unsigned)b[4], (unsigned)b[5], 0u, 0u}; }
__device__ __forceinline__ float bf_lo(unsigned w) { return __uint_as_float(w << 16); }
__device__ __forceinline__ float bf_hi(unsigned w) { return __uint_as_float(w & 0xffff0000u); }
__device__ __forceinline__ float wave_sum(float v) {
#pragma unroll
    for (int o = 1; o < 64; o <<= 1) v += __shfl_xor(v, o);
    return v;
}
__device__ __forceinline__ float sigmoidf_fast(float x) { return __builtin_amdgcn_rcpf(1.0f + __builtin_amdgcn_exp2f(x * -1.4426950408889634f)); }

#define XB_TMO      128
#define XB_XCNT(j)  (256  + 64 * (j))
#define XB_XSUB(j)  (1280 + 64 * (j))
#define XB_XGEN(j)  (2304 + 64 * (j))
#define XB_TOP      3328
#define XB_TOPGEN   3392
#define XCD_BAR_WORDS 3456
#define XB_SPIN_CAP (1u << 18)
__device__ __forceinline__ unsigned xb_ld(unsigned* p)              { return __hip_atomic_load(p, __ATOMIC_RELAXED, __HIP_MEMORY_SCOPE_AGENT); }
__device__ __forceinline__ unsigned xb_add(unsigned* p, unsigned v) { return __hip_atomic_fetch_add(p, v, __ATOMIC_RELAXED, __HIP_MEMORY_SCOPE_AGENT); }
__device__ __forceinline__ unsigned xb_xcc_id() { return (unsigned)__builtin_amdgcn_s_getreg((3 << 11) | 20) & 0xFu; }
#define XB_SPIN(cond, bar) do { unsigned _sp = 0; while (cond) { __builtin_amdgcn_s_sleep(1); \
    if ((++_sp & 255u) == 0u) { if (xb_ld(&(bar)[XB_TMO])) break; if (_sp > XB_SPIN_CAP) { atomicAdd(&(bar)[XB_TMO], 1u); break; } } } } while (0)
struct XcdBarrier { unsigned* bar; unsigned x; volatile LAS unsigned* st; };
__device__ __forceinline__ XcdBarrier xcd_barrier_post(unsigned* bar, volatile LAS unsigned* st) {
    XcdBarrier b; b.bar = bar; b.x = xb_xcc_id(); b.st = st;
    if (threadIdx.x == 0) (void)xb_add(&bar[XB_XCNT(b.x)], 1u);
    return b;
}
__device__ __forceinline__ void xcd_barrier_complete(unsigned* bar, unsigned x, unsigned& nloc, unsigned& nx) {
    const unsigned G = gridDim.x * gridDim.y * gridDim.z;
    unsigned sum, cnt, mine, sp = 0u;
    for (;;) {
        sum = 0u; cnt = 0u; mine = 0u;
#pragma unroll
        for (unsigned j = 0; j < 16; ++j) { const unsigned c = xb_ld(&bar[XB_XCNT(j)]); sum += c; cnt += (c > 0u) ? 1u : 0u; mine = (j == x) ? c : mine; }
        if (sum == G) break;
        __builtin_amdgcn_s_sleep(1);
        if ((++sp & 255u) == 0u) { if (xb_ld(&bar[XB_TMO])) break; if (sp > XB_SPIN_CAP) { atomicAdd(&bar[XB_TMO], 1u); break; } }
    }
    nloc = mine > 0u ? mine : 1u; nx = cnt > 0u ? cnt : 1u;
}
__device__ __forceinline__ void xcd_barrier(const XcdBarrier& b) {
    asm volatile("s_waitcnt vmcnt(0)" ::: "memory");
    __syncthreads();
    if (threadIdx.x == 0) {
        unsigned* bar = b.bar;
        __builtin_amdgcn_s_waitcnt(0);
        unsigned nloc = b.st[0], nx = b.st[1];
        if (nloc == 0u) { xcd_barrier_complete(bar, b.x, nloc, nx); b.st[0] = nloc; b.st[1] = nx; }
        const unsigned old = xb_add(&bar[XB_XSUB(b.x)], 1u);
        const unsigned gen = old / nloc;
        if (old + 1u == (gen + 1u) * nloc) {
            __builtin_amdgcn_fence(__ATOMIC_RELEASE, "agent");
            asm volatile("s_waitcnt vmcnt(0)" ::: "memory");
            const unsigned og = xb_add(&bar[XB_TOP], 1u);
            const unsigned tg = og / nx;
            if (og + 1u == (tg + 1u) * nx) xb_add(&bar[XB_TOPGEN], 1u);
            else XB_SPIN(xb_ld(&bar[XB_TOPGEN]) == tg, bar);
            __builtin_amdgcn_fence(__ATOMIC_ACQUIRE, "agent");
            xb_add(&bar[XB_XGEN(b.x)], 1u);
            asm volatile("s_waitcnt vmcnt(0)" ::: "memory");
        } else {
            XB_SPIN(xb_ld(&bar[XB_XGEN(b.x)]) == gen, bar);
            __builtin_amdgcn_fence(__ATOMIC_ACQUIRE, "agent");
            asm volatile("s_waitcnt vmcnt(0)" ::: "memory");
        }
    }
    __syncthreads();
}

namespace pg8 {
constexpr int BM = 256, BK = 64, HALF = 128, HTB = HALF * BK * 2, STAGE_BYTES = 8 * HTB, NXCD = 8, WGM = 8;
__host__ __device__ __forceinline__ int lds_byte(int r, int c) { const int st = (r >> 4) * 2 + (c >> 5), rr = r & 15, cc = c & 31, ob = rr * 64 + cc * 2; return st * 1024 + (ob ^ (((ob >> 9) & 1) << 5)); }
__host__ __device__ __forceinline__ void stage_rc(int b, int& R, int& C) { const int st = b / 1024, sb = b % 1024, swz = sb ^ (((sb >> 9) & 1) << 5); R = (st >> 1) * 16 + swz / 64; C = (st & 1) * 32 + (swz % 64) / 2; }
__host__ __device__ __forceinline__ int perm32(int rho) { const int n = rho >> 4, i = rho & 15; return 8 * (i >> 2) + 4 * n + (i & 3); }

struct Unit { const char* A; const char* B0; const char* B1; int r0, c0, x; };

__device__ __forceinline__ void tile_of(int L, int nM, int nN, int& pm, int& pn) {
    const int nwg = nM * nN; int wgid = L;
    { const int q = nwg / NXCD, r = nwg % NXCD, xcd = wgid % NXCD, off = wgid / NXCD; wgid = (xcd < r ? xcd * (q + 1) : r * (q + 1) + (xcd - r) * q) + off; }
    const int nig = WGM * nN, gid = wgid / nig, fm = gid * WGM, gsz = (nM - fm) < WGM ? (nM - fm) : WGM;
    pm = fm + ((wgid % nig) % gsz); pn = (wgid % nig) / gsz;
}
struct DenseSched {
    const char* A; const char* B; int lda, ldb, nM, nN, G, c;
    __device__ __forceinline__ bool next(int i, Unit& u) const {
        const long L = (long)i * G + c; if (L >= (long)nM * nN) return false;
        int pm, pn; tile_of((int)L, nM, nN, pm, pn);
        u.A = A + (size_t)pm * BM * lda * 2; u.B0 = B + (size_t)pn * BM * ldb * 2; u.B1 = u.B0 + (size_t)HALF * ldb * 2; u.r0 = pm * BM; u.c0 = pn * BM; u.x = 0; return true;
    }
};
struct BranchSched {
    const char* A0; const char* A1; const char* B0; const char* B1; int lda, ldb, nM, nN, G, c;
    __device__ __forceinline__ bool next(int i, Unit& u) const {
        const long L = (long)(i >> 1) * G + c; if (L >= (long)nM * nN) return false;
        int pm, pn; tile_of((int)L, nM, nN, pm, pn); const int br = i & 1;
        u.A = (br ? A1 : A0) + (size_t)pm * BM * lda * 2; u.B0 = (br ? B1 : B0) + (size_t)pn * BM * ldb * 2; u.B1 = u.B0 + (size_t)HALF * ldb * 2; u.r0 = pm * BM; u.c0 = pn * BM; u.x = br; return true;
    }
};
struct PoolSched {
    const char* A; const char* B; int G, c;
    __device__ __forceinline__ bool next(int i, Unit& u) const {
        const int L = i * G + c; if (L >= (S / BM) * 4) return false;
        const int pm = L >> 2, g = L & 3;
        u.A = A + ((size_t)pm * BM * POOLW + g * 256) * 2; u.B0 = B + (size_t)g * 256 * 256 * 2; u.B1 = u.B0 + (size_t)HALF * 256 * 2; u.r0 = pm * BM; u.c0 = g * 256; u.x = g; return true;
    }
};
struct MoeSched {
    const char* A; const char* B; int NT; size_t estride; size_t tstride; size_t hoff; const LAS int* tab; int G, c; bool gather; size_t arow;
    __device__ __forceinline__ int tu(int i) const { return __builtin_amdgcn_readfirstlane(tab[i]); }
    __device__ __forceinline__ bool next(int i, Unit& u) const {
        const int L = i * G + c; if (L >= tu(32)) return false;
        int e = 0;
#pragma unroll
        for (int s = 16; s >= 1; s >>= 1) { if (tu(e + s) <= L) e += s; }
        const int r = L - tu(e), nb = tu(66 + e), nt = r / nb, blk = r - nt * nb, prow = tu(33 + e) + blk * EBLK;
        u.A = gather ? A : A + (size_t)prow * arow; u.B0 = B + (size_t)e * estride + (size_t)nt * tstride; u.B1 = u.B0 + hoff; u.r0 = prow; u.c0 = nt; u.x = e; return true;
    }
};

template <class Epi, class Sched, bool ALIGN_EPI, bool GATHER = false, int PREC = 0>
__device__ __forceinline__ void gemm_phase(LAS unsigned char* lds, const int K, const int lda, const int ldb, const Sched& S, const Epi& E, const LAS int* gtab = nullptr) {
    const int tid = threadIdx.x, wid = __builtin_amdgcn_readfirstlane(tid >> 6), lane = tid & 63, wr = wid >> 2, wc = wid & 3, fr = lane & 15, fq = lane >> 4;
    const int nt = K / BK;
    unsigned voffB[2], vc[2][2], vn[2][2]; int RA[2], CA[2];
#pragma unroll
    for (int i = 0; i < 2; ++i) { int R, C; stage_rc(tid * 16 + i * 8192, R, C); const int Rb = Epi::PERM ? ((R & ~31) + perm32(R & 31)) : R; RA[i] = R; CA[i] = C;
        voffB[i] = (unsigned)(Rb * ldb + C) * 2u; }
#define PG8_AOFF(dst, ord) do { _Pragma("unroll") for (int _h = 0; _h < 2; ++_h) _Pragma("unroll") for (int _i = 0; _i < 2; ++_i) \
        dst[_h][_i] = GATHER ? ((unsigned)gtab[(ord) * 256 + _h * HALF + RA[_i]] * (unsigned)lda + (unsigned)CA[_i]) * 2u : (unsigned)((_h * HALF + RA[_i]) * lda + CA[_i]) * 2u; } while (0)
    const size_t kstep = (size_t)(BK * 2);
    const unsigned ldsw = (unsigned)wid * 1024u;
    const int aoff = lds_byte(wr * 64 + fr, fq * 8), boff = lds_byte(wc * 32 + fr, fq * 8);
#define PG8_SA(b, h) (((b) * 2 + (h)) * HTB)
#define PG8_SB(b, h) ((4 + (b) * 2 + (h)) * HTB)
#define PG8_STAGE(bufoff, gbase, voff) do { _Pragma("unroll") for (int _i = 0; _i < 2; ++_i) \
        __builtin_amdgcn_global_load_lds((const unsigned*)((const char*)(gbase) + (voff)[_i]), (LAS unsigned*)(lds + (bufoff) + ldsw + _i * 8192), 16, 0, 0); } while (0)
#define PG8_LD6(off) __builtin_bit_cast(v6i32, __builtin_shufflevector(*(const LAS u32x4*)(lds + (off)), __builtin_shufflevector(*(const LAS u32x2*)(lds + (off) + 1024), *(const LAS u32x2*)(lds + (off) + 1024), 0, 1, -1, -1), 0, 1, 2, 3, 4, 5))
#define PG8_LD8(off) __builtin_bit_cast(v8i32, __builtin_shufflevector(*(const LAS u32x4*)(lds + (off)), *(const LAS u32x4*)(lds + (off) + 1024), 0, 1, 2, 3, 4, 5, 6, 7))
#define PG8_LDA(dst, b, h) do { if (PREC == 2) { _Pragma("unroll") for (int m = 0; m < 4; ++m) dst##6[m] = PG8_LD6(PG8_SA(b, h) + aoff + m * 2048); } \
      else if (PREC == 1) { _Pragma("unroll") for (int m = 0; m < 4; ++m) dst##8[m] = PG8_LD8(PG8_SA(b, h) + aoff + m * 2048); } \
      else { _Pragma("unroll") for (int m = 0; m < 4; ++m) _Pragma("unroll") for (int k = 0; k < 2; ++k) dst[m][k] = *(const LAS bf16x8*)(lds + PG8_SA(b, h) + aoff + m * 2048 + k * 1024); } } while (0)
#define PG8_LDB(dst, b, h) do { if (PREC == 2) { _Pragma("unroll") for (int n = 0; n < 2; ++n) dst##6[n] = PG8_LD6(PG8_SB(b, h) + boff + n * 2048); } \
      else if (PREC == 1) { _Pragma("unroll") for (int n = 0; n < 2; ++n) dst##8[n] = PG8_LD8(PG8_SB(b, h) + boff + n * 2048); } \
      else { _Pragma("unroll") for (int n = 0; n < 2; ++n) _Pragma("unroll") for (int k = 0; k < 2; ++k) dst[n][k] = *(const LAS bf16x8*)(lds + PG8_SB(b, h) + boff + n * 2048 + k * 1024); } } while (0)
#define PG8_MMA(ai, bj, At, Bt) do { __builtin_amdgcn_s_setprio(1); if (PREC == 2) { _Pragma("unroll") for (int m = 0; m < 4; ++m) _Pragma("unroll") for (int n = 0; n < 2; ++n) \
        asm volatile("v_mfma_scale_f32_16x16x128_f8f6f4 %0, %1, %2, %0, %3, %4 op_sel_hi:[0,0,0] cbsz:2 blgp:2" : "+v"(acc[ai][bj][m][n]) : "v"(Bt##6[n]), "v"(At##6[m]), "v"(sc_w), "v"(sc_a)); } \
      else if (PREC == 1) { _Pragma("unroll") for (int m = 0; m < 4; ++m) _Pragma("unroll") for (int n = 0; n < 2; ++n) \
        asm volatile("v_mfma_scale_f32_16x16x128_f8f6f4 %0, %1, %2, %0, %3, %4 op_sel_hi:[0,0,0]" : "+v"(acc[ai][bj][m][n]) : "v"(Bt##8[n]), "v"(At##8[m]), "v"(sc_w), "v"(sc_a)); } \
      else { _Pragma("unroll") for (int m = 0; m < 4; ++m) _Pragma("unroll") for (int n = 0; n < 2; ++n) _Pragma("unroll") for (int k = 0; k < 2; ++k) \
        acc[ai][bj][m][n] = __builtin_amdgcn_mfma_f32_16x16x32_bf16(Bt[n][k], At[m][k], acc[ai][bj][m][n], 0, 0, 0); } __builtin_amdgcn_s_setprio(0); } while (0)
#define PG8_WAIT_V(n) asm volatile("s_waitcnt vmcnt(" #n ")" ::: "memory")
#define PG8_WAIT_L(n) asm volatile("s_waitcnt lgkmcnt(" #n ")" ::: "memory")
#define PG8_BAR __builtin_amdgcn_s_barrier()
#define PG8_SCHED __builtin_amdgcn_sched_barrier(0)
    Unit cur, nxt; int ui = 0;
    if (!S.next(0, cur)) return;
    f32x4 acc[2][2][4][2];
#pragma unroll
    for (int a = 0; a < 2; ++a)
#pragma unroll
        for (int b = 0; b < 2; ++b)
#pragma unroll
            for (int m = 0; m < 4; ++m)
#pragma unroll
                for (int n = 0; n < 2; ++n) acc[a][b][m][n] = (f32x4){0.f, 0.f, 0.f, 0.f};
    bf16x8 At[4][2], B0[2][2], B1[2][2]; v8i32 At8[4], B08[2], B18[2]; v6i32 At6[4], B06[2], B16[2];
    const int sc_w = 121, sc_a = (PREC == 2) ? 126 : 127;
    PG8_AOFF(vc, 0);
#pragma unroll
    for (int _h = 0; _h < 2; ++_h) { vn[_h][0] = vc[_h][0]; vn[_h][1] = vc[_h][1]; }
    PG8_STAGE(PG8_SB(0, 0), cur.B0, voffB); PG8_STAGE(PG8_SB(0, 1), cur.B1, voffB); PG8_STAGE(PG8_SA(0, 0), cur.A, vc[0]); PG8_STAGE(PG8_SA(0, 1), cur.A, vc[1]);
    if (wr == 1) PG8_BAR;
    PG8_WAIT_V(2); PG8_BAR;
    PG8_STAGE(PG8_SB(1, 0), cur.B0 + kstep, voffB); PG8_STAGE(PG8_SA(1, 0), cur.A + kstep, vc[0]); PG8_STAGE(PG8_SB(1, 1), cur.B1 + kstep, voffB);
    PG8_WAIT_V(6); PG8_BAR;
    for (;;) {
        const bool has_next = S.next(ui + 1, nxt);
        if (GATHER && has_next) PG8_AOFF(vn, ui + 1);
        const char* nA = has_next ? nxt.A : cur.A; const char* nB0 = has_next ? nxt.B0 : cur.B0; const char* nB1 = has_next ? nxt.B1 : cur.B1;
#pragma nounroll
        for (int t = 0; t < nt; t += 2) {
            const bool last = (t == nt - 2);
            const char* a1 = cur.A + (size_t)(t + 1) * kstep;
            const char* a2 = last ? nA : cur.A + (size_t)(t + 2) * kstep;
            const char* b20 = last ? nB0 : cur.B0 + (size_t)(t + 2) * kstep; const char* b21 = last ? nB1 : cur.B1 + (size_t)(t + 2) * kstep;
            const char* a3 = a2 + kstep; const char* b30 = b20 + kstep; const char* b31 = b21 + kstep;
            unsigned v2[2][2];
#pragma unroll
            for (int _h = 0; _h < 2; ++_h) { v2[_h][0] = (GATHER && last) ? vn[_h][0] : vc[_h][0]; v2[_h][1] = (GATHER && last) ? vn[_h][1] : vc[_h][1]; }
            PG8_LDB(B0, 0, 0); PG8_LDB(B1, 0, 1); PG8_SCHED; PG8_LDA(At, 0, 0); PG8_STAGE(PG8_SA(1, 1), a1, vc[1]);
            PG8_WAIT_V(8); PG8_WAIT_L(0); PG8_BAR; PG8_MMA(0, 0, At, B0); PG8_MMA(0, 1, At, B1); PG8_BAR; PG8_SCHED;
            PG8_LDA(At, 0, 1); PG8_STAGE(PG8_SB(0, 0), b20, voffB); PG8_STAGE(PG8_SB(0, 1), b21, voffB); PG8_STAGE(PG8_SA(0, 0), a2, v2[0]);
            PG8_WAIT_V(8); PG8_WAIT_L(0); PG8_BAR; PG8_MMA(1, 0, At, B0); PG8_MMA(1, 1, At, B1); PG8_BAR; PG8_SCHED;
            PG8_LDB(B0, 1, 0); PG8_LDB(B1, 1, 1); PG8_SCHED; PG8_LDA(At, 1, 0); PG8_STAGE(PG8_SA(0, 1), a2, v2[1]);
            PG8_WAIT_V(8); PG8_WAIT_L(0); PG8_BAR; PG8_MMA(0, 0, At, B0); PG8_MMA(0, 1, At, B1); PG8_BAR; PG8_SCHED;
            PG8_LDA(At, 1, 1); PG8_STAGE(PG8_SB(1, 0), b30, voffB); PG8_STAGE(PG8_SB(1, 1), b31, voffB); PG8_STAGE(PG8_SA(1, 0), a3, v2[0]);
            PG8_WAIT_V(8); PG8_WAIT_L(0); PG8_BAR; PG8_MMA(1, 0, At, B0); PG8_MMA(1, 1, At, B1); PG8_BAR; PG8_SCHED;
        }
        if constexpr (ALIGN_EPI) { if (wr == 0) PG8_BAR; }
        if (PREC != 0) asm volatile("s_nop 15\n\ts_nop 15\n\ts_nop 15\n\ts_nop 15" ::: "memory");
        E(acc, cur, wr, wc, fr, fq);
        if (!has_next) break;
        bool kp = false; if constexpr (Epi::KEEPS) kp = E.keep(cur);
        if (!kp) {
#pragma unroll
        for (int a = 0; a < 2; ++a)
#pragma unroll
            for (int b = 0; b < 2; ++b)
#pragma unroll
                for (int m = 0; m < 4; ++m)
#pragma unroll
                    for (int n = 0; n < 2; ++n) acc[a][b][m][n] = (f32x4){0.f, 0.f, 0.f, 0.f}; }
        cur = nxt; ++ui;
        if (GATHER) {
#pragma unroll
            for (int _h = 0; _h < 2; ++_h) { vc[_h][0] = vn[_h][0]; vc[_h][1] = vn[_h][1]; } }
        if constexpr (ALIGN_EPI) { if (wr == 1) PG8_BAR; }
    }
    PG8_WAIT_V(0);
    if constexpr (!ALIGN_EPI) { if (wr == 0) PG8_BAR; }
    PG8_BAR;
#undef PG8_AOFF
#undef PG8_SA
#undef PG8_SB
#undef PG8_STAGE
#undef PG8_LDA
#undef PG8_LDB
#undef PG8_MMA
#undef PG8_LD8
#undef PG8_LD6
#undef PG8_WAIT_V
#undef PG8_WAIT_L
#undef PG8_BAR
#undef PG8_SCHED
}

template <int OFF>
__device__ __forceinline__ v6i32 ld6x(unsigned addr) {
    u32x4 lo; u32x2 hi;
    asm volatile("ds_read_b128 %0, %1 offset:%2" : "=v"(lo) : "v"(addr), "n"(OFF));
    asm volatile("ds_read_b64 %0, %1 offset:%2" : "=v"(hi) : "v"(addr), "n"(OFF + 1024));
    return (v6i32){(int)lo[0], (int)lo[1], (int)lo[2], (int)lo[3], (int)hi[0], (int)hi[1]};
}
template <class Epi, class Sched>
__device__ __forceinline__ void gemm_phase_db6(LAS unsigned char* lds, const int K, const int lda, const int ldb, const Sched& S, const Epi& E, const LAS int* gtab) {
    const int tid = threadIdx.x, wid = __builtin_amdgcn_readfirstlane(tid >> 6), lane = tid & 63, wr = wid >> 2, wc = wid & 3, fr = lane & 15, fq = lane >> 4;
    const int nt = K / BK;
    unsigned voffB0, vc[2][2]; const size_t bstep = (size_t)64 * ldb * 2;
    { int R, C; stage_rc(tid * 16, R, C); const int Rb = Epi::PERM ? ((R & ~31) + perm32(R & 31)) : R; voffB0 = (unsigned)(Rb * ldb + C) * 2u; }
#define DB_AOFF(dst, ord) do { _Pragma("unroll") for (int _i = 0; _i < 2; ++_i) { int _R, _C; stage_rc((int)threadIdx.x * 16 + _i * 8192, _R, _C); _Pragma("unroll") for (int _h = 0; _h < 2; ++_h) \
        dst[_h][_i] = ((unsigned)gtab[(ord) * 256 + _h * HALF + _R] * (unsigned)lda + (unsigned)_C) * 2u; } } while (0)
    const size_t kstep = (size_t)(BK * 2);
    const unsigned ldsw = (unsigned)wid * 1024u;
    const int aoff = lds_byte(wr * 64 + fr, fq * 8), boff = lds_byte(wc * 32 + fr, fq * 8);
    const unsigned aA = (unsigned)(size_t)(lds + aoff), aB = (unsigned)(size_t)(lds + 4 * HTB + boff);
#define DB_SA(b, h) (((b) * 2 + (h)) * HTB)
#define DB_SB(b, h) ((4 + (b) * 2 + (h)) * HTB)
#define DB_STAGEA1(bufoff, gbase, voff, i) __builtin_amdgcn_global_load_lds((const unsigned*)((const char*)(gbase) + (voff)[i]), (LAS unsigned*)(lds + (bufoff) + ldsw + (i) * 8192), 16, 0, 0)
#define DB_STAGEB1(bufoff, gbase, i) __builtin_amdgcn_global_load_lds((const unsigned*)((const char*)(gbase) + (size_t)(i) * bstep + voffB0), (LAS unsigned*)(lds + (bufoff) + ldsw + (i) * 8192), 16, 0, 0)
#define DB_STAGEA(bufoff, gbase, voff) do { DB_STAGEA1(bufoff, gbase, voff, 0); DB_STAGEA1(bufoff, gbase, voff, 1); } while (0)
#define DB_STAGEB(bufoff, gbase) do { DB_STAGEB1(bufoff, gbase, 0); DB_STAGEB1(bufoff, gbase, 1); } while (0)
#define DB_LDA(dst, b, h) do { dst[0] = ld6x<DB_SA(b, h)>(aA); dst[1] = ld6x<DB_SA(b, h) + 2048>(aA); dst[2] = ld6x<DB_SA(b, h) + 4096>(aA); dst[3] = ld6x<DB_SA(b, h) + 6144>(aA); } while (0)
#define DB_LDB(dst, b, h) do { dst[0] = ld6x<((b) * 2 + (h)) * HTB>(aB); dst[1] = ld6x<((b) * 2 + (h)) * HTB + 2048>(aB); } while (0)
#define DB_MMA(ai, bj, At, Bt) do { __builtin_amdgcn_s_setprio(1); _Pragma("unroll") for (int m = 0; m < 4; ++m) _Pragma("unroll") for (int n = 0; n < 2; ++n) \
        asm volatile("v_mfma_scale_f32_16x16x128_f8f6f4 %0, %1, %2, %0, %3, %4 op_sel_hi:[0,0,0] cbsz:2 blgp:2" : "+v"(acc[ai][bj][m][n]) : "v"(Bt[n]), "v"(At[m]), "v"(sc_w), "v"(sc_a)); __builtin_amdgcn_s_setprio(0); } while (0)
#define DB_MMA4(ai, bj, mlo, At, Bt) do { _Pragma("unroll") for (int m = (mlo); m < (mlo) + 2; ++m) _Pragma("unroll") for (int n = 0; n < 2; ++n) \
        asm volatile("v_mfma_scale_f32_16x16x128_f8f6f4 %0, %1, %2, %0, %3, %4 op_sel_hi:[0,0,0] cbsz:2 blgp:2" : "+v"(acc[ai][bj][m][n]) : "v"(Bt[n]), "v"(At[m]), "v"(sc_w), "v"(sc_a)); } while (0)
#define DB_SYNC() do { asm volatile("s_waitcnt vmcnt(8) lgkmcnt(0)" ::: "memory"); __builtin_amdgcn_s_barrier(); } while (0)
#define DB_SYNC6() do { asm volatile("s_waitcnt vmcnt(6) lgkmcnt(0)" ::: "memory"); __builtin_amdgcn_s_barrier(); } while (0)
#define DB_STEP(ai, At, sb, sa, gb, ga, vo) do { \
        DB_STAGEB1(sb, gb, 0); DB_SCHED; DB_MMA4(ai, 0, 0, At, B0); DB_SCHED; DB_STAGEB1(sb, gb, 1); DB_SCHED; DB_MMA4(ai, 0, 2, At, B0); DB_SCHED; \
        DB_STAGEA1(sa, ga, vo, 0); DB_SCHED; DB_MMA4(ai, 1, 0, At, B1); DB_SCHED; DB_STAGEA1(sa, ga, vo, 1); DB_SCHED; DB_MMA4(ai, 1, 2, At, B1); DB_SCHED; } while (0)
#define DB_SCHED __builtin_amdgcn_sched_barrier(0)
    Unit cur, nxt; int ui = 0;
    if (!S.next(0, cur)) return;
    f32x4 acc[2][2][4][2]; typename Epi::Pre pre;
    E.prefetch(pre, cur, wc, fq); E.init(acc, pre);
    v6i32 A0[4], A1[4], B0[2], B1[2];
    const int sc_w = 121, sc_a = 126;
    if (wid >= 4) __builtin_amdgcn_s_setprio(1);
    DB_AOFF(vc, 0);
    DB_STAGEB(DB_SB(0, 0), cur.B0); DB_STAGEA(DB_SA(0, 0), cur.A, vc[0]); DB_STAGEB(DB_SB(0, 1), cur.B1); DB_STAGEA(DB_SA(0, 1), cur.A, vc[1]);
    DB_STAGEB(DB_SB(1, 0), cur.B0 + kstep); DB_STAGEA(DB_SA(1, 0), cur.A + kstep, vc[0]); DB_STAGEB(DB_SB(1, 1), cur.B1 + kstep); DB_STAGEA(DB_SA(1, 1), cur.A + kstep, vc[1]);
    DB_SYNC();
    DB_LDB(B0, 0, 0); DB_LDB(B1, 0, 1); DB_LDA(A0, 0, 0); DB_SCHED;
    for (;;) {
        const bool has_next = S.next(ui + 1, nxt);
        const char* nA = has_next ? nxt.A : cur.A; const char* nB0 = has_next ? nxt.B0 : cur.B0; const char* nB1 = has_next ? nxt.B1 : cur.B1;
#pragma nounroll
        for (int t = 0; t < nt; t += 2) {
            const bool last = (t == nt - 2);
            const char* a2 = last ? nA : cur.A + (size_t)(t + 2) * kstep;
            const char* b20 = last ? nB0 : cur.B0 + (size_t)(t + 2) * kstep; const char* b21 = last ? nB1 : cur.B1 + (size_t)(t + 2) * kstep;
            const char* a3 = a2 + kstep; const char* b30 = b20 + kstep; const char* b31 = b21 + kstep;
            if (last && has_next) DB_AOFF(vc, ui + 1);
            DB_SYNC(); DB_LDA(A1, 0, 1); DB_SCHED; DB_STEP(0, A0, DB_SB(0, 0), DB_SA(0, 0), b20, a2, vc[0]);
            DB_SYNC6(); DB_LDA(A0, 1, 0); DB_SCHED; DB_STEP(1, A1, DB_SB(0, 1), DB_SA(0, 1), b21, a2, vc[1]); DB_LDB(B0, 1, 0); DB_LDB(B1, 1, 1); DB_SCHED;
            DB_SYNC(); DB_LDA(A1, 1, 1); DB_SCHED; DB_STEP(0, A0, DB_SB(1, 0), DB_SA(1, 0), b30, a3, vc[0]);
            DB_SYNC6(); if (!last) DB_LDA(A0, 0, 0); DB_SCHED; DB_STEP(1, A1, DB_SB(1, 1), DB_SA(1, 1), b31, a3, vc[1]); if (!last) { DB_LDB(B0, 0, 0); DB_LDB(B1, 0, 1); } DB_SCHED;
        }
        asm volatile("s_nop 15\n\ts_nop 15\n\ts_nop 15\n\ts_nop 15" ::: "memory");
        { const unsigned _l = (unsigned)__builtin_amdgcn_mbcnt_hi(~0u, __builtin_amdgcn_mbcnt_lo(~0u, 0u)); if (has_next) E.prefetch(pre, nxt, wc, (int)(_l >> 4)); E(acc, cur, wr, wc, (int)(_l & 15u), (int)(_l >> 4)); }
        if (!has_next) break;
        E.init(acc, pre);
        cur = nxt; ++ui;
        DB_LDB(B0, 0, 0); DB_LDB(B1, 0, 1); DB_LDA(A0, 0, 0); DB_SCHED;
    }
    asm volatile("s_waitcnt vmcnt(0) lgkmcnt(0)" ::: "memory");
    __builtin_amdgcn_s_setprio(0);
    __builtin_amdgcn_s_barrier();
#undef DB_AOFF
#undef DB_SA
#undef DB_SB
#undef DB_STAGEA
#undef DB_STAGEB
#undef DB_LDA
#undef DB_LDB
#undef DB_MMA
#undef DB_SYNC
#undef DB_SYNC6
#undef DB_STEP
#undef DB_MMA4
#undef DB_STAGEA1
#undef DB_STAGEB1
#undef DB_SCHED
}

typedef f32x4 Acc[2][2][4][2];

struct EpiProj {
    static constexpr bool PERM = true, KEEPS = false;
    bf16_t* O; const float* bgate;
    __device__ __forceinline__ void operator()(Acc& acc, const Unit& u, int wr, int wc, int fr, int fq) const {
        const int row0 = u.r0 + wr * 64 + fr, col0 = u.c0 + wc * 32 + 8 * fq; const bool gate = u.c0 >= INW;
        typedef float f32x2v __attribute__((ext_vector_type(2)));
        f32x4 bv[2][2];
#pragma unroll
        for (int bj = 0; bj < 2; ++bj)
#pragma unroll
            for (int n = 0; n < 2; ++n) bv[bj][n] = gate ? *(const f32x4*)(bgate + (col0 - INW) + bj * HALF + 4 * n) * -1.4426950408889634f : (f32x4){0.f, 0.f, 0.f, 0.f};
#pragma unroll
        for (int ai = 0; ai < 2; ++ai)
#pragma unroll
            for (int m = 0; m < 4; ++m) { bf16_t* rowp = O + (size_t)(row0 + ai * HALF + m * 16) * NP1 + col0;
#pragma unroll
                for (int bj = 0; bj < 2; ++bj) { f32x4 v[2] = {acc[ai][bj][m][0], acc[ai][bj][m][1]};
                    if (gate) {
#pragma unroll
                        for (int n = 0; n < 2; ++n)
#pragma unroll
                            for (int j = 0; j < 4; j += 2) { const f32x2v a2 = {v[n][j], v[n][j + 1]}, b2 = {bv[bj][n][j], bv[bj][n][j + 1]};
                                const f32x2v t = a2 * -1.4426950408889634f + b2; const f32x2v e = {__builtin_amdgcn_exp2f(t.x), __builtin_amdgcn_exp2f(t.y)}; const f32x2v d = e + 1.0f;
                                v[n][j] = __builtin_amdgcn_rcpf(d.x); v[n][j + 1] = __builtin_amdgcn_rcpf(d.y); } }
                    u32x4 w; w.x = cvt_pk_bf16(v[0][0], v[0][1]); w.y = cvt_pk_bf16(v[0][2], v[0][3]); w.z = cvt_pk_bf16(v[1][0], v[1][1]); w.w = cvt_pk_bf16(v[1][2], v[1][3]);
                    *(u32x4*)(rowp + bj * HALF) = w; } }
    }
};
struct EpiBf16 {
    static constexpr bool PERM = true, KEEPS = false;
    bf16_t* O; int ldc; const float* cscale;
    __device__ __forceinline__ void operator()(Acc& acc, const Unit& u, int wr, int wc, int fr, int fq) const {
        const int row0 = u.r0 + wr * 64 + fr, col0 = u.c0 + wc * 32 + 8 * fq;
#pragma unroll
        for (int bj = 0; bj < 2; ++bj) {
            const f32x4 s0 = cscale ? *(const f32x4*)(cscale + col0 + bj * HALF) : (f32x4){1.f, 1.f, 1.f, 1.f}, s1 = cscale ? *(const f32x4*)(cscale + col0 + bj * HALF + 4) : (f32x4){1.f, 1.f, 1.f, 1.f};
#pragma unroll
            for (int ai = 0; ai < 2; ++ai)
#pragma unroll
                for (int m = 0; m < 4; ++m) { bf16_t* rowp = O + (size_t)(row0 + ai * HALF + m * 16) * ldc + col0;
                    const f32x4 v0 = acc[ai][bj][m][0] * s0, v1 = acc[ai][bj][m][1] * s1;
                    u32x4 w; w.x = cvt_pk_bf16(v0[0], v0[1]); w.y = cvt_pk_bf16(v0[2], v0[3]); w.z = cvt_pk_bf16(v1[0], v1[1]); w.w = cvt_pk_bf16(v1[2], v1[3]);
                    *(u32x4*)(rowp + bj * HALF) = w; } }
    }
};
struct EpiBranch {
    static constexpr bool PERM = true, KEEPS = true;
    const bf16_t* PG; bf16_t* MG;
    __device__ __forceinline__ bool keep(const Unit& u) const { return u.x == 0; }
    __device__ __forceinline__ void operator()(Acc& acc, const Unit& u, int wr, int wc, int fr, int fq) const {
        const int row0 = u.r0 + wr * 64 + fr, col0 = u.c0 + wc * 32 + 8 * fq;
        if (u.x == 0) {
#pragma unroll
            for (int ai = 0; ai < 2; ++ai) { u32x4 gb[4][2], ga[4][2];
#pragma unroll
                for (int m = 0; m < 4; ++m)
#pragma unroll
                    for (int bj = 0; bj < 2; ++bj) { const bf16_t* gp = PG + (size_t)(row0 + ai * HALF + m * 16) * NP1 + INW + col0 + bj * HALF; gb[m][bj] = *(const u32x4*)(gp + D); ga[m][bj] = *(const u32x4*)gp; }
                asm volatile("" ::: "memory");
#pragma unroll
                for (int m = 0; m < 4; ++m)
#pragma unroll
                    for (int bj = 0; bj < 2; ++bj) { const u32x4 g = gb[m][bj], a = ga[m][bj];
                        const f32x4 h0 = {bf_lo(g.x), bf_hi(g.x), bf_lo(g.y), bf_hi(g.y)}, h1 = {bf_lo(g.z), bf_hi(g.z), bf_lo(g.w), bf_hi(g.w)};
                        const f32x4 a0 = {bf_lo(a.x), bf_hi(a.x), bf_lo(a.y), bf_hi(a.y)}, a1 = {bf_lo(a.z), bf_hi(a.z), bf_lo(a.w), bf_hi(a.w)};
#pragma unroll
                        for (int j = 0; j < 4; ++j) { acc[ai][bj][m][0][j] *= a0[j] * __builtin_amdgcn_rcpf(fmaxf(h0[j], 1e-30f)); acc[ai][bj][m][1][j] *= a1[j] * __builtin_amdgcn_rcpf(fmaxf(h1[j], 1e-30f)); } }
                asm volatile("" ::: "memory"); }
        } else {
#pragma unroll
            for (int ai = 0; ai < 2; ++ai) { u32x4 gb[4][2];
#pragma unroll
                for (int m = 0; m < 4; ++m)
#pragma unroll
                    for (int bj = 0; bj < 2; ++bj) gb[m][bj] = *(const u32x4*)(PG + (size_t)(row0 + ai * HALF + m * 16) * NP1 + INW + D + col0 + bj * HALF);
                asm volatile("" ::: "memory");
#pragma unroll
                for (int m = 0; m < 4; ++m)
#pragma unroll
                    for (int bj = 0; bj < 2; ++bj) { const u32x4 g = gb[m][bj];
                        f32x4 h0 = {bf_lo(g.x), bf_hi(g.x), bf_lo(g.y), bf_hi(g.y)}, h1 = {bf_lo(g.z), bf_hi(g.z), bf_lo(g.w), bf_hi(g.w)};
#pragma unroll
                        for (int j = 0; j < 4; ++j) { h0[j] = fmaxf(h0[j], 1e-30f); h1[j] = fmaxf(h1[j], 1e-30f); }
                        const f32x4 v0 = acc[ai][bj][m][0] * h0, v1 = acc[ai][bj][m][1] * h1;
                        u32x4 w; w.x = cvt_pk_bf16(v0[0], v0[1]); w.y = cvt_pk_bf16(v0[2], v0[3]); w.z = cvt_pk_bf16(v1[0], v1[1]); w.w = cvt_pk_bf16(v1[2], v1[3]);
                        *(u32x4*)(MG + (size_t)(row0 + ai * HALF + m * 16) * D + col0 + bj * HALF) = w; }
                asm volatile("" ::: "memory"); }
        }
    }
};
struct EpiResid {
    static constexpr bool PERM = false, KEEPS = false;
    const float* res; float* out; int ldc;
    __device__ __forceinline__ void operator()(Acc& acc, const Unit& u, int wr, int wc, int fr, int fq) const {
        const int row0 = u.r0 + wr * 64 + fr, col0 = u.c0 + wc * 32 + 4 * fq;
#pragma unroll
        for (int ai = 0; ai < 2; ++ai) {
            f32x4 r[4][2][2];
#pragma unroll
            for (int m = 0; m < 4; ++m) { const size_t off = (size_t)(row0 + ai * HALF + m * 16) * ldc + col0;
#pragma unroll
                for (int bj = 0; bj < 2; ++bj)
#pragma unroll
                    for (int n = 0; n < 2; ++n) r[m][bj][n] = *(const f32x4*)(res + off + bj * HALF + n * 16); }
            asm volatile("" ::: "memory");
#pragma unroll
            for (int m = 0; m < 4; ++m) { const size_t off = (size_t)(row0 + ai * HALF + m * 16) * ldc + col0;
#pragma unroll
                for (int bj = 0; bj < 2; ++bj)
#pragma unroll
                    for (int n = 0; n < 2; ++n) *(f32x4*)(out + off + bj * HALF + n * 16) = r[m][bj][n] + acc[ai][bj][m][n]; }
            asm volatile("" ::: "memory"); }
    }
};
struct EpiUp {
    static constexpr bool PERM = true, KEEPS = false;
    const float* bup; unsigned char* ACT;
    struct Pre { f32x4 bg[2], bl[2]; };
    __device__ __forceinline__ void prefetch(Pre& p, const Unit& u, int wc, int fq) const {
        const float* be = bup + (size_t)u.x * (2 * DFF) + u.c0 * HALF + wc * 32 + 8 * fq;
#pragma unroll
        for (int n = 0; n < 2; ++n) { p.bg[n] = *(const f32x4*)(be + 4 * n); p.bl[n] = *(const f32x4*)(be + DFF + 4 * n) + 1.0f; }
    }
    __device__ __forceinline__ void init(Acc& acc, const Pre& p) const {
#pragma unroll
        for (int ai = 0; ai < 2; ++ai)
#pragma unroll
            for (int m = 0; m < 4; ++m)
#pragma unroll
                for (int n = 0; n < 2; ++n) { acc[ai][0][m][n] = p.bg[n]; acc[ai][1][m][n] = p.bl[n]; }
    }
    __device__ __forceinline__ void operator()(Acc& acc, const Unit& u, int wr, int wc, int fr, int fq) const {
        const int row0 = u.r0 + wr * 64 + fr, col0 = u.c0 * HALF + wc * 32 + 8 * fq;
        typedef float f32x2v __attribute__((ext_vector_type(2)));
#pragma unroll
        for (int ai = 0; ai < 2; ++ai)
#pragma unroll
            for (int m = 0; m < 4; ++m) { unsigned char* rowp = ACT + (size_t)(row0 + ai * HALF + m * 16) * DFF + col0; f32x4 o[2];
#pragma unroll
                for (int n = 0; n < 2; ++n) { const f32x4 gv = acc[ai][0][m][n], lv = acc[ai][1][m][n];
#pragma unroll
                    for (int j = 0; j < 4; j += 2) {
                        const f32x2v g = {__builtin_amdgcn_fmed3f(gv[j], -3.0e38f, 7.0f), __builtin_amdgcn_fmed3f(gv[j + 1], -3.0e38f, 7.0f)}, l = {__builtin_amdgcn_fmed3f(lv[j], -6.0f, 8.0f), __builtin_amdgcn_fmed3f(lv[j + 1], -6.0f, 8.0f)};
                        const f32x2v t = g * -2.4554669595930156f; const f32x2v e = {__builtin_amdgcn_exp2f(t.x), __builtin_amdgcn_exp2f(t.y)}; const f32x2v d = e + 1.0f;
                        const f32x2v r = {__builtin_amdgcn_rcpf(d.x), __builtin_amdgcn_rcpf(d.y)}; const f32x2v q = (g * l) * r; o[n][j] = q.x; o[n][j + 1] = q.y; } }
                u32x2 w; w.x = pk4_fp8(o[0][0], o[0][1], o[0][2], o[0][3]); w.y = pk4_fp8(o[1][0], o[1][1], o[1][2], o[1][3]);
                *(u32x2*)rowp = w; }
    }
};
struct EpiDown {
    static constexpr bool PERM = true, KEEPS = false;
    const float* bdn; const int* rslot; const float* gate; unsigned char* SLOT;
    __device__ __forceinline__ void operator()(Acc& acc, const Unit& u, int wr, int wc, int fr, int fq) const {
        const int row0 = u.r0 + wr * 64 + fr, col0 = u.c0 * BM + wc * 32 + 8 * fq; const float* be = bdn + (size_t)u.x * D;
        int sl[2][4]; float gt[2][4];
#pragma unroll
        for (int ai = 0; ai < 2; ++ai)
#pragma unroll
            for (int m = 0; m < 4; ++m) sl[ai][m] = rslot[row0 + ai * HALF + m * 16];
#pragma unroll
        for (int ai = 0; ai < 2; ++ai)
#pragma unroll
            for (int m = 0; m < 4; ++m) gt[ai][m] = gate[sl[ai][m] < 0 ? 0 : sl[ai][m]] * 16.0f;
        f32x4 bv[2][2];
#pragma unroll
        for (int bj = 0; bj < 2; ++bj)
#pragma unroll
            for (int n = 0; n < 2; ++n) bv[bj][n] = *(const f32x4*)(be + col0 + bj * HALF + 4 * n);
#pragma unroll
        for (int ai = 0; ai < 2; ++ai)
#pragma unroll
            for (int m = 0; m < 4; ++m) {
                if (sl[ai][m] >= 0) { const float g = gt[ai][m]; unsigned char* rowp = SLOT + (size_t)sl[ai][m] * D + col0;
#pragma unroll
                    for (int bj = 0; bj < 2; ++bj) { const f32x4 v0 = (acc[ai][bj][m][0] + bv[bj][0]) * g, v1 = (acc[ai][bj][m][1] + bv[bj][1]) * g;
                        u32x2 w; w.x = pk4_fp8(v0[0], v0[1], v0[2], v0[3]); w.y = pk4_fp8(v1[0], v1[1], v1[2], v1[3]);
                        *(u32x2*)(rowp + bj * HALF) = w; } } }
    }
};
}

struct Frame {
    LAS unsigned char* lds;
    int tid, lane, wave, vcu, G;
};

__device__ __forceinline__ void cvt_item_addr(const float* W, int K, int N, bf16_t* WT, int row_off, int item, int lane, const float*& src, bf16_t*& dst) {
    const int nblk = N >> 5, kb = item / nblk, nb = item - kb * nblk, kl = lane >> 3, nl = lane & 7;
    src = W + (size_t)(64 * kb + 8 * kl) * N + 32 * nb + 4 * nl; dst = WT + (size_t)(row_off + 32 * nb + 4 * nl) * K + 64 * kb + 8 * kl;
}
__device__ __forceinline__ void cvt_store(const f32x4 (&v)[8], bf16_t* dst, int K) {
#pragma unroll
    for (int i = 0; i < 4; ++i) { u32x4 o; o.x = cvt_pk_bf16(v[0][i], v[1][i]); o.y = cvt_pk_bf16(v[2][i], v[3][i]); o.z = cvt_pk_bf16(v[4][i], v[5][i]); o.w = cvt_pk_bf16(v[6][i], v[7][i]);
        *(u32x4*)(dst + (size_t)i * K) = o; }
}
__device__ __forceinline__ void cvt_store8(const f32x4 (&v)[8], unsigned char* dst, int K) {
#pragma unroll
    for (int i = 0; i < 4; ++i) { u32x2 o; o.x = pk4_fp8(v[0][i] * 64.f, v[1][i] * 64.f, v[2][i] * 64.f, v[3][i] * 64.f); o.y = pk4_fp8(v[4][i] * 64.f, v[5][i] * 64.f, v[6][i] * 64.f, v[7][i] * 64.f);
        *(u32x2*)(dst + (size_t)i * K) = o; }
}
__device__ __forceinline__ void cvt_range(const float* W, int K, int N, bf16_t* WT, int row_off, int i0, int cnt, int r, int nw, int lane) {
    int it = i0 + r; const int end = i0 + cnt;
    for (; it + nw < end; it += 2 * nw) {
        const float* s0; bf16_t* d0; const float* s1; bf16_t* d1;
        cvt_item_addr(W, K, N, WT, row_off, it, lane, s0, d0); cvt_item_addr(W, K, N, WT, row_off, it + nw, lane, s1, d1);
        f32x4 a[8], b[8];
#pragma unroll
        for (int j = 0; j < 8; ++j) a[j] = *(const f32x4*)(s0 + (size_t)j * N);
#pragma unroll
        for (int j = 0; j < 8; ++j) b[j] = *(const f32x4*)(s1 + (size_t)j * N);
        cvt_store(a, d0, K); cvt_store(b, d1, K);
    }
    if (it < end) { const float* s0; bf16_t* d0; cvt_item_addr(W, K, N, WT, row_off, it, lane, s0, d0); f32x4 a[8];
#pragma unroll
        for (int j = 0; j < 8; ++j) a[j] = *(const f32x4*)(s0 + (size_t)j * N);
        cvt_store(a, d0, K); }
}
constexpr int CV_UP = NE * (D / 64) * (2 * DFF / 32), CV_DN = NE * (DFF / 64) * (D / 32), CV_ALL = CV_UP + CV_DN;
struct MoeW { const float* w_up; const float* w_down; unsigned char* WUPT; unsigned char* WDNT; };
__device__ __forceinline__ void cvt_moe_addr(const MoeW& mw, int chunk, int w, int h, int lane, const float*& src, unsigned char*& dst, int& N) {
    const int kl = lane >> 3, nl = lane & 7;
    if (chunk < CV_UP / 64) { const int e = chunk >> 6, cc = chunk & 63, kb = 8 * (cc >> 4) + w, nb = 8 * (cc & 15) + h; N = 2 * DFF;
        src = mw.w_up + (size_t)e * D * 2 * DFF + (size_t)(64 * kb + 8 * kl) * (2 * DFF) + 32 * nb + 4 * nl; dst = mw.WUPT + (size_t)e * 2 * DFF * D + (size_t)(32 * nb + 4 * nl) * D + 64 * kb + 8 * kl; }
    else { const int q = chunk - CV_UP / 64, e = q >> 5, cc = q & 31, kb = 8 * (cc >> 3) + w, nb = 8 * (cc & 7) + h; N = D;
        src = mw.w_down + (size_t)e * DFF * D + (size_t)(64 * kb + 8 * kl) * D + 32 * nb + 4 * nl; dst = mw.WDNT + (size_t)e * D * DFF + (size_t)(32 * nb + 4 * nl) * DFF + 64 * kb + 8 * kl; }
}
__device__ __forceinline__ f32x4 ld_nt(const float* p) { return __builtin_nontemporal_load((const f32x4*)p); }
constexpr int CV_WG = 64;
__device__ __forceinline__ int cvt_claim(unsigned* cursor, int cap, unsigned* done, unsigned need) {
    if (done && __hip_atomic_load(done, __ATOMIC_RELAXED, __HIP_MEMORY_SCOPE_AGENT) >= need) return CV_ALL;
    if ((int)__hip_atomic_load(cursor, __ATOMIC_RELAXED, __HIP_MEMORY_SCOPE_AGENT) >= cap) return CV_ALL;
    return (int)__hip_atomic_fetch_add(cursor, (unsigned)CV_WG, __ATOMIC_RELAXED, __HIP_MEMORY_SCOPE_AGENT);
}
__device__ __forceinline__ void cvt_pull(const MoeW& mw, unsigned* cursor, int cap, unsigned* done, unsigned need, volatile LAS int* slot, int tid, int wave, int lane) {
    __syncthreads();
    if (tid == 0) *slot = cvt_claim(cursor, cap, done, need);
    __syncthreads();
    int base = __builtin_amdgcn_readfirstlane(*slot);
    while (base < CV_ALL) {
        int nb = CV_ALL; if (tid == 0) nb = cvt_claim(cursor, cap, done, need);
        const int chunk = base >> 6;
        if (chunk < CV_UP / 64) {
            const int e = chunk >> 6, cc = chunk & 63, nb = 8 * (cc & 15) + wave, kl = lane >> 3, nl = lane & 7;
#pragma unroll 1
            for (int q = 0; q < 2; ++q) { const int kq = 2 * (cc >> 4) + q, kb32 = 8 * kq + kl;
                const float* src = mw.w_up + (size_t)e * D * 2 * DFF + (size_t)(32 * kb32) * (2 * DFF) + 32 * nb + 4 * nl;
                f32x4 a[32];
#pragma unroll
                for (int j = 0; j < 32; ++j) a[j] = ld_nt(src + (size_t)j * (2 * DFF));
                unsigned char* dst = mw.WUPT + (size_t)e * 2 * DFF * D + (size_t)(32 * nb + 4 * nl) * D + 128 * (kb32 >> 2) + 16 * (kb32 & 3);
#pragma unroll
                for (int i = 0; i < 4; ++i) { f32x16 lo, hi;
#pragma unroll
                    for (int j = 0; j < 16; ++j) { lo[j] = a[j][i] * 64.f; hi[j] = a[16 + j][i] * 64.f; }
                    st_fp6_block(dst + (size_t)i * D, pk32_fp6(lo, hi)); } }
        } else
#pragma unroll
        for (int h = 0; h < 8; h += 4) {
            const float* s0; unsigned char* d0; const float* s1; unsigned char* d1; const float* s2; unsigned char* d2; const float* s3; unsigned char* d3; int N0, N1, N2, N3;
            cvt_moe_addr(mw, chunk, wave, h, lane, s0, d0, N0); cvt_moe_addr(mw, chunk, wave, h + 1, lane, s1, d1, N1); cvt_moe_addr(mw, chunk, wave, h + 2, lane, s2, d2, N2); cvt_moe_addr(mw, chunk, wave, h + 3, lane, s3, d3, N3);
            f32x4 a[8], b[8], c[8], d[8];
#pragma unroll
            for (int j = 0; j < 8; ++j) a[j] = ld_nt(s0 + (size_t)j * N0);
#pragma unroll
            for (int j = 0; j < 8; ++j) b[j] = ld_nt(s1 + (size_t)j * N1);
#pragma unroll
            for (int j = 0; j < 8; ++j) c[j] = ld_nt(s2 + (size_t)j * N2);
#pragma unroll
            for (int j = 0; j < 8; ++j) d[j] = ld_nt(s3 + (size_t)j * N3);
            cvt_store8(a, d0, D); cvt_store8(b, d1, D); cvt_store8(c, d2, D); cvt_store8(d, d3, D);
        }
        __syncthreads();
        if (tid == 0) *slot = nb;
        __syncthreads();
        base = __builtin_amdgcn_readfirstlane(*slot);
    }
}
__device__ __forceinline__ void rms_row_to_bf16(const float* xrow, const float* gvec, bf16_t* orow, int lane) {
    const f32x4* xr = (const f32x4*)xrow + lane; const f32x4* gr = (const f32x4*)gvec + lane; f32x4 v[8], g[8]; float s = 0.f;
#pragma unroll
    for (int j = 0; j < 8; ++j) { v[j] = xr[64 * j]; g[j] = gr[64 * j]; }
#pragma unroll
    for (int j = 0; j < 8; ++j) s += (v[j].x * v[j].x + v[j].y * v[j].y) + (v[j].z * v[j].z + v[j].w * v[j].w);
    const float rstd = 1.0f / sqrtf(wave_sum(s) * (1.0f / D) + RMS_EPS);
    u32x2* o8 = (u32x2*)orow + lane;
#pragma unroll
    for (int j = 0; j < 8; ++j) { const f32x4 y = v[j] * rstd * g[j]; u32x2 w; w.x = cvt_pk_bf16(y.x, y.y); w.y = cvt_pk_bf16(y.z, y.w); o8[64 * j] = w; }
}

__device__ __forceinline__ unsigned voff_b(unsigned row, unsigned ch) { return 256u * row + 16u * (ch ^ (((row & 3u) << 2) | ((row >> 2) & 3u))); }
__device__ __forceinline__ s16x4 vtr(const LAS unsigned char* p) { return __builtin_bit_cast(s16x4, __builtin_amdgcn_ds_read_tr16_b64_v4i16((LAS s16x4*)p)); }

__device__ __forceinline__ void sb_wg_unit(const bf16_t* PG, bf16_t* OA, int h, int qb, LAS unsigned char* lds, volatile LAS int* flags, int tid, int wave, int lane) {
    const int fr = lane & 15, fq = lane >> 4, q0w = qb * 128 + wave * 16, qi = q0w + fr;
    bf16x8 Qf[4];
    { const bf16_t* qp = PG + (size_t)qi * NP1 + h * HD + 8 * fq;
#pragma unroll
      for (int ks = 0; ks < 4; ++ks) Qf[ks] = *(const bf16x8*)(qp + 32 * ks); }
    f32x4 O[8];
#pragma unroll
    for (int db = 0; db < 8; ++db) O[db] = (f32x4){0.f, 0.f, 0.f, 0.f};
    float carry = 0.f; bool sat = false;
    const float scale = 0.08838834764831845f;
    const unsigned p = fr & 3, qq = fr >> 2;
    const int jt_hi = 2 * qb + 1, jt_w = q0w >> 6;
    const int srow = tid >> 4, sch = tid & 15;
    const bf16_t* kg = PG + (size_t)srow * NP1 + SBW + h * HD + 8 * sch;
    u32x4 kr[2], vr[2];
    __syncthreads();
    if (tid < 8) flags[tid] = 0;
    { const bf16_t* g = kg + (size_t)(jt_hi * 64) * NP1;
#pragma unroll
      for (int i = 0; i < 2; ++i) { kr[i] = *(const u32x4*)(g + (size_t)(32 * i) * NP1); vr[i] = *(const u32x4*)(g + (size_t)(32 * i) * NP1 + SBW); } }
    for (int jt = jt_hi, it = 0; jt >= 0; --jt, ++it) {
        LAS unsigned char* kb = lds + (it & 1) * 32768; LAS unsigned char* vb = kb + 16384;
#pragma unroll
        for (int i = 0; i < 2; ++i) { *(LAS u32x4*)(kb + voff_b(srow + 32 * i, sch)) = kr[i]; *(LAS u32x4*)(vb + voff_b(srow + 32 * i, sch)) = vr[i]; }
        __syncthreads();
        { int ns = 0;
#pragma unroll
          for (int w = 0; w < 8; ++w) ns += flags[w];
          if (__builtin_amdgcn_readfirstlane(ns) == 8) break; }
        if (jt > 0) { const bf16_t* g = kg + (size_t)((jt - 1) * 64) * NP1;
#pragma unroll
            for (int i = 0; i < 2; ++i) { kr[i] = *(const u32x4*)(g + (size_t)(32 * i) * NP1); vr[i] = *(const u32x4*)(g + (size_t)(32 * i) * NP1 + SBW); } }
        if (!sat && jt <= jt_w) {
            const int key0 = jt * 64;
            f32x4 z[4];
#pragma unroll
            for (int sb = 0; sb < 4; ++sb) { z[sb] = (f32x4){0.f, 0.f, 0.f, 0.f};
#pragma unroll
                for (int ks = 0; ks < 4; ++ks) { const bf16x8 kf = *(const LAS bf16x8*)(kb + voff_b(16 * sb + fr, 4 * ks + fq)); z[sb] = __builtin_amdgcn_mfma_f32_16x16x32_bf16(kf, Qf[ks], z[sb], 0, 0, 0); } }
            float sfx[4][4], g[4], lex[4], T[4];
            const bool diag = key0 + 64 > q0w;
#pragma unroll
            for (int sb = 0; sb < 4; ++sb) {
                float sp[4];
#pragma unroll
                for (int i = 0; i < 4; ++i) { const float y = z[sb][i] * (scale * 1.4426950408889634f); z[sb][i] = y;
                    sp[i] = fmaxf(y, 0.f) + __builtin_amdgcn_logf(1.0f + __builtin_amdgcn_exp2f(-fabsf(y))); }
                if (diag) {
#pragma unroll
                    for (int i = 0; i < 4; ++i) { const int key = key0 + 16 * sb + 4 * fq + i; sp[i] = (key < qi) ? sp[i] : 0.f; } }
                sfx[sb][3] = sp[3]; sfx[sb][2] = sp[2] + sfx[sb][3]; sfx[sb][1] = sp[1] + sfx[sb][2]; sfx[sb][0] = sp[0] + sfx[sb][1]; g[sb] = sfx[sb][0];
            }
#pragma unroll
            for (int sb = 0; sb < 4; ++sb) { const float x1 = __shfl_xor(g[sb], 16), x2 = __shfl_xor(g[sb], 32), x3 = __shfl_xor(g[sb], 48);
                T[sb] = (g[sb] + x1) + (x2 + x3); lex[sb] = ((fq & 1) ? 0.f : x1) + ((fq < 2) ? (x2 + x3) : 0.f); }
            float run = carry; bf16x8 Wf[2]; unsigned wpk[8];
#pragma unroll
            for (int sb = 3; sb >= 0; --sb) { const float base = run + lex[sb]; float w[4];
#pragma unroll
                for (int i = 0; i < 4; ++i) w[i] = __builtin_amdgcn_exp2f(z[sb][i] - (base + sfx[sb][i]));
                if (diag) {
#pragma unroll
                    for (int i = 0; i < 4; ++i) { const int key = key0 + 16 * sb + 4 * fq + i; w[i] = (key < qi) ? w[i] : 0.f; } }
                wpk[2 * sb] = cvt_pk_bf16(w[0], w[1]); wpk[2 * sb + 1] = cvt_pk_bf16(w[2], w[3]); run += T[sb]; }
            carry = run;
            { u32x4 a = {wpk[0], wpk[1], wpk[2], wpk[3]}, b = {wpk[4], wpk[5], wpk[6], wpk[7]}; Wf[0] = __builtin_bit_cast(bf16x8, a); Wf[1] = __builtin_bit_cast(bf16x8, b); }
#pragma unroll
            for (int db = 0; db < 8; ++db)
#pragma unroll
                for (int m = 0; m < 2; ++m) { const unsigned r1 = 32 * m + 4 * fq + qq, r2 = r1 + 16;
                    const s16x4 lo = vtr(vb + voff_b(r1, 2 * db + (p >> 1)) + 8 * (p & 1)), hi = vtr(vb + voff_b(r2, 2 * db + (p >> 1)) + 8 * (p & 1));
                    const bf16x8 vf = {lo[0], lo[1], lo[2], lo[3], hi[0], hi[1], hi[2], hi[3]};
                    O[db] = __builtin_amdgcn_mfma_f32_16x16x32_bf16(vf, Wf[m], O[db], 0, 0, 0); }
            if (__all(carry > 150.1f)) { sat = true; if (lane == 0) flags[wave] = 1; }
        }
    }
    { bf16_t* op = OA + (size_t)qi * SBW + h * HD + 4 * fq;
#pragma unroll
      for (int db = 0; db < 8; ++db) { u32x2 w; w.x = cvt_pk_bf16(O[db][0], O[db][1]); w.y = cvt_pk_bf16(O[db][2], O[db][3]); *(u32x2*)(op + 16 * db) = w; } }
}

__device__ __forceinline__ void xa_unit(const bf16_t* QXA, const bf16_t* KVM, bf16_t* OXA, int h, int qb, const LAS unsigned char* vl, int lane) {
    const int fr = lane & 15, fq = lane >> 4, q0 = qb * 16, qi = q0 + fr;
    bf16x8 Qf[4];
    { const bf16_t* qp = QXA + (size_t)qi * XAW + h * HD + 8 * fq;
#pragma unroll
      for (int ks = 0; ks < 4; ++ks) Qf[ks] = *(const bf16x8*)(qp + 32 * ks); }
    f32x4 z[16];
    { const bf16_t* kp = KVM + (size_t)fr * (2 * XAW) + h * HD + 8 * fq;
#pragma unroll
      for (int sb = 0; sb < 16; ++sb) { z[sb] = (f32x4){0.f, 0.f, 0.f, 0.f};
#pragma unroll
          for (int ks = 0; ks < 4; ++ks) { const bf16x8 kf = *(const bf16x8*)(kp + (size_t)(16 * sb) * (2 * XAW) + 32 * ks); z[sb] = __builtin_amdgcn_mfma_f32_16x16x32_bf16(kf, Qf[ks], z[sb], 0, 0, 0); } } }
    const float scale = 0.08838834764831845f * 1.4426950408889634f;
    float mx = -3.0e38f;
#pragma unroll
    for (int sb = 0; sb < 16; ++sb)
#pragma unroll
        for (int i = 0; i < 4; ++i) { z[sb][i] *= scale; mx = fmaxf(mx, z[sb][i]); }
    mx = fmaxf(mx, __shfl_xor(mx, 16)); mx = fmaxf(mx, __shfl_xor(mx, 32));
    float sum = 0.f;
#pragma unroll
    for (int sb = 0; sb < 16; ++sb)
#pragma unroll
        for (int i = 0; i < 4; ++i) { const float e = __builtin_amdgcn_exp2f(z[sb][i] - mx); z[sb][i] = e; sum += e; }
    sum += __shfl_xor(sum, 16); sum += __shfl_xor(sum, 32);
    const float inv = 1.0f / sum;
    f32x4 O[8];
#pragma unroll
    for (int db = 0; db < 8; ++db) O[db] = (f32x4){0.f, 0.f, 0.f, 0.f};
    const unsigned p = fr & 3, qq = fr >> 2;
#pragma unroll
    for (int m = 0; m < 8; ++m) {
        u32x4 a = {cvt_pk_bf16(z[2 * m][0], z[2 * m][1]), cvt_pk_bf16(z[2 * m][2], z[2 * m][3]), cvt_pk_bf16(z[2 * m + 1][0], z[2 * m + 1][1]), cvt_pk_bf16(z[2 * m + 1][2], z[2 * m + 1][3])};
        const bf16x8 Wf = __builtin_bit_cast(bf16x8, a);
#pragma unroll
        for (int db = 0; db < 8; ++db) { const unsigned r1 = 32 * m + 4 * fq + qq, r2 = r1 + 16;
            const s16x4 lo = vtr(vl + voff_b(r1, 2 * db + (p >> 1)) + 8 * (p & 1)), hi = vtr(vl + voff_b(r2, 2 * db + (p >> 1)) + 8 * (p & 1));
            const bf16x8 vf = {lo[0], lo[1], lo[2], lo[3], hi[0], hi[1], hi[2], hi[3]};
            O[db] = __builtin_amdgcn_mfma_f32_16x16x32_bf16(vf, Wf, O[db], 0, 0, 0); }
    }
    { bf16_t* op = OXA + (size_t)qi * XAW + h * HD + 4 * fq;
#pragma unroll
      for (int db = 0; db < 8; ++db) { const f32x4 o = O[db] * inv; u32x2 w; w.x = cvt_pk_bf16(o[0], o[1]); w.y = cvt_pk_bf16(o[2], o[3]); *(u32x2*)(op + 16 * db) = w; } }
}

template <int W>
__device__ __forceinline__ void pool_run(const bf16_t* PG, bf16_t* PO, int t0, int ch) {
    constexpr int NR = W + 7;
    const bf16_t* pp = PG + (size_t)(t0 + 7) * NP1 + 3 * SBW + ch * 8;
    u32x4 v[NR];
#pragma unroll
    for (int k = 0; k < NR; ++k) v[k] = (t0 + 7 - k >= 0) ? *(const u32x4*)(pp - (size_t)k * NP1) : (u32x4){0u, 0u, 0u, 0u};
#pragma unroll
    for (int i = 0; i < 8; ++i) {
        float s[8];
#pragma unroll
        for (int j = 0; j < 8; ++j) s[j] = 0.f;
#pragma unroll
        for (int j = W - 1; j >= 0; --j) { const u32x4 x = v[7 - i + j];
            s[0] += bf_lo(x.x); s[1] += bf_hi(x.x); s[2] += bf_lo(x.y); s[3] += bf_hi(x.y); s[4] += bf_lo(x.z); s[5] += bf_hi(x.z); s[6] += bf_lo(x.w); s[7] += bf_hi(x.w); }
        const int t = t0 + i, n = (t + 1 < W) ? (t + 1) : W; const float inv = 1.0f / (float)n; const u32x4 me = v[7 - i]; u32x4 o;
        o.x = cvt_pk_bf16(s[0] * inv - bf_lo(me.x), s[1] * inv - bf_hi(me.x)); o.y = cvt_pk_bf16(s[2] * inv - bf_lo(me.y), s[3] * inv - bf_hi(me.y));
        o.z = cvt_pk_bf16(s[4] * inv - bf_lo(me.z), s[5] * inv - bf_hi(me.z)); o.w = cvt_pk_bf16(s[6] * inv - bf_lo(me.w), s[7] * inv - bf_hi(me.w));
        *(u32x4*)(PO + (size_t)t * POOLW + ch * 8) = o;
    }
}

constexpr int NPHASE = 15;
struct Args { const float* in[24]; float* out; unsigned char* ws; int ph_lo, ph_hi; };
static_assert(sizeof(Args) == 24 * 8 + 8 + 8 + 8, "Args has no padding");

__global__ void __launch_bounds__(NWAVES * 64, 2) moe_fwd(Args args) {
    extern __shared__ __attribute__((aligned(16))) unsigned char lds_raw[];
    Frame F;
    F.lds = (LAS unsigned char*)lds_raw;
    F.tid = threadIdx.x; F.lane = F.tid & 63; F.wave = __builtin_amdgcn_readfirstlane(F.tid >> 6);
    F.G = gridDim.x; { const int bx = blockIdx.x; F.vcu = (F.G % 8 == 0) ? (bx % 8) * (F.G / 8) + bx / 8 : bx; }
    unsigned char* ws = args.ws;
    unsigned* ctl = (unsigned*)(ws + WS_CTL);
    LAS unsigned char* lx = F.lds + LDS_X_OFF;
    for (int u = F.tid; u < (LDS_BYTES - LDS_X_OFF) / 4; u += NWAVES * 64) ((LAS unsigned*)lx)[u] = 0u;
    __syncthreads();
#if MK_ONE_LAUNCH
    XcdBarrier bar = xcd_barrier_post(ctl + CW_BAR, (volatile LAS unsigned*)(lx + LX_BAR));
#define GRID_BAR() xcd_barrier(bar)
#else
#define GRID_BAR() do {} while (0)
#endif
    const int lo = args.ph_lo, hi = args.ph_hi;
#ifndef PHASE_MASK
#define PHASE_MASK 0x7fff
#endif
#define IN(k) (((PHASE_MASK >> (k)) & 1) && lo <= (k) && (k) < hi)
#define SEAM(k) do { if (IN((k) + 1)) GRID_BAR(); } while (0)

    const float* x = args.in[0]; const float* mem = args.in[1]; const float* norm_mix = args.in[2]; const float* w_in = args.in[3]; const float* pool_lin = args.in[4];
    const float* pool_scale = args.in[5]; const float* w_branch_a = args.in[6]; const float* w_branch_b = args.in[7]; const float* w_gate = args.in[8]; const float* b_gate = args.in[9];
    const float* w_mix_out = args.in[10]; const float* xa_norm = args.in[11]; const float* mem_norm = args.in[12]; const float* xa_wq = args.in[13]; const float* xa_wkv = args.in[14];
    const float* xa_wo = args.in[15]; const float* moe_norm = args.in[16]; const float* w_router = args.in[17]; const float* b_router = args.in[18]; const float* w_up = args.in[19];
    const float* b_up = args.in[20]; const float* w_down = args.in[21]; const float* b_down = args.in[22]; const float* final_norm = args.in[23];
    bf16_t* W1T = (bf16_t*)(ws + WS_W1T); bf16_t* WAT = (bf16_t*)(ws + WS_WAT); bf16_t* WBT = (bf16_t*)(ws + WS_WBT); bf16_t* WMT = (bf16_t*)(ws + WS_WMT); bf16_t* PLT = (bf16_t*)(ws + WS_PLT);
    bf16_t* WQT = (bf16_t*)(ws + WS_WQT); bf16_t* WKVT = (bf16_t*)(ws + WS_WKVT); bf16_t* WOT = (bf16_t*)(ws + WS_WOT); unsigned char* WUPT = ws + WS_WUPT; unsigned char* WDNT = ws + WS_WDNT;
    bf16_t* U = (bf16_t*)(ws + WS_U); bf16_t* MEMN = (bf16_t*)(ws + WS_MEMN); bf16_t* PG = (bf16_t*)(ws + WS_PG); bf16_t* OA = (bf16_t*)(ws + WS_OA); bf16_t* PO = (bf16_t*)(ws + WS_PO);
    bf16_t* OB = (bf16_t*)(ws + WS_OB); float* TMP = (float*)(ws + WS_TMP); bf16_t* MG = (bf16_t*)(ws + WS_MG); float* H1 = (float*)(ws + WS_H1); bf16_t* U2 = (bf16_t*)(ws + WS_U2);
    bf16_t* QXA = (bf16_t*)(ws + WS_QXA); bf16_t* KVM = (bf16_t*)(ws + WS_KVM); bf16_t* OXA = (bf16_t*)(ws + WS_OXA); float* H2 = (float*)(ws + WS_H2); unsigned char* TB = ws + WS_TB;
    bf16_t* ROWS = (bf16_t*)(ws + WS_ROWS); unsigned char* ACT = ws + WS_ACT; unsigned char* SLOT = ws + WS_SLOT;
    int* ASGE = (int*)(ws + WS_ASGE); int* ASGP = (int*)(ws + WS_ASGP); float* GATE = (float*)(ws + WS_GATE); int* RSLOT = (int*)(ws + WS_RSLOT);
    int* CNT = (int*)(ctl + CW_CNT); bf16_t* WRT = (bf16_t*)(ws + WS_WRT);
    const int gw = F.vcu * NWAVES + F.wave, NGW = F.G * NWAVES;
    const MoeW mw{w_up, w_down, WUPT, WDNT};
    unsigned* CUR = ctl + CW_CUR; volatile LAS int* cvs = (volatile LAS int*)(lx + LX_CVS);
#define CVT_PULL(cap) cvt_pull(mw, CUR, (cap), nullptr, 0u, cvs, F.tid, F.wave, F.lane)
#define CVT_BESIDE(cap, ph, need) cvt_pull(mw, CUR, (cap), ctl + CW_DONE + 64 * (ph), (unsigned)(need), cvs, F.tid, F.wave, F.lane)
#define MARK_DONE(ph) do { if (F.tid == 0) __hip_atomic_fetch_add(ctl + CW_DONE + 64 * (ph), 1u, __ATOMIC_RELAXED, __HIP_MEMORY_SCOPE_AGENT); } while (0)

    if (IN(0)) {
        constexpr int I_IN = (D / 64) * (INW / 32), I_BR = (SBW / 64) * (D / 32), I_MX = (D / 64) * (D / 32), I_PL = (256 / 64) * (256 / 32);
        constexpr int I_Q = (D / 64) * (XAW / 32), I_KV = (D / 64) * (2 * XAW / 32), I_O = (XAW / 64) * (D / 32);
        cvt_range(w_in, D, INW, W1T, 0, 0, I_IN, gw, NGW, F.lane);
        cvt_range(w_gate, D, INW, W1T, INW, 0, I_IN, gw, NGW, F.lane);
        for (int m = gw; m < S; m += NGW) rms_row_to_bf16(x + (size_t)m * D, norm_mix, U + (size_t)m * D, F.lane);
        for (int m = gw; m < MEM; m += NGW) rms_row_to_bf16(mem + (size_t)m * D, mem_norm, MEMN + (size_t)m * D, F.lane);
        for (int i = blockIdx.x * (NWAVES * 64) + F.tid; i < NE * D / 2; i += F.G * NWAVES * 64) {
            const int e = i >> 10, c = (i & 1023) * 2; const float a = w_router[(size_t)c * NE + e], b = w_router[(size_t)(c + 1) * NE + e];
            const unsigned hi = cvt_pk_bf16(a, b); const unsigned lo = cvt_pk_bf16(a - bf_lo(hi), b - bf_hi(hi));
            *(unsigned*)(WRT + (size_t)e * D + c) = hi; *(unsigned*)(WRT + (size_t)(NE + e) * D + c) = lo; }
        __syncthreads();
        SEAM(0);
    }

    if (IN(1)) {
        const int gc = (F.G == 256) ? GC_P1 : F.G;
        if ((int)blockIdx.x < gc) {
            pg8::DenseSched Sc{(const char*)U, (const char*)W1T, D, D, S / 256, NP1 / 256, gc, (int)blockIdx.x};
            pg8::EpiProj E{PG, b_gate};
            pg8::gemm_phase<pg8::EpiProj, pg8::DenseSched, true>(F.lds, D, D, D, Sc, E);
            MARK_DONE(1);
        }
        if ((int)blockIdx.x >= gc) {
            constexpr int I_BR = (SBW / 64) * (D / 32), I_MX = (D / 64) * (D / 32), I_PL = (256 / 64) * (256 / 32), I_Q = (D / 64) * (XAW / 32), I_KV = (D / 64) * (2 * XAW / 32), I_O = (XAW / 64) * (D / 32);
            const int cr = ((int)blockIdx.x - gc) * NWAVES + F.wave, cn = (F.G - gc) * NWAVES;
        cvt_range(w_branch_a, SBW, D, WAT, 0, 0, I_BR, cr, cn, F.lane);
        cvt_range(w_branch_b, POOLW, D, WBT, 0, 0, I_BR, cr, cn, F.lane);
        cvt_range(w_mix_out, D, D, WMT, 0, 0, I_MX, cr, cn, F.lane);
        for (int g = 0; g < 4; ++g) cvt_range(pool_lin + (size_t)g * 65536, 256, 256, PLT + (size_t)g * 65536, 0, 0, I_PL, cr, cn, F.lane);
        cvt_range(xa_wq, D, XAW, WQT, 0, 0, I_Q, cr, cn, F.lane);
        cvt_range(xa_wkv, D, 2 * XAW, WKVT, 0, 0, I_KV, cr, cn, F.lane);
        cvt_range(xa_wo, XAW, D, WOT, 0, 0, I_O, cr, cn, F.lane);
        }
        CVT_BESIDE(CV_UP, 1, gc);
        SEAM(1);
    }

    if (IN(2)) {
        for (int it = blockIdx.x * (NWAVES * 64) + F.tid; it < (S / 8) * (POOLW / 8); it += F.G * NWAVES * 64) {
            const int wv = it >> 6, g = wv & 3, rb = (wv >> 2) * 2 + (F.lane >> 5), ch = g * 32 + (F.lane & 31), t0 = rb * 8;
            if (g == 0) pool_run<2>(PG, PO, t0, ch); else if (g == 1) pool_run<4>(PG, PO, t0, ch); else if (g == 2) pool_run<8>(PG, PO, t0, ch); else pool_run<16>(PG, PO, t0, ch);
        }
        for (int it = F.vcu; it < SBH * (S / 128); it += F.G) { const int h = it & 7, qb = (S / 128 - 1) - (it >> 3); sb_wg_unit(PG, OA, h, qb, F.lds, (volatile LAS int*)(lx + LX_SBF), F.tid, F.wave, F.lane); }
        __syncthreads();
        SEAM(2);
    }

    if (IN(3)) {
        pg8::PoolSched Sc{(const char*)PO, (const char*)PLT, F.G, F.vcu};
        pg8::EpiBf16 E{OB, POOLW, pool_scale};
        pg8::gemm_phase<pg8::EpiBf16, pg8::PoolSched, true>(F.lds, 256, POOLW, 256, Sc, E);
        if (F.vcu < (S / 256) * 4) MARK_DONE(3);
        CVT_BESIDE(CV_UP, 3, (S / 256) * 4);
        SEAM(3);
    }

    if (IN(4)) {
        pg8::BranchSched Sc{(const char*)OA, (const char*)OB, (const char*)WAT, (const char*)WBT, SBW, SBW, S / 256, D / 256, F.G, (int)blockIdx.x};
        pg8::EpiBranch E{PG, MG};
        pg8::gemm_phase<pg8::EpiBranch, pg8::BranchSched, true>(F.lds, SBW, SBW, SBW, Sc, E);
        SEAM(4);
    }

    if (IN(5)) {
        pg8::DenseSched Sc{(const char*)MG, (const char*)WMT, D, D, S / 256, D / 256, F.G, (int)blockIdx.x};
        pg8::EpiResid E{x, H1, D};
        pg8::gemm_phase<pg8::EpiResid, pg8::DenseSched, true>(F.lds, D, D, D, Sc, E);
        SEAM(5);
    }

    if (IN(6)) {
        for (int m = gw; m < S; m += NGW) rms_row_to_bf16(H1 + (size_t)m * D, xa_norm, U2 + (size_t)m * D, F.lane);
        SEAM(6);
    }

    if (IN(7)) {
        { pg8::DenseSched Sc{(const char*)U2, (const char*)WQT, D, D, S / 256, XAW / 256, F.G, (int)blockIdx.x};
          pg8::EpiBf16 E{QXA, XAW, nullptr};
          pg8::gemm_phase<pg8::EpiBf16, pg8::DenseSched, true>(F.lds, D, D, D, Sc, E); }
        { const int c2 = ((int)blockIdx.x >= 64) ? (int)blockIdx.x - 64 : (int)blockIdx.x + F.G - 64;
          pg8::DenseSched Sc{(const char*)MEMN, (const char*)WKVT, D, D, MEM / 256, 2 * XAW / 256, F.G, c2};
          pg8::EpiBf16 E{KVM, 2 * XAW, nullptr};
          pg8::gemm_phase<pg8::EpiBf16, pg8::DenseSched, true>(F.lds, D, D, D, Sc, E); }
        if ((int)blockIdx.x < 68) MARK_DONE(7);
        CVT_BESIDE(CV_UP, 7, 68);
        SEAM(7);
    }

    if (IN(8)) {
        for (int it = F.vcu; it < XAH * (S / 128); it += F.G) {
            const int h = it & 3, qg = it >> 2;
            __syncthreads();
#pragma unroll
            for (int t = 0; t < 8; ++t) { const int c = t * 512 + F.tid, row = c >> 4, ch = c & 15;
                const u32x4 vv = *(const u32x4*)(KVM + (size_t)row * (2 * XAW) + XAW + h * HD + 8 * ch); *(LAS u32x4*)(F.lds + voff_b(row, ch)) = vv; }
            __syncthreads();
            xa_unit(QXA, KVM, OXA, h, qg * 8 + F.wave, F.lds, F.lane);
        }
        __syncthreads();
        SEAM(8);
    }

    if (IN(9)) {
        pg8::DenseSched Sc{(const char*)OXA, (const char*)WOT, XAW, XAW, S / 256, D / 256, F.G, (int)blockIdx.x};
        pg8::EpiResid E{H1, H2, D};
        pg8::gemm_phase<pg8::EpiResid, pg8::DenseSched, true>(F.lds, XAW, XAW, XAW, Sc, E);
        SEAM(9);
    }

    if (IN(10)) {
        for (int i = blockIdx.x * (NWAVES * 64) + F.tid; i < PROWS; i += F.G * NWAVES * 64) RSLOT[i] = -1;
        LAS unsigned char* thi = F.lds;
        LAS float* lg = (LAS float*)(lx + LX_LOG);
        LAS float* part = (LAS float*)(lx + LX_RPART);
        for (int rg = F.vcu; rg < S / 16; rg += F.G) {
            __syncthreads();
#pragma unroll
            for (int rr = 0; rr < 2; ++rr) { const int r = 2 * F.wave + rr, m = rg * 16 + r;
                const f32x4* xr = (const f32x4*)(H2 + (size_t)m * D) + F.lane; f32x4 v[8]; float s = 0.f;
#pragma unroll
                for (int j = 0; j < 8; ++j) { v[j] = xr[64 * j]; s += (v[j].x * v[j].x + v[j].y * v[j].y) + (v[j].z * v[j].z + v[j].w * v[j].w); }
                const float rstd = 1.0f / sqrtf(wave_sum(s) * (1.0f / D) + RMS_EPS);
                const f32x4* gr = (const f32x4*)moe_norm + F.lane; f32x4 gv[8];
#pragma unroll
                for (int j = 0; j < 8; ++j) gv[j] = gr[64 * j];
#pragma unroll
                for (int j = 0; j < 8; ++j) { const f32x4 g = gv[j]; const f32x4 y = v[j] * rstd * g; u32x2 w; w.x = cvt_pk_bf16(y.x, y.y); w.y = cvt_pk_bf16(y.z, y.w);
                    u32x2 l; l.x = cvt_pk_bf16(y.x - bf_lo(w.x), y.y - bf_hi(w.x)); l.y = cvt_pk_bf16(y.z - bf_lo(w.y), y.w - bf_hi(w.y));
                    const unsigned off = (unsigned)r * 4096u + ((((unsigned)F.lane >> 1) + 32u * j) ^ (unsigned)r) * 16u + (F.lane & 1) * 8u;
                    *(LAS u32x2*)(thi + off) = w; *(LAS u32x2*)(thi + 65536 + off) = l; } }
            __syncthreads();
#pragma unroll
            for (int q = 0; q < 2; ++q) { const int blk = F.tid + 512 * q, r = blk >> 6, kb32 = blk & 63; f32x16 lo, hi;
#pragma unroll
                for (int c4 = 0; c4 < 4; ++c4) { const u32x4 v = *(const LAS u32x4*)(thi + r * 4096 + ((unsigned)((4 * kb32 + c4) ^ r) * 16u));
                    const float f[8] = {bf_lo(v.x), bf_hi(v.x), bf_lo(v.y), bf_hi(v.y), bf_lo(v.z), bf_hi(v.z), bf_lo(v.w), bf_hi(v.w)};
#pragma unroll
                    for (int j = 0; j < 8; ++j) { if (c4 < 2) lo[8 * c4 + j] = f[j] * 2.0f; else hi[8 * (c4 - 2) + j] = f[j] * 2.0f; } }
                st_fp6_block(TB + (size_t)(rg * 16 + r) * D + 128 * (kb32 >> 2) + 16 * (kb32 & 3), pk32_fp6(lo, hi)); }
            { const int fr = F.lane & 15, fq = F.lane >> 4; f32x4 c0 = {0.f, 0.f, 0.f, 0.f}, c1 = {0.f, 0.f, 0.f, 0.f};
              const bf16_t* wh = WRT + (size_t)fr * D + 256 * F.wave + 8 * fq;
#pragma unroll
              for (int st = 0; st < 8; ++st) { const unsigned ch = (unsigned)(32 * F.wave + 4 * st + fq);
                  const bf16x8 ah = *(const LAS bf16x8*)(thi + fr * 4096 + ((ch ^ (unsigned)fr) * 16u)), al = *(const LAS bf16x8*)(thi + 65536 + fr * 4096 + ((ch ^ (unsigned)fr) * 16u));
                  const bf16x8 bh0 = *(const bf16x8*)(wh + 32 * st), bh1 = *(const bf16x8*)(wh + (size_t)16 * D + 32 * st), bl0 = *(const bf16x8*)(wh + (size_t)NE * D + 32 * st), bl1 = *(const bf16x8*)(wh + (size_t)(NE + 16) * D + 32 * st);
                  c0 = __builtin_amdgcn_mfma_f32_16x16x32_bf16(ah, bh0, c0, 0, 0, 0); c1 = __builtin_amdgcn_mfma_f32_16x16x32_bf16(ah, bh1, c1, 0, 0, 0);
                  c0 = __builtin_amdgcn_mfma_f32_16x16x32_bf16(ah, bl0, c0, 0, 0, 0); c1 = __builtin_amdgcn_mfma_f32_16x16x32_bf16(ah, bl1, c1, 0, 0, 0);
                  c0 = __builtin_amdgcn_mfma_f32_16x16x32_bf16(al, bh0, c0, 0, 0, 0); c1 = __builtin_amdgcn_mfma_f32_16x16x32_bf16(al, bh1, c1, 0, 0, 0); }
#pragma unroll
              for (int i = 0; i < 4; ++i) { part[(F.wave * 16 + 4 * fq + i) * 32 + fr] = c0[i]; part[(F.wave * 16 + 4 * fq + i) * 32 + 16 + fr] = c1[i]; } }
            __syncthreads();
            { const int r = F.tid >> 5, e = F.tid & 31; float a = 0.f;
#pragma unroll
              for (int w = 0; w < 8; ++w) a += part[(w * 16 + r) * 32 + e];
              lg[r * 32 + e] = a + b_router[e]; }
            __syncthreads();
            if (F.tid < 16) { const int r = F.tid, m = rg * 16 + r; float l[32];
#pragma unroll
                for (int e = 0; e < 32; ++e) l[e] = lg[r * 32 + e];
                int idx[4]; float val[4]; unsigned taken = 0u;
#pragma unroll
                for (int k = 0; k < 4; ++k) { float best = -3.4e38f; int bi = 0;
#pragma unroll
                    for (int e = 0; e < 32; ++e) { const bool ok = !((taken >> e) & 1u) && (l[e] > best); best = ok ? l[e] : best; bi = ok ? e : bi; }
                    idx[k] = bi; val[k] = best; taken |= 1u << bi; }
                const float e0 = 1.0f, e1 = expf(val[1] - val[0]), e2 = expf(val[2] - val[0]), e3 = expf(val[3] - val[0]); const float inv = 1.0f / (((e0 + e1) + e2) + e3);
                const float gk[4] = {e0 * inv, e1 * inv, e2 * inv, e3 * inv};
#pragma unroll
                for (int k = 0; k < 4; ++k) { const int pos = atomicAdd(CNT + idx[k], 1); ASGE[m * 4 + k] = idx[k]; ASGP[m * 4 + k] = pos; GATE[m * 4 + k] = gk[k]; } }
        }
        __syncthreads();
        SEAM(10);
    }

    LAS int* tab = (LAS int*)(lx + LX_TAB);
#define BUILD_TAB(NT) do { __syncthreads(); if (F.tid == 0) { int us = 0, ps = 0; for (int e = 0; e < NE; ++e) { const int c = CNT[e], nb = (c + EBLK - 1) / EBLK; tab[e] = us; tab[33 + e] = ps; tab[66 + e] = nb > 0 ? nb : 1; us += nb * (NT); ps += nb * EBLK; } tab[32] = us; tab[65] = ps; } __syncthreads(); } while (0)

    if (IN(11)) {
        BUILD_TAB(1);
        for (int s = blockIdx.x * (NWAVES * 64) + F.tid; s < NK; s += F.G * NWAVES * 64) { const int e = ASGE[s], pos = ASGP[s]; RSLOT[tab[33 + e] + pos] = s; }
        CVT_PULL(CV_UP);
        SEAM(11);
    }

    if (IN(12)) {
        BUILD_TAB(16);
        const int gc = (F.G == 256) ? GC_P12 : F.G; const int bx = (int)blockIdx.x;
        if ((bx >> 3) < (gc >> 3) || F.G != 256) {
            pg8::MoeSched Sc{(const char*)TB, (const char*)WUPT, 16, (size_t)2 * DFF * D, (size_t)128 * D, (size_t)DFF * D, tab, gc, (F.G == 256) ? (bx & 7) * (gc >> 3) + (bx >> 3) : F.vcu, true, (size_t)D};
            pg8::EpiUp E{b_up, ACT};
            LAS int* gtab = (LAS int*)(lx + LX_RPART);
            { int slv[8]; bool okv[8];
#pragma unroll
              for (int k = 0; k < 8; ++k) { pg8::Unit uu; okv[k] = Sc.next(2 * k + (F.tid >> 8), uu); slv[k] = RSLOT[(okv[k] ? uu.r0 : 0) + (F.tid & 255)]; }
#pragma unroll
              for (int k = 0; k < 8; ++k) if (okv[k]) gtab[(2 * k + (F.tid >> 8)) * 256 + (F.tid & 255)] = (slv[k] < 0 ? 0 : slv[k]) >> 2; }
            __syncthreads();
            pg8::gemm_phase_db6<pg8::EpiUp, pg8::MoeSched>(F.lds, D / 2, D / 2, D / 2, Sc, E, gtab);
            MARK_DONE(12);
        }
        CVT_BESIDE(CV_ALL, 12, gc);
        CVT_PULL(CV_ALL);
        SEAM(12);
    }

    if (IN(13)) {
        BUILD_TAB(8);
        pg8::MoeSched Sc{(const char*)ACT, (const char*)WDNT, 8, (size_t)D * DFF, (size_t)256 * DFF, (size_t)128 * DFF, tab, F.G, F.vcu, false, (size_t)DFF};
        pg8::EpiDown E{b_down, RSLOT, GATE, SLOT};
        pg8::gemm_phase<pg8::EpiDown, pg8::MoeSched, true, false, 1>(F.lds, DFF / 2, DFF / 2, DFF / 2, Sc, E);
        SEAM(13);
    }

    if (IN(14)) {
        for (int m = gw; m < S; m += NGW) {
            const f32x4* xr = (const f32x4*)(H2 + (size_t)m * D) + F.lane; f32x4 v[8]; float s = 0.f;
#pragma unroll
            for (int j = 0; j < 8; ++j) { v[j] = xr[64 * j];
#pragma unroll
                for (int k = 0; k < 4; ++k) { const int w = (int)*((const unsigned*)(SLOT + (size_t)(m * 4 + k) * D) + F.lane + 64 * j); const f32x2 lo = __builtin_amdgcn_cvt_pk_f32_fp8(w, false), hi = __builtin_amdgcn_cvt_pk_f32_fp8(w, true);
                    v[j].x += lo.x * 0.0625f; v[j].y += lo.y * 0.0625f; v[j].z += hi.x * 0.0625f; v[j].w += hi.y * 0.0625f; }
                s += (v[j].x * v[j].x + v[j].y * v[j].y) + (v[j].z * v[j].z + v[j].w * v[j].w); }
            const float rstd = 1.0f / sqrtf(wave_sum(s) * (1.0f / D) + RMS_EPS);
            const f32x4* gr = (const f32x4*)final_norm + F.lane; f32x4* o = (f32x4*)(args.out + (size_t)m * D) + F.lane; f32x4 gv[8];
#pragma unroll
            for (int j = 0; j < 8; ++j) gv[j] = gr[64 * j];
#pragma unroll
            for (int j = 0; j < 8; ++j) o[64 * j] = v[j] * rstd * gv[j];
        }
    }
#undef IN
#undef SEAM
}

extern "C" void kernel_launch(void* const* d_in, const int* in_sizes, int n_in, void* d_out, int out_size, void* d_ws, size_t ws_size, hipStream_t stream) {
    static int grid = 0;
    if (grid == 0) {
        if (n_in != 24 || out_size != S * D || ws_size < WS_END) { fprintf(stderr, "kernel_launch: unexpected shapes (n_in %d out %d ws %zu need %zu)\n", n_in, out_size, ws_size, (size_t)WS_END); grid = -1; return; }
        int dev = 0, cus = 0, per_cu = 0;
        if (hipGetDevice(&dev) != hipSuccess || hipDeviceGetAttribute(&cus, hipDeviceAttributeMultiprocessorCount, dev) != hipSuccess) { grid = -1; return; }
        if (hipFuncSetAttribute((const void*)moe_fwd, hipFuncAttributeMaxDynamicSharedMemorySize, LDS_BYTES) != hipSuccess) { fprintf(stderr, "kernel_launch: hipFuncSetAttribute failed\n"); grid = -1; return; }
        if (hipOccupancyMaxActiveBlocksPerMultiprocessor(&per_cu, (const void*)moe_fwd, NWAVES * 64, LDS_BYTES) != hipSuccess || per_cu < 1) { fprintf(stderr, "kernel_launch: occupancy query says %d\n", per_cu); per_cu = 1; }
        (void)hipGetLastError();
        grid = cus;
    }
    if (grid < 0) return;
    (void)hipMemsetAsync((char*)d_ws + WS_CTL, 0, CTL_ZERO_BYTES, stream);
    Args a{};
    for (int i = 0; i < 24; ++i) a.in[i] = (const float*)d_in[i];
    a.out = (float*)d_out; a.ws = (unsigned char*)d_ws;
#if MK_ONE_LAUNCH
    a.ph_lo = 0; a.ph_hi = NPHASE;
    hipLaunchKernelGGL(moe_fwd, dim3(grid), dim3(NWAVES * 64), LDS_BYTES, stream, a);
#else
    for (int p = 0; p < NPHASE; ++p) { a.ph_lo = p; a.ph_hi = p + 1; for (int rep = 0; rep < (((REPEAT_MASK >> p) & 1) ? 2 : 1); ++rep) hipLaunchKernelGGL(moe_fwd, dim3(grid), dim3(NWAVES * 64), LDS_BYTES, stream, a); }
#endif
}
```

```cpp
#include <hip/hip_runtime.h>
#include <cstdio>
#include <cstdint>

#ifndef MK_ONE_LAUNCH
#define MK_ONE_LAUNCH 1
#endif
#ifndef REPEAT_MASK
#define REPEAT_MASK 0
#endif
#define GC_P1 160
#define GC_P12 224

#define LAS __attribute__((address_space(3)))
#define GAS __attribute__((address_space(1)))
typedef unsigned short bf16_t;
typedef short bf16x8 __attribute__((ext_vector_type(8)));
typedef short s16x4 __attribute__((ext_vector_type(4)));
typedef float f32x4 __attribute__((ext_vector_type(4)));
typedef float f32x2 __attribute__((ext_vector_type(2)));
typedef unsigned u32x4 __attribute__((ext_vector_type(4)));
typedef unsigned u32x2 __attribute__((ext_vector_type(2)));
typedef int v8i32 __attribute__((ext_vector_type(8)));
typedef int v6i32 __attribute__((ext_vector_type(6)));
typedef unsigned u32x3 __attribute__((ext_vector_type(3)));
typedef float f32x16 __attribute__((ext_vector_type(16)));

constexpr int S = 8192, D = 2048, MEM = 256;
constexpr int SBH = 8, HD = 128, SBW = 1024, POOLW = 1024, INW = 4096, NP1 = 8192;
constexpr int XAH = 4, XAW = 512;
constexpr int NE = 32, TOPK = 4, DFF = 2048, NK = S * TOPK, EBLK = 256, MAXBLK = NK / EBLK + NE, PROWS = MAXBLK * EBLK;
constexpr float RMS_EPS = 1e-5f;

constexpr size_t MiB = 1u << 20;
constexpr size_t WS_CTL = 0, CTL_ZERO_BYTES = 1 * MiB;
constexpr size_t WS_W1T = 2 * MiB;
constexpr size_t WS_WAT = WS_W1T + 32 * MiB;
constexpr size_t WS_WBT = WS_WAT + 4 * MiB;
constexpr size_t WS_WMT = WS_WBT + 4 * MiB;
constexpr size_t WS_PLT = WS_WMT + 8 * MiB;
constexpr size_t WS_WQT = WS_PLT + 1 * MiB;
constexpr size_t WS_WKVT = WS_WQT + 2 * MiB;
constexpr size_t WS_WOT = WS_WKVT + 4 * MiB;
constexpr size_t WS_WUPT = WS_WOT + 2 * MiB;
constexpr size_t WS_WDNT = WS_WUPT + 512 * MiB;
constexpr size_t WS_U = WS_WDNT + 256 * MiB;
constexpr size_t WS_MEMN = WS_U + 32 * MiB;
constexpr size_t WS_PG = WS_MEMN + 1 * MiB;
constexpr size_t WS_OA = WS_PG + 128 * MiB;
constexpr size_t WS_PO = WS_OA + 16 * MiB;
constexpr size_t WS_OB = WS_PO + 16 * MiB;
constexpr size_t WS_TMP = WS_OB + 16 * MiB;
constexpr size_t WS_MG = WS_TMP + 64 * MiB;
constexpr size_t WS_H1 = WS_MG + 32 * MiB;
constexpr size_t WS_U2 = WS_H1 + 64 * MiB;
constexpr size_t WS_QXA = WS_U2 + 32 * MiB;
constexpr size_t WS_KVM = WS_QXA + 8 * MiB;
constexpr size_t WS_OXA = WS_KVM + 1 * MiB;
constexpr size_t WS_H2 = WS_OXA + 8 * MiB;
constexpr size_t WS_TB = WS_H2 + 64 * MiB;
constexpr size_t WS_ROWS = WS_TB + 32 * MiB;
constexpr size_t WS_ACT = WS_ROWS + 160 * MiB;
constexpr size_t WS_SLOT = WS_ACT + 160 * MiB;
constexpr size_t WS_ASGE = WS_SLOT + 128 * MiB;
constexpr size_t WS_ASGP = WS_ASGE + 1 * MiB;
constexpr size_t WS_GATE = WS_ASGP + 1 * MiB;
constexpr size_t WS_RSLOT = WS_GATE + 1 * MiB;
constexpr size_t WS_WRT = WS_RSLOT + 1 * MiB;
constexpr size_t WS_END = WS_WRT + 1 * MiB;
constexpr int CW_CNT = 64;
constexpr int CW_CUR = 192;  constexpr int CW_DONE = 256;
constexpr int CW_BAR = 4096;

constexpr int RING_BYTES = 131072;
constexpr int LDS_X_OFF = RING_BYTES;
constexpr int LDS_BYTES = 163840;
constexpr int LX_BAR = 0;
constexpr int LX_TAB = 64;
constexpr int LX_CVS = 32;
constexpr int LX_SBF = 128;
constexpr int LX_LOG = 1024;
constexpr int LX_RPART = 4096;

constexpr int NWAVES = 8;

__device__ __forceinline__ unsigned cvt_pk_bf16(float lo, float hi) { unsigned r; asm volatile("v_cvt_pk_bf16_f32 %0, %1, %2" : "=v"(r) : "v"(lo), "v"(hi)); return r; }
__device__ __forceinline__ unsigned pk4_fp8(float a, float b, float c, float d) { int p = __builtin_amdgcn_cvt_pk_fp8_f32(a, b, 0, false); p = __builtin_amdgcn_cvt_pk_fp8_f32(c, d, p, true); return (unsigned)p; }
__device__ __forceinline__ v6i32 pk32_fp6(const f32x16& lo, const f32x16& hi) { return __builtin_amdgcn_cvt_scalef32_2xpk16_fp6_f32(lo, hi, 1.0f); }
__device__ __forceinline__ void st_fp6_block(unsigned char* p, const v6i32& b) { *(u32x4*)p = (u32x4){(unsigned)b[0], (unsigned)b[1], (unsigned)b[2], (unsigned)b[3]}; *(u32x4*)(p + 64) = (u32x4){(unsigned)b[4], (unsigned)b[5], 0u, 0u}; }
__device__ __forceinline__ float bf_lo(unsigned w) { return __uint_as_float(w << 16); }
__device__ __forceinline__ float bf_hi(unsigned w) { return __uint_as_float(w & 0xffff0000u); }
__device__ __forceinline__ float wave_sum(float v) {
#pragma unroll
    for (int o = 1; o < 64; o <<= 1) v += __shfl_xor(v, o);
    return v;
}
__device__ __forceinline__ float sigmoidf_fast(float x) { return __builtin_amdgcn_rcpf(1.0f + __builtin_amdgcn_exp2f(x * -1.4426950408889634f)); }

#define XB_TMO      128
#define XB_XCNT(j)  (256  + 64 * (j))
#define XB_XSUB(j)  (1280 + 64 * (j))
#define XB_XGEN(j)  (2304 + 64 * (j))
#define XB_TOP      3328
#define XB_TOPGEN   3392
#define XCD_BAR_WORDS 3456
#define XB_SPIN_CAP (1u << 18)
__device__ __forceinline__ unsigned xb_ld(unsigned* p)              { return __hip_atomic_load(p, __ATOMIC_RELAXED, __HIP_MEMORY_SCOPE_AGENT); }
__device__ __forceinline__ unsigned xb_add(unsigned* p, unsigned v) { return __hip_atomic_fetch_add(p, v, __ATOMIC_RELAXED, __HIP_MEMORY_SCOPE_AGENT); }
__device__ __forceinline__ unsigned xb_xcc_id() { return (unsigned)__builtin_amdgcn_s_getreg((3 << 11) | 20) & 0xFu; }
#define XB_SPIN(cond, bar) do { unsigned _sp = 0; while (cond) { __builtin_amdgcn_s_sleep(1); \
    if ((++_sp & 255u) == 0u) { if (xb_ld(&(bar)[XB_TMO])) break; if (_sp > XB_SPIN_CAP) { atomicAdd(&(bar)[XB_TMO], 1u); break; } } } } while (0)
struct XcdBarrier { unsigned* bar; unsigned x; volatile LAS unsigned* st; };
__device__ __forceinline__ XcdBarrier xcd_barrier_post(unsigned* bar, volatile LAS unsigned* st) {
    XcdBarrier b; b.bar = bar; b.x = xb_xcc_id(); b.st = st;
    if (threadIdx.x == 0) (void)xb_add(&bar[XB_XCNT(b.x)], 1u);
    return b;
}
__device__ __forceinline__ void xcd_barrier_complete(unsigned* bar, unsigned x, unsigned& nloc, unsigned& nx) {
    const unsigned G = gridDim.x * gridDim.y * gridDim.z;
    unsigned sum, cnt, mine, sp = 0u;
    for (;;) {
        sum = 0u; cnt = 0u; mine = 0u;
#pragma unroll
        for (unsigned j = 0; j < 16; ++j) { const unsigned c = xb_ld(&bar[XB_XCNT(j)]); sum += c; cnt += (c > 0u) ? 1u : 0u; mine = (j == x) ? c : mine; }
        if (sum == G) break;
        __builtin_amdgcn_s_sleep(1);
        if ((++sp & 255u) == 0u) { if (xb_ld(&bar[XB_TMO])) break; if (sp > XB_SPIN_CAP) { atomicAdd(&bar[XB_TMO], 1u); break; } }
    }
    nloc = mine > 0u ? mine : 1u; nx = cnt > 0u ? cnt : 1u;
}
__device__ __forceinline__ void xcd_barrier(const XcdBarrier& b) {
    asm volatile("s_waitcnt vmcnt(0)" ::: "memory");
    __syncthreads();
    if (threadIdx.x == 0) {
        unsigned* bar = b.bar;
        __builtin_amdgcn_s_waitcnt(0);
        unsigned nloc = b.st[0], nx = b.st[1];
        if (nloc == 0u) { xcd_barrier_complete(bar, b.x, nloc, nx); b.st[0] = nloc; b.st[1] = nx; }
        const unsigned old = xb_add(&bar[XB_XSUB(b.x)], 1u);
        const unsigned gen = old / nloc;
        if (old + 1u == (gen + 1u) * nloc) {
            __builtin_amdgcn_fence(__ATOMIC_RELEASE, "agent");
            asm volatile("s_waitcnt vmcnt(0)" ::: "memory");
            const unsigned og = xb_add(&bar[XB_TOP], 1u);
            const unsigned tg = og / nx;
            if (og + 1u == (tg + 1u) * nx) xb_add(&bar[XB_TOPGEN], 1u);
            else XB_SPIN(xb_ld(&bar[XB_TOPGEN]) == tg, bar);
            __builtin_amdgcn_fence(__ATOMIC_ACQUIRE, "agent");
            xb_add(&bar[XB_XGEN(b.x)], 1u);
            asm volatile("s_waitcnt vmcnt(0)" ::: "memory");
        } else {
            XB_SPIN(xb_ld(&bar[XB_XGEN(b.x)]) == gen, bar);
            __builtin_amdgcn_fence(__ATOMIC_ACQUIRE, "agent");
            asm volatile("s_waitcnt vmcnt(0)" ::: "memory");
        }
    }
    __syncthreads();
}

namespace pg8 {
constexpr int BM = 256, BK = 64, HALF = 128, HTB = HALF * BK * 2, STAGE_BYTES = 8 * HTB, NXCD = 8, WGM = 8;
__host__ __device__ __forceinline__ int lds_byte(int r, int c) { const int st = (r >> 4) * 2 + (c >> 5), rr = r & 15, cc = c & 31, ob = rr * 64 + cc * 2; return st * 1024 + (ob ^ (((ob >> 9) & 1) << 5)); }
__host__ __device__ __forceinline__ void stage_rc(int b, int& R, int& C) { const int st = b / 1024, sb = b % 1024, swz = sb ^ (((sb >> 9) & 1) << 5); R = (st >> 1) * 16 + swz / 64; C = (st & 1) * 32 + (swz % 64) / 2; }
__host__ __device__ __forceinline__ int perm32(int rho) { const int n = rho >> 4, i = rho & 15; return 8 * (i >> 2) + 4 * n + (i & 3); }

struct Unit { const char* A; const char* B0; const char* B1; int r0, c0, x; };

__device__ __forceinline__ void tile_of(int L, int nM, int nN, int& pm, int& pn) {
    const int nwg = nM * nN; int wgid = L;
    { const int q = nwg / NXCD, r = nwg % NXCD, xcd = wgid % NXCD, off = wgid / NXCD; wgid = (xcd < r ? xcd * (q + 1) : r * (q + 1) + (xcd - r) * q) + off; }
    const int nig = WGM * nN, gid = wgid / nig, fm = gid * WGM, gsz = (nM - fm) < WGM ? (nM - fm) : WGM;
    pm = fm + ((wgid % nig) % gsz); pn = (wgid % nig) / gsz;
}
struct DenseSched {
    const char* A; const char* B; int lda, ldb, nM, nN, G, c;
    __device__ __forceinline__ bool next(int i, Unit& u) const {
        const long L = (long)i * G + c; if (L >= (long)nM * nN) return false;
        int pm, pn; tile_of((int)L, nM, nN, pm, pn);
        u.A = A + (size_t)pm * BM * lda * 2; u.B0 = B + (size_t)pn * BM * ldb * 2; u.B1 = u.B0 + (size_t)HALF * ldb * 2; u.r0 = pm * BM; u.c0 = pn * BM; u.x = 0; return true;
    }
};
struct BranchSched {
    const char* A0; const char* A1; const char* B0; const char* B1; int lda, ldb, nM, nN, G, c;
    __device__ __forceinline__ bool next(int i, Unit& u) const {
        const long L = (long)(i >> 1) * G + c; if (L >= (long)nM * nN) return false;
        int pm, pn; tile_of((int)L, nM, nN, pm, pn); const int br = i & 1;
        u.A = (br ? A1 : A0) + (size_t)pm * BM * lda * 2; u.B0 = (br ? B1 : B0) + (size_t)pn * BM * ldb * 2; u.B1 = u.B0 + (size_t)HALF * ldb * 2; u.r0 = pm * BM; u.c0 = pn * BM; u.x = br; return true;
    }
};
struct PoolSched {
    const char* A; const char* B; int G, c;
    __device__ __forceinline__ bool next(int i, Unit& u) const {
        const int L = i * G + c; if (L >= (S / BM) * 4) return false;
        const int pm = L >> 2, g = L & 3;
        u.A = A + ((size_t)pm * BM * POOLW + g * 256) * 2; u.B0 = B + (size_t)g * 256 * 256 * 2; u.B1 = u.B0 + (size_t)HALF * 256 * 2; u.r0 = pm * BM; u.c0 = g * 256; u.x = g; return true;
    }
};
struct MoeSched {
    const char* A; const char* B; int NT; size_t estride; size_t tstride; size_t hoff; const LAS int* tab; int G, c; bool gather; size_t arow;
    __device__ __forceinline__ int tu(int i) const { return __builtin_amdgcn_readfirstlane(tab[i]); }
    __device__ __forceinline__ bool next(int i, Unit& u) const {
        const int L = i * G + c; if (L >= tu(32)) return false;
        int e = 0;
#pragma unroll
        for (int s = 16; s >= 1; s >>= 1) { if (tu(e + s) <= L) e += s; }
        const int r = L - tu(e), nb = tu(66 + e), nt = r / nb, blk = r - nt * nb, prow = tu(33 + e) + blk * EBLK;
        u.A = gather ? A : A + (size_t)prow * arow; u.B0 = B + (size_t)e * estride + (size_t)nt * tstride; u.B1 = u.B0 + hoff; u.r0 = prow; u.c0 = nt; u.x = e; return true;
    }
};

template <class Epi, class Sched, bool ALIGN_EPI, bool GATHER = false, int PREC = 0>
__device__ __forceinline__ void gemm_phase(LAS unsigned char* lds, const int K, const int lda, const int ldb, const Sched& S, const Epi& E, const LAS int* gtab = nullptr) {
    const int tid = threadIdx.x, wid = __builtin_amdgcn_readfirstlane(tid >> 6), lane = tid & 63, wr = wid >> 2, wc = wid & 3, fr = lane & 15, fq = lane >> 4;
    const int nt = K / BK;
    unsigned voffB[2], vc[2][2], vn[2][2]; int RA[2], CA[2];
#pragma unroll
    for (int i = 0; i < 2; ++i) { int R, C; stage_rc(tid * 16 + i * 8192, R, C); const int Rb = Epi::PERM ? ((R & ~31) + perm32(R & 31)) : R; RA[i] = R; CA[i] = C;
        voffB[i] = (unsigned)(Rb * ldb + C) * 2u; }
#define PG8_AOFF(dst, ord) do { _Pragma("unroll") for (int _h = 0; _h < 2; ++_h) _Pragma("unroll") for (int _i = 0; _i < 2; ++_i) \
        dst[_h][_i] = GATHER ? ((unsigned)gtab[(ord) * 256 + _h * HALF + RA[_i]] * (unsigned)lda + (unsigned)CA[_i]) * 2u : (unsigned)((_h * HALF + RA[_i]) * lda + CA[_i]) * 2u; } while (0)
    const size_t kstep = (size_t)(BK * 2);
    const unsigned ldsw = (unsigned)wid * 1024u;
    const int aoff = lds_byte(wr * 64 + fr, fq * 8), boff = lds_byte(wc * 32 + fr, fq * 8);
#define PG8_SA(b, h) (((b) * 2 + (h)) * HTB)
#define PG8_SB(b, h) ((4 + (b) * 2 + (h)) * HTB)
#define PG8_STAGE(bufoff, gbase, voff) do { _Pragma("unroll") for (int _i = 0; _i < 2; ++_i) \
        __builtin_amdgcn_global_load_lds((const unsigned*)((const char*)(gbase) + (voff)[_i]), (LAS unsigned*)(lds + (bufoff) + ldsw + _i * 8192), 16, 0, 0); } while (0)
#define PG8_LD6(off) __builtin_bit_cast(v6i32, __builtin_shufflevector(*(const LAS u32x4*)(lds + (off)), __builtin_shufflevector(*(const LAS u32x2*)(lds + (off) + 1024), *(const LAS u32x2*)(lds + (off) + 1024), 0, 1, -1, -1), 0, 1, 2, 3, 4, 5))
#define PG8_LD8(off) __builtin_bit_cast(v8i32, __builtin_shufflevector(*(const LAS u32x4*)(lds + (off)), *(const LAS u32x4*)(lds + (off) + 1024), 0, 1, 2, 3, 4, 5, 6, 7))
#define PG8_LDA(dst, b, h) do { if (PREC == 2) { _Pragma("unroll") for (int m = 0; m < 4; ++m) dst##6[m] = PG8_LD6(PG8_SA(b, h) + aoff + m * 2048); } \
      else if (PREC == 1) { _Pragma("unroll") for (int m = 0; m < 4; ++m) dst##8[m] = PG8_LD8(PG8_SA(b, h) + aoff + m * 2048); } \
      else { _Pragma("unroll") for (int m = 0; m < 4; ++m) _Pragma("unroll") for (int k = 0; k < 2; ++k) dst[m][k] = *(const LAS bf16x8*)(lds + PG8_SA(b, h) + aoff + m * 2048 + k * 1024); } } while (0)
#define PG8_LDB(dst, b, h) do { if (PREC == 2) { _Pragma("unroll") for (int n = 0; n < 2; ++n) dst##6[n] = PG8_LD6(PG8_SB(b, h) + boff + n * 2048); } \
      else if (PREC == 1) { _Pragma("unroll") for (int n = 0; n < 2; ++n) dst##8[n] = PG8_LD8(PG8_SB(b, h) + boff + n * 2048); } \
      else { _Pragma("unroll") for (int n = 0; n < 2; ++n) _Pragma("unroll") for (int k = 0; k < 2; ++k) dst[n][k] = *(const LAS bf16x8*)(lds + PG8_SB(b, h) + boff + n * 2048 + k * 1024); } } while (0)
#define PG8_MMA(ai, bj, At, Bt) do { __builtin_amdgcn_s_setprio(1); if (PREC == 2) { _Pragma("unroll") for (int m = 0; m < 4; ++m) _Pragma("unroll") for (int n = 0; n < 2; ++n) \
        asm volatile("v_mfma_scale_f32_16x16x128_f8f6f4 %0, %1, %2, %0, %3, %4 op_sel_hi:[0,0,0] cbsz:2 blgp:2" : "+v"(acc[ai][bj][m][n]) : "v"(Bt##6[n]), "v"(At##6[m]), "v"(sc_w), "v"(sc_a)); } \
      else if (PREC == 1) { _Pragma("unroll") for (int m = 0; m < 4; ++m) _Pragma("unroll") for (int n = 0; n < 2; ++n) \
        asm volatile("v_mfma_scale_f32_16x16x128_f8f6f4 %0, %1, %2, %0, %3, %4 op_sel_hi:[0,0,0]" : "+v"(acc[ai][bj][m][n]) : "v"(Bt##8[n]), "v"(At##8[m]), "v"(sc_w), "v"(sc_a)); } \
      else { _Pragma("unroll") for (int m = 0; m < 4; ++m) _Pragma("unroll") for (int n = 0; n < 2; ++n) _Pragma("unroll") for (int k = 0; k < 2; ++k) \
        acc[ai][bj][m][n] = __builtin_amdgcn_mfma_f32_16x16x32_bf16(Bt[n][k], At[m][k], acc[ai][bj][m][n], 0, 0, 0); } __builtin_amdgcn_s_setprio(0); } while (0)
#define PG8_WAIT_V(n) asm volatile("s_waitcnt vmcnt(" #n ")" ::: "memory")
#define PG8_WAIT_L(n) asm volatile("s_waitcnt lgkmcnt(" #n ")" ::: "memory")
#define PG8_BAR __builtin_amdgcn_s_barrier()
#define PG8_SCHED __builtin_amdgcn_sched_barrier(0)
    Unit cur, nxt; int ui = 0;
    if (!S.next(0, cur)) return;
    f32x4 acc[2][2][4][2];
#pragma unroll
    for (int a = 0; a < 2; ++a)
#pragma unroll
        for (int b = 0; b < 2; ++b)
#pragma unroll
            for (int m = 0; m < 4; ++m)
#pragma unroll
                for (int n = 0; n < 2; ++n) acc[a][b][m][n] = (f32x4){0.f, 0.f, 0.f, 0.f};
    bf16x8 At[4][2], B0[2][2], B1[2][2]; v8i32 At8[4], B08[2], B18[2]; v6i32 At6[4], B06[2], B16[2];
    const int sc_w = 121, sc_a = (PREC == 2) ? 126 : 127;
    PG8_AOFF(vc, 0);
#pragma unroll
    for (int _h = 0; _h < 2; ++_h) { vn[_h][0] = vc[_h][0]; vn[_h][1] = vc[_h][1]; }
    PG8_STAGE(PG8_SB(0, 0), cur.B0, voffB); PG8_STAGE(PG8_SB(0, 1), cur.B1, voffB); PG8_STAGE(PG8_SA(0, 0), cur.A, vc[0]); PG8_STAGE(PG8_SA(0, 1), cur.A, vc[1]);
    if (wr == 1) PG8_BAR;
    PG8_WAIT_V(2); PG8_BAR;
    PG8_STAGE(PG8_SB(1, 0), cur.B0 + kstep, voffB); PG8_STAGE(PG8_SA(1, 0), cur.A + kstep, vc[0]); PG8_STAGE(PG8_SB(1, 1), cur.B1 + kstep, voffB);
    PG8_WAIT_V(6); PG8_BAR;
    for (;;) {
        const bool has_next = S.next(ui + 1, nxt);
        if (GATHER && has_next) PG8_AOFF(vn, ui + 1);
        const char* nA = has_next ? nxt.A : cur.A; const char* nB0 = has_next ? nxt.B0 : cur.B0; const char* nB1 = has_next ? nxt.B1 : cur.B1;
#pragma nounroll
        for (int t = 0; t < nt; t += 2) {
            const bool last = (t == nt - 2);
            const char* a1 = cur.A + (size_t)(t + 1) * kstep;
            const char* a2 = last ? nA : cur.A + (size_t)(t + 2) * kstep;
            const char* b20 = last ? nB0 : cur.B0 + (size_t)(t + 2) * kstep; const char* b21 = last ? nB1 : cur.B1 + (size_t)(t + 2) * kstep;
            const char* a3 = a2 + kstep; const char* b30 = b20 + kstep; const char* b31 = b21 + kstep;
            unsigned v2[2][2];
#pragma unroll
            for (int _h = 0; _h < 2; ++_h) { v2[_h][0] = (GATHER && last) ? vn[_h][0] : vc[_h][0]; v2[_h][1] = (GATHER && last) ? vn[_h][1] : vc[_h][1]; }
            PG8_LDB(B0, 0, 0); PG8_LDB(B1, 0, 1); PG8_SCHED; PG8_LDA(At, 0, 0); PG8_STAGE(PG8_SA(1, 1), a1, vc[1]);
            PG8_WAIT_V(8); PG8_WAIT_L(0); PG8_BAR; PG8_MMA(0, 0, At, B0); PG8_MMA(0, 1, At, B1); PG8_BAR; PG8_SCHED;
            PG8_LDA(At, 0, 1); PG8_STAGE(PG8_SB(0, 0), b20, voffB); PG8_STAGE(PG8_SB(0, 1), b21, voffB); PG8_STAGE(PG8_SA(0, 0), a2, v2[0]);
            PG8_WAIT_V(8); PG8_WAIT_L(0); PG8_BAR; PG8_MMA(1, 0, At, B0); PG8_MMA(1, 1, At, B1); PG8_BAR; PG8_SCHED;
            PG8_LDB(B0, 1, 0); PG8_LDB(B1, 1, 1); PG8_SCHED; PG8_LDA(At, 1, 0); PG8_STAGE(PG8_SA(0, 1), a2, v2[1]);
            PG8_WAIT_V(8); PG8_WAIT_L(0); PG8_BAR; PG8_MMA(0, 0, At, B0); PG8_MMA(0, 1, At, B1); PG8_BAR; PG8_SCHED;
            PG8_LDA(At, 1, 1); PG8_STAGE(PG8_SB(1, 0), b30, voffB); PG8_STAGE(PG8_SB(1, 1), b31, voffB); PG8_STAGE(PG8_SA(1, 0), a3, v2[0]);
            PG8_WAIT_V(8); PG8_WAIT_L(0); PG8_BAR; PG8_MMA(1, 0, At, B0); PG8_MMA(1, 1, At, B1); PG8_BAR; PG8_SCHED;
        }
        if constexpr (ALIGN_EPI) { if (wr == 0) PG8_BAR; }
        if (PREC != 0) asm volatile("s_nop 15\n\ts_nop 15\n\ts_nop 15\n\ts_nop 15" ::: "memory");
        E(acc, cur, wr, wc, fr, fq);
        if (!has_next) break;
        bool kp = false; if constexpr (Epi::KEEPS) kp = E.keep(cur);
        if (!kp) {
#pragma unroll
        for (int a = 0; a < 2; ++a)
#pragma unroll
            for (int b = 0; b < 2; ++b)
#pragma unroll
                for (int m = 0; m < 4; ++m)
#pragma unroll
                    for (int n = 0; n < 2; ++n) acc[a][b][m][n] = (f32x4){0.f, 0.f, 0.f, 0.f}; }
        cur = nxt; ++ui;
        if (GATHER) {
#pragma unroll
            for (int _h = 0; _h < 2; ++_h) { vc[_h][0] = vn[_h][0]; vc[_h][1] = vn[_h][1]; } }
        if constexpr (ALIGN_EPI) { if (wr == 1) PG8_BAR; }
    }
    PG8_WAIT_V(0);
    if constexpr (!ALIGN_EPI) { if (wr == 0) PG8_BAR; }
    PG8_BAR;
#undef PG8_AOFF
#undef PG8_SA
#undef PG8_SB
#undef PG8_STAGE
#undef PG8_LDA
#undef PG8_LDB
#undef PG8_MMA
#undef PG8_LD8
#undef PG8_LD6
#undef PG8_WAIT_V
#undef PG8_WAIT_L
#undef PG8_BAR
#undef PG8_SCHED
}

template <int OFF>
__device__ __forceinline__ v6i32 ld6x(unsigned addr) {
    u32x4 lo; u32x2 hi;
    asm volatile("ds_read_b128 %0, %1 offset:%2" : "=v"(lo) : "v"(addr), "n"(OFF));
    asm volatile("ds_read_b64 %0, %1 offset:%2" : "=v"(hi) : "v"(addr), "n"(OFF + 1024));
    return (v6i32){(int)lo[0], (int)lo[1], (int)lo[2], (int)lo[3], (int)hi[0], (int)hi[1]};
}
template <class Epi, class Sched>
__device__ __forceinline__ void gemm_phase_db6(LAS unsigned char* lds, const int K, const int lda, const int ldb, const Sched& S, const Epi& E, const LAS int* gtab) {
    const int tid = threadIdx.x, wid = __builtin_amdgcn_readfirstlane(tid >> 6), lane = tid & 63, wr = wid >> 2, wc = wid & 3, fr = lane & 15, fq = lane >> 4;
    const int nt = K / BK;
    unsigned voffB0, vc[2][2]; const size_t bstep = (size_t)64 * ldb * 2;
    { int R, C; stage_rc(tid * 16, R, C); const int Rb = Epi::PERM ? ((R & ~31) + perm32(R & 31)) : R; voffB0 = (unsigned)(Rb * ldb + C) * 2u; }
#define DB_AOFF(dst, ord) do { _Pragma("unroll") for (int _i = 0; _i < 2; ++_i) { int _R, _C; stage_rc((int)threadIdx.x * 16 + _i * 8192, _R, _C); _Pragma("unroll") for (int _h = 0; _h < 2; ++_h) \
        dst[_h][_i] = ((unsigned)gtab[(ord) * 256 + _h * HALF + _R] * (unsigned)lda + (unsigned)_C) * 2u; } } while (0)
    const size_t kstep = (size_t)(BK * 2);
    const unsigned ldsw = (unsigned)wid * 1024u;
    const int aoff = lds_byte(wr * 64 + fr, fq * 8), boff = lds_byte(wc * 32 + fr, fq * 8);
    const unsigned aA = (unsigned)(size_t)(lds + aoff), aB = (unsigned)(size_t)(lds + 4 * HTB + boff);
#define DB_SA(b, h) (((b) * 2 + (h)) * HTB)
#define DB_SB(b, h) ((4 + (b) * 2 + (h)) * HTB)
#define DB_STAGEA1(bufoff, gbase, voff, i) __builtin_amdgcn_global_load_lds((const unsigned*)((const char*)(gbase) + (voff)[i]), (LAS unsigned*)(lds + (bufoff) + ldsw + (i) * 8192), 16, 0, 0)
#define DB_STAGEB1(bufoff, gbase, i) __builtin_amdgcn_global_load_lds((const unsigned*)((const char*)(gbase) + (size_t)(i) * bstep + voffB0), (LAS unsigned*)(lds + (bufoff) + ldsw + (i) * 8192), 16, 0, 0)
#define DB_STAGEA(bufoff, gbase, voff) do { DB_STAGEA1(bufoff, gbase, voff, 0); DB_STAGEA1(bufoff, gbase, voff, 1); } while (0)
#define DB_STAGEB(bufoff, gbase) do { DB_STAGEB1(bufoff, gbase, 0); DB_STAGEB1(bufoff, gbase, 1); } while (0)
#define DB_LDA(dst, b, h) do { dst[0] = ld6x<DB_SA(b, h)>(aA); dst[1] = ld6x<DB_SA(b, h) + 2048>(aA); dst[2] = ld6x<DB_SA(b, h) + 4096>(aA); dst[3] = ld6x<DB_SA(b, h) + 6144>(aA); } while (0)
#define DB_LDB(dst, b, h) do { dst[0] = ld6x<((b) * 2 + (h)) * HTB>(aB); dst[1] = ld6x<((b) * 2 + (h)) * HTB + 2048>(aB); } while (0)
#define DB_MMA(ai, bj, At, Bt) do { __builtin_amdgcn_s_setprio(1); _Pragma("unroll") for (int m = 0; m < 4; ++m) _Pragma("unroll") for (int n = 0; n < 2; ++n) \
        asm volatile("v_mfma_scale_f32_16x16x128_f8f6f4 %0, %1, %2, %0, %3, %4 op_sel_hi:[0,0,0] cbsz:2 blgp:2" : "+v"(acc[ai][bj][m][n]) : "v"(Bt[n]), "v"(At[m]), "v"(sc_w), "v"(sc_a)); __builtin_amdgcn_s_setprio(0); } while (0)
#define DB_MMA4(ai, bj, mlo, At, Bt) do { _Pragma("unroll") for (int m = (mlo); m < (mlo) + 2; ++m) _Pragma("unroll") for (int n = 0; n < 2; ++n) \
        asm volatile("v_mfma_scale_f32_16x16x128_f8f6f4 %0, %1, %2, %0, %3, %4 op_sel_hi:[0,0,0] cbsz:2 blgp:2" : "+v"(acc[ai][bj][m][n]) : "v"(Bt[n]), "v"(At[m]), "v"(sc_w), "v"(sc_a)); } while (0)
#define DB_SYNC() do { asm volatile("s_waitcnt vmcnt(8) lgkmcnt(0)" ::: "memory"); __builtin_amdgcn_s_barrier(); } while (0)
#define DB_SYNC6() do { asm volatile("s_waitcnt vmcnt(6) lgkmcnt(0)" ::: "memory"); __builtin_amdgcn_s_barrier(); } while (0)
#define DB_STEP(ai, At, sb, sa, gb, ga, vo) do { \
        DB_STAGEB1(sb, gb, 0); DB_SCHED; DB_MMA4(ai, 0, 0, At, B0); DB_SCHED; DB_STAGEB1(sb, gb, 1); DB_SCHED; DB_MMA4(ai, 0, 2, At, B0); DB_SCHED; \
        DB_STAGEA1(sa, ga, vo, 0); DB_SCHED; DB_MMA4(ai, 1, 0, At, B1); DB_SCHED; DB_STAGEA1(sa, ga, vo, 1); DB_SCHED; DB_MMA4(ai, 1, 2, At, B1); DB_SCHED; } while (0)
#define DB_SCHED __builtin_amdgcn_sched_barrier(0)
    Unit cur, nxt; int ui = 0;
    if (!S.next(0, cur)) return;
    f32x4 acc[2][2][4][2]; typename Epi::Pre pre;
    E.prefetch(pre, cur, wc, fq); E.init(acc, pre);
    v6i32 A0[4], A1[4], B0[2], B1[2];
    const int sc_w = 121, sc_a = 126;
    if (wid >= 4) __builtin_amdgcn_s_setprio(1);
    DB_AOFF(vc, 0);
    DB_STAGEB(DB_SB(0, 0), cur.B0); DB_STAGEA(DB_SA(0, 0), cur.A, vc[0]); DB_STAGEB(DB_SB(0, 1), cur.B1); DB_STAGEA(DB_SA(0, 1), cur.A, vc[1]);
    DB_STAGEB(DB_SB(1, 0), cur.B0 + kstep); DB_STAGEA(DB_SA(1, 0), cur.A + kstep, vc[0]); DB_STAGEB(DB_SB(1, 1), cur.B1 + kstep); DB_STAGEA(DB_SA(1, 1), cur.A + kstep, vc[1]);
    DB_SYNC();
    DB_LDB(B0, 0, 0); DB_LDB(B1, 0, 1); DB_LDA(A0, 0, 0); DB_SCHED;
    for (;;) {
        const bool has_next = S.next(ui + 1, nxt);
        const char* nA = has_next ? nxt.A : cur.A; const char* nB0 = has_next ? nxt.B0 : cur.B0; const char* nB1 = has_next ? nxt.B1 : cur.B1;
#pragma nounroll
        for (int t = 0; t < nt; t += 2) {
            const bool last = (t == nt - 2);
            const char* a2 = last ? nA : cur.A + (size_t)(t + 2) * kstep;
            const char* b20 = last ? nB0 : cur.B0 + (size_t)(t + 2) * kstep; const char* b21 = last ? nB1 : cur.B1 + (size_t)(t + 2) * kstep;
            const char* a3 = a2 + kstep; const char* b30 = b20 + kstep; const char* b31 = b21 + kstep;
            if (last && has_next) DB_AOFF(vc, ui + 1);
            DB_SYNC(); DB_LDA(A1, 0, 1); DB_SCHED; DB_STEP(0, A0, DB_SB(0, 0), DB_SA(0, 0), b20, a2, vc[0]);
            DB_SYNC6(); DB_LDA(A0, 1, 0); DB_SCHED; DB_STEP(1, A1, DB_SB(0, 1), DB_SA(0, 1), b21, a2, vc[1]); DB_LDB(B0, 1, 0); DB_LDB(B1, 1, 1); DB_SCHED;
            DB_SYNC(); DB_LDA(A1, 1, 1); DB_SCHED; DB_STEP(0, A0, DB_SB(1, 0), DB_SA(1, 0), b30, a3, vc[0]);
            DB_SYNC6(); if (!last) DB_LDA(A0, 0, 0); DB_SCHED; DB_STEP(1, A1, DB_SB(1, 1), DB_SA(1, 1), b31, a3, vc[1]); if (!last) { DB_LDB(B0, 0, 0); DB_LDB(B1, 0, 1); } DB_SCHED;
        }
        asm volatile("s_nop 15\n\ts_nop 15\n\ts_nop 15\n\ts_nop 15" ::: "memory");
        { const unsigned _l = (unsigned)__builtin_amdgcn_mbcnt_hi(~0u, __builtin_amdgcn_mbcnt_lo(~0u, 0u)); if (has_next) E.prefetch(pre, nxt, wc, (int)(_l >> 4)); E(acc, cur, wr, wc, (int)(_l & 15u), (int)(_l >> 4)); }
        if (!has_next) break;
        E.init(acc, pre);
        cur = nxt; ++ui;
        DB_LDB(B0, 0, 0); DB_LDB(B1, 0, 1); DB_LDA(A0, 0, 0); DB_SCHED;
    }
    asm volatile("s_waitcnt vmcnt(0) lgkmcnt(0)" ::: "memory");
    __builtin_amdgcn_s_setprio(0);
    __builtin_amdgcn_s_barrier();
#undef DB_AOFF
#undef DB_SA
#undef DB_SB
#undef DB_STAGEA
#undef DB_STAGEB
#undef DB_LDA
#undef DB_LDB
#undef DB_MMA
#undef DB_SYNC
#undef DB_SYNC6
#undef DB_STEP
#undef DB_MMA4
#undef DB_STAGEA1
#undef DB_STAGEB1
#undef DB_SCHED
}

typedef f32x4 Acc[2][2][4][2];

struct EpiProj {
    static constexpr bool PERM = true, KEEPS = false;
    bf16_t* O; const float* bgate;
    __device__ __forceinline__ void operator()(Acc& acc, const Unit& u, int wr, int wc, int fr, int fq) const {
        const int row0 = u.r0 + wr * 64 + fr, col0 = u.c0 + wc * 32 + 8 * fq; const bool gate = u.c0 >= INW;
        typedef float f32x2v __attribute__((ext_vector_type(2)));
        f32x4 bv[2][2];
#pragma unroll
        for (int bj = 0; bj < 2; ++bj)
#pragma unroll
            for (int n = 0; n < 2; ++n) bv[bj][n] = gate ? *(const f32x4*)(bgate + (col0 - INW) + bj * HALF + 4 * n) * -1.4426950408889634f : (f32x4){0.f, 0.f, 0.f, 0.f};
#pragma unroll
        for (int ai = 0; ai < 2; ++ai)
#pragma unroll
            for (int m = 0; m < 4; ++m) { bf16_t* rowp = O + (size_t)(row0 + ai * HALF + m * 16) * NP1 + col0;
#pragma unroll
                for (int bj = 0; bj < 2; ++bj) { f32x4 v[2] = {acc[ai][bj][m][0], acc[ai][bj][m][1]};
                    if (gate) {
#pragma unroll
                        for (int n = 0; n < 2; ++n)
#pragma unroll
                            for (int j = 0; j < 4; j += 2) { const f32x2v a2 = {v[n][j], v[n][j + 1]}, b2 = {bv[bj][n][j], bv[bj][n][j + 1]};
                                const f32x2v t = a2 * -1.4426950408889634f + b2; const f32x2v e = {__builtin_amdgcn_exp2f(t.x), __builtin_amdgcn_exp2f(t.y)}; const f32x2v d = e + 1.0f;
                                v[n][j] = __builtin_amdgcn_rcpf(d.x); v[n][j + 1] = __builtin_amdgcn_rcpf(d.y); } }
                    u32x4 w; w.x = cvt_pk_bf16(v[0][0], v[0][1]); w.y = cvt_pk_bf16(v[0][2], v[0][3]); w.z = cvt_pk_bf16(v[1][0], v[1][1]); w.w = cvt_pk_bf16(v[1][2], v[1][3]);
                    *(u32x4*)(rowp + bj * HALF) = w; } }
    }
};
struct EpiBf16 {
    static constexpr bool PERM = true, KEEPS = false;
    bf16_t* O; int ldc; const float* cscale;
    __device__ __forceinline__ void operator()(Acc& acc, const Unit& u, int wr, int wc, int fr, int fq) const {
        const int row0 = u.r0 + wr * 64 + fr, col0 = u.c0 + wc * 32 + 8 * fq;
#pragma unroll
        for (int bj = 0; bj < 2; ++bj) {
            const f32x4 s0 = cscale ? *(const f32x4*)(cscale + col0 + bj * HALF) : (f32x4){1.f, 1.f, 1.f, 1.f}, s1 = cscale ? *(const f32x4*)(cscale + col0 + bj * HALF + 4) : (f32x4){1.f, 1.f, 1.f, 1.f};
#pragma unroll
            for (int ai = 0; ai < 2; ++ai)
#pragma unroll
                for (int m = 0; m < 4; ++m) { bf16_t* rowp = O + (size_t)(row0 + ai * HALF + m * 16) * ldc + col0;
                    const f32x4 v0 = acc[ai][bj][m][0] * s0, v1 = acc[ai][bj][m][1] * s1;
                    u32x4 w; w.x = cvt_pk_bf16(v0[0], v0[1]); w.y = cvt_pk_bf16(v0[2], v0[3]); w.z = cvt_pk_bf16(v1[0], v1[1]); w.w = cvt_pk_bf16(v1[2], v1[3]);
                    *(u32x4*)(rowp + bj * HALF) = w; } }
    }
};
struct EpiBranch {
    static constexpr bool PERM = true, KEEPS = true;
    const bf16_t* PG; bf16_t* MG;
    __device__ __forceinline__ bool keep(const Unit& u) const { return u.x == 0; }
    __device__ __forceinline__ void operator()(Acc& acc, const Unit& u, int wr, int wc, int fr, int fq) const {
        const int row0 = u.r0 + wr * 64 + fr, col0 = u.c0 + wc * 32 + 8 * fq;
        if (u.x == 0) {
#pragma unroll
            for (int ai = 0; ai < 2; ++ai) { u32x4 gb[4][2], ga[4][2];
#pragma unroll
                for (int m = 0; m < 4; ++m)
#pragma unroll
                    for (int bj = 0; bj < 2; ++bj) { const bf16_t* gp = PG + (size_t)(row0 + ai * HALF + m * 16) * NP1 + INW + col0 + bj * HALF; gb[m][bj] = *(const u32x4*)(gp + D); ga[m][bj] = *(const u32x4*)gp; }
                asm volatile("" ::: "memory");
#pragma unroll
                for (int m = 0; m < 4; ++m)
#pragma unroll
                    for (int bj = 0; bj < 2; ++bj) { const u32x4 g = gb[m][bj], a = ga[m][bj];
                        const f32x4 h0 = {bf_lo(g.x), bf_hi(g.x), bf_lo(g.y), bf_hi(g.y)}, h1 = {bf_lo(g.z), bf_hi(g.z), bf_lo(g.w), bf_hi(g.w)};
                        const f32x4 a0 = {bf_lo(a.x), bf_hi(a.x), bf_lo(a.y), bf_hi(a.y)}, a1 = {bf_lo(a.z), bf_hi(a.z), bf_lo(a.w), bf_hi(a.w)};
#pragma unroll
                        for (int j = 0; j < 4; ++j) { acc[ai][bj][m][0][j] *= a0[j] * __builtin_amdgcn_rcpf(fmaxf(h0[j], 1e-30f)); acc[ai][bj][m][1][j] *= a1[j] * __builtin_amdgcn_rcpf(fmaxf(h1[j], 1e-30f)); } }
                asm volatile("" ::: "memory"); }
        } else {
#pragma unroll
            for (int ai = 0; ai < 2; ++ai) { u32x4 gb[4][2];
#pragma unroll
                for (int m = 0; m < 4; ++m)
#pragma unroll
                    for (int bj = 0; bj < 2; ++bj) gb[m][bj] = *(const u32x4*)(PG + (size_t)(row0 + ai * HALF + m * 16) * NP1 + INW + D + col0 + bj * HALF);
                asm volatile("" ::: "memory");
#pragma unroll
                for (int m = 0; m < 4; ++m)
#pragma unroll
                    for (int bj = 0; bj < 2; ++bj) { const u32x4 g = gb[m][bj];
                        f32x4 h0 = {bf_lo(g.x), bf_hi(g.x), bf_lo(g.y), bf_hi(g.y)}, h1 = {bf_lo(g.z), bf_hi(g.z), bf_lo(g.w), bf_hi(g.w)};
#pragma unroll
                        for (int j = 0; j < 4; ++j) { h0[j] = fmaxf(h0[j], 1e-30f); h1[j] = fmaxf(h1[j], 1e-30f); }
                        const f32x4 v0 = acc[ai][bj][m][0] * h0, v1 = acc[ai][bj][m][1] * h1;
                        u32x4 w; w.x = cvt_pk_bf16(v0[0], v0[1]); w.y = cvt_pk_bf16(v0[2], v0[3]); w.z = cvt_pk_bf16(v1[0], v1[1]); w.w = cvt_pk_bf16(v1[2], v1[3]);
                        *(u32x4*)(MG + (size_t)(row0 + ai * HALF + m * 16) * D + col0 + bj * HALF) = w; }
                asm volatile("" ::: "memory"); }
        }
    }
};
struct EpiResid {
    static constexpr bool PERM = false, KEEPS = false;
    const float* res; float* out; int ldc;
    __device__ __forceinline__ void operator()(Acc& acc, const Unit& u, int wr, int wc, int fr, int fq) const {
        const int row0 = u.r0 + wr * 64 + fr, col0 = u.c0 + wc * 32 + 4 * fq;
#pragma unroll
        for (int ai = 0; ai < 2; ++ai) {
            f32x4 r[4][2][2];
#pragma unroll
            for (int m = 0; m < 4; ++m) { const size_t off = (size_t)(row0 + ai * HALF + m * 16) * ldc + col0;
#pragma unroll
                for (int bj = 0; bj < 2; ++bj)
#pragma unroll
                    for (int n = 0; n < 2; ++n) r[m][bj][n] = *(const f32x4*)(res + off + bj * HALF + n * 16); }
            asm volatile("" ::: "memory");
#pragma unroll
            for (int m = 0; m < 4; ++m) { const size_t off = (size_t)(row0 + ai * HALF + m * 16) * ldc + col0;
#pragma unroll
                for (int bj = 0; bj < 2; ++bj)
#pragma unroll
                    for (int n = 0; n < 2; ++n) *(f32x4*)(out + off + bj * HALF + n * 16) = r[m][bj][n] + acc[ai][bj][m][n]; }
            asm volatile("" ::: "memory"); }
    }
};
struct EpiUp {
    static constexpr bool PERM = true, KEEPS = false;
    const float* bup; unsigned char* ACT;
    struct Pre { f32x4 bg[2], bl[2]; };
    __device__ __forceinline__ void prefetch(Pre& p, const Unit& u, int wc, int fq) const {
        const float* be = bup + (size_t)u.x * (2 * DFF) + u.c0 * HALF + wc * 32 + 8 * fq;
#pragma unroll
        for (int n = 0; n < 2; ++n) { p.bg[n] = *(const f32x4*)(be + 4 * n); p.bl[n] = *(const f32x4*)(be + DFF + 4 * n) + 1.0f; }
    }
    __device__ __forceinline__ void init(Acc& acc, const Pre& p) const {
#pragma unroll
        for (int ai = 0; ai < 2; ++ai)
#pragma unroll
            for (int m = 0; m < 4; ++m)
#pragma unroll
                for (int n = 0; n < 2; ++n) { acc[ai][0][m][n] = p.bg[n]; acc[ai][1][m][n] = p.bl[n]; }
    }
    __device__ __forceinline__ void operator()(Acc& acc, const Unit& u, int wr, int wc, int fr, int fq) const {
        const int row0 = u.r0 + wr * 64 + fr, col0 = u.c0 * HALF + wc * 32 + 8 * fq;
        typedef float f32x2v __attribute__((ext_vector_type(2)));
#pragma unroll
        for (int ai = 0; ai < 2; ++ai)
#pragma unroll
            for (int m = 0; m < 4; ++m) { unsigned char* rowp = ACT + (size_t)(row0 + ai * HALF + m * 16) * DFF + col0; f32x4 o[2];
#pragma unroll
                for (int n = 0; n < 2; ++n) { const f32x4 gv = acc[ai][0][m][n], lv = acc[ai][1][m][n];
#pragma unroll
                    for (int j = 0; j < 4; j += 2) {
                        const f32x2v g = {__builtin_amdgcn_fmed3f(gv[j], -3.0e38f, 7.0f), __builtin_amdgcn_fmed3f(gv[j + 1], -3.0e38f, 7.0f)}, l = {__builtin_amdgcn_fmed3f(lv[j], -6.0f, 8.0f), __builtin_amdgcn_fmed3f(lv[j + 1], -6.0f, 8.0f)};
                        const f32x2v t = g * -2.4554669595930156f; const f32x2v e = {__builtin_amdgcn_exp2f(t.x), __builtin_amdgcn_exp2f(t.y)}; const f32x2v d = e + 1.0f;
                        const f32x2v r = {__builtin_amdgcn_rcpf(d.x), __builtin_amdgcn_rcpf(d.y)}; const f32x2v q = (g * l) * r; o[n][j] = q.x; o[n][j + 1] = q.y; } }
                u32x2 w; w.x = pk4_fp8(o[0][0], o[0][1], o[0][2], o[0][3]); w.y = pk4_fp8(o[1][0], o[1][1], o[1][2], o[1][3]);
                *(u32x2*)rowp = w; }
    }
};
struct EpiDown {
    static constexpr bool PERM = true, KEEPS = false;
    const float* bdn; const int* rslot; const float* gate; unsigned char* SLOT;
    __device__ __forceinline__ void operator()(Acc& acc, const Unit& u, int wr, int wc, int fr, int fq) const {
        const int row0 = u.r0 + wr * 64 + fr, col0 = u.c0 * BM + wc * 32 + 8 * fq; const float* be = bdn + (size_t)u.x * D;
        int sl[2][4]; float gt[2][4];
#pragma unroll
        for (int ai = 0; ai < 2; ++ai)
#pragma unroll
            for (int m = 0; m < 4; ++m) sl[ai][m] = rslot[row0 + ai * HALF + m * 16];
#pragma unroll
        for (int ai = 0; ai < 2; ++ai)
#pragma unroll
            for (int m = 0; m < 4; ++m) gt[ai][m] = gate[sl[ai][m] < 0 ? 0 : sl[ai][m]] * 16.0f;
        f32x4 bv[2][2];
#pragma unroll
        for (int bj = 0; bj < 2; ++bj)
#pragma unroll
            for (int n = 0; n < 2; ++n) bv[bj][n] = *(const f32x4*)(be + col0 + bj * HALF + 4 * n);
#pragma unroll
        for (int ai = 0; ai < 2; ++ai)
#pragma unroll
            for (int m = 0; m < 4; ++m) {
                if (sl[ai][m] >= 0) { const float g = gt[ai][m]; unsigned char* rowp = SLOT + (size_t)sl[ai][m] * D + col0;
#pragma unroll
                    for (int bj = 0; bj < 2; ++bj) { const f32x4 v0 = (acc[ai][bj][m][0] + bv[bj][0]) * g, v1 = (acc[ai][bj][m][1] + bv[bj][1]) * g;
                        u32x2 w; w.x = pk4_fp8(v0[0], v0[1], v0[2], v0[3]); w.y = pk4_fp8(v1[0], v1[1], v1[2], v1[3]);
                        *(u32x2*)(rowp + bj * HALF) = w; } } }
    }
};
}

struct Frame {
    LAS unsigned char* lds;
    int tid, lane, wave, vcu, G;
};

__device__ __forceinline__ void cvt_item_addr(const float* W, int K, int N, bf16_t* WT, int row_off, int item, int lane, const float*& src, bf16_t*& dst) {
    const int nblk = N >> 5, kb = item / nblk, nb = item - kb * nblk, kl = lane >> 3, nl = lane & 7;
    src = W + (size_t)(64 * kb + 8 * kl) * N + 32 * nb + 4 * nl; dst = WT + (size_t)(row_off + 32 * nb + 4 * nl) * K + 64 * kb + 8 * kl;
}
__device__ __forceinline__ void cvt_store(const f32x4 (&v)[8], bf16_t* dst, int K) {
#pragma unroll
    for (int i = 0; i < 4; ++i) { u32x4 o; o.x = cvt_pk_bf16(v[0][i], v[1][i]); o.y = cvt_pk_bf16(v[2][i], v[3][i]); o.z = cvt_pk_bf16(v[4][i], v[5][i]); o.w = cvt_pk_bf16(v[6][i], v[7][i]);
        *(u32x4*)(dst + (size_t)i * K) = o; }
}
__device__ __forceinline__ void cvt_store8(const f32x4 (&v)[8], unsigned char* dst, int K) {
#pragma unroll
    for (int i = 0; i < 4; ++i) { u32x2 o; o.x = pk4_fp8(v[0][i] * 64.f, v[1][i] * 64.f, v[2][i] * 64.f, v[3][i] * 64.f); o.y = pk4_fp8(v[4][i] * 64.f, v[5][i] * 64.f, v[6][i] * 64.f, v[7][i] * 64.f);
        __builtin_nontemporal_store(o, (u32x2*)(dst + (size_t)i * K)); }
}
__device__ __forceinline__ void cvt_range(const float* W, int K, int N, bf16_t* WT, int row_off, int i0, int cnt, int r, int nw, int lane) {
    int it = i0 + r; const int end = i0 + cnt;
    for (; it + nw < end; it += 2 * nw) {
        const float* s0; bf16_t* d0; const float* s1; bf16_t* d1;
        cvt_item_addr(W, K, N, WT, row_off, it, lane, s0, d0); cvt_item_addr(W, K, N, WT, row_off, it + nw, lane, s1, d1);
        f32x4 a[8], b[8];
#pragma unroll
        for (int j = 0; j < 8; ++j) a[j] = __builtin_nontemporal_load((const f32x4*)(s0 + (size_t)j * N));
#pragma unroll
        for (int j = 0; j < 8; ++j) b[j] = __builtin_nontemporal_load((const f32x4*)(s1 + (size_t)j * N));
        cvt_store(a, d0, K); cvt_store(b, d1, K);
    }
    if (it < end) { const float* s0; bf16_t* d0; cvt_item_addr(W, K, N, WT, row_off, it, lane, s0, d0); f32x4 a[8];
#pragma unroll
        for (int j = 0; j < 8; ++j) a[j] = __builtin_nontemporal_load((const f32x4*)(s0 + (size_t)j * N));
        cvt_store(a, d0, K); }
}
constexpr int CV_UP = NE * (D / 64) * (2 * DFF / 32), CV_DN = NE * (DFF / 64) * (D / 32), CV_ALL = CV_UP + CV_DN;
struct MoeW { const float* w_up; const float* w_down; unsigned char* WUPT; unsigned char* WDNT; };
__device__ __forceinline__ void cvt_moe_addr(const MoeW& mw, int chunk, int w, int h, int lane, const float*& src, unsigned char*& dst, int& N) {
    const int kl = lane >> 3, nl = lane & 7;
    if (chunk < CV_UP / 64) { const int e = chunk >> 6, cc = chunk & 63, kb = 8 * (cc >> 4) + w, nb = 8 * (cc & 15) + h; N = 2 * DFF;
        src = mw.w_up + (size_t)e * D * 2 * DFF + (size_t)(64 * kb + 8 * kl) * (2 * DFF) + 32 * nb + 4 * nl; dst = mw.WUPT + (size_t)e * 2 * DFF * D + (size_t)(32 * nb + 4 * nl) * D + 64 * kb + 8 * kl; }
    else { const int q = chunk - CV_UP / 64, e = q >> 5, cc = q & 31, kb = 8 * (cc >> 3) + w, nb = 8 * (cc & 7) + h; N = D;
        src = mw.w_down + (size_t)e * DFF * D + (size_t)(64 * kb + 8 * kl) * D + 32 * nb + 4 * nl; dst = mw.WDNT + (size_t)e * D * DFF + (size_t)(32 * nb + 4 * nl) * DFF + 64 * kb + 8 * kl; }
}
__device__ __forceinline__ f32x4 ld_nt(const float* p) { return __builtin_nontemporal_load((const f32x4*)p); }
constexpr int CV_WG = 64;
__device__ __forceinline__ int cvt_claim(unsigned* cursor, int cap, unsigned* done, unsigned need) {
    if (done && __hip_atomic_load(done, __ATOMIC_RELAXED, __HIP_MEMORY_SCOPE_AGENT) >= need) return CV_ALL;
    if ((int)__hip_atomic_load(cursor, __ATOMIC_RELAXED, __HIP_MEMORY_SCOPE_AGENT) >= cap) return CV_ALL;
    return (int)__hip_atomic_fetch_add(cursor, (unsigned)CV_WG, __ATOMIC_RELAXED, __HIP_MEMORY_SCOPE_AGENT);
}
__device__ __forceinline__ void cvt_pull(const MoeW& mw, unsigned* cursor, int cap, unsigned* done, unsigned need, volatile LAS int* slot, int tid, int wave, int lane) {
    __syncthreads();
    if (tid == 0) *slot = cvt_claim(cursor, cap, done, need);
    __syncthreads();
    int base = __builtin_amdgcn_readfirstlane(*slot);
    while (base < CV_ALL) {
        int nb = CV_ALL; if (tid == 0) nb = cvt_claim(cursor, cap, done, need);
        const int chunk = base >> 6;
        if (chunk < CV_UP / 64) {
            const int e = chunk >> 6, cc = chunk & 63, nb = 8 * (cc & 15) + wave, kl = lane >> 3, nl = lane & 7;
#pragma unroll 1
            for (int q = 0; q < 2; ++q) { const int kq = 2 * (cc >> 4) + q, kb32 = 8 * kq + kl;
                const float* src = mw.w_up + (size_t)e * D * 2 * DFF + (size_t)(32 * kb32) * (2 * DFF) + 32 * nb + 4 * nl;
                f32x4 a[32];
#pragma unroll
                for (int j = 0; j < 32; ++j) a[j] = ld_nt(src + (size_t)j * (2 * DFF));
                unsigned char* dst = mw.WUPT + (size_t)e * 2 * DFF * D + (size_t)(32 * nb + 4 * nl) * D + 128 * (kb32 >> 2) + 16 * (kb32 & 3);
#pragma unroll
                for (int i = 0; i < 4; ++i) { f32x16 lo, hi;
#pragma unroll
                    for (int j = 0; j < 16; ++j) { lo[j] = a[j][i] * 64.f; hi[j] = a[16 + j][i] * 64.f; }
                    { const v6i32 b6 = pk32_fp6(lo, hi); unsigned char* pp = dst + (size_t)i * D; __builtin_nontemporal_store((u32x4){(unsigned)b6[0], (unsigned)b6[1], (unsigned)b6[2], (unsigned)b6[3]}, (u32x4*)pp); __builtin_nontemporal_store((u32x4){(unsigned)b6[4], (unsigned)b6[5], 0u, 0u}, (u32x4*)(pp + 64)); } } }
        } else
#pragma unroll
        for (int h = 0; h < 8; h += 4) {
            const float* s0; unsigned char* d0; const float* s1; unsigned char* d1; const float* s2; unsigned char* d2; const float* s3; unsigned char* d3; int N0, N1, N2, N3;
            cvt_moe_addr(mw, chunk, wave, h, lane, s0, d0, N0); cvt_moe_addr(mw, chunk, wave, h + 1, lane, s1, d1, N1); cvt_moe_addr(mw, chunk, wave, h + 2, lane, s2, d2, N2); cvt_moe_addr(mw, chunk, wave, h + 3, lane, s3, d3, N3);
            f32x4 a[8], b[8], c[8], d[8];
#pragma unroll
            for (int j = 0; j < 8; ++j) a[j] = ld_nt(s0 + (size_t)j * N0);
#pragma unroll
            for (int j = 0; j < 8; ++j) b[j] = ld_nt(s1 + (size_t)j * N1);
#pragma unroll
            for (int j = 0; j < 8; ++j) c[j] = ld_nt(s2 + (size_t)j * N2);
#pragma unroll
            for (int j = 0; j < 8; ++j) d[j] = ld_nt(s3 + (size_t)j * N3);
            cvt_store8(a, d0, D); cvt_store8(b, d1, D); cvt_store8(c, d2, D); cvt_store8(d, d3, D);
        }
        __syncthreads();
        if (tid == 0) *slot = nb;
        __syncthreads();
        base = __builtin_amdgcn_readfirstlane(*slot);
    }
}
template <bool NT = false>
__device__ __forceinline__ void rms_row_to_bf16(const float* xrow, const float* gvec, bf16_t* orow, int lane) {
    const f32x4* xr = (const f32x4*)xrow + lane; const f32x4* gr = (const f32x4*)gvec + lane; f32x4 v[8], g[8]; float s = 0.f;
#pragma unroll
    for (int j = 0; j < 8; ++j) { v[j] = NT ? __builtin_nontemporal_load(xr + 64 * j) : xr[64 * j]; g[j] = gr[64 * j]; }
#pragma unroll
    for (int j = 0; j < 8; ++j) s += (v[j].x * v[j].x + v[j].y * v[j].y) + (v[j].z * v[j].z + v[j].w * v[j].w);
    const float rstd = 1.0f / sqrtf(wave_sum(s) * (1.0f / D) + RMS_EPS);
    u32x2* o8 = (u32x2*)orow + lane;
#pragma unroll
    for (int j = 0; j < 8; ++j) { const f32x4 y = v[j] * rstd * g[j]; u32x2 w; w.x = cvt_pk_bf16(y.x, y.y); w.y = cvt_pk_bf16(y.z, y.w); o8[64 * j] = w; }
}

__device__ __forceinline__ unsigned voff_b(unsigned row, unsigned ch) { return 256u * row + 16u * (ch ^ (((row & 3u) << 2) | ((row >> 2) & 3u))); }
__device__ __forceinline__ s16x4 vtr(const LAS unsigned char* p) { return __builtin_bit_cast(s16x4, __builtin_amdgcn_ds_read_tr16_b64_v4i16((LAS s16x4*)p)); }

__device__ __forceinline__ void sb_wg_unit(const bf16_t* PG, bf16_t* OA, int h, int qb, LAS unsigned char* lds, volatile LAS int* flags, int tid, int wave, int lane) {
    const int fr = lane & 15, fq = lane >> 4, q0w = qb * 128 + wave * 16, qi = q0w + fr;
    bf16x8 Qf[4];
    { const bf16_t* qp = PG + (size_t)qi * NP1 + h * HD + 8 * fq;
#pragma unroll
      for (int ks = 0; ks < 4; ++ks) Qf[ks] = *(const bf16x8*)(qp + 32 * ks); }
    f32x4 O[8];
#pragma unroll
    for (int db = 0; db < 8; ++db) O[db] = (f32x4){0.f, 0.f, 0.f, 0.f};
    float carry = 0.f; bool sat = false;
    const float scale = 0.08838834764831845f;
    const unsigned p = fr & 3, qq = fr >> 2;
    const int jt_hi = 2 * qb + 1, jt_w = q0w >> 6;
    const int srow = tid >> 4, sch = tid & 15;
    const bf16_t* kg = PG + (size_t)srow * NP1 + SBW + h * HD + 8 * sch;
    u32x4 kr[2], vr[2];
    __syncthreads();
    if (tid < 8) flags[tid] = 0;
    { const bf16_t* g = kg + (size_t)(jt_hi * 64) * NP1;
#pragma unroll
      for (int i = 0; i < 2; ++i) { kr[i] = *(const u32x4*)(g + (size_t)(32 * i) * NP1); vr[i] = *(const u32x4*)(g + (size_t)(32 * i) * NP1 + SBW); } }
    for (int jt = jt_hi, it = 0; jt >= 0; --jt, ++it) {
        LAS unsigned char* kb = lds + (it & 1) * 32768; LAS unsigned char* vb = kb + 16384;
#pragma unroll
        for (int i = 0; i < 2; ++i) { *(LAS u32x4*)(kb + voff_b(srow + 32 * i, sch)) = kr[i]; *(LAS u32x4*)(vb + voff_b(srow + 32 * i, sch)) = vr[i]; }
        __syncthreads();
        { int ns = 0;
#pragma unroll
          for (int w = 0; w < 8; ++w) ns += flags[w];
          if (__builtin_amdgcn_readfirstlane(ns) == 8) break; }
        if (jt > 0) { const bf16_t* g = kg + (size_t)((jt - 1) * 64) * NP1;
#pragma unroll
            for (int i = 0; i < 2; ++i) { kr[i] = *(const u32x4*)(g + (size_t)(32 * i) * NP1); vr[i] = *(const u32x4*)(g + (size_t)(32 * i) * NP1 + SBW); } }
        if (!sat && jt <= jt_w) {
            const int key0 = jt * 64;
            f32x4 z[4];
#pragma unroll
            for (int sb = 0; sb < 4; ++sb) { z[sb] = (f32x4){0.f, 0.f, 0.f, 0.f};
#pragma unroll
                for (int ks = 0; ks < 4; ++ks) { const bf16x8 kf = *(const LAS bf16x8*)(kb + voff_b(16 * sb + fr, 4 * ks + fq)); z[sb] = __builtin_amdgcn_mfma_f32_16x16x32_bf16(kf, Qf[ks], z[sb], 0, 0, 0); } }
            float sfx[4][4], g[4], lex[4], T[4];
            const bool diag = key0 + 64 > q0w;
#pragma unroll
            for (int sb = 0; sb < 4; ++sb) {
                float sp[4];
#pragma unroll
                for (int i = 0; i < 4; ++i) { const float y = z[sb][i] * (scale * 1.4426950408889634f); z[sb][i] = y;
                    sp[i] = fmaxf(y, 0.f) + __builtin_amdgcn_logf(1.0f + __builtin_amdgcn_exp2f(-fabsf(y))); }
                if (diag) {
#pragma unroll
                    for (int i = 0; i < 4; ++i) { const int key = key0 + 16 * sb + 4 * fq + i; sp[i] = (key < qi) ? sp[i] : 0.f; } }
                sfx[sb][3] = sp[3]; sfx[sb][2] = sp[2] + sfx[sb][3]; sfx[sb][1] = sp[1] + sfx[sb][2]; sfx[sb][0] = sp[0] + sfx[sb][1]; g[sb] = sfx[sb][0];
            }
#pragma unroll
            for (int sb = 0; sb < 4; ++sb) { const float x1 = __shfl_xor(g[sb], 16), x2 = __shfl_xor(g[sb], 32), x3 = __shfl_xor(g[sb], 48);
                T[sb] = (g[sb] + x1) + (x2 + x3); lex[sb] = ((fq & 1) ? 0.f : x1) + ((fq < 2) ? (x2 + x3) : 0.f); }
            float run = carry; bf16x8 Wf[2]; unsigned wpk[8];
#pragma unroll
            for (int sb = 3; sb >= 0; --sb) { const float base = run + lex[sb]; float w[4];
#pragma unroll
                for (int i = 0; i < 4; ++i) w[i] = __builtin_amdgcn_exp2f(z[sb][i] - (base + sfx[sb][i]));
                if (diag) {
#pragma unroll
                    for (int i = 0; i < 4; ++i) { const int key = key0 + 16 * sb + 4 * fq + i; w[i] = (key < qi) ? w[i] : 0.f; } }
                wpk[2 * sb] = cvt_pk_bf16(w[0], w[1]); wpk[2 * sb + 1] = cvt_pk_bf16(w[2], w[3]); run += T[sb]; }
            carry = run;
            { u32x4 a = {wpk[0], wpk[1], wpk[2], wpk[3]}, b = {wpk[4], wpk[5], wpk[6], wpk[7]}; Wf[0] = __builtin_bit_cast(bf16x8, a); Wf[1] = __builtin_bit_cast(bf16x8, b); }
#pragma unroll
            for (int db = 0; db < 8; ++db)
#pragma unroll
                for (int m = 0; m < 2; ++m) { const unsigned r1 = 32 * m + 4 * fq + qq, r2 = r1 + 16;
                    const s16x4 lo = vtr(vb + voff_b(r1, 2 * db + (p >> 1)) + 8 * (p & 1)), hi = vtr(vb + voff_b(r2, 2 * db + (p >> 1)) + 8 * (p & 1));
                    const bf16x8 vf = {lo[0], lo[1], lo[2], lo[3], hi[0], hi[1], hi[2], hi[3]};
                    O[db] = __builtin_amdgcn_mfma_f32_16x16x32_bf16(vf, Wf[m], O[db], 0, 0, 0); }
            if (__all(carry > 150.1f)) { sat = true; if (lane == 0) flags[wave] = 1; }
        }
    }
    { bf16_t* op = OA + (size_t)qi * SBW + h * HD + 4 * fq;
#pragma unroll
      for (int db = 0; db < 8; ++db) { u32x2 w; w.x = cvt_pk_bf16(O[db][0], O[db][1]); w.y = cvt_pk_bf16(O[db][2], O[db][3]); *(u32x2*)(op + 16 * db) = w; } }
}

__device__ __forceinline__ void xa_unit(const bf16_t* QXA, const bf16_t* KVM, bf16_t* OXA, int h, int qb, const LAS unsigned char* vl, int lane) {
    const int fr = lane & 15, fq = lane >> 4, q0 = qb * 16, qi = q0 + fr;
    bf16x8 Qf[4];
    { const bf16_t* qp = QXA + (size_t)qi * XAW + h * HD + 8 * fq;
#pragma unroll
      for (int ks = 0; ks < 4; ++ks) Qf[ks] = *(const bf16x8*)(qp + 32 * ks); }
    f32x4 z[16];
    { const bf16_t* kp = KVM + (size_t)fr * (2 * XAW) + h * HD + 8 * fq;
#pragma unroll
      for (int sb = 0; sb < 16; ++sb) { z[sb] = (f32x4){0.f, 0.f, 0.f, 0.f};
#pragma unroll
          for (int ks = 0; ks < 4; ++ks) { const bf16x8 kf = *(const bf16x8*)(kp + (size_t)(16 * sb) * (2 * XAW) + 32 * ks); z[sb] = __builtin_amdgcn_mfma_f32_16x16x32_bf16(kf, Qf[ks], z[sb], 0, 0, 0); } } }
    const float scale = 0.08838834764831845f * 1.4426950408889634f;
    float mx = -3.0e38f;
#pragma unroll
    for (int sb = 0; sb < 16; ++sb)
#pragma unroll
        for (int i = 0; i < 4; ++i) { z[sb][i] *= scale; mx = fmaxf(mx, z[sb][i]); }
    mx = fmaxf(mx, __shfl_xor(mx, 16)); mx = fmaxf(mx, __shfl_xor(mx, 32));
    float sum = 0.f;
#pragma unroll
    for (int sb = 0; sb < 16; ++sb)
#pragma unroll
        for (int i = 0; i < 4; ++i) { const float e = __builtin_amdgcn_exp2f(z[sb][i] - mx); z[sb][i] = e; sum += e; }
    sum += __shfl_xor(sum, 16); sum += __shfl_xor(sum, 32);
    const float inv = 1.0f / sum;
    f32x4 O[8];
#pragma unroll
    for (int db = 0; db < 8; ++db) O[db] = (f32x4){0.f, 0.f, 0.f, 0.f};
    const unsigned p = fr & 3, qq = fr >> 2;
#pragma unroll
    for (int m = 0; m < 8; ++m) {
        u32x4 a = {cvt_pk_bf16(z[2 * m][0], z[2 * m][1]), cvt_pk_bf16(z[2 * m][2], z[2 * m][3]), cvt_pk_bf16(z[2 * m + 1][0], z[2 * m + 1][1]), cvt_pk_bf16(z[2 * m + 1][2], z[2 * m + 1][3])};
        const bf16x8 Wf = __builtin_bit_cast(bf16x8, a);
#pragma unroll
        for (int db = 0; db < 8; ++db) { const unsigned r1 = 32 * m + 4 * fq + qq, r2 = r1 + 16;
            const s16x4 lo = vtr(vl + voff_b(r1, 2 * db + (p >> 1)) + 8 * (p & 1)), hi = vtr(vl + voff_b(r2, 2 * db + (p >> 1)) + 8 * (p & 1));
            const bf16x8 vf = {lo[0], lo[1], lo[2], lo[3], hi[0], hi[1], hi[2], hi[3]};
            O[db] = __builtin_amdgcn_mfma_f32_16x16x32_bf16(vf, Wf, O[db], 0, 0, 0); }
    }
    { bf16_t* op = OXA + (size_t)qi * XAW + h * HD + 4 * fq;
#pragma unroll
      for (int db = 0; db < 8; ++db) { const f32x4 o = O[db] * inv; u32x2 w; w.x = cvt_pk_bf16(o[0], o[1]); w.y = cvt_pk_bf16(o[2], o[3]); *(u32x2*)(op + 16 * db) = w; } }
}

template <int W>
__device__ __forceinline__ void pool_run(const bf16_t* PG, bf16_t* PO, int t0, int ch) {
    constexpr int NR = W + 7;
    const bf16_t* pp = PG + (size_t)(t0 + 7) * NP1 + 3 * SBW + ch * 8;
    u32x4 v[NR];
#pragma unroll
    for (int k = 0; k < NR; ++k) v[k] = (t0 + 7 - k >= 0) ? *(const u32x4*)(pp - (size_t)k * NP1) : (u32x4){0u, 0u, 0u, 0u};
#pragma unroll
    for (int i = 0; i < 8; ++i) {
        float s[8];
#pragma unroll
        for (int j = 0; j < 8; ++j) s[j] = 0.f;
#pragma unroll
        for (int j = W - 1; j >= 0; --j) { const u32x4 x = v[7 - i + j];
            s[0] += bf_lo(x.x); s[1] += bf_hi(x.x); s[2] += bf_lo(x.y); s[3] += bf_hi(x.y); s[4] += bf_lo(x.z); s[5] += bf_hi(x.z); s[6] += bf_lo(x.w); s[7] += bf_hi(x.w); }
        const int t = t0 + i, n = (t + 1 < W) ? (t + 1) : W; const float inv = 1.0f / (float)n; const u32x4 me = v[7 - i]; u32x4 o;
        o.x = cvt_pk_bf16(s[0] * inv - bf_lo(me.x), s[1] * inv - bf_hi(me.x)); o.y = cvt_pk_bf16(s[2] * inv - bf_lo(me.y), s[3] * inv - bf_hi(me.y));
        o.z = cvt_pk_bf16(s[4] * inv - bf_lo(me.z), s[5] * inv - bf_hi(me.z)); o.w = cvt_pk_bf16(s[6] * inv - bf_lo(me.w), s[7] * inv - bf_hi(me.w));
        *(u32x4*)(PO + (size_t)t * POOLW + ch * 8) = o;
    }
}

constexpr int NPHASE = 15;
struct Args { const float* in[24]; float* out; unsigned char* ws; int ph_lo, ph_hi; };
static_assert(sizeof(Args) == 24 * 8 + 8 + 8 + 8, "Args has no padding");

__global__ void __launch_bounds__(NWAVES * 64, 2) moe_fwd(Args args) {
    extern __shared__ __attribute__((aligned(16))) unsigned char lds_raw[];
    Frame F;
    F.lds = (LAS unsigned char*)lds_raw;
    F.tid = threadIdx.x; F.lane = F.tid & 63; F.wave = __builtin_amdgcn_readfirstlane(F.tid >> 6);
    F.G = gridDim.x; { const int bx = blockIdx.x; F.vcu = (F.G % 8 == 0) ? (bx % 8) * (F.G / 8) + bx / 8 : bx; }
    unsigned char* ws = args.ws;
    unsigned* ctl = (unsigned*)(ws + WS_CTL);
    LAS unsigned char* lx = F.lds + LDS_X_OFF;
    for (int u = F.tid; u < (LDS_BYTES - LDS_X_OFF) / 4; u += NWAVES * 64) ((LAS unsigned*)lx)[u] = 0u;
    __syncthreads();
#if MK_ONE_LAUNCH
    XcdBarrier bar = xcd_barrier_post(ctl + CW_BAR, (volatile LAS unsigned*)(lx + LX_BAR));
#define GRID_BAR() xcd_barrier(bar)
#else
#define GRID_BAR() do {} while (0)
#endif
    const int lo = args.ph_lo, hi = args.ph_hi;
#ifndef PHASE_MASK
#define PHASE_MASK 0x7fff
#endif
#define IN(k) (((PHASE_MASK >> (k)) & 1) && lo <= (k) && (k) < hi)
#define SEAM(k) do { if (IN((k) + 1)) GRID_BAR(); } while (0)

    const float* x = args.in[0]; const float* mem = args.in[1]; const float* norm_mix = args.in[2]; const float* w_in = args.in[3]; const float* pool_lin = args.in[4];
    const float* pool_scale = args.in[5]; const float* w_branch_a = args.in[6]; const float* w_branch_b = args.in[7]; const float* w_gate = args.in[8]; const float* b_gate = args.in[9];
    const float* w_mix_out = args.in[10]; const float* xa_norm = args.in[11]; const float* mem_norm = args.in[12]; const float* xa_wq = args.in[13]; const float* xa_wkv = args.in[14];
    const float* xa_wo = args.in[15]; const float* moe_norm = args.in[16]; const float* w_router = args.in[17]; const float* b_router = args.in[18]; const float* w_up = args.in[19];
    const float* b_up = args.in[20]; const float* w_down = args.in[21]; const float* b_down = args.in[22]; const float* final_norm = args.in[23];
    bf16_t* W1T = (bf16_t*)(ws + WS_W1T); bf16_t* WAT = (bf16_t*)(ws + WS_WAT); bf16_t* WBT = (bf16_t*)(ws + WS_WBT); bf16_t* WMT = (bf16_t*)(ws + WS_WMT); bf16_t* PLT = (bf16_t*)(ws + WS_PLT);
    bf16_t* WQT = (bf16_t*)(ws + WS_WQT); bf16_t* WKVT = (bf16_t*)(ws + WS_WKVT); bf16_t* WOT = (bf16_t*)(ws + WS_WOT); unsigned char* WUPT = ws + WS_WUPT; unsigned char* WDNT = ws + WS_WDNT;
    bf16_t* U = (bf16_t*)(ws + WS_U); bf16_t* MEMN = (bf16_t*)(ws + WS_MEMN); bf16_t* PG = (bf16_t*)(ws + WS_PG); bf16_t* OA = (bf16_t*)(ws + WS_OA); bf16_t* PO = (bf16_t*)(ws + WS_PO);
    bf16_t* OB = (bf16_t*)(ws + WS_OB); float* TMP = (float*)(ws + WS_TMP); bf16_t* MG = (bf16_t*)(ws + WS_MG); float* H1 = (float*)(ws + WS_H1); bf16_t* U2 = (bf16_t*)(ws + WS_U2);
    bf16_t* QXA = (bf16_t*)(ws + WS_QXA); bf16_t* KVM = (bf16_t*)(ws + WS_KVM); bf16_t* OXA = (bf16_t*)(ws + WS_OXA); float* H2 = (float*)(ws + WS_H2); unsigned char* TB = ws + WS_TB;
    bf16_t* ROWS = (bf16_t*)(ws + WS_ROWS); unsigned char* ACT = ws + WS_ACT; unsigned char* SLOT = ws + WS_SLOT;
    int* ASGE = (int*)(ws + WS_ASGE); int* ASGP = (int*)(ws + WS_ASGP); float* GATE = (float*)(ws + WS_GATE); int* RSLOT = (int*)(ws + WS_RSLOT);
    int* CNT = (int*)(ctl + CW_CNT); bf16_t* WRT = (bf16_t*)(ws + WS_WRT);
    const int gw = F.vcu * NWAVES + F.wave, NGW = F.G * NWAVES;
    const MoeW mw{w_up, w_down, WUPT, WDNT};
    unsigned* CUR = ctl + CW_CUR; volatile LAS int* cvs = (volatile LAS int*)(lx + LX_CVS);
#define CVT_PULL(cap) cvt_pull(mw, CUR, (cap), nullptr, 0u, cvs, F.tid, F.wave, F.lane)
#define CVT_BESIDE(cap, ph, need) cvt_pull(mw, CUR, (cap), ctl + CW_DONE + 64 * (ph), (unsigned)(need), cvs, F.tid, F.wave, F.lane)
#define MARK_DONE(ph) do { if (F.tid == 0) __hip_atomic_fetch_add(ctl + CW_DONE + 64 * (ph), 1u, __ATOMIC_RELAXED, __HIP_MEMORY_SCOPE_AGENT); } while (0)

    if (IN(0)) {
        constexpr int I_IN = (D / 64) * (INW / 32), I_BR = (SBW / 64) * (D / 32), I_MX = (D / 64) * (D / 32), I_PL = (256 / 64) * (256 / 32);
        constexpr int I_Q = (D / 64) * (XAW / 32), I_KV = (D / 64) * (2 * XAW / 32), I_O = (XAW / 64) * (D / 32);
        cvt_range(w_in, D, INW, W1T, 0, 0, I_IN, gw, NGW, F.lane);
        cvt_range(w_gate, D, INW, W1T, INW, 0, I_IN, gw, NGW, F.lane);
        for (int m = gw; m < S; m += NGW) rms_row_to_bf16<true>(x + (size_t)m * D, norm_mix, U + (size_t)m * D, F.lane);
        for (int m = gw; m < MEM; m += NGW) rms_row_to_bf16(mem + (size_t)m * D, mem_norm, MEMN + (size_t)m * D, F.lane);
        for (int i = blockIdx.x * (NWAVES * 64) + F.tid; i < NE * D / 2; i += F.G * NWAVES * 64) {
            const int e = i >> 10, c = (i & 1023) * 2; const float a = w_router[(size_t)c * NE + e], b = w_router[(size_t)(c + 1) * NE + e];
            const unsigned hi = cvt_pk_bf16(a, b); const unsigned lo = cvt_pk_bf16(a - bf_lo(hi), b - bf_hi(hi));
            *(unsigned*)(WRT + (size_t)e * D + c) = hi; *(unsigned*)(WRT + (size_t)(NE + e) * D + c) = lo; }
        __syncthreads();
        SEAM(0);
    }

    if (IN(1)) {
        const int gc = (F.G == 256) ? GC_P1 : F.G;
        if ((int)blockIdx.x < gc) {
            pg8::DenseSched Sc{(const char*)U, (const char*)W1T, D, D, S / 256, NP1 / 256, gc, (int)blockIdx.x};
            pg8::EpiProj E{PG, b_gate};
            pg8::gemm_phase<pg8::EpiProj, pg8::DenseSched, true>(F.lds, D, D, D, Sc, E);
            MARK_DONE(1);
        }
        if ((int)blockIdx.x >= gc) {
            constexpr int I_BR = (SBW / 64) * (D / 32), I_MX = (D / 64) * (D / 32), I_PL = (256 / 64) * (256 / 32), I_Q = (D / 64) * (XAW / 32), I_KV = (D / 64) * (2 * XAW / 32), I_O = (XAW / 64) * (D / 32);
            const int cr = ((int)blockIdx.x - gc) * NWAVES + F.wave, cn = (F.G - gc) * NWAVES;
        cvt_range(w_branch_a, SBW, D, WAT, 0, 0, I_BR, cr, cn, F.lane);
        cvt_range(w_branch_b, POOLW, D, WBT, 0, 0, I_BR, cr, cn, F.lane);
        cvt_range(w_mix_out, D, D, WMT, 0, 0, I_MX, cr, cn, F.lane);
        for (int g = 0; g < 4; ++g) cvt_range(pool_lin + (size_t)g * 65536, 256, 256, PLT + (size_t)g * 65536, 0, 0, I_PL, cr, cn, F.lane);
        cvt_range(xa_wq, D, XAW, WQT, 0, 0, I_Q, cr, cn, F.lane);
        cvt_range(xa_wkv, D, 2 * XAW, WKVT, 0, 0, I_KV, cr, cn, F.lane);
        cvt_range(xa_wo, XAW, D, WOT, 0, 0, I_O, cr, cn, F.lane);
        }
        CVT_BESIDE(CV_UP, 1, gc);
        SEAM(1);
    }

    if (IN(2)) {
        for (int it = blockIdx.x * (NWAVES * 64) + F.tid; it < (S / 8) * (POOLW / 8); it += F.G * NWAVES * 64) {
            const int wv = it >> 6, g = wv & 3, rb = (wv >> 2) * 2 + (F.lane >> 5), ch = g * 32 + (F.lane & 31), t0 = rb * 8;
            if (g == 0) pool_run<2>(PG, PO, t0, ch); else if (g == 1) pool_run<4>(PG, PO, t0, ch); else if (g == 2) pool_run<8>(PG, PO, t0, ch); else pool_run<16>(PG, PO, t0, ch);
        }
        for (int it = F.vcu; it < SBH * (S / 128); it += F.G) { const int h = it & 7, qb = (S / 128 - 1) - (it >> 3); sb_wg_unit(PG, OA, h, qb, F.lds, (volatile LAS int*)(lx + LX_SBF), F.tid, F.wave, F.lane); }
        __syncthreads();
        SEAM(2);
    }

    if (IN(3)) {
        pg8::PoolSched Sc{(const char*)PO, (const char*)PLT, F.G, F.vcu};
        pg8::EpiBf16 E{OB, POOLW, pool_scale};
        pg8::gemm_phase<pg8::EpiBf16, pg8::PoolSched, true>(F.lds, 256, POOLW, 256, Sc, E);
        if (F.vcu < (S / 256) * 4) MARK_DONE(3);
        CVT_BESIDE(CV_UP, 3, (S / 256) * 4);
        SEAM(3);
    }

    if (IN(4)) {
        pg8::BranchSched Sc{(const char*)OA, (const char*)OB, (const char*)WAT, (const char*)WBT, SBW, SBW, S / 256, D / 256, F.G, (int)blockIdx.x};
        pg8::EpiBranch E{PG, MG};
        pg8::gemm_phase<pg8::EpiBranch, pg8::BranchSched, true>(F.lds, SBW, SBW, SBW, Sc, E);
        SEAM(4);
    }

    if (IN(5)) {
        pg8::DenseSched Sc{(const char*)MG, (const char*)WMT, D, D, S / 256, D / 256, F.G, (int)blockIdx.x};
        pg8::EpiResid E{x, H1, D};
        pg8::gemm_phase<pg8::EpiResid, pg8::DenseSched, true>(F.lds, D, D, D, Sc, E);
        SEAM(5);
    }

    if (IN(6)) {
        for (int m = gw; m < S; m += NGW) rms_row_to_bf16(H1 + (size_t)m * D, xa_norm, U2 + (size_t)m * D, F.lane);
        SEAM(6);
    }

    if (IN(7)) {
        { pg8::DenseSched Sc{(const char*)U2, (const char*)WQT, D, D, S / 256, XAW / 256, F.G, (int)blockIdx.x};
          pg8::EpiBf16 E{QXA, XAW, nullptr};
          pg8::gemm_phase<pg8::EpiBf16, pg8::DenseSched, true>(F.lds, D, D, D, Sc, E); }
        { const int c2 = ((int)blockIdx.x >= 64) ? (int)blockIdx.x - 64 : (int)blockIdx.x + F.G - 64;
          pg8::DenseSched Sc{(const char*)MEMN, (const char*)WKVT, D, D, MEM / 256, 2 * XAW / 256, F.G, c2};
          pg8::EpiBf16 E{KVM, 2 * XAW, nullptr};
          pg8::gemm_phase<pg8::EpiBf16, pg8::DenseSched, true>(F.lds, D, D, D, Sc, E); }
        if ((int)blockIdx.x < 68) MARK_DONE(7);
        CVT_BESIDE(CV_UP, 7, 68);
        SEAM(7);
    }

    if (IN(8)) {
        for (int it = F.vcu; it < XAH * (S / 128); it += F.G) {
            const int h = it & 3, qg = it >> 2;
            __syncthreads();
#pragma unroll
            for (int t = 0; t < 8; ++t) { const int c = t * 512 + F.tid, row = c >> 4, ch = c & 15;
                const u32x4 vv = *(const u32x4*)(KVM + (size_t)row * (2 * XAW) + XAW + h * HD + 8 * ch); *(LAS u32x4*)(F.lds + voff_b(row, ch)) = vv; }
            __syncthreads();
            xa_unit(QXA, KVM, OXA, h, qg * 8 + F.wave, F.lds, F.lane);
        }
        __syncthreads();
        SEAM(8);
    }

    if (IN(9)) {
        pg8::DenseSched Sc{(const char*)OXA, (const char*)WOT, XAW, XAW, S / 256, D / 256, F.G, (int)blockIdx.x};
        pg8::EpiResid E{H1, H2, D};
        pg8::gemm_phase<pg8::EpiResid, pg8::DenseSched, true>(F.lds, XAW, XAW, XAW, Sc, E);
        SEAM(9);
    }

    if (IN(10)) {
        for (int i = blockIdx.x * (NWAVES * 64) + F.tid; i < PROWS; i += F.G * NWAVES * 64) RSLOT[i] = -1;
        LAS unsigned char* thi = F.lds;
        LAS float* lg = (LAS float*)(lx + LX_LOG);
        LAS float* part = (LAS float*)(lx + LX_RPART);
        for (int rg = F.vcu; rg < S / 16; rg += F.G) {
            __syncthreads();
#pragma unroll
            for (int rr = 0; rr < 2; ++rr) { const int r = 2 * F.wave + rr, m = rg * 16 + r;
                const f32x4* xr = (const f32x4*)(H2 + (size_t)m * D) + F.lane; f32x4 v[8]; float s = 0.f;
#pragma unroll
                for (int j = 0; j < 8; ++j) { v[j] = xr[64 * j]; s += (v[j].x * v[j].x + v[j].y * v[j].y) + (v[j].z * v[j].z + v[j].w * v[j].w); }
                const float rstd = 1.0f / sqrtf(wave_sum(s) * (1.0f / D) + RMS_EPS);
                const f32x4* gr = (const f32x4*)moe_norm + F.lane; f32x4 gv[8];
#pragma unroll
                for (int j = 0; j < 8; ++j) gv[j] = gr[64 * j];
#pragma unroll
                for (int j = 0; j < 8; ++j) { const f32x4 g = gv[j]; const f32x4 y = v[j] * rstd * g; u32x2 w; w.x = cvt_pk_bf16(y.x, y.y); w.y = cvt_pk_bf16(y.z, y.w);
                    u32x2 l; l.x = cvt_pk_bf16(y.x - bf_lo(w.x), y.y - bf_hi(w.x)); l.y = cvt_pk_bf16(y.z - bf_lo(w.y), y.w - bf_hi(w.y));
                    const unsigned off = (unsigned)r * 4096u + ((((unsigned)F.lane >> 1) + 32u * j) ^ (unsigned)r) * 16u + (F.lane & 1) * 8u;
                    *(LAS u32x2*)(thi + off) = w; *(LAS u32x2*)(thi + 65536 + off) = l; } }
            __syncthreads();
#pragma unroll
            for (int q = 0; q < 2; ++q) { const int blk = F.tid + 512 * q, r = blk >> 6, kb32 = blk & 63; f32x16 lo, hi;
#pragma unroll
                for (int c4 = 0; c4 < 4; ++c4) { const u32x4 v = *(const LAS u32x4*)(thi + r * 4096 + ((unsigned)((4 * kb32 + c4) ^ r) * 16u));
                    const float f[8] = {bf_lo(v.x), bf_hi(v.x), bf_lo(v.y), bf_hi(v.y), bf_lo(v.z), bf_hi(v.z), bf_lo(v.w), bf_hi(v.w)};
#pragma unroll
                    for (int j = 0; j < 8; ++j) { if (c4 < 2) lo[8 * c4 + j] = f[j] * 2.0f; else hi[8 * (c4 - 2) + j] = f[j] * 2.0f; } }
                st_fp6_block(TB + (size_t)(rg * 16 + r) * D + 128 * (kb32 >> 2) + 16 * (kb32 & 3), pk32_fp6(lo, hi)); }
            { const int fr = F.lane & 15, fq = F.lane >> 4; f32x4 c0 = {0.f, 0.f, 0.f, 0.f}, c1 = {0.f, 0.f, 0.f, 0.f};
              const bf16_t* wh = WRT + (size_t)fr * D + 256 * F.wave + 8 * fq;
#pragma unroll
              for (int st = 0; st < 8; ++st) { const unsigned ch = (unsigned)(32 * F.wave + 4 * st + fq);
                  const bf16x8 ah = *(const LAS bf16x8*)(thi + fr * 4096 + ((ch ^ (unsigned)fr) * 16u)), al = *(const LAS bf16x8*)(thi + 65536 + fr * 4096 + ((ch ^ (unsigned)fr) * 16u));
                  const bf16x8 bh0 = *(const bf16x8*)(wh + 32 * st), bh1 = *(const bf16x8*)(wh + (size_t)16 * D + 32 * st), bl0 = *(const bf16x8*)(wh + (size_t)NE * D + 32 * st), bl1 = *(const bf16x8*)(wh + (size_t)(NE + 16) * D + 32 * st);
                  c0 = __builtin_amdgcn_mfma_f32_16x16x32_bf16(ah, bh0, c0, 0, 0, 0); c1 = __builtin_amdgcn_mfma_f32_16x16x32_bf16(ah, bh1, c1, 0, 0, 0);
                  c0 = __builtin_amdgcn_mfma_f32_16x16x32_bf16(ah, bl0, c0, 0, 0, 0); c1 = __builtin_amdgcn_mfma_f32_16x16x32_bf16(ah, bl1, c1, 0, 0, 0);
                  c0 = __builtin_amdgcn_mfma_f32_16x16x32_bf16(al, bh0, c0, 0, 0, 0); c1 = __builtin_amdgcn_mfma_f32_16x16x32_bf16(al, bh1, c1, 0, 0, 0); }
#pragma unroll
              for (int i = 0; i < 4; ++i) { part[(F.wave * 16 + 4 * fq + i) * 32 + fr] = c0[i]; part[(F.wave * 16 + 4 * fq + i) * 32 + 16 + fr] = c1[i]; } }
            __syncthreads();
            { const int r = F.tid >> 5, e = F.tid & 31; float a = 0.f;
#pragma unroll
              for (int w = 0; w < 8; ++w) a += part[(w * 16 + r) * 32 + e];
              lg[r * 32 + e] = a + b_router[e]; }
            __syncthreads();
            if (F.tid < 16) { const int r = F.tid, m = rg * 16 + r; float l[32];
#pragma unroll
                for (int e = 0; e < 32; ++e) l[e] = lg[r * 32 + e];
                int idx[4]; float val[4]; unsigned taken = 0u;
#pragma unroll
                for (int k = 0; k < 4; ++k) { float best = -3.4e38f; int bi = 0;
#pragma unroll
                    for (int e = 0; e < 32; ++e) { const bool ok = !((taken >> e) & 1u) && (l[e] > best); best = ok ? l[e] : best; bi = ok ? e : bi; }
                    idx[k] = bi; val[k] = best; taken |= 1u << bi; }
                const float e0 = 1.0f, e1 = expf(val[1] - val[0]), e2 = expf(val[2] - val[0]), e3 = expf(val[3] - val[0]); const float inv = 1.0f / (((e0 + e1) + e2) + e3);
                const float gk[4] = {e0 * inv, e1 * inv, e2 * inv, e3 * inv};
#pragma unroll
                for (int k = 0; k < 4; ++k) { const int pos = atomicAdd(CNT + idx[k], 1); ASGE[m * 4 + k] = idx[k]; ASGP[m * 4 + k] = pos; GATE[m * 4 + k] = gk[k]; } }
        }
        __syncthreads();
        SEAM(10);
    }

    LAS int* tab = (LAS int*)(lx + LX_TAB);
#define BUILD_TAB(NT) do { __syncthreads(); if (F.tid == 0) { int us = 0, ps = 0; for (int e = 0; e < NE; ++e) { const int c = CNT[e], nb = (c + EBLK - 1) / EBLK; tab[e] = us; tab[33 + e] = ps; tab[66 + e] = nb > 0 ? nb : 1; us += nb * (NT); ps += nb * EBLK; } tab[32] = us; tab[65] = ps; } __syncthreads(); } while (0)

    if (IN(11)) {
        BUILD_TAB(1);
        for (int s = blockIdx.x * (NWAVES * 64) + F.tid; s < NK; s += F.G * NWAVES * 64) { const int e = ASGE[s], pos = ASGP[s]; RSLOT[tab[33 + e] + pos] = s; }
        CVT_PULL(CV_UP);
        SEAM(11);
    }

    if (IN(12)) {
        BUILD_TAB(16);
        const int gc = (F.G == 256) ? GC_P12 : F.G; const int bx = (int)blockIdx.x;
        if ((bx >> 3) < (gc >> 3) || F.G != 256) {
            pg8::MoeSched Sc{(const char*)TB, (const char*)WUPT, 16, (size_t)2 * DFF * D, (size_t)128 * D, (size_t)DFF * D, tab, gc, (F.G == 256) ? (bx & 7) * (gc >> 3) + (bx >> 3) : F.vcu, true, (size_t)D};
            pg8::EpiUp E{b_up, ACT};
            LAS int* gtab = (LAS int*)(lx + LX_RPART);
            { int slv[8]; bool okv[8];
#pragma unroll
              for (int k = 0; k < 8; ++k) { pg8::Unit uu; okv[k] = Sc.next(2 * k + (F.tid >> 8), uu); slv[k] = RSLOT[(okv[k] ? uu.r0 : 0) + (F.tid & 255)]; }
#pragma unroll
              for (int k = 0; k < 8; ++k) if (okv[k]) gtab[(2 * k + (F.tid >> 8)) * 256 + (F.tid & 255)] = (slv[k] < 0 ? 0 : slv[k]) >> 2; }
            __syncthreads();
            pg8::gemm_phase_db6<pg8::EpiUp, pg8::MoeSched>(F.lds, D / 2, D / 2, D / 2, Sc, E, gtab);
            MARK_DONE(12);
        }
        CVT_BESIDE(CV_ALL, 12, gc);
        CVT_PULL(CV_ALL);
        SEAM(12);
    }

    if (IN(13)) {
        BUILD_TAB(8);
        pg8::MoeSched Sc{(const char*)ACT, (const char*)WDNT, 8, (size_t)D * DFF, (size_t)256 * DFF, (size_t)128 * DFF, tab, F.G, F.vcu, false, (size_t)DFF};
        pg8::EpiDown E{b_down, RSLOT, GATE, SLOT};
        pg8::gemm_phase<pg8::EpiDown, pg8::MoeSched, true, false, 1>(F.lds, DFF / 2, DFF / 2, DFF / 2, Sc, E);
        SEAM(13);
    }

    if (IN(14)) {
        for (int m = gw; m < S; m += NGW) {
            const f32x4* xr = (const f32x4*)(H2 + (size_t)m * D) + F.lane; f32x4 v[8]; float s = 0.f;
#pragma unroll
            for (int j = 0; j < 8; ++j) { v[j] = __builtin_nontemporal_load(xr + 64 * j);
#pragma unroll
                for (int k = 0; k < 4; ++k) { const int w = (int)*((const unsigned*)(SLOT + (size_t)(m * 4 + k) * D) + F.lane + 64 * j); const f32x2 lo = __builtin_amdgcn_cvt_pk_f32_fp8(w, false), hi = __builtin_amdgcn_cvt_pk_f32_fp8(w, true);
                    v[j].x += lo.x * 0.0625f; v[j].y += lo.y * 0.0625f; v[j].z += hi.x * 0.0625f; v[j].w += hi.y * 0.0625f; }
                s += (v[j].x * v[j].x + v[j].y * v[j].y) + (v[j].z * v[j].z + v[j].w * v[j].w); }
            const float rstd = 1.0f / sqrtf(wave_sum(s) * (1.0f / D) + RMS_EPS);
            const f32x4* gr = (const f32x4*)final_norm + F.lane; f32x4* o = (f32x4*)(args.out + (size_t)m * D) + F.lane; f32x4 gv[8];
#pragma unroll
            for (int j = 0; j < 8; ++j) gv[j] = gr[64 * j];
#pragma unroll
            for (int j = 0; j < 8; ++j) o[64 * j] = v[j] * rstd * gv[j];
        }
    }
#undef IN
#undef SEAM
}

extern "C" void kernel_launch(void* const* d_in, const int* in_sizes, int n_in, void* d_out, int out_size, void* d_ws, size_t ws_size, hipStream_t stream) {
    static int grid = 0;
    if (grid == 0) {
        if (n_in != 24 || out_size != S * D || ws_size < WS_END) { fprintf(stderr, "kernel_launch: unexpected shapes (n_in %d out %d ws %zu need %zu)\n", n_in, out_size, ws_size, (size_t)WS_END); grid = -1; return; }
        int dev = 0, cus = 0, per_cu = 0;
        if (hipGetDevice(&dev) != hipSuccess || hipDeviceGetAttribute(&cus, hipDeviceAttributeMultiprocessorCount, dev) != hipSuccess) { grid = -1; return; }
        if (hipFuncSetAttribute((const void*)moe_fwd, hipFuncAttributeMaxDynamicSharedMemorySize, LDS_BYTES) != hipSuccess) { fprintf(stderr, "kernel_launch: hipFuncSetAttribute failed\n"); grid = -1; return; }
        if (hipOccupancyMaxActiveBlocksPerMultiprocessor(&per_cu, (const void*)moe_fwd, NWAVES * 64, LDS_BYTES) != hipSuccess || per_cu < 1) { fprintf(stderr, "kernel_launch: occupancy query says %d\n", per_cu); per_cu = 1; }
        (void)hipGetLastError();
        grid = cus;
    }
    if (grid < 0) return;
    (void)hipMemsetAsync((char*)d_ws + WS_CTL, 0, CTL_ZERO_BYTES, stream);
    Args a{};
    for (int i = 0; i < 24; ++i) a.in[i] = (const float*)d_in[i];
    a.out = (float*)d_out; a.ws = (unsigned char*)d_ws;
#if MK_ONE_LAUNCH
    a.ph_lo = 0; a.ph_hi = NPHASE;
    hipLaunchKernelGGL(moe_fwd, dim3(grid), dim3(NWAVES * 64), LDS_BYTES, stream, a);
#else
    for (int p = 0; p < NPHASE; ++p) { a.ph_lo = p; a.ph_hi = p + 1; for (int rep = 0; rep < (((REPEAT_MASK >> p) & 1) ? 2 : 1); ++rep) hipLaunchKernelGGL(moe_fwd, dim3(grid), dim3(NWAVES * 64), LDS_BYTES, stream, a); }
#endif
}
```

```cpp
#include <hip/hip_runtime.h>
#include <cstdio>
#include <cstdint>

#ifndef MK_ONE_LAUNCH
#define MK_ONE_LAUNCH 1
#endif
#ifndef REPEAT_MASK
#define REPEAT_MASK 0
#endif
#define GC_P1 160
#define GC_P12 224

#define LAS __attribute__((address_space(3)))
#define GAS __attribute__((address_space(1)))
typedef unsigned short bf16_t;
typedef short bf16x8 __attribute__((ext_vector_type(8)));
typedef short s16x4 __attribute__((ext_vector_type(4)));
typedef float f32x4 __attribute__((ext_vector_type(4)));
typedef float f32x2 __attribute__((ext_vector_type(2)));
typedef unsigned u32x4 __attribute__((ext_vector_type(4)));
typedef unsigned u32x2 __attribute__((ext_vector_type(2)));
typedef int v8i32 __attribute__((ext_vector_type(8)));
typedef int v6i32 __attribute__((ext_vector_type(6)));
typedef unsigned u32x3 __attribute__((ext_vector_type(3)));
typedef float f32x16 __attribute__((ext_vector_type(16)));

constexpr int S = 8192, D = 2048, MEM = 256;
constexpr int SBH = 8, HD = 128, SBW = 1024, POOLW = 1024, INW = 4096, NP1 = 8192;
constexpr int XAH = 4, XAW = 512;
constexpr int NE = 32, TOPK = 4, DFF = 2048, NK = S * TOPK, EBLK = 256, MAXBLK = NK / EBLK + NE, PROWS = MAXBLK * EBLK;
constexpr float RMS_EPS = 1e-5f;

constexpr size_t MiB = 1u << 20;
constexpr size_t WS_CTL = 0, CTL_ZERO_BYTES = 1 * MiB;
constexpr size_t WS_W1T = 2 * MiB;
constexpr size_t WS_WAT = WS_W1T + 32 * MiB;
constexpr size_t WS_WBT = WS_WAT + 4 * MiB;
constexpr size_t WS_WMT = WS_WBT + 4 * MiB;
constexpr size_t WS_PLT = WS_WMT + 8 * MiB;
constexpr size_t WS_WQT = WS_PLT + 1 * MiB;
constexpr size_t WS_WKVT = WS_WQT + 2 * MiB;
constexpr size_t WS_WOT = WS_WKVT + 4 * MiB;
constexpr size_t WS_WUPT = WS_WOT + 2 * MiB;
constexpr size_t WS_WDNT = WS_WUPT + 512 * MiB;
constexpr size_t WS_U = WS_WDNT + 256 * MiB;
constexpr size_t WS_MEMN = WS_U + 32 * MiB;
constexpr size_t WS_PG = WS_MEMN + 1 * MiB;
constexpr size_t WS_OA = WS_PG + 128 * MiB;
constexpr size_t WS_PO = WS_OA + 16 * MiB;
constexpr size_t WS_OB = WS_PO + 16 * MiB;
constexpr size_t WS_TMP = WS_OB + 16 * MiB;
constexpr size_t WS_MG = WS_TMP + 64 * MiB;
constexpr size_t WS_H1 = WS_MG + 32 * MiB;
constexpr size_t WS_U2 = WS_H1 + 64 * MiB;
constexpr size_t WS_QXA = WS_U2 + 32 * MiB;
constexpr size_t WS_KVM = WS_QXA + 8 * MiB;
constexpr size_t WS_OXA = WS_KVM + 1 * MiB;
constexpr size_t WS_H2 = WS_OXA + 8 * MiB;
constexpr size_t WS_TB = WS_H2 + 64 * MiB;
constexpr size_t WS_ROWS = WS_TB + 32 * MiB;
constexpr size_t WS_ACT = WS_ROWS + 160 * MiB;
constexpr size_t WS_SLOT = WS_ACT + 160 * MiB;
constexpr size_t WS_ASGE = WS_SLOT + 128 * MiB;
constexpr size_t WS_ASGP = WS_ASGE + 1 * MiB;
constexpr size_t WS_GATE = WS_ASGP + 1 * MiB;
constexpr size_t WS_RSLOT = WS_GATE + 1 * MiB;
constexpr size_t WS_WRT = WS_RSLOT + 1 * MiB;
constexpr size_t WS_END = WS_WRT + 1 * MiB;
constexpr int CW_CNT = 64;
constexpr int CW_CUR = 192;  constexpr int CW_DONE = 256;
constexpr int CW_BAR = 4096;

constexpr int RING_BYTES = 131072;
constexpr int LDS_X_OFF = RING_BYTES;
constexpr int LDS_BYTES = 163840;
constexpr int LX_BAR = 0;
constexpr int LX_TAB = 64;
constexpr int LX_CVS = 32;
constexpr int LX_SBF = 128;
constexpr int LX_LOG = 1024;
constexpr int LX_RPART = 4096;

constexpr int NWAVES = 8;

__device__ __forceinline__ unsigned cvt_pk_bf16(float lo, float hi) { unsigned r; asm volatile("v_cvt_pk_bf16_f32 %0, %1, %2" : "=v"(r) : "v"(lo), "v"(hi)); return r; }
__device__ __forceinline__ unsigned pk4_fp8(float a, float b, float c, float d) { int p = __builtin_amdgcn_cvt_pk_fp8_f32(a, b, 0, false); p = __builtin_amdgcn_cvt_pk_fp8_f32(c, d, p, true); return (unsigned)p; }
__device__ __forceinline__ v6i32 pk32_fp6(const f32x16& lo, const f32x16& hi) { return __builtin_amdgcn_cvt_scalef32_2xpk16_fp6_f32(lo, hi, 1.0f); }
__device__ __forceinline__ void st_fp6_block(unsigned char* p, const v6i32& b) { *(u32x4*)p = (u32x4){(unsigned)b[0], (unsigned)b[1], (unsigned)b[2], (unsigned)b[3]}; *(u32x4*)(p + 64) = (u32x4){(unsigned)b[4], (unsigned)b[5], 0u, 0u}; }
__device__ __forceinline__ float bf_lo(unsigned w) { return __uint_as_float(w << 16); }
__device__ __forceinline__ float bf_hi(unsigned w) { return __uint_as_float(w & 0xffff0000u); }
__device__ __forceinline__ float wave_sum(float v) {
#pragma unroll
    for (int o = 1; o < 64; o <<= 1) v += __shfl_xor(v, o);
    return v;
}
__device__ __forceinline__ float sigmoidf_fast(float x) { return __builtin_amdgcn_rcpf(1.0f + __builtin_amdgcn_exp2f(x * -1.4426950408889634f)); }

#define XB_TMO      128
#define XB_XCNT(j)  (256  + 64 * (j))
#define XB_XSUB(j)  (1280 + 64 * (j))
#define XB_XGEN(j)  (2304 + 64 * (j))
#define XB_TOP      3328
#define XB_TOPGEN   3392
#define XCD_BAR_WORDS 3456
#define XB_SPIN_CAP (1u << 18)
__device__ __forceinline__ unsigned xb_ld(unsigned* p)              { return __hip_atomic_load(p, __ATOMIC_RELAXED, __HIP_MEMORY_SCOPE_AGENT); }
__device__ __forceinline__ unsigned xb_add(unsigned* p, unsigned v) { return __hip_atomic_fetch_add(p, v, __ATOMIC_RELAXED, __HIP_MEMORY_SCOPE_AGENT); }
__device__ __forceinline__ unsigned xb_xcc_id() { return (unsigned)__builtin_amdgcn_s_getreg((3 << 11) | 20) & 0xFu; }
#define XB_SPIN(cond, bar) do { unsigned _sp = 0; while (cond) { __builtin_amdgcn_s_sleep(1); \
    if ((++_sp & 255u) == 0u) { if (xb_ld(&(bar)[XB_TMO])) break; if (_sp > XB_SPIN_CAP) { atomicAdd(&(bar)[XB_TMO], 1u); break; } } } } while (0)
struct XcdBarrier { unsigned* bar; unsigned x; volatile LAS unsigned* st; };
__device__ __forceinline__ XcdBarrier xcd_barrier_post(unsigned* bar, volatile LAS unsigned* st) {
    XcdBarrier b; b.bar = bar; b.x = xb_xcc_id(); b.st = st;
    if (threadIdx.x == 0) (void)xb_add(&bar[XB_XCNT(b.x)], 1u);
    return b;
}
__device__ __forceinline__ void xcd_barrier_complete(unsigned* bar, unsigned x, unsigned& nloc, unsigned& nx) {
    const unsigned G = gridDim.x * gridDim.y * gridDim.z;
    unsigned sum, cnt, mine, sp = 0u;
    for (;;) {
        sum = 0u; cnt = 0u; mine = 0u;
#pragma unroll
        for (unsigned j = 0; j < 16; ++j) { const unsigned c = xb_ld(&bar[XB_XCNT(j)]); sum += c; cnt += (c > 0u) ? 1u : 0u; mine = (j == x) ? c : mine; }
        if (sum == G) break;
        __builtin_amdgcn_s_sleep(1);
        if ((++sp & 255u) == 0u) { if (xb_ld(&bar[XB_TMO])) break; if (sp > XB_SPIN_CAP) { atomicAdd(&bar[XB_TMO], 1u); break; } }
    }
    nloc = mine > 0u ? mine : 1u; nx = cnt > 0u ? cnt : 1u;
}
__device__ __forceinline__ void xcd_barrier(const XcdBarrier& b) {
    asm volatile("s_waitcnt vmcnt(0)" ::: "memory");
    __syncthreads();
    if (threadIdx.x == 0) {
        unsigned* bar = b.bar;
        __builtin_amdgcn_s_waitcnt(0);
        unsigned nloc = b.st[0], nx = b.st[1];
        if (nloc == 0u) { xcd_barrier_complete(bar, b.x, nloc, nx); b.st[0] = nloc; b.st[1] = nx; }
        const unsigned old = xb_add(&bar[XB_XSUB(b.x)], 1u);
        const unsigned gen = old / nloc;
        if (old + 1u == (gen + 1u) * nloc) {
            __builtin_amdgcn_fence(__ATOMIC_RELEASE, "agent");
            asm volatile("s_waitcnt vmcnt(0)" ::: "memory");
            const unsigned og = xb_add(&bar[XB_TOP], 1u);
            const unsigned tg = og / nx;
            if (og + 1u == (tg + 1u) * nx) xb_add(&bar[XB_TOPGEN], 1u);
            else XB_SPIN(xb_ld(&bar[XB_TOPGEN]) == tg, bar);
            __builtin_amdgcn_fence(__ATOMIC_ACQUIRE, "agent");
            xb_add(&bar[XB_XGEN(b.x)], 1u);
            asm volatile("s_waitcnt vmcnt(0)" ::: "memory");
        } else {
            XB_SPIN(xb_ld(&bar[XB_XGEN(b.x)]) == gen, bar);
            __builtin_amdgcn_fence(__ATOMIC_ACQUIRE, "agent");
            asm volatile("s_waitcnt vmcnt(0)" ::: "memory");
        }
    }
    __syncthreads();
}

namespace pg8 {
constexpr int BM = 256, BK = 64, HALF = 128, HTB = HALF * BK * 2, STAGE_BYTES = 8 * HTB, NXCD = 8, WGM = 8;
__host__ __device__ __forceinline__ int lds_byte(int r, int c) { const int st = (r >> 4) * 2 + (c >> 5), rr = r & 15, cc = c & 31, ob = rr * 64 + cc * 2; return st * 1024 + (ob ^ (((ob >> 9) & 1) << 5)); }
__host__ __device__ __forceinline__ void stage_rc(int b, int& R, int& C) { const int st = b / 1024, sb = b % 1024, swz = sb ^ (((sb >> 9) & 1) << 5); R = (st >> 1) * 16 + swz / 64; C = (st & 1) * 32 + (swz % 64) / 2; }
__host__ __device__ __forceinline__ int perm32(int rho) { const int n = rho >> 4, i = rho & 15; return 8 * (i >> 2) + 4 * n + (i & 3); }

struct Unit { const char* A; const char* B0; const char* B1; int r0, c0, x; };

__device__ __forceinline__ void tile_of(int L, int nM, int nN, int& pm, int& pn) {
    const int nwg = nM * nN; int wgid = L;
    { const int q = nwg / NXCD, r = nwg % NXCD, xcd = wgid % NXCD, off = wgid / NXCD; wgid = (xcd < r ? xcd * (q + 1) : r * (q + 1) + (xcd - r) * q) + off; }
    const int nig = WGM * nN, gid = wgid / nig, fm = gid * WGM, gsz = (nM - fm) < WGM ? (nM - fm) : WGM;
    pm = fm + ((wgid % nig) % gsz); pn = (wgid % nig) / gsz;
}
struct DenseSched {
    const char* A; const char* B; int lda, ldb, nM, nN, G, c;
    __device__ __forceinline__ bool next(int i, Unit& u) const {
        const long L = (long)i * G + c; if (L >= (long)nM * nN) return false;
        int pm, pn; tile_of((int)L, nM, nN, pm, pn);
        u.A = A + (size_t)pm * BM * lda * 2; u.B0 = B + (size_t)pn * BM * ldb * 2; u.B1 = u.B0 + (size_t)HALF * ldb * 2; u.r0 = pm * BM; u.c0 = pn * BM; u.x = 0; return true;
    }
};
struct BranchSched {
    const char* A0; const char* A1; const char* B0; const char* B1; int lda, ldb, nM, nN, G, c;
    __device__ __forceinline__ bool next(int i, Unit& u) const {
        const long L = (long)(i >> 1) * G + c; if (L >= (long)nM * nN) return false;
        int pm, pn; tile_of((int)L, nM, nN, pm, pn); const int br = i & 1;
        u.A = (br ? A1 : A0) + (size_t)pm * BM * lda * 2; u.B0 = (br ? B1 : B0) + (size_t)pn * BM * ldb * 2; u.B1 = u.B0 + (size_t)HALF * ldb * 2; u.r0 = pm * BM; u.c0 = pn * BM; u.x = br; return true;
    }
};
struct PoolSched {
    const char* A; const char* B; int G, c;
    __device__ __forceinline__ bool next(int i, Unit& u) const {
        const int L = i * G + c; if (L >= (S / BM) * 4) return false;
        const int pm = L >> 2, g = L & 3;
        u.A = A + ((size_t)pm * BM * POOLW + g * 256) * 2; u.B0 = B + (size_t)g * 256 * 256 * 2; u.B1 = u.B0 + (size_t)HALF * 256 * 2; u.r0 = pm * BM; u.c0 = g * 256; u.x = g; return true;
    }
};
struct MoeSched {
    const char* A; const char* B; int NT; size_t estride; size_t tstride; size_t hoff; const LAS int* tab; int G, c; bool gather; size_t arow;
    __device__ __forceinline__ int tu(int i) const { return __builtin_amdgcn_readfirstlane(tab[i]); }
    __device__ __forceinline__ bool next(int i, Unit& u) const {
        const int L = i * G + c; if (L >= tu(32)) return false;
        int e = 0;
#pragma unroll
        for (int s = 16; s >= 1; s >>= 1) { if (tu(e + s) <= L) e += s; }
        const int r = L - tu(e), nb = tu(66 + e), nt = r / nb, blk = r - nt * nb, prow = tu(33 + e) + blk * EBLK;
        u.A = gather ? A : A + (size_t)prow * arow; u.B0 = B + (size_t)e * estride + (size_t)nt * tstride; u.B1 = u.B0 + hoff; u.r0 = prow; u.c0 = nt; u.x = e; return true;
    }
};

template <class Epi, class Sched, bool ALIGN_EPI, bool GATHER = false, int PREC = 0>
__device__ __forceinline__ void gemm_phase(LAS unsigned char* lds, const int K, const int lda, const int ldb, const Sched& S, const Epi& E, const LAS int* gtab = nullptr) {
    const int tid = threadIdx.x, wid = __builtin_amdgcn_readfirstlane(tid >> 6), lane = tid & 63, wr = wid >> 2, wc = wid & 3, fr = lane & 15, fq = lane >> 4;
    const int nt = K / BK;
    unsigned voffB[2], vc[2][2], vn[2][2]; int RA[2], CA[2];
#pragma unroll
    for (int i = 0; i < 2; ++i) { int R, C; stage_rc(tid * 16 + i * 8192, R, C); const int Rb = Epi::PERM ? ((R & ~31) + perm32(R & 31)) : R; RA[i] = R; CA[i] = C;
        voffB[i] = (unsigned)(Rb * ldb + C) * 2u; }
#define PG8_AOFF(dst, ord) do { _Pragma("unroll") for (int _h = 0; _h < 2; ++_h) _Pragma("unroll") for (int _i = 0; _i < 2; ++_i) \
        dst[_h][_i] = GATHER ? ((unsigned)gtab[(ord) * 256 + _h * HALF + RA[_i]] * (unsigned)lda + (unsigned)CA[_i]) * 2u : (unsigned)((_h * HALF + RA[_i]) * lda + CA[_i]) * 2u; } while (0)
    const size_t kstep = (size_t)(BK * 2);
    const unsigned ldsw = (unsigned)wid * 1024u;
    const int aoff = lds_byte(wr * 64 + fr, fq * 8), boff = lds_byte(wc * 32 + fr, fq * 8);
#define PG8_SA(b, h) (((b) * 2 + (h)) * HTB)
#define PG8_SB(b, h) ((4 + (b) * 2 + (h)) * HTB)
#define PG8_STAGE(bufoff, gbase, voff) do { _Pragma("unroll") for (int _i = 0; _i < 2; ++_i) \
        __builtin_amdgcn_global_load_lds((const unsigned*)((const char*)(gbase) + (voff)[_i]), (LAS unsigned*)(lds + (bufoff) + ldsw + _i * 8192), 16, 0, 0); } while (0)
#define PG8_LD6(off) __builtin_bit_cast(v6i32, __builtin_shufflevector(*(const LAS u32x4*)(lds + (off)), __builtin_shufflevector(*(const LAS u32x2*)(lds + (off) + 1024), *(const LAS u32x2*)(lds + (off) + 1024), 0, 1, -1, -1), 0, 1, 2, 3, 4, 5))
#define PG8_LD8(off) __builtin_bit_cast(v8i32, __builtin_shufflevector(*(const LAS u32x4*)(lds + (off)), *(const LAS u32x4*)(lds + (off) + 1024), 0, 1, 2, 3, 4, 5, 6, 7))
#define PG8_LDA(dst, b, h) do { if (PREC == 2) { _Pragma("unroll") for (int m = 0; m < 4; ++m) dst##6[m] = PG8_LD6(PG8_SA(b, h) + aoff + m * 2048); } \
      else if (PREC == 1) { _Pragma("unroll") for (int m = 0; m < 4; ++m) dst##8[m] = PG8_LD8(PG8_SA(b, h) + aoff + m * 2048); } \
      else { _Pragma("unroll") for (int m = 0; m < 4; ++m) _Pragma("unroll") for (int k = 0; k < 2; ++k) dst[m][k] = *(const LAS bf16x8*)(lds + PG8_SA(b, h) + aoff + m * 2048 + k * 1024); } } while (0)
#define PG8_LDB(dst, b, h) do { if (PREC == 2) { _Pragma("unroll") for (int n = 0; n < 2; ++n) dst##6[n] = PG8_LD6(PG8_SB(b, h) + boff + n * 2048); } \
      else if (PREC == 1) { _Pragma("unroll") for (int n = 0; n < 2; ++n) dst##8[n] = PG8_LD8(PG8_SB(b, h) + boff + n * 2048); } \
      else { _Pragma("unroll") for (int n = 0; n < 2; ++n) _Pragma("unroll") for (int k = 0; k < 2; ++k) dst[n][k] = *(const LAS bf16x8*)(lds + PG8_SB(b, h) + boff + n * 2048 + k * 1024); } } while (0)
#define PG8_MMA(ai, bj, At, Bt) do { __builtin_amdgcn_s_setprio(1); if (PREC == 2) { _Pragma("unroll") for (int m = 0; m < 4; ++m) _Pragma("unroll") for (int n = 0; n < 2; ++n) \
        asm volatile("v_mfma_scale_f32_16x16x128_f8f6f4 %0, %1, %2, %0, %3, %4 op_sel_hi:[0,0,0] cbsz:2 blgp:2" : "+v"(acc[ai][bj][m][n]) : "v"(Bt##6[n]), "v"(At##6[m]), "v"(sc_w), "v"(sc_a)); } \
      else if (PREC == 1) { _Pragma("unroll") for (int m = 0; m < 4; ++m) _Pragma("unroll") for (int n = 0; n < 2; ++n) \
        asm volatile("v_mfma_scale_f32_16x16x128_f8f6f4 %0, %1, %2, %0, %3, %4 op_sel_hi:[0,0,0]" : "+v"(acc[ai][bj][m][n]) : "v"(Bt##8[n]), "v"(At##8[m]), "v"(sc_w), "v"(sc_a)); } \
      else { _Pragma("unroll") for (int m = 0; m < 4; ++m) _Pragma("unroll") for (int n = 0; n < 2; ++n) _Pragma("unroll") for (int k = 0; k < 2; ++k) \
        acc[ai][bj][m][n] = __builtin_amdgcn_mfma_f32_16x16x32_bf16(Bt[n][k], At[m][k], acc[ai][bj][m][n], 0, 0, 0); } __builtin_amdgcn_s_setprio(0); } while (0)
#define PG8_WAIT_V(n) asm volatile("s_waitcnt vmcnt(" #n ")" ::: "memory")
#define PG8_WAIT_L(n) asm volatile("s_waitcnt lgkmcnt(" #n ")" ::: "memory")
#define PG8_BAR __builtin_amdgcn_s_barrier()
#define PG8_SCHED __builtin_amdgcn_sched_barrier(0)
    Unit cur, nxt; int ui = 0;
    if (!S.next(0, cur)) return;
    f32x4 acc[2][2][4][2];
#pragma unroll
    for (int a = 0; a < 2; ++a)
#pragma unroll
        for (int b = 0; b < 2; ++b)
#pragma unroll
            for (int m = 0; m < 4; ++m)
#pragma unroll
                for (int n = 0; n < 2; ++n) acc[a][b][m][n] = (f32x4){0.f, 0.f, 0.f, 0.f};
    bf16x8 At[4][2], B0[2][2], B1[2][2]; v8i32 At8[4], B08[2], B18[2]; v6i32 At6[4], B06[2], B16[2];
    const int sc_w = 121, sc_a = (PREC == 2) ? 126 : 127;
    PG8_AOFF(vc, 0);
#pragma unroll
    for (int _h = 0; _h < 2; ++_h) { vn[_h][0] = vc[_h][0]; vn[_h][1] = vc[_h][1]; }
    PG8_STAGE(PG8_SB(0, 0), cur.B0, voffB); PG8_STAGE(PG8_SB(0, 1), cur.B1, voffB); PG8_STAGE(PG8_SA(0, 0), cur.A, vc[0]); PG8_STAGE(PG8_SA(0, 1), cur.A, vc[1]);
    if (wr == 1) PG8_BAR;
    PG8_WAIT_V(2); PG8_BAR;
    PG8_STAGE(PG8_SB(1, 0), cur.B0 + kstep, voffB); PG8_STAGE(PG8_SA(1, 0), cur.A + kstep, vc[0]); PG8_STAGE(PG8_SB(1, 1), cur.B1 + kstep, voffB);
    PG8_WAIT_V(6); PG8_BAR;
    for (;;) {
        const bool has_next = S.next(ui + 1, nxt);
        if (GATHER && has_next) PG8_AOFF(vn, ui + 1);
        const char* nA = has_next ? nxt.A : cur.A; const char* nB0 = has_next ? nxt.B0 : cur.B0; const char* nB1 = has_next ? nxt.B1 : cur.B1;
#pragma nounroll
        for (int t = 0; t < nt; t += 2) {
            const bool last = (t == nt - 2);
            const char* a1 = cur.A + (size_t)(t + 1) * kstep;
            const char* a2 = last ? nA : cur.A + (size_t)(t + 2) * kstep;
            const char* b20 = last ? nB0 : cur.B0 + (size_t)(t + 2) * kstep; const char* b21 = last ? nB1 : cur.B1 + (size_t)(t + 2) * kstep;
            const char* a3 = a2 + kstep; const char* b30 = b20 + kstep; const char* b31 = b21 + kstep;
            unsigned v2[2][2];
#pragma unroll
            for (int _h = 0; _h < 2; ++_h) { v2[_h][0] = (GATHER && last) ? vn[_h][0] : vc[_h][0]; v2[_h][1] = (GATHER && last) ? vn[_h][1] : vc[_h][1]; }
            PG8_LDB(B0, 0, 0); PG8_LDB(B1, 0, 1); PG8_SCHED; PG8_LDA(At, 0, 0); PG8_STAGE(PG8_SA(1, 1), a1, vc[1]);
            PG8_WAIT_V(8); PG8_WAIT_L(0); PG8_BAR; PG8_MMA(0, 0, At, B0); PG8_MMA(0, 1, At, B1); PG8_BAR; PG8_SCHED;
            PG8_LDA(At, 0, 1); PG8_STAGE(PG8_SB(0, 0), b20, voffB); PG8_STAGE(PG8_SB(0, 1), b21, voffB); PG8_STAGE(PG8_SA(0, 0), a2, v2[0]);
            PG8_WAIT_V(8); PG8_WAIT_L(0); PG8_BAR; PG8_MMA(1, 0, At, B0); PG8_MMA(1, 1, At, B1); PG8_BAR; PG8_SCHED;
            PG8_LDB(B0, 1, 0); PG8_LDB(B1, 1, 1); PG8_SCHED; PG8_LDA(At, 1, 0); PG8_STAGE(PG8_SA(0, 1), a2, v2[1]);
            PG8_WAIT_V(8); PG8_WAIT_L(0); PG8_BAR; PG8_MMA(0, 0, At, B0); PG8_MMA(0, 1, At, B1); PG8_BAR; PG8_SCHED;
            PG8_LDA(At, 1, 1); PG8_STAGE(PG8_SB(1, 0), b30, voffB); PG8_STAGE(PG8_SB(1, 1), b31, voffB); PG8_STAGE(PG8_SA(1, 0), a3, v2[0]);
            PG8_WAIT_V(8); PG8_WAIT_L(0); PG8_BAR; PG8_MMA(1, 0, At, B0); PG8_MMA(1, 1, At, B1); PG8_BAR; PG8_SCHED;
        }
        if constexpr (ALIGN_EPI) { if (wr == 0) PG8_BAR; }
        if (PREC != 0) asm volatile("s_nop 15\n\ts_nop 15\n\ts_nop 15\n\ts_nop 15" ::: "memory");
        E(acc, cur, wr, wc, fr, fq);
        if (!has_next) break;
        bool kp = false; if constexpr (Epi::KEEPS) kp = E.keep(cur);
        if (!kp) {
#pragma unroll
        for (int a = 0; a < 2; ++a)
#pragma unroll
            for (int b = 0; b < 2; ++b)
#pragma unroll
                for (int m = 0; m < 4; ++m)
#pragma unroll
                    for (int n = 0; n < 2; ++n) acc[a][b][m][n] = (f32x4){0.f, 0.f, 0.f, 0.f}; }
        cur = nxt; ++ui;
        if (GATHER) {
#pragma unroll
            for (int _h = 0; _h < 2; ++_h) { vc[_h][0] = vn[_h][0]; vc[_h][1] = vn[_h][1]; } }
        if constexpr (ALIGN_EPI) { if (wr == 1) PG8_BAR; }
    }
    PG8_WAIT_V(0);
    if constexpr (!ALIGN_EPI) { if (wr == 0) PG8_BAR; }
    PG8_BAR;
#undef PG8_AOFF
#undef PG8_SA
#undef PG8_SB
#undef PG8_STAGE
#undef PG8_LDA
#undef PG8_LDB
#undef PG8_MMA
#undef PG8_LD8
#undef PG8_LD6
#undef PG8_WAIT_V
#undef PG8_WAIT_L
#undef PG8_BAR
#undef PG8_SCHED
}

template <int OFF>
__device__ __forceinline__ v6i32 ld6x(unsigned addr) {
    u32x4 lo; u32x2 hi;
    asm volatile("ds_read_b128 %0, %1 offset:%2" : "=v"(lo) : "v"(addr), "n"(OFF));
    asm volatile("ds_read_b64 %0, %1 offset:%2" : "=v"(hi) : "v"(addr), "n"(OFF + 1024));
    return (v6i32){(int)lo[0], (int)lo[1], (int)lo[2], (int)lo[3], (int)hi[0], (int)hi[1]};
}
template <class Epi, class Sched>
__device__ __forceinline__ void gemm_phase_db6(LAS unsigned char* lds, const int K, const int lda, const int ldb, const Sched& S, const Epi& E, const LAS int* gtab) {
    const int tid = threadIdx.x, wid = __builtin_amdgcn_readfirstlane(tid >> 6), lane = tid & 63, wr = wid >> 2, wc = wid & 3, fr = lane & 15, fq = lane >> 4;
    const int nt = K / BK;
    unsigned voffB0, vc[2][2]; const size_t bstep = (size_t)64 * ldb * 2;
    { int R, C; stage_rc(tid * 16, R, C); const int Rb = Epi::PERM ? ((R & ~31) + perm32(R & 31)) : R; voffB0 = (unsigned)(Rb * ldb + C) * 2u; }
#define DB_AOFF(dst, ord) do { _Pragma("unroll") for (int _i = 0; _i < 2; ++_i) { int _R, _C; stage_rc((int)threadIdx.x * 16 + _i * 8192, _R, _C); _Pragma("unroll") for (int _h = 0; _h < 2; ++_h) \
        dst[_h][_i] = ((unsigned)gtab[(ord) * 256 + _h * HALF + _R] * (unsigned)lda + (unsigned)_C) * 2u; } } while (0)
    const size_t kstep = (size_t)(BK * 2);
    const unsigned ldsw = (unsigned)wid * 1024u;
    const int aoff = lds_byte(wr * 64 + fr, fq * 8), boff = lds_byte(wc * 32 + fr, fq * 8);
    const unsigned aA = (unsigned)(size_t)(lds + aoff), aB = (unsigned)(size_t)(lds + 4 * HTB + boff);
#define DB_SA(b, h) (((b) * 2 + (h)) * HTB)
#define DB_SB(b, h) ((4 + (b) * 2 + (h)) * HTB)
#define DB_STAGEA1(bufoff, gbase, voff, i) __builtin_amdgcn_global_load_lds((const unsigned*)((const char*)(gbase) + (voff)[i]), (LAS unsigned*)(lds + (bufoff) + ldsw + (i) * 8192), 16, 0, 0)
#define DB_STAGEB1(bufoff, gbase, i) __builtin_amdgcn_global_load_lds((const unsigned*)((const char*)(gbase) + (size_t)(i) * bstep + voffB0), (LAS unsigned*)(lds + (bufoff) + ldsw + (i) * 8192), 16, 0, 0)
#define DB_STAGEA(bufoff, gbase, voff) do { DB_STAGEA1(bufoff, gbase, voff, 0); DB_STAGEA1(bufoff, gbase, voff, 1); } while (0)
#define DB_STAGEB(bufoff, gbase) do { DB_STAGEB1(bufoff, gbase, 0); DB_STAGEB1(bufoff, gbase, 1); } while (0)
#define DB_LDA(dst, b, h) do { dst[0] = ld6x<DB_SA(b, h)>(aA); dst[1] = ld6x<DB_SA(b, h) + 2048>(aA); dst[2] = ld6x<DB_SA(b, h) + 4096>(aA); dst[3] = ld6x<DB_SA(b, h) + 6144>(aA); } while (0)
#define DB_LDB(dst, b, h) do { dst[0] = ld6x<((b) * 2 + (h)) * HTB>(aB); dst[1] = ld6x<((b) * 2 + (h)) * HTB + 2048>(aB); } while (0)
#define DB_MMA(ai, bj, At, Bt) do { __builtin_amdgcn_s_setprio(1); _Pragma("unroll") for (int m = 0; m < 4; ++m) _Pragma("unroll") for (int n = 0; n < 2; ++n) \
        asm volatile("v_mfma_scale_f32_16x16x128_f8f6f4 %0, %1, %2, %0, %3, %4 op_sel_hi:[0,0,0] cbsz:2 blgp:2" : "+v"(acc[ai][bj][m][n]) : "v"(Bt[n]), "v"(At[m]), "v"(sc_w), "v"(sc_a)); __builtin_amdgcn_s_setprio(0); } while (0)
#define DB_MMA4(ai, bj, mlo, At, Bt) do { _Pragma("unroll") for (int m = (mlo); m < (mlo) + 2; ++m) _Pragma("unroll") for (int n = 0; n < 2; ++n) \
        asm volatile("v_mfma_scale_f32_16x16x128_f8f6f4 %0, %1, %2, %0, %3, %4 op_sel_hi:[0,0,0] cbsz:2 blgp:2" : "+v"(acc[ai][bj][m][n]) : "v"(Bt[n]), "v"(At[m]), "v"(sc_w), "v"(sc_a)); } while (0)
#define DB_SYNC() do { asm volatile("s_waitcnt vmcnt(8) lgkmcnt(0)" ::: "memory"); __builtin_amdgcn_s_barrier(); } while (0)
#define DB_SYNC6() do { asm volatile("s_waitcnt vmcnt(6) lgkmcnt(0)" ::: "memory"); __builtin_amdgcn_s_barrier(); } while (0)
#define DB_STEP(ai, At, sb, sa, gb, ga, vo) do { \
        DB_STAGEB1(sb, gb, 0); DB_SCHED; DB_MMA4(ai, 0, 0, At, B0); DB_SCHED; DB_STAGEB1(sb, gb, 1); DB_SCHED; DB_MMA4(ai, 0, 2, At, B0); DB_SCHED; \
        DB_STAGEA1(sa, ga, vo, 0); DB_SCHED; DB_MMA4(ai, 1, 0, At, B1); DB_SCHED; DB_STAGEA1(sa, ga, vo, 1); DB_SCHED; DB_MMA4(ai, 1, 2, At, B1); DB_SCHED; } while (0)
#define DB_SCHED __builtin_amdgcn_sched_barrier(0)
    Unit cur, nxt; int ui = 0;
    if (!S.next(0, cur)) return;
    f32x4 acc[2][2][4][2]; typename Epi::Pre pre;
    E.prefetch(pre, cur, wc, fq); E.init(acc, pre);
    v6i32 A0[4], A1[4], B0[2], B1[2];
    const int sc_w = 121, sc_a = 126;
    if (wid >= 4) __builtin_amdgcn_s_setprio(1);
    DB_AOFF(vc, 0);
    DB_STAGEB(DB_SB(0, 0), cur.B0); DB_STAGEA(DB_SA(0, 0), cur.A, vc[0]); DB_STAGEB(DB_SB(0, 1), cur.B1); DB_STAGEA(DB_SA(0, 1), cur.A, vc[1]);
    DB_STAGEB(DB_SB(1, 0), cur.B0 + kstep); DB_STAGEA(DB_SA(1, 0), cur.A + kstep, vc[0]); DB_STAGEB(DB_SB(1, 1), cur.B1 + kstep); DB_STAGEA(DB_SA(1, 1), cur.A + kstep, vc[1]);
    DB_SYNC();
    DB_LDB(B0, 0, 0); DB_LDB(B1, 0, 1); DB_LDA(A0, 0, 0); DB_SCHED;
    for (;;) {
        const bool has_next = S.next(ui + 1, nxt);
        const char* nA = has_next ? nxt.A : cur.A; const char* nB0 = has_next ? nxt.B0 : cur.B0; const char* nB1 = has_next ? nxt.B1 : cur.B1;
#pragma nounroll
        for (int t = 0; t < nt; t += 2) {
            const bool last = (t == nt - 2);
            const char* a2 = last ? nA : cur.A + (size_t)(t + 2) * kstep;
            const char* b20 = last ? nB0 : cur.B0 + (size_t)(t + 2) * kstep; const char* b21 = last ? nB1 : cur.B1 + (size_t)(t + 2) * kstep;
            const char* a3 = a2 + kstep; const char* b30 = b20 + kstep; const char* b31 = b21 + kstep;
            if (last && has_next) DB_AOFF(vc, ui + 1);
            DB_SYNC(); DB_LDA(A1, 0, 1); DB_SCHED; DB_STEP(0, A0, DB_SB(0, 0), DB_SA(0, 0), b20, a2, vc[0]);
            DB_SYNC6(); DB_LDA(A0, 1, 0); DB_SCHED; DB_STEP(1, A1, DB_SB(0, 1), DB_SA(0, 1), b21, a2, vc[1]); DB_LDB(B0, 1, 0); DB_LDB(B1, 1, 1); DB_SCHED;
            DB_SYNC(); DB_LDA(A1, 1, 1); DB_SCHED; DB_STEP(0, A0, DB_SB(1, 0), DB_SA(1, 0), b30, a3, vc[0]);
            DB_SYNC6(); if (!last) DB_LDA(A0, 0, 0); DB_SCHED; DB_STEP(1, A1, DB_SB(1, 1), DB_SA(1, 1), b31, a3, vc[1]); if (!last) { DB_LDB(B0, 0, 0); DB_LDB(B1, 0, 1); } DB_SCHED;
        }
        asm volatile("s_nop 15\n\ts_nop 15\n\ts_nop 15\n\ts_nop 15" ::: "memory");
        { const unsigned _l = (unsigned)__builtin_amdgcn_mbcnt_hi(~0u, __builtin_amdgcn_mbcnt_lo(~0u, 0u)); if (has_next) E.prefetch(pre, nxt, wc, (int)(_l >> 4)); E(acc, cur, wr, wc, (int)(_l & 15u), (int)(_l >> 4)); }
        if (!has_next) break;
        E.init(acc, pre);
        cur = nxt; ++ui;
        DB_LDB(B0, 0, 0); DB_LDB(B1, 0, 1); DB_LDA(A0, 0, 0); DB_SCHED;
    }
    asm volatile("s_waitcnt vmcnt(0) lgkmcnt(0)" ::: "memory");
    __builtin_amdgcn_s_setprio(0);
    __builtin_amdgcn_s_barrier();
#undef DB_AOFF
#undef DB_SA
#undef DB_SB
#undef DB_STAGEA
#undef DB_STAGEB
#undef DB_LDA
#undef DB_LDB
#undef DB_MMA
#undef DB_SYNC
#undef DB_SYNC6
#undef DB_STEP
#undef DB_MMA4
#undef DB_STAGEA1
#undef DB_STAGEB1
#undef DB_SCHED
}

typedef f32x4 Acc[2][2][4][2];

struct EpiProj {
    static constexpr bool PERM = true, KEEPS = false;
    bf16_t* O; const float* bgate;
    __device__ __forceinline__ void operator()(Acc& acc, const Unit& u, int wr, int wc, int fr, int fq) const {
        const int row0 = u.r0 + wr * 64 + fr, col0 = u.c0 + wc * 32 + 8 * fq; const bool gate = u.c0 >= INW;
        typedef float f32x2v __attribute__((ext_vector_type(2)));
        f32x4 bv[2][2];
#pragma unroll
        for (int bj = 0; bj < 2; ++bj)
#pragma unroll
            for (int n = 0; n < 2; ++n) bv[bj][n] = gate ? *(const f32x4*)(bgate + (col0 - INW) + bj * HALF + 4 * n) * -1.4426950408889634f : (f32x4){0.f, 0.f, 0.f, 0.f};
#pragma unroll
        for (int ai = 0; ai < 2; ++ai)
#pragma unroll
            for (int m = 0; m < 4; ++m) { bf16_t* rowp = O + (size_t)(row0 + ai * HALF + m * 16) * NP1 + col0;
#pragma unroll
                for (int bj = 0; bj < 2; ++bj) { f32x4 v[2] = {acc[ai][bj][m][0], acc[ai][bj][m][1]};
                    if (gate) {
#pragma unroll
                        for (int n = 0; n < 2; ++n)
#pragma unroll
                            for (int j = 0; j < 4; j += 2) { const f32x2v a2 = {v[n][j], v[n][j + 1]}, b2 = {bv[bj][n][j], bv[bj][n][j + 1]};
                                const f32x2v t = a2 * -1.4426950408889634f + b2; const f32x2v e = {__builtin_amdgcn_exp2f(t.x), __builtin_amdgcn_exp2f(t.y)}; const f32x2v d = e + 1.0f;
                                v[n][j] = __builtin_amdgcn_rcpf(d.x); v[n][j + 1] = __builtin_amdgcn_rcpf(d.y); } }
                    u32x4 w; w.x = cvt_pk_bf16(v[0][0], v[0][1]); w.y = cvt_pk_bf16(v[0][2], v[0][3]); w.z = cvt_pk_bf16(v[1][0], v[1][1]); w.w = cvt_pk_bf16(v[1][2], v[1][3]);
                    *(u32x4*)(rowp + bj * HALF) = w; } }
    }
};
struct EpiBf16 {
    static constexpr bool PERM = true, KEEPS = false;
    bf16_t* O; int ldc; const float* cscale;
    __device__ __forceinline__ void operator()(Acc& acc, const Unit& u, int wr, int wc, int fr, int fq) const {
        const int row0 = u.r0 + wr * 64 + fr, col0 = u.c0 + wc * 32 + 8 * fq;
#pragma unroll
        for (int bj = 0; bj < 2; ++bj) {
            const f32x4 s0 = cscale ? *(const f32x4*)(cscale + col0 + bj * HALF) : (f32x4){1.f, 1.f, 1.f, 1.f}, s1 = cscale ? *(const f32x4*)(cscale + col0 + bj * HALF + 4) : (f32x4){1.f, 1.f, 1.f, 1.f};
#pragma unroll
            for (int ai = 0; ai < 2; ++ai)
#pragma unroll
                for (int m = 0; m < 4; ++m) { bf16_t* rowp = O + (size_t)(row0 + ai * HALF + m * 16) * ldc + col0;
                    const f32x4 v0 = acc[ai][bj][m][0] * s0, v1 = acc[ai][bj][m][1] * s1;
                    u32x4 w; w.x = cvt_pk_bf16(v0[0], v0[1]); w.y = cvt_pk_bf16(v0[2], v0[3]); w.z = cvt_pk_bf16(v1[0], v1[1]); w.w = cvt_pk_bf16(v1[2], v1[3]);
                    *(u32x4*)(rowp + bj * HALF) = w; } }
    }
};
struct EpiBranch {
    static constexpr bool PERM = true, KEEPS = true;
    const bf16_t* PG; bf16_t* MG;
    __device__ __forceinline__ bool keep(const Unit& u) const { return u.x == 0; }
    __device__ __forceinline__ void operator()(Acc& acc, const Unit& u, int wr, int wc, int fr, int fq) const {
        const int row0 = u.r0 + wr * 64 + fr, col0 = u.c0 + wc * 32 + 8 * fq;
        if (u.x == 0) {
#pragma unroll
            for (int ai = 0; ai < 2; ++ai) { u32x4 gb[4][2], ga[4][2];
#pragma unroll
                for (int m = 0; m < 4; ++m)
#pragma unroll
                    for (int bj = 0; bj < 2; ++bj) { const bf16_t* gp = PG + (size_t)(row0 + ai * HALF + m * 16) * NP1 + INW + col0 + bj * HALF; gb[m][bj] = *(const u32x4*)(gp + D); ga[m][bj] = *(const u32x4*)gp; }
                asm volatile("" ::: "memory");
#pragma unroll
                for (int m = 0; m < 4; ++m)
#pragma unroll
                    for (int bj = 0; bj < 2; ++bj) { const u32x4 g = gb[m][bj], a = ga[m][bj];
                        const f32x4 h0 = {bf_lo(g.x), bf_hi(g.x), bf_lo(g.y), bf_hi(g.y)}, h1 = {bf_lo(g.z), bf_hi(g.z), bf_lo(g.w), bf_hi(g.w)};
                        const f32x4 a0 = {bf_lo(a.x), bf_hi(a.x), bf_lo(a.y), bf_hi(a.y)}, a1 = {bf_lo(a.z), bf_hi(a.z), bf_lo(a.w), bf_hi(a.w)};
#pragma unroll
                        for (int j = 0; j < 4; ++j) { acc[ai][bj][m][0][j] *= a0[j] * __builtin_amdgcn_rcpf(fmaxf(h0[j], 1e-30f)); acc[ai][bj][m][1][j] *= a1[j] * __builtin_amdgcn_rcpf(fmaxf(h1[j], 1e-30f)); } }
                asm volatile("" ::: "memory"); }
        } else {
#pragma unroll
            for (int ai = 0; ai < 2; ++ai) { u32x4 gb[4][2];
#pragma unroll
                for (int m = 0; m < 4; ++m)
#pragma unroll
                    for (int bj = 0; bj < 2; ++bj) gb[m][bj] = *(const u32x4*)(PG + (size_t)(row0 + ai * HALF + m * 16) * NP1 + INW + D + col0 + bj * HALF);
                asm volatile("" ::: "memory");
#pragma unroll
                for (int m = 0; m < 4; ++m)
#pragma unroll
                    for (int bj = 0; bj < 2; ++bj) { const u32x4 g = gb[m][bj];
                        f32x4 h0 = {bf_lo(g.x), bf_hi(g.x), bf_lo(g.y), bf_hi(g.y)}, h1 = {bf_lo(g.z), bf_hi(g.z), bf_lo(g.w), bf_hi(g.w)};
#pragma unroll
                        for (int j = 0; j < 4; ++j) { h0[j] = fmaxf(h0[j], 1e-30f); h1[j] = fmaxf(h1[j], 1e-30f); }
                        const f32x4 v0 = acc[ai][bj][m][0] * h0, v1 = acc[ai][bj][m][1] * h1;
                        u32x4 w; w.x = cvt_pk_bf16(v0[0], v0[1]); w.y = cvt_pk_bf16(v0[2], v0[3]); w.z = cvt_pk_bf16(v1[0], v1[1]); w.w = cvt_pk_bf16(v1[2], v1[3]);
                        *(u32x4*)(MG + (size_t)(row0 + ai * HALF + m * 16) * D + col0 + bj * HALF) = w; }
                asm volatile("" ::: "memory"); }
        }
    }
};
template <bool RB, bool OB> struct EpiResidT {
    static constexpr bool PERM = true, KEEPS = false;
    const void* res; void* out; int ldc;
    __device__ __forceinline__ void operator()(Acc& acc, const Unit& u, int wr, int wc, int fr, int fq) const {
        const int row0 = u.r0 + wr * 64 + fr, col0 = u.c0 + wc * 32 + 8 * fq;
#pragma unroll
        for (int ai = 0; ai < 2; ++ai) {
            f32x4 r[RB ? 1 : 4][2][2]; u32x4 rb[RB ? 4 : 1][2];
#pragma unroll
            for (int m = 0; m < 4; ++m)
#pragma unroll
                for (int bj = 0; bj < 2; ++bj) { const size_t o = (size_t)(row0 + ai * HALF + m * 16) * ldc + col0 + bj * HALF;
                    if constexpr (RB) rb[m][bj] = *(const u32x4*)((const bf16_t*)res + o);
                    else { r[m][bj][0] = *(const f32x4*)((const float*)res + o); r[m][bj][1] = *(const f32x4*)((const float*)res + o + 4); } }
            asm volatile("" ::: "memory");
#pragma unroll
            for (int m = 0; m < 4; ++m)
#pragma unroll
                for (int bj = 0; bj < 2; ++bj) { const size_t o = (size_t)(row0 + ai * HALF + m * 16) * ldc + col0 + bj * HALF; f32x4 v0, v1;
                    if constexpr (RB) { const u32x4 w = rb[m][bj]; v0 = (f32x4){bf_lo(w.x), bf_hi(w.x), bf_lo(w.y), bf_hi(w.y)}; v1 = (f32x4){bf_lo(w.z), bf_hi(w.z), bf_lo(w.w), bf_hi(w.w)}; }
                    else { v0 = r[m][bj][0]; v1 = r[m][bj][1]; }
                    v0 += acc[ai][bj][m][0]; v1 += acc[ai][bj][m][1];
                    if constexpr (OB) { u32x4 w; w.x = cvt_pk_bf16(v0[0], v0[1]); w.y = cvt_pk_bf16(v0[2], v0[3]); w.z = cvt_pk_bf16(v1[0], v1[1]); w.w = cvt_pk_bf16(v1[2], v1[3]); *(u32x4*)((bf16_t*)out + o) = w; }
                    else { *(f32x4*)((float*)out + o) = v0; *(f32x4*)((float*)out + o + 4) = v1; } }
            asm volatile("" ::: "memory"); }
    }
};
struct EpiUp {
    static constexpr bool PERM = true, KEEPS = false;
    const float* bup; unsigned char* ACT;
    struct Pre { f32x4 bg[2], bl[2]; };
    __device__ __forceinline__ void prefetch(Pre& p, const Unit& u, int wc, int fq) const {
        const float* be = bup + (size_t)u.x * (2 * DFF) + u.c0 * HALF + wc * 32 + 8 * fq;
#pragma unroll
        for (int n = 0; n < 2; ++n) { p.bg[n] = *(const f32x4*)(be + 4 * n); p.bl[n] = *(const f32x4*)(be + DFF + 4 * n) + 1.0f; }
    }
    __device__ __forceinline__ void init(Acc& acc, const Pre& p) const {
#pragma unroll
        for (int ai = 0; ai < 2; ++ai)
#pragma unroll
            for (int m = 0; m < 4; ++m)
#pragma unroll
                for (int n = 0; n < 2; ++n) { acc[ai][0][m][n] = p.bg[n]; acc[ai][1][m][n] = p.bl[n]; }
    }
    __device__ __forceinline__ void operator()(Acc& acc, const Unit& u, int wr, int wc, int fr, int fq) const {
        const int row0 = u.r0 + wr * 64 + fr, col0 = u.c0 * HALF + wc * 32 + 8 * fq;
        typedef float f32x2v __attribute__((ext_vector_type(2)));
#pragma unroll
        for (int ai = 0; ai < 2; ++ai)
#pragma unroll
            for (int m = 0; m < 4; ++m) { unsigned char* rowp = ACT + (size_t)(row0 + ai * HALF + m * 16) * DFF + col0; f32x4 o[2];
#pragma unroll
                for (int n = 0; n < 2; ++n) { const f32x4 gv = acc[ai][0][m][n], lv = acc[ai][1][m][n];
#pragma unroll
                    for (int j = 0; j < 4; j += 2) {
                        const f32x2v g = {__builtin_amdgcn_fmed3f(gv[j], -3.0e38f, 7.0f), __builtin_amdgcn_fmed3f(gv[j + 1], -3.0e38f, 7.0f)}, l = {__builtin_amdgcn_fmed3f(lv[j], -6.0f, 8.0f), __builtin_amdgcn_fmed3f(lv[j + 1], -6.0f, 8.0f)};
                        const f32x2v t = g * -2.4554669595930156f; const f32x2v e = {__builtin_amdgcn_exp2f(t.x), __builtin_amdgcn_exp2f(t.y)}; const f32x2v d = e + 1.0f;
                        const f32x2v r = {__builtin_amdgcn_rcpf(d.x), __builtin_amdgcn_rcpf(d.y)}; const f32x2v q = (g * l) * r; o[n][j] = q.x; o[n][j + 1] = q.y; } }
                u32x2 w; w.x = pk4_fp8(o[0][0], o[0][1], o[0][2], o[0][3]); w.y = pk4_fp8(o[1][0], o[1][1], o[1][2], o[1][3]);
                *(u32x2*)rowp = w; }
    }
};
struct EpiDown {
    static constexpr bool PERM = true, KEEPS = false;
    const float* bdn; const int* rslot; const float* gate; unsigned char* SLOT;
    __device__ __forceinline__ void operator()(Acc& acc, const Unit& u, int wr, int wc, int fr, int fq) const {
        const int row0 = u.r0 + wr * 64 + fr, col0 = u.c0 * BM + wc * 32 + 8 * fq; const float* be = bdn + (size_t)u.x * D;
        int sl[2][4]; float gt[2][4];
#pragma unroll
        for (int ai = 0; ai < 2; ++ai)
#pragma unroll
            for (int m = 0; m < 4; ++m) sl[ai][m] = rslot[row0 + ai * HALF + m * 16];
#pragma unroll
        for (int ai = 0; ai < 2; ++ai)
#pragma unroll
            for (int m = 0; m < 4; ++m) gt[ai][m] = gate[sl[ai][m] < 0 ? 0 : sl[ai][m]] * 16.0f;
        f32x4 bv[2][2];
#pragma unroll
        for (int bj = 0; bj < 2; ++bj)
#pragma unroll
            for (int n = 0; n < 2; ++n) bv[bj][n] = *(const f32x4*)(be + col0 + bj * HALF + 4 * n);
#pragma unroll
        for (int ai = 0; ai < 2; ++ai)
#pragma unroll
            for (int m = 0; m < 4; ++m) {
                if (sl[ai][m] >= 0) { const float g = gt[ai][m]; unsigned char* rowp = SLOT + (size_t)sl[ai][m] * D + col0;
#pragma unroll
                    for (int bj = 0; bj < 2; ++bj) { const f32x4 v0 = (acc[ai][bj][m][0] + bv[bj][0]) * g, v1 = (acc[ai][bj][m][1] + bv[bj][1]) * g;
                        u32x2 w; w.x = pk4_fp8(v0[0], v0[1], v0[2], v0[3]); w.y = pk4_fp8(v1[0], v1[1], v1[2], v1[3]);
                        *(u32x2*)(rowp + bj * HALF) = w; } } }
    }
};
}

struct Frame {
    LAS unsigned char* lds;
    int tid, lane, wave, vcu, G;
};

__device__ __forceinline__ void cvt_item_addr(const float* W, int K, int N, bf16_t* WT, int row_off, int item, int lane, const float*& src, bf16_t*& dst) {
    const int nblk = N >> 5, kb = item / nblk, nb = item - kb * nblk, kl = lane >> 3, nl = lane & 7;
    src = W + (size_t)(64 * kb + 8 * kl) * N + 32 * nb + 4 * nl; dst = WT + (size_t)(row_off + 32 * nb + 4 * nl) * K + 64 * kb + 8 * kl;
}
__device__ __forceinline__ void cvt_store(const f32x4 (&v)[8], bf16_t* dst, int K) {
#pragma unroll
    for (int i = 0; i < 4; ++i) { u32x4 o; o.x = cvt_pk_bf16(v[0][i], v[1][i]); o.y = cvt_pk_bf16(v[2][i], v[3][i]); o.z = cvt_pk_bf16(v[4][i], v[5][i]); o.w = cvt_pk_bf16(v[6][i], v[7][i]);
        *(u32x4*)(dst + (size_t)i * K) = o; }
}
__device__ __forceinline__ void cvt_store8(const f32x4 (&v)[8], unsigned char* dst, int K) {
#pragma unroll
    for (int i = 0; i < 4; ++i) { u32x2 o; o.x = pk4_fp8(v[0][i] * 64.f, v[1][i] * 64.f, v[2][i] * 64.f, v[3][i] * 64.f); o.y = pk4_fp8(v[4][i] * 64.f, v[5][i] * 64.f, v[6][i] * 64.f, v[7][i] * 64.f);
        __builtin_nontemporal_store(o, (u32x2*)(dst + (size_t)i * K)); }
}
__device__ __forceinline__ void cvt_range(const float* W, int K, int N, bf16_t* WT, int row_off, int i0, int cnt, int r, int nw, int lane) {
    int it = i0 + r; const int end = i0 + cnt;
    for (; it + nw < end; it += 2 * nw) {
        const float* s0; bf16_t* d0; const float* s1; bf16_t* d1;
        cvt_item_addr(W, K, N, WT, row_off, it, lane, s0, d0); cvt_item_addr(W, K, N, WT, row_off, it + nw, lane, s1, d1);
        f32x4 a[8], b[8];
#pragma unroll
        for (int j = 0; j < 8; ++j) a[j] = __builtin_nontemporal_load((const f32x4*)(s0 + (size_t)j * N));
#pragma unroll
        for (int j = 0; j < 8; ++j) b[j] = __builtin_nontemporal_load((const f32x4*)(s1 + (size_t)j * N));
        cvt_store(a, d0, K); cvt_store(b, d1, K);
    }
    if (it < end) { const float* s0; bf16_t* d0; cvt_item_addr(W, K, N, WT, row_off, it, lane, s0, d0); f32x4 a[8];
#pragma unroll
        for (int j = 0; j < 8; ++j) a[j] = __builtin_nontemporal_load((const f32x4*)(s0 + (size_t)j * N));
        cvt_store(a, d0, K); }
}
constexpr int CV_UP = NE * (D / 64) * (2 * DFF / 32), CV_DN = NE * (DFF / 64) * (D / 32), CV_ALL = CV_UP + CV_DN;
struct MoeW { const float* w_up; const float* w_down; unsigned char* WUPT; unsigned char* WDNT; };
__device__ __forceinline__ void cvt_moe_addr(const MoeW& mw, int chunk, int w, int h, int lane, const float*& src, unsigned char*& dst, int& N) {
    const int kl = lane >> 3, nl = lane & 7;
    if (chunk < CV_UP / 64) { const int e = chunk >> 6, cc = chunk & 63, kb = 8 * (cc >> 4) + w, nb = 8 * (cc & 15) + h; N = 2 * DFF;
        src = mw.w_up + (size_t)e * D * 2 * DFF + (size_t)(64 * kb + 8 * kl) * (2 * DFF) + 32 * nb + 4 * nl; dst = mw.WUPT + (size_t)e * 2 * DFF * D + (size_t)(32 * nb + 4 * nl) * D + 64 * kb + 8 * kl; }
    else { const int q = chunk - CV_UP / 64, e = q >> 5, cc = q & 31, kb = 8 * (cc >> 3) + w, nb = 8 * (cc & 7) + h; N = D;
        src = mw.w_down + (size_t)e * DFF * D + (size_t)(64 * kb + 8 * kl) * D + 32 * nb + 4 * nl; dst = mw.WDNT + (size_t)e * D * DFF + (size_t)(32 * nb + 4 * nl) * DFF + 64 * kb + 8 * kl; }
}
__device__ __forceinline__ f32x4 ld_nt(const float* p) { return __builtin_nontemporal_load((const f32x4*)p); }
constexpr int CV_WG = 64;
__device__ __forceinline__ int cvt_claim(unsigned* cursor, int cap, unsigned* done, unsigned need) {
    if (done && __hip_atomic_load(done, __ATOMIC_RELAXED, __HIP_MEMORY_SCOPE_AGENT) >= need) return CV_ALL;
    if ((int)__hip_atomic_load(cursor, __ATOMIC_RELAXED, __HIP_MEMORY_SCOPE_AGENT) >= cap) return CV_ALL;
    return (int)__hip_atomic_fetch_add(cursor, (unsigned)CV_WG, __ATOMIC_RELAXED, __HIP_MEMORY_SCOPE_AGENT);
}
__device__ __forceinline__ void cvt_pull(const MoeW& mw, unsigned* cursor, int cap, unsigned* done, unsigned need, volatile LAS int* slot, int tid, int wave, int lane) {
    __syncthreads();
    if (tid == 0) *slot = cvt_claim(cursor, cap, done, need);
    __syncthreads();
    int base = __builtin_amdgcn_readfirstlane(*slot);
    while (base < CV_ALL) {
        int nb = CV_ALL; if (tid == 0) nb = cvt_claim(cursor, cap, done, need);
        const int chunk = base >> 6;
        if (chunk < CV_UP / 64) {
            const int e = chunk >> 6, cc = chunk & 63, nb = 8 * (cc & 15) + wave, kl = lane >> 3, nl = lane & 7;
#pragma unroll 1
            for (int q = 0; q < 2; ++q) { const int kq = 2 * (cc >> 4) + q, kb32 = 8 * kq + kl;
                const float* src = mw.w_up + (size_t)e * D * 2 * DFF + (size_t)(32 * kb32) * (2 * DFF) + 32 * nb + 4 * nl;
                f32x4 a[32];
#pragma unroll
                for (int j = 0; j < 32; ++j) a[j] = ld_nt(src + (size_t)j * (2 * DFF));
                unsigned char* dst = mw.WUPT + (size_t)e * 2 * DFF * D + (size_t)(32 * nb + 4 * nl) * D + 128 * (kb32 >> 2) + 16 * (kb32 & 3);
#pragma unroll
                for (int i = 0; i < 4; ++i) { f32x16 lo, hi;
#pragma unroll
                    for (int j = 0; j < 16; ++j) { lo[j] = a[j][i] * 64.f; hi[j] = a[16 + j][i] * 64.f; }
                    { const v6i32 b6 = pk32_fp6(lo, hi); unsigned char* pp = dst + (size_t)i * D; __builtin_nontemporal_store((u32x4){(unsigned)b6[0], (unsigned)b6[1], (unsigned)b6[2], (unsigned)b6[3]}, (u32x4*)pp); __builtin_nontemporal_store((u32x4){(unsigned)b6[4], (unsigned)b6[5], 0u, 0u}, (u32x4*)(pp + 64)); } } }
        } else
#pragma unroll
        for (int h = 0; h < 8; h += 4) {
            const float* s0; unsigned char* d0; const float* s1; unsigned char* d1; const float* s2; unsigned char* d2; const float* s3; unsigned char* d3; int N0, N1, N2, N3;
            cvt_moe_addr(mw, chunk, wave, h, lane, s0, d0, N0); cvt_moe_addr(mw, chunk, wave, h + 1, lane, s1, d1, N1); cvt_moe_addr(mw, chunk, wave, h + 2, lane, s2, d2, N2); cvt_moe_addr(mw, chunk, wave, h + 3, lane, s3, d3, N3);
            f32x4 a[8], b[8], c[8], d[8];
#pragma unroll
            for (int j = 0; j < 8; ++j) a[j] = ld_nt(s0 + (size_t)j * N0);
#pragma unroll
            for (int j = 0; j < 8; ++j) b[j] = ld_nt(s1 + (size_t)j * N1);
#pragma unroll
            for (int j = 0; j < 8; ++j) c[j] = ld_nt(s2 + (size_t)j * N2);
#pragma unroll
            for (int j = 0; j < 8; ++j) d[j] = ld_nt(s3 + (size_t)j * N3);
            cvt_store8(a, d0, D); cvt_store8(b, d1, D); cvt_store8(c, d2, D); cvt_store8(d, d3, D);
        }
        __syncthreads();
        if (tid == 0) *slot = nb;
        __syncthreads();
        base = __builtin_amdgcn_readfirstlane(*slot);
    }
}
template <bool NT = false>
__device__ __forceinline__ void rms_row_to_bf16(const float* xrow, const float* gvec, bf16_t* orow, int lane) {
    const f32x4* xr = (const f32x4*)xrow + lane; const f32x4* gr = (const f32x4*)gvec + lane; f32x4 v[8], g[8]; float s = 0.f;
#pragma unroll
    for (int j = 0; j < 8; ++j) { v[j] = NT ? __builtin_nontemporal_load(xr + 64 * j) : xr[64 * j]; g[j] = gr[64 * j]; }
#pragma unroll
    for (int j = 0; j < 8; ++j) s += (v[j].x * v[j].x + v[j].y * v[j].y) + (v[j].z * v[j].z + v[j].w * v[j].w);
    const float rstd = 1.0f / sqrtf(wave_sum(s) * (1.0f / D) + RMS_EPS);
    u32x2* o8 = (u32x2*)orow + lane;
#pragma unroll
    for (int j = 0; j < 8; ++j) { const f32x4 y = v[j] * rstd * g[j]; u32x2 w; w.x = cvt_pk_bf16(y.x, y.y); w.y = cvt_pk_bf16(y.z, y.w); o8[64 * j] = w; }
}

__device__ __forceinline__ unsigned voff_b(unsigned row, unsigned ch) { return 256u * row + 16u * (ch ^ (((row & 3u) << 2) | ((row >> 2) & 3u))); }
__device__ __forceinline__ s16x4 vtr(const LAS unsigned char* p) { return __builtin_bit_cast(s16x4, __builtin_amdgcn_ds_read_tr16_b64_v4i16((LAS s16x4*)p)); }

__device__ __forceinline__ void sb_wg_unit(const bf16_t* PG, bf16_t* OA, int h, int qb, LAS unsigned char* lds, volatile LAS int* flags, int tid, int wave, int lane) {
    const int fr = lane & 15, fq = lane >> 4, q0w = qb * 128 + wave * 16, qi = q0w + fr;
    bf16x8 Qf[4];
    { const bf16_t* qp = PG + (size_t)qi * NP1 + h * HD + 8 * fq;
#pragma unroll
      for (int ks = 0; ks < 4; ++ks) Qf[ks] = *(const bf16x8*)(qp + 32 * ks); }
    f32x4 O[8];
#pragma unroll
    for (int db = 0; db < 8; ++db) O[db] = (f32x4){0.f, 0.f, 0.f, 0.f};
    float carry = 0.f; bool sat = false;
    const float scale = 0.08838834764831845f;
    const unsigned p = fr & 3, qq = fr >> 2;
    const int jt_hi = 2 * qb + 1, jt_w = q0w >> 6;
    const int srow = tid >> 4, sch = tid & 15;
    const bf16_t* kg = PG + (size_t)srow * NP1 + SBW + h * HD + 8 * sch;
    u32x4 kr[2], vr[2];
    __syncthreads();
    if (tid < 8) flags[tid] = 0;
    { const bf16_t* g = kg + (size_t)(jt_hi * 64) * NP1;
#pragma unroll
      for (int i = 0; i < 2; ++i) { kr[i] = *(const u32x4*)(g + (size_t)(32 * i) * NP1); vr[i] = *(const u32x4*)(g + (size_t)(32 * i) * NP1 + SBW); } }
    for (int jt = jt_hi, it = 0; jt >= 0; --jt, ++it) {
        LAS unsigned char* kb = lds + (it & 1) * 32768; LAS unsigned char* vb = kb + 16384;
#pragma unroll
        for (int i = 0; i < 2; ++i) { *(LAS u32x4*)(kb + voff_b(srow + 32 * i, sch)) = kr[i]; *(LAS u32x4*)(vb + voff_b(srow + 32 * i, sch)) = vr[i]; }
        __syncthreads();
        { int ns = 0;
#pragma unroll
          for (int w = 0; w < 8; ++w) ns += flags[w];
          if (__builtin_amdgcn_readfirstlane(ns) == 8) break; }
        if (jt > 0) { const bf16_t* g = kg + (size_t)((jt - 1) * 64) * NP1;
#pragma unroll
            for (int i = 0; i < 2; ++i) { kr[i] = *(const u32x4*)(g + (size_t)(32 * i) * NP1); vr[i] = *(const u32x4*)(g + (size_t)(32 * i) * NP1 + SBW); } }
        if (!sat && jt <= jt_w) {
            const int key0 = jt * 64;
            f32x4 z[4];
#pragma unroll
            for (int sb = 0; sb < 4; ++sb) { z[sb] = (f32x4){0.f, 0.f, 0.f, 0.f};
#pragma unroll
                for (int ks = 0; ks < 4; ++ks) { const bf16x8 kf = *(const LAS bf16x8*)(kb + voff_b(16 * sb + fr, 4 * ks + fq)); z[sb] = __builtin_amdgcn_mfma_f32_16x16x32_bf16(kf, Qf[ks], z[sb], 0, 0, 0); } }
            float sfx[4][4], g[4], lex[4], T[4];
            const bool diag = key0 + 64 > q0w;
#pragma unroll
            for (int sb = 0; sb < 4; ++sb) {
                float sp[4];
#pragma unroll
                for (int i = 0; i < 4; ++i) { const float y = z[sb][i] * (scale * 1.4426950408889634f); z[sb][i] = y;
                    sp[i] = fmaxf(y, 0.f) + __builtin_amdgcn_logf(1.0f + __builtin_amdgcn_exp2f(-fabsf(y))); }
                if (diag) {
#pragma unroll
                    for (int i = 0; i < 4; ++i) { const int key = key0 + 16 * sb + 4 * fq + i; sp[i] = (key < qi) ? sp[i] : 0.f; } }
                sfx[sb][3] = sp[3]; sfx[sb][2] = sp[2] + sfx[sb][3]; sfx[sb][1] = sp[1] + sfx[sb][2]; sfx[sb][0] = sp[0] + sfx[sb][1]; g[sb] = sfx[sb][0];
            }
#pragma unroll
            for (int sb = 0; sb < 4; ++sb) { const float x1 = __shfl_xor(g[sb], 16), x2 = __shfl_xor(g[sb], 32), x3 = __shfl_xor(g[sb], 48);
                T[sb] = (g[sb] + x1) + (x2 + x3); lex[sb] = ((fq & 1) ? 0.f : x1) + ((fq < 2) ? (x2 + x3) : 0.f); }
            float run = carry; bf16x8 Wf[2]; unsigned wpk[8];
#pragma unroll
            for (int sb = 3; sb >= 0; --sb) { const float base = run + lex[sb]; float w[4];
#pragma unroll
                for (int i = 0; i < 4; ++i) w[i] = __builtin_amdgcn_exp2f(z[sb][i] - (base + sfx[sb][i]));
                if (diag) {
#pragma unroll
                    for (int i = 0; i < 4; ++i) { const int key = key0 + 16 * sb + 4 * fq + i; w[i] = (key < qi) ? w[i] : 0.f; } }
                wpk[2 * sb] = cvt_pk_bf16(w[0], w[1]); wpk[2 * sb + 1] = cvt_pk_bf16(w[2], w[3]); run += T[sb]; }
            carry = run;
            { u32x4 a = {wpk[0], wpk[1], wpk[2], wpk[3]}, b = {wpk[4], wpk[5], wpk[6], wpk[7]}; Wf[0] = __builtin_bit_cast(bf16x8, a); Wf[1] = __builtin_bit_cast(bf16x8, b); }
#pragma unroll
            for (int db = 0; db < 8; ++db)
#pragma unroll
                for (int m = 0; m < 2; ++m) { const unsigned r1 = 32 * m + 4 * fq + qq, r2 = r1 + 16;
                    const s16x4 lo = vtr(vb + voff_b(r1, 2 * db + (p >> 1)) + 8 * (p & 1)), hi = vtr(vb + voff_b(r2, 2 * db + (p >> 1)) + 8 * (p & 1));
                    const bf16x8 vf = {lo[0], lo[1], lo[2], lo[3], hi[0], hi[1], hi[2], hi[3]};
                    O[db] = __builtin_amdgcn_mfma_f32_16x16x32_bf16(vf, Wf[m], O[db], 0, 0, 0); }
            if (__all(carry > 150.1f)) { sat = true; if (lane == 0) flags[wave] = 1; }
        }
    }
    { bf16_t* op = OA + (size_t)qi * SBW + h * HD + 4 * fq;
#pragma unroll
      for (int db = 0; db < 8; ++db) { u32x2 w; w.x = cvt_pk_bf16(O[db][0], O[db][1]); w.y = cvt_pk_bf16(O[db][2], O[db][3]); *(u32x2*)(op + 16 * db) = w; } }
}

__device__ __forceinline__ void xa_unit(const bf16_t* QXA, const bf16_t* KVM, bf16_t* OXA, int h, int qb, const LAS unsigned char* vl, int lane) {
    const int fr = lane & 15, fq = lane >> 4, q0 = qb * 16, qi = q0 + fr;
    bf16x8 Qf[4];
    { const bf16_t* qp = QXA + (size_t)qi * XAW + h * HD + 8 * fq;
#pragma unroll
      for (int ks = 0; ks < 4; ++ks) Qf[ks] = *(const bf16x8*)(qp + 32 * ks); }
    f32x4 z[16];
    { const bf16_t* kp = KVM + (size_t)fr * (2 * XAW) + h * HD + 8 * fq;
#pragma unroll
      for (int sb = 0; sb < 16; ++sb) { z[sb] = (f32x4){0.f, 0.f, 0.f, 0.f};
#pragma unroll
          for (int ks = 0; ks < 4; ++ks) { const bf16x8 kf = *(const bf16x8*)(kp + (size_t)(16 * sb) * (2 * XAW) + 32 * ks); z[sb] = __builtin_amdgcn_mfma_f32_16x16x32_bf16(kf, Qf[ks], z[sb], 0, 0, 0); } } }
    const float scale = 0.08838834764831845f * 1.4426950408889634f;
    float mx = -3.0e38f;
#pragma unroll
    for (int sb = 0; sb < 16; ++sb)
#pragma unroll
        for (int i = 0; i < 4; ++i) { z[sb][i] *= scale; mx = fmaxf(mx, z[sb][i]); }
    mx = fmaxf(mx, __shfl_xor(mx, 16)); mx = fmaxf(mx, __shfl_xor(mx, 32));
    float sum = 0.f;
#pragma unroll
    for (int sb = 0; sb < 16; ++sb)
#pragma unroll
        for (int i = 0; i < 4; ++i) { const float e = __builtin_amdgcn_exp2f(z[sb][i] - mx); z[sb][i] = e; sum += e; }
    sum += __shfl_xor(sum, 16); sum += __shfl_xor(sum, 32);
    const float inv = 1.0f / sum;
    f32x4 O[8];
#pragma unroll
    for (int db = 0; db < 8; ++db) O[db] = (f32x4){0.f, 0.f, 0.f, 0.f};
    const unsigned p = fr & 3, qq = fr >> 2;
#pragma unroll
    for (int m = 0; m < 8; ++m) {
        u32x4 a = {cvt_pk_bf16(z[2 * m][0], z[2 * m][1]), cvt_pk_bf16(z[2 * m][2], z[2 * m][3]), cvt_pk_bf16(z[2 * m + 1][0], z[2 * m + 1][1]), cvt_pk_bf16(z[2 * m + 1][2], z[2 * m + 1][3])};
        const bf16x8 Wf = __builtin_bit_cast(bf16x8, a);
#pragma unroll
        for (int db = 0; db < 8; ++db) { const unsigned r1 = 32 * m + 4 * fq + qq, r2 = r1 + 16;
            const s16x4 lo = vtr(vl + voff_b(r1, 2 * db + (p >> 1)) + 8 * (p & 1)), hi = vtr(vl + voff_b(r2, 2 * db + (p >> 1)) + 8 * (p & 1));
            const bf16x8 vf = {lo[0], lo[1], lo[2], lo[3], hi[0], hi[1], hi[2], hi[3]};
            O[db] = __builtin_amdgcn_mfma_f32_16x16x32_bf16(vf, Wf, O[db], 0, 0, 0); }
    }
    { bf16_t* op = OXA + (size_t)qi * XAW + h * HD + 4 * fq;
#pragma unroll
      for (int db = 0; db < 8; ++db) { const f32x4 o = O[db] * inv; u32x2 w; w.x = cvt_pk_bf16(o[0], o[1]); w.y = cvt_pk_bf16(o[2], o[3]); *(u32x2*)(op + 16 * db) = w; } }
}

template <int W>
__device__ __forceinline__ void pool_run(const bf16_t* PG, bf16_t* PO, int t0, int ch) {
    constexpr int NR = W + 7;
    const bf16_t* pp = PG + (size_t)(t0 + 7) * NP1 + 3 * SBW + ch * 8;
    u32x4 v[NR];
#pragma unroll
    for (int k = 0; k < NR; ++k) v[k] = (t0 + 7 - k >= 0) ? *(const u32x4*)(pp - (size_t)k * NP1) : (u32x4){0u, 0u, 0u, 0u};
#pragma unroll
    for (int i = 0; i < 8; ++i) {
        float s[8];
#pragma unroll
        for (int j = 0; j < 8; ++j) s[j] = 0.f;
#pragma unroll
        for (int j = W - 1; j >= 0; --j) { const u32x4 x = v[7 - i + j];
            s[0] += bf_lo(x.x); s[1] += bf_hi(x.x); s[2] += bf_lo(x.y); s[3] += bf_hi(x.y); s[4] += bf_lo(x.z); s[5] += bf_hi(x.z); s[6] += bf_lo(x.w); s[7] += bf_hi(x.w); }
        const int t = t0 + i, n = (t + 1 < W) ? (t + 1) : W; const float inv = 1.0f / (float)n; const u32x4 me = v[7 - i]; u32x4 o;
        o.x = cvt_pk_bf16(s[0] * inv - bf_lo(me.x), s[1] * inv - bf_hi(me.x)); o.y = cvt_pk_bf16(s[2] * inv - bf_lo(me.y), s[3] * inv - bf_hi(me.y));
        o.z = cvt_pk_bf16(s[4] * inv - bf_lo(me.z), s[5] * inv - bf_hi(me.z)); o.w = cvt_pk_bf16(s[6] * inv - bf_lo(me.w), s[7] * inv - bf_hi(me.w));
        *(u32x4*)(PO + (size_t)t * POOLW + ch * 8) = o;
    }
}

constexpr int NPHASE = 15;
struct Args { const float* in[24]; float* out; unsigned char* ws; int ph_lo, ph_hi; };
static_assert(sizeof(Args) == 24 * 8 + 8 + 8 + 8, "Args has no padding");

__global__ void __launch_bounds__(NWAVES * 64, 2) moe_fwd(Args args) {
    extern __shared__ __attribute__((aligned(16))) unsigned char lds_raw[];
    Frame F;
    F.lds = (LAS unsigned char*)lds_raw;
    F.tid = threadIdx.x; F.lane = F.tid & 63; F.wave = __builtin_amdgcn_readfirstlane(F.tid >> 6);
    F.G = gridDim.x; { const int bx = blockIdx.x; F.vcu = (F.G % 8 == 0) ? (bx % 8) * (F.G / 8) + bx / 8 : bx; }
    unsigned char* ws = args.ws;
    unsigned* ctl = (unsigned*)(ws + WS_CTL);
    LAS unsigned char* lx = F.lds + LDS_X_OFF;
    for (int u = F.tid; u < (LDS_BYTES - LDS_X_OFF) / 4; u += NWAVES * 64) ((LAS unsigned*)lx)[u] = 0u;
    __syncthreads();
#if MK_ONE_LAUNCH
    XcdBarrier bar = xcd_barrier_post(ctl + CW_BAR, (volatile LAS unsigned*)(lx + LX_BAR));
#define GRID_BAR() xcd_barrier(bar)
#else
#define GRID_BAR() do {} while (0)
#endif
    const int lo = args.ph_lo, hi = args.ph_hi;
#ifndef PHASE_MASK
#define PHASE_MASK 0x7fff
#endif
#define IN(k) (((PHASE_MASK >> (k)) & 1) && lo <= (k) && (k) < hi)
#define SEAM(k) do { if (IN((k) + 1)) GRID_BAR(); } while (0)

    const float* x = args.in[0]; const float* mem = args.in[1]; const float* norm_mix = args.in[2]; const float* w_in = args.in[3]; const float* pool_lin = args.in[4];
    const float* pool_scale = args.in[5]; const float* w_branch_a = args.in[6]; const float* w_branch_b = args.in[7]; const float* w_gate = args.in[8]; const float* b_gate = args.in[9];
    const float* w_mix_out = args.in[10]; const float* xa_norm = args.in[11]; const float* mem_norm = args.in[12]; const float* xa_wq = args.in[13]; const float* xa_wkv = args.in[14];
    const float* xa_wo = args.in[15]; const float* moe_norm = args.in[16]; const float* w_router = args.in[17]; const float* b_router = args.in[18]; const float* w_up = args.in[19];
    const float* b_up = args.in[20]; const float* w_down = args.in[21]; const float* b_down = args.in[22]; const float* final_norm = args.in[23];
    bf16_t* W1T = (bf16_t*)(ws + WS_W1T); bf16_t* WAT = (bf16_t*)(ws + WS_WAT); bf16_t* WBT = (bf16_t*)(ws + WS_WBT); bf16_t* WMT = (bf16_t*)(ws + WS_WMT); bf16_t* PLT = (bf16_t*)(ws + WS_PLT);
    bf16_t* WQT = (bf16_t*)(ws + WS_WQT); bf16_t* WKVT = (bf16_t*)(ws + WS_WKVT); bf16_t* WOT = (bf16_t*)(ws + WS_WOT); unsigned char* WUPT = ws + WS_WUPT; unsigned char* WDNT = ws + WS_WDNT;
    bf16_t* U = (bf16_t*)(ws + WS_U); bf16_t* MEMN = (bf16_t*)(ws + WS_MEMN); bf16_t* PG = (bf16_t*)(ws + WS_PG); bf16_t* OA = (bf16_t*)(ws + WS_OA); bf16_t* PO = (bf16_t*)(ws + WS_PO);
    bf16_t* OB = (bf16_t*)(ws + WS_OB); float* TMP = (float*)(ws + WS_TMP); bf16_t* MG = (bf16_t*)(ws + WS_MG); bf16_t* H1 = (bf16_t*)(ws + WS_H1); bf16_t* U2 = (bf16_t*)(ws + WS_U2);
    bf16_t* QXA = (bf16_t*)(ws + WS_QXA); bf16_t* KVM = (bf16_t*)(ws + WS_KVM); bf16_t* OXA = (bf16_t*)(ws + WS_OXA); bf16_t* H2 = (bf16_t*)(ws + WS_H2); unsigned char* TB = ws + WS_TB;
    bf16_t* ROWS = (bf16_t*)(ws + WS_ROWS); unsigned char* ACT = ws + WS_ACT; unsigned char* SLOT = ws + WS_SLOT;
    int* ASGE = (int*)(ws + WS_ASGE); int* ASGP = (int*)(ws + WS_ASGP); float* GATE = (float*)(ws + WS_GATE); int* RSLOT = (int*)(ws + WS_RSLOT);
    int* CNT = (int*)(ctl + CW_CNT); bf16_t* WRT = (bf16_t*)(ws + WS_WRT);
    const int gw = F.vcu * NWAVES + F.wave, NGW = F.G * NWAVES;
    const MoeW mw{w_up, w_down, WUPT, WDNT};
    unsigned* CUR = ctl + CW_CUR; volatile LAS int* cvs = (volatile LAS int*)(lx + LX_CVS);
#define CVT_PULL(cap) cvt_pull(mw, CUR, (cap), nullptr, 0u, cvs, F.tid, F.wave, F.lane)
#define CVT_BESIDE(cap, ph, need) cvt_pull(mw, CUR, (cap), ctl + CW_DONE + 64 * (ph), (unsigned)(need), cvs, F.tid, F.wave, F.lane)
#define MARK_DONE(ph) do { if (F.tid == 0) __hip_atomic_fetch_add(ctl + CW_DONE + 64 * (ph), 1u, __ATOMIC_RELAXED, __HIP_MEMORY_SCOPE_AGENT); } while (0)

    if (IN(0)) {
        constexpr int I_IN = (D / 64) * (INW / 32), I_BR = (SBW / 64) * (D / 32), I_MX = (D / 64) * (D / 32), I_PL = (256 / 64) * (256 / 32);
        constexpr int I_Q = (D / 64) * (XAW / 32), I_KV = (D / 64) * (2 * XAW / 32), I_O = (XAW / 64) * (D / 32);
        cvt_range(w_in, D, INW, W1T, 0, 0, I_IN, gw, NGW, F.lane);
        cvt_range(w_gate, D, INW, W1T, INW, 0, I_IN, gw, NGW, F.lane);
        for (int m = gw; m < S; m += NGW) rms_row_to_bf16<true>(x + (size_t)m * D, norm_mix, U + (size_t)m * D, F.lane);
        for (int m = gw; m < MEM; m += NGW) rms_row_to_bf16(mem + (size_t)m * D, mem_norm, MEMN + (size_t)m * D, F.lane);
        for (int i = blockIdx.x * (NWAVES * 64) + F.tid; i < NE * D / 2; i += F.G * NWAVES * 64) {
            const int e = i >> 10, c = (i & 1023) * 2; const float a = w_router[(size_t)c * NE + e], b = w_router[(size_t)(c + 1) * NE + e];
            const unsigned hi = cvt_pk_bf16(a, b); const unsigned lo = cvt_pk_bf16(a - bf_lo(hi), b - bf_hi(hi));
            *(unsigned*)(WRT + (size_t)e * D + c) = hi; *(unsigned*)(WRT + (size_t)(NE + e) * D + c) = lo; }
        __syncthreads();
        SEAM(0);
    }

    if (IN(1)) {
        const int gc = (F.G == 256) ? GC_P1 : F.G;
        if ((int)blockIdx.x < gc) {
            pg8::DenseSched Sc{(const char*)U, (const char*)W1T, D, D, S / 256, NP1 / 256, gc, (int)blockIdx.x};
            pg8::EpiProj E{PG, b_gate};
            pg8::gemm_phase<pg8::EpiProj, pg8::DenseSched, true>(F.lds, D, D, D, Sc, E);
            MARK_DONE(1);
        }
        if ((int)blockIdx.x >= gc) {
            constexpr int I_BR = (SBW / 64) * (D / 32), I_MX = (D / 64) * (D / 32), I_PL = (256 / 64) * (256 / 32), I_Q = (D / 64) * (XAW / 32), I_KV = (D / 64) * (2 * XAW / 32), I_O = (XAW / 64) * (D / 32);
            const int cr = ((int)blockIdx.x - gc) * NWAVES + F.wave, cn = (F.G - gc) * NWAVES;
        cvt_range(w_branch_a, SBW, D, WAT, 0, 0, I_BR, cr, cn, F.lane);
        cvt_range(w_branch_b, POOLW, D, WBT, 0, 0, I_BR, cr, cn, F.lane);
        cvt_range(w_mix_out, D, D, WMT, 0, 0, I_MX, cr, cn, F.lane);
        for (int g = 0; g < 4; ++g) cvt_range(pool_lin + (size_t)g * 65536, 256, 256, PLT + (size_t)g * 65536, 0, 0, I_PL, cr, cn, F.lane);
        cvt_range(xa_wq, D, XAW, WQT, 0, 0, I_Q, cr, cn, F.lane);
        cvt_range(xa_wkv, D, 2 * XAW, WKVT, 0, 0, I_KV, cr, cn, F.lane);
        cvt_range(xa_wo, XAW, D, WOT, 0, 0, I_O, cr, cn, F.lane);
        }
        CVT_BESIDE(CV_UP, 1, gc);
        SEAM(1);
    }

    if (IN(2)) {
        for (int it = blockIdx.x * (NWAVES * 64) + F.tid; it < (S / 8) * (POOLW / 8); it += F.G * NWAVES * 64) {
            const int wv = it >> 6, g = wv & 3, rb = (wv >> 2) * 2 + (F.lane >> 5), ch = g * 32 + (F.lane & 31), t0 = rb * 8;
            if (g == 0) pool_run<2>(PG, PO, t0, ch); else if (g == 1) pool_run<4>(PG, PO, t0, ch); else if (g == 2) pool_run<8>(PG, PO, t0, ch); else pool_run<16>(PG, PO, t0, ch);
        }
        for (int it = F.vcu; it < SBH * (S / 128); it += F.G) { const int h = it & 7, qb = (S / 128 - 1) - (it >> 3); sb_wg_unit(PG, OA, h, qb, F.lds, (volatile LAS int*)(lx + LX_SBF), F.tid, F.wave, F.lane); }
        __syncthreads();
        SEAM(2);
    }

    if (IN(3)) {
        pg8::PoolSched Sc{(const char*)PO, (const char*)PLT, F.G, F.vcu};
        pg8::EpiBf16 E{OB, POOLW, pool_scale};
        pg8::gemm_phase<pg8::EpiBf16, pg8::PoolSched, true>(F.lds, 256, POOLW, 256, Sc, E);
        if (F.vcu < (S / 256) * 4) MARK_DONE(3);
        CVT_BESIDE(CV_UP, 3, (S / 256) * 4);
        SEAM(3);
    }

    if (IN(4)) {
        pg8::BranchSched Sc{(const char*)OA, (const char*)OB, (const char*)WAT, (const char*)WBT, SBW, SBW, S / 256, D / 256, F.G, (int)blockIdx.x};
        pg8::EpiBranch E{PG, MG};
        pg8::gemm_phase<pg8::EpiBranch, pg8::BranchSched, true>(F.lds, SBW, SBW, SBW, Sc, E);
        SEAM(4);
    }

    if (IN(5)) {
        pg8::DenseSched Sc{(const char*)MG, (const char*)WMT, D, D, S / 256, D / 256, F.G, (int)blockIdx.x};
        pg8::EpiResidT<false, true> E{x, H1, D};
        pg8::gemm_phase<pg8::EpiResidT<false, true>, pg8::DenseSched, true>(F.lds, D, D, D, Sc, E);
        SEAM(5);
    }

    if (IN(6)) {
        { f32x4 g[4][2];
#pragma unroll
          for (int j = 0; j < 4; ++j) { g[j][0] = *((const f32x4*)xa_norm + 2 * (F.lane + 64 * j)); g[j][1] = *((const f32x4*)xa_norm + 2 * (F.lane + 64 * j) + 1); }
          for (int m = gw; m < S; m += NGW) {
            const u32x4* xr = (const u32x4*)(H1 + (size_t)m * D) + F.lane; u32x4 v[4]; float sq = 0.f;
#pragma unroll
            for (int j = 0; j < 4; ++j) v[j] = xr[64 * j];
#pragma unroll
            for (int j = 0; j < 4; ++j) { const float f[8] = {bf_lo(v[j].x), bf_hi(v[j].x), bf_lo(v[j].y), bf_hi(v[j].y), bf_lo(v[j].z), bf_hi(v[j].z), bf_lo(v[j].w), bf_hi(v[j].w)};
#pragma unroll
                for (int q = 0; q < 8; ++q) sq += f[q] * f[q]; }
            const float rstd = 1.0f / sqrtf(wave_sum(sq) * (1.0f / D) + RMS_EPS);
            u32x4* o = (u32x4*)(U2 + (size_t)m * D) + F.lane;
#pragma unroll
            for (int j = 0; j < 4; ++j) { const f32x4 g0 = g[j][0], g1 = g[j][1]; u32x4 w;
                w.x = cvt_pk_bf16(bf_lo(v[j].x) * rstd * g0.x, bf_hi(v[j].x) * rstd * g0.y); w.y = cvt_pk_bf16(bf_lo(v[j].y) * rstd * g0.z, bf_hi(v[j].y) * rstd * g0.w);
                w.z = cvt_pk_bf16(bf_lo(v[j].z) * rstd * g1.x, bf_hi(v[j].z) * rstd * g1.y); w.w = cvt_pk_bf16(bf_lo(v[j].w) * rstd * g1.z, bf_hi(v[j].w) * rstd * g1.w); o[64 * j] = w; }
          } }
        SEAM(6);
    }

    if (IN(7)) {
        { pg8::DenseSched Sc{(const char*)U2, (const char*)WQT, D, D, S / 256, XAW / 256, F.G, (int)blockIdx.x};
          pg8::EpiBf16 E{QXA, XAW, nullptr};
          pg8::gemm_phase<pg8::EpiBf16, pg8::DenseSched, true>(F.lds, D, D, D, Sc, E); }
        { const int c2 = ((int)blockIdx.x >= 64) ? (int)blockIdx.x - 64 : (int)blockIdx.x + F.G - 64;
          pg8::DenseSched Sc{(const char*)MEMN, (const char*)WKVT, D, D, MEM / 256, 2 * XAW / 256, F.G, c2};
          pg8::EpiBf16 E{KVM, 2 * XAW, nullptr};
          pg8::gemm_phase<pg8::EpiBf16, pg8::DenseSched, true>(F.lds, D, D, D, Sc, E); }
        if ((int)blockIdx.x < 68) MARK_DONE(7);
        CVT_BESIDE(CV_UP, 7, 68);
        SEAM(7);
    }

    if (IN(8)) {
        for (int it = F.vcu; it < XAH * (S / 128); it += F.G) {
            const int h = it & 3, qg = it >> 2;
            __syncthreads();
#pragma unroll
            for (int t = 0; t < 8; ++t) { const int c = t * 512 + F.tid, row = c >> 4, ch = c & 15;
                const u32x4 vv = *(const u32x4*)(KVM + (size_t)row * (2 * XAW) + XAW + h * HD + 8 * ch); *(LAS u32x4*)(F.lds + voff_b(row, ch)) = vv; }
            __syncthreads();
            xa_unit(QXA, KVM, OXA, h, qg * 8 + F.wave, F.lds, F.lane);
        }
        __syncthreads();
        SEAM(8);
    }

    if (IN(9)) {
        pg8::DenseSched Sc{(const char*)OXA, (const char*)WOT, XAW, XAW, S / 256, D / 256, F.G, (int)blockIdx.x};
        pg8::EpiResidT<true, true> E{H1, H2, D};
        pg8::gemm_phase<pg8::EpiResidT<true, true>, pg8::DenseSched, true>(F.lds, XAW, XAW, XAW, Sc, E);
        SEAM(9);
    }

    if (IN(10)) {
        for (int i = blockIdx.x * (NWAVES * 64) + F.tid; i < PROWS; i += F.G * NWAVES * 64) RSLOT[i] = -1;
        LAS unsigned char* thi = F.lds;
        LAS float* lg = (LAS float*)(lx + LX_LOG);
        LAS float* part = (LAS float*)(lx + LX_RPART);
        for (int rg = F.vcu; rg < S / 16; rg += F.G) {
            __syncthreads();
#pragma unroll
            for (int rr = 0; rr < 2; ++rr) { const int r = 2 * F.wave + rr, m = rg * 16 + r;
                const u32x2* xr = (const u32x2*)(H2 + (size_t)m * D) + F.lane; f32x4 v[8]; float s = 0.f;
#pragma unroll
                for (int j = 0; j < 8; ++j) { const u32x2 hw = xr[64 * j]; v[j] = (f32x4){bf_lo(hw.x), bf_hi(hw.x), bf_lo(hw.y), bf_hi(hw.y)}; s += (v[j].x * v[j].x + v[j].y * v[j].y) + (v[j].z * v[j].z + v[j].w * v[j].w); }
                const float rstd = 1.0f / sqrtf(wave_sum(s) * (1.0f / D) + RMS_EPS);
                const f32x4* gr = (const f32x4*)moe_norm + F.lane; f32x4 gv[8];
#pragma unroll
                for (int j = 0; j < 8; ++j) gv[j] = gr[64 * j];
#pragma unroll
                for (int j = 0; j < 8; ++j) { const f32x4 g = gv[j]; const f32x4 y = v[j] * rstd * g; u32x2 w; w.x = cvt_pk_bf16(y.x, y.y); w.y = cvt_pk_bf16(y.z, y.w);
                    u32x2 l; l.x = cvt_pk_bf16(y.x - bf_lo(w.x), y.y - bf_hi(w.x)); l.y = cvt_pk_bf16(y.z - bf_lo(w.y), y.w - bf_hi(w.y));
                    const unsigned off = (unsigned)r * 4096u + ((((unsigned)F.lane >> 1) + 32u * j) ^ (unsigned)r) * 16u + (F.lane & 1) * 8u;
                    *(LAS u32x2*)(thi + off) = w; *(LAS u32x2*)(thi + 65536 + off) = l; } }
            __syncthreads();
#pragma unroll
            for (int q = 0; q < 2; ++q) { const int blk = F.tid + 512 * q, r = blk >> 6, kb32 = blk & 63; f32x16 lo, hi;
#pragma unroll
                for (int c4 = 0; c4 < 4; ++c4) { const u32x4 v = *(const LAS u32x4*)(thi + r * 4096 + ((unsigned)((4 * kb32 + c4) ^ r) * 16u));
                    const float f[8] = {bf_lo(v.x), bf_hi(v.x), bf_lo(v.y), bf_hi(v.y), bf_lo(v.z), bf_hi(v.z), bf_lo(v.w), bf_hi(v.w)};
#pragma unroll
                    for (int j = 0; j < 8; ++j) { if (c4 < 2) lo[8 * c4 + j] = f[j] * 2.0f; else hi[8 * (c4 - 2) + j] = f[j] * 2.0f; } }
                st_fp6_block(TB + (size_t)(rg * 16 + r) * D + 128 * (kb32 >> 2) + 16 * (kb32 & 3), pk32_fp6(lo, hi)); }
            { const int fr = F.lane & 15, fq = F.lane >> 4; f32x4 c0 = {0.f, 0.f, 0.f, 0.f}, c1 = {0.f, 0.f, 0.f, 0.f};
              const bf16_t* wh = WRT + (size_t)fr * D + 256 * F.wave + 8 * fq;
#pragma unroll
              for (int st = 0; st < 8; ++st) { const unsigned ch = (unsigned)(32 * F.wave + 4 * st + fq);
                  const bf16x8 ah = *(const LAS bf16x8*)(thi + fr * 4096 + ((ch ^ (unsigned)fr) * 16u)), al = *(const LAS bf16x8*)(thi + 65536 + fr * 4096 + ((ch ^ (unsigned)fr) * 16u));
                  const bf16x8 bh0 = *(const bf16x8*)(wh + 32 * st), bh1 = *(const bf16x8*)(wh + (size_t)16 * D + 32 * st), bl0 = *(const bf16x8*)(wh + (size_t)NE * D + 32 * st), bl1 = *(const bf16x8*)(wh + (size_t)(NE + 16) * D + 32 * st);
                  c0 = __builtin_amdgcn_mfma_f32_16x16x32_bf16(ah, bh0, c0, 0, 0, 0); c1 = __builtin_amdgcn_mfma_f32_16x16x32_bf16(ah, bh1, c1, 0, 0, 0);
                  c0 = __builtin_amdgcn_mfma_f32_16x16x32_bf16(ah, bl0, c0, 0, 0, 0); c1 = __builtin_amdgcn_mfma_f32_16x16x32_bf16(ah, bl1, c1, 0, 0, 0);
                  c0 = __builtin_amdgcn_mfma_f32_16x16x32_bf16(al, bh0, c0, 0, 0, 0); c1 = __builtin_amdgcn_mfma_f32_16x16x32_bf16(al, bh1, c1, 0, 0, 0); }
#pragma unroll
              for (int i = 0; i < 4; ++i) { part[(F.wave * 16 + 4 * fq + i) * 32 + fr] = c0[i]; part[(F.wave * 16 + 4 * fq + i) * 32 + 16 + fr] = c1[i]; } }
            __syncthreads();
            { const int r = F.tid >> 5, e = F.tid & 31; float a = 0.f;
#pragma unroll
              for (int w = 0; w < 8; ++w) a += part[(w * 16 + r) * 32 + e];
              lg[r * 32 + e] = a + b_router[e]; }
            __syncthreads();
            if (F.tid < 16) { const int r = F.tid, m = rg * 16 + r; float l[32];
#pragma unroll
                for (int e = 0; e < 32; ++e) l[e] = lg[r * 32 + e];
                int idx[4]; float val[4]; unsigned taken = 0u;
#pragma unroll
                for (int k = 0; k < 4; ++k) { float best = -3.4e38f; int bi = 0;
#pragma unroll
                    for (int e = 0; e < 32; ++e) { const bool ok = !((taken >> e) & 1u) && (l[e] > best); best = ok ? l[e] : best; bi = ok ? e : bi; }
                    idx[k] = bi; val[k] = best; taken |= 1u << bi; }
                const float e0 = 1.0f, e1 = expf(val[1] - val[0]), e2 = expf(val[2] - val[0]), e3 = expf(val[3] - val[0]); const float inv = 1.0f / (((e0 + e1) + e2) + e3);
                const float gk[4] = {e0 * inv, e1 * inv, e2 * inv, e3 * inv};
#pragma unroll
                for (int k = 0; k < 4; ++k) { const int pos = atomicAdd(CNT + idx[k], 1); ASGE[m * 4 + k] = idx[k]; ASGP[m * 4 + k] = pos; GATE[m * 4 + k] = gk[k]; } }
        }
        __syncthreads();
        SEAM(10);
    }

    LAS int* tab = (LAS int*)(lx + LX_TAB);
#define BUILD_TAB(NT) do { __syncthreads(); if (F.tid == 0) { int us = 0, ps = 0; for (int e = 0; e < NE; ++e) { const int c = CNT[e], nb = (c + EBLK - 1) / EBLK; tab[e] = us; tab[33 + e] = ps; tab[66 + e] = nb > 0 ? nb : 1; us += nb * (NT); ps += nb * EBLK; } tab[32] = us; tab[65] = ps; } __syncthreads(); } while (0)

    if (IN(11)) {
        BUILD_TAB(1);
        for (int s = blockIdx.x * (NWAVES * 64) + F.tid; s < NK; s += F.G * NWAVES * 64) { const int e = ASGE[s], pos = ASGP[s]; RSLOT[tab[33 + e] + pos] = s; }
        CVT_PULL(CV_UP);
        SEAM(11);
    }

    if (IN(12)) {
        BUILD_TAB(16);
        const int gc = (F.G == 256) ? GC_P12 : F.G; const int bx = (int)blockIdx.x;
        if ((bx >> 3) < (gc >> 3) || F.G != 256) {
            pg8::MoeSched Sc{(const char*)TB, (const char*)WUPT, 16, (size_t)2 * DFF * D, (size_t)128 * D, (size_t)DFF * D, tab, gc, (F.G == 256) ? (bx & 7) * (gc >> 3) + (bx >> 3) : F.vcu, true, (size_t)D};
            pg8::EpiUp E{b_up, ACT};
            LAS int* gtab = (LAS int*)(lx + LX_RPART);
            { int slv[8]; bool okv[8];
#pragma unroll
              for (int k = 0; k < 8; ++k) { pg8::Unit uu; okv[k] = Sc.next(2 * k + (F.tid >> 8), uu); slv[k] = RSLOT[(okv[k] ? uu.r0 : 0) + (F.tid & 255)]; }
#pragma unroll
              for (int k = 0; k < 8; ++k) if (okv[k]) gtab[(2 * k + (F.tid >> 8)) * 256 + (F.tid & 255)] = (slv[k] < 0 ? 0 : slv[k]) >> 2; }
            __syncthreads();
            pg8::gemm_phase_db6<pg8::EpiUp, pg8::MoeSched>(F.lds, D / 2, D / 2, D / 2, Sc, E, gtab);
            MARK_DONE(12);
        }
        CVT_BESIDE(CV_ALL, 12, gc);
        CVT_PULL(CV_ALL);
        SEAM(12);
    }

    if (IN(13)) {
        BUILD_TAB(8);
        pg8::MoeSched Sc{(const char*)ACT, (const char*)WDNT, 8, (size_t)D * DFF, (size_t)256 * DFF, (size_t)128 * DFF, tab, F.G, F.vcu, false, (size_t)DFF};
        pg8::EpiDown E{b_down, RSLOT, GATE, SLOT};
        pg8::gemm_phase<pg8::EpiDown, pg8::MoeSched, true, false, 1>(F.lds, DFF / 2, DFF / 2, DFF / 2, Sc, E);
        SEAM(13);
    }

    if (IN(14)) {
        for (int m = gw; m < S; m += NGW) {
            const u32x2* xr = (const u32x2*)(H2 + (size_t)m * D) + F.lane; f32x4 v[8]; float s = 0.f;
#pragma unroll
            for (int j = 0; j < 8; ++j) { const u32x2 hw = __builtin_nontemporal_load(xr + 64 * j); v[j] = (f32x4){bf_lo(hw.x), bf_hi(hw.x), bf_lo(hw.y), bf_hi(hw.y)};
#pragma unroll
                for (int k = 0; k < 4; ++k) { const int w = (int)*((const unsigned*)(SLOT + (size_t)(m * 4 + k) * D) + F.lane + 64 * j); const f32x2 lo = __builtin_amdgcn_cvt_pk_f32_fp8(w, false), hi = __builtin_amdgcn_cvt_pk_f32_fp8(w, true);
                    v[j].x += lo.x * 0.0625f; v[j].y += lo.y * 0.0625f; v[j].z += hi.x * 0.0625f; v[j].w += hi.y * 0.0625f; }
                s += (v[j].x * v[j].x + v[j].y * v[j].y) + (v[j].z * v[j].z + v[j].w * v[j].w); }
            const float rstd = 1.0f / sqrtf(wave_sum(s) * (1.0f / D) + RMS_EPS);
            const f32x4* gr = (const f32x4*)final_norm + F.lane; f32x4* o = (f32x4*)(args.out + (size_t)m * D) + F.lane; f32x4 gv[8];
#pragma unroll
            for (int j = 0; j < 8; ++j) gv[j] = gr[64 * j];
#pragma unroll
            for (int j = 0; j < 8; ++j) o[64 * j] = v[j] * rstd * gv[j];
        }
    }
#undef IN
#undef SEAM
}

extern "C" void kernel_launch(void* const* d_in, const int* in_sizes, int n_in, void* d_out, int out_size, void* d_ws, size_t ws_size, hipStream_t stream) {
    static int grid = 0;
    if (grid == 0) {
        if (n_in != 24 || out_size != S * D || ws_size < WS_END) { fprintf(stderr, "kernel_launch: unexpected shapes (n_in %d out %d ws %zu need %zu)\n", n_in, out_size, ws_size, (size_t)WS_END); grid = -1; return; }
        int dev = 0, cus = 0, per_cu = 0;
        if (hipGetDevice(&dev) != hipSuccess || hipDeviceGetAttribute(&cus, hipDeviceAttributeMultiprocessorCount, dev) != hipSuccess) { grid = -1; return; }
        if (hipFuncSetAttribute((const void*)moe_fwd, hipFuncAttributeMaxDynamicSharedMemorySize, LDS_BYTES) != hipSuccess) { fprintf(stderr, "kernel_launch: hipFuncSetAttribute failed\n"); grid = -1; return; }
        if (hipOccupancyMaxActiveBlocksPerMultiprocessor(&per_cu, (const void*)moe_fwd, NWAVES * 64, LDS_BYTES) != hipSuccess || per_cu < 1) { fprintf(stderr, "kernel_launch: occupancy query says %d\n", per_cu); per_cu = 1; }
        (void)hipGetLastError();
        grid = cus;
    }
    if (grid < 0) return;
    (void)hipMemsetAsync((char*)d_ws + WS_CTL, 0, CTL_ZERO_BYTES, stream);
    Args a{};
    for (int i = 0; i < 24; ++i) a.in[i] = (const float*)d_in[i];
    a.out = (float*)d_out; a.ws = (unsigned char*)d_ws;
#if MK_ONE_LAUNCH
    a.ph_lo = 0; a.ph_hi = NPHASE;
    hipLaunchKernelGGL(moe_fwd, dim3(grid), dim3(NWAVES * 64), LDS_BYTES, stream, a);
#else
    for (int p = 0; p < NPHASE; ++p) { a.ph_lo = p; a.ph_hi = p + 1; for (int rep = 0; rep < (((REPEAT_MASK >> p) & 1) ? 2 : 1); ++rep) hipLaunchKernelGGL(moe_fwd, dim3(grid), dim3(NWAVES * 64), LDS_BYTES, stream, a); }
#endif
}
```
